# Optimizing an MI355X kernel written in HIP

```python
import jax, jax.numpy as jnp
from jax import lax
import numpy as np

D_MODEL = 2048
BATCH = 4
SEQ = 8192
DEPTH = 2

CHUNK = 64
D_MIX = D_MODEL
F32 = jnp.float32

A_HEAD_DIM = 128
A_HEADS = (D_MIX // 2) // A_HEAD_DIM
IDX_HEADS = 16
IDX_DIM = 64
IDX_W_SCALE = (IDX_HEADS * IDX_DIM) ** -0.5
TOPK_MAX = 256
Q_BLOCK = 128
ROPE_THETA = 500000.0
ROPE_FRAC = 4

R_HEADS = 4
R_V_DIM = (D_MIX // 4) // R_HEADS
R_QK_DIM = R_V_DIM // 2
R_THETA = 10000.0

W_HEAD_DIM = 64
W_HEADS = (D_MIX // 4) // W_HEAD_DIM
DECAY_LORA = 96
AAA_LORA = 96
MV_LORA = 64
GATE_LORA = 256
LNX_EPS = 64e-5

D_FF = -(-(8 * D_MODEL) // (3 * 256)) * 256

A_W = A_HEADS * A_HEAD_DIM
B_QK_W = R_HEADS * R_QK_DIM
B_V_W = R_HEADS * R_V_DIM
C_W = W_HEADS * W_HEAD_DIM
SPLIT_AB = [A_W, A_W, A_W, IDX_HEADS * IDX_DIM, IDX_DIM, IDX_HEADS, B_QK_W, B_QK_W, B_V_W, B_V_W]
SPLIT_C = [C_W, C_W, C_W, DECAY_LORA, AAA_LORA, GATE_LORA]
N_AB = sum(SPLIT_AB)
N_C = sum(SPLIT_C)
N_IN = N_AB + N_C

kernel_name = 'hybrid_dsa_retention_rwkv7_chunk_encoder'


def split_cols(t, sizes):
    offs, acc = [], 0
    for s in sizes[:-1]:
        acc += s
        offs.append(acc)
    return jnp.split(t, offs, axis=-1)


def heads(t, n, d):
    return t.reshape(t.shape[0], t.shape[1], n, d)


def rms_norm(x, g, eps=1e-5):
    xf = x.astype(F32)
    y = xf * lax.rsqrt(jnp.mean(xf * xf, axis=-1, keepdims=True) + eps)
    return (y * g.astype(F32)).astype(x.dtype)


def head_norm(y, eps):
    yf = y.astype(F32)
    mu = jnp.mean(yf, axis=-1, keepdims=True)
    var = jnp.mean(jnp.square(yf - mu), axis=-1, keepdims=True)
    return (yf - mu) * lax.rsqrt(var + eps)


def rope(x, pos, rot_dim, theta):
    half = rot_dim // 2
    freqs = jnp.power(F32(theta), -jnp.arange(half, dtype=F32) / half)
    ang = pos.astype(F32)[:, None] * freqs[None, :]
    cos = jnp.cos(ang)[:, None, :]
    sin = jnp.sin(ang)[:, None, :]
    xf = x.astype(F32)
    x1, x2, rest = xf[..., :half], xf[..., half:rot_dim], xf[..., rot_dim:]
    return jnp.concatenate([x1 * cos - x2 * sin, x2 * cos + x1 * sin, rest], axis=-1).astype(x.dtype)


def token_shift(p, mu):
    prev = jnp.pad(p, ((0, 0), (1, 0), (0, 0)))[:, :-1]
    return p + (prev - p) * mu


def sparse_indexer_attention(q, k, v, q_idx, k_idx, w_idx):
    bsz, seq = q.shape[0], q.shape[1]
    top_k = min(TOPK_MAX, seq // 4)
    n_blk = seq // Q_BLOCK
    key_chunk = jnp.arange(seq) // CHUNK
    qpos = jnp.arange(seq).reshape(n_blk, Q_BLOCK)
    scale = A_HEAD_DIM ** -0.5
    gather = jax.vmap(lambda src, ii: src[ii])

    def to_blocks(t):
        return jnp.moveaxis(t.reshape((bsz, n_blk, Q_BLOCK) + t.shape[2:]), 1, 0)

    def one_block(args):
        qb, qib, wb, pb = args
        q_chunk = pb // CHUNK
        rel = jax.nn.relu(jnp.einsum('bqhd,bsd->bqhs', qib, k_idx).astype(F32))
        score = jnp.einsum('bqhs,bqh->bqs', rel, wb.astype(F32))
        adm = key_chunk[None, :] <= q_chunk[:, None]
        score = jnp.where(adm[None], score, -jnp.inf)
        _, idx = lax.top_k(score, top_k)
        valid = (idx // CHUNK) <= q_chunk[None, :, None]
        kg = gather(k, idx)
        vg = gather(v, idx)
        s = jnp.einsum('bqhd,bqkhd->bhqk', qb, kg).astype(F32) * scale
        s = jnp.where(valid[:, None], s, -jnp.inf)
        p = jax.nn.softmax(s, axis=-1).astype(v.dtype)
        return jnp.einsum('bhqk,bqkhd->bqhd', p, vg)

    out = lax.map(one_block, (to_blocks(q), to_blocks(q_idx), to_blocks(w_idx), qpos))
    return jnp.moveaxis(out, 0, 1).reshape(bsz, seq, -1)


def retention(q, k, v):
    bsz, seq, nh, dk = q.shape
    dv = v.shape[-1]
    nc = seq // CHUNK
    log_g = jnp.log1p(-jnp.power(2.0, -5.0 - jnp.arange(nh, dtype=F32)))
    pos = jnp.arange(CHUNK, dtype=F32)
    diff = pos[:, None] - pos[None, :]
    decay = jnp.where(diff >= 0, jnp.exp(jnp.maximum(diff, 0.0)[None] * log_g[:, None, None]), 0.0)
    zeta = jnp.exp((CHUNK - 1.0 - pos)[None, :] * log_g[:, None])
    xi = jnp.exp((pos + 1.0)[None, :] * log_g[:, None])
    g_chunk = jnp.exp(CHUNK * log_g)
    qc = q.astype(F32).reshape(bsz, nc, CHUNK, nh, dk)
    kc = k.astype(F32).reshape(bsz, nc, CHUNK, nh, dk) * dk ** -0.5
    vc = v.astype(F32).reshape(bsz, nc, CHUNK, nh, dv)
    scores = jnp.einsum('bcnhd,bcmhd->bchnm', qc, kc) * decay
    intra = jnp.einsum('bchnm,bcmhe->bcnhe', scores, vc)
    kv = jnp.einsum('bcmhd,bcmhe,hm->bchde', kc, vc, zeta)

    def step(state, kv_c):
        return state * g_chunk[None, :, None, None] + kv_c, state

    _, prev = lax.scan(step, jnp.zeros((bsz, nh, dk, dv), F32), jnp.moveaxis(kv, 1, 0))
    cross = jnp.einsum('bcnhd,cbhde,hn->bcnhe', qc, prev, xi)
    return (intra + cross).reshape(bsz, seq, nh, dv)


def wkv7_scan(r, w, k, v, a, b):
    bsz, _, nh, n = r.shape

    def step(state, inp):
        r_t, w_t, k_t, v_t, a_t, b_t = inp
        sa = jnp.einsum('bhij,bhj->bhi', state, a_t)
        state = state * w_t[:, :, None, :] + sa[..., None] * b_t[:, :, None, :] + v_t[..., None] * k_t[:, :, None, :]
        return state, jnp.einsum('bhij,bhj->bhi', state, r_t)

    xs = tuple(jnp.moveaxis(t, 1, 0) for t in (r, w, k, v, a, b))
    _, y = lax.scan(step, jnp.zeros((bsz, nh, n, n), F32), xs)
    return jnp.moveaxis(y, 0, 1)


def rwkv7_branch(c, mu, w0, w_lb, a0, a_lb, g_lb, k_k, k_a, r_k, lnx_g, lnx_b, v_first, v0, v_lb):
    bsz, seq = c.shape[0], c.shape[1]
    c = token_shift(c, mu)
    has_vres = v0 is not None
    parts = split_cols(c, (SPLIT_C + [MV_LORA]) if has_vres else SPLIT_C)
    r, k, v, wl, al, gl = parts[:6]
    w_log = -jax.nn.softplus(-(w0 + jnp.tanh(wl) @ w_lb)) - 0.5
    decay = jnp.exp(-jnp.exp(w_log.astype(F32)))
    a = jax.nn.sigmoid(a0 + al @ a_lb)
    g = jax.nn.sigmoid(gl) @ g_lb
    if has_vres:
        v = v + (v_first - v) * jax.nn.sigmoid(v0 + parts[6] @ v_lb)
    else:
        v_first = v
    hs = lambda t: t.reshape(bsz, seq, W_HEADS, W_HEAD_DIM).astype(F32)
    kk = hs(k * k_k)
    kk = kk / jnp.maximum(jnp.sqrt(jnp.sum(kk * kk, axis=-1, keepdims=True)), 1e-12)
    k_h = hs(k * (1.0 + (a - 1.0) * k_a))
    r_h, v_h, a_h = hs(r), hs(v), hs(a)
    y = wkv7_scan(r_h, hs(decay), k_h, v_h, -kk, kk * a_h)
    y = head_norm(y, LNX_EPS).reshape(bsz, seq, C_W) * lnx_g + lnx_b
    bonus = jnp.sum(r_h * k_h * r_k, axis=-1, keepdims=True) * v_h
    out = (y + bonus.reshape(bsz, seq, C_W)) * g
    return out.astype(c.dtype), v_first


def setup_inputs(seed: int = 0) -> dict:
    key = jax.random.key(seed)
    ks = iter(jax.random.split(key, 32))
    nrm = lambda shape, scale: jax.random.normal(next(ks), shape, F32) * scale
    uni = lambda shape, lo, hi: jax.random.uniform(next(ks), shape, F32, lo, hi)
    return {
        'x': nrm((BATCH, SEQ, D_MODEL), 1.0),
        'norm_mix_g': 1.0 + nrm((DEPTH, D_MODEL), 0.02),
        'w_in': nrm((DEPTH, D_MODEL, N_IN), D_MODEL ** -0.5),
        'w_in_vres': nrm((DEPTH - 1, D_MODEL, MV_LORA), D_MODEL ** -0.5),
        'rwkv_mu': uni((DEPTH, N_C), 0.0, 1.0),
        'rwkv_mu_vres': uni((DEPTH - 1, MV_LORA), 0.0, 1.0),
        'rwkv_w0': uni((DEPTH, C_W), -6.0, -1.0),
        'rwkv_w_lora_b': nrm((DEPTH, DECAY_LORA, C_W), 0.1 * DECAY_LORA ** -0.5),
        'rwkv_a0': nrm((DEPTH, C_W), 0.1),
        'rwkv_a_lora_b': nrm((DEPTH, AAA_LORA, C_W), AAA_LORA ** -0.5),
        'rwkv_v0': 1.0 + nrm((DEPTH - 1, C_W), 0.1),
        'rwkv_v_lora_b': nrm((DEPTH - 1, MV_LORA, C_W), MV_LORA ** -0.5),
        'rwkv_g_lora_b': nrm((DEPTH, GATE_LORA, C_W), GATE_LORA ** -0.5),
        'rwkv_k_k': 0.85 + nrm((DEPTH, C_W), 0.02),
        'rwkv_k_a': 1.0 + nrm((DEPTH, C_W), 0.02),
        'rwkv_r_k': nrm((DEPTH, W_HEADS, W_HEAD_DIM), 0.1),
        'rwkv_lnx_g': 1.0 + nrm((DEPTH, C_W), 0.02),
        'rwkv_lnx_b': nrm((DEPTH, C_W), 0.02),
        'w_out': nrm((DEPTH, D_MIX, D_MODEL), D_MIX ** -0.5),
        'norm_ffn_g': 1.0 + nrm((DEPTH, D_MODEL), 0.02),
        'w_gate_up': nrm((DEPTH, D_MODEL, 2 * D_FF), D_MODEL ** -0.5),
        'w_down': nrm((DEPTH, D_FF, D_MODEL), D_FF ** -0.5),
        'final_norm_g': 1.0 + nrm((D_MODEL,), 0.02),
    }


def reference(x, norm_mix_g, w_in, w_in_vres, rwkv_mu, rwkv_mu_vres, rwkv_w0, rwkv_w_lora_b,
              rwkv_a0, rwkv_a_lora_b, rwkv_v0, rwkv_v_lora_b, rwkv_g_lora_b, rwkv_k_k, rwkv_k_a,
              rwkv_r_k, rwkv_lnx_g, rwkv_lnx_b, w_out, norm_ffn_g, w_gate_up, w_down, final_norm_g):
    bsz, seq = x.shape[0], x.shape[1]
    positions = jnp.arange(seq)
    v_first = None
    for l in range(DEPTH):
        h = rms_norm(x, norm_mix_g[l])
        w_full = w_in[l] if l == 0 else jnp.concatenate([w_in[l], w_in_vres[l - 1]], axis=1)
        proj = h @ w_full
        a_q, a_k, a_v, a_qi, a_ki, a_wi, b_q, b_k, b_v, b_g = split_cols(proj[..., :N_AB], SPLIT_AB)
        c_cols = proj[..., N_AB:]

        q = rope(heads(a_q, A_HEADS, A_HEAD_DIM), positions, A_HEAD_DIM // ROPE_FRAC, ROPE_THETA)
        k = rope(heads(a_k, A_HEADS, A_HEAD_DIM), positions, A_HEAD_DIM // ROPE_FRAC, ROPE_THETA)
        v = heads(a_v, A_HEADS, A_HEAD_DIM)
        qi = rope(heads(a_qi, IDX_HEADS, IDX_DIM), positions, IDX_DIM // ROPE_FRAC, ROPE_THETA)
        ki = rope(a_ki[:, :, None, :], positions, IDX_DIM // ROPE_FRAC, ROPE_THETA)[:, :, 0]
        out_a = sparse_indexer_attention(q, k, v, qi, ki, a_wi * IDX_W_SCALE)

        rq = rope(heads(b_q, R_HEADS, R_QK_DIM), positions, R_QK_DIM, R_THETA)
        rk = rope(heads(b_k, R_HEADS, R_QK_DIM), positions, R_QK_DIM, R_THETA)
        ret = retention(rq, rk, heads(b_v, R_HEADS, R_V_DIM))
        out_b = (head_norm(ret, 1e-5).reshape(bsz, seq, B_V_W) * jax.nn.silu(b_g.astype(F32))).astype(x.dtype)

        if l == 0:
            mu_l, v0_l, v_lb_l = rwkv_mu[l], None, None
        else:
            mu_l = jnp.concatenate([rwkv_mu[l], rwkv_mu_vres[l - 1]])
            v0_l, v_lb_l = rwkv_v0[l - 1], rwkv_v_lora_b[l - 1]
        out_c, v_first = rwkv7_branch(c_cols, mu_l, rwkv_w0[l], rwkv_w_lora_b[l], rwkv_a0[l],
                                      rwkv_a_lora_b[l], rwkv_g_lora_b[l], rwkv_k_k[l], rwkv_k_a[l],
                                      rwkv_r_k[l], rwkv_lnx_g[l], rwkv_lnx_b[l], v_first, v0_l, v_lb_l)

        x = x + jnp.concatenate([out_a, out_b, out_c], axis=-1) @ w_out[l]

        h = rms_norm(x, norm_ffn_g[l])
        gate, up = jnp.split(h @ w_gate_up[l], 2, axis=-1)
        x = x + (jax.nn.silu(gate) * up) @ w_down[l]
    return rms_norm(x, final_norm_g)
```

```cpp
#include <hip/hip_runtime.h>
#include <hip/hip_fp16.h>
#include <cstdio>
#include <cstdint>
namespace pg8 {
#define PG8_LAS __attribute__((address_space(3)))
typedef unsigned short bf16_t;
typedef short bf16x8 __attribute__((ext_vector_type(8)));
typedef float f32x4 __attribute__((ext_vector_type(4)));
typedef unsigned u32x4 __attribute__((ext_vector_type(4)));
constexpr int BM = 256, BK = 64, HALF = 128, HTB = HALF * BK * 2  , STAGE_BYTES = 8 * HTB, NXCD = 8, WGM = 8;

__host__ __device__ __forceinline__ int lds_byte(int r, int c) { const int st = (r >> 4) * 2 + (c >> 5), rr = r & 15, cc = c & 31, ob = rr * 64 + cc * 2; return st * 1024 + (ob ^ (((ob >> 9) & 1) << 5)); }
__host__ __device__ __forceinline__ void stage_rc(int b, int& R, int& C) { const int st = b / 1024, sb = b % 1024, swz = sb ^ (((sb >> 9) & 1) << 5); R = (st >> 1) * 16 + swz / 64; C = (st & 1) * 32 + (swz % 64) / 2; }
__host__ __device__ __forceinline__ int perm32(int rho) { const int n = rho >> 4, i = rho & 15; return 8 * (i >> 2) + 4 * n + (i & 3); }

struct Unit { int pm, pn; };
struct Gemm { const bf16_t* A; const bf16_t* Bt; int M, N, K; };

struct StaticOrder {
    int nM, nN, nwg, G, c;
    __host__ __device__ void init(int M, int N, int G_, int c_) { nM = M / BM; nN = N / BM; nwg = nM * nN; G = G_; c = c_; }
    __host__ __device__ bool next(int i, Unit& u) const {
        const long L = (long)i * G + c; if (L >= nwg) return false;
        int wgid = (int)L; { const int q = nwg / NXCD, r = nwg % NXCD, xcd = wgid % NXCD, off = wgid / NXCD; wgid = (xcd < r ? xcd * (q + 1) : r * (q + 1) + (xcd - r) * q) + off; }
        const int nig = WGM * nN, gid = wgid / nig, fm = gid * WGM, gsz = (nM - fm) < WGM ? (nM - fm) : WGM;
        u.pm = fm + ((wgid % nig) % gsz); u.pn = (wgid % nig) / gsz; return true;
    }
    __device__ __forceinline__ void a_ready(const Unit&) const {}
    __device__ __forceinline__ void done(const Unit&) const {}
};

__device__ __forceinline__ unsigned cvt_pk_bf16(float lo, float hi) { unsigned r; asm volatile("v_cvt_pk_bf16_f32 %0, %1, %2" : "=v"(r) : "v"(lo), "v"(hi)); return r; }
typedef float f32x2 __attribute__((ext_vector_type(2)));
__device__ __forceinline__ f32x2 gelu_pk(f32x2 v) {
    const f32x2 av = __builtin_elementwise_abs(v), d = av * 0.2316418882f + 1.0f;
    f32x2 t; t.x = __builtin_amdgcn_rcpf(d.x); t.y = __builtin_amdgcn_rcpf(d.y);
    f32x2 q = t * 0.5307027145f + (-0.7265760135f); q = q * t + 0.7107068705f; q = q * t + (-0.142248368f); q = q * t + 0.127414796f; q = q * t;
    const f32x2 s = (v * v) * (-0.72134752044f);
    f32x2 e; e.x = __builtin_amdgcn_exp2f(s.x); e.y = __builtin_amdgcn_exp2f(s.y);
    const f32x2 m = v * (q * e), r = v - m;
    f32x2 o; o.x = v.x < 0.f ? m.x : r.x; o.y = v.y < 0.f ? m.y : r.y; return o;
}

template <int ACT  > struct EpiBf16 {
    static constexpr bool PERM = true, AFTER_DRAIN = false; static_assert(ACT == 0 || ACT == 1, "EpiBf16: ACT is 0 (none) or 1 (gelu_pk)");
    bf16_t* O; int ldc; const float* bias; int split_cols; size_t split_stride; float scale0;
    __device__ __forceinline__ void operator()(const f32x4 (&acc)[2][2][4][2], const Unit& u, int wr, int wc, int fr, int fq) const {
        const int row0 = u.pm * BM + wr * 64 + fr; int colt = u.pn * BM; bf16_t* base = O;
        float sc = 1.f; if (split_cols) { const int t = colt / split_cols; base += (size_t)t * split_stride; colt -= t * split_cols; if (t == 0) sc = scale0; }
        const int col0 = colt + wc * 32 + 8 * fq, bcol0 = u.pn * BM + wc * 32 + 8 * fq;
        f32x4 bv[2][2];
#pragma unroll
        for (int bj = 0; bj < 2; ++bj)
#pragma unroll
            for (int n = 0; n < 2; ++n) bv[bj][n] = bias ? *(const f32x4*)(bias + bcol0 + bj * HALF + 4 * n) : (f32x4){0.f, 0.f, 0.f, 0.f};
#pragma unroll
        for (int ai = 0; ai < 2; ++ai)
#pragma unroll
            for (int m = 0; m < 4; ++m) { bf16_t* rowp = base + (size_t)(row0 + ai * HALF + m * 16) * ldc + col0;
#pragma unroll
                for (int bj = 0; bj < 2; ++bj) { f32x4 v0 = acc[ai][bj][m][0] + bv[bj][0], v1 = acc[ai][bj][m][1] + bv[bj][1];
                    if (ACT == 1) { f32x2 a = gelu_pk((f32x2){v0[0], v0[1]}), b = gelu_pk((f32x2){v0[2], v0[3]}), c = gelu_pk((f32x2){v1[0], v1[1]}), d = gelu_pk((f32x2){v1[2], v1[3]});
                        v0 = (f32x4){a.x, a.y, b.x, b.y}; v1 = (f32x4){c.x, c.y, d.x, d.y}; }
                    v0 = v0 * sc; v1 = v1 * sc; u32x4 w; w.x = cvt_pk_bf16(v0[0], v0[1]); w.y = cvt_pk_bf16(v0[2], v0[3]); w.z = cvt_pk_bf16(v1[0], v1[1]); w.w = cvt_pk_bf16(v1[2], v1[3]);
                    *(u32x4*)(rowp + bj * HALF) = w; } }
    }
};

__device__ __forceinline__ void tile_dest(int pn, size_t& off, int& ld, int& colt);
struct EpiProj {
    static constexpr bool PERM = true, AFTER_DRAIN = false;
    unsigned char* ws;
    __device__ __forceinline__ void operator()(const f32x4 (&acc)[2][2][4][2], const Unit& u, int wr, int wc, int fr, int fq) const {
        size_t off; int ld, colt; tile_dest(u.pn, off, ld, colt);
        bf16_t* base = (bf16_t*)(ws + off);
        const int row0 = u.pm * BM + wr * 64 + fr, col0 = colt + wc * 32 + 8 * fq;
#pragma unroll
        for (int ai = 0; ai < 2; ++ai)
#pragma unroll
            for (int m = 0; m < 4; ++m) { bf16_t* rowp = base + (size_t)(row0 + ai * HALF + m * 16) * ld + col0;
#pragma unroll
                for (int bj = 0; bj < 2; ++bj) { const f32x4 v0 = acc[ai][bj][m][0], v1 = acc[ai][bj][m][1];
                    u32x4 w; w.x = cvt_pk_bf16(v0[0], v0[1]); w.y = cvt_pk_bf16(v0[2], v0[3]); w.z = cvt_pk_bf16(v1[0], v1[1]); w.w = cvt_pk_bf16(v1[2], v1[3]);
                    *(u32x4*)(rowp + bj * HALF) = w; } }
    }
};
struct EpiResid {
    static constexpr bool PERM = false, AFTER_DRAIN = false;
    const float* base; float* out; int ldc;
    __device__ __forceinline__ void operator()(const f32x4 (&acc)[2][2][4][2], const Unit& u, int wr, int wc, int fr, int fq) const {
        const int row0 = u.pm * BM + wr * 64 + fr, col0 = u.pn * BM + wc * 32 + 4 * fq;
#pragma unroll
        for (int ai = 0; ai < 2; ++ai)
#pragma unroll
            for (int m = 0; m < 4; ++m) { const size_t off = (size_t)(row0 + ai * HALF + m * 16) * ldc + col0;
#pragma unroll
                for (int bj = 0; bj < 2; ++bj)
#pragma unroll
                    for (int n = 0; n < 2; ++n) { const size_t p = off + bj * HALF + n * 16; const f32x4 b = *(const f32x4*)(base + p); *(f32x4*)(out + p) = b + acc[ai][bj][m][n]; } }
    }
};
struct EpiSwiGLU {
    static constexpr bool PERM = true, AFTER_DRAIN = false;
    bf16_t* O; int ldc;
    __device__ __forceinline__ static float silu_mul(float g, float u) { return g * u * __builtin_amdgcn_rcpf(1.0f + __expf(-g)); }
    __device__ __forceinline__ void operator()(const f32x4 (&acc)[2][2][4][2], const Unit& u, int wr, int wc, int fr, int fq) const {
        const int row0 = u.pm * BM + wr * 64 + fr, col0 = u.pn * HALF + wc * 32 + 8 * fq;
#pragma unroll
        for (int ai = 0; ai < 2; ++ai)
#pragma unroll
            for (int m = 0; m < 4; ++m) { bf16_t* rowp = O + (size_t)(row0 + ai * HALF + m * 16) * ldc + col0;
                const f32x4 g0 = acc[ai][0][m][0], g1 = acc[ai][0][m][1], u0 = acc[ai][1][m][0], u1 = acc[ai][1][m][1];
                u32x4 w; w.x = cvt_pk_bf16(silu_mul(g0[0], u0[0]), silu_mul(g0[1], u0[1])); w.y = cvt_pk_bf16(silu_mul(g0[2], u0[2]), silu_mul(g0[3], u0[3]));
                w.z = cvt_pk_bf16(silu_mul(g1[0], u1[0]), silu_mul(g1[1], u1[1])); w.w = cvt_pk_bf16(silu_mul(g1[2], u1[2]), silu_mul(g1[3], u1[3]));
                *(u32x4*)rowp = w; }
    }
};
template <class Epi, class Sched, bool ALIGN_EPI = false, bool SP2 = false>
__device__ __forceinline__ void gemm_phase(PG8_LAS unsigned char* lds, const Gemm g, const Sched& S, const Epi& E) {
    int tid_ = threadIdx.x; asm volatile("" : "+v"(tid_));
    const int tid = tid_, wid = __builtin_amdgcn_readfirstlane(tid >> 6), lane = tid & 63, wr = wid >> 2, wc = wid & 3, fr = lane & 15, fq = lane >> 4;
    const int K = g.K, nt = K / BK;
    unsigned voffA[2], voffB[2];
#pragma unroll
    for (int i = 0; i < 2; ++i) { int R, C; stage_rc(tid * 16 + i * 8192, R, C); const int Rb = Epi::PERM ? ((R & ~31) + perm32(R & 31)) : R;
        voffA[i] = (unsigned)(R * K + C) * 2u; voffB[i] = (unsigned)(Rb * K + C) * 2u; }
    const size_t kstep = (size_t)(BK * 2);
    const size_t hstep = (size_t)HALF * K * 2;
    const size_t tstep = 2 * hstep;
    const unsigned ldsw = (unsigned)wid * 1024u;
    const int aoff = lds_byte(wr * 64 + fr, fq * 8), boff = lds_byte(wc * 32 + fr, fq * 8);
#define PG8_SA(b, h) (((b) * 2 + (h)) * HTB)
#define PG8_SB(b, h) ((4 + (b) * 2 + (h)) * HTB)
#define PG8_STAGE(bufoff, gbase, voff) do { _Pragma("unroll") for (int _i = 0; _i < 2; ++_i) \
        __builtin_amdgcn_global_load_lds((const unsigned*)((const char*)(gbase) + (voff)[_i]), (PG8_LAS unsigned*)(lds + (bufoff) + ldsw + _i * 8192), 16, 0, 0); } while (0)
#define PG8_LDA(dst, b, h) do { _Pragma("unroll") for (int m = 0; m < 4; ++m) _Pragma("unroll") for (int k = 0; k < 2; ++k) dst[m][k] = *(const PG8_LAS bf16x8*)(lds + PG8_SA(b, h) + aoff + m * 2048 + k * 1024); } while (0)
#define PG8_LDB(dst, b, h) do { _Pragma("unroll") for (int n = 0; n < 2; ++n) _Pragma("unroll") for (int k = 0; k < 2; ++k) dst[n][k] = *(const PG8_LAS bf16x8*)(lds + PG8_SB(b, h) + boff + n * 2048 + k * 1024); } while (0)
#define PG8_MMA(ai, bj, At, Bt) do { __builtin_amdgcn_s_setprio(1); _Pragma("unroll") for (int m = 0; m < 4; ++m) _Pragma("unroll") for (int n = 0; n < 2; ++n) _Pragma("unroll") for (int k = 0; k < 2; ++k) \
        acc[ai][bj][m][n] = __builtin_amdgcn_mfma_f32_16x16x32_bf16(Bt[n][k], At[m][k], acc[ai][bj][m][n], 0, 0, 0); __builtin_amdgcn_s_setprio(0); } while (0)
#define PG8_WAIT_V(n) asm volatile("s_waitcnt vmcnt(" #n ")" ::: "memory")
#define PG8_WAIT_L(n) asm volatile("s_waitcnt lgkmcnt(" #n ")" ::: "memory")
#define PG8_BAR __builtin_amdgcn_s_barrier()
#define PG8_SCHED __builtin_amdgcn_sched_barrier(0)
    Unit cur, nxt; int ui = 0;
    if (!S.next(0, cur)) return;
    f32x4 acc[2][2][4][2];
#pragma unroll
    for (int a = 0; a < 2; ++a)
#pragma unroll
        for (int b = 0; b < 2; ++b)
#pragma unroll
            for (int m = 0; m < 4; ++m)
#pragma unroll
                for (int n = 0; n < 2; ++n) acc[a][b][m][n] = (f32x4){0.f, 0.f, 0.f, 0.f};
    bf16x8 At[4][2], B0[2][2], B1[2][2];
    const char* cA = (const char*)g.A + (size_t)cur.pm * tstep; const char* cB = (const char*)g.Bt + (size_t)cur.pn * tstep;
    S.a_ready(cur);
    if constexpr (SP2) {
        PG8_STAGE(PG8_SB(0, 0), cB, voffB); PG8_STAGE(PG8_SB(0, 1), cB + hstep, voffB); PG8_STAGE(PG8_SA(0, 0), cA, voffA); PG8_STAGE(PG8_SA(0, 1), cA + hstep, voffA);
        if (wr == 1) PG8_BAR;
        PG8_WAIT_V(2); PG8_BAR;
        PG8_STAGE(PG8_SB(1, 0), cB + kstep, voffB); PG8_STAGE(PG8_SA(1, 0), cA + kstep, voffA); PG8_STAGE(PG8_SB(1, 1), cB + hstep + kstep, voffB);
        PG8_WAIT_V(6); PG8_BAR;
    } else {
        PG8_STAGE(PG8_SB(0, 0), cB, voffB); PG8_STAGE(PG8_SA(0, 0), cA, voffA); PG8_STAGE(PG8_SB(0, 1), cB + hstep, voffB); PG8_STAGE(PG8_SA(0, 1), cA + hstep, voffA);
        if (wr == 1) PG8_BAR;
        PG8_WAIT_V(4); PG8_BAR;
        PG8_STAGE(PG8_SB(1, 0), cB + kstep, voffB); PG8_STAGE(PG8_SA(1, 0), cA + kstep, voffA); PG8_STAGE(PG8_SB(1, 1), cB + hstep + kstep, voffB);
        PG8_WAIT_V(6); PG8_BAR;
    }
    for (;;) {
        const bool has_next = S.next(ui + 1, nxt);
        const char* nA = has_next ? (const char*)g.A + (size_t)nxt.pm * tstep : cA; const char* nB = has_next ? (const char*)g.Bt + (size_t)nxt.pn * tstep : cB;
        for (int t = 0; t < nt; t += 2) {
            const bool last = (t == nt - 2);
            const char* a1 = cA + (size_t)(t + 1) * kstep;
            const char* a2 = last ? nA : cA + (size_t)(t + 2) * kstep; const char* b2 = last ? nB : cB + (size_t)(t + 2) * kstep;
            const char* a3 = a2 + kstep; const char* b3 = b2 + kstep;
            if (last && has_next) S.a_ready(nxt);
            if constexpr (SP2) {
            PG8_LDB(B0, 0, 0); PG8_LDB(B1, 0, 1); PG8_SCHED; PG8_LDA(At, 0, 0); PG8_STAGE(PG8_SA(1, 1), a1 + hstep, voffA);
            PG8_WAIT_V(8); PG8_WAIT_L(0); PG8_BAR; PG8_MMA(0, 0, At, B0); PG8_MMA(0, 1, At, B1); PG8_BAR; PG8_SCHED;
            PG8_LDA(At, 0, 1); PG8_STAGE(PG8_SB(0, 0), b2, voffB); PG8_STAGE(PG8_SB(0, 1), b2 + hstep, voffB); PG8_STAGE(PG8_SA(0, 0), a2, voffA);
            PG8_WAIT_V(8); PG8_WAIT_L(0); PG8_BAR; PG8_MMA(1, 0, At, B0); PG8_MMA(1, 1, At, B1); PG8_BAR; PG8_SCHED;
            PG8_LDB(B0, 1, 0); PG8_LDB(B1, 1, 1); PG8_SCHED; PG8_LDA(At, 1, 0); PG8_STAGE(PG8_SA(0, 1), a2 + hstep, voffA);
            PG8_WAIT_V(8); PG8_WAIT_L(0); PG8_BAR; PG8_MMA(0, 0, At, B0); PG8_MMA(0, 1, At, B1); PG8_BAR; PG8_SCHED;
            PG8_LDA(At, 1, 1); PG8_STAGE(PG8_SB(1, 0), b3, voffB); PG8_STAGE(PG8_SB(1, 1), b3 + hstep, voffB); PG8_STAGE(PG8_SA(1, 0), a3, voffA);
            PG8_WAIT_V(8); PG8_WAIT_L(0); PG8_BAR; PG8_MMA(1, 0, At, B0); PG8_MMA(1, 1, At, B1); PG8_BAR; PG8_SCHED;
            } else {
            PG8_LDB(B0, 0, 0); PG8_SCHED; PG8_LDA(At, 0, 0); PG8_STAGE(PG8_SA(1, 1), a1 + hstep, voffA);
            PG8_WAIT_L(8); PG8_BAR; PG8_WAIT_L(0); PG8_MMA(0, 0, At, B0); PG8_BAR; PG8_SCHED;
            PG8_LDB(B1, 0, 1); PG8_STAGE(PG8_SB(0, 0), b2, voffB);
            PG8_BAR; PG8_WAIT_L(0); PG8_MMA(0, 1, At, B1); PG8_BAR;
            PG8_LDA(At, 0, 1); PG8_STAGE(PG8_SA(0, 0), a2, voffA);
            PG8_BAR; PG8_WAIT_L(0); PG8_MMA(1, 0, At, B0); PG8_BAR; PG8_SCHED;
            PG8_STAGE(PG8_SB(0, 1), b2 + hstep, voffB);
            PG8_WAIT_V(6); PG8_BAR; PG8_MMA(1, 1, At, B1); PG8_BAR;
            PG8_LDB(B0, 1, 0); PG8_SCHED; PG8_LDA(At, 1, 0); PG8_STAGE(PG8_SA(0, 1), a2 + hstep, voffA);
            PG8_WAIT_L(8); PG8_BAR; PG8_WAIT_L(0); PG8_MMA(0, 0, At, B0); PG8_BAR; PG8_SCHED;
            PG8_LDB(B1, 1, 1); PG8_STAGE(PG8_SB(1, 0), b3, voffB);
            PG8_BAR; PG8_WAIT_L(0); PG8_MMA(0, 1, At, B1); PG8_BAR;
            PG8_LDA(At, 1, 1); PG8_STAGE(PG8_SA(1, 0), a3, voffA);
            PG8_BAR; PG8_WAIT_L(0); PG8_MMA(1, 0, At, B0); PG8_BAR; PG8_SCHED;
            PG8_STAGE(PG8_SB(1, 1), b3 + hstep, voffB);
            PG8_WAIT_V(6); PG8_BAR; PG8_MMA(1, 1, At, B1); PG8_BAR;
            }
        }
        if constexpr (ALIGN_EPI) { if (wr == 0) PG8_BAR; }
        if constexpr (!Epi::AFTER_DRAIN) { E(acc, cur, wr, wc, fr, fq); S.done(cur); }
        if (!has_next) break;
#pragma unroll
        for (int a = 0; a < 2; ++a)
#pragma unroll
            for (int b = 0; b < 2; ++b)
#pragma unroll
                for (int m = 0; m < 4; ++m)
#pragma unroll
                    for (int n = 0; n < 2; ++n) acc[a][b][m][n] = (f32x4){0.f, 0.f, 0.f, 0.f};
        cur = nxt; cA = nA; cB = nB; ++ui;
        if constexpr (ALIGN_EPI) { if (wr == 1) PG8_BAR; }
    }
    PG8_WAIT_V(0);
    if constexpr (!ALIGN_EPI) { if (wr == 0) PG8_BAR; }
    PG8_BAR;
    if constexpr (Epi::AFTER_DRAIN) { E.fused(acc, cur, wr, wc, fr, fq, lds, wid, lane); S.done(cur); }
#undef PG8_SA
#undef PG8_SB
#undef PG8_STAGE
#undef PG8_LDA
#undef PG8_LDB
#undef PG8_MMA
#undef PG8_WAIT_V
#undef PG8_WAIT_L
#undef PG8_BAR
#undef PG8_SCHED
}
}
constexpr int NB = 4, T = 8192, M = NB * T, DM = 2048, DFF = 5632, DEPTH = 2;
constexpr int N_IN = 7696, N_INP = 7936;
constexpr int NWAVES = 8, NTHR = NWAVES * 64;
#define LAS __attribute__((address_space(3)))
#define GAS __attribute__((address_space(1)))
#define CAS __attribute__((address_space(4)))
typedef unsigned short bf16;
typedef short bf16x8 __attribute__((ext_vector_type(8)));
typedef float f32x4 __attribute__((ext_vector_type(4)));
typedef float f32x16 __attribute__((ext_vector_type(16)));
typedef unsigned u32x4 __attribute__((ext_vector_type(4)));
typedef unsigned u32x2 __attribute__((ext_vector_type(2)));
typedef unsigned long long u64;

constexpr size_t MiB = 1u << 20;
constexpr size_t WS_CTL = 0, CTL_ZERO_BYTES = 1 * MiB;
constexpr size_t WS_WIN = 1 * MiB, WS_WOUT = 32 * MiB, WS_WGU = 40 * MiB, WS_WDN = 84 * MiB;
constexpr size_t WS_LORA = 106 * MiB;
constexpr size_t LO_W = 0, LO_A = 512 * 96 * 2, LO_V = 2 * 512 * 96 * 2, LO_G = LO_V + 512 * 64 * 2;
constexpr size_t WS_VFIRST = 107 * MiB;
constexpr size_t WS_H = 139 * MiB;
constexpr size_t WS_VT = 139 * MiB, WS_MASK = 203 * MiB;
constexpr size_t WS_Q = 267 * MiB, WS_K = 331 * MiB, WS_QI = 395 * MiB, WS_V = 459 * MiB, WS_KW = 523 * MiB, WS_BQ = 539 * MiB, WS_BK = 555 * MiB, WS_BV = 571 * MiB, WS_BG = 603 * MiB;
constexpr size_t WS_CR = 635 * MiB, WS_CK = 667 * MiB, WS_CV = 699 * MiB, WS_CL = 731 * MiB, WS_CG = 747 * MiB;
constexpr size_t WS_CAT = 763 * MiB;
constexpr size_t WS_KVST = 891 * MiB;
constexpr size_t WS_TAB = 955 * MiB;
constexpr size_t TAB_A = 0, TAB_I = (size_t)T * 16 * 8, TAB_R = TAB_I + (size_t)T * 8 * 8, TAB_END = TAB_R + (size_t)T * 32 * 8;
constexpr size_t WS_RR = 139 * MiB, WS_RW = 203 * MiB, WS_RKH = 267 * MiB, WS_RV = 331 * MiB, WS_RA = 395 * MiB, WS_RB = 459 * MiB;
constexpr size_t WS_PHI = 523 * MiB, WS_PSI = 539 * MiB, WS_SST = 555 * MiB, WS_Y = 571 * MiB;
constexpr size_t WS_H2 = 139 * MiB, WS_ACT = 267 * MiB;
constexpr size_t WS_NEED = 1024 * MiB;
static_assert(WS_TAB + TAB_END <= WS_NEED && WS_ACT + (size_t)M * DFF * 2 <= WS_CR && WS_Y + (size_t)M * 512 * 4 <= WS_CR, "ws map");

constexpr int LDS_BYTES = 147456, MISC_OFF = 143360;
constexpr int CW_BAR = 4096;

__device__ __forceinline__ unsigned f2bf(float f) { unsigned u = __builtin_bit_cast(unsigned, f); return (u + 0x7fffu + ((u >> 16) & 1u)) >> 16; }
__device__ __forceinline__ unsigned pk2(float lo, float hi) { return f2bf(lo) | (f2bf(hi) << 16); }
__device__ __forceinline__ float bf2f(unsigned short b) { return __builtin_bit_cast(float, (unsigned)b << 16); }
__device__ __forceinline__ float bflo(unsigned w) { return __builtin_bit_cast(float, w << 16); }
__device__ __forceinline__ float bfhi(unsigned w) { return __builtin_bit_cast(float, w & 0xffff0000u); }
__device__ __forceinline__ float wave_sum(float v) {
#pragma unroll
    for (int o = 1; o < 64; o <<= 1) v += __shfl_xor(v, o);
    return v;
}
#define LDS_WAIT() asm volatile("s_waitcnt lgkmcnt(0)" ::: "memory")

namespace pg8 {
__device__ __forceinline__ void tile_dest(int pn, size_t& off, int& ld, int& colt) {
    if (pn < 16) { const int g = pn >> 2; off = g == 0 ? WS_Q : g == 1 ? WS_K : g == 2 ? WS_V : WS_QI; ld = 1024; colt = (pn & 3) * 256; }
    else if (pn == 16) { off = WS_BQ; ld = 256; colt = 0; }
    else if (pn == 17) { off = WS_BK; ld = 256; colt = 0; }
    else if (pn < 20) { off = WS_BV; ld = 512; colt = (pn - 18) * 256; }
    else if (pn < 22) { off = WS_BG; ld = 512; colt = (pn - 20) * 256; }
    else if (pn == 22) { off = WS_KW; ld = 256; colt = 0; }
    else if (pn < 25) { off = WS_CR; ld = 512; colt = (pn - 23) * 256; }
    else if (pn < 27) { off = WS_CK; ld = 512; colt = (pn - 25) * 256; }
    else if (pn < 29) { off = WS_CV; ld = 512; colt = (pn - 27) * 256; }
    else if (pn == 29) { off = WS_CL; ld = 256; colt = 0; }
    else { off = WS_CG; ld = 256; colt = 0; }
}
}
__device__ __forceinline__ int win_src(int n, int layer) {
    if (n < 4096) return n;
    if (n < 4352) return 4176 + (n - 4096);
    if (n < 4608) return 4432 + (n - 4352);
    if (n < 5120) return 4688 + (n - 4608);
    if (n < 5632) return 5200 + (n - 5120);
    if (n < 5888) { const int j = n - 5632; return j < 64 ? 4096 + j : (j < 80 ? 4160 + (j - 64) : -1); }
    if (n < 7424) return 5712 + (n - 5888);
    if (n < 7680) { const int j = n - 7424; return j < 96 ? 7248 + j : (j < 192 ? 7344 + (j - 96) : (layer > 0 ? -2 - (j - 192) : -1)); }
    return 7440 + (n - 7680);
}
#define XB_TMO      128
#define XB_XCNT(j)  (256  + 64 * (j))
#define XB_XSUB(j)  (1280 + 64 * (j))
#define XB_XGEN(j)  (2304 + 64 * (j))
#define XB_TOP      3328
#define XB_TOPGEN   3392
#define XCD_BAR_WORDS 3456
#define XB_SPIN_CAP (1u << 18)

__device__ __forceinline__ unsigned xb_ld(unsigned* p)              { return __hip_atomic_load(p, __ATOMIC_RELAXED, __HIP_MEMORY_SCOPE_AGENT); }
__device__ __forceinline__ unsigned xb_add(unsigned* p, unsigned v) { return __hip_atomic_fetch_add(p, v, __ATOMIC_RELAXED, __HIP_MEMORY_SCOPE_AGENT); }
__device__ __forceinline__ unsigned xb_xcc_id() { return (unsigned)__builtin_amdgcn_s_getreg((3 << 11) | 20) & 0xFu; }
#define XB_SPIN(cond, bar) do { unsigned _sp = 0; while (cond) { __builtin_amdgcn_s_sleep(1); \
    if ((++_sp & 255u) == 0u) { if (xb_ld(&(bar)[XB_TMO])) break; if (_sp > XB_SPIN_CAP) { atomicAdd(&(bar)[XB_TMO], 1u); break; } } } } while (0)

struct XcdBarrier {
    unsigned* bar; unsigned x;
    volatile LAS unsigned* st;
};

__device__ __forceinline__ XcdBarrier xcd_barrier_post(unsigned* bar, volatile LAS unsigned* st) {
    XcdBarrier b; b.bar = bar; b.x = xb_xcc_id(); b.st = st;
    if (threadIdx.x == 0) (void)xb_add(&bar[XB_XCNT(b.x)], 1u);
    return b;
}
__device__ __forceinline__ void xcd_barrier_complete(unsigned* bar, unsigned x, unsigned& nloc, unsigned& nx) {
    const unsigned G = gridDim.x * gridDim.y * gridDim.z;
    unsigned sum, cnt, mine, sp = 0u;
    for (;;) {
        sum = 0u; cnt = 0u; mine = 0u;
#pragma unroll
        for (unsigned j = 0; j < 16; ++j) { const unsigned c = xb_ld(&bar[XB_XCNT(j)]); sum += c; cnt += (c > 0u) ? 1u : 0u; mine = (j == x) ? c : mine; }
        if (sum == G) break;
        __builtin_amdgcn_s_sleep(1);
        if ((++sp & 255u) == 0u) { if (xb_ld(&bar[XB_TMO])) break; if (sp > XB_SPIN_CAP) { atomicAdd(&bar[XB_TMO], 1u); break; } }
    }
    nloc = mine > 0u ? mine : 1u; nx = cnt > 0u ? cnt : 1u;
}

__device__ __forceinline__ void xcd_barrier(const XcdBarrier& b) {
    asm volatile("s_waitcnt vmcnt(0)" ::: "memory");
    __syncthreads();
    if (threadIdx.x == 0) {
        unsigned* bar = b.bar;
        __builtin_amdgcn_s_waitcnt(0);
        unsigned nloc = b.st[0], nx = b.st[1];
        if (nloc == 0u) { xcd_barrier_complete(bar, b.x, nloc, nx); b.st[0] = nloc; b.st[1] = nx; }
        const unsigned old = xb_add(&bar[XB_XSUB(b.x)], 1u);
        const unsigned gen = old / nloc;
        if (old + 1u == (gen + 1u) * nloc) {
            __builtin_amdgcn_fence(__ATOMIC_RELEASE, "agent");
            asm volatile("s_waitcnt vmcnt(0)" ::: "memory");
            const unsigned og = xb_add(&bar[XB_TOP], 1u);
            const unsigned tg = og / nx;
            if (og + 1u == (tg + 1u) * nx) xb_add(&bar[XB_TOPGEN], 1u);
            else XB_SPIN(xb_ld(&bar[XB_TOPGEN]) == tg, bar);
            __builtin_amdgcn_fence(__ATOMIC_ACQUIRE, "agent");
            xb_add(&bar[XB_XGEN(b.x)], 1u);
            asm volatile("s_waitcnt vmcnt(0)" ::: "memory");
        } else {
            XB_SPIN(xb_ld(&bar[XB_XGEN(b.x)]) == gen, bar);
            __builtin_amdgcn_fence(__ATOMIC_ACQUIRE, "agent");
            asm volatile("s_waitcnt vmcnt(0)" ::: "memory");
        }
    }
    __syncthreads();
}

struct Ctx {
    LAS unsigned char* lds; int tid, lane, wave, G, bid; unsigned char* ws; float* out;
};

template <int MAP>
__device__ __forceinline__ void wconv_item(const float* W, int ldw, const float* W2, int K, bf16* WT, LAS float* scr, int item, int nblk, int lane, int layer) {
    const int kb = item / nblk, nb = item % nblk, k0 = 64 * kb, n0 = 32 * nb;
    const int n = n0 + (lane & 31);
    const float* src = nullptr; int ld = ldw;
    if (MAP == 0) src = W + n;
    else if (MAP == 1) { const int s = win_src(n, layer); if (s >= 0) src = W + s; else if (s <= -2) { src = W2 + (-2 - s); ld = 64; } }
    else { const int tl = n >> 8, j = n & 255; src = W + (j < 128 ? tl * 128 + j : DFF + tl * 128 + (j - 128)); }
#pragma unroll 8
    for (int i = 0; i < 32; ++i) { const int kk = 2 * i + (lane >> 5); scr[kk * 33 + (lane & 31)] = src ? src[(size_t)(k0 + kk) * ld] : 0.f; }
    LDS_WAIT(); asm volatile("" ::: "memory");
    const int c = lane & 7;
#pragma unroll
    for (int j = 0; j < 4; ++j) { const int nn = (lane >> 3) + 8 * j; const LAS float* s = scr + (8 * c) * 33 + nn;
        u32x4 o; o.x = pk2(s[0 * 33], s[1 * 33]); o.y = pk2(s[2 * 33], s[3 * 33]); o.z = pk2(s[4 * 33], s[5 * 33]); o.w = pk2(s[6 * 33], s[7 * 33]);
        *(u32x4*)(WT + (size_t)(n0 + nn) * K + k0 + 8 * c) = o; }
    LDS_WAIT(); asm volatile("" ::: "memory");
}
struct WSrc { const float *w_in, *w_vres, *w_out, *w_gu, *w_dn, *wlb, *alb, *glb, *vlb; };
__device__ __forceinline__ void phase_wconv(const Ctx& C, int layer, const WSrc& W) {
    LAS float* scr = (LAS float*)(C.lds + C.wave * 16384);
    const int gw = C.bid * NWAVES + C.wave, NGW = C.G * NWAVES;
    const float* w_in = W.w_in + (size_t)layer * DM * N_IN; const float* w_vres = W.w_vres;
    const float* w_out = W.w_out + (size_t)layer * DM * DM; const float* w_gu = W.w_gu + (size_t)layer * DM * 2 * DFF; const float* w_dn = W.w_dn + (size_t)layer * DFF * DM;
    constexpr int I_IN = (DM / 64) * (N_INP / 32), I_OUT = (DM / 64) * (DM / 32), I_GU = (DM / 64) * (2 * DFF / 32), I_DN = (DFF / 64) * (DM / 32);
    for (int it = gw; it < I_IN + I_OUT + I_GU + I_DN; it += NGW) {
        int r = it;
        if (r < I_IN) { wconv_item<1>(w_in, N_IN, w_vres, DM, (bf16*)(C.ws + WS_WIN), scr, r, N_INP / 32, C.lane, layer); continue; } r -= I_IN;
        if (r < I_OUT) { wconv_item<0>(w_out, DM, nullptr, DM, (bf16*)(C.ws + WS_WOUT), scr, r, DM / 32, C.lane, layer); continue; } r -= I_OUT;
        if (r < I_GU) { wconv_item<2>(w_gu, 2 * DFF, nullptr, DM, (bf16*)(C.ws + WS_WGU), scr, r, 2 * DFF / 32, C.lane, layer); continue; } r -= I_GU;
        wconv_item<0>(w_dn, DM, nullptr, DFF, (bf16*)(C.ws + WS_WDN), scr, r, DM / 32, C.lane, layer);
    }
    const int gt = C.bid * NTHR + C.tid, NGT = C.G * NTHR;
    const float* wlb = W.wlb + (size_t)layer * 96 * 512; const float* alb = W.alb + (size_t)layer * 96 * 512; const float* glb = W.glb + (size_t)layer * 256 * 512;
    const float* vlb = W.vlb;
    bf16* LW = (bf16*)(C.ws + WS_LORA + LO_W); bf16* LA = (bf16*)(C.ws + WS_LORA + LO_A); bf16* LV = (bf16*)(C.ws + WS_LORA + LO_V); bf16* LG = (bf16*)(C.ws + WS_LORA + LO_G);
    for (int i = gt; i < 512 * 96; i += NGT) { const int n = i / 96, k = i % 96; LW[i] = (bf16)f2bf(wlb[k * 512 + n]); LA[i] = (bf16)f2bf(alb[k * 512 + n]); }
    for (int i = gt; i < 512 * 64; i += NGT) { const int n = i / 64, k = i % 64; LV[i] = (bf16)f2bf(layer > 0 ? vlb[k * 512 + n] : 0.f); }
    for (int i = gt; i < 512 * 256; i += NGT) { const int n = i / 256, k = i % 256; LG[i] = (bf16)f2bf(glb[k * 512 + n]); }
    if (layer == 0) {
        float2* TA = (float2*)(C.ws + WS_TAB + TAB_A); float2* TI = (float2*)(C.ws + WS_TAB + TAB_I); float2* TR = (float2*)(C.ws + WS_TAB + TAB_R);
        const float l2a = 18.931568569324174f  , l2r = 13.287712379549449f  ;
        for (int i = gt; i < T * 56; i += NGT) {
            const int pos = i / 56, j = i % 56; float fr; float2* dst;
            if (j < 16) { fr = exp2f(-(float)j * (1.0f / 16.0f) * l2a); dst = TA + pos * 16 + j; }
            else if (j < 24) { fr = exp2f(-(float)(j - 16) * (1.0f / 8.0f) * l2a); dst = TI + pos * 8 + (j - 16); }
            else { fr = exp2f(-(float)(j - 24) * (1.0f / 32.0f) * l2r); dst = TR + pos * 32 + (j - 24); }
            const float ang = (float)pos * fr; *dst = make_float2(cosf(ang), sinf(ang));
        }
    }
}
__device__ __forceinline__ void phase_norm_bf16(const Ctx& C, const float* x, const float* g, bf16* out) {
    const int gw = C.bid * NWAVES + C.wave, NGW = C.G * NWAVES;
    f32x4 gv[8];
#pragma unroll
    for (int j = 0; j < 8; ++j) gv[j] = *(const f32x4*)(g + 4 * (C.lane + 64 * j));
    for (int m = gw; m < M; m += NGW) {
        const f32x4* xr = (const f32x4*)(x + (size_t)m * DM) + C.lane; f32x4 v[8]; float s = 0.f;
#pragma unroll
        for (int j = 0; j < 8; ++j) { v[j] = xr[64 * j]; s += (v[j].x * v[j].x + v[j].y * v[j].y) + (v[j].z * v[j].z + v[j].w * v[j].w); }
        const float rs = rsqrtf(wave_sum(s) * (1.0f / DM) + 1e-5f);
        u32x2* o = (u32x2*)(out + (size_t)m * DM) + C.lane;
#pragma unroll
        for (int j = 0; j < 8; ++j) { u32x2 w; w.x = pk2(v[j].x * rs * gv[j].x, v[j].y * rs * gv[j].y); w.y = pk2(v[j].z * rs * gv[j].z, v[j].w * rs * gv[j].w); o[64 * j] = w; }
    }
}
__device__ __forceinline__ void phase_final_norm(const Ctx& C, float* x, const float* g) {
    const int gw = C.bid * NWAVES + C.wave, NGW = C.G * NWAVES;
    f32x4 gv[8];
#pragma unroll
    for (int j = 0; j < 8; ++j) gv[j] = *(const f32x4*)(g + 4 * (C.lane + 64 * j));
    for (int m = gw; m < M; m += NGW) {
        f32x4* xr = (f32x4*)(x + (size_t)m * DM) + C.lane; f32x4 v[8]; float s = 0.f;
#pragma unroll
        for (int j = 0; j < 8; ++j) { v[j] = xr[64 * j]; s += (v[j].x * v[j].x + v[j].y * v[j].y) + (v[j].z * v[j].z + v[j].w * v[j].w); }
        const float rs = rsqrtf(wave_sum(s) * (1.0f / DM) + 1e-5f);
#pragma unroll
        for (int j = 0; j < 8; ++j) xr[64 * j] = v[j] * rs * gv[j];
    }
}
__device__ __forceinline__ void phase_prep_a(const Ctx& C) {
    const long gt = (long)C.bid * NTHR + C.tid, NGT = (long)C.G * NTHR;
    for (int cfg = 0; cfg < 6; ++cfg) {
        size_t off; int ld, nh, hd, half; size_t tab;
        if (cfg == 0) { off = WS_Q; ld = 1024; nh = 8; hd = 128; half = 16; tab = TAB_A; }
        else if (cfg == 1) { off = WS_K; ld = 1024; nh = 8; hd = 128; half = 16; tab = TAB_A; }
        else if (cfg == 2) { off = WS_QI; ld = 1024; nh = 16; hd = 64; half = 8; tab = TAB_I; }
        else if (cfg == 3) { off = WS_KW; ld = 256; nh = 1; hd = 64; half = 8; tab = TAB_I; }
        else if (cfg == 4) { off = WS_BQ; ld = 256; nh = 4; hd = 64; half = 32; tab = TAB_R; }
        else { off = WS_BK; ld = 256; nh = 4; hd = 64; half = 32; tab = TAB_R; }
        bf16* buf = (bf16*)(C.ws + off); const float2* tb = (const float2*)(C.ws + WS_TAB + tab);
        const int cpp = half >> 3; const long total = (long)M * nh * cpp;
        for (long it = gt; it < total; it += NGT) {
            const int c = (int)(it % cpp); const long r2 = it / cpp; const int h = (int)(r2 % nh); const int row = (int)(r2 / nh); const int pos = row & (T - 1);
            bf16* p1 = buf + (size_t)row * ld + h * hd + 8 * c; bf16* p2 = p1 + half;
            const u32x4 a = *(const u32x4*)p1, b = *(const u32x4*)p2; const float2* tp = tb + (size_t)pos * half + 8 * c;
            float x1[8], x2[8];
#pragma unroll
            for (int e = 0; e < 4; ++e) { x1[2 * e] = bflo(a[e]); x1[2 * e + 1] = bfhi(a[e]); x2[2 * e] = bflo(b[e]); x2[2 * e + 1] = bfhi(b[e]); }
            u32x4 oa, ob;
#pragma unroll
            for (int e = 0; e < 4; ++e) {
                const float2 t0 = tp[2 * e], t1 = tp[2 * e + 1];
                oa[e] = pk2(x1[2 * e] * t0.x - x2[2 * e] * t0.y, x1[2 * e + 1] * t1.x - x2[2 * e + 1] * t1.y);
                ob[e] = pk2(x2[2 * e] * t0.x + x1[2 * e] * t0.y, x2[2 * e + 1] * t1.x + x1[2 * e + 1] * t1.y);
            }
            *(u32x4*)p1 = oa; *(u32x4*)p2 = ob;
        }
    }
    {
        LAS unsigned short* scr = (LAS unsigned short*)(C.lds + C.wave * 8704);
        const bf16* V = (const bf16*)(C.ws + WS_V); bf16* Vt = (bf16*)(C.ws + WS_VT);
        const int gw = C.bid * NWAVES + C.wave, NGW = C.G * NWAVES;
        for (int it = gw; it < NB * 128 * 16; it += NGW) {
            const int ct = it & 15, tt = (it >> 4) & 127, b = it >> 11;
            const int t0 = tt * 64, c0 = ct * 64;
#pragma unroll 4
            for (int i = 0; i < 32; ++i) { const int tr = 2 * i + (C.lane >> 5), cc = 2 * (C.lane & 31);
                const unsigned w = *(const unsigned*)(V + (size_t)(b * T + t0 + tr) * 1024 + c0 + cc); scr[tr * 66 + cc] = (unsigned short)(w & 0xffffu); scr[tr * 66 + cc + 1] = (unsigned short)(w >> 16); }
            LDS_WAIT(); asm volatile("" ::: "memory");
#pragma unroll 4
            for (int i = 0; i < 32; ++i) { const int cr = 2 * i + (C.lane >> 5), tp = 2 * (C.lane & 31);
                const unsigned w = (unsigned)scr[tp * 66 + cr] | ((unsigned)scr[(tp + 1) * 66 + cr] << 16);
                *(unsigned*)(Vt + ((size_t)b * 1024 + c0 + cr) * T + t0 + tp) = w; }
            LDS_WAIT(); asm volatile("" ::: "memory");
        }
    }
}
__device__ __forceinline__ void phase_indexer(const Ctx& C) {
    LAS unsigned short* sc = (LAS unsigned short*)C.lds;
    LAS unsigned* hist = (LAS unsigned*)(C.lds + 131072) + C.wave * 256;
    const bf16* QI = (const bf16*)(C.ws + WS_QI); const bf16* KW = (const bf16*)(C.ws + WS_KW); u64* MASK = (u64*)(C.ws + WS_MASK);
    const int lane = C.lane, r32 = lane & 31, hi = lane >> 5;
    for (int it = C.bid; it < NB * (T / 8); it += C.G) {
        const int b = it & 3, qg = it >> 2, q0 = qg * 8, qchunk = q0 >> 6, nadm = 64 * (qchunk + 1);
        const int qrow = b * T + q0 + C.wave;
        if (qchunk < 4) {
            MASK[(size_t)qrow * 128 + lane] = lane <= qchunk ? ~0ull : 0ull; MASK[(size_t)qrow * 128 + 64 + lane] = 0ull;
            continue;
        }
        bf16x8 af[4][4]; float wv[4][16];
        {
            const int qq = (r32 >> 2) & 1, hh = (r32 & 3) + 4 * (r32 >> 3);
#pragma unroll
            for (int pr = 0; pr < 4; ++pr) {
                const bf16* qp = QI + (size_t)(b * T + q0 + 2 * pr + qq) * 1024 + hh * 64 + 8 * hi;
#pragma unroll
                for (int kk = 0; kk < 4; ++kk) af[pr][kk] = *(const bf16x8*)(qp + 16 * kk);
                const bf16* wp = KW + (size_t)(b * T + q0 + 2 * pr + hi) * 256 + 64;
                const u32x4 w0 = *(const u32x4*)wp, w1 = *(const u32x4*)(wp + 8);
#pragma unroll
                for (int e = 0; e < 4; ++e) { wv[pr][2 * e] = bflo(w0[e]) * 0.03125f; wv[pr][2 * e + 1] = bfhi(w0[e]) * 0.03125f; wv[pr][8 + 2 * e] = bflo(w1[e]) * 0.03125f; wv[pr][8 + 2 * e + 1] = bfhi(w1[e]) * 0.03125f; }
            }
        }
        for (int tile = C.wave; tile < nadm / 32; tile += NWAVES) {
            const int key0 = 32 * tile;
            const bf16* kp = KW + (size_t)(b * T + key0 + r32) * 256 + 8 * hi;
            bf16x8 bfr[4];
#pragma unroll
            for (int kk = 0; kk < 4; ++kk) bfr[kk] = *(const bf16x8*)(kp + 16 * kk);
#pragma unroll
            for (int pr = 0; pr < 4; ++pr) {
                f32x16 d = {0.f, 0.f, 0.f, 0.f, 0.f, 0.f, 0.f, 0.f, 0.f, 0.f, 0.f, 0.f, 0.f, 0.f, 0.f, 0.f};
#pragma unroll
                for (int kk = 0; kk < 4; ++kk) d = __builtin_amdgcn_mfma_f32_32x32x16_bf16(af[pr][kk], bfr[kk], d, 0, 0, 0);
                float s = 0.f;
#pragma unroll
                for (int r = 0; r < 16; ++r) s += fmaxf(d[r], 0.f) * wv[pr][r];
                const unsigned short hb = __half_as_ushort(__float2half_rn(s));
                const unsigned short key = (hb & 0x8000u) ? (unsigned short)~hb : (unsigned short)(hb | 0x8000u);
                sc[(2 * pr + hi) * 8192 + key0 + r32] = key;
            }
        }
        __syncthreads();
        const LAS unsigned short* my = sc + C.wave * 8192;
        unsigned thr = 0;
        {
            unsigned want = 256u, prefix = 0u;
#pragma unroll 1
            for (int lvl = 0; lvl < 2; ++lvl) {
                hist[lane] = 0u; hist[64 + lane] = 0u; hist[128 + lane] = 0u; hist[192 + lane] = 0u;
                LDS_WAIT(); asm volatile("" ::: "memory");
                for (int i = 0; i < nadm / 64; ++i) { const unsigned k = my[64 * i + lane];
                    if (lvl == 0) atomicAdd((unsigned*)&hist[k >> 8], 1u); else if ((k >> 8) == prefix) atomicAdd((unsigned*)&hist[k & 255u], 1u); }
                LDS_WAIT(); asm volatile("" ::: "memory");
                const unsigned c0 = hist[4 * lane], c1 = hist[4 * lane + 1], c2 = hist[4 * lane + 2], c3 = hist[4 * lane + 3];
                const unsigned tl = c0 + c1 + c2 + c3; unsigned inc = tl;
#pragma unroll
                for (int o = 1; o < 64; o <<= 1) { const unsigned v = __shfl_down(inc, o); if (lane + o < 64) inc += v; }
                const unsigned ab3 = inc - tl, ab2 = ab3 + c3, ab1 = ab2 + c2, ab0 = ab1 + c1;
                int selb = -1; unsigned rem = 0;
                if (ab3 < want && ab3 + c3 >= want) { selb = 3; rem = want - ab3; }
                else if (ab2 < want && ab2 + c2 >= want) { selb = 2; rem = want - ab2; }
                else if (ab1 < want && ab1 + c1 >= want) { selb = 1; rem = want - ab1; }
                else if (ab0 < want && ab0 + c0 >= want) { selb = 0; rem = want - ab0; }
                const u64 bal = __ballot(selb >= 0); const int src = bal ? (int)__ffsll((long long)bal) - 1 : 0;
                const unsigned bin = (unsigned)__shfl(4 * lane + (selb < 0 ? 0 : selb), src); want = (unsigned)__shfl((int)rem, src);
                if (lvl == 0) prefix = bin; else thr = (prefix << 8) | bin;
                LDS_WAIT(); asm volatile("" ::: "memory");
            }
        }
        u64 w0 = 0, w1 = 0;
        for (int i = 0; i < nadm / 64; ++i) { const unsigned k = my[64 * i + lane]; const u64 bal = __ballot(k >= thr);
            if (i < 64) { if (lane == i) w0 = bal; } else { if (lane == i - 64) w1 = bal; } }
        MASK[(size_t)qrow * 128 + lane] = w0; MASK[(size_t)qrow * 128 + 64 + lane] = w1;
        __syncthreads();
    }
}
constexpr int AT_KROW = 272, AT_VROW = 136, AT_KB = 64 * AT_KROW, AT_VB = 128 * AT_VROW, AT_BUF = AT_KB + AT_VB;
__device__ __forceinline__ void attn_unit(const Ctx& C, int b, int head, int qb) {
    const bf16* Q = (const bf16*)(C.ws + WS_Q); const bf16* K = (const bf16*)(C.ws + WS_K); const bf16* Vt = (const bf16*)(C.ws + WS_VT);
    const u64* MASK = (const u64*)(C.ws + WS_MASK); bf16* CAT = (bf16*)(C.ws + WS_CAT);
    const int tid = C.tid, lane = C.lane, wid = C.wave, r32 = lane & 31, hi = lane >> 5;
    const int q = 256 * qb + 32 * wid + r32; const size_t row = (size_t)b * T + q;
    const int nt = 4 * qb + 4, myc = 4 * qb + (wid >> 1);
    bf16x8 qf[8];
#pragma unroll
    for (int d0 = 0; d0 < 8; ++d0) qf[d0] = *(const bf16x8*)(Q + row * 1024 + head * 128 + 16 * d0 + 8 * hi);
    const bf16* kg[2]; const bf16* vg[2]; int kl[2], vl[2];
#pragma unroll
    for (int i = 0; i < 2; ++i) { const int c = tid + 512 * i;
        kg[i] = K + ((size_t)b * T + (c >> 4)) * 1024 + head * 128 + (c & 15) * 8; kl[i] = (c >> 4) * AT_KROW + (c & 15) * 16;
        vg[i] = Vt + ((size_t)(b * 8 + head) * 128 + (c >> 3)) * T + (c & 7) * 8; vl[i] = AT_KB + (c >> 3) * AT_VROW + (c & 7) * 16; }
    u32x4 kr[2], vr[2];
#pragma unroll
    for (int i = 0; i < 2; ++i) { kr[i] = *(const u32x4*)kg[i]; vr[i] = *(const u32x4*)vg[i]; }
#pragma unroll
    for (int i = 0; i < 2; ++i) { *(LAS u32x4*)(C.lds + kl[i]) = kr[i]; *(LAS u32x2*)(C.lds + vl[i]) = (u32x2){vr[i].x, vr[i].y}; *(LAS u32x2*)(C.lds + vl[i] + 8) = (u32x2){vr[i].z, vr[i].w}; }
    __syncthreads();
    float mrun = -1e30f, lrun = 0.f; f32x16 o[4];
#pragma unroll
    for (int db = 0; db < 4; ++db)
#pragma unroll
        for (int r = 0; r < 16; ++r) o[db][r] = 0.f;
    const float SC = 0.08838834764831845f * 1.4426950408889634f;
    for (int t = 0; t < nt; ++t) {
        const int cur = (t & 1) * AT_BUF, nxt = ((t + 1) & 1) * AT_BUF;
        if (t + 1 < nt) {
#pragma unroll
            for (int i = 0; i < 2; ++i) { kr[i] = *(const u32x4*)(kg[i] + (size_t)(t + 1) * 64 * 1024); vr[i] = *(const u32x4*)(vg[i] + (t + 1) * 64); }
        }
        if (t <= myc) {
            const u64 mw = MASK[row * 128 + t];
            const LAS unsigned char* Ks = C.lds + cur; const LAS unsigned char* Vs = C.lds + cur + AT_KB;
            f32x16 p0, p1;
#pragma unroll
            for (int r = 0; r < 16; ++r) { p0[r] = 0.f; p1[r] = 0.f; }
#pragma unroll
            for (int d0 = 0; d0 < 8; ++d0) {
                const bf16x8 k0 = *(const LAS bf16x8*)(Ks + r32 * AT_KROW + (16 * d0 + 8 * hi) * 2);
                const bf16x8 k1 = *(const LAS bf16x8*)(Ks + (32 + r32) * AT_KROW + (16 * d0 + 8 * hi) * 2);
                p0 = __builtin_amdgcn_mfma_f32_32x32x16_bf16(k0, qf[d0], p0, 0, 0, 0);
                p1 = __builtin_amdgcn_mfma_f32_32x32x16_bf16(k1, qf[d0], p1, 0, 0, 0);
            }
            const unsigned mlo = (unsigned)mw >> (4 * hi), mhi = (unsigned)(mw >> 32) >> (4 * hi);
            float rm = -1e30f;
#pragma unroll
            for (int r = 0; r < 16; ++r) { const int c = (r & 3) + 8 * (r >> 2);
                p0[r] = ((mlo >> c) & 1u) ? p0[r] * SC : -1e30f; p1[r] = ((mhi >> c) & 1u) ? p1[r] * SC : -1e30f;
                rm = fmaxf(rm, fmaxf(p0[r], p1[r])); }
            rm = fmaxf(rm, __shfl_xor(rm, 32));
            const float mnew = fmaxf(mrun, rm);
            if (__any(mnew > mrun)) {
                const float f = __builtin_amdgcn_exp2f(mrun - mnew); lrun *= f;
#pragma unroll
                for (int db = 0; db < 4; ++db)
#pragma unroll
                    for (int r = 0; r < 16; ++r) o[db][r] *= f;
            }
            mrun = mnew;
            float ls = 0.f;
#pragma unroll
            for (int r = 0; r < 16; ++r) { const int c = (r & 3) + 8 * (r >> 2);
                p0[r] = ((mlo >> c) & 1u) ? __builtin_amdgcn_exp2f(p0[r] - mrun) : 0.f; p1[r] = ((mhi >> c) & 1u) ? __builtin_amdgcn_exp2f(p1[r] - mrun) : 0.f;
                ls += p0[r] + p1[r]; }
            lrun += ls;
            bf16x8 pb[4];
#pragma unroll
            for (int kk = 0; kk < 4; ++kk) { u32x4 w;
#pragma unroll
                for (int e = 0; e < 4; ++e) { const int r = 8 * (kk & 1) + 2 * e; w[e] = (kk < 2) ? pk2(p0[r], p0[r + 1]) : pk2(p1[r], p1[r + 1]); }
                pb[kk] = __builtin_bit_cast(bf16x8, w); }
#pragma unroll
            for (int db = 0; db < 4; ++db)
#pragma unroll
                for (int kk = 0; kk < 4; ++kk) {
                    const LAS unsigned char* vp = Vs + (32 * db + r32) * AT_VROW + (16 * kk + 4 * hi) * 2;
                    const u32x2 a0 = *(const LAS u32x2*)vp, a1 = *(const LAS u32x2*)(vp + 16);
                    const u32x4 w = {a0.x, a0.y, a1.x, a1.y};
                    o[db] = __builtin_amdgcn_mfma_f32_32x32x16_bf16(__builtin_bit_cast(bf16x8, w), pb[kk], o[db], 0, 0, 0);
                }
        }
        if (t + 1 < nt) {
#pragma unroll
            for (int i = 0; i < 2; ++i) { *(LAS u32x4*)(C.lds + nxt + kl[i]) = kr[i]; *(LAS u32x2*)(C.lds + nxt + vl[i]) = (u32x2){vr[i].x, vr[i].y}; *(LAS u32x2*)(C.lds + nxt + vl[i] + 8) = (u32x2){vr[i].z, vr[i].w}; }
        }
        __syncthreads();
    }
    lrun += __shfl_xor(lrun, 32);
    const float inv = 1.0f / lrun;
    bf16* op = CAT + row * 2048 + head * 128 + 4 * hi;
#pragma unroll
    for (int db = 0; db < 4; ++db)
#pragma unroll
        for (int g = 0; g < 4; ++g) { u32x2 w; w.x = pk2(o[db][4 * g] * inv, o[db][4 * g + 1] * inv); w.y = pk2(o[db][4 * g + 2] * inv, o[db][4 * g + 3] * inv);
            *(u32x2*)(op + 32 * db + 8 * g) = w; }
}
__device__ __forceinline__ void phase_attn(const Ctx& C) {
    for (int i = C.bid; i < 1024; i += C.G) {
        const int w = i & 255, k = i >> 8, combo = w >> 3, j = w & 7;
        const int qb = k == 0 ? j : k == 1 ? 15 - j : k == 2 ? 16 + j : 31 - j;
        attn_unit(C, combo >> 3, combo & 7, qb);
        __syncthreads();
    }
}
__device__ __forceinline__ float ret_logg(int h) { return log1pf(-exp2f(-5.0f - (float)h)); }
constexpr int RT_KS = 68;
__device__ __forceinline__ void phase_ret1(const Ctx& C) {
    LAS float* Ks = (LAS float*)C.lds;
    LAS float* Vs = (LAS float*)(C.lds + 64 * RT_KS * 4);
    const bf16* BK = (const bf16*)(C.ws + WS_BK); const bf16* BV = (const bf16*)(C.ws + WS_BV); float* KV = (float*)(C.ws + WS_KVST);
    const int tid = C.tid;
    for (int u = C.bid; u < NB * 128 * 4; u += C.G) {
        const int h = u & 3, c = (u >> 2) & 127, b = u >> 9; const size_t row0 = (size_t)b * T + 64 * c; const float lg = ret_logg(h);
        { const int m = tid >> 3, d8 = (tid & 7) * 8; const u32x4 w = *(const u32x4*)(BK + (row0 + m) * 256 + h * 64 + d8); const float z = __expf((63.0f - (float)m) * lg) * 0.125f;
#pragma unroll
          for (int e = 0; e < 4; ++e) { Ks[m * RT_KS + d8 + 2 * e] = bflo(w[e]) * z; Ks[m * RT_KS + d8 + 2 * e + 1] = bfhi(w[e]) * z; } }
#pragma unroll
        for (int i = 0; i < 2; ++i) { const int cidx = tid + 512 * i, m = cidx >> 4, e8 = (cidx & 15) * 8; const u32x4 w = *(const u32x4*)(BV + (row0 + m) * 512 + h * 128 + e8);
#pragma unroll
          for (int e = 0; e < 4; ++e) { Vs[m * 128 + e8 + 2 * e] = bflo(w[e]); Vs[m * 128 + e8 + 2 * e + 1] = bfhi(w[e]); } }
        __syncthreads();
        const int d = tid & 63, eg = tid >> 6; float acc[16];
#pragma unroll
        for (int e = 0; e < 16; ++e) acc[e] = 0.f;
        for (int m = 0; m < 64; ++m) { const float kv = Ks[m * RT_KS + d];
#pragma unroll
            for (int e4 = 0; e4 < 4; ++e4) { const f32x4 v = *(const LAS f32x4*)(Vs + m * 128 + 16 * eg + 4 * e4); acc[4 * e4] += kv * v.x; acc[4 * e4 + 1] += kv * v.y; acc[4 * e4 + 2] += kv * v.z; acc[4 * e4 + 3] += kv * v.w; } }
        float* dst = KV + (size_t)u * 8192 + d * 128 + 16 * eg;
#pragma unroll
        for (int e4 = 0; e4 < 4; ++e4) *(f32x4*)(dst + 4 * e4) = (f32x4){acc[4 * e4], acc[4 * e4 + 1], acc[4 * e4 + 2], acc[4 * e4 + 3]};
        __syncthreads();
    }
}
__device__ __forceinline__ void phase_ret2(const Ctx& C) {
    float* KV = (float*)(C.ws + WS_KVST);
    for (int g = C.bid * NTHR + C.tid; g < NB * 4 * 8192; g += C.G * NTHR) {
        const int el = g & 8191, h = (g >> 13) & 3, b = g >> 15; const float gc = __expf(64.0f * ret_logg(h));
        float* p = KV + ((size_t)b * 512 + h) * 8192 + el;
        float st = 0.f;
        for (int c0 = 0; c0 < 128; c0 += 8) { float x[8];
#pragma unroll
            for (int i = 0; i < 8; ++i) x[i] = p[(size_t)(c0 + i) * 4 * 8192];
#pragma unroll
            for (int i = 0; i < 8; ++i) { p[(size_t)(c0 + i) * 4 * 8192] = st; st = st * gc + x[i]; } }
    }
}
__device__ __forceinline__ void phase_ret3(const Ctx& C) {
    LAS float* Qs = (LAS float*)C.lds;
    LAS float* Ks = Qs + 64 * RT_KS;
    LAS float* Sc = Ks + 64 * RT_KS;
    LAS float* Vs = Sc + 64 * RT_KS;
    LAS float* Ps = Vs + 64 * 128;
    const bf16* BQ = (const bf16*)(C.ws + WS_BQ); const bf16* BK = (const bf16*)(C.ws + WS_BK); const bf16* BV = (const bf16*)(C.ws + WS_BV); const bf16* BG = (const bf16*)(C.ws + WS_BG);
    const float* KV = (const float*)(C.ws + WS_KVST); bf16* CAT = (bf16*)(C.ws + WS_CAT);
    const int tid = C.tid;
    for (int u = C.bid; u < NB * 128 * 4; u += C.G) {
        const int h = u & 3, c = (u >> 2) & 127, b = u >> 9; const size_t row0 = (size_t)b * T + 64 * c; const float lg = ret_logg(h);
        { const int m = tid >> 3, d8 = (tid & 7) * 8; const u32x4 wq = *(const u32x4*)(BQ + (row0 + m) * 256 + h * 64 + d8), wk = *(const u32x4*)(BK + (row0 + m) * 256 + h * 64 + d8);
#pragma unroll
          for (int e = 0; e < 4; ++e) { Qs[m * RT_KS + d8 + 2 * e] = bflo(wq[e]); Qs[m * RT_KS + d8 + 2 * e + 1] = bfhi(wq[e]); Ks[m * RT_KS + d8 + 2 * e] = bflo(wk[e]) * 0.125f; Ks[m * RT_KS + d8 + 2 * e + 1] = bfhi(wk[e]) * 0.125f; } }
#pragma unroll
        for (int i = 0; i < 2; ++i) { const int cidx = tid + 512 * i, m = cidx >> 4, e8 = (cidx & 15) * 8; const u32x4 w = *(const u32x4*)(BV + (row0 + m) * 512 + h * 128 + e8);
#pragma unroll
          for (int e = 0; e < 4; ++e) { Vs[m * 128 + e8 + 2 * e] = bflo(w[e]); Vs[m * 128 + e8 + 2 * e + 1] = bfhi(w[e]); } }
#pragma unroll
        for (int i = 0; i < 4; ++i) { const int cidx = tid + 512 * i; *(LAS f32x4*)(Ps + 4 * cidx) = *(const f32x4*)(KV + (size_t)u * 8192 + 4 * cidx); }
        __syncthreads();
        {
            const int n = tid >> 3, mg = tid & 7; float s[8];
#pragma unroll
            for (int j = 0; j < 8; ++j) s[j] = 0.f;
            for (int d4 = 0; d4 < 16; ++d4) { const f32x4 qv = *(const LAS f32x4*)(Qs + n * RT_KS + 4 * d4);
#pragma unroll
                for (int j = 0; j < 8; ++j) { const f32x4 kv = *(const LAS f32x4*)(Ks + (mg + 8 * j) * RT_KS + 4 * d4); s[j] += (qv.x * kv.x + qv.y * kv.y) + (qv.z * kv.z + qv.w * kv.w); } }
#pragma unroll
            for (int j = 0; j < 8; ++j) { const int m = mg + 8 * j; Sc[n * RT_KS + m] = (m <= n) ? s[j] * __expf((float)(n - m) * lg) : 0.f; }
        }
        __syncthreads();
        {
            const int n = tid >> 3, eg = tid & 7; float acc[16], cr[16];
#pragma unroll
            for (int e = 0; e < 16; ++e) { acc[e] = 0.f; cr[e] = 0.f; }
            for (int m = 0; m <= n; ++m) { const float sv = Sc[n * RT_KS + m];
#pragma unroll
                for (int e4 = 0; e4 < 4; ++e4) { const f32x4 v = *(const LAS f32x4*)(Vs + m * 128 + 16 * eg + 4 * e4); acc[4 * e4] += sv * v.x; acc[4 * e4 + 1] += sv * v.y; acc[4 * e4 + 2] += sv * v.z; acc[4 * e4 + 3] += sv * v.w; } }
            for (int d = 0; d < 64; ++d) { const float qv = Qs[n * RT_KS + d];
#pragma unroll
                for (int e4 = 0; e4 < 4; ++e4) { const f32x4 v = *(const LAS f32x4*)(Ps + d * 128 + 16 * eg + 4 * e4); cr[4 * e4] += qv * v.x; cr[4 * e4 + 1] += qv * v.y; cr[4 * e4 + 2] += qv * v.z; cr[4 * e4 + 3] += qv * v.w; } }
            const float xi = __expf((float)(n + 1) * lg); float sum = 0.f;
#pragma unroll
            for (int e = 0; e < 16; ++e) { acc[e] += xi * cr[e]; sum += acc[e]; }
            sum += __shfl_xor(sum, 1); sum += __shfl_xor(sum, 2); sum += __shfl_xor(sum, 4);
            const float mu = sum * (1.0f / 128.0f); float var = 0.f;
#pragma unroll
            for (int e = 0; e < 16; ++e) { const float dlt = acc[e] - mu; var += dlt * dlt; }
            var += __shfl_xor(var, 1); var += __shfl_xor(var, 2); var += __shfl_xor(var, 4);
            const float rstd = rsqrtf(var * (1.0f / 128.0f) + 1e-5f);
            const bf16* gp = BG + (row0 + n) * 512 + h * 128 + 16 * eg; const u32x4 g0 = *(const u32x4*)gp, g1 = *(const u32x4*)(gp + 8);
            float gv[16];
#pragma unroll
            for (int e = 0; e < 4; ++e) { gv[2 * e] = bflo(g0[e]); gv[2 * e + 1] = bfhi(g0[e]); gv[8 + 2 * e] = bflo(g1[e]); gv[8 + 2 * e + 1] = bfhi(g1[e]); }
            float ov[16];
#pragma unroll
            for (int e = 0; e < 16; ++e) { const float gg = gv[e]; const float sl = gg * __builtin_amdgcn_rcpf(1.0f + __expf(-gg)); ov[e] = (acc[e] - mu) * rstd * sl; }
            bf16* op = CAT + (row0 + n) * 2048 + 1024 + h * 128 + 16 * eg;
            u32x4 w0, w1;
#pragma unroll
            for (int e = 0; e < 4; ++e) { w0[e] = pk2(ov[2 * e], ov[2 * e + 1]); w1[e] = pk2(ov[8 + 2 * e], ov[8 + 2 * e + 1]); }
            *(u32x4*)op = w0; *(u32x4*)(op + 8) = w1;
        }
        __syncthreads();
    }
}
__device__ __forceinline__ float sigmoidf_(float x) { return __builtin_amdgcn_rcpf(1.0f + __expf(-x)); }
constexpr int RW_AW = 104, RW_AV = 72, RW_AG = 264;
__device__ __forceinline__ void ld4bf(const bf16* p, float (&v)[4]) { const u32x2 w = *(const u32x2*)p; v[0] = bflo(w.x); v[1] = bfhi(w.x); v[2] = bflo(w.y); v[3] = bfhi(w.y); }
__device__ __forceinline__ void shift4(const bf16* buf, size_t m, int ld, int c4, bool first, const float* mu, float (&o)[4]) {
    float cur[4], prv[4] = {0.f, 0.f, 0.f, 0.f}; ld4bf(buf + m * ld + c4, cur); if (!first) ld4bf(buf + (m - 1) * ld + c4, prv);
    const f32x4 muv = *(const f32x4*)mu;
#pragma unroll
    for (int e = 0; e < 4; ++e) o[e] = cur[e] + (prv[e] - cur[e]) * muv[e];
}
struct RwP { const float *mu, *mu_v, *w0, *a0, *v0, *k_k, *k_a, *r_k, *lnx_g, *lnx_b; };
__device__ __forceinline__ void phase_rw1(const Ctx& C, int layer, const RwP& P) {
    LAS bf16* AW = (LAS bf16*)C.lds; LAS bf16* AA = AW + 32 * RW_AW; LAS bf16* AV = AA + 32 * RW_AW;
    const bf16* CR = (const bf16*)(C.ws + WS_CR); const bf16* CK = (const bf16*)(C.ws + WS_CK); const bf16* CV = (const bf16*)(C.ws + WS_CV); const bf16* CL = (const bf16*)(C.ws + WS_CL);
    const bf16* LW = (const bf16*)(C.ws + WS_LORA + LO_W); const bf16* LA = (const bf16*)(C.ws + WS_LORA + LO_A); const bf16* LV = (const bf16*)(C.ws + WS_LORA + LO_V);
    bf16* VF = (bf16*)(C.ws + WS_VFIRST);
    float* RR = (float*)(C.ws + WS_RR); float* RWd = (float*)(C.ws + WS_RW); float* RKH = (float*)(C.ws + WS_RKH); float* RV = (float*)(C.ws + WS_RV); float* RA = (float*)(C.ws + WS_RA); float* RB = (float*)(C.ws + WS_RB);
    const float* mu = P.mu + (size_t)layer * 1984; const float* mu_v = P.mu_v;
    const float* w0 = P.w0 + layer * 512; const float* a0 = P.a0 + layer * 512; const float* v0 = P.v0; const float* k_k = P.k_k + layer * 512; const float* k_a = P.k_a + layer * 512;
    const int tid = C.tid, lane = C.lane, wid = C.wave;
    for (int u = C.bid; u < M / 32; u += C.G) {
        int r32 = lane & 31, hi = lane >> 5; asm volatile("" : "+v"(r32), "+v"(hi));
        const size_t m0 = (size_t)u * 32;
        for (int idx = tid; idx < 32 * 256; idx += NTHR) {
            const int tok = idx >> 8, c = idx & 255; const size_t m = m0 + tok; const bool first = (m & (T - 1)) == 0;
            const float cur = bf2f(CL[m * 256 + c]); const float prv = first ? 0.f : bf2f(CL[(m - 1) * 256 + c]);
            const float muc = c < 192 ? mu[1536 + c] : (layer > 0 ? mu_v[c - 192] : 0.f);
            const float xs = cur + (prv - cur) * muc;
            if (c < 96) AW[tok * RW_AW + c] = (bf16)f2bf(tanhf(xs)); else if (c < 192) AA[tok * RW_AW + (c - 96)] = (bf16)f2bf(xs); else AV[tok * RW_AV + (c - 192)] = (bf16)f2bf(xs);
        }
        __syncthreads();
        const size_t m = m0 + r32; const bool first = (m & (T - 1)) == 0;
        float ksv[32]; float ss = 0.f;
#pragma unroll
        for (int cb = 0; cb < 2; ++cb)
#pragma unroll
            for (int g = 0; g < 4; ++g) { const int c4 = 64 * wid + 32 * cb + 8 * g + 4 * hi; float ks[4]; shift4(CK, m, 512, c4, first, mu + 512 + c4, ks); const f32x4 kkv = *(const f32x4*)(k_k + c4);
#pragma unroll
                for (int e = 0; e < 4; ++e) { ksv[16 * cb + 4 * g + e] = ks[e]; const float kr = ks[e] * kkv[e]; ss += kr * kr; } }
        ss += __shfl_xor(ss, 32);
        const float inv = 1.0f / fmaxf(sqrtf(ss), 1e-12f);
#pragma unroll
        for (int cb = 0; cb < 2; ++cb) {
            f32x16 dw, da, dv;
#pragma unroll
            for (int r = 0; r < 16; ++r) { dw[r] = 0.f; da[r] = 0.f; dv[r] = 0.f; }
            const int ch = 64 * wid + 32 * cb + r32;
#pragma unroll
            for (int kk = 0; kk < 6; ++kk) {
                const bf16x8 aw = *(const bf16x8*)(LW + ch * 96 + 16 * kk + 8 * hi), aa = *(const bf16x8*)(LA + ch * 96 + 16 * kk + 8 * hi);
                const bf16x8 bw = *(const LAS bf16x8*)(AW + r32 * RW_AW + 16 * kk + 8 * hi), ba = *(const LAS bf16x8*)(AA + r32 * RW_AW + 16 * kk + 8 * hi);
                dw = __builtin_amdgcn_mfma_f32_32x32x16_bf16(aw, bw, dw, 0, 0, 0); da = __builtin_amdgcn_mfma_f32_32x32x16_bf16(aa, ba, da, 0, 0, 0);
            }
            if (layer > 0) {
#pragma unroll
                for (int kk = 0; kk < 4; ++kk) {
                    const bf16x8 av = *(const bf16x8*)(LV + ch * 64 + 16 * kk + 8 * hi); const bf16x8 bv = *(const LAS bf16x8*)(AV + r32 * RW_AV + 16 * kk + 8 * hi);
                    dv = __builtin_amdgcn_mfma_f32_32x32x16_bf16(av, bv, dv, 0, 0, 0);
                }
            }
#pragma unroll
            for (int g = 0; g < 4; ++g) {
                const int c4 = 64 * wid + 32 * cb + 8 * g + 4 * hi;
                float rs[4], vs[4];
                shift4(CR, m, 512, c4, first, mu + c4, rs); shift4(CV, m, 512, c4, first, mu + 1024 + c4, vs);
                const f32x4 w0v = *(const f32x4*)(w0 + c4), a0v = *(const f32x4*)(a0 + c4), kkv = *(const f32x4*)(k_k + c4), kav = *(const f32x4*)(k_a + c4);
                f32x4 vo, wo, kho, ao, bo;
                if (layer > 0) { float vf[4]; ld4bf(VF + m * 512 + c4, vf); const f32x4 v0v = *(const f32x4*)(v0 + c4);
#pragma unroll
                    for (int e = 0; e < 4; ++e) vo[e] = vs[e] + (vf[e] - vs[e]) * sigmoidf_(v0v[e] + dv[4 * g + e]); }
                else { u32x2 w; w.x = pk2(vs[0], vs[1]); w.y = pk2(vs[2], vs[3]); *(u32x2*)(VF + m * 512 + c4) = w;
#pragma unroll
                    for (int e = 0; e < 4; ++e) vo[e] = vs[e]; }
#pragma unroll
                for (int e = 0; e < 4; ++e) {
                    const float x = w0v[e] + dw[4 * g + e];
                    const float z = -x; const float sp = fmaxf(z, 0.f) + log1pf(__expf(-fabsf(z)));
                    wo[e] = __expf(-__expf(-sp - 0.5f));
                    const float a = sigmoidf_(a0v[e] + da[4 * g + e]);
                    const float ksx = ksv[16 * cb + 4 * g + e]; const float kk = ksx * kkv[e] * inv;
                    kho[e] = ksx * (1.0f + (a - 1.0f) * kav[e]); ao[e] = -kk; bo[e] = kk * a;
                }
                *(f32x4*)(RR + m * 512 + c4) = (f32x4){rs[0], rs[1], rs[2], rs[3]}; *(f32x4*)(RWd + m * 512 + c4) = wo; *(f32x4*)(RKH + m * 512 + c4) = kho; *(f32x4*)(RV + m * 512 + c4) = vo;
                *(f32x4*)(RA + m * 512 + c4) = ao; *(f32x4*)(RB + m * 512 + c4) = bo;
            }
        }
        __syncthreads();
    }
}
constexpr int RW_TB = 8, RW_STG = 6 * RW_TB * 64;
#define RW_FENCE() asm volatile("" ::: "memory")
#define RW_PIN16(A, o) asm volatile("" : "+v"(A[(o)]), "+v"(A[(o) + 1]), "+v"(A[(o) + 2]), "+v"(A[(o) + 3]), "+v"(A[(o) + 4]), "+v"(A[(o) + 5]), "+v"(A[(o) + 6]), "+v"(A[(o) + 7]), "+v"(A[(o) + 8]), "+v"(A[(o) + 9]), "+v"(A[(o) + 10]), "+v"(A[(o) + 11]), "+v"(A[(o) + 12]), "+v"(A[(o) + 13]), "+v"(A[(o) + 14]), "+v"(A[(o) + 15]) :: "memory")
template <bool INJECT, bool OUT>
__device__ __forceinline__ void rwkv_chunk(float (&S)[64], LAS float* stg, const float* RWd, const float* RA, const float* RB, const float* RKH, const float* RV, const float* RR, float* Y, size_t base0, int nsteps, int lane) {
    for (int t0 = 0; t0 < nsteps; t0 += RW_TB) {
        {
            float tw[RW_TB], ta[RW_TB], tb[RW_TB], tk[RW_TB], tr[RW_TB], tv[RW_TB];
#pragma unroll
            for (int s = 0; s < RW_TB; ++s) { const size_t o = base0 + (size_t)(t0 + s) * 512 + lane; tw[s] = RWd[o]; ta[s] = RA[o]; tb[s] = RB[o]; tk[s] = INJECT ? RKH[o] : 0.f; tr[s] = OUT ? RR[o] : 0.f; tv[s] = INJECT ? RV[o] : 0.f; }
#pragma unroll
            for (int s = 0; s < RW_TB; ++s) { stg[(0 * RW_TB + s) * 64 + lane] = tw[s]; stg[(1 * RW_TB + s) * 64 + lane] = ta[s]; stg[(2 * RW_TB + s) * 64 + lane] = tb[s];
                if (INJECT) { stg[(3 * RW_TB + s) * 64 + lane] = tk[s]; stg[(5 * RW_TB + s) * 64 + lane] = tv[s]; } if (OUT) stg[(4 * RW_TB + s) * 64 + lane] = tr[s]; }
        }
        LDS_WAIT(); RW_FENCE();
#pragma unroll 1
        for (int s = 0; s < RW_TB; ++s) {
            const LAS f32x4* wp = (const LAS f32x4*)(stg + (0 * RW_TB + s) * 64); const LAS f32x4* ap = (const LAS f32x4*)(stg + (1 * RW_TB + s) * 64); const LAS f32x4* bp = (const LAS f32x4*)(stg + (2 * RW_TB + s) * 64);
            const LAS f32x4* kp = (const LAS f32x4*)(stg + (3 * RW_TB + s) * 64); const LAS f32x4* rp = (const LAS f32x4*)(stg + (4 * RW_TB + s) * 64);
            float v = 0.f; if (INJECT) v = stg[(5 * RW_TB + s) * 64 + lane];
            float sa0 = 0.f, sa1 = 0.f;
#pragma unroll
            for (int g = 0; g < 4; ++g) {
#pragma unroll
                for (int q = 0; q < 4; ++q) { const int j4 = 4 * g + q; const f32x4 a4 = ap[j4]; sa0 += S[4 * j4] * a4.x; sa1 += S[4 * j4 + 1] * a4.y; sa0 += S[4 * j4 + 2] * a4.z; sa1 += S[4 * j4 + 3] * a4.w; }
                asm volatile("" : "+v"(sa0), "+v"(sa1) :: "memory"); }
            const float sa = sa0 + sa1;
#pragma unroll
            for (int g = 0; g < 8; ++g) {
#pragma unroll
                for (int q = 0; q < 2; ++q) { const int j4 = 2 * g + q; const f32x4 w4 = wp[j4], b4 = bp[j4];
                    if (INJECT) { const f32x4 k4 = kp[j4];
                        S[4 * j4] = S[4 * j4] * w4.x + (sa * b4.x + v * k4.x); S[4 * j4 + 1] = S[4 * j4 + 1] * w4.y + (sa * b4.y + v * k4.y);
                        S[4 * j4 + 2] = S[4 * j4 + 2] * w4.z + (sa * b4.z + v * k4.z); S[4 * j4 + 3] = S[4 * j4 + 3] * w4.w + (sa * b4.w + v * k4.w);
                    } else {
                        S[4 * j4] = S[4 * j4] * w4.x + sa * b4.x; S[4 * j4 + 1] = S[4 * j4 + 1] * w4.y + sa * b4.y; S[4 * j4 + 2] = S[4 * j4 + 2] * w4.z + sa * b4.z; S[4 * j4 + 3] = S[4 * j4 + 3] * w4.w + sa * b4.w;
                    } }
                asm volatile("" : "+v"(S[8 * g]), "+v"(S[8 * g + 1]), "+v"(S[8 * g + 2]), "+v"(S[8 * g + 3]), "+v"(S[8 * g + 4]), "+v"(S[8 * g + 5]), "+v"(S[8 * g + 6]), "+v"(S[8 * g + 7]) :: "memory"); }
            if (OUT) { float y0 = 0.f, y1 = 0.f;
#pragma unroll
                for (int g = 0; g < 4; ++g) {
#pragma unroll
                    for (int q = 0; q < 4; ++q) { const int j4 = 4 * g + q; const f32x4 r4 = rp[j4]; y0 += S[4 * j4] * r4.x; y1 += S[4 * j4 + 1] * r4.y; y0 += S[4 * j4 + 2] * r4.z; y1 += S[4 * j4 + 3] * r4.w; }
                    asm volatile("" : "+v"(y0), "+v"(y1) :: "memory"); }
                Y[base0 + (size_t)(t0 + s) * 512 + lane] = y0 + y1; }
        }
        LDS_WAIT(); RW_FENCE();
    }
}
constexpr int RW_L = 256, RW_NC = T / RW_L;
__device__ __forceinline__ void phase_rw2(const Ctx& C) {
    const float* RWd = (const float*)(C.ws + WS_RW); const float* RA = (const float*)(C.ws + WS_RA); const float* RB = (const float*)(C.ws + WS_RB); const float* RKH = (const float*)(C.ws + WS_RKH); const float* RV = (const float*)(C.ws + WS_RV);
    float* PHI = (float*)(C.ws + WS_PHI); float* PSI = (float*)(C.ws + WS_PSI);
    LAS float* stg = (LAS float*)C.lds + C.wave * RW_STG;
    const int ntask = NB * 8 * RW_NC * 2;
    for (int wt = C.bid * NWAVES + C.wave; wt < ntask; wt += C.G * NWAVES) {
        const int kind = wt & 1, task = wt >> 1, ck = task % RW_NC, bh = task / RW_NC, h = bh & 7, b = bh >> 3;
        const size_t base0 = ((size_t)b * T + (size_t)ck * RW_L) * 512 + h * 64;
        float S[64];
#pragma unroll
        for (int j = 0; j < 64; ++j) S[j] = (kind == 0 && j == C.lane) ? 1.f : 0.f;
        float* dst = (kind == 0 ? PHI : PSI) + (size_t)task * 4096 + C.lane * 64;
        if (kind == 0) rwkv_chunk<false, false>(S, stg, RWd, RA, RB, RKH, RV, nullptr, nullptr, base0, RW_L, C.lane);
        else rwkv_chunk<true, false>(S, stg, RWd, RA, RB, RKH, RV, nullptr, nullptr, base0, RW_L, C.lane);
#pragma unroll
        for (int j = 0; j < 64; j += 4) *(f32x4*)(dst + j) = (f32x4){S[j], S[j + 1], S[j + 2], S[j + 3]};
    }
}
__device__ __forceinline__ void phase_rw3(const Ctx& C) {
    const float* PHI = (const float*)(C.ws + WS_PHI); const float* PSI = (const float*)(C.ws + WS_PSI); float* SST = (float*)(C.ws + WS_SST);
    LAS float* ph = (LAS float*)C.lds;
    if (C.wave != 0) return;
    for (int bh = C.bid; bh < NB * 8; bh += C.G) {
        float S[64];
#pragma unroll
        for (int j = 0; j < 64; ++j) S[j] = 0.f;
        for (int ck = 0; ck < RW_NC; ++ck) {
            const size_t task = (size_t)bh * RW_NC + ck; float* dst = SST + task * 4096 + C.lane * 64;
#pragma unroll
            for (int j = 0; j < 64; j += 4) *(f32x4*)(dst + j) = (f32x4){S[j], S[j + 1], S[j + 2], S[j + 3]};
            if (ck + 1 == RW_NC) break;
            const float* pg = PHI + task * 4096;
#pragma unroll
            for (int i = 0; i < 16; ++i) *(LAS f32x4*)(ph + 4 * (C.lane + 64 * i)) = *(const f32x4*)(pg + 4 * (C.lane + 64 * i));
            LDS_WAIT(); RW_FENCE();
            float N[64]; const float* ps = PSI + task * 4096 + C.lane * 64;
#pragma unroll
            for (int j = 0; j < 64; j += 4) { const f32x4 v = *(const f32x4*)(ps + j); N[j] = v.x; N[j + 1] = v.y; N[j + 2] = v.z; N[j + 3] = v.w; }
            RW_FENCE();
#pragma unroll
            for (int j = 0; j < 64; ++j) { const float sj = S[j];
#pragma unroll
                for (int g = 0; g < 4; ++g) {
#pragma unroll
                    for (int q = 0; q < 4; ++q) { const int k4 = 4 * g + q; const f32x4 p = *(const LAS f32x4*)(ph + j * 64 + 4 * k4); N[4 * k4] += sj * p.x; N[4 * k4 + 1] += sj * p.y; N[4 * k4 + 2] += sj * p.z; N[4 * k4 + 3] += sj * p.w; }
                    RW_PIN16(N, 16 * g); } }
#pragma unroll
            for (int j = 0; j < 64; ++j) S[j] = N[j];
            LDS_WAIT(); asm volatile("" ::: "memory");
        }
    }
}
__device__ __forceinline__ void phase_rw4(const Ctx& C) {
    const float* RWd = (const float*)(C.ws + WS_RW); const float* RA = (const float*)(C.ws + WS_RA); const float* RB = (const float*)(C.ws + WS_RB); const float* RKH = (const float*)(C.ws + WS_RKH); const float* RV = (const float*)(C.ws + WS_RV); const float* RR = (const float*)(C.ws + WS_RR);
    const float* SST = (const float*)(C.ws + WS_SST); float* Y = (float*)(C.ws + WS_Y);
    LAS float* stg = (LAS float*)C.lds + C.wave * RW_STG;
    const int ntask = NB * 8 * RW_NC;
    for (int wt = C.wave * C.G + C.bid; wt < ntask; wt += C.G * NWAVES) {
        const int task = wt, ck = task % RW_NC, bh = task / RW_NC, h = bh & 7, b = bh >> 3;
        const size_t base0 = ((size_t)b * T + (size_t)ck * RW_L) * 512 + h * 64;
        float S[64]; const float* src = SST + (size_t)task * 4096 + C.lane * 64;
#pragma unroll
        for (int j = 0; j < 64; j += 4) { const f32x4 v = *(const f32x4*)(src + j); S[j] = v.x; S[j + 1] = v.y; S[j + 2] = v.z; S[j + 3] = v.w; }
        rwkv_chunk<true, true>(S, stg, RWd, RA, RB, RKH, RV, RR, Y, base0, RW_L, C.lane);
    }
}
__device__ __forceinline__ void phase_rw5(const Ctx& C, int layer, const RwP& P) {
    LAS bf16* AG = (LAS bf16*)C.lds;
    const bf16* CG = (const bf16*)(C.ws + WS_CG); const bf16* LG = (const bf16*)(C.ws + WS_LORA + LO_G);
    const float* Y = (const float*)(C.ws + WS_Y); const float* RR = (const float*)(C.ws + WS_RR); const float* RKH = (const float*)(C.ws + WS_RKH); const float* RV = (const float*)(C.ws + WS_RV);
    bf16* CAT = (bf16*)(C.ws + WS_CAT);
    const float* mu = P.mu + (size_t)layer * 1984 + 1728; const float* r_k = P.r_k + layer * 512; const float* lnx_g = P.lnx_g + layer * 512; const float* lnx_b = P.lnx_b + layer * 512;
    const int tid = C.tid, lane = C.lane, wid = C.wave;
    for (int u = C.bid; u < M / 32; u += C.G) {
        int r32 = lane & 31, hi = lane >> 5; asm volatile("" : "+v"(r32), "+v"(hi));
        const size_t m0 = (size_t)u * 32;
        for (int idx = tid; idx < 32 * 256; idx += NTHR) {
            const int tok = idx >> 8, c = idx & 255; const size_t m = m0 + tok; const bool first = (m & (T - 1)) == 0;
            const float cur = bf2f(CG[m * 256 + c]); const float prv = first ? 0.f : bf2f(CG[(m - 1) * 256 + c]);
            AG[tok * RW_AG + c] = (bf16)f2bf(sigmoidf_(cur + (prv - cur) * mu[c]));
        }
        __syncthreads();
        f32x16 dg[2];
#pragma unroll
        for (int cb = 0; cb < 2; ++cb) {
#pragma unroll
            for (int r = 0; r < 16; ++r) dg[cb][r] = 0.f;
            const int ch = 64 * wid + 32 * cb + r32;
#pragma unroll
            for (int kk = 0; kk < 16; ++kk) {
                const bf16x8 ag = *(const bf16x8*)(LG + ch * 256 + 16 * kk + 8 * hi); const bf16x8 bg = *(const LAS bf16x8*)(AG + r32 * RW_AG + 16 * kk + 8 * hi);
                dg[cb] = __builtin_amdgcn_mfma_f32_32x32x16_bf16(ag, bg, dg[cb], 0, 0, 0);
            }
        }
        const size_t m = m0 + r32;
        float yv[32], vv[32]; float sy = 0.f, sb = 0.f;
#pragma unroll
        for (int cb = 0; cb < 2; ++cb)
#pragma unroll
            for (int g = 0; g < 4; ++g) { const int c4 = 64 * wid + 32 * cb + 8 * g + 4 * hi;
                const f32x4 y4 = *(const f32x4*)(Y + m * 512 + c4), r4 = *(const f32x4*)(RR + m * 512 + c4), k4 = *(const f32x4*)(RKH + m * 512 + c4), v4 = *(const f32x4*)(RV + m * 512 + c4), rk4 = *(const f32x4*)(r_k + c4);
#pragma unroll
                for (int e = 0; e < 4; ++e) { yv[16 * cb + 4 * g + e] = y4[e]; vv[16 * cb + 4 * g + e] = v4[e]; sy += y4[e]; sb += r4[e] * k4[e] * rk4[e]; } }
        sy += __shfl_xor(sy, 32); sb += __shfl_xor(sb, 32);
        const float mean = sy * (1.0f / 64.0f); float var = 0.f;
#pragma unroll
        for (int i = 0; i < 32; ++i) { const float d = yv[i] - mean; var += d * d; }
        var += __shfl_xor(var, 32);
        const float rstd = rsqrtf(var * (1.0f / 64.0f) + 64e-5f);
#pragma unroll
        for (int cb = 0; cb < 2; ++cb)
#pragma unroll
            for (int g = 0; g < 4; ++g) { const int c4 = 64 * wid + 32 * cb + 8 * g + 4 * hi;
                const f32x4 lg4 = *(const f32x4*)(lnx_g + c4), lb4 = *(const f32x4*)(lnx_b + c4); float o[4];
#pragma unroll
                for (int e = 0; e < 4; ++e) { const int i = 16 * cb + 4 * g + e; o[e] = ((yv[i] - mean) * rstd * lg4[e] + lb4[e] + sb * vv[i]) * dg[cb][4 * g + e]; }
                u32x2 w; w.x = pk2(o[0], o[1]); w.y = pk2(o[2], o[3]); *(u32x2*)(CAT + m * 2048 + 1536 + c4) = w; }
        __syncthreads();
    }
}
__device__ __forceinline__ void* launder_ptr(const void* p) {
    unsigned lo = (unsigned)(uintptr_t)p, hi = (unsigned)((uintptr_t)p >> 32); asm volatile("" : "+v"(lo), "+v"(hi));
    lo = __builtin_amdgcn_readfirstlane(lo); hi = __builtin_amdgcn_readfirstlane(hi); return (void*)(((uintptr_t)hi << 32) | lo);
}
#ifndef MK_PER_PHASE
#define MK_PER_PHASE 0
#endif
constexpr int PH_PER_LAYER = 17, N_PHASES = DEPTH * PH_PER_LAYER + 1;
struct Args { const float* in[23]; float* out; unsigned char* ws; int ph_lo, ph_hi; };
__global__ void __launch_bounds__(NTHR, 2) fwd_kernel(Args args) {
    extern __shared__ __attribute__((aligned(16))) unsigned char lds_raw[];
    Ctx C;
    C.lds = (LAS unsigned char*)lds_raw; C.tid = threadIdx.x; C.lane = C.tid & 63; C.wave = __builtin_amdgcn_readfirstlane(C.tid >> 6);
    C.G = gridDim.x; C.bid = blockIdx.x;
    const CAS Args* KA = (const CAS Args*)launder_ptr((const void*)(uintptr_t)__builtin_amdgcn_kernarg_segment_ptr());
    C.ws = KA->ws; C.out = KA->out;
    volatile LAS unsigned* MISC = (volatile LAS unsigned*)(C.lds + MISC_OFF);
    if (C.tid < 32) MISC[C.tid] = 0u;
    __syncthreads();
    unsigned* ctl = (unsigned*)(C.ws + WS_CTL);
    XcdBarrier bar; bar.bar = ctl + CW_BAR; bar.x = 0; bar.st = nullptr;
    if (!MK_PER_PHASE) bar = xcd_barrier_post(ctl + CW_BAR, MISC + 8);
    const int lo = KA->ph_lo, hi = KA->ph_hi;
#define FRESH() do { KA = (const CAS Args*)launder_ptr((const void*)(uintptr_t)__builtin_amdgcn_kernarg_segment_ptr()); C.ws = KA->ws; C.out = KA->out; ctl = (unsigned*)(C.ws + WS_CTL); asm volatile("" : "+v"(C.tid)); C.lane = C.tid & 63; C.wave = __builtin_amdgcn_readfirstlane(C.tid >> 6); C.lds = (LAS unsigned char*)lds_raw; } while (0)
#ifndef ONLY_PH
#define ONLY_PH -1
#endif
#ifndef PH_MASK
#define PH_MASK 0xFFFFFFFFu
#endif
#define IN(k) (lo <= (k) && (k) < hi && (ONLY_PH < 0 || ((k) % PH_PER_LAYER) == ONLY_PH) && ((PH_MASK >> ((k) % PH_PER_LAYER)) & 1u))
#define SEAM(k) do { if (IN(k) && IN((k) + 1)) { bar.bar = ctl + CW_BAR; xcd_barrier(bar); } } while (0)
    for (int layer = 0; layer < DEPTH; ++layer) {
        const int p0 = layer * PH_PER_LAYER;
        const float* xin = layer == 0 ? KA->in[0] : C.out;
        FRESH(); if (IN(p0 + 0)) { { const WSrc W{KA->in[2], KA->in[3], KA->in[18], KA->in[20], KA->in[21], KA->in[7], KA->in[9], KA->in[12], KA->in[11]}; phase_wconv(C, layer, W); } phase_norm_bf16(C, xin, KA->in[1] + layer * DM, (bf16*)(C.ws + WS_H)); }
        SEAM(p0 + 0);
        FRESH(); if (IN(p0 + 1)) { pg8::Gemm g{(const pg8::bf16_t*)(C.ws + WS_H), (const pg8::bf16_t*)(C.ws + WS_WIN), M, N_INP, DM}; pg8::StaticOrder S; S.init(M, N_INP, C.G, C.bid);
            pg8::EpiProj E{C.ws}; pg8::gemm_phase<pg8::EpiProj, pg8::StaticOrder, true, true>(C.lds, g, S, E); }
        SEAM(p0 + 1);
        FRESH(); if (IN(p0 + 2)) phase_prep_a(C);
        SEAM(p0 + 2);
        FRESH(); if (IN(p0 + 3)) phase_indexer(C);
        SEAM(p0 + 3);
        FRESH(); if (IN(p0 + 4)) phase_attn(C);
        SEAM(p0 + 4);
        FRESH(); if (IN(p0 + 5)) phase_ret1(C);
        SEAM(p0 + 5);
        FRESH(); if (IN(p0 + 6)) phase_ret2(C);
        SEAM(p0 + 6);
        FRESH(); if (IN(p0 + 7)) phase_ret3(C);
        SEAM(p0 + 7);
        FRESH(); if (IN(p0 + 8)) { const RwP P{KA->in[4], KA->in[5], KA->in[6], KA->in[8], KA->in[10], KA->in[13], KA->in[14], KA->in[15], KA->in[16], KA->in[17]}; phase_rw1(C, layer, P); }
        SEAM(p0 + 8);
        FRESH(); if (IN(p0 + 9)) phase_rw2(C);
        SEAM(p0 + 9);
        FRESH(); if (IN(p0 + 10)) phase_rw3(C);
        SEAM(p0 + 10);
        FRESH(); if (IN(p0 + 11)) phase_rw4(C);
        SEAM(p0 + 11);
        FRESH(); if (IN(p0 + 12)) { const RwP P{KA->in[4], KA->in[5], KA->in[6], KA->in[8], KA->in[10], KA->in[13], KA->in[14], KA->in[15], KA->in[16], KA->in[17]}; phase_rw5(C, layer, P); }
        SEAM(p0 + 12);
        FRESH(); if (IN(p0 + 13)) { pg8::Gemm g{(const pg8::bf16_t*)(C.ws + WS_CAT), (const pg8::bf16_t*)(C.ws + WS_WOUT), M, DM, DM}; pg8::StaticOrder S; S.init(M, DM, C.G, C.bid);
            pg8::EpiResid E{xin, C.out, DM}; pg8::gemm_phase<pg8::EpiResid, pg8::StaticOrder, true, true>(C.lds, g, S, E); }
        SEAM(p0 + 13);
        FRESH(); if (IN(p0 + 14)) phase_norm_bf16(C, C.out, KA->in[19] + layer * DM, (bf16*)(C.ws + WS_H2));
        SEAM(p0 + 14);
        FRESH(); if (IN(p0 + 15)) { pg8::Gemm g{(const pg8::bf16_t*)(C.ws + WS_H2), (const pg8::bf16_t*)(C.ws + WS_WGU), M, 2 * DFF, DM}; pg8::StaticOrder S; S.init(M, 2 * DFF, C.G, C.bid);
            pg8::EpiSwiGLU E{(pg8::bf16_t*)(C.ws + WS_ACT), DFF}; pg8::gemm_phase<pg8::EpiSwiGLU, pg8::StaticOrder, true, true>(C.lds, g, S, E); }
        SEAM(p0 + 15);
        FRESH(); if (IN(p0 + 16)) { pg8::Gemm g{(const pg8::bf16_t*)(C.ws + WS_ACT), (const pg8::bf16_t*)(C.ws + WS_WDN), M, DM, DFF}; pg8::StaticOrder S; S.init(M, DM, C.G, C.bid);
            pg8::EpiResid E{C.out, C.out, DM}; pg8::gemm_phase<pg8::EpiResid, pg8::StaticOrder, true, true>(C.lds, g, S, E); }
        SEAM(p0 + 16);
    }
    if (IN(N_PHASES - 1)) phase_final_norm(C, C.out, KA->in[22]);
#undef IN
#undef SEAM
}

extern "C" void kernel_launch(void* const* d_in, const int* in_sizes, int n_in, void* d_out, int out_size, void* d_ws, size_t ws_size, hipStream_t stream) {
    static int grid = 0;
    if (grid == 0) {
        if (n_in != 23 || out_size != M * DM || ws_size < WS_NEED) { fprintf(stderr, "kernel_launch: unexpected problem (n_in %d, out %d, ws %zu); nothing launched\n", n_in, out_size, ws_size); grid = -1; return; }
        int dev = 0, cus = 0, per_cu = 0;
        if (hipGetDevice(&dev) != hipSuccess || hipDeviceGetAttribute(&cus, hipDeviceAttributeMultiprocessorCount, dev) != hipSuccess) { grid = -1; return; }
        if (hipFuncSetAttribute((const void*)fwd_kernel, hipFuncAttributeMaxDynamicSharedMemorySize, LDS_BYTES) != hipSuccess) { fprintf(stderr, "kernel_launch: hipFuncSetAttribute failed\n"); grid = -1; return; }
        if (hipOccupancyMaxActiveBlocksPerMultiprocessor(&per_cu, (const void*)fwd_kernel, NTHR, LDS_BYTES) != hipSuccess || per_cu < 1) { fprintf(stderr, "kernel_launch: occupancy query says %d blocks per CU\n", per_cu); }
        (void)hipGetLastError();
        grid = cus;
    }
    if (grid < 0) return;
    (void)hipMemsetAsync((char*)d_ws + WS_CTL, 0, CTL_ZERO_BYTES, stream);
    Args a{};
    for (int i = 0; i < 23; ++i) a.in[i] = (const float*)d_in[i];
    a.out = (float*)d_out; a.ws = (unsigned char*)d_ws;
#if MK_PER_PHASE
    for (int p = 0; p < N_PHASES; ++p) { a.ph_lo = p; a.ph_hi = p + 1; hipLaunchKernelGGL(fwd_kernel, dim3(grid), dim3(NTHR), LDS_BYTES, stream, a); }
#else
    a.ph_lo = 0; a.ph_hi = N_PHASES;
    hipLaunchKernelGGL(fwd_kernel, dim3(grid), dim3(NTHR), LDS_BYTES, stream, a);
#endif
    const hipError_t le = hipPeekAtLastError();
    if (le != hipSuccess) fprintf(stderr, "kernel_launch: launch failed: %s\n", hipGetErrorName(le));
}
```

```cpp
#include <hip/hip_runtime.h>
#include <hip/hip_fp16.h>
#include <cstdio>
#include <cstdint>
namespace pg8 {
#define PG8_LAS __attribute__((address_space(3)))
typedef unsigned short bf16_t;
typedef short bf16x8 __attribute__((ext_vector_type(8)));
typedef float f32x4 __attribute__((ext_vector_type(4)));
typedef unsigned u32x4 __attribute__((ext_vector_type(4)));
constexpr int BM = 256, BK = 64, HALF = 128, HTB = HALF * BK * 2  , STAGE_BYTES = 8 * HTB, NXCD = 8, WGM = 8;

__host__ __device__ __forceinline__ int lds_byte(int r, int c) { const int st = (r >> 4) * 2 + (c >> 5), rr = r & 15, cc = c & 31, ob = rr * 64 + cc * 2; return st * 1024 + (ob ^ (((ob >> 9) & 1) << 5)); }
__host__ __device__ __forceinline__ void stage_rc(int b, int& R, int& C) { const int st = b / 1024, sb = b % 1024, swz = sb ^ (((sb >> 9) & 1) << 5); R = (st >> 1) * 16 + swz / 64; C = (st & 1) * 32 + (swz % 64) / 2; }
__host__ __device__ __forceinline__ int perm32(int rho) { const int n = rho >> 4, i = rho & 15; return 8 * (i >> 2) + 4 * n + (i & 3); }

struct Unit { int pm, pn; };
struct Gemm { const bf16_t* A; const bf16_t* Bt; int M, N, K; };

struct StaticOrder {
    int nM, nN, nwg, G, c;
    __host__ __device__ void init(int M, int N, int G_, int c_) { nM = M / BM; nN = N / BM; nwg = nM * nN; G = G_; c = c_; }
    __host__ __device__ bool next(int i, Unit& u) const {
        const long L = (long)i * G + c; if (L >= nwg) return false;
        int wgid = (int)L; { const int q = nwg / NXCD, r = nwg % NXCD, xcd = wgid % NXCD, off = wgid / NXCD; wgid = (xcd < r ? xcd * (q + 1) : r * (q + 1) + (xcd - r) * q) + off; }
        const int nig = WGM * nN, gid = wgid / nig, fm = gid * WGM, gsz = (nM - fm) < WGM ? (nM - fm) : WGM;
        u.pm = fm + ((wgid % nig) % gsz); u.pn = (wgid % nig) / gsz; return true;
    }
    __device__ __forceinline__ void a_ready(const Unit&) const {}
    __device__ __forceinline__ void done(const Unit&) const {}
};

__device__ __forceinline__ unsigned cvt_pk_bf16(float lo, float hi) { unsigned r; asm volatile("v_cvt_pk_bf16_f32 %0, %1, %2" : "=v"(r) : "v"(lo), "v"(hi)); return r; }
typedef float f32x2 __attribute__((ext_vector_type(2)));
__device__ __forceinline__ f32x2 gelu_pk(f32x2 v) {
    const f32x2 av = __builtin_elementwise_abs(v), d = av * 0.2316418882f + 1.0f;
    f32x2 t; t.x = __builtin_amdgcn_rcpf(d.x); t.y = __builtin_amdgcn_rcpf(d.y);
    f32x2 q = t * 0.5307027145f + (-0.7265760135f); q = q * t + 0.7107068705f; q = q * t + (-0.142248368f); q = q * t + 0.127414796f; q = q * t;
    const f32x2 s = (v * v) * (-0.72134752044f);
    f32x2 e; e.x = __builtin_amdgcn_exp2f(s.x); e.y = __builtin_amdgcn_exp2f(s.y);
    const f32x2 m = v * (q * e), r = v - m;
    f32x2 o; o.x = v.x < 0.f ? m.x : r.x; o.y = v.y < 0.f ? m.y : r.y; return o;
}

template <int ACT  > struct EpiBf16 {
    static constexpr bool PERM = true, AFTER_DRAIN = false; static_assert(ACT == 0 || ACT == 1, "EpiBf16: ACT is 0 (none) or 1 (gelu_pk)");
    bf16_t* O; int ldc; const float* bias; int split_cols; size_t split_stride; float scale0;
    __device__ __forceinline__ void operator()(const f32x4 (&acc)[2][2][4][2], const Unit& u, int wr, int wc, int fr, int fq) const {
        const int row0 = u.pm * BM + wr * 64 + fr; int colt = u.pn * BM; bf16_t* base = O;
        float sc = 1.f; if (split_cols) { const int t = colt / split_cols; base += (size_t)t * split_stride; colt -= t * split_cols; if (t == 0) sc = scale0; }
        const int col0 = colt + wc * 32 + 8 * fq, bcol0 = u.pn * BM + wc * 32 + 8 * fq;
        f32x4 bv[2][2];
#pragma unroll
        for (int bj = 0; bj < 2; ++bj)
#pragma unroll
            for (int n = 0; n < 2; ++n) bv[bj][n] = bias ? *(const f32x4*)(bias + bcol0 + bj * HALF + 4 * n) : (f32x4){0.f, 0.f, 0.f, 0.f};
#pragma unroll
        for (int ai = 0; ai < 2; ++ai)
#pragma unroll
            for (int m = 0; m < 4; ++m) { bf16_t* rowp = base + (size_t)(row0 + ai * HALF + m * 16) * ldc + col0;
#pragma unroll
                for (int bj = 0; bj < 2; ++bj) { f32x4 v0 = acc[ai][bj][m][0] + bv[bj][0], v1 = acc[ai][bj][m][1] + bv[bj][1];
                    if (ACT == 1) { f32x2 a = gelu_pk((f32x2){v0[0], v0[1]}), b = gelu_pk((f32x2){v0[2], v0[3]}), c = gelu_pk((f32x2){v1[0], v1[1]}), d = gelu_pk((f32x2){v1[2], v1[3]});
                        v0 = (f32x4){a.x, a.y, b.x, b.y}; v1 = (f32x4){c.x, c.y, d.x, d.y}; }
                    v0 = v0 * sc; v1 = v1 * sc; u32x4 w; w.x = cvt_pk_bf16(v0[0], v0[1]); w.y = cvt_pk_bf16(v0[2], v0[3]); w.z = cvt_pk_bf16(v1[0], v1[1]); w.w = cvt_pk_bf16(v1[2], v1[3]);
                    *(u32x4*)(rowp + bj * HALF) = w; } }
    }
};

__device__ __forceinline__ void tile_dest(int pn, size_t& off, int& ld, int& colt);
struct EpiProj {
    static constexpr bool PERM = true, AFTER_DRAIN = false;
    unsigned char* ws;
    __device__ __forceinline__ void operator()(const f32x4 (&acc)[2][2][4][2], const Unit& u, int wr, int wc, int fr, int fq) const {
        size_t off; int ld, colt; tile_dest(u.pn, off, ld, colt);
        bf16_t* base = (bf16_t*)(ws + off);
        const int row0 = u.pm * BM + wr * 64 + fr, col0 = colt + wc * 32 + 8 * fq;
#pragma unroll
        for (int ai = 0; ai < 2; ++ai)
#pragma unroll
            for (int m = 0; m < 4; ++m) { bf16_t* rowp = base + (size_t)(row0 + ai * HALF + m * 16) * ld + col0;
#pragma unroll
                for (int bj = 0; bj < 2; ++bj) { const f32x4 v0 = acc[ai][bj][m][0], v1 = acc[ai][bj][m][1];
                    u32x4 w; w.x = cvt_pk_bf16(v0[0], v0[1]); w.y = cvt_pk_bf16(v0[2], v0[3]); w.z = cvt_pk_bf16(v1[0], v1[1]); w.w = cvt_pk_bf16(v1[2], v1[3]);
                    *(u32x4*)(rowp + bj * HALF) = w; } }
    }
};
struct EpiResid {
    static constexpr bool PERM = false, AFTER_DRAIN = false;
    const float* base; float* out; int ldc;
    __device__ __forceinline__ void operator()(const f32x4 (&acc)[2][2][4][2], const Unit& u, int wr, int wc, int fr, int fq) const {
        const int row0 = u.pm * BM + wr * 64 + fr, col0 = u.pn * BM + wc * 32 + 4 * fq;
#pragma unroll
        for (int ai = 0; ai < 2; ++ai)
#pragma unroll
            for (int m = 0; m < 4; ++m) { const size_t off = (size_t)(row0 + ai * HALF + m * 16) * ldc + col0;
#pragma unroll
                for (int bj = 0; bj < 2; ++bj)
#pragma unroll
                    for (int n = 0; n < 2; ++n) { const size_t p = off + bj * HALF + n * 16; const f32x4 b = *(const f32x4*)(base + p); *(f32x4*)(out + p) = b + acc[ai][bj][m][n]; } }
    }
};
struct EpiSwiGLU {
    static constexpr bool PERM = true, AFTER_DRAIN = false;
    bf16_t* O; int ldc;
    __device__ __forceinline__ static float silu_mul(float g, float u) { return g * u * __builtin_amdgcn_rcpf(1.0f + __expf(-g)); }
    __device__ __forceinline__ void operator()(const f32x4 (&acc)[2][2][4][2], const Unit& u, int wr, int wc, int fr, int fq) const {
        const int row0 = u.pm * BM + wr * 64 + fr, col0 = u.pn * HALF + wc * 32 + 8 * fq;
#pragma unroll
        for (int ai = 0; ai < 2; ++ai)
#pragma unroll
            for (int m = 0; m < 4; ++m) { bf16_t* rowp = O + (size_t)(row0 + ai * HALF + m * 16) * ldc + col0;
                const f32x4 g0 = acc[ai][0][m][0], g1 = acc[ai][0][m][1], u0 = acc[ai][1][m][0], u1 = acc[ai][1][m][1];
                u32x4 w; w.x = cvt_pk_bf16(silu_mul(g0[0], u0[0]), silu_mul(g0[1], u0[1])); w.y = cvt_pk_bf16(silu_mul(g0[2], u0[2]), silu_mul(g0[3], u0[3]));
                w.z = cvt_pk_bf16(silu_mul(g1[0], u1[0]), silu_mul(g1[1], u1[1])); w.w = cvt_pk_bf16(silu_mul(g1[2], u1[2]), silu_mul(g1[3], u1[3]));
                *(u32x4*)rowp = w; }
    }
};
template <class Epi, class Sched, bool ALIGN_EPI = false, bool SP2 = false>
__device__ __forceinline__ void gemm_phase(PG8_LAS unsigned char* lds, const Gemm g, const Sched& S, const Epi& E) {
    int tid_ = threadIdx.x; asm volatile("" : "+v"(tid_));
    const int tid = tid_, wid = __builtin_amdgcn_readfirstlane(tid >> 6), lane = tid & 63, wr = wid >> 2, wc = wid & 3, fr = lane & 15, fq = lane >> 4;
    const int K = g.K, nt = K / BK;
    unsigned voffA[2], voffB[2];
#pragma unroll
    for (int i = 0; i < 2; ++i) { int R, C; stage_rc(tid * 16 + i * 8192, R, C); const int Rb = Epi::PERM ? ((R & ~31) + perm32(R & 31)) : R;
        voffA[i] = (unsigned)(R * K + C) * 2u; voffB[i] = (unsigned)(Rb * K + C) * 2u; }
    const size_t kstep = (size_t)(BK * 2);
    const size_t hstep = (size_t)HALF * K * 2;
    const size_t tstep = 2 * hstep;
    const unsigned ldsw = (unsigned)wid * 1024u;
    const int aoff = lds_byte(wr * 64 + fr, fq * 8), boff = lds_byte(wc * 32 + fr, fq * 8);
#define PG8_SA(b, h) (((b) * 2 + (h)) * HTB)
#define PG8_SB(b, h) ((4 + (b) * 2 + (h)) * HTB)
#define PG8_STAGE(bufoff, gbase, voff) do { _Pragma("unroll") for (int _i = 0; _i < 2; ++_i) \
        __builtin_amdgcn_global_load_lds((const unsigned*)((const char*)(gbase) + (voff)[_i]), (PG8_LAS unsigned*)(lds + (bufoff) + ldsw + _i * 8192), 16, 0, 0); } while (0)
#define PG8_LDA(dst, b, h) do { _Pragma("unroll") for (int m = 0; m < 4; ++m) _Pragma("unroll") for (int k = 0; k < 2; ++k) dst[m][k] = *(const PG8_LAS bf16x8*)(lds + PG8_SA(b, h) + aoff + m * 2048 + k * 1024); } while (0)
#define PG8_LDB(dst, b, h) do { _Pragma("unroll") for (int n = 0; n < 2; ++n) _Pragma("unroll") for (int k = 0; k < 2; ++k) dst[n][k] = *(const PG8_LAS bf16x8*)(lds + PG8_SB(b, h) + boff + n * 2048 + k * 1024); } while (0)
#define PG8_MMA(ai, bj, At, Bt) do { __builtin_amdgcn_s_setprio(1); _Pragma("unroll") for (int m = 0; m < 4; ++m) _Pragma("unroll") for (int n = 0; n < 2; ++n) _Pragma("unroll") for (int k = 0; k < 2; ++k) \
        acc[ai][bj][m][n] = __builtin_amdgcn_mfma_f32_16x16x32_bf16(Bt[n][k], At[m][k], acc[ai][bj][m][n], 0, 0, 0); __builtin_amdgcn_s_setprio(0); } while (0)
#define PG8_WAIT_V(n) asm volatile("s_waitcnt vmcnt(" #n ")" ::: "memory")
#define PG8_WAIT_L(n) asm volatile("s_waitcnt lgkmcnt(" #n ")" ::: "memory")
#define PG8_BAR __builtin_amdgcn_s_barrier()
#define PG8_SCHED __builtin_amdgcn_sched_barrier(0)
    Unit cur, nxt; int ui = 0;
    if (!S.next(0, cur)) return;
    f32x4 acc[2][2][4][2];
#pragma unroll
    for (int a = 0; a < 2; ++a)
#pragma unroll
        for (int b = 0; b < 2; ++b)
#pragma unroll
            for (int m = 0; m < 4; ++m)
#pragma unroll
                for (int n = 0; n < 2; ++n) acc[a][b][m][n] = (f32x4){0.f, 0.f, 0.f, 0.f};
    bf16x8 At[4][2], B0[2][2], B1[2][2];
    const char* cA = (const char*)g.A + (size_t)cur.pm * tstep; const char* cB = (const char*)g.Bt + (size_t)cur.pn * tstep;
    S.a_ready(cur);
    if constexpr (SP2) {
        PG8_STAGE(PG8_SB(0, 0), cB, voffB); PG8_STAGE(PG8_SB(0, 1), cB + hstep, voffB); PG8_STAGE(PG8_SA(0, 0), cA, voffA); PG8_STAGE(PG8_SA(0, 1), cA + hstep, voffA);
        if (wr == 1) PG8_BAR;
        PG8_WAIT_V(2); PG8_BAR;
        PG8_STAGE(PG8_SB(1, 0), cB + kstep, voffB); PG8_STAGE(PG8_SA(1, 0), cA + kstep, voffA); PG8_STAGE(PG8_SB(1, 1), cB + hstep + kstep, voffB);
        PG8_WAIT_V(6); PG8_BAR;
    } else {
        PG8_STAGE(PG8_SB(0, 0), cB, voffB); PG8_STAGE(PG8_SA(0, 0), cA, voffA); PG8_STAGE(PG8_SB(0, 1), cB + hstep, voffB); PG8_STAGE(PG8_SA(0, 1), cA + hstep, voffA);
        if (wr == 1) PG8_BAR;
        PG8_WAIT_V(4); PG8_BAR;
        PG8_STAGE(PG8_SB(1, 0), cB + kstep, voffB); PG8_STAGE(PG8_SA(1, 0), cA + kstep, voffA); PG8_STAGE(PG8_SB(1, 1), cB + hstep + kstep, voffB);
        PG8_WAIT_V(6); PG8_BAR;
    }
    for (;;) {
        const bool has_next = S.next(ui + 1, nxt);
        const char* nA = has_next ? (const char*)g.A + (size_t)nxt.pm * tstep : cA; const char* nB = has_next ? (const char*)g.Bt + (size_t)nxt.pn * tstep : cB;
        for (int t = 0; t < nt; t += 2) {
            const bool last = (t == nt - 2);
            const char* a1 = cA + (size_t)(t + 1) * kstep;
            const char* a2 = last ? nA : cA + (size_t)(t + 2) * kstep; const char* b2 = last ? nB : cB + (size_t)(t + 2) * kstep;
            const char* a3 = a2 + kstep; const char* b3 = b2 + kstep;
            if (last && has_next) S.a_ready(nxt);
            if constexpr (SP2) {
            PG8_LDB(B0, 0, 0); PG8_LDB(B1, 0, 1); PG8_SCHED; PG8_LDA(At, 0, 0); PG8_STAGE(PG8_SA(1, 1), a1 + hstep, voffA);
            PG8_WAIT_V(8); PG8_WAIT_L(0); PG8_BAR; PG8_MMA(0, 0, At, B0); PG8_MMA(0, 1, At, B1); PG8_BAR; PG8_SCHED;
            PG8_LDA(At, 0, 1); PG8_STAGE(PG8_SB(0, 0), b2, voffB); PG8_STAGE(PG8_SB(0, 1), b2 + hstep, voffB); PG8_STAGE(PG8_SA(0, 0), a2, voffA);
            PG8_WAIT_V(8); PG8_WAIT_L(0); PG8_BAR; PG8_MMA(1, 0, At, B0); PG8_MMA(1, 1, At, B1); PG8_BAR; PG8_SCHED;
            PG8_LDB(B0, 1, 0); PG8_LDB(B1, 1, 1); PG8_SCHED; PG8_LDA(At, 1, 0); PG8_STAGE(PG8_SA(0, 1), a2 + hstep, voffA);
            PG8_WAIT_V(8); PG8_WAIT_L(0); PG8_BAR; PG8_MMA(0, 0, At, B0); PG8_MMA(0, 1, At, B1); PG8_BAR; PG8_SCHED;
            PG8_LDA(At, 1, 1); PG8_STAGE(PG8_SB(1, 0), b3, voffB); PG8_STAGE(PG8_SB(1, 1), b3 + hstep, voffB); PG8_STAGE(PG8_SA(1, 0), a3, voffA);
            PG8_WAIT_V(8); PG8_WAIT_L(0); PG8_BAR; PG8_MMA(1, 0, At, B0); PG8_MMA(1, 1, At, B1); PG8_BAR; PG8_SCHED;
            } else {
            PG8_LDB(B0, 0, 0); PG8_SCHED; PG8_LDA(At, 0, 0); PG8_STAGE(PG8_SA(1, 1), a1 + hstep, voffA);
            PG8_WAIT_L(8); PG8_BAR; PG8_WAIT_L(0); PG8_MMA(0, 0, At, B0); PG8_BAR; PG8_SCHED;
            PG8_LDB(B1, 0, 1); PG8_STAGE(PG8_SB(0, 0), b2, voffB);
            PG8_BAR; PG8_WAIT_L(0); PG8_MMA(0, 1, At, B1); PG8_BAR;
            PG8_LDA(At, 0, 1); PG8_STAGE(PG8_SA(0, 0), a2, voffA);
            PG8_BAR; PG8_WAIT_L(0); PG8_MMA(1, 0, At, B0); PG8_BAR; PG8_SCHED;
            PG8_STAGE(PG8_SB(0, 1), b2 + hstep, voffB);
            PG8_WAIT_V(6); PG8_BAR; PG8_MMA(1, 1, At, B1); PG8_BAR;
            PG8_LDB(B0, 1, 0); PG8_SCHED; PG8_LDA(At, 1, 0); PG8_STAGE(PG8_SA(0, 1), a2 + hstep, voffA);
            PG8_WAIT_L(8); PG8_BAR; PG8_WAIT_L(0); PG8_MMA(0, 0, At, B0); PG8_BAR; PG8_SCHED;
            PG8_LDB(B1, 1, 1); PG8_STAGE(PG8_SB(1, 0), b3, voffB);
            PG8_BAR; PG8_WAIT_L(0); PG8_MMA(0, 1, At, B1); PG8_BAR;
            PG8_LDA(At, 1, 1); PG8_STAGE(PG8_SA(1, 0), a3, voffA);
            PG8_BAR; PG8_WAIT_L(0); PG8_MMA(1, 0, At, B0); PG8_BAR; PG8_SCHED;
            PG8_STAGE(PG8_SB(1, 1), b3 + hstep, voffB);
            PG8_WAIT_V(6); PG8_BAR; PG8_MMA(1, 1, At, B1); PG8_BAR;
            }
        }
        if constexpr (ALIGN_EPI) { if (wr == 0) PG8_BAR; }
        if constexpr (!Epi::AFTER_DRAIN) { E(acc, cur, wr, wc, fr, fq); S.done(cur); }
        if (!has_next) break;
#pragma unroll
        for (int a = 0; a < 2; ++a)
#pragma unroll
            for (int b = 0; b < 2; ++b)
#pragma unroll
                for (int m = 0; m < 4; ++m)
#pragma unroll
                    for (int n = 0; n < 2; ++n) acc[a][b][m][n] = (f32x4){0.f, 0.f, 0.f, 0.f};
        cur = nxt; cA = nA; cB = nB; ++ui;
        if constexpr (ALIGN_EPI) { if (wr == 1) PG8_BAR; }
    }
    PG8_WAIT_V(0);
    if constexpr (!ALIGN_EPI) { if (wr == 0) PG8_BAR; }
    PG8_BAR;
    if constexpr (Epi::AFTER_DRAIN) { E.fused(acc, cur, wr, wc, fr, fq, lds, wid, lane); S.done(cur); }
#undef PG8_SA
#undef PG8_SB
#undef PG8_STAGE
#undef PG8_LDA
#undef PG8_LDB
#undef PG8_MMA
#undef PG8_WAIT_V
#undef PG8_WAIT_L
#undef PG8_BAR
#undef PG8_SCHED
}
}
constexpr int NB = 4, T = 8192, M = NB * T, DM = 2048, DFF = 5632, DEPTH = 2;
constexpr int N_IN = 7696, N_INP = 7936;
constexpr int NWAVES = 8, NTHR = NWAVES * 64;
#define LAS __attribute__((address_space(3)))
#define GAS __attribute__((address_space(1)))
#define CAS __attribute__((address_space(4)))
typedef unsigned short bf16;
typedef short bf16x8 __attribute__((ext_vector_type(8)));
typedef float f32x4 __attribute__((ext_vector_type(4)));
typedef float f32x16 __attribute__((ext_vector_type(16)));
typedef unsigned u32x4 __attribute__((ext_vector_type(4)));
typedef unsigned u32x2 __attribute__((ext_vector_type(2)));
typedef unsigned long long u64;

constexpr size_t MiB = 1u << 20;
constexpr size_t WS_CTL = 0, CTL_ZERO_BYTES = 1 * MiB;
constexpr size_t WS_WIN = 1 * MiB, WS_WOUT = 32 * MiB, WS_WGU = 40 * MiB, WS_WDN = 84 * MiB;
constexpr size_t WS_LORA = 106 * MiB;
constexpr size_t LO_W = 0, LO_A = 512 * 96 * 2, LO_V = 2 * 512 * 96 * 2, LO_G = LO_V + 512 * 64 * 2;
constexpr size_t WS_VFIRST = 107 * MiB;
constexpr size_t WS_H = 139 * MiB;
constexpr size_t WS_VT = 139 * MiB, WS_MASK = 203 * MiB;
constexpr size_t WS_Q = 267 * MiB, WS_K = 331 * MiB, WS_QI = 395 * MiB, WS_V = 459 * MiB, WS_KW = 523 * MiB, WS_BQ = 539 * MiB, WS_BK = 555 * MiB, WS_BV = 571 * MiB, WS_BG = 603 * MiB;
constexpr size_t WS_CR = 635 * MiB, WS_CK = 667 * MiB, WS_CV = 699 * MiB, WS_CL = 731 * MiB, WS_CG = 747 * MiB;
constexpr size_t WS_CAT = 763 * MiB;
constexpr size_t WS_KVST = 891 * MiB;
constexpr size_t WS_TAB = 955 * MiB;
constexpr size_t TAB_A = 0, TAB_I = (size_t)T * 16 * 8, TAB_R = TAB_I + (size_t)T * 8 * 8, TAB_END = TAB_R + (size_t)T * 32 * 8;
constexpr size_t WS_RR = 139 * MiB, WS_RW = 203 * MiB, WS_RKH = 267 * MiB, WS_RV = 331 * MiB, WS_RA = 395 * MiB, WS_RB = 459 * MiB;
constexpr size_t WS_PHI = 523 * MiB, WS_PSI = 555 * MiB, WS_SST = 587 * MiB, WS_Y = 635 * MiB;
constexpr size_t WS_H2 = 139 * MiB, WS_ACT = 267 * MiB;
constexpr size_t WS_NEED = 1024 * MiB;
static_assert(WS_TAB + TAB_END <= WS_NEED && WS_ACT + (size_t)M * DFF * 2 <= WS_CR && WS_SST + 32 * MiB <= WS_CR && WS_Y + (size_t)M * 512 * 4 <= WS_CV, "ws map");

constexpr int LDS_BYTES = 147456, MISC_OFF = 143360;
constexpr int CW_BAR = 4096;

__device__ __forceinline__ unsigned f2bf(float f) { unsigned u = __builtin_bit_cast(unsigned, f); return (u + 0x7fffu + ((u >> 16) & 1u)) >> 16; }
__device__ __forceinline__ unsigned pk2(float lo, float hi) { return f2bf(lo) | (f2bf(hi) << 16); }
__device__ __forceinline__ float bf2f(unsigned short b) { return __builtin_bit_cast(float, (unsigned)b << 16); }
__device__ __forceinline__ float bflo(unsigned w) { return __builtin_bit_cast(float, w << 16); }
__device__ __forceinline__ float bfhi(unsigned w) { return __builtin_bit_cast(float, w & 0xffff0000u); }
__device__ __forceinline__ float wave_sum(float v) {
#pragma unroll
    for (int o = 1; o < 64; o <<= 1) v += __shfl_xor(v, o);
    return v;
}
#define LDS_WAIT() asm volatile("s_waitcnt lgkmcnt(0)" ::: "memory")

namespace pg8 {
__device__ __forceinline__ void tile_dest(int pn, size_t& off, int& ld, int& colt) {
    if (pn < 16) { const int g = pn >> 2; off = g == 0 ? WS_Q : g == 1 ? WS_K : g == 2 ? WS_V : WS_QI; ld = 1024; colt = (pn & 3) * 256; }
    else if (pn == 16) { off = WS_BQ; ld = 256; colt = 0; }
    else if (pn == 17) { off = WS_BK; ld = 256; colt = 0; }
    else if (pn < 20) { off = WS_BV; ld = 512; colt = (pn - 18) * 256; }
    else if (pn < 22) { off = WS_BG; ld = 512; colt = (pn - 20) * 256; }
    else if (pn == 22) { off = WS_KW; ld = 256; colt = 0; }
    else if (pn < 25) { off = WS_CR; ld = 512; colt = (pn - 23) * 256; }
    else if (pn < 27) { off = WS_CK; ld = 512; colt = (pn - 25) * 256; }
    else if (pn < 29) { off = WS_CV; ld = 512; colt = (pn - 27) * 256; }
    else if (pn == 29) { off = WS_CL; ld = 256; colt = 0; }
    else { off = WS_CG; ld = 256; colt = 0; }
}
}
__device__ __forceinline__ int win_src(int n, int layer) {
    if (n < 4096) return n;
    if (n < 4352) return 4176 + (n - 4096);
    if (n < 4608) return 4432 + (n - 4352);
    if (n < 5120) return 4688 + (n - 4608);
    if (n < 5632) return 5200 + (n - 5120);
    if (n < 5888) { const int j = n - 5632; return j < 64 ? 4096 + j : (j < 80 ? 4160 + (j - 64) : -1); }
    if (n < 7424) return 5712 + (n - 5888);
    if (n < 7680) { const int j = n - 7424; return j < 96 ? 7248 + j : (j < 192 ? 7344 + (j - 96) : (layer > 0 ? -2 - (j - 192) : -1)); }
    return 7440 + (n - 7680);
}
#define XB_TMO      128
#define XB_XCNT(j)  (256  + 64 * (j))
#define XB_XSUB(j)  (1280 + 64 * (j))
#define XB_XGEN(j)  (2304 + 64 * (j))
#define XB_TOP      3328
#define XB_TOPGEN   3392
#define XCD_BAR_WORDS 3456
#define XB_SPIN_CAP (1u << 18)

__device__ __forceinline__ unsigned xb_ld(unsigned* p)              { return __hip_atomic_load(p, __ATOMIC_RELAXED, __HIP_MEMORY_SCOPE_AGENT); }
__device__ __forceinline__ unsigned xb_add(unsigned* p, unsigned v) { return __hip_atomic_fetch_add(p, v, __ATOMIC_RELAXED, __HIP_MEMORY_SCOPE_AGENT); }
__device__ __forceinline__ unsigned xb_xcc_id() { return (unsigned)__builtin_amdgcn_s_getreg((3 << 11) | 20) & 0xFu; }
#define XB_SPIN(cond, bar) do { unsigned _sp = 0; while (cond) { __builtin_amdgcn_s_sleep(1); \
    if ((++_sp & 255u) == 0u) { if (xb_ld(&(bar)[XB_TMO])) break; if (_sp > XB_SPIN_CAP) { atomicAdd(&(bar)[XB_TMO], 1u); break; } } } } while (0)

struct XcdBarrier {
    unsigned* bar; unsigned x;
    volatile LAS unsigned* st;
};

__device__ __forceinline__ XcdBarrier xcd_barrier_post(unsigned* bar, volatile LAS unsigned* st) {
    XcdBarrier b; b.bar = bar; b.x = xb_xcc_id(); b.st = st;
    if (threadIdx.x == 0) (void)xb_add(&bar[XB_XCNT(b.x)], 1u);
    return b;
}
__device__ __forceinline__ void xcd_barrier_complete(unsigned* bar, unsigned x, unsigned& nloc, unsigned& nx) {
    const unsigned G = gridDim.x * gridDim.y * gridDim.z;
    unsigned sum, cnt, mine, sp = 0u;
    for (;;) {
        sum = 0u; cnt = 0u; mine = 0u;
#pragma unroll
        for (unsigned j = 0; j < 16; ++j) { const unsigned c = xb_ld(&bar[XB_XCNT(j)]); sum += c; cnt += (c > 0u) ? 1u : 0u; mine = (j == x) ? c : mine; }
        if (sum == G) break;
        __builtin_amdgcn_s_sleep(1);
        if ((++sp & 255u) == 0u) { if (xb_ld(&bar[XB_TMO])) break; if (sp > XB_SPIN_CAP) { atomicAdd(&bar[XB_TMO], 1u); break; } }
    }
    nloc = mine > 0u ? mine : 1u; nx = cnt > 0u ? cnt : 1u;
}

__device__ __forceinline__ void xcd_barrier(const XcdBarrier& b) {
    asm volatile("s_waitcnt vmcnt(0)" ::: "memory");
    __syncthreads();
    if (threadIdx.x == 0) {
        unsigned* bar = b.bar;
        __builtin_amdgcn_s_waitcnt(0);
        unsigned nloc = b.st[0], nx = b.st[1];
        if (nloc == 0u) { xcd_barrier_complete(bar, b.x, nloc, nx); b.st[0] = nloc; b.st[1] = nx; }
        const unsigned old = xb_add(&bar[XB_XSUB(b.x)], 1u);
        const unsigned gen = old / nloc;
        if (old + 1u == (gen + 1u) * nloc) {
            __builtin_amdgcn_fence(__ATOMIC_RELEASE, "agent");
            asm volatile("s_waitcnt vmcnt(0)" ::: "memory");
            const unsigned og = xb_add(&bar[XB_TOP], 1u);
            const unsigned tg = og / nx;
            if (og + 1u == (tg + 1u) * nx) xb_add(&bar[XB_TOPGEN], 1u);
            else XB_SPIN(xb_ld(&bar[XB_TOPGEN]) == tg, bar);
            __builtin_amdgcn_fence(__ATOMIC_ACQUIRE, "agent");
            xb_add(&bar[XB_XGEN(b.x)], 1u);
            asm volatile("s_waitcnt vmcnt(0)" ::: "memory");
        } else {
            XB_SPIN(xb_ld(&bar[XB_XGEN(b.x)]) == gen, bar);
            __builtin_amdgcn_fence(__ATOMIC_ACQUIRE, "agent");
            asm volatile("s_waitcnt vmcnt(0)" ::: "memory");
        }
    }
    __syncthreads();
}

struct Ctx {
    LAS unsigned char* lds; int tid, lane, wave, G, bid; unsigned char* ws; float* out;
};

template <int MAP>
__device__ __forceinline__ void wconv_item(const float* W, int ldw, const float* W2, int K, bf16* WT, LAS float* scr, int item, int nblk, int lane, int layer) {
    const int kb = item / nblk, nb = item % nblk, k0 = 64 * kb, n0 = 32 * nb;
    const int n = n0 + (lane & 31);
    const float* src = nullptr; int ld = ldw;
    if (MAP == 0) src = W + n;
    else if (MAP == 1) { const int s = win_src(n, layer); if (s >= 0) src = W + s; else if (s <= -2) { src = W2 + (-2 - s); ld = 64; } }
    else { const int tl = n >> 8, j = n & 255; src = W + (j < 128 ? tl * 128 + j : DFF + tl * 128 + (j - 128)); }
#pragma unroll 8
    for (int i = 0; i < 32; ++i) { const int kk = 2 * i + (lane >> 5); scr[kk * 33 + (lane & 31)] = src ? src[(size_t)(k0 + kk) * ld] : 0.f; }
    LDS_WAIT(); asm volatile("" ::: "memory");
    const int c = lane & 7;
#pragma unroll
    for (int j = 0; j < 4; ++j) { const int nn = (lane >> 3) + 8 * j; const LAS float* s = scr + (8 * c) * 33 + nn;
        u32x4 o; o.x = pk2(s[0 * 33], s[1 * 33]); o.y = pk2(s[2 * 33], s[3 * 33]); o.z = pk2(s[4 * 33], s[5 * 33]); o.w = pk2(s[6 * 33], s[7 * 33]);
        *(u32x4*)(WT + (size_t)(n0 + nn) * K + k0 + 8 * c) = o; }
    LDS_WAIT(); asm volatile("" ::: "memory");
}
struct WSrc { const float *w_in, *w_vres, *w_out, *w_gu, *w_dn, *wlb, *alb, *glb, *vlb; };
__device__ __forceinline__ void phase_wconv(const Ctx& C, int layer, const WSrc& W) {
    LAS float* scr = (LAS float*)(C.lds + C.wave * 16384);
    const int gw = C.bid * NWAVES + C.wave, NGW = C.G * NWAVES;
    const float* w_in = W.w_in + (size_t)layer * DM * N_IN; const float* w_vres = W.w_vres;
    const float* w_out = W.w_out + (size_t)layer * DM * DM; const float* w_gu = W.w_gu + (size_t)layer * DM * 2 * DFF; const float* w_dn = W.w_dn + (size_t)layer * DFF * DM;
    constexpr int I_IN = (DM / 64) * (N_INP / 32), I_OUT = (DM / 64) * (DM / 32), I_GU = (DM / 64) * (2 * DFF / 32), I_DN = (DFF / 64) * (DM / 32);
    for (int it = gw; it < I_IN + I_OUT + I_GU + I_DN; it += NGW) {
        int r = it;
        if (r < I_IN) { wconv_item<1>(w_in, N_IN, w_vres, DM, (bf16*)(C.ws + WS_WIN), scr, r, N_INP / 32, C.lane, layer); continue; } r -= I_IN;
        if (r < I_OUT) { wconv_item<0>(w_out, DM, nullptr, DM, (bf16*)(C.ws + WS_WOUT), scr, r, DM / 32, C.lane, layer); continue; } r -= I_OUT;
        if (r < I_GU) { wconv_item<2>(w_gu, 2 * DFF, nullptr, DM, (bf16*)(C.ws + WS_WGU), scr, r, 2 * DFF / 32, C.lane, layer); continue; } r -= I_GU;
        wconv_item<0>(w_dn, DM, nullptr, DFF, (bf16*)(C.ws + WS_WDN), scr, r, DM / 32, C.lane, layer);
    }
    const int gt = C.bid * NTHR + C.tid, NGT = C.G * NTHR;
    const float* wlb = W.wlb + (size_t)layer * 96 * 512; const float* alb = W.alb + (size_t)layer * 96 * 512; const float* glb = W.glb + (size_t)layer * 256 * 512;
    const float* vlb = W.vlb;
    bf16* LW = (bf16*)(C.ws + WS_LORA + LO_W); bf16* LA = (bf16*)(C.ws + WS_LORA + LO_A); bf16* LV = (bf16*)(C.ws + WS_LORA + LO_V); bf16* LG = (bf16*)(C.ws + WS_LORA + LO_G);
    for (int i = gt; i < 512 * 96; i += NGT) { const int n = i / 96, k = i % 96; LW[i] = (bf16)f2bf(wlb[k * 512 + n]); LA[i] = (bf16)f2bf(alb[k * 512 + n]); }
    for (int i = gt; i < 512 * 64; i += NGT) { const int n = i / 64, k = i % 64; LV[i] = (bf16)f2bf(layer > 0 ? vlb[k * 512 + n] : 0.f); }
    for (int i = gt; i < 512 * 256; i += NGT) { const int n = i / 256, k = i % 256; LG[i] = (bf16)f2bf(glb[k * 512 + n]); }
    if (layer == 0) {
        float2* TA = (float2*)(C.ws + WS_TAB + TAB_A); float2* TI = (float2*)(C.ws + WS_TAB + TAB_I); float2* TR = (float2*)(C.ws + WS_TAB + TAB_R);
        const float l2a = 18.931568569324174f  , l2r = 13.287712379549449f  ;
        for (int i = gt; i < T * 56; i += NGT) {
            const int pos = i / 56, j = i % 56; float fr; float2* dst;
            if (j < 16) { fr = exp2f(-(float)j * (1.0f / 16.0f) * l2a); dst = TA + pos * 16 + j; }
            else if (j < 24) { fr = exp2f(-(float)(j - 16) * (1.0f / 8.0f) * l2a); dst = TI + pos * 8 + (j - 16); }
            else { fr = exp2f(-(float)(j - 24) * (1.0f / 32.0f) * l2r); dst = TR + pos * 32 + (j - 24); }
            const float ang = (float)pos * fr; *dst = make_float2(cosf(ang), sinf(ang));
        }
    }
}
__device__ __forceinline__ void phase_norm_bf16(const Ctx& C, const float* x, const float* g, bf16* out) {
    const int gw = C.bid * NWAVES + C.wave, NGW = C.G * NWAVES;
    f32x4 gv[8];
#pragma unroll
    for (int j = 0; j < 8; ++j) gv[j] = *(const f32x4*)(g + 4 * (C.lane + 64 * j));
    for (int m = gw; m < M; m += NGW) {
        const f32x4* xr = (const f32x4*)(x + (size_t)m * DM) + C.lane; f32x4 v[8]; float s = 0.f;
#pragma unroll
        for (int j = 0; j < 8; ++j) { v[j] = xr[64 * j]; s += (v[j].x * v[j].x + v[j].y * v[j].y) + (v[j].z * v[j].z + v[j].w * v[j].w); }
        const float rs = rsqrtf(wave_sum(s) * (1.0f / DM) + 1e-5f);
        u32x2* o = (u32x2*)(out + (size_t)m * DM) + C.lane;
#pragma unroll
        for (int j = 0; j < 8; ++j) { u32x2 w; w.x = pk2(v[j].x * rs * gv[j].x, v[j].y * rs * gv[j].y); w.y = pk2(v[j].z * rs * gv[j].z, v[j].w * rs * gv[j].w); o[64 * j] = w; }
    }
}
__device__ __forceinline__ void phase_final_norm(const Ctx& C, float* x, const float* g) {
    const int gw = C.bid * NWAVES + C.wave, NGW = C.G * NWAVES;
    f32x4 gv[8];
#pragma unroll
    for (int j = 0; j < 8; ++j) gv[j] = *(const f32x4*)(g + 4 * (C.lane + 64 * j));
    for (int m = gw; m < M; m += NGW) {
        f32x4* xr = (f32x4*)(x + (size_t)m * DM) + C.lane; f32x4 v[8]; float s = 0.f;
#pragma unroll
        for (int j = 0; j < 8; ++j) { v[j] = xr[64 * j]; s += (v[j].x * v[j].x + v[j].y * v[j].y) + (v[j].z * v[j].z + v[j].w * v[j].w); }
        const float rs = rsqrtf(wave_sum(s) * (1.0f / DM) + 1e-5f);
#pragma unroll
        for (int j = 0; j < 8; ++j) xr[64 * j] = v[j] * rs * gv[j];
    }
}
__device__ __forceinline__ void phase_prep_a(const Ctx& C) {
    const long gt = (long)C.bid * NTHR + C.tid, NGT = (long)C.G * NTHR;
    for (int cfg = 0; cfg < 6; ++cfg) {
        size_t off; int ld, nh, hd, half; size_t tab;
        if (cfg == 0) { off = WS_Q; ld = 1024; nh = 8; hd = 128; half = 16; tab = TAB_A; }
        else if (cfg == 1) { off = WS_K; ld = 1024; nh = 8; hd = 128; half = 16; tab = TAB_A; }
        else if (cfg == 2) { off = WS_QI; ld = 1024; nh = 16; hd = 64; half = 8; tab = TAB_I; }
        else if (cfg == 3) { off = WS_KW; ld = 256; nh = 1; hd = 64; half = 8; tab = TAB_I; }
        else if (cfg == 4) { off = WS_BQ; ld = 256; nh = 4; hd = 64; half = 32; tab = TAB_R; }
        else { off = WS_BK; ld = 256; nh = 4; hd = 64; half = 32; tab = TAB_R; }
        bf16* buf = (bf16*)(C.ws + off); const float2* tb = (const float2*)(C.ws + WS_TAB + tab);
        const int cpp = half >> 3; const long total = (long)M * nh * cpp;
        for (long it = gt; it < total; it += NGT) {
            const int c = (int)(it % cpp); const long r2 = it / cpp; const int h = (int)(r2 % nh); const int row = (int)(r2 / nh); const int pos = row & (T - 1);
            bf16* p1 = buf + (size_t)row * ld + h * hd + 8 * c; bf16* p2 = p1 + half;
            const u32x4 a = *(const u32x4*)p1, b = *(const u32x4*)p2; const float2* tp = tb + (size_t)pos * half + 8 * c;
            float x1[8], x2[8];
#pragma unroll
            for (int e = 0; e < 4; ++e) { x1[2 * e] = bflo(a[e]); x1[2 * e + 1] = bfhi(a[e]); x2[2 * e] = bflo(b[e]); x2[2 * e + 1] = bfhi(b[e]); }
            u32x4 oa, ob;
#pragma unroll
            for (int e = 0; e < 4; ++e) {
                const float2 t0 = tp[2 * e], t1 = tp[2 * e + 1];
                oa[e] = pk2(x1[2 * e] * t0.x - x2[2 * e] * t0.y, x1[2 * e + 1] * t1.x - x2[2 * e + 1] * t1.y);
                ob[e] = pk2(x2[2 * e] * t0.x + x1[2 * e] * t0.y, x2[2 * e + 1] * t1.x + x1[2 * e + 1] * t1.y);
            }
            *(u32x4*)p1 = oa; *(u32x4*)p2 = ob;
        }
    }
    {
        LAS unsigned short* scr = (LAS unsigned short*)(C.lds + C.wave * 8704);
        const bf16* V = (const bf16*)(C.ws + WS_V); bf16* Vt = (bf16*)(C.ws + WS_VT);
        const int gw = C.bid * NWAVES + C.wave, NGW = C.G * NWAVES;
        for (int it = gw; it < NB * 128 * 16; it += NGW) {
            const int ct = it & 15, tt = (it >> 4) & 127, b = it >> 11;
            const int t0 = tt * 64, c0 = ct * 64;
#pragma unroll 4
            for (int i = 0; i < 32; ++i) { const int tr = 2 * i + (C.lane >> 5), cc = 2 * (C.lane & 31);
                const unsigned w = *(const unsigned*)(V + (size_t)(b * T + t0 + tr) * 1024 + c0 + cc); scr[tr * 66 + cc] = (unsigned short)(w & 0xffffu); scr[tr * 66 + cc + 1] = (unsigned short)(w >> 16); }
            LDS_WAIT(); asm volatile("" ::: "memory");
#pragma unroll 4
            for (int i = 0; i < 32; ++i) { const int cr = 2 * i + (C.lane >> 5), tp = 2 * (C.lane & 31);
                const unsigned w = (unsigned)scr[tp * 66 + cr] | ((unsigned)scr[(tp + 1) * 66 + cr] << 16);
                *(unsigned*)(Vt + ((size_t)b * 1024 + c0 + cr) * T + t0 + tp) = w; }
            LDS_WAIT(); asm volatile("" ::: "memory");
        }
    }
}
__device__ __forceinline__ void phase_indexer(const Ctx& C) {
    LAS unsigned short* sc = (LAS unsigned short*)C.lds;
    LAS unsigned* hist = (LAS unsigned*)(C.lds + 131072) + C.wave * 256;
    const bf16* QI = (const bf16*)(C.ws + WS_QI); const bf16* KW = (const bf16*)(C.ws + WS_KW); u64* MASK = (u64*)(C.ws + WS_MASK);
    const int lane = C.lane, r32 = lane & 31, hi = lane >> 5;
    for (int it = C.bid; it < NB * (T / 8); it += C.G) {
        const int b = it & 3, qg = it >> 2, q0 = qg * 8, qchunk = q0 >> 6, nadm = 64 * (qchunk + 1);
        const int qrow = b * T + q0 + C.wave;
        if (qchunk < 4) {
            MASK[(size_t)qrow * 128 + lane] = lane <= qchunk ? ~0ull : 0ull; MASK[(size_t)qrow * 128 + 64 + lane] = 0ull;
            continue;
        }
        bf16x8 af[4][4]; float wv[4][16];
        {
            const int qq = (r32 >> 2) & 1, hh = (r32 & 3) + 4 * (r32 >> 3);
#pragma unroll
            for (int pr = 0; pr < 4; ++pr) {
                const bf16* qp = QI + (size_t)(b * T + q0 + 2 * pr + qq) * 1024 + hh * 64 + 8 * hi;
#pragma unroll
                for (int kk = 0; kk < 4; ++kk) af[pr][kk] = *(const bf16x8*)(qp + 16 * kk);
                const bf16* wp = KW + (size_t)(b * T + q0 + 2 * pr + hi) * 256 + 64;
                const u32x4 w0 = *(const u32x4*)wp, w1 = *(const u32x4*)(wp + 8);
#pragma unroll
                for (int e = 0; e < 4; ++e) { wv[pr][2 * e] = bflo(w0[e]) * 0.03125f; wv[pr][2 * e + 1] = bfhi(w0[e]) * 0.03125f; wv[pr][8 + 2 * e] = bflo(w1[e]) * 0.03125f; wv[pr][8 + 2 * e + 1] = bfhi(w1[e]) * 0.03125f; }
            }
        }
        for (int tile = C.wave; tile < nadm / 32; tile += NWAVES) {
            const int key0 = 32 * tile;
            const bf16* kp = KW + (size_t)(b * T + key0 + r32) * 256 + 8 * hi;
            bf16x8 bfr[4];
#pragma unroll
            for (int kk = 0; kk < 4; ++kk) bfr[kk] = *(const bf16x8*)(kp + 16 * kk);
#pragma unroll
            for (int pr = 0; pr < 4; ++pr) {
                f32x16 d = {0.f, 0.f, 0.f, 0.f, 0.f, 0.f, 0.f, 0.f, 0.f, 0.f, 0.f, 0.f, 0.f, 0.f, 0.f, 0.f};
#pragma unroll
                for (int kk = 0; kk < 4; ++kk) d = __builtin_amdgcn_mfma_f32_32x32x16_bf16(af[pr][kk], bfr[kk], d, 0, 0, 0);
                float s = 0.f;
#pragma unroll
                for (int r = 0; r < 16; ++r) s += fmaxf(d[r], 0.f) * wv[pr][r];
                const unsigned short hb = __half_as_ushort(__float2half_rn(s));
                const unsigned short key = (hb & 0x8000u) ? (unsigned short)~hb : (unsigned short)(hb | 0x8000u);
                sc[(2 * pr + hi) * 8192 + key0 + r32] = key;
            }
        }
        __syncthreads();
        const LAS unsigned short* my = sc + C.wave * 8192;
        unsigned thr = 0;
        {
            unsigned want = 256u, prefix = 0u;
#pragma unroll 1
            for (int lvl = 0; lvl < 2; ++lvl) {
                hist[lane] = 0u; hist[64 + lane] = 0u; hist[128 + lane] = 0u; hist[192 + lane] = 0u;
                LDS_WAIT(); asm volatile("" ::: "memory");
                for (int i = 0; i < nadm / 64; ++i) { const unsigned k = my[64 * i + lane];
                    if (lvl == 0) atomicAdd((unsigned*)&hist[k >> 8], 1u); else if ((k >> 8) == prefix) atomicAdd((unsigned*)&hist[k & 255u], 1u); }
                LDS_WAIT(); asm volatile("" ::: "memory");
                const unsigned c0 = hist[4 * lane], c1 = hist[4 * lane + 1], c2 = hist[4 * lane + 2], c3 = hist[4 * lane + 3];
                const unsigned tl = c0 + c1 + c2 + c3; unsigned inc = tl;
#pragma unroll
                for (int o = 1; o < 64; o <<= 1) { const unsigned v = __shfl_down(inc, o); if (lane + o < 64) inc += v; }
                const unsigned ab3 = inc - tl, ab2 = ab3 + c3, ab1 = ab2 + c2, ab0 = ab1 + c1;
                int selb = -1; unsigned rem = 0;
                if (ab3 < want && ab3 + c3 >= want) { selb = 3; rem = want - ab3; }
                else if (ab2 < want && ab2 + c2 >= want) { selb = 2; rem = want - ab2; }
                else if (ab1 < want && ab1 + c1 >= want) { selb = 1; rem = want - ab1; }
                else if (ab0 < want && ab0 + c0 >= want) { selb = 0; rem = want - ab0; }
                const u64 bal = __ballot(selb >= 0); const int src = bal ? (int)__ffsll((long long)bal) - 1 : 0;
                const unsigned bin = (unsigned)__shfl(4 * lane + (selb < 0 ? 0 : selb), src); want = (unsigned)__shfl((int)rem, src);
                if (lvl == 0) prefix = bin; else thr = (prefix << 8) | bin;
                LDS_WAIT(); asm volatile("" ::: "memory");
            }
        }
        u64 w0 = 0, w1 = 0;
        for (int i = 0; i < nadm / 64; ++i) { const unsigned k = my[64 * i + lane]; const u64 bal = __ballot(k >= thr);
            if (i < 64) { if (lane == i) w0 = bal; } else { if (lane == i - 64) w1 = bal; } }
        MASK[(size_t)qrow * 128 + lane] = w0; MASK[(size_t)qrow * 128 + 64 + lane] = w1;
        __syncthreads();
    }
}
constexpr int AT_KROW = 272, AT_VROW = 136, AT_KB = 64 * AT_KROW, AT_VB = 128 * AT_VROW, AT_BUF = AT_KB + AT_VB;
__device__ __forceinline__ void attn_unit(const Ctx& C, int b, int head, int qb) {
    const bf16* Q = (const bf16*)(C.ws + WS_Q); const bf16* K = (const bf16*)(C.ws + WS_K); const bf16* Vt = (const bf16*)(C.ws + WS_VT);
    const u64* MASK = (const u64*)(C.ws + WS_MASK); bf16* CAT = (bf16*)(C.ws + WS_CAT);
    const int tid = C.tid, lane = C.lane, wid = C.wave, r32 = lane & 31, hi = lane >> 5;
    const int q = 256 * qb + 32 * wid + r32; const size_t row = (size_t)b * T + q;
    const int nt = 4 * qb + 4, myc = 4 * qb + (wid >> 1);
    bf16x8 qf[8];
#pragma unroll
    for (int d0 = 0; d0 < 8; ++d0) qf[d0] = *(const bf16x8*)(Q + row * 1024 + head * 128 + 16 * d0 + 8 * hi);
    const bf16* kg[2]; const bf16* vg[2]; int kl[2], vl[2];
#pragma unroll
    for (int i = 0; i < 2; ++i) { const int c = tid + 512 * i;
        kg[i] = K + ((size_t)b * T + (c >> 4)) * 1024 + head * 128 + (c & 15) * 8; kl[i] = (c >> 4) * AT_KROW + (c & 15) * 16;
        vg[i] = Vt + ((size_t)(b * 8 + head) * 128 + (c >> 3)) * T + (c & 7) * 8; vl[i] = AT_KB + (c >> 3) * AT_VROW + (c & 7) * 16; }
    u32x4 kr[2], vr[2];
#pragma unroll
    for (int i = 0; i < 2; ++i) { kr[i] = *(const u32x4*)kg[i]; vr[i] = *(const u32x4*)vg[i]; }
#pragma unroll
    for (int i = 0; i < 2; ++i) { *(LAS u32x4*)(C.lds + kl[i]) = kr[i]; *(LAS u32x2*)(C.lds + vl[i]) = (u32x2){vr[i].x, vr[i].y}; *(LAS u32x2*)(C.lds + vl[i] + 8) = (u32x2){vr[i].z, vr[i].w}; }
    __syncthreads();
    float mrun = -1e30f, lrun = 0.f; f32x16 o[4];
#pragma unroll
    for (int db = 0; db < 4; ++db)
#pragma unroll
        for (int r = 0; r < 16; ++r) o[db][r] = 0.f;
    const float SC = 0.08838834764831845f * 1.4426950408889634f;
    for (int t = 0; t < nt; ++t) {
        const int cur = (t & 1) * AT_BUF, nxt = ((t + 1) & 1) * AT_BUF;
        if (t + 1 < nt) {
#pragma unroll
            for (int i = 0; i < 2; ++i) { kr[i] = *(const u32x4*)(kg[i] + (size_t)(t + 1) * 64 * 1024); vr[i] = *(const u32x4*)(vg[i] + (t + 1) * 64); }
        }
        if (t <= myc) {
            const u64 mw = MASK[row * 128 + t];
            const LAS unsigned char* Ks = C.lds + cur; const LAS unsigned char* Vs = C.lds + cur + AT_KB;
            f32x16 p0, p1;
#pragma unroll
            for (int r = 0; r < 16; ++r) { p0[r] = 0.f; p1[r] = 0.f; }
#pragma unroll
            for (int d0 = 0; d0 < 8; ++d0) {
                const bf16x8 k0 = *(const LAS bf16x8*)(Ks + r32 * AT_KROW + (16 * d0 + 8 * hi) * 2);
                const bf16x8 k1 = *(const LAS bf16x8*)(Ks + (32 + r32) * AT_KROW + (16 * d0 + 8 * hi) * 2);
                p0 = __builtin_amdgcn_mfma_f32_32x32x16_bf16(k0, qf[d0], p0, 0, 0, 0);
                p1 = __builtin_amdgcn_mfma_f32_32x32x16_bf16(k1, qf[d0], p1, 0, 0, 0);
            }
            const unsigned mlo = (unsigned)mw >> (4 * hi), mhi = (unsigned)(mw >> 32) >> (4 * hi);
            float rm = -1e30f;
#pragma unroll
            for (int r = 0; r < 16; ++r) { const int c = (r & 3) + 8 * (r >> 2);
                p0[r] = ((mlo >> c) & 1u) ? p0[r] * SC : -1e30f; p1[r] = ((mhi >> c) & 1u) ? p1[r] * SC : -1e30f;
                rm = fmaxf(rm, fmaxf(p0[r], p1[r])); }
            rm = fmaxf(rm, __shfl_xor(rm, 32));
            const float mnew = fmaxf(mrun, rm);
            if (__any(mnew > mrun)) {
                const float f = __builtin_amdgcn_exp2f(mrun - mnew); lrun *= f;
#pragma unroll
                for (int db = 0; db < 4; ++db)
#pragma unroll
                    for (int r = 0; r < 16; ++r) o[db][r] *= f;
            }
            mrun = mnew;
            float ls = 0.f;
#pragma unroll
            for (int r = 0; r < 16; ++r) { const int c = (r & 3) + 8 * (r >> 2);
                p0[r] = ((mlo >> c) & 1u) ? __builtin_amdgcn_exp2f(p0[r] - mrun) : 0.f; p1[r] = ((mhi >> c) & 1u) ? __builtin_amdgcn_exp2f(p1[r] - mrun) : 0.f;
                ls += p0[r] + p1[r]; }
            lrun += ls;
            bf16x8 pb[4];
#pragma unroll
            for (int kk = 0; kk < 4; ++kk) { u32x4 w;
#pragma unroll
                for (int e = 0; e < 4; ++e) { const int r = 8 * (kk & 1) + 2 * e; w[e] = (kk < 2) ? pk2(p0[r], p0[r + 1]) : pk2(p1[r], p1[r + 1]); }
                pb[kk] = __builtin_bit_cast(bf16x8, w); }
#pragma unroll
            for (int db = 0; db < 4; ++db)
#pragma unroll
                for (int kk = 0; kk < 4; ++kk) {
                    const LAS unsigned char* vp = Vs + (32 * db + r32) * AT_VROW + (16 * kk + 4 * hi) * 2;
                    const u32x2 a0 = *(const LAS u32x2*)vp, a1 = *(const LAS u32x2*)(vp + 16);
                    const u32x4 w = {a0.x, a0.y, a1.x, a1.y};
                    o[db] = __builtin_amdgcn_mfma_f32_32x32x16_bf16(__builtin_bit_cast(bf16x8, w), pb[kk], o[db], 0, 0, 0);
                }
        }
        if (t + 1 < nt) {
#pragma unroll
            for (int i = 0; i < 2; ++i) { *(LAS u32x4*)(C.lds + nxt + kl[i]) = kr[i]; *(LAS u32x2*)(C.lds + nxt + vl[i]) = (u32x2){vr[i].x, vr[i].y}; *(LAS u32x2*)(C.lds + nxt + vl[i] + 8) = (u32x2){vr[i].z, vr[i].w}; }
        }
        __syncthreads();
    }
    lrun += __shfl_xor(lrun, 32);
    const float inv = 1.0f / lrun;
    bf16* op = CAT + row * 2048 + head * 128 + 4 * hi;
#pragma unroll
    for (int db = 0; db < 4; ++db)
#pragma unroll
        for (int g = 0; g < 4; ++g) { u32x2 w; w.x = pk2(o[db][4 * g] * inv, o[db][4 * g + 1] * inv); w.y = pk2(o[db][4 * g + 2] * inv, o[db][4 * g + 3] * inv);
            *(u32x2*)(op + 32 * db + 8 * g) = w; }
}
__device__ __forceinline__ void phase_attn(const Ctx& C) {
    for (int i = C.bid; i < 1024; i += C.G) {
        const int w = i & 255, k = i >> 8, combo = w >> 3, j = w & 7;
        const int qb = k == 0 ? j : k == 1 ? 15 - j : k == 2 ? 16 + j : 31 - j;
        attn_unit(C, combo >> 3, combo & 7, qb);
        __syncthreads();
    }
}
__device__ __forceinline__ float ret_logg(int h) { return log1pf(-exp2f(-5.0f - (float)h)); }
constexpr int RT_KS = 68;
__device__ __forceinline__ void phase_ret1(const Ctx& C) {
    LAS float* Ks = (LAS float*)C.lds;
    LAS float* Vs = (LAS float*)(C.lds + 64 * RT_KS * 4);
    const bf16* BK = (const bf16*)(C.ws + WS_BK); const bf16* BV = (const bf16*)(C.ws + WS_BV); float* KV = (float*)(C.ws + WS_KVST);
    const int tid = C.tid;
    for (int u = C.bid; u < NB * 128 * 4; u += C.G) {
        const int h = u & 3, c = (u >> 2) & 127, b = u >> 9; const size_t row0 = (size_t)b * T + 64 * c; const float lg = ret_logg(h);
        { const int m = tid >> 3, d8 = (tid & 7) * 8; const u32x4 w = *(const u32x4*)(BK + (row0 + m) * 256 + h * 64 + d8); const float z = __expf((63.0f - (float)m) * lg) * 0.125f;
#pragma unroll
          for (int e = 0; e < 4; ++e) { Ks[m * RT_KS + d8 + 2 * e] = bflo(w[e]) * z; Ks[m * RT_KS + d8 + 2 * e + 1] = bfhi(w[e]) * z; } }
#pragma unroll
        for (int i = 0; i < 2; ++i) { const int cidx = tid + 512 * i, m = cidx >> 4, e8 = (cidx & 15) * 8; const u32x4 w = *(const u32x4*)(BV + (row0 + m) * 512 + h * 128 + e8);
#pragma unroll
          for (int e = 0; e < 4; ++e) { Vs[m * 128 + e8 + 2 * e] = bflo(w[e]); Vs[m * 128 + e8 + 2 * e + 1] = bfhi(w[e]); } }
        __syncthreads();
        const int d = tid & 63, eg = tid >> 6; float acc[16];
#pragma unroll
        for (int e = 0; e < 16; ++e) acc[e] = 0.f;
        for (int m = 0; m < 64; ++m) { const float kv = Ks[m * RT_KS + d];
#pragma unroll
            for (int e4 = 0; e4 < 4; ++e4) { const f32x4 v = *(const LAS f32x4*)(Vs + m * 128 + 16 * eg + 4 * e4); acc[4 * e4] += kv * v.x; acc[4 * e4 + 1] += kv * v.y; acc[4 * e4 + 2] += kv * v.z; acc[4 * e4 + 3] += kv * v.w; } }
        float* dst = KV + (size_t)u * 8192 + d * 128 + 16 * eg;
#pragma unroll
        for (int e4 = 0; e4 < 4; ++e4) *(f32x4*)(dst + 4 * e4) = (f32x4){acc[4 * e4], acc[4 * e4 + 1], acc[4 * e4 + 2], acc[4 * e4 + 3]};
        __syncthreads();
    }
}
__device__ __forceinline__ void phase_ret2(const Ctx& C) {
    float* KV = (float*)(C.ws + WS_KVST);
    for (int g = C.bid * NTHR + C.tid; g < NB * 4 * 8192; g += C.G * NTHR) {
        const int el = g & 8191, h = (g >> 13) & 3, b = g >> 15; const float gc = __expf(64.0f * ret_logg(h));
        float* p = KV + ((size_t)b * 512 + h) * 8192 + el;
        float st = 0.f;
        for (int c0 = 0; c0 < 128; c0 += 8) { float x[8];
#pragma unroll
            for (int i = 0; i < 8; ++i) x[i] = p[(size_t)(c0 + i) * 4 * 8192];
#pragma unroll
            for (int i = 0; i < 8; ++i) { p[(size_t)(c0 + i) * 4 * 8192] = st; st = st * gc + x[i]; } }
    }
}
__device__ __forceinline__ void phase_ret3(const Ctx& C) {
    LAS float* Qs = (LAS float*)C.lds;
    LAS float* Ks = Qs + 64 * RT_KS;
    LAS float* Sc = Ks + 64 * RT_KS;
    LAS float* Vs = Sc + 64 * RT_KS;
    LAS float* Ps = Vs + 64 * 128;
    const bf16* BQ = (const bf16*)(C.ws + WS_BQ); const bf16* BK = (const bf16*)(C.ws + WS_BK); const bf16* BV = (const bf16*)(C.ws + WS_BV); const bf16* BG = (const bf16*)(C.ws + WS_BG);
    const float* KV = (const float*)(C.ws + WS_KVST); bf16* CAT = (bf16*)(C.ws + WS_CAT);
    const int tid = C.tid;
    for (int u = C.bid; u < NB * 128 * 4; u += C.G) {
        const int h = u & 3, c = (u >> 2) & 127, b = u >> 9; const size_t row0 = (size_t)b * T + 64 * c; const float lg = ret_logg(h);
        { const int m = tid >> 3, d8 = (tid & 7) * 8; const u32x4 wq = *(const u32x4*)(BQ + (row0 + m) * 256 + h * 64 + d8), wk = *(const u32x4*)(BK + (row0 + m) * 256 + h * 64 + d8);
#pragma unroll
          for (int e = 0; e < 4; ++e) { Qs[m * RT_KS + d8 + 2 * e] = bflo(wq[e]); Qs[m * RT_KS + d8 + 2 * e + 1] = bfhi(wq[e]); Ks[m * RT_KS + d8 + 2 * e] = bflo(wk[e]) * 0.125f; Ks[m * RT_KS + d8 + 2 * e + 1] = bfhi(wk[e]) * 0.125f; } }
#pragma unroll
        for (int i = 0; i < 2; ++i) { const int cidx = tid + 512 * i, m = cidx >> 4, e8 = (cidx & 15) * 8; const u32x4 w = *(const u32x4*)(BV + (row0 + m) * 512 + h * 128 + e8);
#pragma unroll
          for (int e = 0; e < 4; ++e) { Vs[m * 128 + e8 + 2 * e] = bflo(w[e]); Vs[m * 128 + e8 + 2 * e + 1] = bfhi(w[e]); } }
#pragma unroll
        for (int i = 0; i < 4; ++i) { const int cidx = tid + 512 * i; *(LAS f32x4*)(Ps + 4 * cidx) = *(const f32x4*)(KV + (size_t)u * 8192 + 4 * cidx); }
        __syncthreads();
        {
            const int n = tid >> 3, mg = tid & 7; float s[8];
#pragma unroll
            for (int j = 0; j < 8; ++j) s[j] = 0.f;
            for (int d4 = 0; d4 < 16; ++d4) { const f32x4 qv = *(const LAS f32x4*)(Qs + n * RT_KS + 4 * d4);
#pragma unroll
                for (int j = 0; j < 8; ++j) { const f32x4 kv = *(const LAS f32x4*)(Ks + (mg + 8 * j) * RT_KS + 4 * d4); s[j] += (qv.x * kv.x + qv.y * kv.y) + (qv.z * kv.z + qv.w * kv.w); } }
#pragma unroll
            for (int j = 0; j < 8; ++j) { const int m = mg + 8 * j; Sc[n * RT_KS + m] = (m <= n) ? s[j] * __expf((float)(n - m) * lg) : 0.f; }
        }
        __syncthreads();
        {
            const int n = tid >> 3, eg = tid & 7; float acc[16], cr[16];
#pragma unroll
            for (int e = 0; e < 16; ++e) { acc[e] = 0.f; cr[e] = 0.f; }
            for (int m = 0; m <= n; ++m) { const float sv = Sc[n * RT_KS + m];
#pragma unroll
                for (int e4 = 0; e4 < 4; ++e4) { const f32x4 v = *(const LAS f32x4*)(Vs + m * 128 + 16 * eg + 4 * e4); acc[4 * e4] += sv * v.x; acc[4 * e4 + 1] += sv * v.y; acc[4 * e4 + 2] += sv * v.z; acc[4 * e4 + 3] += sv * v.w; } }
            for (int d = 0; d < 64; ++d) { const float qv = Qs[n * RT_KS + d];
#pragma unroll
                for (int e4 = 0; e4 < 4; ++e4) { const f32x4 v = *(const LAS f32x4*)(Ps + d * 128 + 16 * eg + 4 * e4); cr[4 * e4] += qv * v.x; cr[4 * e4 + 1] += qv * v.y; cr[4 * e4 + 2] += qv * v.z; cr[4 * e4 + 3] += qv * v.w; } }
            const float xi = __expf((float)(n + 1) * lg); float sum = 0.f;
#pragma unroll
            for (int e = 0; e < 16; ++e) { acc[e] += xi * cr[e]; sum += acc[e]; }
            sum += __shfl_xor(sum, 1); sum += __shfl_xor(sum, 2); sum += __shfl_xor(sum, 4);
            const float mu = sum * (1.0f / 128.0f); float var = 0.f;
#pragma unroll
            for (int e = 0; e < 16; ++e) { const float dlt = acc[e] - mu; var += dlt * dlt; }
            var += __shfl_xor(var, 1); var += __shfl_xor(var, 2); var += __shfl_xor(var, 4);
            const float rstd = rsqrtf(var * (1.0f / 128.0f) + 1e-5f);
            const bf16* gp = BG + (row0 + n) * 512 + h * 128 + 16 * eg; const u32x4 g0 = *(const u32x4*)gp, g1 = *(const u32x4*)(gp + 8);
            float gv[16];
#pragma unroll
            for (int e = 0; e < 4; ++e) { gv[2 * e] = bflo(g0[e]); gv[2 * e + 1] = bfhi(g0[e]); gv[8 + 2 * e] = bflo(g1[e]); gv[8 + 2 * e + 1] = bfhi(g1[e]); }
            float ov[16];
#pragma unroll
            for (int e = 0; e < 16; ++e) { const float gg = gv[e]; const float sl = gg * __builtin_amdgcn_rcpf(1.0f + __expf(-gg)); ov[e] = (acc[e] - mu) * rstd * sl; }
            bf16* op = CAT + (row0 + n) * 2048 + 1024 + h * 128 + 16 * eg;
            u32x4 w0, w1;
#pragma unroll
            for (int e = 0; e < 4; ++e) { w0[e] = pk2(ov[2 * e], ov[2 * e + 1]); w1[e] = pk2(ov[8 + 2 * e], ov[8 + 2 * e + 1]); }
            *(u32x4*)op = w0; *(u32x4*)(op + 8) = w1;
        }
        __syncthreads();
    }
}
__device__ __forceinline__ float sigmoidf_(float x) { return __builtin_amdgcn_rcpf(1.0f + __expf(-x)); }
constexpr int RW_AW = 104, RW_AV = 72, RW_AG = 264;
__device__ __forceinline__ void ld4bf(const bf16* p, float (&v)[4]) { const u32x2 w = *(const u32x2*)p; v[0] = bflo(w.x); v[1] = bfhi(w.x); v[2] = bflo(w.y); v[3] = bfhi(w.y); }
__device__ __forceinline__ void shift4(const bf16* buf, size_t m, int ld, int c4, bool first, const float* mu, float (&o)[4]) {
    float cur[4], prv[4] = {0.f, 0.f, 0.f, 0.f}; ld4bf(buf + m * ld + c4, cur); if (!first) ld4bf(buf + (m - 1) * ld + c4, prv);
    const f32x4 muv = *(const f32x4*)mu;
#pragma unroll
    for (int e = 0; e < 4; ++e) o[e] = cur[e] + (prv[e] - cur[e]) * muv[e];
}
struct RwP { const float *mu, *mu_v, *w0, *a0, *v0, *k_k, *k_a, *r_k, *lnx_g, *lnx_b; };
__device__ __forceinline__ void phase_rw1(const Ctx& C, int layer, const RwP& P) {
    LAS bf16* AW = (LAS bf16*)C.lds; LAS bf16* AA = AW + 32 * RW_AW; LAS bf16* AV = AA + 32 * RW_AW;
    const bf16* CR = (const bf16*)(C.ws + WS_CR); const bf16* CK = (const bf16*)(C.ws + WS_CK); const bf16* CV = (const bf16*)(C.ws + WS_CV); const bf16* CL = (const bf16*)(C.ws + WS_CL);
    const bf16* LW = (const bf16*)(C.ws + WS_LORA + LO_W); const bf16* LA = (const bf16*)(C.ws + WS_LORA + LO_A); const bf16* LV = (const bf16*)(C.ws + WS_LORA + LO_V);
    bf16* VF = (bf16*)(C.ws + WS_VFIRST);
    float* RR = (float*)(C.ws + WS_RR); float* RWd = (float*)(C.ws + WS_RW); float* RKH = (float*)(C.ws + WS_RKH); float* RV = (float*)(C.ws + WS_RV); float* RA = (float*)(C.ws + WS_RA); float* RB = (float*)(C.ws + WS_RB);
    const float* mu = P.mu + (size_t)layer * 1984; const float* mu_v = P.mu_v;
    const float* w0 = P.w0 + layer * 512; const float* a0 = P.a0 + layer * 512; const float* v0 = P.v0; const float* k_k = P.k_k + layer * 512; const float* k_a = P.k_a + layer * 512;
    const int tid = C.tid, lane = C.lane, wid = C.wave;
    for (int u = C.bid; u < M / 32; u += C.G) {
        int r32 = lane & 31, hi = lane >> 5; asm volatile("" : "+v"(r32), "+v"(hi));
        const size_t m0 = (size_t)u * 32;
        for (int idx = tid; idx < 32 * 256; idx += NTHR) {
            const int tok = idx >> 8, c = idx & 255; const size_t m = m0 + tok; const bool first = (m & (T - 1)) == 0;
            const float cur = bf2f(CL[m * 256 + c]); const float prv = first ? 0.f : bf2f(CL[(m - 1) * 256 + c]);
            const float muc = c < 192 ? mu[1536 + c] : (layer > 0 ? mu_v[c - 192] : 0.f);
            const float xs = cur + (prv - cur) * muc;
            if (c < 96) AW[tok * RW_AW + c] = (bf16)f2bf(tanhf(xs)); else if (c < 192) AA[tok * RW_AW + (c - 96)] = (bf16)f2bf(xs); else AV[tok * RW_AV + (c - 192)] = (bf16)f2bf(xs);
        }
        __syncthreads();
        const size_t m = m0 + r32; const bool first = (m & (T - 1)) == 0;
        float ksv[32]; float ss = 0.f;
#pragma unroll
        for (int cb = 0; cb < 2; ++cb)
#pragma unroll
            for (int g = 0; g < 4; ++g) { const int c4 = 64 * wid + 32 * cb + 8 * g + 4 * hi; float ks[4]; shift4(CK, m, 512, c4, first, mu + 512 + c4, ks); const f32x4 kkv = *(const f32x4*)(k_k + c4);
#pragma unroll
                for (int e = 0; e < 4; ++e) { ksv[16 * cb + 4 * g + e] = ks[e]; const float kr = ks[e] * kkv[e]; ss += kr * kr; } }
        ss += __shfl_xor(ss, 32);
        const float inv = 1.0f / fmaxf(sqrtf(ss), 1e-12f);
#pragma unroll
        for (int cb = 0; cb < 2; ++cb) {
            f32x16 dw, da, dv;
#pragma unroll
            for (int r = 0; r < 16; ++r) { dw[r] = 0.f; da[r] = 0.f; dv[r] = 0.f; }
            const int ch = 64 * wid + 32 * cb + r32;
#pragma unroll
            for (int kk = 0; kk < 6; ++kk) {
                const bf16x8 aw = *(const bf16x8*)(LW + ch * 96 + 16 * kk + 8 * hi), aa = *(const bf16x8*)(LA + ch * 96 + 16 * kk + 8 * hi);
                const bf16x8 bw = *(const LAS bf16x8*)(AW + r32 * RW_AW + 16 * kk + 8 * hi), ba = *(const LAS bf16x8*)(AA + r32 * RW_AW + 16 * kk + 8 * hi);
                dw = __builtin_amdgcn_mfma_f32_32x32x16_bf16(aw, bw, dw, 0, 0, 0); da = __builtin_amdgcn_mfma_f32_32x32x16_bf16(aa, ba, da, 0, 0, 0);
            }
            if (layer > 0) {
#pragma unroll
                for (int kk = 0; kk < 4; ++kk) {
                    const bf16x8 av = *(const bf16x8*)(LV + ch * 64 + 16 * kk + 8 * hi); const bf16x8 bv = *(const LAS bf16x8*)(AV + r32 * RW_AV + 16 * kk + 8 * hi);
                    dv = __builtin_amdgcn_mfma_f32_32x32x16_bf16(av, bv, dv, 0, 0, 0);
                }
            }
#pragma unroll
            for (int g = 0; g < 4; ++g) {
                const int c4 = 64 * wid + 32 * cb + 8 * g + 4 * hi;
                float rs[4], vs[4];
                shift4(CR, m, 512, c4, first, mu + c4, rs); shift4(CV, m, 512, c4, first, mu + 1024 + c4, vs);
                const f32x4 w0v = *(const f32x4*)(w0 + c4), a0v = *(const f32x4*)(a0 + c4), kkv = *(const f32x4*)(k_k + c4), kav = *(const f32x4*)(k_a + c4);
                f32x4 vo, wo, kho, ao, bo;
                if (layer > 0) { float vf[4]; ld4bf(VF + m * 512 + c4, vf); const f32x4 v0v = *(const f32x4*)(v0 + c4);
#pragma unroll
                    for (int e = 0; e < 4; ++e) vo[e] = vs[e] + (vf[e] - vs[e]) * sigmoidf_(v0v[e] + dv[4 * g + e]); }
                else { u32x2 w; w.x = pk2(vs[0], vs[1]); w.y = pk2(vs[2], vs[3]); *(u32x2*)(VF + m * 512 + c4) = w;
#pragma unroll
                    for (int e = 0; e < 4; ++e) vo[e] = vs[e]; }
#pragma unroll
                for (int e = 0; e < 4; ++e) {
                    const float x = w0v[e] + dw[4 * g + e];
                    const float z = -x; const float sp = fmaxf(z, 0.f) + log1pf(__expf(-fabsf(z)));
                    wo[e] = __expf(-__expf(-sp - 0.5f));
                    const float a = sigmoidf_(a0v[e] + da[4 * g + e]);
                    const float ksx = ksv[16 * cb + 4 * g + e]; const float kk = ksx * kkv[e] * inv;
                    kho[e] = ksx * (1.0f + (a - 1.0f) * kav[e]); ao[e] = -kk; bo[e] = kk * a;
                }
                *(f32x4*)(RR + m * 512 + c4) = (f32x4){rs[0], rs[1], rs[2], rs[3]}; *(f32x4*)(RWd + m * 512 + c4) = wo; *(f32x4*)(RKH + m * 512 + c4) = kho; *(f32x4*)(RV + m * 512 + c4) = vo;
                *(f32x4*)(RA + m * 512 + c4) = ao; *(f32x4*)(RB + m * 512 + c4) = bo;
            }
        }
        __syncthreads();
    }
}
constexpr int RW_L = 128, RW_NC = T / RW_L;
constexpr int RW_TB = 8, RW_STG = 6 * RW_TB * 64;
__device__ __forceinline__ float xhalf_sum(float x) { const auto rr = __builtin_amdgcn_permlane32_swap(__float_as_uint(x), __float_as_uint(x), false, false); return __uint_as_float(rr[0]) + __uint_as_float(rr[1]); }
template <int NS, bool OUT>
__device__ __forceinline__ void rwkv_chunk(f32x16 (&D)[NS][2][2], LAS float* stg, const float* RWd, const float* RA, const float* RB, const float* RKH, const float* RV, const float* RR, float* Y, size_t base0, int nsteps, int lane) {
    const int r32 = lane & 31, hi = lane >> 5;
    for (int t0 = 0; t0 < nsteps; t0 += RW_TB) {
        {
            float tw[RW_TB], ta[RW_TB], tr[RW_TB], tb[RW_TB], tk[RW_TB], tv[RW_TB];
#pragma unroll
            for (int s = 0; s < RW_TB; ++s) { const size_t o = base0 + (size_t)(t0 + s) * 512 + lane; tw[s] = RWd[o]; ta[s] = RA[o]; tr[s] = OUT ? RR[o] : 0.f; tb[s] = RB[o]; tk[s] = RKH[o]; tv[s] = RV[o]; }
#pragma unroll
            for (int s = 0; s < RW_TB; ++s) { stg[(0 * RW_TB + s) * 64 + lane] = tw[s]; stg[(1 * RW_TB + s) * 64 + lane] = ta[s]; if (OUT) stg[(2 * RW_TB + s) * 64 + lane] = tr[s];
                stg[(3 * RW_TB + s) * 64 + lane] = tb[s]; stg[(4 * RW_TB + s) * 64 + lane] = tk[s]; stg[(5 * RW_TB + s) * 64 + lane] = tv[s]; }
        }
        LDS_WAIT(); asm volatile("" ::: "memory");
#pragma unroll 1
        for (int s = 0; s < RW_TB; ++s) {
            const LAS float* sw = stg + (0 * RW_TB + s) * 64 + 4 * hi; const LAS float* sa_ = stg + (1 * RW_TB + s) * 64 + 4 * hi; const LAS float* sr = stg + (2 * RW_TB + s) * 64 + 4 * hi;
            const LAS float* sbk = stg + ((hi ? 4 : 3) * RW_TB + s) * 64 + r32; const LAS float* sv = stg + (5 * RW_TB + s) * 64 + r32;
            const float bk0 = sbk[0], bk1 = sbk[32], v0 = sv[0], v1 = sv[32];
            float sav[NS][2];
            {
                f32x4 av[2][4];
#pragma unroll
                for (int jb = 0; jb < 2; ++jb)
#pragma unroll
                    for (int g = 0; g < 4; ++g) av[jb][g] = *(const LAS f32x4*)(sa_ + 32 * jb + 8 * g);
#pragma unroll
                for (int st = 0; st < NS; ++st)
#pragma unroll
                    for (int ib = 0; ib < 2; ++ib) { float p0 = 0.f, p1 = 0.f;
#pragma unroll
                        for (int jb = 0; jb < 2; ++jb)
#pragma unroll
                            for (int g = 0; g < 4; ++g) { const f32x16& d = D[st][jb][ib]; p0 += d[4 * g] * av[jb][g].x; p1 += d[4 * g + 1] * av[jb][g].y; p0 += d[4 * g + 2] * av[jb][g].z; p1 += d[4 * g + 3] * av[jb][g].w; }
                        sav[st][ib] = xhalf_sum(p0 + p1); }
            }
            {
                f32x4 wv[2][4];
#pragma unroll
                for (int jb = 0; jb < 2; ++jb)
#pragma unroll
                    for (int g = 0; g < 4; ++g) wv[jb][g] = *(const LAS f32x4*)(sw + 32 * jb + 8 * g);
#pragma unroll
                for (int st = 0; st < NS; ++st)
#pragma unroll
                    for (int jb = 0; jb < 2; ++jb)
#pragma unroll
                        for (int ib = 0; ib < 2; ++ib)
#pragma unroll
                            for (int g = 0; g < 4; ++g) { f32x16& d = D[st][jb][ib]; d[4 * g] *= wv[jb][g].x; d[4 * g + 1] *= wv[jb][g].y; d[4 * g + 2] *= wv[jb][g].z; d[4 * g + 3] *= wv[jb][g].w; }
            }
#pragma unroll
            for (int st = 0; st < NS; ++st) {
                const bool inject = (NS == 1) || (st == 1);
#pragma unroll
                for (int jb = 0; jb < 2; ++jb) { const float bkj = jb == 0 ? bk0 : bk1; const float A = inject ? bkj : (hi ? 0.f : bkj);
#pragma unroll
                    for (int ib = 0; ib < 2; ++ib) { const float B = hi ? (ib == 0 ? v0 : v1) : sav[st][ib];
                        D[st][jb][ib] = __builtin_amdgcn_mfma_f32_32x32x2f32(A, B, D[st][jb][ib], 0, 0, 0); } }
            }
            if (OUT) {
                f32x4 rv[2][4];
#pragma unroll
                for (int jb = 0; jb < 2; ++jb)
#pragma unroll
                    for (int g = 0; g < 4; ++g) rv[jb][g] = *(const LAS f32x4*)(sr + 32 * jb + 8 * g);
#pragma unroll
                for (int ib = 0; ib < 2; ++ib) { float p0 = 0.f, p1 = 0.f;
#pragma unroll
                    for (int jb = 0; jb < 2; ++jb)
#pragma unroll
                        for (int g = 0; g < 4; ++g) { const f32x16& d = D[NS - 1][jb][ib]; p0 += d[4 * g] * rv[jb][g].x; p1 += d[4 * g + 1] * rv[jb][g].y; p0 += d[4 * g + 2] * rv[jb][g].z; p1 += d[4 * g + 3] * rv[jb][g].w; }
                    const float y = xhalf_sum(p0 + p1);
                    if (hi == 0) Y[base0 + (size_t)(t0 + s) * 512 + 32 * ib + r32] = y; }
            }
        }
        LDS_WAIT(); asm volatile("" ::: "memory");
    }
}
__device__ __forceinline__ void phase_rw2(const Ctx& C) {
    const float* RWd = (const float*)(C.ws + WS_RW); const float* RA = (const float*)(C.ws + WS_RA); const float* RB = (const float*)(C.ws + WS_RB); const float* RKH = (const float*)(C.ws + WS_RKH); const float* RV = (const float*)(C.ws + WS_RV);
    float* PHI = (float*)(C.ws + WS_PHI); float* PSI = (float*)(C.ws + WS_PSI);
    LAS float* stg = (LAS float*)C.lds + C.wave * RW_STG;
    const int ntask = NB * 8 * RW_NC, r32 = C.lane & 31, hi = C.lane >> 5;
    for (int task = C.wave * C.G + C.bid; task < ntask; task += C.G * NWAVES) {
        const int ck = task % RW_NC, bh = task / RW_NC, h = bh & 7, b = bh >> 3;
        const size_t base0 = ((size_t)b * T + (size_t)ck * RW_L) * 512 + h * 64;
        f32x16 D[2][2][2];
#pragma unroll
        for (int jb = 0; jb < 2; ++jb)
#pragma unroll
            for (int ib = 0; ib < 2; ++ib)
#pragma unroll
                for (int r = 0; r < 16; ++r) { D[0][jb][ib][r] = (jb == ib && ((r & 3) + 8 * (r >> 2) + 4 * hi) == r32) ? 1.f : 0.f; D[1][jb][ib][r] = 0.f; }
        rwkv_chunk<2, false>(D, stg, RWd, RA, RB, RKH, RV, nullptr, nullptr, base0, RW_L, C.lane);
#pragma unroll
        for (int st = 0; st < 2; ++st) { float* dst = (st == 0 ? PHI : PSI) + (size_t)task * 4096;
#pragma unroll
            for (int jb = 0; jb < 2; ++jb)
#pragma unroll
                for (int ib = 0; ib < 2; ++ib)
#pragma unroll
                    for (int g = 0; g < 4; ++g) *(f32x4*)(dst + (32 * ib + r32) * 64 + 32 * jb + 8 * g + 4 * hi) = (f32x4){D[st][jb][ib][4 * g], D[st][jb][ib][4 * g + 1], D[st][jb][ib][4 * g + 2], D[st][jb][ib][4 * g + 3]}; }
    }
}
constexpr int R3_P = 65;
__device__ __forceinline__ void phase_rw3(const Ctx& C) {
    const float* PHI = (const float*)(C.ws + WS_PHI); const float* PSI = (const float*)(C.ws + WS_PSI); float* SST = (float*)(C.ws + WS_SST);
    const int half = C.wave >> 2, w4 = C.wave & 3, ibo = w4 >> 1, kb = w4 & 1, r32 = C.lane & 31, hi = C.lane >> 5;
    LAS float* Sl = (LAS float*)C.lds + half * (2 * 64 * R3_P);
    for (int pr = C.bid; pr < NB * 8 / 2; pr += C.G) {
        const int bh = 2 * pr + half;
        f32x16 acc;
#pragma unroll
        for (int r = 0; r < 16; ++r) acc[r] = 0.f;
        for (int ck = 0; ck < RW_NC; ++ck) {
            const size_t task = (size_t)bh * RW_NC + ck; LAS float* Sb = Sl + (ck & 1) * (64 * R3_P);
            float* dst = SST + task * 4096;
#pragma unroll
            for (int r = 0; r < 16; ++r) { const int i = 32 * ibo + (r & 3) + 8 * (r >> 2) + 4 * hi; dst[i * 64 + 32 * kb + r32] = acc[r]; Sb[i * R3_P + 32 * kb + r32] = acc[r]; }
            if (ck + 1 == RW_NC) break;
            float ph[32];
#pragma unroll
            for (int s = 0; s < 32; ++s) ph[s] = PHI[task * 4096 + (2 * s + hi) * 64 + 32 * kb + r32];
#pragma unroll
            for (int r = 0; r < 16; ++r) { const int i = 32 * ibo + (r & 3) + 8 * (r >> 2) + 4 * hi; acc[r] = PSI[task * 4096 + i * 64 + 32 * kb + r32]; }
            __syncthreads();
#pragma unroll
            for (int s = 0; s < 32; ++s) { const float a = Sb[(32 * ibo + r32) * R3_P + 2 * s + hi]; acc = __builtin_amdgcn_mfma_f32_32x32x2f32(a, ph[s], acc, 0, 0, 0); }
        }
        __syncthreads();
    }
}
__device__ __forceinline__ void phase_rw4(const Ctx& C) {
    const float* RWd = (const float*)(C.ws + WS_RW); const float* RA = (const float*)(C.ws + WS_RA); const float* RB = (const float*)(C.ws + WS_RB); const float* RKH = (const float*)(C.ws + WS_RKH); const float* RV = (const float*)(C.ws + WS_RV); const float* RR = (const float*)(C.ws + WS_RR);
    const float* SST = (const float*)(C.ws + WS_SST); float* Y = (float*)(C.ws + WS_Y);
    LAS float* stg = (LAS float*)C.lds + C.wave * RW_STG;
    const int ntask = NB * 8 * RW_NC, r32 = C.lane & 31, hi = C.lane >> 5;
    for (int task = C.wave * C.G + C.bid; task < ntask; task += C.G * NWAVES) {
        const int ck = task % RW_NC, bh = task / RW_NC, h = bh & 7, b = bh >> 3;
        const size_t base0 = ((size_t)b * T + (size_t)ck * RW_L) * 512 + h * 64;
        f32x16 D[1][2][2]; const float* src = SST + (size_t)task * 4096;
#pragma unroll
        for (int jb = 0; jb < 2; ++jb)
#pragma unroll
            for (int ib = 0; ib < 2; ++ib)
#pragma unroll
                for (int g = 0; g < 4; ++g) { const f32x4 v = *(const f32x4*)(src + (32 * ib + r32) * 64 + 32 * jb + 8 * g + 4 * hi); D[0][jb][ib][4 * g] = v.x; D[0][jb][ib][4 * g + 1] = v.y; D[0][jb][ib][4 * g + 2] = v.z; D[0][jb][ib][4 * g + 3] = v.w; }
        rwkv_chunk<1, true>(D, stg, RWd, RA, RB, RKH, RV, RR, Y, base0, RW_L, C.lane);
    }
}
__device__ __forceinline__ void phase_rw5(const Ctx& C, int layer, const RwP& P) {
    LAS bf16* AG = (LAS bf16*)C.lds;
    const bf16* CG = (const bf16*)(C.ws + WS_CG); const bf16* LG = (const bf16*)(C.ws + WS_LORA + LO_G);
    const float* Y = (const float*)(C.ws + WS_Y); const float* RR = (const float*)(C.ws + WS_RR); const float* RKH = (const float*)(C.ws + WS_RKH); const float* RV = (const float*)(C.ws + WS_RV);
    bf16* CAT = (bf16*)(C.ws + WS_CAT);
    const float* mu = P.mu + (size_t)layer * 1984 + 1728; const float* r_k = P.r_k + layer * 512; const float* lnx_g = P.lnx_g + layer * 512; const float* lnx_b = P.lnx_b + layer * 512;
    const int tid = C.tid, lane = C.lane, wid = C.wave;
    for (int u = C.bid; u < M / 32; u += C.G) {
        int r32 = lane & 31, hi = lane >> 5; asm volatile("" : "+v"(r32), "+v"(hi));
        const size_t m0 = (size_t)u * 32;
        for (int idx = tid; idx < 32 * 256; idx += NTHR) {
            const int tok = idx >> 8, c = idx & 255; const size_t m = m0 + tok; const bool first = (m & (T - 1)) == 0;
            const float cur = bf2f(CG[m * 256 + c]); const float prv = first ? 0.f : bf2f(CG[(m - 1) * 256 + c]);
            AG[tok * RW_AG + c] = (bf16)f2bf(sigmoidf_(cur + (prv - cur) * mu[c]));
        }
        __syncthreads();
        f32x16 dg[2];
#pragma unroll
        for (int cb = 0; cb < 2; ++cb) {
#pragma unroll
            for (int r = 0; r < 16; ++r) dg[cb][r] = 0.f;
            const int ch = 64 * wid + 32 * cb + r32;
#pragma unroll
            for (int kk = 0; kk < 16; ++kk) {
                const bf16x8 ag = *(const bf16x8*)(LG + ch * 256 + 16 * kk + 8 * hi); const bf16x8 bg = *(const LAS bf16x8*)(AG + r32 * RW_AG + 16 * kk + 8 * hi);
                dg[cb] = __builtin_amdgcn_mfma_f32_32x32x16_bf16(ag, bg, dg[cb], 0, 0, 0);
            }
        }
        const size_t m = m0 + r32;
        float yv[32], vv[32]; float sy = 0.f, sb = 0.f;
#pragma unroll
        for (int cb = 0; cb < 2; ++cb)
#pragma unroll
            for (int g = 0; g < 4; ++g) { const int c4 = 64 * wid + 32 * cb + 8 * g + 4 * hi;
                const f32x4 y4 = *(const f32x4*)(Y + m * 512 + c4), r4 = *(const f32x4*)(RR + m * 512 + c4), k4 = *(const f32x4*)(RKH + m * 512 + c4), v4 = *(const f32x4*)(RV + m * 512 + c4), rk4 = *(const f32x4*)(r_k + c4);
#pragma unroll
                for (int e = 0; e < 4; ++e) { yv[16 * cb + 4 * g + e] = y4[e]; vv[16 * cb + 4 * g + e] = v4[e]; sy += y4[e]; sb += r4[e] * k4[e] * rk4[e]; } }
        sy += __shfl_xor(sy, 32); sb += __shfl_xor(sb, 32);
        const float mean = sy * (1.0f / 64.0f); float var = 0.f;
#pragma unroll
        for (int i = 0; i < 32; ++i) { const float d = yv[i] - mean; var += d * d; }
        var += __shfl_xor(var, 32);
        const float rstd = rsqrtf(var * (1.0f / 64.0f) + 64e-5f);
#pragma unroll
        for (int cb = 0; cb < 2; ++cb)
#pragma unroll
            for (int g = 0; g < 4; ++g) { const int c4 = 64 * wid + 32 * cb + 8 * g + 4 * hi;
                const f32x4 lg4 = *(const f32x4*)(lnx_g + c4), lb4 = *(const f32x4*)(lnx_b + c4); float o[4];
#pragma unroll
                for (int e = 0; e < 4; ++e) { const int i = 16 * cb + 4 * g + e; o[e] = ((yv[i] - mean) * rstd * lg4[e] + lb4[e] + sb * vv[i]) * dg[cb][4 * g + e]; }
                u32x2 w; w.x = pk2(o[0], o[1]); w.y = pk2(o[2], o[3]); *(u32x2*)(CAT + m * 2048 + 1536 + c4) = w; }
        __syncthreads();
    }
}
__device__ __forceinline__ void* launder_ptr(const void* p) {
    unsigned lo = (unsigned)(uintptr_t)p, hi = (unsigned)((uintptr_t)p >> 32); asm volatile("" : "+v"(lo), "+v"(hi));
    lo = __builtin_amdgcn_readfirstlane(lo); hi = __builtin_amdgcn_readfirstlane(hi); return (void*)(((uintptr_t)hi << 32) | lo);
}
#ifndef MK_PER_PHASE
#define MK_PER_PHASE 0
#endif
constexpr int PH_PER_LAYER = 17, N_PHASES = DEPTH * PH_PER_LAYER + 1;
struct Args { const float* in[23]; float* out; unsigned char* ws; int ph_lo, ph_hi; };
__global__ void __launch_bounds__(NTHR, 2) fwd_kernel(Args args) {
    extern __shared__ __attribute__((aligned(16))) unsigned char lds_raw[];
    Ctx C;
    C.lds = (LAS unsigned char*)lds_raw; C.tid = threadIdx.x; C.lane = C.tid & 63; C.wave = __builtin_amdgcn_readfirstlane(C.tid >> 6);
    C.G = gridDim.x; C.bid = blockIdx.x;
    const CAS Args* KA = (const CAS Args*)launder_ptr((const void*)(uintptr_t)__builtin_amdgcn_kernarg_segment_ptr());
    C.ws = KA->ws; C.out = KA->out;
    volatile LAS unsigned* MISC = (volatile LAS unsigned*)(C.lds + MISC_OFF);
    if (C.tid < 32) MISC[C.tid] = 0u;
    __syncthreads();
    unsigned* ctl = (unsigned*)(C.ws + WS_CTL);
    XcdBarrier bar; bar.bar = ctl + CW_BAR; bar.x = 0; bar.st = nullptr;
    if (!MK_PER_PHASE) bar = xcd_barrier_post(ctl + CW_BAR, MISC + 8);
    const int lo = KA->ph_lo, hi = KA->ph_hi;
#define FRESH() do { KA = (const CAS Args*)launder_ptr((const void*)(uintptr_t)__builtin_amdgcn_kernarg_segment_ptr()); C.ws = KA->ws; C.out = KA->out; ctl = (unsigned*)(C.ws + WS_CTL); asm volatile("" : "+v"(C.tid)); C.lane = C.tid & 63; C.wave = __builtin_amdgcn_readfirstlane(C.tid >> 6); C.lds = (LAS unsigned char*)lds_raw; } while (0)
#ifndef REP_MASK
#define REP_MASK 0u
#endif
#ifndef ONLY_PH
#define ONLY_PH -1
#endif
#ifndef PH_MASK
#define PH_MASK 0xFFFFFFFFu
#endif
#define IN(k) (lo <= (k) && (k) < hi && (ONLY_PH < 0 || ((k) % PH_PER_LAYER) == ONLY_PH) && ((PH_MASK >> ((k) % PH_PER_LAYER)) & 1u))
#define SEAM(k) do { if (IN(k) && IN((k) + 1)) { bar.bar = ctl + CW_BAR; xcd_barrier(bar); } } while (0)
    for (int layer = 0; layer < DEPTH; ++layer) {
        const int p0 = layer * PH_PER_LAYER;
        const float* xin = layer == 0 ? KA->in[0] : C.out;
        FRESH(); if (IN(p0 + 0)) { { { const WSrc W{KA->in[2], KA->in[3], KA->in[18], KA->in[20], KA->in[21], KA->in[7], KA->in[9], KA->in[12], KA->in[11]}; phase_wconv(C, layer, W); } phase_norm_bf16(C, xin, KA->in[1] + layer * DM, (bf16*)(C.ws + WS_H)); }
            if ((REP_MASK >> 0) & 1u) { xcd_barrier(bar); FRESH(); { { const WSrc W{KA->in[2], KA->in[3], KA->in[18], KA->in[20], KA->in[21], KA->in[7], KA->in[9], KA->in[12], KA->in[11]}; phase_wconv(C, layer, W); } phase_norm_bf16(C, xin, KA->in[1] + layer * DM, (bf16*)(C.ws + WS_H)); } } }
        SEAM(p0 + 0);
        FRESH(); if (IN(p0 + 1)) { { pg8::Gemm g{(const pg8::bf16_t*)(C.ws + WS_H), (const pg8::bf16_t*)(C.ws + WS_WIN), M, N_INP, DM}; pg8::StaticOrder S; S.init(M, N_INP, C.G, C.bid);
            pg8::EpiProj E{C.ws}; pg8::gemm_phase<pg8::EpiProj, pg8::StaticOrder, true, true>(C.lds, g, S, E); }
            if ((REP_MASK >> 1) & 1u) { xcd_barrier(bar); FRESH(); { pg8::Gemm g{(const pg8::bf16_t*)(C.ws + WS_H), (const pg8::bf16_t*)(C.ws + WS_WIN), M, N_INP, DM}; pg8::StaticOrder S; S.init(M, N_INP, C.G, C.bid);
            pg8::EpiProj E{C.ws}; pg8::gemm_phase<pg8::EpiProj, pg8::StaticOrder, true, true>(C.lds, g, S, E); } } }
        SEAM(p0 + 1);
        FRESH(); if (IN(p0 + 2)) { phase_prep_a(C);
            if ((REP_MASK >> 2) & 1u) { xcd_barrier(bar); FRESH(); phase_prep_a(C); } }
        SEAM(p0 + 2);
        FRESH(); if (IN(p0 + 3)) { phase_indexer(C);
            if ((REP_MASK >> 3) & 1u) { xcd_barrier(bar); FRESH(); phase_indexer(C); } }
        SEAM(p0 + 3);
        FRESH(); if (IN(p0 + 4)) { phase_attn(C);
            if ((REP_MASK >> 4) & 1u) { xcd_barrier(bar); FRESH(); phase_attn(C); } }
        SEAM(p0 + 4);
        FRESH(); if (IN(p0 + 5)) { phase_ret1(C);
            if ((REP_MASK >> 5) & 1u) { xcd_barrier(bar); FRESH(); phase_ret1(C); } }
        SEAM(p0 + 5);
        FRESH(); if (IN(p0 + 6)) { phase_ret2(C);
            if ((REP_MASK >> 6) & 1u) { xcd_barrier(bar); FRESH(); phase_ret2(C); } }
        SEAM(p0 + 6);
        FRESH(); if (IN(p0 + 7)) { phase_ret3(C);
            if ((REP_MASK >> 7) & 1u) { xcd_barrier(bar); FRESH(); phase_ret3(C); } }
        SEAM(p0 + 7);
        FRESH(); if (IN(p0 + 8)) { { const RwP P{KA->in[4], KA->in[5], KA->in[6], KA->in[8], KA->in[10], KA->in[13], KA->in[14], KA->in[15], KA->in[16], KA->in[17]}; phase_rw1(C, layer, P); }
            if ((REP_MASK >> 8) & 1u) { xcd_barrier(bar); FRESH(); { const RwP P{KA->in[4], KA->in[5], KA->in[6], KA->in[8], KA->in[10], KA->in[13], KA->in[14], KA->in[15], KA->in[16], KA->in[17]}; phase_rw1(C, layer, P); } } }
        SEAM(p0 + 8);
        FRESH(); if (IN(p0 + 9)) { phase_rw2(C);
            if ((REP_MASK >> 9) & 1u) { xcd_barrier(bar); FRESH(); phase_rw2(C); } }
        SEAM(p0 + 9);
        FRESH(); if (IN(p0 + 10)) { phase_rw3(C);
            if ((REP_MASK >> 10) & 1u) { xcd_barrier(bar); FRESH(); phase_rw3(C); } }
        SEAM(p0 + 10);
        FRESH(); if (IN(p0 + 11)) { phase_rw4(C);
            if ((REP_MASK >> 11) & 1u) { xcd_barrier(bar); FRESH(); phase_rw4(C); } }
        SEAM(p0 + 11);
        FRESH(); if (IN(p0 + 12)) { { const RwP P{KA->in[4], KA->in[5], KA->in[6], KA->in[8], KA->in[10], KA->in[13], KA->in[14], KA->in[15], KA->in[16], KA->in[17]}; phase_rw5(C, layer, P); }
            if ((REP_MASK >> 12) & 1u) { xcd_barrier(bar); FRESH(); { const RwP P{KA->in[4], KA->in[5], KA->in[6], KA->in[8], KA->in[10], KA->in[13], KA->in[14], KA->in[15], KA->in[16], KA->in[17]}; phase_rw5(C, layer, P); } } }
        SEAM(p0 + 12);
        FRESH(); if (IN(p0 + 13)) { { pg8::Gemm g{(const pg8::bf16_t*)(C.ws + WS_CAT), (const pg8::bf16_t*)(C.ws + WS_WOUT), M, DM, DM}; pg8::StaticOrder S; S.init(M, DM, C.G, C.bid);
            pg8::EpiResid E{xin, C.out, DM}; pg8::gemm_phase<pg8::EpiResid, pg8::StaticOrder, true, true>(C.lds, g, S, E); }
            if ((REP_MASK >> 13) & 1u) { xcd_barrier(bar); FRESH(); { pg8::Gemm g{(const pg8::bf16_t*)(C.ws + WS_CAT), (const pg8::bf16_t*)(C.ws + WS_WOUT), M, DM, DM}; pg8::StaticOrder S; S.init(M, DM, C.G, C.bid);
            pg8::EpiResid E{xin, C.out, DM}; pg8::gemm_phase<pg8::EpiResid, pg8::StaticOrder, true, true>(C.lds, g, S, E); } } }
        SEAM(p0 + 13);
        FRESH(); if (IN(p0 + 14)) { phase_norm_bf16(C, C.out, KA->in[19] + layer * DM, (bf16*)(C.ws + WS_H2));
            if ((REP_MASK >> 14) & 1u) { xcd_barrier(bar); FRESH(); phase_norm_bf16(C, C.out, KA->in[19] + layer * DM, (bf16*)(C.ws + WS_H2)); } }
        SEAM(p0 + 14);
        FRESH(); if (IN(p0 + 15)) { { pg8::Gemm g{(const pg8::bf16_t*)(C.ws + WS_H2), (const pg8::bf16_t*)(C.ws + WS_WGU), M, 2 * DFF, DM}; pg8::StaticOrder S; S.init(M, 2 * DFF, C.G, C.bid);
            pg8::EpiSwiGLU E{(pg8::bf16_t*)(C.ws + WS_ACT), DFF}; pg8::gemm_phase<pg8::EpiSwiGLU, pg8::StaticOrder, true, true>(C.lds, g, S, E); }
            if ((REP_MASK >> 15) & 1u) { xcd_barrier(bar); FRESH(); { pg8::Gemm g{(const pg8::bf16_t*)(C.ws + WS_H2), (const pg8::bf16_t*)(C.ws + WS_WGU), M, 2 * DFF, DM}; pg8::StaticOrder S; S.init(M, 2 * DFF, C.G, C.bid);
            pg8::EpiSwiGLU E{(pg8::bf16_t*)(C.ws + WS_ACT), DFF}; pg8::gemm_phase<pg8::EpiSwiGLU, pg8::StaticOrder, true, true>(C.lds, g, S, E); } } }
        SEAM(p0 + 15);
        FRESH(); if (IN(p0 + 16)) { { pg8::Gemm g{(const pg8::bf16_t*)(C.ws + WS_ACT), (const pg8::bf16_t*)(C.ws + WS_WDN), M, DM, DFF}; pg8::StaticOrder S; S.init(M, DM, C.G, C.bid);
            pg8::EpiResid E{C.out, C.out, DM}; pg8::gemm_phase<pg8::EpiResid, pg8::StaticOrder, true, true>(C.lds, g, S, E); }
            if ((REP_MASK >> 16) & 1u) { xcd_barrier(bar); FRESH(); { pg8::Gemm g{(const pg8::bf16_t*)(C.ws + WS_ACT), (const pg8::bf16_t*)(C.ws + WS_WDN), M, DM, DFF}; pg8::StaticOrder S; S.init(M, DM, C.G, C.bid);
            pg8::EpiResid E{C.out, C.out, DM}; pg8::gemm_phase<pg8::EpiResid, pg8::StaticOrder, true, true>(C.lds, g, S, E); } } }
        SEAM(p0 + 16);
    }
    if (IN(N_PHASES - 1)) phase_final_norm(C, C.out, KA->in[22]);
#undef IN
#undef SEAM
}

extern "C" void kernel_launch(void* const* d_in, const int* in_sizes, int n_in, void* d_out, int out_size, void* d_ws, size_t ws_size, hipStream_t stream) {
    static int grid = 0;
    if (grid == 0) {
        if (n_in != 23 || out_size != M * DM || ws_size < WS_NEED) { fprintf(stderr, "kernel_launch: unexpected problem (n_in %d, out %d, ws %zu); nothing launched\n", n_in, out_size, ws_size); grid = -1; return; }
        int dev = 0, cus = 0, per_cu = 0;
        if (hipGetDevice(&dev) != hipSuccess || hipDeviceGetAttribute(&cus, hipDeviceAttributeMultiprocessorCount, dev) != hipSuccess) { grid = -1; return; }
        if (hipFuncSetAttribute((const void*)fwd_kernel, hipFuncAttributeMaxDynamicSharedMemorySize, LDS_BYTES) != hipSuccess) { fprintf(stderr, "kernel_launch: hipFuncSetAttribute failed\n"); grid = -1; return; }
        if (hipOccupancyMaxActiveBlocksPerMultiprocessor(&per_cu, (const void*)fwd_kernel, NTHR, LDS_BYTES) != hipSuccess || per_cu < 1) { fprintf(stderr, "kernel_launch: occupancy query says %d blocks per CU\n", per_cu); }
        (void)hipGetLastError();
        grid = cus;
    }
    if (grid < 0) return;
    (void)hipMemsetAsync((char*)d_ws + WS_CTL, 0, CTL_ZERO_BYTES, stream);
    Args a{};
    for (int i = 0; i < 23; ++i) a.in[i] = (const float*)d_in[i];
    a.out = (float*)d_out; a.ws = (unsigned char*)d_ws;
#if MK_PER_PHASE
    for (int p = 0; p < N_PHASES; ++p) { a.ph_lo = p; a.ph_hi = p + 1; hipLaunchKernelGGL(fwd_kernel, dim3(grid), dim3(NTHR), LDS_BYTES, stream, a); }
#else
    a.ph_lo = 0; a.ph_hi = N_PHASES;
    hipLaunchKernelGGL(fwd_kernel, dim3(grid), dim3(NTHR), LDS_BYTES, stream, a);
#endif
    const hipError_t le = hipPeekAtLastError();
    if (le != hipSuccess) fprintf(stderr, "kernel_launch: launch failed: %s\n", hipGetErrorName(le));
}
```

```cpp
#include <hip/hip_runtime.h>
#include <hip/hip_fp16.h>
#include <cstdio>
#include <cstdint>
namespace pg8 {
#define PG8_LAS __attribute__((address_space(3)))
typedef unsigned short bf16_t;
typedef short bf16x8 __attribute__((ext_vector_type(8)));
typedef float f32x4 __attribute__((ext_vector_type(4)));
typedef unsigned u32x4 __attribute__((ext_vector_type(4)));
constexpr int BM = 256, BK = 64, HALF = 128, HTB = HALF * BK * 2  , STAGE_BYTES = 8 * HTB, NXCD = 8, WGM = 8;

__host__ __device__ __forceinline__ int lds_byte(int r, int c) { const int st = (r >> 4) * 2 + (c >> 5), rr = r & 15, cc = c & 31, ob = rr * 64 + cc * 2; return st * 1024 + (ob ^ (((ob >> 9) & 1) << 5)); }
__host__ __device__ __forceinline__ void stage_rc(int b, int& R, int& C) { const int st = b / 1024, sb = b % 1024, swz = sb ^ (((sb >> 9) & 1) << 5); R = (st >> 1) * 16 + swz / 64; C = (st & 1) * 32 + (swz % 64) / 2; }
__host__ __device__ __forceinline__ int perm32(int rho) { const int n = rho >> 4, i = rho & 15; return 8 * (i >> 2) + 4 * n + (i & 3); }

struct Unit { int pm, pn; };
struct Gemm { const bf16_t* A; const bf16_t* Bt; int M, N, K; };

struct StaticOrder {
    int nM, nN, nwg, G, c;
    __host__ __device__ void init(int M, int N, int G_, int c_) { nM = M / BM; nN = N / BM; nwg = nM * nN; G = G_; c = c_; }
    __host__ __device__ bool next(int i, Unit& u) const {
        const long L = (long)i * G + c; if (L >= nwg) return false;
        int wgid = (int)L; { const int q = nwg / NXCD, r = nwg % NXCD, xcd = wgid % NXCD, off = wgid / NXCD; wgid = (xcd < r ? xcd * (q + 1) : r * (q + 1) + (xcd - r) * q) + off; }
        const int nig = WGM * nN, gid = wgid / nig, fm = gid * WGM, gsz = (nM - fm) < WGM ? (nM - fm) : WGM;
        u.pm = fm + ((wgid % nig) % gsz); u.pn = (wgid % nig) / gsz; return true;
    }
    __device__ __forceinline__ void a_ready(const Unit&) const {}
    __device__ __forceinline__ void done(const Unit&) const {}
};

__device__ __forceinline__ unsigned cvt_pk_bf16(float lo, float hi) { unsigned r; asm volatile("v_cvt_pk_bf16_f32 %0, %1, %2" : "=v"(r) : "v"(lo), "v"(hi)); return r; }
typedef float f32x2 __attribute__((ext_vector_type(2)));
__device__ __forceinline__ f32x2 gelu_pk(f32x2 v) {
    const f32x2 av = __builtin_elementwise_abs(v), d = av * 0.2316418882f + 1.0f;
    f32x2 t; t.x = __builtin_amdgcn_rcpf(d.x); t.y = __builtin_amdgcn_rcpf(d.y);
    f32x2 q = t * 0.5307027145f + (-0.7265760135f); q = q * t + 0.7107068705f; q = q * t + (-0.142248368f); q = q * t + 0.127414796f; q = q * t;
    const f32x2 s = (v * v) * (-0.72134752044f);
    f32x2 e; e.x = __builtin_amdgcn_exp2f(s.x); e.y = __builtin_amdgcn_exp2f(s.y);
    const f32x2 m = v * (q * e), r = v - m;
    f32x2 o; o.x = v.x < 0.f ? m.x : r.x; o.y = v.y < 0.f ? m.y : r.y; return o;
}

template <int ACT  > struct EpiBf16 {
    static constexpr bool PERM = true, AFTER_DRAIN = false; static_assert(ACT == 0 || ACT == 1, "EpiBf16: ACT is 0 (none) or 1 (gelu_pk)");
    bf16_t* O; int ldc; const float* bias; int split_cols; size_t split_stride; float scale0;
    __device__ __forceinline__ void operator()(const f32x4 (&acc)[2][2][4][2], const Unit& u, int wr, int wc, int fr, int fq) const {
        const int row0 = u.pm * BM + wr * 64 + fr; int colt = u.pn * BM; bf16_t* base = O;
        float sc = 1.f; if (split_cols) { const int t = colt / split_cols; base += (size_t)t * split_stride; colt -= t * split_cols; if (t == 0) sc = scale0; }
        const int col0 = colt + wc * 32 + 8 * fq, bcol0 = u.pn * BM + wc * 32 + 8 * fq;
        f32x4 bv[2][2];
#pragma unroll
        for (int bj = 0; bj < 2; ++bj)
#pragma unroll
            for (int n = 0; n < 2; ++n) bv[bj][n] = bias ? *(const f32x4*)(bias + bcol0 + bj * HALF + 4 * n) : (f32x4){0.f, 0.f, 0.f, 0.f};
#pragma unroll
        for (int ai = 0; ai < 2; ++ai)
#pragma unroll
            for (int m = 0; m < 4; ++m) { bf16_t* rowp = base + (size_t)(row0 + ai * HALF + m * 16) * ldc + col0;
#pragma unroll
                for (int bj = 0; bj < 2; ++bj) { f32x4 v0 = acc[ai][bj][m][0] + bv[bj][0], v1 = acc[ai][bj][m][1] + bv[bj][1];
                    if (ACT == 1) { f32x2 a = gelu_pk((f32x2){v0[0], v0[1]}), b = gelu_pk((f32x2){v0[2], v0[3]}), c = gelu_pk((f32x2){v1[0], v1[1]}), d = gelu_pk((f32x2){v1[2], v1[3]});
                        v0 = (f32x4){a.x, a.y, b.x, b.y}; v1 = (f32x4){c.x, c.y, d.x, d.y}; }
                    v0 = v0 * sc; v1 = v1 * sc; u32x4 w; w.x = cvt_pk_bf16(v0[0], v0[1]); w.y = cvt_pk_bf16(v0[2], v0[3]); w.z = cvt_pk_bf16(v1[0], v1[1]); w.w = cvt_pk_bf16(v1[2], v1[3]);
                    *(u32x4*)(rowp + bj * HALF) = w; } }
    }
};

__device__ __forceinline__ void tile_dest(int pn, size_t& off, int& ld, int& colt);
struct EpiProj {
    static constexpr bool PERM = true, AFTER_DRAIN = false;
    unsigned char* ws;
    __device__ __forceinline__ void operator()(const f32x4 (&acc)[2][2][4][2], const Unit& u, int wr, int wc, int fr, int fq) const {
        size_t off; int ld, colt; tile_dest(u.pn, off, ld, colt);
        bf16_t* base = (bf16_t*)(ws + off);
        const int row0 = u.pm * BM + wr * 64 + fr, col0 = colt + wc * 32 + 8 * fq;
        const float sc = u.pn < 4 ? 0.12751743074602467f : 1.0f;
#pragma unroll
        for (int ai = 0; ai < 2; ++ai)
#pragma unroll
            for (int m = 0; m < 4; ++m) { bf16_t* rowp = base + (size_t)(row0 + ai * HALF + m * 16) * ld + col0;
#pragma unroll
                for (int bj = 0; bj < 2; ++bj) { const f32x4 v0 = acc[ai][bj][m][0] * sc, v1 = acc[ai][bj][m][1] * sc;
                    u32x4 w; w.x = cvt_pk_bf16(v0[0], v0[1]); w.y = cvt_pk_bf16(v0[2], v0[3]); w.z = cvt_pk_bf16(v1[0], v1[1]); w.w = cvt_pk_bf16(v1[2], v1[3]);
                    *(u32x4*)(rowp + bj * HALF) = w; } }
    }
};
struct EpiResid {
    static constexpr bool PERM = false, AFTER_DRAIN = false;
    const float* base; float* out; int ldc;
    __device__ __forceinline__ void operator()(const f32x4 (&acc)[2][2][4][2], const Unit& u, int wr, int wc, int fr, int fq) const {
        const int row0 = u.pm * BM + wr * 64 + fr, col0 = u.pn * BM + wc * 32 + 4 * fq;
#pragma unroll
        for (int ai = 0; ai < 2; ++ai)
#pragma unroll
            for (int m = 0; m < 4; ++m) { const size_t off = (size_t)(row0 + ai * HALF + m * 16) * ldc + col0;
#pragma unroll
                for (int bj = 0; bj < 2; ++bj)
#pragma unroll
                    for (int n = 0; n < 2; ++n) { const size_t p = off + bj * HALF + n * 16; const f32x4 b = *(const f32x4*)(base + p); *(f32x4*)(out + p) = b + acc[ai][bj][m][n]; } }
    }
};
struct EpiSwiGLU {
    static constexpr bool PERM = true, AFTER_DRAIN = false;
    bf16_t* O; int ldc;
    __device__ __forceinline__ static float silu_mul(float g, float u) { return g * u * __builtin_amdgcn_rcpf(1.0f + __expf(-g)); }
    __device__ __forceinline__ void operator()(const f32x4 (&acc)[2][2][4][2], const Unit& u, int wr, int wc, int fr, int fq) const {
        const int row0 = u.pm * BM + wr * 64 + fr, col0 = u.pn * HALF + wc * 32 + 8 * fq;
#pragma unroll
        for (int ai = 0; ai < 2; ++ai)
#pragma unroll
            for (int m = 0; m < 4; ++m) { bf16_t* rowp = O + (size_t)(row0 + ai * HALF + m * 16) * ldc + col0;
                const f32x4 g0 = acc[ai][0][m][0], g1 = acc[ai][0][m][1], u0 = acc[ai][1][m][0], u1 = acc[ai][1][m][1];
                u32x4 w; w.x = cvt_pk_bf16(silu_mul(g0[0], u0[0]), silu_mul(g0[1], u0[1])); w.y = cvt_pk_bf16(silu_mul(g0[2], u0[2]), silu_mul(g0[3], u0[3]));
                w.z = cvt_pk_bf16(silu_mul(g1[0], u1[0]), silu_mul(g1[1], u1[1])); w.w = cvt_pk_bf16(silu_mul(g1[2], u1[2]), silu_mul(g1[3], u1[3]));
                *(u32x4*)rowp = w; }
    }
};
template <class Epi, class Sched, bool ALIGN_EPI = false, bool SP2 = false>
__device__ __forceinline__ void gemm_phase(PG8_LAS unsigned char* lds, const Gemm g, const Sched& S, const Epi& E) {
    int tid_ = threadIdx.x; asm volatile("" : "+v"(tid_));
    const int tid = tid_, wid = __builtin_amdgcn_readfirstlane(tid >> 6), lane = tid & 63, wr = wid >> 2, wc = wid & 3, fr = lane & 15, fq = lane >> 4;
    const int K = g.K, nt = K / BK;
    unsigned voffA[2], voffB[2];
#pragma unroll
    for (int i = 0; i < 2; ++i) { int R, C; stage_rc(tid * 16 + i * 8192, R, C); const int Rb = Epi::PERM ? ((R & ~31) + perm32(R & 31)) : R;
        voffA[i] = (unsigned)(R * K + C) * 2u; voffB[i] = (unsigned)(Rb * K + C) * 2u; }
    const size_t kstep = (size_t)(BK * 2);
    const size_t hstep = (size_t)HALF * K * 2;
    const size_t tstep = 2 * hstep;
    const unsigned ldsw = (unsigned)wid * 1024u;
    const int aoff = lds_byte(wr * 64 + fr, fq * 8), boff = lds_byte(wc * 32 + fr, fq * 8);
#define PG8_SA(b, h) (((b) * 2 + (h)) * HTB)
#define PG8_SB(b, h) ((4 + (b) * 2 + (h)) * HTB)
#define PG8_STAGE(bufoff, gbase, voff) do { _Pragma("unroll") for (int _i = 0; _i < 2; ++_i) \
        __builtin_amdgcn_global_load_lds((const unsigned*)((const char*)(gbase) + (voff)[_i]), (PG8_LAS unsigned*)(lds + (bufoff) + ldsw + _i * 8192), 16, 0, 0); } while (0)
#define PG8_LDA(dst, b, h) do { _Pragma("unroll") for (int m = 0; m < 4; ++m) _Pragma("unroll") for (int k = 0; k < 2; ++k) dst[m][k] = *(const PG8_LAS bf16x8*)(lds + PG8_SA(b, h) + aoff + m * 2048 + k * 1024); } while (0)
#define PG8_LDB(dst, b, h) do { _Pragma("unroll") for (int n = 0; n < 2; ++n) _Pragma("unroll") for (int k = 0; k < 2; ++k) dst[n][k] = *(const PG8_LAS bf16x8*)(lds + PG8_SB(b, h) + boff + n * 2048 + k * 1024); } while (0)
#define PG8_MMA(ai, bj, At, Bt) do { __builtin_amdgcn_s_setprio(1); _Pragma("unroll") for (int m = 0; m < 4; ++m) _Pragma("unroll") for (int n = 0; n < 2; ++n) _Pragma("unroll") for (int k = 0; k < 2; ++k) \
        acc[ai][bj][m][n] = __builtin_amdgcn_mfma_f32_16x16x32_bf16(Bt[n][k], At[m][k], acc[ai][bj][m][n], 0, 0, 0); __builtin_amdgcn_s_setprio(0); } while (0)
#define PG8_WAIT_V(n) asm volatile("s_waitcnt vmcnt(" #n ")" ::: "memory")
#define PG8_WAIT_L(n) asm volatile("s_waitcnt lgkmcnt(" #n ")" ::: "memory")
#define PG8_BAR __builtin_amdgcn_s_barrier()
#define PG8_SCHED __builtin_amdgcn_sched_barrier(0)
    Unit cur, nxt; int ui = 0;
    if (!S.next(0, cur)) return;
    f32x4 acc[2][2][4][2];
#pragma unroll
    for (int a = 0; a < 2; ++a)
#pragma unroll
        for (int b = 0; b < 2; ++b)
#pragma unroll
            for (int m = 0; m < 4; ++m)
#pragma unroll
                for (int n = 0; n < 2; ++n) acc[a][b][m][n] = (f32x4){0.f, 0.f, 0.f, 0.f};
    bf16x8 At[4][2], B0[2][2], B1[2][2];
    const char* cA = (const char*)g.A + (size_t)cur.pm * tstep; const char* cB = (const char*)g.Bt + (size_t)cur.pn * tstep;
    S.a_ready(cur);
    if constexpr (SP2) {
        PG8_STAGE(PG8_SB(0, 0), cB, voffB); PG8_STAGE(PG8_SB(0, 1), cB + hstep, voffB); PG8_STAGE(PG8_SA(0, 0), cA, voffA); PG8_STAGE(PG8_SA(0, 1), cA + hstep, voffA);
        if (wr == 1) PG8_BAR;
        PG8_WAIT_V(2); PG8_BAR;
        PG8_STAGE(PG8_SB(1, 0), cB + kstep, voffB); PG8_STAGE(PG8_SA(1, 0), cA + kstep, voffA); PG8_STAGE(PG8_SB(1, 1), cB + hstep + kstep, voffB);
        PG8_WAIT_V(6); PG8_BAR;
    } else {
        PG8_STAGE(PG8_SB(0, 0), cB, voffB); PG8_STAGE(PG8_SA(0, 0), cA, voffA); PG8_STAGE(PG8_SB(0, 1), cB + hstep, voffB); PG8_STAGE(PG8_SA(0, 1), cA + hstep, voffA);
        if (wr == 1) PG8_BAR;
        PG8_WAIT_V(4); PG8_BAR;
        PG8_STAGE(PG8_SB(1, 0), cB + kstep, voffB); PG8_STAGE(PG8_SA(1, 0), cA + kstep, voffA); PG8_STAGE(PG8_SB(1, 1), cB + hstep + kstep, voffB);
        PG8_WAIT_V(6); PG8_BAR;
    }
    for (;;) {
        const bool has_next = S.next(ui + 1, nxt);
        const char* nA = has_next ? (const char*)g.A + (size_t)nxt.pm * tstep : cA; const char* nB = has_next ? (const char*)g.Bt + (size_t)nxt.pn * tstep : cB;
        for (int t = 0; t < nt; t += 2) {
            const bool last = (t == nt - 2);
            const char* a1 = cA + (size_t)(t + 1) * kstep;
            const char* a2 = last ? nA : cA + (size_t)(t + 2) * kstep; const char* b2 = last ? nB : cB + (size_t)(t + 2) * kstep;
            const char* a3 = a2 + kstep; const char* b3 = b2 + kstep;
            if (last && has_next) S.a_ready(nxt);
            if constexpr (SP2) {
            PG8_LDB(B0, 0, 0); PG8_LDB(B1, 0, 1); PG8_SCHED; PG8_LDA(At, 0, 0); PG8_STAGE(PG8_SA(1, 1), a1 + hstep, voffA);
            PG8_WAIT_V(8); PG8_WAIT_L(0); PG8_BAR; PG8_MMA(0, 0, At, B0); PG8_MMA(0, 1, At, B1); PG8_BAR; PG8_SCHED;
            PG8_LDA(At, 0, 1); PG8_STAGE(PG8_SB(0, 0), b2, voffB); PG8_STAGE(PG8_SB(0, 1), b2 + hstep, voffB); PG8_STAGE(PG8_SA(0, 0), a2, voffA);
            PG8_WAIT_V(8); PG8_WAIT_L(0); PG8_BAR; PG8_MMA(1, 0, At, B0); PG8_MMA(1, 1, At, B1); PG8_BAR; PG8_SCHED;
            PG8_LDB(B0, 1, 0); PG8_LDB(B1, 1, 1); PG8_SCHED; PG8_LDA(At, 1, 0); PG8_STAGE(PG8_SA(0, 1), a2 + hstep, voffA);
            PG8_WAIT_V(8); PG8_WAIT_L(0); PG8_BAR; PG8_MMA(0, 0, At, B0); PG8_MMA(0, 1, At, B1); PG8_BAR; PG8_SCHED;
            PG8_LDA(At, 1, 1); PG8_STAGE(PG8_SB(1, 0), b3, voffB); PG8_STAGE(PG8_SB(1, 1), b3 + hstep, voffB); PG8_STAGE(PG8_SA(1, 0), a3, voffA);
            PG8_WAIT_V(8); PG8_WAIT_L(0); PG8_BAR; PG8_MMA(1, 0, At, B0); PG8_MMA(1, 1, At, B1); PG8_BAR; PG8_SCHED;
            } else {
            PG8_LDB(B0, 0, 0); PG8_SCHED; PG8_LDA(At, 0, 0); PG8_STAGE(PG8_SA(1, 1), a1 + hstep, voffA);
            PG8_WAIT_L(8); PG8_BAR; PG8_WAIT_L(0); PG8_MMA(0, 0, At, B0); PG8_BAR; PG8_SCHED;
            PG8_LDB(B1, 0, 1); PG8_STAGE(PG8_SB(0, 0), b2, voffB);
            PG8_BAR; PG8_WAIT_L(0); PG8_MMA(0, 1, At, B1); PG8_BAR;
            PG8_LDA(At, 0, 1); PG8_STAGE(PG8_SA(0, 0), a2, voffA);
            PG8_BAR; PG8_WAIT_L(0); PG8_MMA(1, 0, At, B0); PG8_BAR; PG8_SCHED;
            PG8_STAGE(PG8_SB(0, 1), b2 + hstep, voffB);
            PG8_WAIT_V(6); PG8_BAR; PG8_MMA(1, 1, At, B1); PG8_BAR;
            PG8_LDB(B0, 1, 0); PG8_SCHED; PG8_LDA(At, 1, 0); PG8_STAGE(PG8_SA(0, 1), a2 + hstep, voffA);
            PG8_WAIT_L(8); PG8_BAR; PG8_WAIT_L(0); PG8_MMA(0, 0, At, B0); PG8_BAR; PG8_SCHED;
            PG8_LDB(B1, 1, 1); PG8_STAGE(PG8_SB(1, 0), b3, voffB);
            PG8_BAR; PG8_WAIT_L(0); PG8_MMA(0, 1, At, B1); PG8_BAR;
            PG8_LDA(At, 1, 1); PG8_STAGE(PG8_SA(1, 0), a3, voffA);
            PG8_BAR; PG8_WAIT_L(0); PG8_MMA(1, 0, At, B0); PG8_BAR; PG8_SCHED;
            PG8_STAGE(PG8_SB(1, 1), b3 + hstep, voffB);
            PG8_WAIT_V(6); PG8_BAR; PG8_MMA(1, 1, At, B1); PG8_BAR;
            }
        }
        if constexpr (ALIGN_EPI) { if (wr == 0) PG8_BAR; }
        if constexpr (!Epi::AFTER_DRAIN) { E(acc, cur, wr, wc, fr, fq); S.done(cur); }
        if (!has_next) break;
#pragma unroll
        for (int a = 0; a < 2; ++a)
#pragma unroll
            for (int b = 0; b < 2; ++b)
#pragma unroll
                for (int m = 0; m < 4; ++m)
#pragma unroll
                    for (int n = 0; n < 2; ++n) acc[a][b][m][n] = (f32x4){0.f, 0.f, 0.f, 0.f};
        cur = nxt; cA = nA; cB = nB; ++ui;
        if constexpr (ALIGN_EPI) { if (wr == 1) PG8_BAR; }
    }
    PG8_WAIT_V(0);
    if constexpr (!ALIGN_EPI) { if (wr == 0) PG8_BAR; }
    PG8_BAR;
    if constexpr (Epi::AFTER_DRAIN) { E.fused(acc, cur, wr, wc, fr, fq, lds, wid, lane); S.done(cur); }
#undef PG8_SA
#undef PG8_SB
#undef PG8_STAGE
#undef PG8_LDA
#undef PG8_LDB
#undef PG8_MMA
#undef PG8_WAIT_V
#undef PG8_WAIT_L
#undef PG8_BAR
#undef PG8_SCHED
}
}
constexpr int NB = 4, T = 8192, M = NB * T, DM = 2048, DFF = 5632, DEPTH = 2;
constexpr int N_IN = 7696, N_INP = 7936;
constexpr int NWAVES = 8, NTHR = NWAVES * 64;
#define LAS __attribute__((address_space(3)))
#define GAS __attribute__((address_space(1)))
#define CAS __attribute__((address_space(4)))
typedef unsigned short bf16;
typedef short bf16x8 __attribute__((ext_vector_type(8)));
typedef float f32x4 __attribute__((ext_vector_type(4)));
typedef float f32x16 __attribute__((ext_vector_type(16)));
typedef unsigned u32x4 __attribute__((ext_vector_type(4)));
typedef unsigned u32x2 __attribute__((ext_vector_type(2)));
typedef unsigned long long u64;

constexpr size_t MiB = 1u << 20;
constexpr size_t WS_CTL = 0, CTL_ZERO_BYTES = 1 * MiB;
constexpr size_t WS_WIN = 1 * MiB, WS_WOUT = 32 * MiB, WS_WGU = 40 * MiB, WS_WDN = 84 * MiB;
constexpr size_t WS_LORA = 106 * MiB;
constexpr size_t LO_W = 0, LO_A = 512 * 96 * 2, LO_V = 2 * 512 * 96 * 2, LO_G = LO_V + 512 * 64 * 2;
constexpr size_t WS_VFIRST = 107 * MiB;
constexpr size_t WS_H = 139 * MiB;
constexpr size_t WS_VT = 139 * MiB, WS_MASK = 203 * MiB;
constexpr size_t WS_Q = 267 * MiB, WS_K = 331 * MiB, WS_QI = 395 * MiB, WS_V = 459 * MiB, WS_KW = 523 * MiB, WS_BQ = 539 * MiB, WS_BK = 555 * MiB, WS_BV = 571 * MiB, WS_BG = 603 * MiB;
constexpr size_t WS_CR = 635 * MiB, WS_CK = 667 * MiB, WS_CV = 699 * MiB, WS_CL = 731 * MiB, WS_CG = 747 * MiB;
constexpr size_t WS_CAT = 763 * MiB;
constexpr size_t WS_KVST = 891 * MiB;
constexpr size_t WS_TAB = 955 * MiB;
constexpr size_t TAB_A = 0, TAB_I = (size_t)T * 16 * 8, TAB_R = TAB_I + (size_t)T * 8 * 8, TAB_END = TAB_R + (size_t)T * 32 * 8;
constexpr size_t WS_RR = 139 * MiB, WS_RW = 203 * MiB, WS_RKH = 267 * MiB, WS_RV = 331 * MiB, WS_RA = 395 * MiB, WS_RB = 459 * MiB;
constexpr size_t WS_PHI = 523 * MiB, WS_PSI = 555 * MiB, WS_SST = 587 * MiB, WS_Y = 635 * MiB;
constexpr size_t WS_H2 = 139 * MiB, WS_ACT = 267 * MiB;
constexpr size_t WS_NEED = 1024 * MiB;
static_assert(WS_TAB + TAB_END <= WS_NEED && WS_ACT + (size_t)M * DFF * 2 <= WS_CR && WS_SST + 32 * MiB <= WS_CR && WS_Y + (size_t)M * 512 * 4 <= WS_CV, "ws map");

constexpr int LDS_BYTES = 147456, MISC_OFF = 143360;
constexpr int CW_BAR = 4096;

__device__ __forceinline__ unsigned f2bf(float f) { unsigned u = __builtin_bit_cast(unsigned, f); return (u + 0x7fffu + ((u >> 16) & 1u)) >> 16; }
__device__ __forceinline__ unsigned pk2(float lo, float hi) { return f2bf(lo) | (f2bf(hi) << 16); }
__device__ __forceinline__ float bf2f(unsigned short b) { return __builtin_bit_cast(float, (unsigned)b << 16); }
__device__ __forceinline__ float bflo(unsigned w) { return __builtin_bit_cast(float, w << 16); }
__device__ __forceinline__ float bfhi(unsigned w) { return __builtin_bit_cast(float, w & 0xffff0000u); }
__device__ __forceinline__ float wave_sum(float v) {
#pragma unroll
    for (int o = 1; o < 64; o <<= 1) v += __shfl_xor(v, o);
    return v;
}
#define LDS_WAIT() asm volatile("s_waitcnt lgkmcnt(0)" ::: "memory")

namespace pg8 {
__device__ __forceinline__ void tile_dest(int pn, size_t& off, int& ld, int& colt) {
    if (pn < 16) { const int g = pn >> 2; off = g == 0 ? WS_Q : g == 1 ? WS_K : g == 2 ? WS_V : WS_QI; ld = 1024; colt = (pn & 3) * 256; }
    else if (pn == 16) { off = WS_BQ; ld = 256; colt = 0; }
    else if (pn == 17) { off = WS_BK; ld = 256; colt = 0; }
    else if (pn < 20) { off = WS_BV; ld = 512; colt = (pn - 18) * 256; }
    else if (pn < 22) { off = WS_BG; ld = 512; colt = (pn - 20) * 256; }
    else if (pn == 22) { off = WS_KW; ld = 256; colt = 0; }
    else if (pn < 25) { off = WS_CR; ld = 512; colt = (pn - 23) * 256; }
    else if (pn < 27) { off = WS_CK; ld = 512; colt = (pn - 25) * 256; }
    else if (pn < 29) { off = WS_CV; ld = 512; colt = (pn - 27) * 256; }
    else if (pn == 29) { off = WS_CL; ld = 256; colt = 0; }
    else { off = WS_CG; ld = 256; colt = 0; }
}
}
__device__ __forceinline__ int win_src(int n, int layer) {
    if (n < 4096) return n;
    if (n < 4352) return 4176 + (n - 4096);
    if (n < 4608) return 4432 + (n - 4352);
    if (n < 5120) return 4688 + (n - 4608);
    if (n < 5632) return 5200 + (n - 5120);
    if (n < 5888) { const int j = n - 5632; return j < 64 ? 4096 + j : (j < 80 ? 4160 + (j - 64) : -1); }
    if (n < 7424) return 5712 + (n - 5888);
    if (n < 7680) { const int j = n - 7424; return j < 96 ? 7248 + j : (j < 192 ? 7344 + (j - 96) : (layer > 0 ? -2 - (j - 192) : -1)); }
    return 7440 + (n - 7680);
}
#define XB_TMO      128
#define XB_XCNT(j)  (256  + 64 * (j))
#define XB_XSUB(j)  (1280 + 64 * (j))
#define XB_XGEN(j)  (2304 + 64 * (j))
#define XB_TOP      3328
#define XB_TOPGEN   3392
#define XCD_BAR_WORDS 3456
#define XB_SPIN_CAP (1u << 18)

__device__ __forceinline__ unsigned xb_ld(unsigned* p)              { return __hip_atomic_load(p, __ATOMIC_RELAXED, __HIP_MEMORY_SCOPE_AGENT); }
__device__ __forceinline__ unsigned xb_add(unsigned* p, unsigned v) { return __hip_atomic_fetch_add(p, v, __ATOMIC_RELAXED, __HIP_MEMORY_SCOPE_AGENT); }
__device__ __forceinline__ unsigned xb_xcc_id() { return (unsigned)__builtin_amdgcn_s_getreg((3 << 11) | 20) & 0xFu; }
#define XB_SPIN(cond, bar) do { unsigned _sp = 0; while (cond) { __builtin_amdgcn_s_sleep(1); \
    if ((++_sp & 255u) == 0u) { if (xb_ld(&(bar)[XB_TMO])) break; if (_sp > XB_SPIN_CAP) { atomicAdd(&(bar)[XB_TMO], 1u); break; } } } } while (0)

struct XcdBarrier {
    unsigned* bar; unsigned x;
    volatile LAS unsigned* st;
};

__device__ __forceinline__ XcdBarrier xcd_barrier_post(unsigned* bar, volatile LAS unsigned* st) {
    XcdBarrier b; b.bar = bar; b.x = xb_xcc_id(); b.st = st;
    if (threadIdx.x == 0) (void)xb_add(&bar[XB_XCNT(b.x)], 1u);
    return b;
}
__device__ __forceinline__ void xcd_barrier_complete(unsigned* bar, unsigned x, unsigned& nloc, unsigned& nx) {
    const unsigned G = gridDim.x * gridDim.y * gridDim.z;
    unsigned sum, cnt, mine, sp = 0u;
    for (;;) {
        sum = 0u; cnt = 0u; mine = 0u;
#pragma unroll
        for (unsigned j = 0; j < 16; ++j) { const unsigned c = xb_ld(&bar[XB_XCNT(j)]); sum += c; cnt += (c > 0u) ? 1u : 0u; mine = (j == x) ? c : mine; }
        if (sum == G) break;
        __builtin_amdgcn_s_sleep(1);
        if ((++sp & 255u) == 0u) { if (xb_ld(&bar[XB_TMO])) break; if (sp > XB_SPIN_CAP) { atomicAdd(&bar[XB_TMO], 1u); break; } }
    }
    nloc = mine > 0u ? mine : 1u; nx = cnt > 0u ? cnt : 1u;
}

__device__ __forceinline__ void xcd_barrier(const XcdBarrier& b) {
    asm volatile("s_waitcnt vmcnt(0)" ::: "memory");
    __syncthreads();
    if (threadIdx.x == 0) {
        unsigned* bar = b.bar;
        __builtin_amdgcn_s_waitcnt(0);
        unsigned nloc = b.st[0], nx = b.st[1];
        if (nloc == 0u) { xcd_barrier_complete(bar, b.x, nloc, nx); b.st[0] = nloc; b.st[1] = nx; }
        const unsigned old = xb_add(&bar[XB_XSUB(b.x)], 1u);
        const unsigned gen = old / nloc;
        if (old + 1u == (gen + 1u) * nloc) {
            __builtin_amdgcn_fence(__ATOMIC_RELEASE, "agent");
            asm volatile("s_waitcnt vmcnt(0)" ::: "memory");
            const unsigned og = xb_add(&bar[XB_TOP], 1u);
            const unsigned tg = og / nx;
            if (og + 1u == (tg + 1u) * nx) xb_add(&bar[XB_TOPGEN], 1u);
            else XB_SPIN(xb_ld(&bar[XB_TOPGEN]) == tg, bar);
            __builtin_amdgcn_fence(__ATOMIC_ACQUIRE, "agent");
            xb_add(&bar[XB_XGEN(b.x)], 1u);
            asm volatile("s_waitcnt vmcnt(0)" ::: "memory");
        } else {
            XB_SPIN(xb_ld(&bar[XB_XGEN(b.x)]) == gen, bar);
            __builtin_amdgcn_fence(__ATOMIC_ACQUIRE, "agent");
            asm volatile("s_waitcnt vmcnt(0)" ::: "memory");
        }
    }
    __syncthreads();
}

struct Ctx {
    LAS unsigned char* lds; int tid, lane, wave, G, bid; unsigned char* ws; float* out;
};

template <int MAP>
__device__ __forceinline__ void wconv_item(const float* W, int ldw, const float* W2, int K, bf16* WT, LAS float* scr, int item, int nblk, int lane, int layer) {
    const int kb = item / nblk, nb = item % nblk, k0 = 64 * kb, n0 = 32 * nb;
    const int n = n0 + (lane & 31);
    const float* src = nullptr; int ld = ldw;
    if (MAP == 0) src = W + n;
    else if (MAP == 1) { const int s = win_src(n, layer); if (s >= 0) src = W + s; else if (s <= -2) { src = W2 + (-2 - s); ld = 64; } }
    else { const int tl = n >> 8, j = n & 255; src = W + (j < 128 ? tl * 128 + j : DFF + tl * 128 + (j - 128)); }
#pragma unroll 8
    for (int i = 0; i < 32; ++i) { const int kk = 2 * i + (lane >> 5); scr[kk * 33 + (lane & 31)] = src ? src[(size_t)(k0 + kk) * ld] : 0.f; }
    LDS_WAIT(); asm volatile("" ::: "memory");
    const int c = lane & 7;
#pragma unroll
    for (int j = 0; j < 4; ++j) { const int nn = (lane >> 3) + 8 * j; const LAS float* s = scr + (8 * c) * 33 + nn;
        u32x4 o; o.x = pk2(s[0 * 33], s[1 * 33]); o.y = pk2(s[2 * 33], s[3 * 33]); o.z = pk2(s[4 * 33], s[5 * 33]); o.w = pk2(s[6 * 33], s[7 * 33]);
        *(u32x4*)(WT + (size_t)(n0 + nn) * K + k0 + 8 * c) = o; }
    LDS_WAIT(); asm volatile("" ::: "memory");
}
struct WSrc { const float *w_in, *w_vres, *w_out, *w_gu, *w_dn, *wlb, *alb, *glb, *vlb; };
__device__ __forceinline__ void phase_wconv(const Ctx& C, int layer, const WSrc& W) {
    LAS float* scr = (LAS float*)(C.lds + C.wave * 16384);
    const int gw = C.bid * NWAVES + C.wave, NGW = C.G * NWAVES;
    const float* w_in = W.w_in + (size_t)layer * DM * N_IN; const float* w_vres = W.w_vres;
    const float* w_out = W.w_out + (size_t)layer * DM * DM; const float* w_gu = W.w_gu + (size_t)layer * DM * 2 * DFF; const float* w_dn = W.w_dn + (size_t)layer * DFF * DM;
    constexpr int I_IN = (DM / 64) * (N_INP / 32), I_OUT = (DM / 64) * (DM / 32), I_GU = (DM / 64) * (2 * DFF / 32), I_DN = (DFF / 64) * (DM / 32);
    for (int it = gw; it < I_IN + I_OUT + I_GU + I_DN; it += NGW) {
        int r = it;
        if (r < I_IN) { wconv_item<1>(w_in, N_IN, w_vres, DM, (bf16*)(C.ws + WS_WIN), scr, r, N_INP / 32, C.lane, layer); continue; } r -= I_IN;
        if (r < I_OUT) { wconv_item<0>(w_out, DM, nullptr, DM, (bf16*)(C.ws + WS_WOUT), scr, r, DM / 32, C.lane, layer); continue; } r -= I_OUT;
        if (r < I_GU) { wconv_item<2>(w_gu, 2 * DFF, nullptr, DM, (bf16*)(C.ws + WS_WGU), scr, r, 2 * DFF / 32, C.lane, layer); continue; } r -= I_GU;
        wconv_item<0>(w_dn, DM, nullptr, DFF, (bf16*)(C.ws + WS_WDN), scr, r, DM / 32, C.lane, layer);
    }
    const int gt = C.bid * NTHR + C.tid, NGT = C.G * NTHR;
    const float* wlb = W.wlb + (size_t)layer * 96 * 512; const float* alb = W.alb + (size_t)layer * 96 * 512; const float* glb = W.glb + (size_t)layer * 256 * 512;
    const float* vlb = W.vlb;
    bf16* LW = (bf16*)(C.ws + WS_LORA + LO_W); bf16* LA = (bf16*)(C.ws + WS_LORA + LO_A); bf16* LV = (bf16*)(C.ws + WS_LORA + LO_V); bf16* LG = (bf16*)(C.ws + WS_LORA + LO_G);
    for (int i = gt; i < 512 * 96; i += NGT) { const int n = i / 96, k = i % 96; LW[i] = (bf16)f2bf(wlb[k * 512 + n]); LA[i] = (bf16)f2bf(alb[k * 512 + n]); }
    for (int i = gt; i < 512 * 64; i += NGT) { const int n = i / 64, k = i % 64; LV[i] = (bf16)f2bf(layer > 0 ? vlb[k * 512 + n] : 0.f); }
    for (int i = gt; i < 512 * 256; i += NGT) { const int n = i / 256, k = i % 256; LG[i] = (bf16)f2bf(glb[k * 512 + n]); }
    if (layer == 0) {
        float2* TA = (float2*)(C.ws + WS_TAB + TAB_A); float2* TI = (float2*)(C.ws + WS_TAB + TAB_I); float2* TR = (float2*)(C.ws + WS_TAB + TAB_R);
        const float l2a = 18.931568569324174f  , l2r = 13.287712379549449f  ;
        for (int i = gt; i < T * 56; i += NGT) {
            const int pos = i / 56, j = i % 56; float fr; float2* dst;
            if (j < 16) { fr = exp2f(-(float)j * (1.0f / 16.0f) * l2a); dst = TA + pos * 16 + j; }
            else if (j < 24) { fr = exp2f(-(float)(j - 16) * (1.0f / 8.0f) * l2a); dst = TI + pos * 8 + (j - 16); }
            else { fr = exp2f(-(float)(j - 24) * (1.0f / 32.0f) * l2r); dst = TR + pos * 32 + (j - 24); }
            const float ang = (float)pos * fr; *dst = make_float2(cosf(ang), sinf(ang));
        }
    }
}
__device__ __forceinline__ void phase_norm_bf16(const Ctx& C, const float* x, const float* g, bf16* out) {
    const int gw = C.bid * NWAVES + C.wave, NGW = C.G * NWAVES;
    f32x4 gv[8];
#pragma unroll
    for (int j = 0; j < 8; ++j) gv[j] = *(const f32x4*)(g + 4 * (C.lane + 64 * j));
    for (int m = gw; m < M; m += NGW) {
        const f32x4* xr = (const f32x4*)(x + (size_t)m * DM) + C.lane; f32x4 v[8]; float s = 0.f;
#pragma unroll
        for (int j = 0; j < 8; ++j) { v[j] = xr[64 * j]; s += (v[j].x * v[j].x + v[j].y * v[j].y) + (v[j].z * v[j].z + v[j].w * v[j].w); }
        const float rs = rsqrtf(wave_sum(s) * (1.0f / DM) + 1e-5f);
        u32x2* o = (u32x2*)(out + (size_t)m * DM) + C.lane;
#pragma unroll
        for (int j = 0; j < 8; ++j) { u32x2 w; w.x = pk2(v[j].x * rs * gv[j].x, v[j].y * rs * gv[j].y); w.y = pk2(v[j].z * rs * gv[j].z, v[j].w * rs * gv[j].w); o[64 * j] = w; }
    }
}
__device__ __forceinline__ void phase_final_norm(const Ctx& C, float* x, const float* g) {
    const int gw = C.bid * NWAVES + C.wave, NGW = C.G * NWAVES;
    f32x4 gv[8];
#pragma unroll
    for (int j = 0; j < 8; ++j) gv[j] = *(const f32x4*)(g + 4 * (C.lane + 64 * j));
    for (int m = gw; m < M; m += NGW) {
        f32x4* xr = (f32x4*)(x + (size_t)m * DM) + C.lane; f32x4 v[8]; float s = 0.f;
#pragma unroll
        for (int j = 0; j < 8; ++j) { v[j] = xr[64 * j]; s += (v[j].x * v[j].x + v[j].y * v[j].y) + (v[j].z * v[j].z + v[j].w * v[j].w); }
        const float rs = rsqrtf(wave_sum(s) * (1.0f / DM) + 1e-5f);
#pragma unroll
        for (int j = 0; j < 8; ++j) xr[64 * j] = v[j] * rs * gv[j];
    }
}
__device__ __forceinline__ void phase_prep_a(const Ctx& C) {
    const long gt = (long)C.bid * NTHR + C.tid, NGT = (long)C.G * NTHR;
    for (int cfg = 0; cfg < 6; ++cfg) {
        size_t off; int ld, nh, hd, half; size_t tab;
        if (cfg == 0) { off = WS_Q; ld = 1024; nh = 8; hd = 128; half = 16; tab = TAB_A; }
        else if (cfg == 1) { off = WS_K; ld = 1024; nh = 8; hd = 128; half = 16; tab = TAB_A; }
        else if (cfg == 2) { off = WS_QI; ld = 1024; nh = 16; hd = 64; half = 8; tab = TAB_I; }
        else if (cfg == 3) { off = WS_KW; ld = 256; nh = 1; hd = 64; half = 8; tab = TAB_I; }
        else if (cfg == 4) { off = WS_BQ; ld = 256; nh = 4; hd = 64; half = 32; tab = TAB_R; }
        else { off = WS_BK; ld = 256; nh = 4; hd = 64; half = 32; tab = TAB_R; }
        bf16* buf = (bf16*)(C.ws + off); const float2* tb = (const float2*)(C.ws + WS_TAB + tab);
        const int cpp = half >> 3; const long total = (long)M * nh * cpp;
        for (long it = gt; it < total; it += NGT) {
            const int c = (int)(it % cpp); const long r2 = it / cpp; const int h = (int)(r2 % nh); const int row = (int)(r2 / nh); const int pos = row & (T - 1);
            bf16* p1 = buf + (size_t)row * ld + h * hd + 8 * c; bf16* p2 = p1 + half;
            const u32x4 a = *(const u32x4*)p1, b = *(const u32x4*)p2; const float2* tp = tb + (size_t)pos * half + 8 * c;
            float x1[8], x2[8];
#pragma unroll
            for (int e = 0; e < 4; ++e) { x1[2 * e] = bflo(a[e]); x1[2 * e + 1] = bfhi(a[e]); x2[2 * e] = bflo(b[e]); x2[2 * e + 1] = bfhi(b[e]); }
            u32x4 oa, ob;
#pragma unroll
            for (int e = 0; e < 4; ++e) {
                const float2 t0 = tp[2 * e], t1 = tp[2 * e + 1];
                oa[e] = pk2(x1[2 * e] * t0.x - x2[2 * e] * t0.y, x1[2 * e + 1] * t1.x - x2[2 * e + 1] * t1.y);
                ob[e] = pk2(x2[2 * e] * t0.x + x1[2 * e] * t0.y, x2[2 * e + 1] * t1.x + x1[2 * e + 1] * t1.y);
            }
            *(u32x4*)p1 = oa; *(u32x4*)p2 = ob;
        }
    }
    {
        LAS unsigned short* scr = (LAS unsigned short*)(C.lds + C.wave * 8704);
        const bf16* V = (const bf16*)(C.ws + WS_V); bf16* Vt = (bf16*)(C.ws + WS_VT);
        const int gw = C.bid * NWAVES + C.wave, NGW = C.G * NWAVES;
        for (int it = gw; it < NB * 128 * 16; it += NGW) {
            const int ct = it & 15, tt = (it >> 4) & 127, b = it >> 11;
            const int t0 = tt * 64, c0 = ct * 64;
#pragma unroll 4
            for (int i = 0; i < 32; ++i) { const int tr = 2 * i + (C.lane >> 5), cc = 2 * (C.lane & 31);
                const unsigned w = *(const unsigned*)(V + (size_t)(b * T + t0 + tr) * 1024 + c0 + cc); scr[tr * 66 + cc] = (unsigned short)(w & 0xffffu); scr[tr * 66 + cc + 1] = (unsigned short)(w >> 16); }
            LDS_WAIT(); asm volatile("" ::: "memory");
#pragma unroll 4
            for (int i = 0; i < 32; ++i) { const int cr = 2 * i + (C.lane >> 5), tp = 2 * (C.lane & 31);
                const unsigned w = (unsigned)scr[tp * 66 + cr] | ((unsigned)scr[(tp + 1) * 66 + cr] << 16);
                *(unsigned*)(Vt + ((size_t)b * 1024 + c0 + cr) * T + t0 + tp) = w; }
            LDS_WAIT(); asm volatile("" ::: "memory");
        }
    }
}
__device__ __forceinline__ void phase_indexer(const Ctx& C) {
    LAS unsigned short* sc = (LAS unsigned short*)C.lds;
    LAS unsigned* hist = (LAS unsigned*)(C.lds + 131072) + C.wave * 256;
    LAS float* wvl = (LAS float*)(C.lds + 131072 + 8192);
    const bf16* QI = (const bf16*)(C.ws + WS_QI); const bf16* KW = (const bf16*)(C.ws + WS_KW); u64* MASK = (u64*)(C.ws + WS_MASK);
    const int lane = C.lane, r32 = lane & 31, hi = lane >> 5;
    for (int it = C.bid; it < NB * (T / 8); it += C.G) {
        const int b = it & 3, qg = it >> 2, q0 = qg * 8, qchunk = q0 >> 6, nadm = 64 * (qchunk + 1);
        const int qrow = b * T + q0 + C.wave;
        if (qchunk < 4) {
            MASK[(size_t)qrow * 128 + lane] = lane <= qchunk ? ~0ull : 0ull; MASK[(size_t)qrow * 128 + 64 + lane] = 0ull;
            continue;
        }
        bf16x8 af[4][4];
        {
            const int qq = (r32 >> 2) & 1, hh = (r32 & 3) + 4 * (r32 >> 3);
#pragma unroll
            for (int pr = 0; pr < 4; ++pr) {
                const bf16* qp = QI + (size_t)(b * T + q0 + 2 * pr + qq) * 1024 + hh * 64 + 8 * hi;
#pragma unroll
                for (int kk = 0; kk < 4; ++kk) af[pr][kk] = *(const bf16x8*)(qp + 16 * kk);
            }
            if (C.tid < 128) wvl[C.tid] = bf2f(KW[(size_t)(b * T + q0 + (C.tid >> 4)) * 256 + 64 + (C.tid & 15)]) * 0.03125f;
        }
        __syncthreads();
        for (int tile = C.wave; tile < nadm / 32; tile += NWAVES) {
            const int key0 = 32 * tile;
            const bf16* kp = KW + (size_t)(b * T + key0 + r32) * 256 + 8 * hi;
            bf16x8 bfr[4];
#pragma unroll
            for (int kk = 0; kk < 4; ++kk) bfr[kk] = *(const bf16x8*)(kp + 16 * kk);
#pragma unroll
            for (int pr = 0; pr < 4; ++pr) {
                f32x16 d = {0.f, 0.f, 0.f, 0.f, 0.f, 0.f, 0.f, 0.f, 0.f, 0.f, 0.f, 0.f, 0.f, 0.f, 0.f, 0.f};
#pragma unroll
                for (int kk = 0; kk < 4; ++kk) d = __builtin_amdgcn_mfma_f32_32x32x16_bf16(af[pr][kk], bfr[kk], d, 0, 0, 0);
                float s = 0.f;
#pragma unroll
                for (int g = 0; g < 4; ++g) { const f32x4 w4 = *(const LAS f32x4*)(wvl + (2 * pr + hi) * 16 + 4 * g);
                    s += fmaxf(d[4 * g], 0.f) * w4.x; s += fmaxf(d[4 * g + 1], 0.f) * w4.y; s += fmaxf(d[4 * g + 2], 0.f) * w4.z; s += fmaxf(d[4 * g + 3], 0.f) * w4.w; }
                const unsigned short hb = __half_as_ushort(__float2half_rn(s));
                const unsigned short key = (hb & 0x8000u) ? (unsigned short)~hb : (unsigned short)(hb | 0x8000u);
                sc[(2 * pr + hi) * 8192 + key0 + r32] = key;
            }
        }
        __syncthreads();
        const LAS unsigned short* my = sc + C.wave * 8192;
        unsigned thr = 0;
        {
            unsigned want = 256u, prefix = 0u;
#pragma unroll 1
            for (int lvl = 0; lvl < 2; ++lvl) {
                hist[lane] = 0u; hist[64 + lane] = 0u; hist[128 + lane] = 0u; hist[192 + lane] = 0u;
                LDS_WAIT(); asm volatile("" ::: "memory");
                for (int i = 0; i < nadm / 64; ++i) { const unsigned k = my[64 * i + lane];
                    if (lvl == 0) atomicAdd((unsigned*)&hist[k >> 8], 1u); else if ((k >> 8) == prefix) atomicAdd((unsigned*)&hist[k & 255u], 1u); }
                LDS_WAIT(); asm volatile("" ::: "memory");
                const unsigned c0 = hist[4 * lane], c1 = hist[4 * lane + 1], c2 = hist[4 * lane + 2], c3 = hist[4 * lane + 3];
                const unsigned tl = c0 + c1 + c2 + c3; unsigned inc = tl;
#pragma unroll
                for (int o = 1; o < 64; o <<= 1) { const unsigned v = __shfl_down(inc, o); if (lane + o < 64) inc += v; }
                const unsigned ab3 = inc - tl, ab2 = ab3 + c3, ab1 = ab2 + c2, ab0 = ab1 + c1;
                int selb = -1; unsigned rem = 0;
                if (ab3 < want && ab3 + c3 >= want) { selb = 3; rem = want - ab3; }
                else if (ab2 < want && ab2 + c2 >= want) { selb = 2; rem = want - ab2; }
                else if (ab1 < want && ab1 + c1 >= want) { selb = 1; rem = want - ab1; }
                else if (ab0 < want && ab0 + c0 >= want) { selb = 0; rem = want - ab0; }
                const u64 bal = __ballot(selb >= 0); const int src = bal ? (int)__ffsll((long long)bal) - 1 : 0;
                const unsigned bin = (unsigned)__shfl(4 * lane + (selb < 0 ? 0 : selb), src); want = (unsigned)__shfl((int)rem, src);
                if (lvl == 0) prefix = bin; else thr = (prefix << 8) | bin;
                LDS_WAIT(); asm volatile("" ::: "memory");
            }
        }
        u64 w0 = 0, w1 = 0;
        for (int i = 0; i < nadm / 64; ++i) { const unsigned k = my[64 * i + lane]; const u64 bal = __ballot(k >= thr);
            if (i < 64) { if (lane == i) w0 = bal; } else { if (lane == i - 64) w1 = bal; } }
        MASK[(size_t)qrow * 128 + lane] = w0; MASK[(size_t)qrow * 128 + 64 + lane] = w1;
        __syncthreads();
    }
}
constexpr int AT_KROW = 272, AT_VROW = 136, AT_KB = 64 * AT_KROW, AT_VB = 128 * AT_VROW, AT_BUF = AT_KB + AT_VB;
__device__ __forceinline__ void attn_unit(const Ctx& C, int b, int head, int qb) {
    const bf16* Q = (const bf16*)(C.ws + WS_Q); const bf16* K = (const bf16*)(C.ws + WS_K); const bf16* Vt = (const bf16*)(C.ws + WS_VT);
    const u64* MASK = (const u64*)(C.ws + WS_MASK); bf16* CAT = (bf16*)(C.ws + WS_CAT);
    const int tid = C.tid, lane = C.lane, wid = C.wave, r32 = lane & 31, hi = lane >> 5;
    const int q = 256 * qb + 32 * wid + r32; const size_t row = (size_t)b * T + q;
    const int nt = 4 * qb + 4, myc = 4 * qb + (wid >> 1);
    bf16x8 qf[8];
#pragma unroll
    for (int d0 = 0; d0 < 8; ++d0) qf[d0] = *(const bf16x8*)(Q + row * 1024 + head * 128 + 16 * d0 + 8 * hi);
    const bf16* kg[2]; const bf16* vg[2]; int kl[2], vl[2];
#pragma unroll
    for (int i = 0; i < 2; ++i) { const int c = tid + 512 * i;
        kg[i] = K + ((size_t)b * T + (c >> 4)) * 1024 + head * 128 + (c & 15) * 8; kl[i] = (c >> 4) * AT_KROW + (c & 15) * 16;
        vg[i] = Vt + ((size_t)(b * 8 + head) * 128 + (c >> 3)) * T + (c & 7) * 8; vl[i] = AT_KB + (c >> 3) * AT_VROW + (c & 7) * 16; }
    u32x4 kr[2], vr[2];
#pragma unroll
    for (int i = 0; i < 2; ++i) { kr[i] = *(const u32x4*)kg[i]; vr[i] = *(const u32x4*)vg[i]; }
#pragma unroll
    for (int i = 0; i < 2; ++i) { *(LAS u32x4*)(C.lds + kl[i]) = kr[i]; *(LAS u32x2*)(C.lds + vl[i]) = (u32x2){vr[i].x, vr[i].y}; *(LAS u32x2*)(C.lds + vl[i] + 8) = (u32x2){vr[i].z, vr[i].w}; }
    __syncthreads();
    float lrun = 0.f; f32x16 o[4];
#pragma unroll
    for (int db = 0; db < 4; ++db)
#pragma unroll
        for (int r = 0; r < 16; ++r) o[db][r] = 0.f;
    for (int t = 0; t < nt; ++t) {
        const int cur = (t & 1) * AT_BUF, nxt = ((t + 1) & 1) * AT_BUF;
        if (t + 1 < nt) {
#pragma unroll
            for (int i = 0; i < 2; ++i) { kr[i] = *(const u32x4*)(kg[i] + (size_t)(t + 1) * 64 * 1024); vr[i] = *(const u32x4*)(vg[i] + (t + 1) * 64); }
        }
        if (t <= myc) {
            const u64 mw = MASK[row * 128 + t];
            const LAS unsigned char* Ks = C.lds + cur; const LAS unsigned char* Vs = C.lds + cur + AT_KB;
            f32x16 p0, p1;
#pragma unroll
            for (int r = 0; r < 16; ++r) { p0[r] = 0.f; p1[r] = 0.f; }
#pragma unroll
            for (int d0 = 0; d0 < 8; ++d0) {
                const bf16x8 k0 = *(const LAS bf16x8*)(Ks + r32 * AT_KROW + (16 * d0 + 8 * hi) * 2);
                const bf16x8 k1 = *(const LAS bf16x8*)(Ks + (32 + r32) * AT_KROW + (16 * d0 + 8 * hi) * 2);
                p0 = __builtin_amdgcn_mfma_f32_32x32x16_bf16(k0, qf[d0], p0, 0, 0, 0);
                p1 = __builtin_amdgcn_mfma_f32_32x32x16_bf16(k1, qf[d0], p1, 0, 0, 0);
            }
            const int mlo = (int)((unsigned)mw >> (4 * hi)), mhi = (int)((unsigned)(mw >> 32) >> (4 * hi));
            float ls0 = 0.f, ls1 = 0.f;
#pragma unroll
            for (int r = 0; r < 16; ++r) { const int c = (r & 3) + 8 * (r >> 2);
                const unsigned e0 = __float_as_uint(__builtin_amdgcn_exp2f(p0[r])) & (unsigned)__builtin_amdgcn_sbfe(mlo, c, 1);
                const unsigned e1 = __float_as_uint(__builtin_amdgcn_exp2f(p1[r])) & (unsigned)__builtin_amdgcn_sbfe(mhi, c, 1);
                p0[r] = __uint_as_float(e0); p1[r] = __uint_as_float(e1); ls0 += p0[r]; ls1 += p1[r]; }
            lrun += ls0 + ls1;
            bf16x8 pb[4];
#pragma unroll
            for (int kk = 0; kk < 4; ++kk) { u32x4 w;
#pragma unroll
                for (int e = 0; e < 4; ++e) { const int r = 8 * (kk & 1) + 2 * e; w[e] = (kk < 2) ? pg8::cvt_pk_bf16(p0[r], p0[r + 1]) : pg8::cvt_pk_bf16(p1[r], p1[r + 1]); }
                pb[kk] = __builtin_bit_cast(bf16x8, w); }
#pragma unroll
            for (int db = 0; db < 4; ++db)
#pragma unroll
                for (int kk = 0; kk < 4; ++kk) {
                    const LAS unsigned char* vp = Vs + (32 * db + r32) * AT_VROW + (16 * kk + 4 * hi) * 2;
                    const u32x2 a0 = *(const LAS u32x2*)vp, a1 = *(const LAS u32x2*)(vp + 16);
                    const u32x4 w = {a0.x, a0.y, a1.x, a1.y};
                    o[db] = __builtin_amdgcn_mfma_f32_32x32x16_bf16(__builtin_bit_cast(bf16x8, w), pb[kk], o[db], 0, 0, 0);
                }
        }
        if (t + 1 < nt) {
#pragma unroll
            for (int i = 0; i < 2; ++i) { *(LAS u32x4*)(C.lds + nxt + kl[i]) = kr[i]; *(LAS u32x2*)(C.lds + nxt + vl[i]) = (u32x2){vr[i].x, vr[i].y}; *(LAS u32x2*)(C.lds + nxt + vl[i] + 8) = (u32x2){vr[i].z, vr[i].w}; }
        }
        __syncthreads();
    }
    lrun += __shfl_xor(lrun, 32);
    const float inv = 1.0f / lrun;
    bf16* op = CAT + row * 2048 + head * 128 + 4 * hi;
#pragma unroll
    for (int db = 0; db < 4; ++db)
#pragma unroll
        for (int g = 0; g < 4; ++g) { u32x2 w; w.x = pk2(o[db][4 * g] * inv, o[db][4 * g + 1] * inv); w.y = pk2(o[db][4 * g + 2] * inv, o[db][4 * g + 3] * inv);
            *(u32x2*)(op + 32 * db + 8 * g) = w; }
}
__device__ __forceinline__ void phase_attn(const Ctx& C) {
    for (int i = C.bid; i < 1024; i += C.G) {
        const int w = i & 255, k = i >> 8, combo = w >> 3, j = w & 7;
        const int qb = k == 0 ? j : k == 1 ? 15 - j : k == 2 ? 16 + j : 31 - j;
        attn_unit(C, combo >> 3, combo & 7, qb);
        __syncthreads();
    }
}
__device__ __forceinline__ float ret_logg(int h) { return log1pf(-exp2f(-5.0f - (float)h)); }
constexpr int RT_KS = 68;
__device__ __forceinline__ void phase_ret1(const Ctx& C) {
    LAS float* Ks = (LAS float*)C.lds;
    LAS float* Vs = (LAS float*)(C.lds + 64 * RT_KS * 4);
    const bf16* BK = (const bf16*)(C.ws + WS_BK); const bf16* BV = (const bf16*)(C.ws + WS_BV); float* KV = (float*)(C.ws + WS_KVST);
    const int tid = C.tid;
    for (int u = C.bid; u < NB * 128 * 4; u += C.G) {
        const int h = u & 3, c = (u >> 2) & 127, b = u >> 9; const size_t row0 = (size_t)b * T + 64 * c; const float lg = ret_logg(h);
        { const int m = tid >> 3, d8 = (tid & 7) * 8; const u32x4 w = *(const u32x4*)(BK + (row0 + m) * 256 + h * 64 + d8); const float z = __expf((63.0f - (float)m) * lg) * 0.125f;
#pragma unroll
          for (int e = 0; e < 4; ++e) { Ks[m * RT_KS + d8 + 2 * e] = bflo(w[e]) * z; Ks[m * RT_KS + d8 + 2 * e + 1] = bfhi(w[e]) * z; } }
#pragma unroll
        for (int i = 0; i < 2; ++i) { const int cidx = tid + 512 * i, m = cidx >> 4, e8 = (cidx & 15) * 8; const u32x4 w = *(const u32x4*)(BV + (row0 + m) * 512 + h * 128 + e8);
#pragma unroll
          for (int e = 0; e < 4; ++e) { Vs[m * 128 + e8 + 2 * e] = bflo(w[e]); Vs[m * 128 + e8 + 2 * e + 1] = bfhi(w[e]); } }
        __syncthreads();
        const int d = tid & 63, eg = tid >> 6; float acc[16];
#pragma unroll
        for (int e = 0; e < 16; ++e) acc[e] = 0.f;
        for (int m = 0; m < 64; ++m) { const float kv = Ks[m * RT_KS + d];
#pragma unroll
            for (int e4 = 0; e4 < 4; ++e4) { const f32x4 v = *(const LAS f32x4*)(Vs + m * 128 + 16 * eg + 4 * e4); acc[4 * e4] += kv * v.x; acc[4 * e4 + 1] += kv * v.y; acc[4 * e4 + 2] += kv * v.z; acc[4 * e4 + 3] += kv * v.w; } }
        float* dst = KV + (size_t)u * 8192 + d * 128 + 16 * eg;
#pragma unroll
        for (int e4 = 0; e4 < 4; ++e4) *(f32x4*)(dst + 4 * e4) = (f32x4){acc[4 * e4], acc[4 * e4 + 1], acc[4 * e4 + 2], acc[4 * e4 + 3]};
        __syncthreads();
    }
}
__device__ __forceinline__ void phase_ret2(const Ctx& C) {
    float* KV = (float*)(C.ws + WS_KVST);
    for (int g = C.bid * NTHR + C.tid; g < NB * 4 * 8192; g += C.G * NTHR) {
        const int el = g & 8191, h = (g >> 13) & 3, b = g >> 15; const float gc = __expf(64.0f * ret_logg(h));
        float* p = KV + ((size_t)b * 512 + h) * 8192 + el;
        float st = 0.f;
        for (int c0 = 0; c0 < 128; c0 += 8) { float x[8];
#pragma unroll
            for (int i = 0; i < 8; ++i) x[i] = p[(size_t)(c0 + i) * 4 * 8192];
#pragma unroll
            for (int i = 0; i < 8; ++i) { p[(size_t)(c0 + i) * 4 * 8192] = st; st = st * gc + x[i]; } }
    }
}
__device__ __forceinline__ void phase_ret3(const Ctx& C) {
    LAS float* Qs = (LAS float*)C.lds;
    LAS float* Ks = Qs + 64 * RT_KS;
    LAS float* Sc = Ks + 64 * RT_KS;
    LAS float* Vs = Sc + 64 * RT_KS;
    LAS float* Ps = Vs + 64 * 128;
    const bf16* BQ = (const bf16*)(C.ws + WS_BQ); const bf16* BK = (const bf16*)(C.ws + WS_BK); const bf16* BV = (const bf16*)(C.ws + WS_BV); const bf16* BG = (const bf16*)(C.ws + WS_BG);
    const float* KV = (const float*)(C.ws + WS_KVST); bf16* CAT = (bf16*)(C.ws + WS_CAT);
    const int tid = C.tid;
    for (int u = C.bid; u < NB * 128 * 4; u += C.G) {
        const int h = u & 3, c = (u >> 2) & 127, b = u >> 9; const size_t row0 = (size_t)b * T + 64 * c; const float lg = ret_logg(h);
        { const int m = tid >> 3, d8 = (tid & 7) * 8; const u32x4 wq = *(const u32x4*)(BQ + (row0 + m) * 256 + h * 64 + d8), wk = *(const u32x4*)(BK + (row0 + m) * 256 + h * 64 + d8);
#pragma unroll
          for (int e = 0; e < 4; ++e) { Qs[m * RT_KS + d8 + 2 * e] = bflo(wq[e]); Qs[m * RT_KS + d8 + 2 * e + 1] = bfhi(wq[e]); Ks[m * RT_KS + d8 + 2 * e] = bflo(wk[e]) * 0.125f; Ks[m * RT_KS + d8 + 2 * e + 1] = bfhi(wk[e]) * 0.125f; } }
#pragma unroll
        for (int i = 0; i < 2; ++i) { const int cidx = tid + 512 * i, m = cidx >> 4, e8 = (cidx & 15) * 8; const u32x4 w = *(const u32x4*)(BV + (row0 + m) * 512 + h * 128 + e8);
#pragma unroll
          for (int e = 0; e < 4; ++e) { Vs[m * 128 + e8 + 2 * e] = bflo(w[e]); Vs[m * 128 + e8 + 2 * e + 1] = bfhi(w[e]); } }
#pragma unroll
        for (int i = 0; i < 4; ++i) { const int cidx = tid + 512 * i; *(LAS f32x4*)(Ps + 4 * cidx) = *(const f32x4*)(KV + (size_t)u * 8192 + 4 * cidx); }
        __syncthreads();
        {
            const int n = tid >> 3, mg = tid & 7; float s[8];
#pragma unroll
            for (int j = 0; j < 8; ++j) s[j] = 0.f;
            for (int d4 = 0; d4 < 16; ++d4) { const f32x4 qv = *(const LAS f32x4*)(Qs + n * RT_KS + 4 * d4);
#pragma unroll
                for (int j = 0; j < 8; ++j) { const f32x4 kv = *(const LAS f32x4*)(Ks + (mg + 8 * j) * RT_KS + 4 * d4); s[j] += (qv.x * kv.x + qv.y * kv.y) + (qv.z * kv.z + qv.w * kv.w); } }
#pragma unroll
            for (int j = 0; j < 8; ++j) { const int m = mg + 8 * j; Sc[n * RT_KS + m] = (m <= n) ? s[j] * __expf((float)(n - m) * lg) : 0.f; }
        }
        __syncthreads();
        {
            const int n = tid >> 3, eg = tid & 7; float acc[16], cr[16];
#pragma unroll
            for (int e = 0; e < 16; ++e) { acc[e] = 0.f; cr[e] = 0.f; }
            for (int m = 0; m <= n; ++m) { const float sv = Sc[n * RT_KS + m];
#pragma unroll
                for (int e4 = 0; e4 < 4; ++e4) { const f32x4 v = *(const LAS f32x4*)(Vs + m * 128 + 16 * eg + 4 * e4); acc[4 * e4] += sv * v.x; acc[4 * e4 + 1] += sv * v.y; acc[4 * e4 + 2] += sv * v.z; acc[4 * e4 + 3] += sv * v.w; } }
            for (int d = 0; d < 64; ++d) { const float qv = Qs[n * RT_KS + d];
#pragma unroll
                for (int e4 = 0; e4 < 4; ++e4) { const f32x4 v = *(const LAS f32x4*)(Ps + d * 128 + 16 * eg + 4 * e4); cr[4 * e4] += qv * v.x; cr[4 * e4 + 1] += qv * v.y; cr[4 * e4 + 2] += qv * v.z; cr[4 * e4 + 3] += qv * v.w; } }
            const float xi = __expf((float)(n + 1) * lg); float sum = 0.f;
#pragma unroll
            for (int e = 0; e < 16; ++e) { acc[e] += xi * cr[e]; sum += acc[e]; }
            sum += __shfl_xor(sum, 1); sum += __shfl_xor(sum, 2); sum += __shfl_xor(sum, 4);
            const float mu = sum * (1.0f / 128.0f); float var = 0.f;
#pragma unroll
            for (int e = 0; e < 16; ++e) { const float dlt = acc[e] - mu; var += dlt * dlt; }
            var += __shfl_xor(var, 1); var += __shfl_xor(var, 2); var += __shfl_xor(var, 4);
            const float rstd = rsqrtf(var * (1.0f / 128.0f) + 1e-5f);
            const bf16* gp = BG + (row0 + n) * 512 + h * 128 + 16 * eg; const u32x4 g0 = *(const u32x4*)gp, g1 = *(const u32x4*)(gp + 8);
            float gv[16];
#pragma unroll
            for (int e = 0; e < 4; ++e) { gv[2 * e] = bflo(g0[e]); gv[2 * e + 1] = bfhi(g0[e]); gv[8 + 2 * e] = bflo(g1[e]); gv[8 + 2 * e + 1] = bfhi(g1[e]); }
            float ov[16];
#pragma unroll
            for (int e = 0; e < 16; ++e) { const float gg = gv[e]; const float sl = gg * __builtin_amdgcn_rcpf(1.0f + __expf(-gg)); ov[e] = (acc[e] - mu) * rstd * sl; }
            bf16* op = CAT + (row0 + n) * 2048 + 1024 + h * 128 + 16 * eg;
            u32x4 w0, w1;
#pragma unroll
            for (int e = 0; e < 4; ++e) { w0[e] = pk2(ov[2 * e], ov[2 * e + 1]); w1[e] = pk2(ov[8 + 2 * e], ov[8 + 2 * e + 1]); }
            *(u32x4*)op = w0; *(u32x4*)(op + 8) = w1;
        }
        __syncthreads();
    }
}
__device__ __forceinline__ float sigmoidf_(float x) { return __builtin_amdgcn_rcpf(1.0f + __expf(-x)); }
constexpr int RW_AW = 104, RW_AV = 72, RW_AG = 264;
__device__ __forceinline__ void ld4bf(const bf16* p, float (&v)[4]) { const u32x2 w = *(const u32x2*)p; v[0] = bflo(w.x); v[1] = bfhi(w.x); v[2] = bflo(w.y); v[3] = bfhi(w.y); }
__device__ __forceinline__ void shift4(const bf16* buf, size_t m, int ld, int c4, bool first, const float* mu, float (&o)[4]) {
    float cur[4], prv[4] = {0.f, 0.f, 0.f, 0.f}; ld4bf(buf + m * ld + c4, cur); if (!first) ld4bf(buf + (m - 1) * ld + c4, prv);
    const f32x4 muv = *(const f32x4*)mu;
#pragma unroll
    for (int e = 0; e < 4; ++e) o[e] = cur[e] + (prv[e] - cur[e]) * muv[e];
}
struct RwP { const float *mu, *mu_v, *w0, *a0, *v0, *k_k, *k_a, *r_k, *lnx_g, *lnx_b; };
__device__ __forceinline__ void phase_rw1(const Ctx& C, int layer, const RwP& P) {
    LAS bf16* AW = (LAS bf16*)C.lds; LAS bf16* AA = AW + 32 * RW_AW; LAS bf16* AV = AA + 32 * RW_AW;
    const bf16* CR = (const bf16*)(C.ws + WS_CR); const bf16* CK = (const bf16*)(C.ws + WS_CK); const bf16* CV = (const bf16*)(C.ws + WS_CV); const bf16* CL = (const bf16*)(C.ws + WS_CL);
    const bf16* LW = (const bf16*)(C.ws + WS_LORA + LO_W); const bf16* LA = (const bf16*)(C.ws + WS_LORA + LO_A); const bf16* LV = (const bf16*)(C.ws + WS_LORA + LO_V);
    bf16* VF = (bf16*)(C.ws + WS_VFIRST);
    float* RR = (float*)(C.ws + WS_RR); float* RWd = (float*)(C.ws + WS_RW); float* RKH = (float*)(C.ws + WS_RKH); float* RV = (float*)(C.ws + WS_RV); float* RA = (float*)(C.ws + WS_RA); float* RB = (float*)(C.ws + WS_RB);
    const float* mu = P.mu + (size_t)layer * 1984; const float* mu_v = P.mu_v;
    const float* w0 = P.w0 + layer * 512; const float* a0 = P.a0 + layer * 512; const float* v0 = P.v0; const float* k_k = P.k_k + layer * 512; const float* k_a = P.k_a + layer * 512;
    const int tid = C.tid, lane = C.lane, wid = C.wave;
    for (int u = C.bid; u < M / 32; u += C.G) {
        int r32 = lane & 31, hi = lane >> 5; asm volatile("" : "+v"(r32), "+v"(hi));
        const size_t m0 = (size_t)u * 32;
        for (int idx = tid; idx < 32 * 256; idx += NTHR) {
            const int tok = idx >> 8, c = idx & 255; const size_t m = m0 + tok; const bool first = (m & (T - 1)) == 0;
            const float cur = bf2f(CL[m * 256 + c]); const float prv = first ? 0.f : bf2f(CL[(m - 1) * 256 + c]);
            const float muc = c < 192 ? mu[1536 + c] : (layer > 0 ? mu_v[c - 192] : 0.f);
            const float xs = cur + (prv - cur) * muc;
            if (c < 96) AW[tok * RW_AW + c] = (bf16)f2bf(tanhf(xs)); else if (c < 192) AA[tok * RW_AW + (c - 96)] = (bf16)f2bf(xs); else AV[tok * RW_AV + (c - 192)] = (bf16)f2bf(xs);
        }
        __syncthreads();
        const size_t m = m0 + r32; const bool first = (m & (T - 1)) == 0;
        float ss = 0.f;
#pragma unroll
        for (int cb = 0; cb < 2; ++cb)
#pragma unroll
            for (int g = 0; g < 4; ++g) { const int c4 = 64 * wid + 32 * cb + 8 * g + 4 * hi; float ks[4]; shift4(CK, m, 512, c4, first, mu + 512 + c4, ks); const f32x4 kkv = *(const f32x4*)(k_k + c4);
#pragma unroll
                for (int e = 0; e < 4; ++e) { const float kr = ks[e] * kkv[e]; ss += kr * kr; } }
        ss += __shfl_xor(ss, 32);
        const float inv = 1.0f / fmaxf(sqrtf(ss), 1e-12f);
#pragma unroll
        for (int cb = 0; cb < 2; ++cb) {
            f32x16 dw, da, dv;
#pragma unroll
            for (int r = 0; r < 16; ++r) { dw[r] = 0.f; da[r] = 0.f; dv[r] = 0.f; }
            const int ch = 64 * wid + 32 * cb + r32;
#pragma unroll
            for (int kk = 0; kk < 6; ++kk) {
                const bf16x8 aw = *(const bf16x8*)(LW + ch * 96 + 16 * kk + 8 * hi), aa = *(const bf16x8*)(LA + ch * 96 + 16 * kk + 8 * hi);
                const bf16x8 bw = *(const LAS bf16x8*)(AW + r32 * RW_AW + 16 * kk + 8 * hi), ba = *(const LAS bf16x8*)(AA + r32 * RW_AW + 16 * kk + 8 * hi);
                dw = __builtin_amdgcn_mfma_f32_32x32x16_bf16(aw, bw, dw, 0, 0, 0); da = __builtin_amdgcn_mfma_f32_32x32x16_bf16(aa, ba, da, 0, 0, 0);
            }
            if (layer > 0) {
#pragma unroll
                for (int kk = 0; kk < 4; ++kk) {
                    const bf16x8 av = *(const bf16x8*)(LV + ch * 64 + 16 * kk + 8 * hi); const bf16x8 bv = *(const LAS bf16x8*)(AV + r32 * RW_AV + 16 * kk + 8 * hi);
                    dv = __builtin_amdgcn_mfma_f32_32x32x16_bf16(av, bv, dv, 0, 0, 0);
                }
            }
#pragma unroll
            for (int g = 0; g < 4; ++g) {
                const int c4 = 64 * wid + 32 * cb + 8 * g + 4 * hi;
                float rs[4], vs[4], ks[4];
                shift4(CR, m, 512, c4, first, mu + c4, rs); shift4(CV, m, 512, c4, first, mu + 1024 + c4, vs); shift4(CK, m, 512, c4, first, mu + 512 + c4, ks);
                const f32x4 w0v = *(const f32x4*)(w0 + c4), a0v = *(const f32x4*)(a0 + c4), kkv = *(const f32x4*)(k_k + c4), kav = *(const f32x4*)(k_a + c4);
                f32x4 vo, wo, kho, ao, bo;
                if (layer > 0) { float vf[4]; ld4bf(VF + m * 512 + c4, vf); const f32x4 v0v = *(const f32x4*)(v0 + c4);
#pragma unroll
                    for (int e = 0; e < 4; ++e) vo[e] = vs[e] + (vf[e] - vs[e]) * sigmoidf_(v0v[e] + dv[4 * g + e]); }
                else { u32x2 w; w.x = pk2(vs[0], vs[1]); w.y = pk2(vs[2], vs[3]); *(u32x2*)(VF + m * 512 + c4) = w;
#pragma unroll
                    for (int e = 0; e < 4; ++e) vo[e] = vs[e]; }
#pragma unroll
                for (int e = 0; e < 4; ++e) {
                    const float x = w0v[e] + dw[4 * g + e];
                    const float z = -x; const float sp = fmaxf(z, 0.f) + log1pf(__expf(-fabsf(z)));
                    wo[e] = __expf(-__expf(-sp - 0.5f));
                    const float a = sigmoidf_(a0v[e] + da[4 * g + e]);
                    const float ksx = ks[e]; const float kk = ksx * kkv[e] * inv;
                    kho[e] = ksx * (1.0f + (a - 1.0f) * kav[e]); ao[e] = -kk; bo[e] = kk * a;
                }
                *(f32x4*)(RR + m * 512 + c4) = (f32x4){rs[0], rs[1], rs[2], rs[3]}; *(f32x4*)(RWd + m * 512 + c4) = wo; *(f32x4*)(RKH + m * 512 + c4) = kho; *(f32x4*)(RV + m * 512 + c4) = vo;
                *(f32x4*)(RA + m * 512 + c4) = ao; *(f32x4*)(RB + m * 512 + c4) = bo;
            }
        }
        __syncthreads();
    }
}
constexpr int RW_L = 128, RW_NC = T / RW_L;
constexpr int RW_TB = 8, RW_STG = 6 * RW_TB * 64;
__device__ __forceinline__ float xhalf_sum(float x) { const auto rr = __builtin_amdgcn_permlane32_swap(__float_as_uint(x), __float_as_uint(x), false, false); return __uint_as_float(rr[0]) + __uint_as_float(rr[1]); }
template <int NS, bool OUT>
__device__ __forceinline__ void rwkv_chunk(f32x16 (&D)[NS][2][2], LAS float* stg, const float* RWd, const float* RA, const float* RB, const float* RKH, const float* RV, const float* RR, float* Y, size_t base0, int nsteps, int lane) {
    const int r32 = lane & 31, hi = lane >> 5;
    for (int t0 = 0; t0 < nsteps; t0 += RW_TB) {
        {
            float tw[RW_TB], ta[RW_TB], tr[RW_TB], tb[RW_TB], tk[RW_TB], tv[RW_TB];
#pragma unroll
            for (int s = 0; s < RW_TB; ++s) { const size_t o = base0 + (size_t)(t0 + s) * 512 + lane; tw[s] = RWd[o]; ta[s] = RA[o]; tr[s] = OUT ? RR[o] : 0.f; tb[s] = RB[o]; tk[s] = RKH[o]; tv[s] = RV[o]; }
#pragma unroll
            for (int s = 0; s < RW_TB; ++s) { stg[(0 * RW_TB + s) * 64 + lane] = tw[s]; stg[(1 * RW_TB + s) * 64 + lane] = ta[s]; if (OUT) stg[(2 * RW_TB + s) * 64 + lane] = tr[s];
                stg[(3 * RW_TB + s) * 64 + lane] = tb[s]; stg[(4 * RW_TB + s) * 64 + lane] = tk[s]; stg[(5 * RW_TB + s) * 64 + lane] = tv[s]; }
        }
        LDS_WAIT(); asm volatile("" ::: "memory");
#pragma unroll 1
        for (int s = 0; s < RW_TB; ++s) {
            const LAS float* sw = stg + (0 * RW_TB + s) * 64 + 4 * hi; const LAS float* sa_ = stg + (1 * RW_TB + s) * 64 + 4 * hi; const LAS float* sr = stg + (2 * RW_TB + s) * 64 + 4 * hi;
            const LAS float* sbk = stg + ((hi ? 4 : 3) * RW_TB + s) * 64 + r32; const LAS float* sv = stg + (5 * RW_TB + s) * 64 + r32;
            const float bk0 = sbk[0], bk1 = sbk[32], v0 = sv[0], v1 = sv[32];
            float sav[NS][2];
            {
                f32x4 av[2][4];
#pragma unroll
                for (int jb = 0; jb < 2; ++jb)
#pragma unroll
                    for (int g = 0; g < 4; ++g) av[jb][g] = *(const LAS f32x4*)(sa_ + 32 * jb + 8 * g);
#pragma unroll
                for (int st = 0; st < NS; ++st)
#pragma unroll
                    for (int ib = 0; ib < 2; ++ib) { float p0 = 0.f, p1 = 0.f;
#pragma unroll
                        for (int jb = 0; jb < 2; ++jb)
#pragma unroll
                            for (int g = 0; g < 4; ++g) { const f32x16& d = D[st][jb][ib]; p0 += d[4 * g] * av[jb][g].x; p1 += d[4 * g + 1] * av[jb][g].y; p0 += d[4 * g + 2] * av[jb][g].z; p1 += d[4 * g + 3] * av[jb][g].w; }
                        sav[st][ib] = xhalf_sum(p0 + p1); }
            }
            {
                f32x4 wv[2][4];
#pragma unroll
                for (int jb = 0; jb < 2; ++jb)
#pragma unroll
                    for (int g = 0; g < 4; ++g) wv[jb][g] = *(const LAS f32x4*)(sw + 32 * jb + 8 * g);
#pragma unroll
                for (int st = 0; st < NS; ++st)
#pragma unroll
                    for (int jb = 0; jb < 2; ++jb)
#pragma unroll
                        for (int ib = 0; ib < 2; ++ib)
#pragma unroll
                            for (int g = 0; g < 4; ++g) { f32x16& d = D[st][jb][ib]; d[4 * g] *= wv[jb][g].x; d[4 * g + 1] *= wv[jb][g].y; d[4 * g + 2] *= wv[jb][g].z; d[4 * g + 3] *= wv[jb][g].w; }
            }
#pragma unroll
            for (int st = 0; st < NS; ++st) {
                const bool inject = (NS == 1) || (st == 1);
#pragma unroll
                for (int jb = 0; jb < 2; ++jb) { const float bkj = jb == 0 ? bk0 : bk1; const float A = inject ? bkj : (hi ? 0.f : bkj);
#pragma unroll
                    for (int ib = 0; ib < 2; ++ib) { const float B = hi ? (ib == 0 ? v0 : v1) : sav[st][ib];
                        D[st][jb][ib] = __builtin_amdgcn_mfma_f32_32x32x2f32(A, B, D[st][jb][ib], 0, 0, 0); } }
            }
            if (OUT) {
                f32x4 rv[2][4];
#pragma unroll
                for (int jb = 0; jb < 2; ++jb)
#pragma unroll
                    for (int g = 0; g < 4; ++g) rv[jb][g] = *(const LAS f32x4*)(sr + 32 * jb + 8 * g);
#pragma unroll
                for (int ib = 0; ib < 2; ++ib) { float p0 = 0.f, p1 = 0.f;
#pragma unroll
                    for (int jb = 0; jb < 2; ++jb)
#pragma unroll
                        for (int g = 0; g < 4; ++g) { const f32x16& d = D[NS - 1][jb][ib]; p0 += d[4 * g] * rv[jb][g].x; p1 += d[4 * g + 1] * rv[jb][g].y; p0 += d[4 * g + 2] * rv[jb][g].z; p1 += d[4 * g + 3] * rv[jb][g].w; }
                    const float y = xhalf_sum(p0 + p1);
                    if (hi == 0) Y[base0 + (size_t)(t0 + s) * 512 + 32 * ib + r32] = y; }
            }
        }
        LDS_WAIT(); asm volatile("" ::: "memory");
    }
}
__device__ __forceinline__ void phase_rw2(const Ctx& C) {
    const float* RWd = (const float*)(C.ws + WS_RW); const float* RA = (const float*)(C.ws + WS_RA); const float* RB = (const float*)(C.ws + WS_RB); const float* RKH = (const float*)(C.ws + WS_RKH); const float* RV = (const float*)(C.ws + WS_RV);
    float* PHI = (float*)(C.ws + WS_PHI); float* PSI = (float*)(C.ws + WS_PSI);
    LAS float* stg = (LAS float*)C.lds + C.wave * RW_STG;
    const int ntask = NB * 8 * RW_NC, r32 = C.lane & 31, hi = C.lane >> 5;
    for (int task = C.wave * C.G + C.bid; task < ntask; task += C.G * NWAVES) {
        const int ck = task % RW_NC, bh = task / RW_NC, h = bh & 7, b = bh >> 3;
        const size_t base0 = ((size_t)b * T + (size_t)ck * RW_L) * 512 + h * 64;
        f32x16 D[2][2][2];
#pragma unroll
        for (int jb = 0; jb < 2; ++jb)
#pragma unroll
            for (int ib = 0; ib < 2; ++ib)
#pragma unroll
                for (int r = 0; r < 16; ++r) { D[0][jb][ib][r] = (jb == ib && ((r & 3) + 8 * (r >> 2) + 4 * hi) == r32) ? 1.f : 0.f; D[1][jb][ib][r] = 0.f; }
        rwkv_chunk<2, false>(D, stg, RWd, RA, RB, RKH, RV, nullptr, nullptr, base0, RW_L, C.lane);
#pragma unroll
        for (int st = 0; st < 2; ++st) { float* dst = (st == 0 ? PHI : PSI) + (size_t)task * 4096;
#pragma unroll
            for (int jb = 0; jb < 2; ++jb)
#pragma unroll
                for (int ib = 0; ib < 2; ++ib)
#pragma unroll
                    for (int g = 0; g < 4; ++g) *(f32x4*)(dst + (32 * ib + r32) * 64 + 32 * jb + 8 * g + 4 * hi) = (f32x4){D[st][jb][ib][4 * g], D[st][jb][ib][4 * g + 1], D[st][jb][ib][4 * g + 2], D[st][jb][ib][4 * g + 3]}; }
    }
}
constexpr int R3_P = 65;
__device__ __forceinline__ void phase_rw3(const Ctx& C) {
    const float* PHI = (const float*)(C.ws + WS_PHI); const float* PSI = (const float*)(C.ws + WS_PSI); float* SST = (float*)(C.ws + WS_SST);
    const int half = C.wave >> 2, w4 = C.wave & 3, ibo = w4 >> 1, kb = w4 & 1, r32 = C.lane & 31, hi = C.lane >> 5;
    LAS float* Sl = (LAS float*)C.lds + half * (2 * 64 * R3_P);
    for (int pr = C.bid; pr < NB * 8 / 2; pr += C.G) {
        const int bh = 2 * pr + half;
        f32x16 acc;
#pragma unroll
        for (int r = 0; r < 16; ++r) acc[r] = 0.f;
        for (int ck = 0; ck < RW_NC; ++ck) {
            const size_t task = (size_t)bh * RW_NC + ck; LAS float* Sb = Sl + (ck & 1) * (64 * R3_P);
            float* dst = SST + task * 4096;
#pragma unroll
            for (int r = 0; r < 16; ++r) { const int i = 32 * ibo + (r & 3) + 8 * (r >> 2) + 4 * hi; dst[i * 64 + 32 * kb + r32] = acc[r]; Sb[i * R3_P + 32 * kb + r32] = acc[r]; }
            if (ck + 1 == RW_NC) break;
            float ph[32];
#pragma unroll
            for (int s = 0; s < 32; ++s) ph[s] = PHI[task * 4096 + (2 * s + hi) * 64 + 32 * kb + r32];
#pragma unroll
            for (int r = 0; r < 16; ++r) { const int i = 32 * ibo + (r & 3) + 8 * (r >> 2) + 4 * hi; acc[r] = PSI[task * 4096 + i * 64 + 32 * kb + r32]; }
            __syncthreads();
#pragma unroll
            for (int s = 0; s < 32; ++s) { const float a = Sb[(32 * ibo + r32) * R3_P + 2 * s + hi]; acc = __builtin_amdgcn_mfma_f32_32x32x2f32(a, ph[s], acc, 0, 0, 0); }
        }
        __syncthreads();
    }
}
__device__ __forceinline__ void phase_rw4(const Ctx& C) {
    const float* RWd = (const float*)(C.ws + WS_RW); const float* RA = (const float*)(C.ws + WS_RA); const float* RB = (const float*)(C.ws + WS_RB); const float* RKH = (const float*)(C.ws + WS_RKH); const float* RV = (const float*)(C.ws + WS_RV); const float* RR = (const float*)(C.ws + WS_RR);
    const float* SST = (const float*)(C.ws + WS_SST); float* Y = (float*)(C.ws + WS_Y);
    LAS float* stg = (LAS float*)C.lds + C.wave * RW_STG;
    const int ntask = NB * 8 * RW_NC, r32 = C.lane & 31, hi = C.lane >> 5;
    for (int task = C.wave * C.G + C.bid; task < ntask; task += C.G * NWAVES) {
        const int ck = task % RW_NC, bh = task / RW_NC, h = bh & 7, b = bh >> 3;
        const size_t base0 = ((size_t)b * T + (size_t)ck * RW_L) * 512 + h * 64;
        f32x16 D[1][2][2]; const float* src = SST + (size_t)task * 4096;
#pragma unroll
        for (int jb = 0; jb < 2; ++jb)
#pragma unroll
            for (int ib = 0; ib < 2; ++ib)
#pragma unroll
                for (int g = 0; g < 4; ++g) { const f32x4 v = *(const f32x4*)(src + (32 * ib + r32) * 64 + 32 * jb + 8 * g + 4 * hi); D[0][jb][ib][4 * g] = v.x; D[0][jb][ib][4 * g + 1] = v.y; D[0][jb][ib][4 * g + 2] = v.z; D[0][jb][ib][4 * g + 3] = v.w; }
        rwkv_chunk<1, true>(D, stg, RWd, RA, RB, RKH, RV, RR, Y, base0, RW_L, C.lane);
    }
}
__device__ __forceinline__ void phase_rw5(const Ctx& C, int layer, const RwP& P) {
    LAS bf16* AG = (LAS bf16*)C.lds;
    const bf16* CG = (const bf16*)(C.ws + WS_CG); const bf16* LG = (const bf16*)(C.ws + WS_LORA + LO_G);
    const float* Y = (const float*)(C.ws + WS_Y); const float* RR = (const float*)(C.ws + WS_RR); const float* RKH = (const float*)(C.ws + WS_RKH); const float* RV = (const float*)(C.ws + WS_RV);
    bf16* CAT = (bf16*)(C.ws + WS_CAT);
    const float* mu = P.mu + (size_t)layer * 1984 + 1728; const float* r_k = P.r_k + layer * 512; const float* lnx_g = P.lnx_g + layer * 512; const float* lnx_b = P.lnx_b + layer * 512;
    const int tid = C.tid, lane = C.lane, wid = C.wave;
    for (int u = C.bid; u < M / 32; u += C.G) {
        int r32 = lane & 31, hi = lane >> 5; asm volatile("" : "+v"(r32), "+v"(hi));
        const size_t m0 = (size_t)u * 32;
        for (int idx = tid; idx < 32 * 256; idx += NTHR) {
            const int tok = idx >> 8, c = idx & 255; const size_t m = m0 + tok; const bool first = (m & (T - 1)) == 0;
            const float cur = bf2f(CG[m * 256 + c]); const float prv = first ? 0.f : bf2f(CG[(m - 1) * 256 + c]);
            AG[tok * RW_AG + c] = (bf16)f2bf(sigmoidf_(cur + (prv - cur) * mu[c]));
        }
        __syncthreads();
        f32x16 dg[2];
#pragma unroll
        for (int cb = 0; cb < 2; ++cb) {
#pragma unroll
            for (int r = 0; r < 16; ++r) dg[cb][r] = 0.f;
            const int ch = 64 * wid + 32 * cb + r32;
#pragma unroll
            for (int kk = 0; kk < 16; ++kk) {
                const bf16x8 ag = *(const bf16x8*)(LG + ch * 256 + 16 * kk + 8 * hi); const bf16x8 bg = *(const LAS bf16x8*)(AG + r32 * RW_AG + 16 * kk + 8 * hi);
                dg[cb] = __builtin_amdgcn_mfma_f32_32x32x16_bf16(ag, bg, dg[cb], 0, 0, 0);
            }
        }
        const size_t m = m0 + r32;
        float yv[32], vv[32]; float sy = 0.f, sb = 0.f;
#pragma unroll
        for (int cb = 0; cb < 2; ++cb)
#pragma unroll
            for (int g = 0; g < 4; ++g) { const int c4 = 64 * wid + 32 * cb + 8 * g + 4 * hi;
                const f32x4 y4 = *(const f32x4*)(Y + m * 512 + c4), r4 = *(const f32x4*)(RR + m * 512 + c4), k4 = *(const f32x4*)(RKH + m * 512 + c4), v4 = *(const f32x4*)(RV + m * 512 + c4), rk4 = *(const f32x4*)(r_k + c4);
#pragma unroll
                for (int e = 0; e < 4; ++e) { yv[16 * cb + 4 * g + e] = y4[e]; vv[16 * cb + 4 * g + e] = v4[e]; sy += y4[e]; sb += r4[e] * k4[e] * rk4[e]; } }
        sy += __shfl_xor(sy, 32); sb += __shfl_xor(sb, 32);
        const float mean = sy * (1.0f / 64.0f); float var = 0.f;
#pragma unroll
        for (int i = 0; i < 32; ++i) { const float d = yv[i] - mean; var += d * d; }
        var += __shfl_xor(var, 32);
        const float rstd = rsqrtf(var * (1.0f / 64.0f) + 64e-5f);
#pragma unroll
        for (int cb = 0; cb < 2; ++cb)
#pragma unroll
            for (int g = 0; g < 4; ++g) { const int c4 = 64 * wid + 32 * cb + 8 * g + 4 * hi;
                const f32x4 lg4 = *(const f32x4*)(lnx_g + c4), lb4 = *(const f32x4*)(lnx_b + c4); float o[4];
#pragma unroll
                for (int e = 0; e < 4; ++e) { const int i = 16 * cb + 4 * g + e; o[e] = ((yv[i] - mean) * rstd * lg4[e] + lb4[e] + sb * vv[i]) * dg[cb][4 * g + e]; }
                u32x2 w; w.x = pk2(o[0], o[1]); w.y = pk2(o[2], o[3]); *(u32x2*)(CAT + m * 2048 + 1536 + c4) = w; }
        __syncthreads();
    }
}
__device__ __forceinline__ void* launder_ptr(const void* p) {
    unsigned lo = (unsigned)(uintptr_t)p, hi = (unsigned)((uintptr_t)p >> 32); asm volatile("" : "+v"(lo), "+v"(hi));
    lo = __builtin_amdgcn_readfirstlane(lo); hi = __builtin_amdgcn_readfirstlane(hi); return (void*)(((uintptr_t)hi << 32) | lo);
}
#ifndef MK_PER_PHASE
#define MK_PER_PHASE 0
#endif
constexpr int PH_PER_LAYER = 17, N_PHASES = DEPTH * PH_PER_LAYER + 1;
struct Args { const float* in[23]; float* out; unsigned char* ws; int ph_lo, ph_hi; };
#define FRESH() do { KA = (const CAS Args*)launder_ptr((const void*)(uintptr_t)__builtin_amdgcn_kernarg_segment_ptr()); C.ws = KA->ws; C.out = KA->out; ctl = (unsigned*)(C.ws + WS_CTL); asm volatile("" : "+v"(C.tid)); C.lane = C.tid & 63; C.wave = __builtin_amdgcn_readfirstlane(C.tid >> 6); C.lds = (LAS unsigned char*)lds_raw; } while (0)
#ifndef REP_MASK
#define REP_MASK 0u
#endif
#ifndef ONLY_PH
#define ONLY_PH -1
#endif
#ifndef PH_MASK
#define PH_MASK 0xFFFFFFFFu
#endif
#define IN(k) (lo <= (k) && (k) < hi && (ONLY_PH < 0 || ((k) % PH_PER_LAYER) == ONLY_PH) && ((PH_MASK >> ((k) % PH_PER_LAYER)) & 1u))
#define SEAM(k) do { if (IN(k) && IN((k) + 1)) { bar.bar = ctl + CW_BAR; xcd_barrier(bar); } } while (0)
template <int layer>
__device__ __forceinline__ void layer_phases(Ctx& C, const CAS Args*& KA, XcdBarrier& bar, unsigned*& ctl, unsigned char* lds_raw, const int lo, const int hi) {
        const int p0 = layer * PH_PER_LAYER;
        const float* xin = layer == 0 ? KA->in[0] : C.out;
        FRESH(); if (IN(p0 + 0)) { { { const WSrc W{KA->in[2], KA->in[3], KA->in[18], KA->in[20], KA->in[21], KA->in[7], KA->in[9], KA->in[12], KA->in[11]}; phase_wconv(C, layer, W); } phase_norm_bf16(C, xin, KA->in[1] + layer * DM, (bf16*)(C.ws + WS_H)); }
            if ((REP_MASK >> 0) & 1u) { xcd_barrier(bar); FRESH(); { { const WSrc W{KA->in[2], KA->in[3], KA->in[18], KA->in[20], KA->in[21], KA->in[7], KA->in[9], KA->in[12], KA->in[11]}; phase_wconv(C, layer, W); } phase_norm_bf16(C, xin, KA->in[1] + layer * DM, (bf16*)(C.ws + WS_H)); } } }
        SEAM(p0 + 0);
        FRESH(); if (IN(p0 + 1)) { { pg8::Gemm g{(const pg8::bf16_t*)(C.ws + WS_H), (const pg8::bf16_t*)(C.ws + WS_WIN), M, N_INP, DM}; pg8::StaticOrder S; S.init(M, N_INP, C.G, C.bid);
            pg8::EpiProj E{C.ws}; pg8::gemm_phase<pg8::EpiProj, pg8::StaticOrder, true, true>(C.lds, g, S, E); }
            if ((REP_MASK >> 1) & 1u) { xcd_barrier(bar); FRESH(); { pg8::Gemm g{(const pg8::bf16_t*)(C.ws + WS_H), (const pg8::bf16_t*)(C.ws + WS_WIN), M, N_INP, DM}; pg8::StaticOrder S; S.init(M, N_INP, C.G, C.bid);
            pg8::EpiProj E{C.ws}; pg8::gemm_phase<pg8::EpiProj, pg8::StaticOrder, true, true>(C.lds, g, S, E); } } }
        SEAM(p0 + 1);
        FRESH(); if (IN(p0 + 2)) { phase_prep_a(C);
            if ((REP_MASK >> 2) & 1u) { xcd_barrier(bar); FRESH(); phase_prep_a(C); } }
        SEAM(p0 + 2);
        FRESH(); if (IN(p0 + 3)) { phase_indexer(C);
            if ((REP_MASK >> 3) & 1u) { xcd_barrier(bar); FRESH(); phase_indexer(C); } }
        SEAM(p0 + 3);
        FRESH(); if (IN(p0 + 4)) { phase_attn(C);
            if ((REP_MASK >> 4) & 1u) { xcd_barrier(bar); FRESH(); phase_attn(C); } }
        SEAM(p0 + 4);
        FRESH(); if (IN(p0 + 5)) { phase_ret1(C);
            if ((REP_MASK >> 5) & 1u) { xcd_barrier(bar); FRESH(); phase_ret1(C); } }
        SEAM(p0 + 5);
        FRESH(); if (IN(p0 + 6)) { phase_ret2(C);
            if ((REP_MASK >> 6) & 1u) { xcd_barrier(bar); FRESH(); phase_ret2(C); } }
        SEAM(p0 + 6);
        FRESH(); if (IN(p0 + 7)) { phase_ret3(C);
            if ((REP_MASK >> 7) & 1u) { xcd_barrier(bar); FRESH(); phase_ret3(C); } }
        SEAM(p0 + 7);
        FRESH(); if (IN(p0 + 8)) { { const RwP P{KA->in[4], KA->in[5], KA->in[6], KA->in[8], KA->in[10], KA->in[13], KA->in[14], KA->in[15], KA->in[16], KA->in[17]}; phase_rw1(C, layer, P); }
            if ((REP_MASK >> 8) & 1u) { xcd_barrier(bar); FRESH(); { const RwP P{KA->in[4], KA->in[5], KA->in[6], KA->in[8], KA->in[10], KA->in[13], KA->in[14], KA->in[15], KA->in[16], KA->in[17]}; phase_rw1(C, layer, P); } } }
        SEAM(p0 + 8);
        FRESH(); if (IN(p0 + 9)) { phase_rw2(C);
            if ((REP_MASK >> 9) & 1u) { xcd_barrier(bar); FRESH(); phase_rw2(C); } }
        SEAM(p0 + 9);
        FRESH(); if (IN(p0 + 10)) { phase_rw3(C);
            if ((REP_MASK >> 10) & 1u) { xcd_barrier(bar); FRESH(); phase_rw3(C); } }
        SEAM(p0 + 10);
        FRESH(); if (IN(p0 + 11)) { phase_rw4(C);
            if ((REP_MASK >> 11) & 1u) { xcd_barrier(bar); FRESH(); phase_rw4(C); } }
        SEAM(p0 + 11);
        FRESH(); if (IN(p0 + 12)) { { const RwP P{KA->in[4], KA->in[5], KA->in[6], KA->in[8], KA->in[10], KA->in[13], KA->in[14], KA->in[15], KA->in[16], KA->in[17]}; phase_rw5(C, layer, P); }
            if ((REP_MASK >> 12) & 1u) { xcd_barrier(bar); FRESH(); { const RwP P{KA->in[4], KA->in[5], KA->in[6], KA->in[8], KA->in[10], KA->in[13], KA->in[14], KA->in[15], KA->in[16], KA->in[17]}; phase_rw5(C, layer, P); } } }
        SEAM(p0 + 12);
        FRESH(); if (IN(p0 + 13)) { { pg8::Gemm g{(const pg8::bf16_t*)(C.ws + WS_CAT), (const pg8::bf16_t*)(C.ws + WS_WOUT), M, DM, DM}; pg8::StaticOrder S; S.init(M, DM, C.G, C.bid);
            pg8::EpiResid E{xin, C.out, DM}; pg8::gemm_phase<pg8::EpiResid, pg8::StaticOrder, true, true>(C.lds, g, S, E); }
            if ((REP_MASK >> 13) & 1u) { xcd_barrier(bar); FRESH(); { pg8::Gemm g{(const pg8::bf16_t*)(C.ws + WS_CAT), (const pg8::bf16_t*)(C.ws + WS_WOUT), M, DM, DM}; pg8::StaticOrder S; S.init(M, DM, C.G, C.bid);
            pg8::EpiResid E{xin, C.out, DM}; pg8::gemm_phase<pg8::EpiResid, pg8::StaticOrder, true, true>(C.lds, g, S, E); } } }
        SEAM(p0 + 13);
        FRESH(); if (IN(p0 + 14)) { phase_norm_bf16(C, C.out, KA->in[19] + layer * DM, (bf16*)(C.ws + WS_H2));
            if ((REP_MASK >> 14) & 1u) { xcd_barrier(bar); FRESH(); phase_norm_bf16(C, C.out, KA->in[19] + layer * DM, (bf16*)(C.ws + WS_H2)); } }
        SEAM(p0 + 14);
        FRESH(); if (IN(p0 + 15)) { { pg8::Gemm g{(const pg8::bf16_t*)(C.ws + WS_H2), (const pg8::bf16_t*)(C.ws + WS_WGU), M, 2 * DFF, DM}; pg8::StaticOrder S; S.init(M, 2 * DFF, C.G, C.bid);
            pg8::EpiSwiGLU E{(pg8::bf16_t*)(C.ws + WS_ACT), DFF}; pg8::gemm_phase<pg8::EpiSwiGLU, pg8::StaticOrder, true, true>(C.lds, g, S, E); }
            if ((REP_MASK >> 15) & 1u) { xcd_barrier(bar); FRESH(); { pg8::Gemm g{(const pg8::bf16_t*)(C.ws + WS_H2), (const pg8::bf16_t*)(C.ws + WS_WGU), M, 2 * DFF, DM}; pg8::StaticOrder S; S.init(M, 2 * DFF, C.G, C.bid);
            pg8::EpiSwiGLU E{(pg8::bf16_t*)(C.ws + WS_ACT), DFF}; pg8::gemm_phase<pg8::EpiSwiGLU, pg8::StaticOrder, true, true>(C.lds, g, S, E); } } }
        SEAM(p0 + 15);
        FRESH(); if (IN(p0 + 16)) { { pg8::Gemm g{(const pg8::bf16_t*)(C.ws + WS_ACT), (const pg8::bf16_t*)(C.ws + WS_WDN), M, DM, DFF}; pg8::StaticOrder S; S.init(M, DM, C.G, C.bid);
            pg8::EpiResid E{C.out, C.out, DM}; pg8::gemm_phase<pg8::EpiResid, pg8::StaticOrder, true, true>(C.lds, g, S, E); }
            if ((REP_MASK >> 16) & 1u) { xcd_barrier(bar); FRESH(); { pg8::Gemm g{(const pg8::bf16_t*)(C.ws + WS_ACT), (const pg8::bf16_t*)(C.ws + WS_WDN), M, DM, DFF}; pg8::StaticOrder S; S.init(M, DM, C.G, C.bid);
            pg8::EpiResid E{C.out, C.out, DM}; pg8::gemm_phase<pg8::EpiResid, pg8::StaticOrder, true, true>(C.lds, g, S, E); } } }
        SEAM(p0 + 16);
    }
__global__ void __launch_bounds__(NTHR, 2) fwd_kernel(Args args) {
    extern __shared__ __attribute__((aligned(16))) unsigned char lds_raw[];
    Ctx C;
    C.lds = (LAS unsigned char*)lds_raw; C.tid = threadIdx.x; C.lane = C.tid & 63; C.wave = __builtin_amdgcn_readfirstlane(C.tid >> 6);
    C.G = gridDim.x; C.bid = blockIdx.x;
    const CAS Args* KA = (const CAS Args*)launder_ptr((const void*)(uintptr_t)__builtin_amdgcn_kernarg_segment_ptr());
    C.ws = KA->ws; C.out = KA->out;
    volatile LAS unsigned* MISC = (volatile LAS unsigned*)(C.lds + MISC_OFF);
    if (C.tid < 32) MISC[C.tid] = 0u;
    __syncthreads();
    unsigned* ctl = (unsigned*)(C.ws + WS_CTL);
    XcdBarrier bar; bar.bar = ctl + CW_BAR; bar.x = 0; bar.st = nullptr;
    if (!MK_PER_PHASE) bar = xcd_barrier_post(ctl + CW_BAR, MISC + 8);
    const int lo = KA->ph_lo, hi = KA->ph_hi;
    layer_phases<0>(C, KA, bar, ctl, lds_raw, lo, hi);
    layer_phases<1>(C, KA, bar, ctl, lds_raw, lo, hi);
    if (IN(N_PHASES - 1)) phase_final_norm(C, C.out, KA->in[22]);
#undef IN
#undef SEAM
}

extern "C" void kernel_launch(void* const* d_in, const int* in_sizes, int n_in, void* d_out, int out_size, void* d_ws, size_t ws_size, hipStream_t stream) {
    static int grid = 0;
    if (grid == 0) {
        if (n_in != 23 || out_size != M * DM || ws_size < WS_NEED) { fprintf(stderr, "kernel_launch: unexpected problem (n_in %d, out %d, ws %zu); nothing launched\n", n_in, out_size, ws_size); grid = -1; return; }
        int dev = 0, cus = 0, per_cu = 0;
        if (hipGetDevice(&dev) != hipSuccess || hipDeviceGetAttribute(&cus, hipDeviceAttributeMultiprocessorCount, dev) != hipSuccess) { grid = -1; return; }
        if (hipFuncSetAttribute((const void*)fwd_kernel, hipFuncAttributeMaxDynamicSharedMemorySize, LDS_BYTES) != hipSuccess) { fprintf(stderr, "kernel_launch: hipFuncSetAttribute failed\n"); grid = -1; return; }
        if (hipOccupancyMaxActiveBlocksPerMultiprocessor(&per_cu, (const void*)fwd_kernel, NTHR, LDS_BYTES) != hipSuccess || per_cu < 1) { fprintf(stderr, "kernel_launch: occupancy query says %d blocks per CU\n", per_cu); }
        (void)hipGetLastError();
        grid = cus;
    }
    if (grid < 0) return;
    (void)hipMemsetAsync((char*)d_ws + WS_CTL, 0, CTL_ZERO_BYTES, stream);
    Args a{};
    for (int i = 0; i < 23; ++i) a.in[i] = (const float*)d_in[i];
    a.out = (float*)d_out; a.ws = (unsigned char*)d_ws;
#if MK_PER_PHASE
    for (int p = 0; p < N_PHASES; ++p) { a.ph_lo = p; a.ph_hi = p + 1; hipLaunchKernelGGL(fwd_kernel, dim3(grid), dim3(NTHR), LDS_BYTES, stream, a); }
#else
    a.ph_lo = 0; a.ph_hi = N_PHASES;
    hipLaunchKernelGGL(fwd_kernel, dim3(grid), dim3(NTHR), LDS_BYTES, stream, a);
#endif
    const hipError_t le = hipPeekAtLastError();
    if (le != hipSuccess) fprintf(stderr, "kernel_launch: launch failed: %s\n", hipGetErrorName(le));
}
```

```cpp
#include <hip/hip_runtime.h>
#include <hip/hip_fp16.h>
#include <cstdio>
#include <cstdint>
namespace pg8 {
#define PG8_LAS __attribute__((address_space(3)))
typedef unsigned short bf16_t;
typedef short bf16x8 __attribute__((ext_vector_type(8)));
typedef float f32x4 __attribute__((ext_vector_type(4)));
typedef unsigned u32x4 __attribute__((ext_vector_type(4)));
constexpr int BM = 256, BK = 64, HALF = 128, HTB = HALF * BK * 2  , STAGE_BYTES = 8 * HTB, NXCD = 8, WGM = 8;

__host__ __device__ __forceinline__ int lds_byte(int r, int c) { const int st = (r >> 4) * 2 + (c >> 5), rr = r & 15, cc = c & 31, ob = rr * 64 + cc * 2; return st * 1024 + (ob ^ (((ob >> 9) & 1) << 5)); }
__host__ __device__ __forceinline__ void stage_rc(int b, int& R, int& C) { const int st = b / 1024, sb = b % 1024, swz = sb ^ (((sb >> 9) & 1) << 5); R = (st >> 1) * 16 + swz / 64; C = (st & 1) * 32 + (swz % 64) / 2; }
__host__ __device__ __forceinline__ int perm32(int rho) { const int n = rho >> 4, i = rho & 15; return 8 * (i >> 2) + 4 * n + (i & 3); }

struct Unit { int pm, pn; };
struct Gemm { const bf16_t* A; const bf16_t* Bt; int M, N, K; };

struct StaticOrder {
    int nM, nN, nwg, G, c;
    __host__ __device__ void init(int M, int N, int G_, int c_) { nM = M / BM; nN = N / BM; nwg = nM * nN; G = G_; c = c_; }
    __host__ __device__ bool next(int i, Unit& u) const {
        const long L = (long)i * G + c; if (L >= nwg) return false;
        int wgid = (int)L; { const int q = nwg / NXCD, r = nwg % NXCD, xcd = wgid % NXCD, off = wgid / NXCD; wgid = (xcd < r ? xcd * (q + 1) : r * (q + 1) + (xcd - r) * q) + off; }
        const int nig = WGM * nN, gid = wgid / nig, fm = gid * WGM, gsz = (nM - fm) < WGM ? (nM - fm) : WGM;
        u.pm = fm + ((wgid % nig) % gsz); u.pn = (wgid % nig) / gsz; return true;
    }
    __device__ __forceinline__ void a_ready(const Unit&) const {}
    __device__ __forceinline__ void done(const Unit&) const {}
};

__device__ __forceinline__ unsigned cvt_pk_bf16(float lo, float hi) { unsigned r; asm volatile("v_cvt_pk_bf16_f32 %0, %1, %2" : "=v"(r) : "v"(lo), "v"(hi)); return r; }
typedef float f32x2 __attribute__((ext_vector_type(2)));
__device__ __forceinline__ f32x2 gelu_pk(f32x2 v) {
    const f32x2 av = __builtin_elementwise_abs(v), d = av * 0.2316418882f + 1.0f;
    f32x2 t; t.x = __builtin_amdgcn_rcpf(d.x); t.y = __builtin_amdgcn_rcpf(d.y);
    f32x2 q = t * 0.5307027145f + (-0.7265760135f); q = q * t + 0.7107068705f; q = q * t + (-0.142248368f); q = q * t + 0.127414796f; q = q * t;
    const f32x2 s = (v * v) * (-0.72134752044f);
    f32x2 e; e.x = __builtin_amdgcn_exp2f(s.x); e.y = __builtin_amdgcn_exp2f(s.y);
    const f32x2 m = v * (q * e), r = v - m;
    f32x2 o; o.x = v.x < 0.f ? m.x : r.x; o.y = v.y < 0.f ? m.y : r.y; return o;
}

template <int ACT  > struct EpiBf16 {
    static constexpr bool PERM = true, AFTER_DRAIN = false; static_assert(ACT == 0 || ACT == 1, "EpiBf16: ACT is 0 (none) or 1 (gelu_pk)");
    bf16_t* O; int ldc; const float* bias; int split_cols; size_t split_stride; float scale0;
    __device__ __forceinline__ void operator()(const f32x4 (&acc)[2][2][4][2], const Unit& u, int wr, int wc, int fr, int fq) const {
        const int row0 = u.pm * BM + wr * 64 + fr; int colt = u.pn * BM; bf16_t* base = O;
        float sc = 1.f; if (split_cols) { const int t = colt / split_cols; base += (size_t)t * split_stride; colt -= t * split_cols; if (t == 0) sc = scale0; }
        const int col0 = colt + wc * 32 + 8 * fq, bcol0 = u.pn * BM + wc * 32 + 8 * fq;
        f32x4 bv[2][2];
#pragma unroll
        for (int bj = 0; bj < 2; ++bj)
#pragma unroll
            for (int n = 0; n < 2; ++n) bv[bj][n] = bias ? *(const f32x4*)(bias + bcol0 + bj * HALF + 4 * n) : (f32x4){0.f, 0.f, 0.f, 0.f};
#pragma unroll
        for (int ai = 0; ai < 2; ++ai)
#pragma unroll
            for (int m = 0; m < 4; ++m) { bf16_t* rowp = base + (size_t)(row0 + ai * HALF + m * 16) * ldc + col0;
#pragma unroll
                for (int bj = 0; bj < 2; ++bj) { f32x4 v0 = acc[ai][bj][m][0] + bv[bj][0], v1 = acc[ai][bj][m][1] + bv[bj][1];
                    if (ACT == 1) { f32x2 a = gelu_pk((f32x2){v0[0], v0[1]}), b = gelu_pk((f32x2){v0[2], v0[3]}), c = gelu_pk((f32x2){v1[0], v1[1]}), d = gelu_pk((f32x2){v1[2], v1[3]});
                        v0 = (f32x4){a.x, a.y, b.x, b.y}; v1 = (f32x4){c.x, c.y, d.x, d.y}; }
                    v0 = v0 * sc; v1 = v1 * sc; u32x4 w; w.x = cvt_pk_bf16(v0[0], v0[1]); w.y = cvt_pk_bf16(v0[2], v0[3]); w.z = cvt_pk_bf16(v1[0], v1[1]); w.w = cvt_pk_bf16(v1[2], v1[3]);
                    *(u32x4*)(rowp + bj * HALF) = w; } }
    }
};

__device__ __forceinline__ void tile_dest(int pn, size_t& off, int& ld, int& colt);
struct EpiProj {
    static constexpr bool PERM = true, AFTER_DRAIN = false;
    unsigned char* ws;
    __device__ __forceinline__ void operator()(const f32x4 (&acc)[2][2][4][2], const Unit& u, int wr, int wc, int fr, int fq) const {
        size_t off; int ld, colt; tile_dest(u.pn, off, ld, colt);
        bf16_t* base = (bf16_t*)(ws + off);
        const int row0 = u.pm * BM + wr * 64 + fr, col0 = colt + wc * 32 + 8 * fq;
        const float sc = u.pn < 4 ? 0.12751743074602467f : 1.0f;
#pragma unroll
        for (int ai = 0; ai < 2; ++ai)
#pragma unroll
            for (int m = 0; m < 4; ++m) { bf16_t* rowp = base + (size_t)(row0 + ai * HALF + m * 16) * ld + col0;
#pragma unroll
                for (int bj = 0; bj < 2; ++bj) { const f32x4 v0 = acc[ai][bj][m][0] * sc, v1 = acc[ai][bj][m][1] * sc;
                    u32x4 w; w.x = cvt_pk_bf16(v0[0], v0[1]); w.y = cvt_pk_bf16(v0[2], v0[3]); w.z = cvt_pk_bf16(v1[0], v1[1]); w.w = cvt_pk_bf16(v1[2], v1[3]);
                    *(u32x4*)(rowp + bj * HALF) = w; } }
    }
};
struct EpiResid {
    static constexpr bool PERM = false, AFTER_DRAIN = false;
    const float* base; float* out; int ldc;
    __device__ __forceinline__ void operator()(const f32x4 (&acc)[2][2][4][2], const Unit& u, int wr, int wc, int fr, int fq) const {
        const int row0 = u.pm * BM + wr * 64 + fr, col0 = u.pn * BM + wc * 32 + 4 * fq;
#pragma unroll
        for (int ai = 0; ai < 2; ++ai)
#pragma unroll
            for (int m = 0; m < 4; ++m) { const size_t off = (size_t)(row0 + ai * HALF + m * 16) * ldc + col0;
#pragma unroll
                for (int bj = 0; bj < 2; ++bj)
#pragma unroll
                    for (int n = 0; n < 2; ++n) { const size_t p = off + bj * HALF + n * 16; const f32x4 b = *(const f32x4*)(base + p); *(f32x4*)(out + p) = b + acc[ai][bj][m][n]; } }
    }
};
struct EpiSwiGLU {
    static constexpr bool PERM = true, AFTER_DRAIN = false;
    bf16_t* O; int ldc;
    __device__ __forceinline__ static float silu_mul(float g, float u) { return g * u * __builtin_amdgcn_rcpf(1.0f + __expf(-g)); }
    __device__ __forceinline__ void operator()(const f32x4 (&acc)[2][2][4][2], const Unit& u, int wr, int wc, int fr, int fq) const {
        const int row0 = u.pm * BM + wr * 64 + fr, col0 = u.pn * HALF + wc * 32 + 8 * fq;
#pragma unroll
        for (int ai = 0; ai < 2; ++ai)
#pragma unroll
            for (int m = 0; m < 4; ++m) { bf16_t* rowp = O + (size_t)(row0 + ai * HALF + m * 16) * ldc + col0;
                const f32x4 g0 = acc[ai][0][m][0], g1 = acc[ai][0][m][1], u0 = acc[ai][1][m][0], u1 = acc[ai][1][m][1];
                u32x4 w; w.x = cvt_pk_bf16(silu_mul(g0[0], u0[0]), silu_mul(g0[1], u0[1])); w.y = cvt_pk_bf16(silu_mul(g0[2], u0[2]), silu_mul(g0[3], u0[3]));
                w.z = cvt_pk_bf16(silu_mul(g1[0], u1[0]), silu_mul(g1[1], u1[1])); w.w = cvt_pk_bf16(silu_mul(g1[2], u1[2]), silu_mul(g1[3], u1[3]));
                *(u32x4*)rowp = w; }
    }
};
template <class Epi, class Sched, bool ALIGN_EPI = false, bool SP2 = false>
__device__ __forceinline__ void gemm_phase(PG8_LAS unsigned char* lds, const Gemm g, const Sched& S, const Epi& E) {
    int tid_ = threadIdx.x; asm volatile("" : "+v"(tid_));
    const int tid = tid_, wid = __builtin_amdgcn_readfirstlane(tid >> 6), lane = tid & 63, wr = wid >> 2, wc = wid & 3, fr = lane & 15, fq = lane >> 4;
    const int K = g.K, nt = K / BK;
    unsigned voffA[2], voffB[2];
#pragma unroll
    for (int i = 0; i < 2; ++i) { int R, C; stage_rc(tid * 16 + i * 8192, R, C); const int Rb = Epi::PERM ? ((R & ~31) + perm32(R & 31)) : R;
        voffA[i] = (unsigned)(R * K + C) * 2u; voffB[i] = (unsigned)(Rb * K + C) * 2u; }
    const size_t kstep = (size_t)(BK * 2);
    const size_t hstep = (size_t)HALF * K * 2;
    const size_t tstep = 2 * hstep;
    const unsigned ldsw = (unsigned)wid * 1024u;
    const int aoff = lds_byte(wr * 64 + fr, fq * 8), boff = lds_byte(wc * 32 + fr, fq * 8);
#define PG8_SA(b, h) (((b) * 2 + (h)) * HTB)
#define PG8_SB(b, h) ((4 + (b) * 2 + (h)) * HTB)
#define PG8_STAGE(bufoff, gbase, voff) do { _Pragma("unroll") for (int _i = 0; _i < 2; ++_i) \
        __builtin_amdgcn_global_load_lds((const unsigned*)((const char*)(gbase) + (voff)[_i]), (PG8_LAS unsigned*)(lds + (bufoff) + ldsw + _i * 8192), 16, 0, 0); } while (0)
#define PG8_LDA(dst, b, h) do { _Pragma("unroll") for (int m = 0; m < 4; ++m) _Pragma("unroll") for (int k = 0; k < 2; ++k) dst[m][k] = *(const PG8_LAS bf16x8*)(lds + PG8_SA(b, h) + aoff + m * 2048 + k * 1024); } while (0)
#define PG8_LDB(dst, b, h) do { _Pragma("unroll") for (int n = 0; n < 2; ++n) _Pragma("unroll") for (int k = 0; k < 2; ++k) dst[n][k] = *(const PG8_LAS bf16x8*)(lds + PG8_SB(b, h) + boff + n * 2048 + k * 1024); } while (0)
#define PG8_MMA(ai, bj, At, Bt) do { __builtin_amdgcn_s_setprio(1); _Pragma("unroll") for (int m = 0; m < 4; ++m) _Pragma("unroll") for (int n = 0; n < 2; ++n) _Pragma("unroll") for (int k = 0; k < 2; ++k) \
        acc[ai][bj][m][n] = __builtin_amdgcn_mfma_f32_16x16x32_bf16(Bt[n][k], At[m][k], acc[ai][bj][m][n], 0, 0, 0); __builtin_amdgcn_s_setprio(0); } while (0)
#define PG8_WAIT_V(n) asm volatile("s_waitcnt vmcnt(" #n ")" ::: "memory")
#define PG8_WAIT_L(n) asm volatile("s_waitcnt lgkmcnt(" #n ")" ::: "memory")
#define PG8_BAR __builtin_amdgcn_s_barrier()
#define PG8_SCHED __builtin_amdgcn_sched_barrier(0)
    Unit cur, nxt; int ui = 0;
    if (!S.next(0, cur)) return;
    f32x4 acc[2][2][4][2];
#pragma unroll
    for (int a = 0; a < 2; ++a)
#pragma unroll
        for (int b = 0; b < 2; ++b)
#pragma unroll
            for (int m = 0; m < 4; ++m)
#pragma unroll
                for (int n = 0; n < 2; ++n) acc[a][b][m][n] = (f32x4){0.f, 0.f, 0.f, 0.f};
    bf16x8 At[4][2], B0[2][2], B1[2][2];
    const char* cA = (const char*)g.A + (size_t)cur.pm * tstep; const char* cB = (const char*)g.Bt + (size_t)cur.pn * tstep;
    S.a_ready(cur);
    if constexpr (SP2) {
        PG8_STAGE(PG8_SB(0, 0), cB, voffB); PG8_STAGE(PG8_SB(0, 1), cB + hstep, voffB); PG8_STAGE(PG8_SA(0, 0), cA, voffA); PG8_STAGE(PG8_SA(0, 1), cA + hstep, voffA);
        if (wr == 1) PG8_BAR;
        PG8_WAIT_V(2); PG8_BAR;
        PG8_STAGE(PG8_SB(1, 0), cB + kstep, voffB); PG8_STAGE(PG8_SA(1, 0), cA + kstep, voffA); PG8_STAGE(PG8_SB(1, 1), cB + hstep + kstep, voffB);
        PG8_WAIT_V(6); PG8_BAR;
    } else {
        PG8_STAGE(PG8_SB(0, 0), cB, voffB); PG8_STAGE(PG8_SA(0, 0), cA, voffA); PG8_STAGE(PG8_SB(0, 1), cB + hstep, voffB); PG8_STAGE(PG8_SA(0, 1), cA + hstep, voffA);
        if (wr == 1) PG8_BAR;
        PG8_WAIT_V(4); PG8_BAR;
        PG8_STAGE(PG8_SB(1, 0), cB + kstep, voffB); PG8_STAGE(PG8_SA(1, 0), cA + kstep, voffA); PG8_STAGE(PG8_SB(1, 1), cB + hstep + kstep, voffB);
        PG8_WAIT_V(6); PG8_BAR;
    }
    for (;;) {
        const bool has_next = S.next(ui + 1, nxt);
        const char* nA = has_next ? (const char*)g.A + (size_t)nxt.pm * tstep : cA; const char* nB = has_next ? (const char*)g.Bt + (size_t)nxt.pn * tstep : cB;
        for (int t = 0; t < nt; t += 2) {
            const bool last = (t == nt - 2);
            const char* a1 = cA + (size_t)(t + 1) * kstep;
            const char* a2 = last ? nA : cA + (size_t)(t + 2) * kstep; const char* b2 = last ? nB : cB + (size_t)(t + 2) * kstep;
            const char* a3 = a2 + kstep; const char* b3 = b2 + kstep;
            if (last && has_next) S.a_ready(nxt);
            if constexpr (SP2) {
            PG8_LDB(B0, 0, 0); PG8_LDB(B1, 0, 1); PG8_SCHED; PG8_LDA(At, 0, 0); PG8_STAGE(PG8_SA(1, 1), a1 + hstep, voffA);
            PG8_WAIT_V(8); PG8_WAIT_L(0); PG8_BAR; PG8_MMA(0, 0, At, B0); PG8_MMA(0, 1, At, B1); PG8_BAR; PG8_SCHED;
            PG8_LDA(At, 0, 1); PG8_STAGE(PG8_SB(0, 0), b2, voffB); PG8_STAGE(PG8_SB(0, 1), b2 + hstep, voffB); PG8_STAGE(PG8_SA(0, 0), a2, voffA);
            PG8_WAIT_V(8); PG8_WAIT_L(0); PG8_BAR; PG8_MMA(1, 0, At, B0); PG8_MMA(1, 1, At, B1); PG8_BAR; PG8_SCHED;
            PG8_LDB(B0, 1, 0); PG8_LDB(B1, 1, 1); PG8_SCHED; PG8_LDA(At, 1, 0); PG8_STAGE(PG8_SA(0, 1), a2 + hstep, voffA);
            PG8_WAIT_V(8); PG8_WAIT_L(0); PG8_BAR; PG8_MMA(0, 0, At, B0); PG8_MMA(0, 1, At, B1); PG8_BAR; PG8_SCHED;
            PG8_LDA(At, 1, 1); PG8_STAGE(PG8_SB(1, 0), b3, voffB); PG8_STAGE(PG8_SB(1, 1), b3 + hstep, voffB); PG8_STAGE(PG8_SA(1, 0), a3, voffA);
            PG8_WAIT_V(8); PG8_WAIT_L(0); PG8_BAR; PG8_MMA(1, 0, At, B0); PG8_MMA(1, 1, At, B1); PG8_BAR; PG8_SCHED;
            } else {
            PG8_LDB(B0, 0, 0); PG8_SCHED; PG8_LDA(At, 0, 0); PG8_STAGE(PG8_SA(1, 1), a1 + hstep, voffA);
            PG8_WAIT_L(8); PG8_BAR; PG8_WAIT_L(0); PG8_MMA(0, 0, At, B0); PG8_BAR; PG8_SCHED;
            PG8_LDB(B1, 0, 1); PG8_STAGE(PG8_SB(0, 0), b2, voffB);
            PG8_BAR; PG8_WAIT_L(0); PG8_MMA(0, 1, At, B1); PG8_BAR;
            PG8_LDA(At, 0, 1); PG8_STAGE(PG8_SA(0, 0), a2, voffA);
            PG8_BAR; PG8_WAIT_L(0); PG8_MMA(1, 0, At, B0); PG8_BAR; PG8_SCHED;
            PG8_STAGE(PG8_SB(0, 1), b2 + hstep, voffB);
            PG8_WAIT_V(6); PG8_BAR; PG8_MMA(1, 1, At, B1); PG8_BAR;
            PG8_LDB(B0, 1, 0); PG8_SCHED; PG8_LDA(At, 1, 0); PG8_STAGE(PG8_SA(0, 1), a2 + hstep, voffA);
            PG8_WAIT_L(8); PG8_BAR; PG8_WAIT_L(0); PG8_MMA(0, 0, At, B0); PG8_BAR; PG8_SCHED;
            PG8_LDB(B1, 1, 1); PG8_STAGE(PG8_SB(1, 0), b3, voffB);
            PG8_BAR; PG8_WAIT_L(0); PG8_MMA(0, 1, At, B1); PG8_BAR;
            PG8_LDA(At, 1, 1); PG8_STAGE(PG8_SA(1, 0), a3, voffA);
            PG8_BAR; PG8_WAIT_L(0); PG8_MMA(1, 0, At, B0); PG8_BAR; PG8_SCHED;
            PG8_STAGE(PG8_SB(1, 1), b3 + hstep, voffB);
            PG8_WAIT_V(6); PG8_BAR; PG8_MMA(1, 1, At, B1); PG8_BAR;
            }
        }
        if constexpr (ALIGN_EPI) { if (wr == 0) PG8_BAR; }
        if constexpr (!Epi::AFTER_DRAIN) { E(acc, cur, wr, wc, fr, fq); S.done(cur); }
        if (!has_next) break;
#pragma unroll
        for (int a = 0; a < 2; ++a)
#pragma unroll
            for (int b = 0; b < 2; ++b)
#pragma unroll
                for (int m = 0; m < 4; ++m)
#pragma unroll
                    for (int n = 0; n < 2; ++n) acc[a][b][m][n] = (f32x4){0.f, 0.f, 0.f, 0.f};
        cur = nxt; cA = nA; cB = nB; ++ui;
        if constexpr (ALIGN_EPI) { if (wr == 1) PG8_BAR; }
    }
    PG8_WAIT_V(0);
    if constexpr (!ALIGN_EPI) { if (wr == 0) PG8_BAR; }
    PG8_BAR;
    if constexpr (Epi::AFTER_DRAIN) { E.fused(acc, cur, wr, wc, fr, fq, lds, wid, lane); S.done(cur); }
#undef PG8_SA
#undef PG8_SB
#undef PG8_STAGE
#undef PG8_LDA
#undef PG8_LDB
#undef PG8_MMA
#undef PG8_WAIT_V
#undef PG8_WAIT_L
#undef PG8_BAR
#undef PG8_SCHED
}
}
constexpr int NB = 4, T = 8192, M = NB * T, DM = 2048, DFF = 5632, DEPTH = 2;
constexpr int N_IN = 7696, N_INP = 7936;
constexpr int NWAVES = 8, NTHR = NWAVES * 64;
#define LAS __attribute__((address_space(3)))
#define GAS __attribute__((address_space(1)))
#define CAS __attribute__((address_space(4)))
typedef unsigned short bf16;
typedef short bf16x8 __attribute__((ext_vector_type(8)));
typedef float f32x4 __attribute__((ext_vector_type(4)));
typedef float f32x16 __attribute__((ext_vector_type(16)));
typedef unsigned u32x4 __attribute__((ext_vector_type(4)));
typedef unsigned u32x2 __attribute__((ext_vector_type(2)));
typedef unsigned long long u64;

constexpr size_t MiB = 1u << 20;
constexpr size_t WS_CTL = 0, CTL_ZERO_BYTES = 1 * MiB;
constexpr size_t WS_WIN = 1 * MiB, WS_WOUT = 32 * MiB, WS_WGU = 40 * MiB, WS_WDN = 84 * MiB;
constexpr size_t WS_LORA = 106 * MiB;
constexpr size_t LO_W = 0, LO_A = 512 * 96 * 2, LO_V = 2 * 512 * 96 * 2, LO_G = LO_V + 512 * 64 * 2;
constexpr size_t WS_VFIRST = 107 * MiB;
constexpr size_t WS_H = 139 * MiB;
constexpr size_t WS_VT = 139 * MiB, WS_MASK = 203 * MiB;
constexpr size_t WS_Q = 267 * MiB, WS_K = 331 * MiB, WS_QI = 395 * MiB, WS_V = 459 * MiB, WS_KW = 523 * MiB, WS_BQ = 539 * MiB, WS_BK = 555 * MiB, WS_BV = 571 * MiB, WS_BG = 603 * MiB;
constexpr size_t WS_CR = 635 * MiB, WS_CK = 667 * MiB, WS_CV = 699 * MiB, WS_CL = 731 * MiB, WS_CG = 747 * MiB;
constexpr size_t WS_CAT = 763 * MiB;
constexpr size_t WS_KVST = 891 * MiB;
constexpr size_t WS_TAB = 955 * MiB;
constexpr size_t TAB_A = 0, TAB_I = (size_t)T * 16 * 8, TAB_R = TAB_I + (size_t)T * 8 * 8, TAB_END = TAB_R + (size_t)T * 32 * 8;
constexpr size_t WS_RR = 139 * MiB, WS_RW = 203 * MiB, WS_RKH = 267 * MiB, WS_RV = 331 * MiB, WS_RA = 395 * MiB, WS_RB = 459 * MiB;
constexpr size_t WS_PHI = 523 * MiB, WS_PSI = 555 * MiB, WS_SST = 587 * MiB, WS_Y = 635 * MiB;
constexpr size_t WS_H2 = 139 * MiB, WS_ACT = 267 * MiB;
constexpr size_t WS_NEED = 1024 * MiB;
static_assert(WS_TAB + TAB_END <= WS_NEED && WS_ACT + (size_t)M * DFF * 2 <= WS_CR && WS_SST + 32 * MiB <= WS_CR && WS_Y + (size_t)M * 512 * 4 <= WS_CV, "ws map");

constexpr int LDS_BYTES = 147456, MISC_OFF = 143360;
constexpr int CW_BAR = 4096;

__device__ __forceinline__ unsigned f2bf(float f) { unsigned u = __builtin_bit_cast(unsigned, f); return (u + 0x7fffu + ((u >> 16) & 1u)) >> 16; }
__device__ __forceinline__ unsigned pk2(float lo, float hi) { return f2bf(lo) | (f2bf(hi) << 16); }
__device__ __forceinline__ float bf2f(unsigned short b) { return __builtin_bit_cast(float, (unsigned)b << 16); }
__device__ __forceinline__ float bflo(unsigned w) { return __builtin_bit_cast(float, w << 16); }
__device__ __forceinline__ float bfhi(unsigned w) { return __builtin_bit_cast(float, w & 0xffff0000u); }
__device__ __forceinline__ float wave_sum(float v) {
#pragma unroll
    for (int o = 1; o < 64; o <<= 1) v += __shfl_xor(v, o);
    return v;
}
#define LDS_WAIT() asm volatile("s_waitcnt lgkmcnt(0)" ::: "memory")

namespace pg8 {
__device__ __forceinline__ void tile_dest(int pn, size_t& off, int& ld, int& colt) {
    if (pn < 16) { const int g = pn >> 2; off = g == 0 ? WS_Q : g == 1 ? WS_K : g == 2 ? WS_V : WS_QI; ld = 1024; colt = (pn & 3) * 256; }
    else if (pn == 16) { off = WS_BQ; ld = 256; colt = 0; }
    else if (pn == 17) { off = WS_BK; ld = 256; colt = 0; }
    else if (pn < 20) { off = WS_BV; ld = 512; colt = (pn - 18) * 256; }
    else if (pn < 22) { off = WS_BG; ld = 512; colt = (pn - 20) * 256; }
    else if (pn == 22) { off = WS_KW; ld = 256; colt = 0; }
    else if (pn < 25) { off = WS_CR; ld = 512; colt = (pn - 23) * 256; }
    else if (pn < 27) { off = WS_CK; ld = 512; colt = (pn - 25) * 256; }
    else if (pn < 29) { off = WS_CV; ld = 512; colt = (pn - 27) * 256; }
    else if (pn == 29) { off = WS_CL; ld = 256; colt = 0; }
    else { off = WS_CG; ld = 256; colt = 0; }
}
}
__device__ __forceinline__ int win_src(int n, int layer) {
    if (n < 4096) return n;
    if (n < 4352) return 4176 + (n - 4096);
    if (n < 4608) return 4432 + (n - 4352);
    if (n < 5120) return 4688 + (n - 4608);
    if (n < 5632) return 5200 + (n - 5120);
    if (n < 5888) { const int j = n - 5632; return j < 64 ? 4096 + j : (j < 80 ? 4160 + (j - 64) : -1); }
    if (n < 7424) return 5712 + (n - 5888);
    if (n < 7680) { const int j = n - 7424; return j < 96 ? 7248 + j : (j < 192 ? 7344 + (j - 96) : (layer > 0 ? -2 - (j - 192) : -1)); }
    return 7440 + (n - 7680);
}
#define XB_TMO      128
#define XB_XCNT(j)  (256  + 64 * (j))
#define XB_XSUB(j)  (1280 + 64 * (j))
#define XB_XGEN(j)  (2304 + 64 * (j))
#define XB_TOP      3328
#define XB_TOPGEN   3392
#define XCD_BAR_WORDS 3456
#define XB_SPIN_CAP (1u << 18)

__device__ __forceinline__ unsigned xb_ld(unsigned* p)              { return __hip_atomic_load(p, __ATOMIC_RELAXED, __HIP_MEMORY_SCOPE_AGENT); }
__device__ __forceinline__ unsigned xb_add(unsigned* p, unsigned v) { return __hip_atomic_fetch_add(p, v, __ATOMIC_RELAXED, __HIP_MEMORY_SCOPE_AGENT); }
__device__ __forceinline__ unsigned xb_xcc_id() { return (unsigned)__builtin_amdgcn_s_getreg((3 << 11) | 20) & 0xFu; }
#define XB_SPIN(cond, bar) do { unsigned _sp = 0; while (cond) { __builtin_amdgcn_s_sleep(1); \
    if ((++_sp & 255u) == 0u) { if (xb_ld(&(bar)[XB_TMO])) break; if (_sp > XB_SPIN_CAP) { atomicAdd(&(bar)[XB_TMO], 1u); break; } } } } while (0)

struct XcdBarrier {
    unsigned* bar; unsigned x;
    volatile LAS unsigned* st;
};

__device__ __forceinline__ XcdBarrier xcd_barrier_post(unsigned* bar, volatile LAS unsigned* st) {
    XcdBarrier b; b.bar = bar; b.x = xb_xcc_id(); b.st = st;
    if (threadIdx.x == 0) (void)xb_add(&bar[XB_XCNT(b.x)], 1u);
    return b;
}
__device__ __forceinline__ void xcd_barrier_complete(unsigned* bar, unsigned x, unsigned& nloc, unsigned& nx) {
    const unsigned G = gridDim.x * gridDim.y * gridDim.z;
    unsigned sum, cnt, mine, sp = 0u;
    for (;;) {
        sum = 0u; cnt = 0u; mine = 0u;
#pragma unroll
        for (unsigned j = 0; j < 16; ++j) { const unsigned c = xb_ld(&bar[XB_XCNT(j)]); sum += c; cnt += (c > 0u) ? 1u : 0u; mine = (j == x) ? c : mine; }
        if (sum == G) break;
        __builtin_amdgcn_s_sleep(1);
        if ((++sp & 255u) == 0u) { if (xb_ld(&bar[XB_TMO])) break; if (sp > XB_SPIN_CAP) { atomicAdd(&bar[XB_TMO], 1u); break; } }
    }
    nloc = mine > 0u ? mine : 1u; nx = cnt > 0u ? cnt : 1u;
}

__device__ __forceinline__ void xcd_barrier(const XcdBarrier& b) {
    asm volatile("s_waitcnt vmcnt(0)" ::: "memory");
    __syncthreads();
    if (threadIdx.x == 0) {
        unsigned* bar = b.bar;
        __builtin_amdgcn_s_waitcnt(0);
        unsigned nloc = b.st[0], nx = b.st[1];
        if (nloc == 0u) { xcd_barrier_complete(bar, b.x, nloc, nx); b.st[0] = nloc; b.st[1] = nx; }
        const unsigned old = xb_add(&bar[XB_XSUB(b.x)], 1u);
        const unsigned gen = old / nloc;
        if (old + 1u == (gen + 1u) * nloc) {
            __builtin_amdgcn_fence(__ATOMIC_RELEASE, "agent");
            asm volatile("s_waitcnt vmcnt(0)" ::: "memory");
            const unsigned og = xb_add(&bar[XB_TOP], 1u);
            const unsigned tg = og / nx;
            if (og + 1u == (tg + 1u) * nx) xb_add(&bar[XB_TOPGEN], 1u);
            else XB_SPIN(xb_ld(&bar[XB_TOPGEN]) == tg, bar);
            __builtin_amdgcn_fence(__ATOMIC_ACQUIRE, "agent");
            xb_add(&bar[XB_XGEN(b.x)], 1u);
            asm volatile("s_waitcnt vmcnt(0)" ::: "memory");
        } else {
            XB_SPIN(xb_ld(&bar[XB_XGEN(b.x)]) == gen, bar);
            __builtin_amdgcn_fence(__ATOMIC_ACQUIRE, "agent");
            asm volatile("s_waitcnt vmcnt(0)" ::: "memory");
        }
    }
    __syncthreads();
}

struct Ctx {
    LAS unsigned char* lds; int tid, lane, wave, G, bid; unsigned char* ws; float* out;
};

template <int MAP>
__device__ __forceinline__ void wconv_item(const float* W, int ldw, const float* W2, int K, bf16* WT, LAS float* scr, int item, int nblk, int lane, int layer) {
    const int kb = item / nblk, nb = item % nblk, k0 = 64 * kb, n0 = 32 * nb;
    const int n = n0 + (lane & 31);
    const float* src = nullptr; int ld = ldw;
    if (MAP == 0) src = W + n;
    else if (MAP == 1) { const int s = win_src(n, layer); if (s >= 0) src = W + s; else if (s <= -2) { src = W2 + (-2 - s); ld = 64; } }
    else { const int tl = n >> 8, j = n & 255; src = W + (j < 128 ? tl * 128 + j : DFF + tl * 128 + (j - 128)); }
#pragma unroll 8
    for (int i = 0; i < 32; ++i) { const int kk = 2 * i + (lane >> 5); scr[kk * 33 + (lane & 31)] = src ? src[(size_t)(k0 + kk) * ld] : 0.f; }
    LDS_WAIT(); asm volatile("" ::: "memory");
    const int c = lane & 7;
#pragma unroll
    for (int j = 0; j < 4; ++j) { const int nn = (lane >> 3) + 8 * j; const LAS float* s = scr + (8 * c) * 33 + nn;
        u32x4 o; o.x = pk2(s[0 * 33], s[1 * 33]); o.y = pk2(s[2 * 33], s[3 * 33]); o.z = pk2(s[4 * 33], s[5 * 33]); o.w = pk2(s[6 * 33], s[7 * 33]);
        *(u32x4*)(WT + (size_t)(n0 + nn) * K + k0 + 8 * c) = o; }
    LDS_WAIT(); asm volatile("" ::: "memory");
}
struct WSrc { const float *w_in, *w_vres, *w_out, *w_gu, *w_dn, *wlb, *alb, *glb, *vlb; };
__device__ __forceinline__ void phase_wconv(const Ctx& C, int layer, const WSrc& W) {
    LAS float* scr = (LAS float*)(C.lds + C.wave * 16384);
    const int gw = C.bid * NWAVES + C.wave, NGW = C.G * NWAVES;
    const float* w_in = W.w_in + (size_t)layer * DM * N_IN; const float* w_vres = W.w_vres;
    const float* w_out = W.w_out + (size_t)layer * DM * DM; const float* w_gu = W.w_gu + (size_t)layer * DM * 2 * DFF; const float* w_dn = W.w_dn + (size_t)layer * DFF * DM;
    constexpr int I_IN = (DM / 64) * (N_INP / 32), I_OUT = (DM / 64) * (DM / 32), I_GU = (DM / 64) * (2 * DFF / 32), I_DN = (DFF / 64) * (DM / 32);
    for (int it = gw; it < I_IN + I_OUT + I_GU + I_DN; it += NGW) {
        int r = it;
        if (r < I_IN) { wconv_item<1>(w_in, N_IN, w_vres, DM, (bf16*)(C.ws + WS_WIN), scr, r, N_INP / 32, C.lane, layer); continue; } r -= I_IN;
        if (r < I_OUT) { wconv_item<0>(w_out, DM, nullptr, DM, (bf16*)(C.ws + WS_WOUT), scr, r, DM / 32, C.lane, layer); continue; } r -= I_OUT;
        if (r < I_GU) { wconv_item<2>(w_gu, 2 * DFF, nullptr, DM, (bf16*)(C.ws + WS_WGU), scr, r, 2 * DFF / 32, C.lane, layer); continue; } r -= I_GU;
        wconv_item<0>(w_dn, DM, nullptr, DFF, (bf16*)(C.ws + WS_WDN), scr, r, DM / 32, C.lane, layer);
    }
    const int gt = C.bid * NTHR + C.tid, NGT = C.G * NTHR;
    const float* wlb = W.wlb + (size_t)layer * 96 * 512; const float* alb = W.alb + (size_t)layer * 96 * 512; const float* glb = W.glb + (size_t)layer * 256 * 512;
    const float* vlb = W.vlb;
    bf16* LW = (bf16*)(C.ws + WS_LORA + LO_W); bf16* LA = (bf16*)(C.ws + WS_LORA + LO_A); bf16* LV = (bf16*)(C.ws + WS_LORA + LO_V); bf16* LG = (bf16*)(C.ws + WS_LORA + LO_G);
    for (int i = gt; i < 512 * 96; i += NGT) { const int n = i / 96, k = i % 96; LW[i] = (bf16)f2bf(wlb[k * 512 + n]); LA[i] = (bf16)f2bf(alb[k * 512 + n]); }
    for (int i = gt; i < 512 * 64; i += NGT) { const int n = i / 64, k = i % 64; LV[i] = (bf16)f2bf(layer > 0 ? vlb[k * 512 + n] : 0.f); }
    for (int i = gt; i < 512 * 256; i += NGT) { const int n = i / 256, k = i % 256; LG[i] = (bf16)f2bf(glb[k * 512 + n]); }
    if (layer == 0) {
        float2* TA = (float2*)(C.ws + WS_TAB + TAB_A); float2* TI = (float2*)(C.ws + WS_TAB + TAB_I); float2* TR = (float2*)(C.ws + WS_TAB + TAB_R);
        const float l2a = 18.931568569324174f  , l2r = 13.287712379549449f  ;
        for (int i = gt; i < T * 56; i += NGT) {
            const int pos = i / 56, j = i % 56; float fr; float2* dst;
            if (j < 16) { fr = exp2f(-(float)j * (1.0f / 16.0f) * l2a); dst = TA + pos * 16 + j; }
            else if (j < 24) { fr = exp2f(-(float)(j - 16) * (1.0f / 8.0f) * l2a); dst = TI + pos * 8 + (j - 16); }
            else { fr = exp2f(-(float)(j - 24) * (1.0f / 32.0f) * l2r); dst = TR + pos * 32 + (j - 24); }
            const float ang = (float)pos * fr; *dst = make_float2(cosf(ang), sinf(ang));
        }
    }
}
__device__ __forceinline__ void phase_norm_bf16(const Ctx& C, const float* x, const float* g, bf16* out) {
    const int gw = C.bid * NWAVES + C.wave, NGW = C.G * NWAVES;
    f32x4 gv[8];
#pragma unroll
    for (int j = 0; j < 8; ++j) gv[j] = *(const f32x4*)(g + 4 * (C.lane + 64 * j));
    for (int m = gw; m < M; m += NGW) {
        const f32x4* xr = (const f32x4*)(x + (size_t)m * DM) + C.lane; f32x4 v[8]; float s = 0.f;
#pragma unroll
        for (int j = 0; j < 8; ++j) { v[j] = xr[64 * j]; s += (v[j].x * v[j].x + v[j].y * v[j].y) + (v[j].z * v[j].z + v[j].w * v[j].w); }
        const float rs = rsqrtf(wave_sum(s) * (1.0f / DM) + 1e-5f);
        u32x2* o = (u32x2*)(out + (size_t)m * DM) + C.lane;
#pragma unroll
        for (int j = 0; j < 8; ++j) { u32x2 w; w.x = pk2(v[j].x * rs * gv[j].x, v[j].y * rs * gv[j].y); w.y = pk2(v[j].z * rs * gv[j].z, v[j].w * rs * gv[j].w); o[64 * j] = w; }
    }
}
__device__ __forceinline__ void phase_final_norm(const Ctx& C, float* x, const float* g) {
    const int gw = C.bid * NWAVES + C.wave, NGW = C.G * NWAVES;
    f32x4 gv[8];
#pragma unroll
    for (int j = 0; j < 8; ++j) gv[j] = *(const f32x4*)(g + 4 * (C.lane + 64 * j));
    for (int m = gw; m < M; m += NGW) {
        f32x4* xr = (f32x4*)(x + (size_t)m * DM) + C.lane; f32x4 v[8]; float s = 0.f;
#pragma unroll
        for (int j = 0; j < 8; ++j) { v[j] = xr[64 * j]; s += (v[j].x * v[j].x + v[j].y * v[j].y) + (v[j].z * v[j].z + v[j].w * v[j].w); }
        const float rs = rsqrtf(wave_sum(s) * (1.0f / DM) + 1e-5f);
#pragma unroll
        for (int j = 0; j < 8; ++j) xr[64 * j] = v[j] * rs * gv[j];
    }
}
__device__ __forceinline__ void phase_prep_a(const Ctx& C) {
    const long gt = (long)C.bid * NTHR + C.tid, NGT = (long)C.G * NTHR;
    for (int cfg = 0; cfg < 6; ++cfg) {
        size_t off; int ld, nh, hd, half; size_t tab;
        if (cfg == 0) { off = WS_Q; ld = 1024; nh = 8; hd = 128; half = 16; tab = TAB_A; }
        else if (cfg == 1) { off = WS_K; ld = 1024; nh = 8; hd = 128; half = 16; tab = TAB_A; }
        else if (cfg == 2) { off = WS_QI; ld = 1024; nh = 16; hd = 64; half = 8; tab = TAB_I; }
        else if (cfg == 3) { off = WS_KW; ld = 256; nh = 1; hd = 64; half = 8; tab = TAB_I; }
        else if (cfg == 4) { off = WS_BQ; ld = 256; nh = 4; hd = 64; half = 32; tab = TAB_R; }
        else { off = WS_BK; ld = 256; nh = 4; hd = 64; half = 32; tab = TAB_R; }
        bf16* buf = (bf16*)(C.ws + off); const float2* tb = (const float2*)(C.ws + WS_TAB + tab);
        const int cpp = half >> 3; const long total = (long)M * nh * cpp;
        for (long it = gt; it < total; it += NGT) {
            const int c = (int)(it % cpp); const long r2 = it / cpp; const int h = (int)(r2 % nh); const int row = (int)(r2 / nh); const int pos = row & (T - 1);
            bf16* p1 = buf + (size_t)row * ld + h * hd + 8 * c; bf16* p2 = p1 + half;
            const u32x4 a = *(const u32x4*)p1, b = *(const u32x4*)p2; const float2* tp = tb + (size_t)pos * half + 8 * c;
            float x1[8], x2[8];
#pragma unroll
            for (int e = 0; e < 4; ++e) { x1[2 * e] = bflo(a[e]); x1[2 * e + 1] = bfhi(a[e]); x2[2 * e] = bflo(b[e]); x2[2 * e + 1] = bfhi(b[e]); }
            u32x4 oa, ob;
#pragma unroll
            for (int e = 0; e < 4; ++e) {
                const float2 t0 = tp[2 * e], t1 = tp[2 * e + 1];
                oa[e] = pk2(x1[2 * e] * t0.x - x2[2 * e] * t0.y, x1[2 * e + 1] * t1.x - x2[2 * e + 1] * t1.y);
                ob[e] = pk2(x2[2 * e] * t0.x + x1[2 * e] * t0.y, x2[2 * e + 1] * t1.x + x1[2 * e + 1] * t1.y);
            }
            *(u32x4*)p1 = oa; *(u32x4*)p2 = ob;
        }
    }
    {
        LAS unsigned short* scr = (LAS unsigned short*)(C.lds + C.wave * 8704);
        const bf16* V = (const bf16*)(C.ws + WS_V); bf16* Vt = (bf16*)(C.ws + WS_VT);
        const int gw = C.bid * NWAVES + C.wave, NGW = C.G * NWAVES;
        for (int it = gw; it < NB * 128 * 16; it += NGW) {
            const int ct = it & 15, tt = (it >> 4) & 127, b = it >> 11;
            const int t0 = tt * 64, c0 = ct * 64;
#pragma unroll 4
            for (int i = 0; i < 32; ++i) { const int tr = 2 * i + (C.lane >> 5), cc = 2 * (C.lane & 31);
                const unsigned w = *(const unsigned*)(V + (size_t)(b * T + t0 + tr) * 1024 + c0 + cc); scr[tr * 66 + cc] = (unsigned short)(w & 0xffffu); scr[tr * 66 + cc + 1] = (unsigned short)(w >> 16); }
            LDS_WAIT(); asm volatile("" ::: "memory");
#pragma unroll 4
            for (int i = 0; i < 32; ++i) { const int cr = 2 * i + (C.lane >> 5), tp = 2 * (C.lane & 31);
                const unsigned w = (unsigned)scr[tp * 66 + cr] | ((unsigned)scr[(tp + 1) * 66 + cr] << 16);
                *(unsigned*)(Vt + ((size_t)b * 1024 + c0 + cr) * T + t0 + tp) = w; }
            LDS_WAIT(); asm volatile("" ::: "memory");
        }
    }
}
#ifndef IDX_REP_T
#define IDX_REP_T 1
#endif
#ifndef IDX_REP_S
#define IDX_REP_S 1
#endif
__device__ __forceinline__ void phase_indexer(const Ctx& C) {
    LAS unsigned short* sc = (LAS unsigned short*)C.lds;
    LAS unsigned* hist = (LAS unsigned*)(C.lds + 131072) + C.wave * 256;
    LAS float* wvl = (LAS float*)(C.lds + 131072 + 8192);
    LAS unsigned short* qbl = (LAS unsigned short*)(C.lds + 131072 + 8192 + 512);
    const bf16* QI = (const bf16*)(C.ws + WS_QI); const bf16* KW = (const bf16*)(C.ws + WS_KW); u64* MASK = (u64*)(C.ws + WS_MASK);
    const int lane = C.lane, r32 = lane & 31, hi = lane >> 5;
    for (int it = C.bid; it < NB * (T / 8); it += C.G) {
        const int b = it & 3, qg = it >> 2, q0 = qg * 8, qchunk = q0 >> 6, nadm = 64 * (qchunk + 1);
        const int qrow = b * T + q0 + C.wave;
        if (qchunk < 4) {
            MASK[(size_t)qrow * 128 + lane] = lane <= qchunk ? ~0ull : 0ull; MASK[(size_t)qrow * 128 + 64 + lane] = 0ull;
            continue;
        }
        bf16x8 af[4][4];
        {
            const int qq = (r32 >> 2) & 1, hh = (r32 & 3) + 4 * (r32 >> 3);
#pragma unroll
            for (int pr = 0; pr < 4; ++pr) {
                const bf16* qp = QI + (size_t)(b * T + q0 + 2 * pr + qq) * 1024 + hh * 64 + 8 * hi;
#pragma unroll
                for (int kk = 0; kk < 4; ++kk) af[pr][kk] = *(const bf16x8*)(qp + 16 * kk);
            }
            if (C.tid < 128) wvl[C.tid] = bf2f(KW[(size_t)(b * T + q0 + (C.tid >> 4)) * 256 + 64 + (C.tid & 15)]) * 0.015625f;
        }
        __syncthreads();
        { const int qx = C.tid >> 6, dx = C.tid & 63; const bf16* qp = QI + (size_t)(b * T + q0 + qx) * 1024 + dx; float acc = 0.f;
#pragma unroll
          for (int h = 0; h < 16; ++h) acc += wvl[qx * 16 + h] * bf2f(qp[h * 64]);
          qbl[qx * 64 + dx] = (unsigned short)f2bf(acc); }
        __syncthreads();
        bf16x8 afl[4];
        { const int qsel = 2 * (r32 & 3) + ((r32 >> 2) & 1);
#pragma unroll
          for (int kk = 0; kk < 4; ++kk) { const u32x4 z = {0u, 0u, 0u, 0u}; afl[kk] = r32 < 8 ? *(const LAS bf16x8*)(qbl + qsel * 64 + 16 * kk + 8 * hi) : __builtin_bit_cast(bf16x8, z); } }
        for (int rep_t = 0; rep_t < IDX_REP_T; ++rep_t) {
            const int ntile = nadm / 32;
            bf16x8 bfr[4], bnx[4];
            { const bf16* kp = KW + (size_t)(b * T + 32 * C.wave + r32) * 256 + 8 * hi;
#pragma unroll
              for (int kk = 0; kk < 4; ++kk) bnx[kk] = *(const bf16x8*)(kp + 16 * kk); }
            for (int tile = C.wave; tile < ntile; tile += NWAVES) {
                const int key0 = 32 * tile;
#pragma unroll
                for (int kk = 0; kk < 4; ++kk) bfr[kk] = bnx[kk];
                if (tile + NWAVES < ntile) { const bf16* kp = KW + (size_t)(b * T + key0 + 32 * NWAVES + r32) * 256 + 8 * hi;
#pragma unroll
                    for (int kk = 0; kk < 4; ++kk) bnx[kk] = *(const bf16x8*)(kp + 16 * kk); }
                const int kpos = (key0 & ~127) + 2 * ((key0 & 63) + r32) + ((key0 >> 6) & 1);
                f32x16 dl = {0.f, 0.f, 0.f, 0.f, 0.f, 0.f, 0.f, 0.f, 0.f, 0.f, 0.f, 0.f, 0.f, 0.f, 0.f, 0.f};
#pragma unroll
                for (int kk = 0; kk < 4; ++kk) dl = __builtin_amdgcn_mfma_f32_32x32x16_bf16(afl[kk], bfr[kk], dl, 0, 0, 0);
#pragma unroll
                for (int pr = 0; pr < 4; ++pr) {
                    f32x16 d = {0.f, 0.f, 0.f, 0.f, 0.f, 0.f, 0.f, 0.f, 0.f, 0.f, 0.f, 0.f, 0.f, 0.f, 0.f, 0.f};
#pragma unroll
                    for (int kk = 0; kk < 4; ++kk) d = __builtin_amdgcn_mfma_f32_32x32x16_bf16(af[pr][kk], bfr[kk], d, 0, 0, 0);
                    float s0 = dl[pr];
#pragma unroll
                    for (int g = 0; g < 4; ++g) { const f32x4 w4 = *(const LAS f32x4*)(wvl + (2 * pr + hi) * 16 + 4 * g);
                        s0 = __builtin_fmaf(__builtin_fabsf(d[4 * g]), w4.x, s0); s0 = __builtin_fmaf(__builtin_fabsf(d[4 * g + 1]), w4.y, s0); s0 = __builtin_fmaf(__builtin_fabsf(d[4 * g + 2]), w4.z, s0); s0 = __builtin_fmaf(__builtin_fabsf(d[4 * g + 3]), w4.w, s0); }
                    const unsigned short hb = __half_as_ushort(__float2half_rn(s0));
                    const unsigned short key = (hb & 0x8000u) ? (unsigned short)~hb : (unsigned short)(hb | 0x8000u);
                    sc[(2 * pr + hi) * 8192 + kpos] = key;
                }
            }
        }
        __syncthreads();
        const LAS unsigned* my = (const LAS unsigned*)(sc + C.wave * 8192);
        const int nit = nadm / 128;
        const bool tail = (nadm & 64) != 0;
        unsigned thr = 0;
        for (int rep_s = 0; rep_s < IDX_REP_S; ++rep_s) {
            unsigned want = 256u, prefix = 0u;
#pragma unroll 1
            for (int lvl = 0; lvl < 2; ++lvl) {
                hist[lane] = 0u; hist[64 + lane] = 0u; hist[128 + lane] = 0u; hist[192 + lane] = 0u;
                LDS_WAIT(); asm volatile("" ::: "memory");
                int i = 0;
                for (; i + 4 <= nit; i += 4) { unsigned kv[4];
#pragma unroll
                    for (int u = 0; u < 4; ++u) kv[u] = my[64 * (i + u) + lane];
#pragma unroll
                    for (int u = 0; u < 4; ++u) { const unsigned k0 = kv[u] & 0xffffu, k1 = kv[u] >> 16;
                        if (lvl == 0) { atomicAdd((unsigned*)&hist[k0 >> 8], 1u); atomicAdd((unsigned*)&hist[k1 >> 8], 1u); }
                        else { if ((k0 >> 8) == prefix) atomicAdd((unsigned*)&hist[k0 & 255u], 1u); if ((k1 >> 8) == prefix) atomicAdd((unsigned*)&hist[k1 & 255u], 1u); } } }
                for (; i < nit + (tail ? 1 : 0); ++i) { const unsigned kvv = my[64 * i + lane]; const unsigned k0 = kvv & 0xffffu, k1 = kvv >> 16; const bool two = i < nit;
                    if (lvl == 0) { atomicAdd((unsigned*)&hist[k0 >> 8], 1u); if (two) atomicAdd((unsigned*)&hist[k1 >> 8], 1u); }
                    else { if ((k0 >> 8) == prefix) atomicAdd((unsigned*)&hist[k0 & 255u], 1u); if (two && (k1 >> 8) == prefix) atomicAdd((unsigned*)&hist[k1 & 255u], 1u); } }
                LDS_WAIT(); asm volatile("" ::: "memory");
                const unsigned c0 = hist[4 * lane], c1 = hist[4 * lane + 1], c2 = hist[4 * lane + 2], c3 = hist[4 * lane + 3];
                const unsigned tl = c0 + c1 + c2 + c3; unsigned inc = tl;
#pragma unroll
                for (int o = 1; o < 64; o <<= 1) { const unsigned v = __shfl_down(inc, o); if (lane + o < 64) inc += v; }
                const unsigned ab3 = inc - tl, ab2 = ab3 + c3, ab1 = ab2 + c2, ab0 = ab1 + c1;
                int selb = -1; unsigned rem = 0;
                if (ab3 < want && ab3 + c3 >= want) { selb = 3; rem = want - ab3; }
                else if (ab2 < want && ab2 + c2 >= want) { selb = 2; rem = want - ab2; }
                else if (ab1 < want && ab1 + c1 >= want) { selb = 1; rem = want - ab1; }
                else if (ab0 < want && ab0 + c0 >= want) { selb = 0; rem = want - ab0; }
                const u64 bal = __ballot(selb >= 0); const int src = bal ? (int)__ffsll((long long)bal) - 1 : 0;
                const unsigned bin = (unsigned)__shfl(4 * lane + (selb < 0 ? 0 : selb), src); want = (unsigned)__shfl((int)rem, src);
                if (lvl == 0) prefix = bin; else thr = (prefix << 8) | bin;
                LDS_WAIT(); asm volatile("" ::: "memory");
            }
        }
        u64 w0 = 0, w1 = 0;
        for (int i = 0; i < nit + (tail ? 1 : 0); ++i) { const unsigned kvv = my[64 * i + lane]; const u64 b0 = __ballot((kvv & 0xffffu) >= thr), b1 = (i < nit) ? __ballot((kvv >> 16) >= thr) : 0ull;
            if (i < 32) { if (lane == 2 * i) w0 = b0; if (lane == 2 * i + 1) w0 = b1; } else { if (lane == 2 * i - 64) w1 = b0; if (lane == 2 * i - 63) w1 = b1; } }
        MASK[(size_t)qrow * 128 + lane] = w0; MASK[(size_t)qrow * 128 + 64 + lane] = w1;
        __syncthreads();
    }
}
constexpr int AT_KROW = 272, AT_VROW = 136, AT_KB = 64 * AT_KROW, AT_VB = 128 * AT_VROW, AT_BUF = AT_KB + AT_VB;
__device__ __forceinline__ void attn_unit(const Ctx& C, int b, int head, int qb) {
    const bf16* Q = (const bf16*)(C.ws + WS_Q); const bf16* K = (const bf16*)(C.ws + WS_K); const bf16* Vt = (const bf16*)(C.ws + WS_VT);
    const u64* MASK = (const u64*)(C.ws + WS_MASK); bf16* CAT = (bf16*)(C.ws + WS_CAT);
    const int tid = C.tid, lane = C.lane, wid = C.wave, r32 = lane & 31, hi = lane >> 5;
    const int q = 256 * qb + 32 * wid + r32; const size_t row = (size_t)b * T + q;
    const int nt = 4 * qb + 4, myc = 4 * qb + (wid >> 1);
    bf16x8 qf[8];
#pragma unroll
    for (int d0 = 0; d0 < 8; ++d0) qf[d0] = *(const bf16x8*)(Q + row * 1024 + head * 128 + 16 * d0 + 8 * hi);
    const bf16* kg[2]; const bf16* vg[2]; int kl[2], vl[2];
#pragma unroll
    for (int i = 0; i < 2; ++i) { const int c = tid + 512 * i;
        kg[i] = K + ((size_t)b * T + (c >> 4)) * 1024 + head * 128 + (c & 15) * 8; kl[i] = (c >> 4) * AT_KROW + (c & 15) * 16;
        vg[i] = Vt + ((size_t)(b * 8 + head) * 128 + (c >> 3)) * T + (c & 7) * 8; vl[i] = AT_KB + (c >> 3) * AT_VROW + (c & 7) * 16; }
    u32x4 kr[2], vr[2];
#pragma unroll
    for (int i = 0; i < 2; ++i) { kr[i] = *(const u32x4*)kg[i]; vr[i] = *(const u32x4*)vg[i]; }
#pragma unroll
    for (int i = 0; i < 2; ++i) { *(LAS u32x4*)(C.lds + kl[i]) = kr[i]; *(LAS u32x2*)(C.lds + vl[i]) = (u32x2){vr[i].x, vr[i].y}; *(LAS u32x2*)(C.lds + vl[i] + 8) = (u32x2){vr[i].z, vr[i].w}; }
    __syncthreads();
    float lrun = 0.f; f32x16 o[4];
#pragma unroll
    for (int db = 0; db < 4; ++db)
#pragma unroll
        for (int r = 0; r < 16; ++r) o[db][r] = 0.f;
    for (int t = 0; t < nt; ++t) {
        const int cur = (t & 1) * AT_BUF, nxt = ((t + 1) & 1) * AT_BUF;
        if (t + 1 < nt) {
#pragma unroll
            for (int i = 0; i < 2; ++i) { kr[i] = *(const u32x4*)(kg[i] + (size_t)(t + 1) * 64 * 1024); vr[i] = *(const u32x4*)(vg[i] + (t + 1) * 64); }
        }
        if (t <= myc) {
            const u64 mw = MASK[row * 128 + t];
            const LAS unsigned char* Ks = C.lds + cur; const LAS unsigned char* Vs = C.lds + cur + AT_KB;
            f32x16 p0, p1;
#pragma unroll
            for (int r = 0; r < 16; ++r) { p0[r] = 0.f; p1[r] = 0.f; }
#pragma unroll
            for (int d0 = 0; d0 < 8; ++d0) {
                const bf16x8 k0 = *(const LAS bf16x8*)(Ks + r32 * AT_KROW + (16 * d0 + 8 * hi) * 2);
                const bf16x8 k1 = *(const LAS bf16x8*)(Ks + (32 + r32) * AT_KROW + (16 * d0 + 8 * hi) * 2);
                p0 = __builtin_amdgcn_mfma_f32_32x32x16_bf16(k0, qf[d0], p0, 0, 0, 0);
                p1 = __builtin_amdgcn_mfma_f32_32x32x16_bf16(k1, qf[d0], p1, 0, 0, 0);
            }
            const int mlo = (int)((unsigned)mw >> (4 * hi)), mhi = (int)((unsigned)(mw >> 32) >> (4 * hi));
            float ls0 = 0.f, ls1 = 0.f;
#pragma unroll
            for (int r = 0; r < 16; ++r) { const int c = (r & 3) + 8 * (r >> 2);
                const unsigned e0 = __float_as_uint(__builtin_amdgcn_exp2f(p0[r])) & (unsigned)__builtin_amdgcn_sbfe(mlo, c, 1);
                const unsigned e1 = __float_as_uint(__builtin_amdgcn_exp2f(p1[r])) & (unsigned)__builtin_amdgcn_sbfe(mhi, c, 1);
                p0[r] = __uint_as_float(e0); p1[r] = __uint_as_float(e1); ls0 += p0[r]; ls1 += p1[r]; }
            lrun += ls0 + ls1;
            bf16x8 pb[4];
#pragma unroll
            for (int kk = 0; kk < 4; ++kk) { u32x4 w;
#pragma unroll
                for (int e = 0; e < 4; ++e) { const int r = 8 * (kk & 1) + 2 * e; w[e] = (kk < 2) ? pg8::cvt_pk_bf16(p0[r], p0[r + 1]) : pg8::cvt_pk_bf16(p1[r], p1[r + 1]); }
                pb[kk] = __builtin_bit_cast(bf16x8, w); }
#pragma unroll
            for (int db = 0; db < 4; ++db)
#pragma unroll
                for (int kk = 0; kk < 4; ++kk) {
                    const LAS unsigned char* vp = Vs + (32 * db + r32) * AT_VROW + (16 * kk + 4 * hi) * 2;
                    const u32x2 a0 = *(const LAS u32x2*)vp, a1 = *(const LAS u32x2*)(vp + 16);
                    const u32x4 w = {a0.x, a0.y, a1.x, a1.y};
                    o[db] = __builtin_amdgcn_mfma_f32_32x32x16_bf16(__builtin_bit_cast(bf16x8, w), pb[kk], o[db], 0, 0, 0);
                }
        }
        if (t + 1 < nt) {
#pragma unroll
            for (int i = 0; i < 2; ++i) { *(LAS u32x4*)(C.lds + nxt + kl[i]) = kr[i]; *(LAS u32x2*)(C.lds + nxt + vl[i]) = (u32x2){vr[i].x, vr[i].y}; *(LAS u32x2*)(C.lds + nxt + vl[i] + 8) = (u32x2){vr[i].z, vr[i].w}; }
        }
        __syncthreads();
    }
    lrun += __shfl_xor(lrun, 32);
    const float inv = 1.0f / lrun;
    bf16* op = CAT + row * 2048 + head * 128 + 4 * hi;
#pragma unroll
    for (int db = 0; db < 4; ++db)
#pragma unroll
        for (int g = 0; g < 4; ++g) { u32x2 w; w.x = pk2(o[db][4 * g] * inv, o[db][4 * g + 1] * inv); w.y = pk2(o[db][4 * g + 2] * inv, o[db][4 * g + 3] * inv);
            *(u32x2*)(op + 32 * db + 8 * g) = w; }
}
__device__ __forceinline__ void phase_attn(const Ctx& C) {
    for (int i = C.bid; i < 1024; i += C.G) {
        const int w = i & 255, k = i >> 8, combo = w >> 3, j = w & 7;
        const int qb = k == 0 ? j : k == 1 ? 15 - j : k == 2 ? 16 + j : 31 - j;
        attn_unit(C, combo >> 3, combo & 7, qb);
        __syncthreads();
    }
}
__device__ __forceinline__ float ret_logg(int h) { return log1pf(-exp2f(-5.0f - (float)h)); }
constexpr int RT_KS = 68;
__device__ __forceinline__ void phase_ret1(const Ctx& C) {
    LAS float* Ks = (LAS float*)C.lds;
    LAS float* Vs = (LAS float*)(C.lds + 64 * RT_KS * 4);
    const bf16* BK = (const bf16*)(C.ws + WS_BK); const bf16* BV = (const bf16*)(C.ws + WS_BV); float* KV = (float*)(C.ws + WS_KVST);
    const int tid = C.tid;
    for (int u = C.bid; u < NB * 128 * 4; u += C.G) {
        const int h = u & 3, c = (u >> 2) & 127, b = u >> 9; const size_t row0 = (size_t)b * T + 64 * c; const float lg = ret_logg(h);
        { const int m = tid >> 3, d8 = (tid & 7) * 8; const u32x4 w = *(const u32x4*)(BK + (row0 + m) * 256 + h * 64 + d8); const float z = __expf((63.0f - (float)m) * lg) * 0.125f;
#pragma unroll
          for (int e = 0; e < 4; ++e) { Ks[m * RT_KS + d8 + 2 * e] = bflo(w[e]) * z; Ks[m * RT_KS + d8 + 2 * e + 1] = bfhi(w[e]) * z; } }
#pragma unroll
        for (int i = 0; i < 2; ++i) { const int cidx = tid + 512 * i, m = cidx >> 4, e8 = (cidx & 15) * 8; const u32x4 w = *(const u32x4*)(BV + (row0 + m) * 512 + h * 128 + e8);
#pragma unroll
          for (int e = 0; e < 4; ++e) { Vs[m * 128 + e8 + 2 * e] = bflo(w[e]); Vs[m * 128 + e8 + 2 * e + 1] = bfhi(w[e]); } }
        __syncthreads();
        const int d = tid & 63, eg = tid >> 6; float acc[16];
#pragma unroll
        for (int e = 0; e < 16; ++e) acc[e] = 0.f;
        for (int m = 0; m < 64; ++m) { const float kv = Ks[m * RT_KS + d];
#pragma unroll
            for (int e4 = 0; e4 < 4; ++e4) { const f32x4 v = *(const LAS f32x4*)(Vs + m * 128 + 16 * eg + 4 * e4); acc[4 * e4] += kv * v.x; acc[4 * e4 + 1] += kv * v.y; acc[4 * e4 + 2] += kv * v.z; acc[4 * e4 + 3] += kv * v.w; } }
        float* dst = KV + (size_t)u * 8192 + d * 128 + 16 * eg;
#pragma unroll
        for (int e4 = 0; e4 < 4; ++e4) *(f32x4*)(dst + 4 * e4) = (f32x4){acc[4 * e4], acc[4 * e4 + 1], acc[4 * e4 + 2], acc[4 * e4 + 3]};
        __syncthreads();
    }
}
__device__ __forceinline__ void phase_ret2(const Ctx& C) {
    float* KV = (float*)(C.ws + WS_KVST);
    for (int g = C.bid * NTHR + C.tid; g < NB * 4 * 8192; g += C.G * NTHR) {
        const int el = g & 8191, h = (g >> 13) & 3, b = g >> 15; const float gc = __expf(64.0f * ret_logg(h));
        float* p = KV + ((size_t)b * 512 + h) * 8192 + el;
        float st = 0.f;
        for (int c0 = 0; c0 < 128; c0 += 8) { float x[8];
#pragma unroll
            for (int i = 0; i < 8; ++i) x[i] = p[(size_t)(c0 + i) * 4 * 8192];
#pragma unroll
            for (int i = 0; i < 8; ++i) { p[(size_t)(c0 + i) * 4 * 8192] = st; st = st * gc + x[i]; } }
    }
}
__device__ __forceinline__ void phase_ret3(const Ctx& C) {
    LAS float* Qs = (LAS float*)C.lds;
    LAS float* Ks = Qs + 64 * RT_KS;
    LAS float* Sc = Ks + 64 * RT_KS;
    LAS float* Vs = Sc + 64 * RT_KS;
    LAS float* Ps = Vs + 64 * 128;
    const bf16* BQ = (const bf16*)(C.ws + WS_BQ); const bf16* BK = (const bf16*)(C.ws + WS_BK); const bf16* BV = (const bf16*)(C.ws + WS_BV); const bf16* BG = (const bf16*)(C.ws + WS_BG);
    const float* KV = (const float*)(C.ws + WS_KVST); bf16* CAT = (bf16*)(C.ws + WS_CAT);
    const int tid = C.tid;
    for (int u = C.bid; u < NB * 128 * 4; u += C.G) {
        const int h = u & 3, c = (u >> 2) & 127, b = u >> 9; const size_t row0 = (size_t)b * T + 64 * c; const float lg = ret_logg(h);
        { const int m = tid >> 3, d8 = (tid & 7) * 8; const u32x4 wq = *(const u32x4*)(BQ + (row0 + m) * 256 + h * 64 + d8), wk = *(const u32x4*)(BK + (row0 + m) * 256 + h * 64 + d8);
#pragma unroll
          for (int e = 0; e < 4; ++e) { Qs[m * RT_KS + d8 + 2 * e] = bflo(wq[e]); Qs[m * RT_KS + d8 + 2 * e + 1] = bfhi(wq[e]); Ks[m * RT_KS + d8 + 2 * e] = bflo(wk[e]) * 0.125f; Ks[m * RT_KS + d8 + 2 * e + 1] = bfhi(wk[e]) * 0.125f; } }
#pragma unroll
        for (int i = 0; i < 2; ++i) { const int cidx = tid + 512 * i, m = cidx >> 4, e8 = (cidx & 15) * 8; const u32x4 w = *(const u32x4*)(BV + (row0 + m) * 512 + h * 128 + e8);
#pragma unroll
          for (int e = 0; e < 4; ++e) { Vs[m * 128 + e8 + 2 * e] = bflo(w[e]); Vs[m * 128 + e8 + 2 * e + 1] = bfhi(w[e]); } }
#pragma unroll
        for (int i = 0; i < 4; ++i) { const int cidx = tid + 512 * i; *(LAS f32x4*)(Ps + 4 * cidx) = *(const f32x4*)(KV + (size_t)u * 8192 + 4 * cidx); }
        __syncthreads();
        {
            const int n = tid >> 3, mg = tid & 7; float s[8];
#pragma unroll
            for (int j = 0; j < 8; ++j) s[j] = 0.f;
            for (int d4 = 0; d4 < 16; ++d4) { const f32x4 qv = *(const LAS f32x4*)(Qs + n * RT_KS + 4 * d4);
#pragma unroll
                for (int j = 0; j < 8; ++j) { const f32x4 kv = *(const LAS f32x4*)(Ks + (mg + 8 * j) * RT_KS + 4 * d4); s[j] += (qv.x * kv.x + qv.y * kv.y) + (qv.z * kv.z + qv.w * kv.w); } }
#pragma unroll
            for (int j = 0; j < 8; ++j) { const int m = mg + 8 * j; Sc[n * RT_KS + m] = (m <= n) ? s[j] * __expf((float)(n - m) * lg) : 0.f; }
        }
        __syncthreads();
        {
            const int n = tid >> 3, eg = tid & 7; float acc[16], cr[16];
#pragma unroll
            for (int e = 0; e < 16; ++e) { acc[e] = 0.f; cr[e] = 0.f; }
            for (int m = 0; m <= n; ++m) { const float sv = Sc[n * RT_KS + m];
#pragma unroll
                for (int e4 = 0; e4 < 4; ++e4) { const f32x4 v = *(const LAS f32x4*)(Vs + m * 128 + 16 * eg + 4 * e4); acc[4 * e4] += sv * v.x; acc[4 * e4 + 1] += sv * v.y; acc[4 * e4 + 2] += sv * v.z; acc[4 * e4 + 3] += sv * v.w; } }
            for (int d = 0; d < 64; ++d) { const float qv = Qs[n * RT_KS + d];
#pragma unroll
                for (int e4 = 0; e4 < 4; ++e4) { const f32x4 v = *(const LAS f32x4*)(Ps + d * 128 + 16 * eg + 4 * e4); cr[4 * e4] += qv * v.x; cr[4 * e4 + 1] += qv * v.y; cr[4 * e4 + 2] += qv * v.z; cr[4 * e4 + 3] += qv * v.w; } }
            const float xi = __expf((float)(n + 1) * lg); float sum = 0.f;
#pragma unroll
            for (int e = 0; e < 16; ++e) { acc[e] += xi * cr[e]; sum += acc[e]; }
            sum += __shfl_xor(sum, 1); sum += __shfl_xor(sum, 2); sum += __shfl_xor(sum, 4);
            const float mu = sum * (1.0f / 128.0f); float var = 0.f;
#pragma unroll
            for (int e = 0; e < 16; ++e) { const float dlt = acc[e] - mu; var += dlt * dlt; }
            var += __shfl_xor(var, 1); var += __shfl_xor(var, 2); var += __shfl_xor(var, 4);
            const float rstd = rsqrtf(var * (1.0f / 128.0f) + 1e-5f);
            const bf16* gp = BG + (row0 + n) * 512 + h * 128 + 16 * eg; const u32x4 g0 = *(const u32x4*)gp, g1 = *(const u32x4*)(gp + 8);
            float gv[16];
#pragma unroll
            for (int e = 0; e < 4; ++e) { gv[2 * e] = bflo(g0[e]); gv[2 * e + 1] = bfhi(g0[e]); gv[8 + 2 * e] = bflo(g1[e]); gv[8 + 2 * e + 1] = bfhi(g1[e]); }
            float ov[16];
#pragma unroll
            for (int e = 0; e < 16; ++e) { const float gg = gv[e]; const float sl = gg * __builtin_amdgcn_rcpf(1.0f + __expf(-gg)); ov[e] = (acc[e] - mu) * rstd * sl; }
            bf16* op = CAT + (row0 + n) * 2048 + 1024 + h * 128 + 16 * eg;
            u32x4 w0, w1;
#pragma unroll
            for (int e = 0; e < 4; ++e) { w0[e] = pk2(ov[2 * e], ov[2 * e + 1]); w1[e] = pk2(ov[8 + 2 * e], ov[8 + 2 * e + 1]); }
            *(u32x4*)op = w0; *(u32x4*)(op + 8) = w1;
        }
        __syncthreads();
    }
}
__device__ __forceinline__ float sigmoidf_(float x) { return __builtin_amdgcn_rcpf(1.0f + __expf(-x)); }
constexpr int RW_AW = 104, RW_AV = 72, RW_AG = 264;
__device__ __forceinline__ void ld4bf(const bf16* p, float (&v)[4]) { const u32x2 w = *(const u32x2*)p; v[0] = bflo(w.x); v[1] = bfhi(w.x); v[2] = bflo(w.y); v[3] = bfhi(w.y); }
__device__ __forceinline__ void shift4(const bf16* buf, size_t m, int ld, int c4, bool first, const float* mu, float (&o)[4]) {
    float cur[4], prv[4] = {0.f, 0.f, 0.f, 0.f}; ld4bf(buf + m * ld + c4, cur); if (!first) ld4bf(buf + (m - 1) * ld + c4, prv);
    const f32x4 muv = *(const f32x4*)mu;
#pragma unroll
    for (int e = 0; e < 4; ++e) o[e] = cur[e] + (prv[e] - cur[e]) * muv[e];
}
struct RwP { const float *mu, *mu_v, *w0, *a0, *v0, *k_k, *k_a, *r_k, *lnx_g, *lnx_b; };
__device__ __forceinline__ void phase_rw1(const Ctx& C, int layer, const RwP& P) {
    LAS bf16* AW = (LAS bf16*)C.lds; LAS bf16* AA = AW + 32 * RW_AW; LAS bf16* AV = AA + 32 * RW_AW;
    const bf16* CR = (const bf16*)(C.ws + WS_CR); const bf16* CK = (const bf16*)(C.ws + WS_CK); const bf16* CV = (const bf16*)(C.ws + WS_CV); const bf16* CL = (const bf16*)(C.ws + WS_CL);
    const bf16* LW = (const bf16*)(C.ws + WS_LORA + LO_W); const bf16* LA = (const bf16*)(C.ws + WS_LORA + LO_A); const bf16* LV = (const bf16*)(C.ws + WS_LORA + LO_V);
    bf16* VF = (bf16*)(C.ws + WS_VFIRST);
    float* RR = (float*)(C.ws + WS_RR); float* RWd = (float*)(C.ws + WS_RW); float* RKH = (float*)(C.ws + WS_RKH); float* RV = (float*)(C.ws + WS_RV); float* RA = (float*)(C.ws + WS_RA); float* RB = (float*)(C.ws + WS_RB);
    const float* mu = P.mu + (size_t)layer * 1984; const float* mu_v = P.mu_v;
    const float* w0 = P.w0 + layer * 512; const float* a0 = P.a0 + layer * 512; const float* v0 = P.v0; const float* k_k = P.k_k + layer * 512; const float* k_a = P.k_a + layer * 512;
    const int tid = C.tid, lane = C.lane, wid = C.wave;
    for (int u = C.bid; u < M / 32; u += C.G) {
        int r32 = lane & 31, hi = lane >> 5; asm volatile("" : "+v"(r32), "+v"(hi));
        const size_t m0 = (size_t)u * 32;
        for (int idx = tid; idx < 32 * 256; idx += NTHR) {
            const int tok = idx >> 8, c = idx & 255; const size_t m = m0 + tok; const bool first = (m & (T - 1)) == 0;
            const float cur = bf2f(CL[m * 256 + c]); const float prv = first ? 0.f : bf2f(CL[(m - 1) * 256 + c]);
            const float muc = c < 192 ? mu[1536 + c] : (layer > 0 ? mu_v[c - 192] : 0.f);
            const float xs = cur + (prv - cur) * muc;
            if (c < 96) AW[tok * RW_AW + c] = (bf16)f2bf(tanhf(xs)); else if (c < 192) AA[tok * RW_AW + (c - 96)] = (bf16)f2bf(xs); else AV[tok * RW_AV + (c - 192)] = (bf16)f2bf(xs);
        }
        __syncthreads();
        const size_t m = m0 + r32; const bool first = (m & (T - 1)) == 0;
        float ss = 0.f;
#pragma unroll
        for (int cb = 0; cb < 2; ++cb)
#pragma unroll
            for (int g = 0; g < 4; ++g) { const int c4 = 64 * wid + 32 * cb + 8 * g + 4 * hi; float ks[4]; shift4(CK, m, 512, c4, first, mu + 512 + c4, ks); const f32x4 kkv = *(const f32x4*)(k_k + c4);
#pragma unroll
                for (int e = 0; e < 4; ++e) { const float kr = ks[e] * kkv[e]; ss += kr * kr; } }
        ss += __shfl_xor(ss, 32);
        const float inv = 1.0f / fmaxf(sqrtf(ss), 1e-12f);
#pragma unroll
        for (int cb = 0; cb < 2; ++cb) {
            f32x16 dw, da, dv;
#pragma unroll
            for (int r = 0; r < 16; ++r) { dw[r] = 0.f; da[r] = 0.f; dv[r] = 0.f; }
            const int ch = 64 * wid + 32 * cb + r32;
#pragma unroll
            for (int kk = 0; kk < 6; ++kk) {
                const bf16x8 aw = *(const bf16x8*)(LW + ch * 96 + 16 * kk + 8 * hi), aa = *(const bf16x8*)(LA + ch * 96 + 16 * kk + 8 * hi);
                const bf16x8 bw = *(const LAS bf16x8*)(AW + r32 * RW_AW + 16 * kk + 8 * hi), ba = *(const LAS bf16x8*)(AA + r32 * RW_AW + 16 * kk + 8 * hi);
                dw = __builtin_amdgcn_mfma_f32_32x32x16_bf16(aw, bw, dw, 0, 0, 0); da = __builtin_amdgcn_mfma_f32_32x32x16_bf16(aa, ba, da, 0, 0, 0);
            }
            if (layer > 0) {
#pragma unroll
                for (int kk = 0; kk < 4; ++kk) {
                    const bf16x8 av = *(const bf16x8*)(LV + ch * 64 + 16 * kk + 8 * hi); const bf16x8 bv = *(const LAS bf16x8*)(AV + r32 * RW_AV + 16 * kk + 8 * hi);
                    dv = __builtin_amdgcn_mfma_f32_32x32x16_bf16(av, bv, dv, 0, 0, 0);
                }
            }
#pragma unroll
            for (int g = 0; g < 4; ++g) {
                const int c4 = 64 * wid + 32 * cb + 8 * g + 4 * hi;
                float rs[4], vs[4], ks[4];
                shift4(CR, m, 512, c4, first, mu + c4, rs); shift4(CV, m, 512, c4, first, mu + 1024 + c4, vs); shift4(CK, m, 512, c4, first, mu + 512 + c4, ks);
                const f32x4 w0v = *(const f32x4*)(w0 + c4), a0v = *(const f32x4*)(a0 + c4), kkv = *(const f32x4*)(k_k + c4), kav = *(const f32x4*)(k_a + c4);
                f32x4 vo, wo, kho, ao, bo;
                if (layer > 0) { float vf[4]; ld4bf(VF + m * 512 + c4, vf); const f32x4 v0v = *(const f32x4*)(v0 + c4);
#pragma unroll
                    for (int e = 0; e < 4; ++e) vo[e] = vs[e] + (vf[e] - vs[e]) * sigmoidf_(v0v[e] + dv[4 * g + e]); }
                else { u32x2 w; w.x = pk2(vs[0], vs[1]); w.y = pk2(vs[2], vs[3]); *(u32x2*)(VF + m * 512 + c4) = w;
#pragma unroll
                    for (int e = 0; e < 4; ++e) vo[e] = vs[e]; }
#pragma unroll
                for (int e = 0; e < 4; ++e) {
                    const float x = w0v[e] + dw[4 * g + e];
                    const float z = -x; const float sp = fmaxf(z, 0.f) + log1pf(__expf(-fabsf(z)));
                    wo[e] = __expf(-__expf(-sp - 0.5f));
                    const float a = sigmoidf_(a0v[e] + da[4 * g + e]);
                    const float ksx = ks[e]; const float kk = ksx * kkv[e] * inv;
                    kho[e] = ksx * (1.0f + (a - 1.0f) * kav[e]); ao[e] = -kk; bo[e] = kk * a;
                }
                *(f32x4*)(RR + m * 512 + c4) = (f32x4){rs[0], rs[1], rs[2], rs[3]}; *(f32x4*)(RWd + m * 512 + c4) = wo; *(f32x4*)(RKH + m * 512 + c4) = kho; *(f32x4*)(RV + m * 512 + c4) = vo;
                *(f32x4*)(RA + m * 512 + c4) = ao; *(f32x4*)(RB + m * 512 + c4) = bo;
            }
        }
        __syncthreads();
    }
}
constexpr int RW_L = 128, RW_NC = T / RW_L;
constexpr int RW_TB = 8, RW_STG = 6 * RW_TB * 64;
__device__ __forceinline__ float xhalf_sum(float x) { const auto rr = __builtin_amdgcn_permlane32_swap(__float_as_uint(x), __float_as_uint(x), false, false); return __uint_as_float(rr[0]) + __uint_as_float(rr[1]); }
template <int NS, bool OUT>
__device__ __forceinline__ void rwkv_chunk(f32x16 (&D)[NS][2][2], LAS float* stg, const float* RWd, const float* RA, const float* RB, const float* RKH, const float* RV, const float* RR, float* Y, size_t base0, int nsteps, int lane) {
    const int r32 = lane & 31, hi = lane >> 5;
    for (int t0 = 0; t0 < nsteps; t0 += RW_TB) {
        {
            float tw[RW_TB], ta[RW_TB], tr[RW_TB], tb[RW_TB], tk[RW_TB], tv[RW_TB];
#pragma unroll
            for (int s = 0; s < RW_TB; ++s) { const size_t o = base0 + (size_t)(t0 + s) * 512 + lane; tw[s] = RWd[o]; ta[s] = RA[o]; tr[s] = OUT ? RR[o] : 0.f; tb[s] = RB[o]; tk[s] = RKH[o]; tv[s] = RV[o]; }
#pragma unroll
            for (int s = 0; s < RW_TB; ++s) { stg[(0 * RW_TB + s) * 64 + lane] = tw[s]; stg[(1 * RW_TB + s) * 64 + lane] = ta[s]; if (OUT) stg[(2 * RW_TB + s) * 64 + lane] = tr[s];
                stg[(3 * RW_TB + s) * 64 + lane] = tb[s]; stg[(4 * RW_TB + s) * 64 + lane] = tk[s]; stg[(5 * RW_TB + s) * 64 + lane] = tv[s]; }
        }
        LDS_WAIT(); asm volatile("" ::: "memory");
#pragma unroll 1
        for (int s = 0; s < RW_TB; ++s) {
            const LAS float* sw = stg + (0 * RW_TB + s) * 64 + 4 * hi; const LAS float* sa_ = stg + (1 * RW_TB + s) * 64 + 4 * hi; const LAS float* sr = stg + (2 * RW_TB + s) * 64 + 4 * hi;
            const LAS float* sbk = stg + ((hi ? 4 : 3) * RW_TB + s) * 64 + r32; const LAS float* sv = stg + (5 * RW_TB + s) * 64 + r32;
            const float bk0 = sbk[0], bk1 = sbk[32], v0 = sv[0], v1 = sv[32];
            float sav[NS][2];
            {
                f32x4 av[2][4];
#pragma unroll
                for (int jb = 0; jb < 2; ++jb)
#pragma unroll
                    for (int g = 0; g < 4; ++g) av[jb][g] = *(const LAS f32x4*)(sa_ + 32 * jb + 8 * g);
#pragma unroll
                for (int st = 0; st < NS; ++st)
#pragma unroll
                    for (int ib = 0; ib < 2; ++ib) { float p0 = 0.f, p1 = 0.f;
#pragma unroll
                        for (int jb = 0; jb < 2; ++jb)
#pragma unroll
                            for (int g = 0; g < 4; ++g) { const f32x16& d = D[st][jb][ib]; p0 += d[4 * g] * av[jb][g].x; p1 += d[4 * g + 1] * av[jb][g].y; p0 += d[4 * g + 2] * av[jb][g].z; p1 += d[4 * g + 3] * av[jb][g].w; }
                        sav[st][ib] = xhalf_sum(p0 + p1); }
            }
            {
                f32x4 wv[2][4];
#pragma unroll
                for (int jb = 0; jb < 2; ++jb)
#pragma unroll
                    for (int g = 0; g < 4; ++g) wv[jb][g] = *(const LAS f32x4*)(sw + 32 * jb + 8 * g);
#pragma unroll
                for (int st = 0; st < NS; ++st)
#pragma unroll
                    for (int jb = 0; jb < 2; ++jb)
#pragma unroll
                        for (int ib = 0; ib < 2; ++ib)
#pragma unroll
                            for (int g = 0; g < 4; ++g) { f32x16& d = D[st][jb][ib]; d[4 * g] *= wv[jb][g].x; d[4 * g + 1] *= wv[jb][g].y; d[4 * g + 2] *= wv[jb][g].z; d[4 * g + 3] *= wv[jb][g].w; }
            }
#pragma unroll
            for (int st = 0; st < NS; ++st) {
                const bool inject = (NS == 1) || (st == 1);
#pragma unroll
                for (int jb = 0; jb < 2; ++jb) { const float bkj = jb == 0 ? bk0 : bk1; const float A = inject ? bkj : (hi ? 0.f : bkj);
#pragma unroll
                    for (int ib = 0; ib < 2; ++ib) { const float B = hi ? (ib == 0 ? v0 : v1) : sav[st][ib];
                        D[st][jb][ib] = __builtin_amdgcn_mfma_f32_32x32x2f32(A, B, D[st][jb][ib], 0, 0, 0); } }
            }
            if (OUT) {
                f32x4 rv[2][4];
#pragma unroll
                for (int jb = 0; jb < 2; ++jb)
#pragma unroll
                    for (int g = 0; g < 4; ++g) rv[jb][g] = *(const LAS f32x4*)(sr + 32 * jb + 8 * g);
#pragma unroll
                for (int ib = 0; ib < 2; ++ib) { float p0 = 0.f, p1 = 0.f;
#pragma unroll
                    for (int jb = 0; jb < 2; ++jb)
#pragma unroll
                        for (int g = 0; g < 4; ++g) { const f32x16& d = D[NS - 1][jb][ib]; p0 += d[4 * g] * rv[jb][g].x; p1 += d[4 * g + 1] * rv[jb][g].y; p0 += d[4 * g + 2] * rv[jb][g].z; p1 += d[4 * g + 3] * rv[jb][g].w; }
                    const float y = xhalf_sum(p0 + p1);
                    if (hi == 0) Y[base0 + (size_t)(t0 + s) * 512 + 32 * ib + r32] = y; }
            }
        }
        LDS_WAIT(); asm volatile("" ::: "memory");
    }
}
__device__ __forceinline__ void phase_rw2(const Ctx& C) {
    const float* RWd = (const float*)(C.ws + WS_RW); const float* RA = (const float*)(C.ws + WS_RA); const float* RB = (const float*)(C.ws + WS_RB); const float* RKH = (const float*)(C.ws + WS_RKH); const float* RV = (const float*)(C.ws + WS_RV);
    float* PHI = (float*)(C.ws + WS_PHI); float* PSI = (float*)(C.ws + WS_PSI);
    LAS float* stg = (LAS float*)C.lds + C.wave * RW_STG;
    const int ntask = NB * 8 * RW_NC, r32 = C.lane & 31, hi = C.lane >> 5;
    for (int task = C.wave * C.G + C.bid; task < ntask; task += C.G * NWAVES) {
        const int ck = task % RW_NC, bh = task / RW_NC, h = bh & 7, b = bh >> 3;
        const size_t base0 = ((size_t)b * T + (size_t)ck * RW_L) * 512 + h * 64;
        f32x16 D[2][2][2];
#pragma unroll
        for (int jb = 0; jb < 2; ++jb)
#pragma unroll
            for (int ib = 0; ib < 2; ++ib)
#pragma unroll
                for (int r = 0; r < 16; ++r) { D[0][jb][ib][r] = (jb == ib && ((r & 3) + 8 * (r >> 2) + 4 * hi) == r32) ? 1.f : 0.f; D[1][jb][ib][r] = 0.f; }
        rwkv_chunk<2, false>(D, stg, RWd, RA, RB, RKH, RV, nullptr, nullptr, base0, RW_L, C.lane);
#pragma unroll
        for (int st = 0; st < 2; ++st) { float* dst = (st == 0 ? PHI : PSI) + (size_t)task * 4096;
#pragma unroll
            for (int jb = 0; jb < 2; ++jb)
#pragma unroll
                for (int ib = 0; ib < 2; ++ib)
#pragma unroll
                    for (int g = 0; g < 4; ++g) *(f32x4*)(dst + (32 * ib + r32) * 64 + 32 * jb + 8 * g + 4 * hi) = (f32x4){D[st][jb][ib][4 * g], D[st][jb][ib][4 * g + 1], D[st][jb][ib][4 * g + 2], D[st][jb][ib][4 * g + 3]}; }
    }
}
constexpr int R3_P = 65;
__device__ __forceinline__ void phase_rw3(const Ctx& C) {
    const float* PHI = (const float*)(C.ws + WS_PHI); const float* PSI = (const float*)(C.ws + WS_PSI); float* SST = (float*)(C.ws + WS_SST);
    const int half = C.wave >> 2, w4 = C.wave & 3, ibo = w4 >> 1, kb = w4 & 1, r32 = C.lane & 31, hi = C.lane >> 5;
    LAS float* Sl = (LAS float*)C.lds + half * (2 * 64 * R3_P);
    for (int pr = C.bid; pr < NB * 8 / 2; pr += C.G) {
        const int bh = 2 * pr + half;
        f32x16 acc;
#pragma unroll
        for (int r = 0; r < 16; ++r) acc[r] = 0.f;
        for (int ck = 0; ck < RW_NC; ++ck) {
            const size_t task = (size_t)bh * RW_NC + ck; LAS float* Sb = Sl + (ck & 1) * (64 * R3_P);
            float* dst = SST + task * 4096;
#pragma unroll
            for (int r = 0; r < 16; ++r) { const int i = 32 * ibo + (r & 3) + 8 * (r >> 2) + 4 * hi; dst[i * 64 + 32 * kb + r32] = acc[r]; Sb[i * R3_P + 32 * kb + r32] = acc[r]; }
            if (ck + 1 == RW_NC) break;
            float ph[32];
#pragma unroll
            for (int s = 0; s < 32; ++s) ph[s] = PHI[task * 4096 + (2 * s + hi) * 64 + 32 * kb + r32];
#pragma unroll
            for (int r = 0; r < 16; ++r) { const int i = 32 * ibo + (r & 3) + 8 * (r >> 2) + 4 * hi; acc[r] = PSI[task * 4096 + i * 64 + 32 * kb + r32]; }
            __syncthreads();
#pragma unroll
            for (int s = 0; s < 32; ++s) { const float a = Sb[(32 * ibo + r32) * R3_P + 2 * s + hi]; acc = __builtin_amdgcn_mfma_f32_32x32x2f32(a, ph[s], acc, 0, 0, 0); }
        }
        __syncthreads();
    }
}
__device__ __forceinline__ void phase_rw4(const Ctx& C) {
    const float* RWd = (const float*)(C.ws + WS_RW); const float* RA = (const float*)(C.ws + WS_RA); const float* RB = (const float*)(C.ws + WS_RB); const float* RKH = (const float*)(C.ws + WS_RKH); const float* RV = (const float*)(C.ws + WS_RV); const float* RR = (const float*)(C.ws + WS_RR);
    const float* SST = (const float*)(C.ws + WS_SST); float* Y = (float*)(C.ws + WS_Y);
    LAS float* stg = (LAS float*)C.lds + C.wave * RW_STG;
    const int ntask = NB * 8 * RW_NC, r32 = C.lane & 31, hi = C.lane >> 5;
    for (int task = C.wave * C.G + C.bid; task < ntask; task += C.G * NWAVES) {
        const int ck = task % RW_NC, bh = task / RW_NC, h = bh & 7, b = bh >> 3;
        const size_t base0 = ((size_t)b * T + (size_t)ck * RW_L) * 512 + h * 64;
        f32x16 D[1][2][2]; const float* src = SST + (size_t)task * 4096;
#pragma unroll
        for (int jb = 0; jb < 2; ++jb)
#pragma unroll
            for (int ib = 0; ib < 2; ++ib)
#pragma unroll
                for (int g = 0; g < 4; ++g) { const f32x4 v = *(const f32x4*)(src + (32 * ib + r32) * 64 + 32 * jb + 8 * g + 4 * hi); D[0][jb][ib][4 * g] = v.x; D[0][jb][ib][4 * g + 1] = v.y; D[0][jb][ib][4 * g + 2] = v.z; D[0][jb][ib][4 * g + 3] = v.w; }
        rwkv_chunk<1, true>(D, stg, RWd, RA, RB, RKH, RV, RR, Y, base0, RW_L, C.lane);
    }
}
__device__ __forceinline__ void phase_rw5(const Ctx& C, int layer, const RwP& P) {
    LAS bf16* AG = (LAS bf16*)C.lds;
    const bf16* CG = (const bf16*)(C.ws + WS_CG); const bf16* LG = (const bf16*)(C.ws + WS_LORA + LO_G);
    const float* Y = (const float*)(C.ws + WS_Y); const float* RR = (const float*)(C.ws + WS_RR); const float* RKH = (const float*)(C.ws + WS_RKH); const float* RV = (const float*)(C.ws + WS_RV);
    bf16* CAT = (bf16*)(C.ws + WS_CAT);
    const float* mu = P.mu + (size_t)layer * 1984 + 1728; const float* r_k = P.r_k + layer * 512; const float* lnx_g = P.lnx_g + layer * 512; const float* lnx_b = P.lnx_b + layer * 512;
    const int tid = C.tid, lane = C.lane, wid = C.wave;
    for (int u = C.bid; u < M / 32; u += C.G) {
        int r32 = lane & 31, hi = lane >> 5; asm volatile("" : "+v"(r32), "+v"(hi));
        const size_t m0 = (size_t)u * 32;
        for (int idx = tid; idx < 32 * 256; idx += NTHR) {
            const int tok = idx >> 8, c = idx & 255; const size_t m = m0 + tok; const bool first = (m & (T - 1)) == 0;
            const float cur = bf2f(CG[m * 256 + c]); const float prv = first ? 0.f : bf2f(CG[(m - 1) * 256 + c]);
            AG[tok * RW_AG + c] = (bf16)f2bf(sigmoidf_(cur + (prv - cur) * mu[c]));
        }
        __syncthreads();
        f32x16 dg[2];
#pragma unroll
        for (int cb = 0; cb < 2; ++cb) {
#pragma unroll
            for (int r = 0; r < 16; ++r) dg[cb][r] = 0.f;
            const int ch = 64 * wid + 32 * cb + r32;
#pragma unroll
            for (int kk = 0; kk < 16; ++kk) {
                const bf16x8 ag = *(const bf16x8*)(LG + ch * 256 + 16 * kk + 8 * hi); const bf16x8 bg = *(const LAS bf16x8*)(AG + r32 * RW_AG + 16 * kk + 8 * hi);
                dg[cb] = __builtin_amdgcn_mfma_f32_32x32x16_bf16(ag, bg, dg[cb], 0, 0, 0);
            }
        }
        const size_t m = m0 + r32;
        float yv[32], vv[32]; float sy = 0.f, sb = 0.f;
#pragma unroll
        for (int cb = 0; cb < 2; ++cb)
#pragma unroll
            for (int g = 0; g < 4; ++g) { const int c4 = 64 * wid + 32 * cb + 8 * g + 4 * hi;
                const f32x4 y4 = *(const f32x4*)(Y + m * 512 + c4), r4 = *(const f32x4*)(RR + m * 512 + c4), k4 = *(const f32x4*)(RKH + m * 512 + c4), v4 = *(const f32x4*)(RV + m * 512 + c4), rk4 = *(const f32x4*)(r_k + c4);
#pragma unroll
                for (int e = 0; e < 4; ++e) { yv[16 * cb + 4 * g + e] = y4[e]; vv[16 * cb + 4 * g + e] = v4[e]; sy += y4[e]; sb += r4[e] * k4[e] * rk4[e]; } }
        sy += __shfl_xor(sy, 32); sb += __shfl_xor(sb, 32);
        const float mean = sy * (1.0f / 64.0f); float var = 0.f;
#pragma unroll
        for (int i = 0; i < 32; ++i) { const float d = yv[i] - mean; var += d * d; }
        var += __shfl_xor(var, 32);
        const float rstd = rsqrtf(var * (1.0f / 64.0f) + 64e-5f);
#pragma unroll
        for (int cb = 0; cb < 2; ++cb)
#pragma unroll
            for (int g = 0; g < 4; ++g) { const int c4 = 64 * wid + 32 * cb + 8 * g + 4 * hi;
                const f32x4 lg4 = *(const f32x4*)(lnx_g + c4), lb4 = *(const f32x4*)(lnx_b + c4); float o[4];
#pragma unroll
                for (int e = 0; e < 4; ++e) { const int i = 16 * cb + 4 * g + e; o[e] = ((yv[i] - mean) * rstd * lg4[e] + lb4[e] + sb * vv[i]) * dg[cb][4 * g + e]; }
                u32x2 w; w.x = pk2(o[0], o[1]); w.y = pk2(o[2], o[3]); *(u32x2*)(CAT + m * 2048 + 1536 + c4) = w; }
        __syncthreads();
    }
}
__device__ __forceinline__ void* launder_ptr(const void* p) {
    unsigned lo = (unsigned)(uintptr_t)p, hi = (unsigned)((uintptr_t)p >> 32); asm volatile("" : "+v"(lo), "+v"(hi));
    lo = __builtin_amdgcn_readfirstlane(lo); hi = __builtin_amdgcn_readfirstlane(hi); return (void*)(((uintptr_t)hi << 32) | lo);
}
#ifndef MK_PER_PHASE
#define MK_PER_PHASE 0
#endif
constexpr int PH_PER_LAYER = 17, N_PHASES = DEPTH * PH_PER_LAYER + 1;
struct Args { const float* in[23]; float* out; unsigned char* ws; int ph_lo, ph_hi; };
#define FRESH() do { KA = (const CAS Args*)launder_ptr((const void*)(uintptr_t)__builtin_amdgcn_kernarg_segment_ptr()); C.ws = KA->ws; C.out = KA->out; ctl = (unsigned*)(C.ws + WS_CTL); asm volatile("" : "+v"(C.tid)); C.lane = C.tid & 63; C.wave = __builtin_amdgcn_readfirstlane(C.tid >> 6); C.lds = (LAS unsigned char*)lds_raw; } while (0)
#ifndef REP_MASK
#define REP_MASK 0u
#endif
#ifndef ONLY_PH
#define ONLY_PH -1
#endif
#ifndef PH_MASK
#define PH_MASK 0xFFFFFFFFu
#endif
#define IN(k) (lo <= (k) && (k) < hi && (ONLY_PH < 0 || ((k) % PH_PER_LAYER) == ONLY_PH) && ((PH_MASK >> ((k) % PH_PER_LAYER)) & 1u))
#define SEAM(k) do { if (IN(k) && IN((k) + 1)) { bar.bar = ctl + CW_BAR; xcd_barrier(bar); } } while (0)
template <int layer>
__device__ __forceinline__ void layer_phases(Ctx& C, const CAS Args*& KA, XcdBarrier& bar, unsigned*& ctl, unsigned char* lds_raw, const int lo, const int hi) {
        const int p0 = layer * PH_PER_LAYER;
        const float* xin = layer == 0 ? KA->in[0] : C.out;
        FRESH(); if (IN(p0 + 0)) { { { const WSrc W{KA->in[2], KA->in[3], KA->in[18], KA->in[20], KA->in[21], KA->in[7], KA->in[9], KA->in[12], KA->in[11]}; phase_wconv(C, layer, W); } phase_norm_bf16(C, xin, KA->in[1] + layer * DM, (bf16*)(C.ws + WS_H)); }
            if ((REP_MASK >> 0) & 1u) { xcd_barrier(bar); FRESH(); { { const WSrc W{KA->in[2], KA->in[3], KA->in[18], KA->in[20], KA->in[21], KA->in[7], KA->in[9], KA->in[12], KA->in[11]}; phase_wconv(C, layer, W); } phase_norm_bf16(C, xin, KA->in[1] + layer * DM, (bf16*)(C.ws + WS_H)); } } }
        SEAM(p0 + 0);
        FRESH(); if (IN(p0 + 1)) { { pg8::Gemm g{(const pg8::bf16_t*)(C.ws + WS_H), (const pg8::bf16_t*)(C.ws + WS_WIN), M, N_INP, DM}; pg8::StaticOrder S; S.init(M, N_INP, C.G, C.bid);
            pg8::EpiProj E{C.ws}; pg8::gemm_phase<pg8::EpiProj, pg8::StaticOrder, true, true>(C.lds, g, S, E); }
            if ((REP_MASK >> 1) & 1u) { xcd_barrier(bar); FRESH(); { pg8::Gemm g{(const pg8::bf16_t*)(C.ws + WS_H), (const pg8::bf16_t*)(C.ws + WS_WIN), M, N_INP, DM}; pg8::StaticOrder S; S.init(M, N_INP, C.G, C.bid);
            pg8::EpiProj E{C.ws}; pg8::gemm_phase<pg8::EpiProj, pg8::StaticOrder, true, true>(C.lds, g, S, E); } } }
        SEAM(p0 + 1);
        FRESH(); if (IN(p0 + 2)) { phase_prep_a(C);
            if ((REP_MASK >> 2) & 1u) { xcd_barrier(bar); FRESH(); phase_prep_a(C); } }
        SEAM(p0 + 2);
        FRESH(); if (IN(p0 + 3)) { phase_indexer(C);
            if ((REP_MASK >> 3) & 1u) { xcd_barrier(bar); FRESH(); phase_indexer(C); } }
        SEAM(p0 + 3);
        FRESH(); if (IN(p0 + 4)) { phase_attn(C);
            if ((REP_MASK >> 4) & 1u) { xcd_barrier(bar); FRESH(); phase_attn(C); } }
        SEAM(p0 + 4);
        FRESH(); if (IN(p0 + 5)) { phase_ret1(C);
            if ((REP_MASK >> 5) & 1u) { xcd_barrier(bar); FRESH(); phase_ret1(C); } }
        SEAM(p0 + 5);
        FRESH(); if (IN(p0 + 6)) { phase_ret2(C);
            if ((REP_MASK >> 6) & 1u) { xcd_barrier(bar); FRESH(); phase_ret2(C); } }
        SEAM(p0 + 6);
        FRESH(); if (IN(p0 + 7)) { phase_ret3(C);
            if ((REP_MASK >> 7) & 1u) { xcd_barrier(bar); FRESH(); phase_ret3(C); } }
        SEAM(p0 + 7);
        FRESH(); if (IN(p0 + 8)) { { const RwP P{KA->in[4], KA->in[5], KA->in[6], KA->in[8], KA->in[10], KA->in[13], KA->in[14], KA->in[15], KA->in[16], KA->in[17]}; phase_rw1(C, layer, P); }
            if ((REP_MASK >> 8) & 1u) { xcd_barrier(bar); FRESH(); { const RwP P{KA->in[4], KA->in[5], KA->in[6], KA->in[8], KA->in[10], KA->in[13], KA->in[14], KA->in[15], KA->in[16], KA->in[17]}; phase_rw1(C, layer, P); } } }
        SEAM(p0 + 8);
        FRESH(); if (IN(p0 + 9)) { phase_rw2(C);
            if ((REP_MASK >> 9) & 1u) { xcd_barrier(bar); FRESH(); phase_rw2(C); } }
        SEAM(p0 + 9);
        FRESH(); if (IN(p0 + 10)) { phase_rw3(C);
            if ((REP_MASK >> 10) & 1u) { xcd_barrier(bar); FRESH(); phase_rw3(C); } }
        SEAM(p0 + 10);
        FRESH(); if (IN(p0 + 11)) { phase_rw4(C);
            if ((REP_MASK >> 11) & 1u) { xcd_barrier(bar); FRESH(); phase_rw4(C); } }
        SEAM(p0 + 11);
        FRESH(); if (IN(p0 + 12)) { { const RwP P{KA->in[4], KA->in[5], KA->in[6], KA->in[8], KA->in[10], KA->in[13], KA->in[14], KA->in[15], KA->in[16], KA->in[17]}; phase_rw5(C, layer, P); }
            if ((REP_MASK >> 12) & 1u) { xcd_barrier(bar); FRESH(); { const RwP P{KA->in[4], KA->in[5], KA->in[6], KA->in[8], KA->in[10], KA->in[13], KA->in[14], KA->in[15], KA->in[16], KA->in[17]}; phase_rw5(C, layer, P); } } }
        SEAM(p0 + 12);
        FRESH(); if (IN(p0 + 13)) { { pg8::Gemm g{(const pg8::bf16_t*)(C.ws + WS_CAT), (const pg8::bf16_t*)(C.ws + WS_WOUT), M, DM, DM}; pg8::StaticOrder S; S.init(M, DM, C.G, C.bid);
            pg8::EpiResid E{xin, C.out, DM}; pg8::gemm_phase<pg8::EpiResid, pg8::StaticOrder, true, true>(C.lds, g, S, E); }
            if ((REP_MASK >> 13) & 1u) { xcd_barrier(bar); FRESH(); { pg8::Gemm g{(const pg8::bf16_t*)(C.ws + WS_CAT), (const pg8::bf16_t*)(C.ws + WS_WOUT), M, DM, DM}; pg8::StaticOrder S; S.init(M, DM, C.G, C.bid);
            pg8::EpiResid E{xin, C.out, DM}; pg8::gemm_phase<pg8::EpiResid, pg8::StaticOrder, true, true>(C.lds, g, S, E); } } }
        SEAM(p0 + 13);
        FRESH(); if (IN(p0 + 14)) { phase_norm_bf16(C, C.out, KA->in[19] + layer * DM, (bf16*)(C.ws + WS_H2));
            if ((REP_MASK >> 14) & 1u) { xcd_barrier(bar); FRESH(); phase_norm_bf16(C, C.out, KA->in[19] + layer * DM, (bf16*)(C.ws + WS_H2)); } }
        SEAM(p0 + 14);
        FRESH(); if (IN(p0 + 15)) { { pg8::Gemm g{(const pg8::bf16_t*)(C.ws + WS_H2), (const pg8::bf16_t*)(C.ws + WS_WGU), M, 2 * DFF, DM}; pg8::StaticOrder S; S.init(M, 2 * DFF, C.G, C.bid);
            pg8::EpiSwiGLU E{(pg8::bf16_t*)(C.ws + WS_ACT), DFF}; pg8::gemm_phase<pg8::EpiSwiGLU, pg8::StaticOrder, true, true>(C.lds, g, S, E); }
            if ((REP_MASK >> 15) & 1u) { xcd_barrier(bar); FRESH(); { pg8::Gemm g{(const pg8::bf16_t*)(C.ws + WS_H2), (const pg8::bf16_t*)(C.ws + WS_WGU), M, 2 * DFF, DM}; pg8::StaticOrder S; S.init(M, 2 * DFF, C.G, C.bid);
            pg8::EpiSwiGLU E{(pg8::bf16_t*)(C.ws + WS_ACT), DFF}; pg8::gemm_phase<pg8::EpiSwiGLU, pg8::StaticOrder, true, true>(C.lds, g, S, E); } } }
        SEAM(p0 + 15);
        FRESH(); if (IN(p0 + 16)) { { pg8::Gemm g{(const pg8::bf16_t*)(C.ws + WS_ACT), (const pg8::bf16_t*)(C.ws + WS_WDN), M, DM, DFF}; pg8::StaticOrder S; S.init(M, DM, C.G, C.bid);
            pg8::EpiResid E{C.out, C.out, DM}; pg8::gemm_phase<pg8::EpiResid, pg8::StaticOrder, true, true>(C.lds, g, S, E); }
            if ((REP_MASK >> 16) & 1u) { xcd_barrier(bar); FRESH(); { pg8::Gemm g{(const pg8::bf16_t*)(C.ws + WS_ACT), (const pg8::bf16_t*)(C.ws + WS_WDN), M, DM, DFF}; pg8::StaticOrder S; S.init(M, DM, C.G, C.bid);
            pg8::EpiResid E{C.out, C.out, DM}; pg8::gemm_phase<pg8::EpiResid, pg8::StaticOrder, true, true>(C.lds, g, S, E); } } }
        SEAM(p0 + 16);
    }
__global__ void __launch_bounds__(NTHR, 2) fwd_kernel(Args args) {
    extern __shared__ __attribute__((aligned(16))) unsigned char lds_raw[];
    Ctx C;
    C.lds = (LAS unsigned char*)lds_raw; C.tid = threadIdx.x; C.lane = C.tid & 63; C.wave = __builtin_amdgcn_readfirstlane(C.tid >> 6);
    C.G = gridDim.x; C.bid = blockIdx.x;
    const CAS Args* KA = (const CAS Args*)launder_ptr((const void*)(uintptr_t)__builtin_amdgcn_kernarg_segment_ptr());
    C.ws = KA->ws; C.out = KA->out;
    volatile LAS unsigned* MISC = (volatile LAS unsigned*)(C.lds + MISC_OFF);
    if (C.tid < 32) MISC[C.tid] = 0u;
    __syncthreads();
    unsigned* ctl = (unsigned*)(C.ws + WS_CTL);
    XcdBarrier bar; bar.bar = ctl + CW_BAR; bar.x = 0; bar.st = nullptr;
    if (!MK_PER_PHASE) bar = xcd_barrier_post(ctl + CW_BAR, MISC + 8);
    const int lo = KA->ph_lo, hi = KA->ph_hi;
    layer_phases<0>(C, KA, bar, ctl, lds_raw, lo, hi);
    layer_phases<1>(C, KA, bar, ctl, lds_raw, lo, hi);
    if (IN(N_PHASES - 1)) phase_final_norm(C, C.out, KA->in[22]);
#undef IN
#undef SEAM
}

extern "C" void kernel_launch(void* const* d_in, const int* in_sizes, int n_in, void* d_out, int out_size, void* d_ws, size_t ws_size, hipStream_t stream) {
    static int grid = 0;
    if (grid == 0) {
        if (n_in != 23 || out_size != M * DM || ws_size < WS_NEED) { fprintf(stderr, "kernel_launch: unexpected problem (n_in %d, out %d, ws %zu); nothing launched\n", n_in, out_size, ws_size); grid = -1; return; }
        int dev = 0, cus = 0, per_cu = 0;
        if (hipGetDevice(&dev) != hipSuccess || hipDeviceGetAttribute(&cus, hipDeviceAttributeMultiprocessorCount, dev) != hipSuccess) { grid = -1; return; }
        if (hipFuncSetAttribute((const void*)fwd_kernel, hipFuncAttributeMaxDynamicSharedMemorySize, LDS_BYTES) != hipSuccess) { fprintf(stderr, "kernel_launch: hipFuncSetAttribute failed\n"); grid = -1; return; }
        if (hipOccupancyMaxActiveBlocksPerMultiprocessor(&per_cu, (const void*)fwd_kernel, NTHR, LDS_BYTES) != hipSuccess || per_cu < 1) { fprintf(stderr, "kernel_launch: occupancy query says %d blocks per CU\n", per_cu); }
        (void)hipGetLastError();
        grid = cus;
    }
    if (grid < 0) return;
    (void)hipMemsetAsync((char*)d_ws + WS_CTL, 0, CTL_ZERO_BYTES, stream);
    Args a{};
    for (int i = 0; i < 23; ++i) a.in[i] = (const float*)d_in[i];
    a.out = (float*)d_out; a.ws = (unsigned char*)d_ws;
#if MK_PER_PHASE
    for (int p = 0; p < N_PHASES; ++p) { a.ph_lo = p; a.ph_hi = p + 1; hipLaunchKernelGGL(fwd_kernel, dim3(grid), dim3(NTHR), LDS_BYTES, stream, a); }
#else
    a.ph_lo = 0; a.ph_hi = N_PHASES;
    hipLaunchKernelGGL(fwd_kernel, dim3(grid), dim3(NTHR), LDS_BYTES, stream, a);
#endif
    const hipError_t le = hipPeekAtLastError();
    if (le != hipSuccess) fprintf(stderr, "kernel_launch: launch failed: %s\n", hipGetErrorName(le));
}
```

```cpp
#include <hip/hip_runtime.h>
#include <hip/hip_fp16.h>
#include <cstdio>
#include <cstdint>
namespace pg8 {
#define PG8_LAS __attribute__((address_space(3)))
typedef unsigned short bf16_t;
typedef short bf16x8 __attribute__((ext_vector_type(8)));
typedef float f32x4 __attribute__((ext_vector_type(4)));
typedef unsigned u32x4 __attribute__((ext_vector_type(4)));
constexpr int BM = 256, BK = 64, HALF = 128, HTB = HALF * BK * 2  , STAGE_BYTES = 8 * HTB, NXCD = 8, WGM = 8;

__host__ __device__ __forceinline__ int lds_byte(int r, int c) { const int st = (r >> 4) * 2 + (c >> 5), rr = r & 15, cc = c & 31, ob = rr * 64 + cc * 2; return st * 1024 + (ob ^ (((ob >> 9) & 1) << 5)); }
__host__ __device__ __forceinline__ void stage_rc(int b, int& R, int& C) { const int st = b / 1024, sb = b % 1024, swz = sb ^ (((sb >> 9) & 1) << 5); R = (st >> 1) * 16 + swz / 64; C = (st & 1) * 32 + (swz % 64) / 2; }
__host__ __device__ __forceinline__ int perm32(int rho) { const int n = rho >> 4, i = rho & 15; return 8 * (i >> 2) + 4 * n + (i & 3); }

struct Unit { int pm, pn; };
struct Gemm { const bf16_t* A; const bf16_t* Bt; int M, N, K; };

struct StaticOrder {
    int nM, nN, nwg, G, c;
    __host__ __device__ void init(int M, int N, int G_, int c_) { nM = M / BM; nN = N / BM; nwg = nM * nN; G = G_; c = c_; }
    __host__ __device__ bool next(int i, Unit& u) const {
        const long L = (long)i * G + c; if (L >= nwg) return false;
        int wgid = (int)L; { const int q = nwg / NXCD, r = nwg % NXCD, xcd = wgid % NXCD, off = wgid / NXCD; wgid = (xcd < r ? xcd * (q + 1) : r * (q + 1) + (xcd - r) * q) + off; }
        const int nig = WGM * nN, gid = wgid / nig, fm = gid * WGM, gsz = (nM - fm) < WGM ? (nM - fm) : WGM;
        u.pm = fm + ((wgid % nig) % gsz); u.pn = (wgid % nig) / gsz; return true;
    }
    __device__ __forceinline__ void a_ready(const Unit&) const {}
    __device__ __forceinline__ void done(const Unit&) const {}
};

__device__ __forceinline__ unsigned cvt_pk_bf16(float lo, float hi) { unsigned r; asm volatile("v_cvt_pk_bf16_f32 %0, %1, %2" : "=v"(r) : "v"(lo), "v"(hi)); return r; }
typedef float f32x2 __attribute__((ext_vector_type(2)));
__device__ __forceinline__ f32x2 gelu_pk(f32x2 v) {
    const f32x2 av = __builtin_elementwise_abs(v), d = av * 0.2316418882f + 1.0f;
    f32x2 t; t.x = __builtin_amdgcn_rcpf(d.x); t.y = __builtin_amdgcn_rcpf(d.y);
    f32x2 q = t * 0.5307027145f + (-0.7265760135f); q = q * t + 0.7107068705f; q = q * t + (-0.142248368f); q = q * t + 0.127414796f; q = q * t;
    const f32x2 s = (v * v) * (-0.72134752044f);
    f32x2 e; e.x = __builtin_amdgcn_exp2f(s.x); e.y = __builtin_amdgcn_exp2f(s.y);
    const f32x2 m = v * (q * e), r = v - m;
    f32x2 o; o.x = v.x < 0.f ? m.x : r.x; o.y = v.y < 0.f ? m.y : r.y; return o;
}

template <int ACT  > struct EpiBf16 {
    static constexpr bool PERM = true, AFTER_DRAIN = false; static_assert(ACT == 0 || ACT == 1, "EpiBf16: ACT is 0 (none) or 1 (gelu_pk)");
    bf16_t* O; int ldc; const float* bias; int split_cols; size_t split_stride; float scale0;
    __device__ __forceinline__ void operator()(const f32x4 (&acc)[2][2][4][2], const Unit& u, int wr, int wc, int fr, int fq) const {
        const int row0 = u.pm * BM + wr * 64 + fr; int colt = u.pn * BM; bf16_t* base = O;
        float sc = 1.f; if (split_cols) { const int t = colt / split_cols; base += (size_t)t * split_stride; colt -= t * split_cols; if (t == 0) sc = scale0; }
        const int col0 = colt + wc * 32 + 8 * fq, bcol0 = u.pn * BM + wc * 32 + 8 * fq;
        f32x4 bv[2][2];
#pragma unroll
        for (int bj = 0; bj < 2; ++bj)
#pragma unroll
            for (int n = 0; n < 2; ++n) bv[bj][n] = bias ? *(const f32x4*)(bias + bcol0 + bj * HALF + 4 * n) : (f32x4){0.f, 0.f, 0.f, 0.f};
#pragma unroll
        for (int ai = 0; ai < 2; ++ai)
#pragma unroll
            for (int m = 0; m < 4; ++m) { bf16_t* rowp = base + (size_t)(row0 + ai * HALF + m * 16) * ldc + col0;
#pragma unroll
                for (int bj = 0; bj < 2; ++bj) { f32x4 v0 = acc[ai][bj][m][0] + bv[bj][0], v1 = acc[ai][bj][m][1] + bv[bj][1];
                    if (ACT == 1) { f32x2 a = gelu_pk((f32x2){v0[0], v0[1]}), b = gelu_pk((f32x2){v0[2], v0[3]}), c = gelu_pk((f32x2){v1[0], v1[1]}), d = gelu_pk((f32x2){v1[2], v1[3]});
                        v0 = (f32x4){a.x, a.y, b.x, b.y}; v1 = (f32x4){c.x, c.y, d.x, d.y}; }
                    v0 = v0 * sc; v1 = v1 * sc; u32x4 w; w.x = cvt_pk_bf16(v0[0], v0[1]); w.y = cvt_pk_bf16(v0[2], v0[3]); w.z = cvt_pk_bf16(v1[0], v1[1]); w.w = cvt_pk_bf16(v1[2], v1[3]);
                    *(u32x4*)(rowp + bj * HALF) = w; } }
    }
};

__device__ __forceinline__ void tile_dest(int pn, size_t& off, int& ld, int& colt);
struct EpiProj {
    static constexpr bool PERM = true, AFTER_DRAIN = false;
    unsigned char* ws;
    __device__ __forceinline__ void operator()(const f32x4 (&acc)[2][2][4][2], const Unit& u, int wr, int wc, int fr, int fq) const {
        size_t off; int ld, colt; tile_dest(u.pn, off, ld, colt);
        bf16_t* base = (bf16_t*)(ws + off);
        const int row0 = u.pm * BM + wr * 64 + fr, col0 = colt + wc * 32 + 8 * fq;
        const float sc = u.pn < 4 ? 0.12751743074602467f : 1.0f;
#pragma unroll
        for (int ai = 0; ai < 2; ++ai)
#pragma unroll
            for (int m = 0; m < 4; ++m) { bf16_t* rowp = base + (size_t)(row0 + ai * HALF + m * 16) * ld + col0;
#pragma unroll
                for (int bj = 0; bj < 2; ++bj) { const f32x4 v0 = acc[ai][bj][m][0] * sc, v1 = acc[ai][bj][m][1] * sc;
                    u32x4 w; w.x = cvt_pk_bf16(v0[0], v0[1]); w.y = cvt_pk_bf16(v0[2], v0[3]); w.z = cvt_pk_bf16(v1[0], v1[1]); w.w = cvt_pk_bf16(v1[2], v1[3]);
                    *(u32x4*)(rowp + bj * HALF) = w; } }
    }
};
struct EpiResid {
    static constexpr bool PERM = false, AFTER_DRAIN = false;
    const float* base; float* out; int ldc;
    __device__ __forceinline__ void operator()(const f32x4 (&acc)[2][2][4][2], const Unit& u, int wr, int wc, int fr, int fq) const {
        const int row0 = u.pm * BM + wr * 64 + fr, col0 = u.pn * BM + wc * 32 + 4 * fq;
#pragma unroll
        for (int ai = 0; ai < 2; ++ai)
#pragma unroll
            for (int m = 0; m < 4; ++m) { const size_t off = (size_t)(row0 + ai * HALF + m * 16) * ldc + col0;
#pragma unroll
                for (int bj = 0; bj < 2; ++bj)
#pragma unroll
                    for (int n = 0; n < 2; ++n) { const size_t p = off + bj * HALF + n * 16; const f32x4 b = *(const f32x4*)(base + p); *(f32x4*)(out + p) = b + acc[ai][bj][m][n]; } }
    }
};
struct EpiSwiGLU {
    static constexpr bool PERM = true, AFTER_DRAIN = false;
    bf16_t* O; int ldc;
    __device__ __forceinline__ static float silu_mul(float g, float u) { return g * u * __builtin_amdgcn_rcpf(1.0f + __expf(-g)); }
    __device__ __forceinline__ void operator()(const f32x4 (&acc)[2][2][4][2], const Unit& u, int wr, int wc, int fr, int fq) const {
        const int row0 = u.pm * BM + wr * 64 + fr, col0 = u.pn * HALF + wc * 32 + 8 * fq;
#pragma unroll
        for (int ai = 0; ai < 2; ++ai)
#pragma unroll
            for (int m = 0; m < 4; ++m) { bf16_t* rowp = O + (size_t)(row0 + ai * HALF + m * 16) * ldc + col0;
                const f32x4 g0 = acc[ai][0][m][0], g1 = acc[ai][0][m][1], u0 = acc[ai][1][m][0], u1 = acc[ai][1][m][1];
                u32x4 w; w.x = cvt_pk_bf16(silu_mul(g0[0], u0[0]), silu_mul(g0[1], u0[1])); w.y = cvt_pk_bf16(silu_mul(g0[2], u0[2]), silu_mul(g0[3], u0[3]));
                w.z = cvt_pk_bf16(silu_mul(g1[0], u1[0]), silu_mul(g1[1], u1[1])); w.w = cvt_pk_bf16(silu_mul(g1[2], u1[2]), silu_mul(g1[3], u1[3]));
                *(u32x4*)rowp = w; }
    }
};
template <class Epi, class Sched, bool ALIGN_EPI = false, bool SP2 = false>
__device__ __forceinline__ void gemm_phase(PG8_LAS unsigned char* lds, const Gemm g, const Sched& S, const Epi& E) {
    int tid_ = threadIdx.x; asm volatile("" : "+v"(tid_));
    const int tid = tid_, wid = __builtin_amdgcn_readfirstlane(tid >> 6), lane = tid & 63, wr = wid >> 2, wc = wid & 3, fr = lane & 15, fq = lane >> 4;
    const int K = g.K, nt = K / BK;
    unsigned voffA[2], voffB[2];
#pragma unroll
    for (int i = 0; i < 2; ++i) { int R, C; stage_rc(tid * 16 + i * 8192, R, C); const int Rb = Epi::PERM ? ((R & ~31) + perm32(R & 31)) : R;
        voffA[i] = (unsigned)(R * K + C) * 2u; voffB[i] = (unsigned)(Rb * K + C) * 2u; }
    const size_t kstep = (size_t)(BK * 2);
    const size_t hstep = (size_t)HALF * K * 2;
    const size_t tstep = 2 * hstep;
    const unsigned ldsw = (unsigned)wid * 1024u;
    const int aoff = lds_byte(wr * 64 + fr, fq * 8), boff = lds_byte(wc * 32 + fr, fq * 8);
#define PG8_SA(b, h) (((b) * 2 + (h)) * HTB)
#define PG8_SB(b, h) ((4 + (b) * 2 + (h)) * HTB)
#define PG8_STAGE(bufoff, gbase, voff) do { _Pragma("unroll") for (int _i = 0; _i < 2; ++_i) \
        __builtin_amdgcn_global_load_lds((const unsigned*)((const char*)(gbase) + (voff)[_i]), (PG8_LAS unsigned*)(lds + (bufoff) + ldsw + _i * 8192), 16, 0, 0); } while (0)
#define PG8_LDA(dst, b, h) do { _Pragma("unroll") for (int m = 0; m < 4; ++m) _Pragma("unroll") for (int k = 0; k < 2; ++k) dst[m][k] = *(const PG8_LAS bf16x8*)(lds + PG8_SA(b, h) + aoff + m * 2048 + k * 1024); } while (0)
#define PG8_LDB(dst, b, h) do { _Pragma("unroll") for (int n = 0; n < 2; ++n) _Pragma("unroll") for (int k = 0; k < 2; ++k) dst[n][k] = *(const PG8_LAS bf16x8*)(lds + PG8_SB(b, h) + boff + n * 2048 + k * 1024); } while (0)
#define PG8_MMA(ai, bj, At, Bt) do { __builtin_amdgcn_s_setprio(1); _Pragma("unroll") for (int m = 0; m < 4; ++m) _Pragma("unroll") for (int n = 0; n < 2; ++n) _Pragma("unroll") for (int k = 0; k < 2; ++k) \
        acc[ai][bj][m][n] = __builtin_amdgcn_mfma_f32_16x16x32_bf16(Bt[n][k], At[m][k], acc[ai][bj][m][n], 0, 0, 0); __builtin_amdgcn_s_setprio(0); } while (0)
#define PG8_WAIT_V(n) asm volatile("s_waitcnt vmcnt(" #n ")" ::: "memory")
#define PG8_WAIT_L(n) asm volatile("s_waitcnt lgkmcnt(" #n ")" ::: "memory")
#define PG8_BAR __builtin_amdgcn_s_barrier()
#define PG8_SCHED __builtin_amdgcn_sched_barrier(0)
    Unit cur, nxt; int ui = 0;
    if (!S.next(0, cur)) return;
    f32x4 acc[2][2][4][2];
#pragma unroll
    for (int a = 0; a < 2; ++a)
#pragma unroll
        for (int b = 0; b < 2; ++b)
#pragma unroll
            for (int m = 0; m < 4; ++m)
#pragma unroll
                for (int n = 0; n < 2; ++n) acc[a][b][m][n] = (f32x4){0.f, 0.f, 0.f, 0.f};
    bf16x8 At[4][2], B0[2][2], B1[2][2];
    const char* cA = (const char*)g.A + (size_t)cur.pm * tstep; const char* cB = (const char*)g.Bt + (size_t)cur.pn * tstep;
    S.a_ready(cur);
    if constexpr (SP2) {
        PG8_STAGE(PG8_SB(0, 0), cB, voffB); PG8_STAGE(PG8_SB(0, 1), cB + hstep, voffB); PG8_STAGE(PG8_SA(0, 0), cA, voffA); PG8_STAGE(PG8_SA(0, 1), cA + hstep, voffA);
        if (wr == 1) PG8_BAR;
        PG8_WAIT_V(2); PG8_BAR;
        PG8_STAGE(PG8_SB(1, 0), cB + kstep, voffB); PG8_STAGE(PG8_SA(1, 0), cA + kstep, voffA); PG8_STAGE(PG8_SB(1, 1), cB + hstep + kstep, voffB);
        PG8_WAIT_V(6); PG8_BAR;
    } else {
        PG8_STAGE(PG8_SB(0, 0), cB, voffB); PG8_STAGE(PG8_SA(0, 0), cA, voffA); PG8_STAGE(PG8_SB(0, 1), cB + hstep, voffB); PG8_STAGE(PG8_SA(0, 1), cA + hstep, voffA);
        if (wr == 1) PG8_BAR;
        PG8_WAIT_V(4); PG8_BAR;
        PG8_STAGE(PG8_SB(1, 0), cB + kstep, voffB); PG8_STAGE(PG8_SA(1, 0), cA + kstep, voffA); PG8_STAGE(PG8_SB(1, 1), cB + hstep + kstep, voffB);
        PG8_WAIT_V(6); PG8_BAR;
    }
    for (;;) {
        const bool has_next = S.next(ui + 1, nxt);
        const char* nA = has_next ? (const char*)g.A + (size_t)nxt.pm * tstep : cA; const char* nB = has_next ? (const char*)g.Bt + (size_t)nxt.pn * tstep : cB;
        for (int t = 0; t < nt; t += 2) {
            const bool last = (t == nt - 2);
            const char* a1 = cA + (size_t)(t + 1) * kstep;
            const char* a2 = last ? nA : cA + (size_t)(t + 2) * kstep; const char* b2 = last ? nB : cB + (size_t)(t + 2) * kstep;
            const char* a3 = a2 + kstep; const char* b3 = b2 + kstep;
            if (last && has_next) S.a_ready(nxt);
            if constexpr (SP2) {
            PG8_LDB(B0, 0, 0); PG8_LDB(B1, 0, 1); PG8_SCHED; PG8_LDA(At, 0, 0); PG8_STAGE(PG8_SA(1, 1), a1 + hstep, voffA);
            PG8_WAIT_V(8); PG8_WAIT_L(0); PG8_BAR; PG8_MMA(0, 0, At, B0); PG8_MMA(0, 1, At, B1); PG8_BAR; PG8_SCHED;
            PG8_LDA(At, 0, 1); PG8_STAGE(PG8_SB(0, 0), b2, voffB); PG8_STAGE(PG8_SB(0, 1), b2 + hstep, voffB); PG8_STAGE(PG8_SA(0, 0), a2, voffA);
            PG8_WAIT_V(8); PG8_WAIT_L(0); PG8_BAR; PG8_MMA(1, 0, At, B0); PG8_MMA(1, 1, At, B1); PG8_BAR; PG8_SCHED;
            PG8_LDB(B0, 1, 0); PG8_LDB(B1, 1, 1); PG8_SCHED; PG8_LDA(At, 1, 0); PG8_STAGE(PG8_SA(0, 1), a2 + hstep, voffA);
            PG8_WAIT_V(8); PG8_WAIT_L(0); PG8_BAR; PG8_MMA(0, 0, At, B0); PG8_MMA(0, 1, At, B1); PG8_BAR; PG8_SCHED;
            PG8_LDA(At, 1, 1); PG8_STAGE(PG8_SB(1, 0), b3, voffB); PG8_STAGE(PG8_SB(1, 1), b3 + hstep, voffB); PG8_STAGE(PG8_SA(1, 0), a3, voffA);
            PG8_WAIT_V(8); PG8_WAIT_L(0); PG8_BAR; PG8_MMA(1, 0, At, B0); PG8_MMA(1, 1, At, B1); PG8_BAR; PG8_SCHED;
            } else {
            PG8_LDB(B0, 0, 0); PG8_SCHED; PG8_LDA(At, 0, 0); PG8_STAGE(PG8_SA(1, 1), a1 + hstep, voffA);
            PG8_WAIT_L(8); PG8_BAR; PG8_WAIT_L(0); PG8_MMA(0, 0, At, B0); PG8_BAR; PG8_SCHED;
            PG8_LDB(B1, 0, 1); PG8_STAGE(PG8_SB(0, 0), b2, voffB);
            PG8_BAR; PG8_WAIT_L(0); PG8_MMA(0, 1, At, B1); PG8_BAR;
            PG8_LDA(At, 0, 1); PG8_STAGE(PG8_SA(0, 0), a2, voffA);
            PG8_BAR; PG8_WAIT_L(0); PG8_MMA(1, 0, At, B0); PG8_BAR; PG8_SCHED;
            PG8_STAGE(PG8_SB(0, 1), b2 + hstep, voffB);
            PG8_WAIT_V(6); PG8_BAR; PG8_MMA(1, 1, At, B1); PG8_BAR;
            PG8_LDB(B0, 1, 0); PG8_SCHED; PG8_LDA(At, 1, 0); PG8_STAGE(PG8_SA(0, 1), a2 + hstep, voffA);
            PG8_WAIT_L(8); PG8_BAR; PG8_WAIT_L(0); PG8_MMA(0, 0, At, B0); PG8_BAR; PG8_SCHED;
            PG8_LDB(B1, 1, 1); PG8_STAGE(PG8_SB(1, 0), b3, voffB);
            PG8_BAR; PG8_WAIT_L(0); PG8_MMA(0, 1, At, B1); PG8_BAR;
            PG8_LDA(At, 1, 1); PG8_STAGE(PG8_SA(1, 0), a3, voffA);
            PG8_BAR; PG8_WAIT_L(0); PG8_MMA(1, 0, At, B0); PG8_BAR; PG8_SCHED;
            PG8_STAGE(PG8_SB(1, 1), b3 + hstep, voffB);
            PG8_WAIT_V(6); PG8_BAR; PG8_MMA(1, 1, At, B1); PG8_BAR;
            }
        }
        if constexpr (ALIGN_EPI) { if (wr == 0) PG8_BAR; }
        if constexpr (!Epi::AFTER_DRAIN) { E(acc, cur, wr, wc, fr, fq); S.done(cur); }
        if (!has_next) break;
#pragma unroll
        for (int a = 0; a < 2; ++a)
#pragma unroll
            for (int b = 0; b < 2; ++b)
#pragma unroll
                for (int m = 0; m < 4; ++m)
#pragma unroll
                    for (int n = 0; n < 2; ++n) acc[a][b][m][n] = (f32x4){0.f, 0.f, 0.f, 0.f};
        cur = nxt; cA = nA; cB = nB; ++ui;
        if constexpr (ALIGN_EPI) { if (wr == 1) PG8_BAR; }
    }
    PG8_WAIT_V(0);
    if constexpr (!ALIGN_EPI) { if (wr == 0) PG8_BAR; }
    PG8_BAR;
    if constexpr (Epi::AFTER_DRAIN) { E.fused(acc, cur, wr, wc, fr, fq, lds, wid, lane); S.done(cur); }
#undef PG8_SA
#undef PG8_SB
#undef PG8_STAGE
#undef PG8_LDA
#undef PG8_LDB
#undef PG8_MMA
#undef PG8_WAIT_V
#undef PG8_WAIT_L
#undef PG8_BAR
#undef PG8_SCHED
}
}
constexpr int NB = 4, T = 8192, M = NB * T, DM = 2048, DFF = 5632, DEPTH = 2;
constexpr int N_IN = 7696, N_INP = 7936;
constexpr int NWAVES = 8, NTHR = NWAVES * 64;
#define LAS __attribute__((address_space(3)))
#define GAS __attribute__((address_space(1)))
#define CAS __attribute__((address_space(4)))
typedef unsigned short bf16;
typedef short bf16x8 __attribute__((ext_vector_type(8)));
typedef float f32x4 __attribute__((ext_vector_type(4)));
typedef float f32x16 __attribute__((ext_vector_type(16)));
typedef unsigned u32x4 __attribute__((ext_vector_type(4)));
typedef unsigned u32x2 __attribute__((ext_vector_type(2)));
typedef unsigned long long u64;

constexpr size_t MiB = 1u << 20;
constexpr size_t WS_CTL = 0, CTL_ZERO_BYTES = 1 * MiB;
constexpr size_t WS_WIN = 1 * MiB, WS_WOUT = 32 * MiB, WS_WGU = 40 * MiB, WS_WDN = 84 * MiB;
constexpr size_t WS_LORA = 106 * MiB;
constexpr size_t LO_W = 0, LO_A = 512 * 96 * 2, LO_V = 2 * 512 * 96 * 2, LO_G = LO_V + 512 * 64 * 2;
constexpr size_t WS_VFIRST = 107 * MiB;
constexpr size_t WS_H = 139 * MiB;
constexpr size_t WS_VT = 139 * MiB, WS_MASK = 203 * MiB;
constexpr size_t WS_Q = 267 * MiB, WS_K = 331 * MiB, WS_QI = 395 * MiB, WS_V = 459 * MiB, WS_KW = 523 * MiB, WS_BQ = 539 * MiB, WS_BK = 555 * MiB, WS_BV = 571 * MiB, WS_BG = 603 * MiB;
constexpr size_t WS_CR = 635 * MiB, WS_CK = 667 * MiB, WS_CV = 699 * MiB, WS_CL = 731 * MiB, WS_CG = 747 * MiB;
constexpr size_t WS_CAT = 763 * MiB;
constexpr size_t WS_KVST = 891 * MiB;
constexpr size_t WS_TAB = 955 * MiB;
constexpr size_t TAB_A = 0, TAB_I = (size_t)T * 16 * 8, TAB_R = TAB_I + (size_t)T * 8 * 8, TAB_END = TAB_R + (size_t)T * 32 * 8;
constexpr size_t WS_RR = 139 * MiB, WS_RW = 171 * MiB, WS_RKH = 203 * MiB, WS_RV = 235 * MiB, WS_RA = 267 * MiB, WS_RB = 299 * MiB;
constexpr size_t WS_PHI = 523 * MiB, WS_PSI = 555 * MiB, WS_SST = 587 * MiB, WS_Y = 635 * MiB;
constexpr size_t WS_H2 = 139 * MiB, WS_ACT = 267 * MiB;
constexpr size_t WS_NEED = 1024 * MiB;
static_assert(WS_TAB + TAB_END <= WS_NEED && WS_ACT + (size_t)M * DFF * 2 <= WS_CR && WS_SST + 32 * MiB <= WS_CR && WS_Y + (size_t)M * 512 * 4 <= WS_CV, "ws map");

constexpr int LDS_BYTES = 147456, MISC_OFF = 143360;
constexpr int CW_BAR = 4096;

__device__ __forceinline__ unsigned f2bf(float f) { unsigned u = __builtin_bit_cast(unsigned, f); return (u + 0x7fffu + ((u >> 16) & 1u)) >> 16; }
__device__ __forceinline__ unsigned pk2(float lo, float hi) { return f2bf(lo) | (f2bf(hi) << 16); }
__device__ __forceinline__ float bf2f(unsigned short b) { return __builtin_bit_cast(float, (unsigned)b << 16); }
__device__ __forceinline__ float bflo(unsigned w) { return __builtin_bit_cast(float, w << 16); }
__device__ __forceinline__ float bfhi(unsigned w) { return __builtin_bit_cast(float, w & 0xffff0000u); }
__device__ __forceinline__ float wave_sum(float v) {
#pragma unroll
    for (int o = 1; o < 64; o <<= 1) v += __shfl_xor(v, o);
    return v;
}
#define LDS_WAIT() asm volatile("s_waitcnt lgkmcnt(0)" ::: "memory")

namespace pg8 {
__device__ __forceinline__ void tile_dest(int pn, size_t& off, int& ld, int& colt) {
    if (pn < 16) { const int g = pn >> 2; off = g == 0 ? WS_Q : g == 1 ? WS_K : g == 2 ? WS_V : WS_QI; ld = 1024; colt = (pn & 3) * 256; }
    else if (pn == 16) { off = WS_BQ; ld = 256; colt = 0; }
    else if (pn == 17) { off = WS_BK; ld = 256; colt = 0; }
    else if (pn < 20) { off = WS_BV; ld = 512; colt = (pn - 18) * 256; }
    else if (pn < 22) { off = WS_BG; ld = 512; colt = (pn - 20) * 256; }
    else if (pn == 22) { off = WS_KW; ld = 256; colt = 0; }
    else if (pn < 25) { off = WS_CR; ld = 512; colt = (pn - 23) * 256; }
    else if (pn < 27) { off = WS_CK; ld = 512; colt = (pn - 25) * 256; }
    else if (pn < 29) { off = WS_CV; ld = 512; colt = (pn - 27) * 256; }
    else if (pn == 29) { off = WS_CL; ld = 256; colt = 0; }
    else { off = WS_CG; ld = 256; colt = 0; }
}
}
__device__ __forceinline__ int win_src(int n, int layer) {
    if (n < 4096) return n;
    if (n < 4352) return 4176 + (n - 4096);
    if (n < 4608) return 4432 + (n - 4352);
    if (n < 5120) return 4688 + (n - 4608);
    if (n < 5632) return 5200 + (n - 5120);
    if (n < 5888) { const int j = n - 5632; return j < 64 ? 4096 + j : (j < 80 ? 4160 + (j - 64) : -1); }
    if (n < 7424) return 5712 + (n - 5888);
    if (n < 7680) { const int j = n - 7424; return j < 96 ? 7248 + j : (j < 192 ? 7344 + (j - 96) : (layer > 0 ? -2 - (j - 192) : -1)); }
    return 7440 + (n - 7680);
}
#define XB_TMO      128
#define XB_XCNT(j)  (256  + 64 * (j))
#define XB_XSUB(j)  (1280 + 64 * (j))
#define XB_XGEN(j)  (2304 + 64 * (j))
#define XB_TOP      3328
#define XB_TOPGEN   3392
#define XCD_BAR_WORDS 3456
#define XB_SPIN_CAP (1u << 18)

__device__ __forceinline__ unsigned xb_ld(unsigned* p)              { return __hip_atomic_load(p, __ATOMIC_RELAXED, __HIP_MEMORY_SCOPE_AGENT); }
__device__ __forceinline__ unsigned xb_add(unsigned* p, unsigned v) { return __hip_atomic_fetch_add(p, v, __ATOMIC_RELAXED, __HIP_MEMORY_SCOPE_AGENT); }
__device__ __forceinline__ unsigned xb_xcc_id() { return (unsigned)__builtin_amdgcn_s_getreg((3 << 11) | 20) & 0xFu; }
#define XB_SPIN(cond, bar) do { unsigned _sp = 0; while (cond) { __builtin_amdgcn_s_sleep(1); \
    if ((++_sp & 255u) == 0u) { if (xb_ld(&(bar)[XB_TMO])) break; if (_sp > XB_SPIN_CAP) { atomicAdd(&(bar)[XB_TMO], 1u); break; } } } } while (0)

struct XcdBarrier {
    unsigned* bar; unsigned x;
    volatile LAS unsigned* st;
};

__device__ __forceinline__ XcdBarrier xcd_barrier_post(unsigned* bar, volatile LAS unsigned* st) {
    XcdBarrier b; b.bar = bar; b.x = xb_xcc_id(); b.st = st;
    if (threadIdx.x == 0) (void)xb_add(&bar[XB_XCNT(b.x)], 1u);
    return b;
}
__device__ __forceinline__ void xcd_barrier_complete(unsigned* bar, unsigned x, unsigned& nloc, unsigned& nx) {
    const unsigned G = gridDim.x * gridDim.y * gridDim.z;
    unsigned sum, cnt, mine, sp = 0u;
    for (;;) {
        sum = 0u; cnt = 0u; mine = 0u;
#pragma unroll
        for (unsigned j = 0; j < 16; ++j) { const unsigned c = xb_ld(&bar[XB_XCNT(j)]); sum += c; cnt += (c > 0u) ? 1u : 0u; mine = (j == x) ? c : mine; }
        if (sum == G) break;
        __builtin_amdgcn_s_sleep(1);
        if ((++sp & 255u) == 0u) { if (xb_ld(&bar[XB_TMO])) break; if (sp > XB_SPIN_CAP) { atomicAdd(&bar[XB_TMO], 1u); break; } }
    }
    nloc = mine > 0u ? mine : 1u; nx = cnt > 0u ? cnt : 1u;
}

__device__ __forceinline__ void xcd_barrier(const XcdBarrier& b) {
    asm volatile("s_waitcnt vmcnt(0)" ::: "memory");
    __syncthreads();
    if (threadIdx.x == 0) {
        unsigned* bar = b.bar;
        __builtin_amdgcn_s_waitcnt(0);
        unsigned nloc = b.st[0], nx = b.st[1];
        if (nloc == 0u) { xcd_barrier_complete(bar, b.x, nloc, nx); b.st[0] = nloc; b.st[1] = nx; }
        const unsigned old = xb_add(&bar[XB_XSUB(b.x)], 1u);
        const unsigned gen = old / nloc;
        if (old + 1u == (gen + 1u) * nloc) {
            __builtin_amdgcn_fence(__ATOMIC_RELEASE, "agent");
            asm volatile("s_waitcnt vmcnt(0)" ::: "memory");
            const unsigned og = xb_add(&bar[XB_TOP], 1u);
            const unsigned tg = og / nx;
            if (og + 1u == (tg + 1u) * nx) xb_add(&bar[XB_TOPGEN], 1u);
            else XB_SPIN(xb_ld(&bar[XB_TOPGEN]) == tg, bar);
            __builtin_amdgcn_fence(__ATOMIC_ACQUIRE, "agent");
            xb_add(&bar[XB_XGEN(b.x)], 1u);
            asm volatile("s_waitcnt vmcnt(0)" ::: "memory");
        } else {
            XB_SPIN(xb_ld(&bar[XB_XGEN(b.x)]) == gen, bar);
            __builtin_amdgcn_fence(__ATOMIC_ACQUIRE, "agent");
            asm volatile("s_waitcnt vmcnt(0)" ::: "memory");
        }
    }
    __syncthreads();
}

struct Ctx {
    LAS unsigned char* lds; int tid, lane, wave, G, bid; unsigned char* ws; float* out;
};

template <int MAP>
__device__ __forceinline__ void wconv_item(const float* W, int ldw, const float* W2, int K, bf16* WT, LAS float* scr, int item, int nblk, int lane, int layer) {
    const int kb = item / nblk, nb = item % nblk, k0 = 64 * kb, n0 = 32 * nb;
    const int n = n0 + (lane & 31);
    const float* src = nullptr; int ld = ldw;
    if (MAP == 0) src = W + n;
    else if (MAP == 1) { const int s = win_src(n, layer); if (s >= 0) src = W + s; else if (s <= -2) { src = W2 + (-2 - s); ld = 64; } }
    else { const int tl = n >> 8, j = n & 255; src = W + (j < 128 ? tl * 128 + j : DFF + tl * 128 + (j - 128)); }
#pragma unroll 8
    for (int i = 0; i < 32; ++i) { const int kk = 2 * i + (lane >> 5); scr[kk * 33 + (lane & 31)] = src ? src[(size_t)(k0 + kk) * ld] : 0.f; }
    LDS_WAIT(); asm volatile("" ::: "memory");
    const int c = lane & 7;
#pragma unroll
    for (int j = 0; j < 4; ++j) { const int nn = (lane >> 3) + 8 * j; const LAS float* s = scr + (8 * c) * 33 + nn;
        u32x4 o; o.x = pk2(s[0 * 33], s[1 * 33]); o.y = pk2(s[2 * 33], s[3 * 33]); o.z = pk2(s[4 * 33], s[5 * 33]); o.w = pk2(s[6 * 33], s[7 * 33]);
        *(u32x4*)(WT + (size_t)(n0 + nn) * K + k0 + 8 * c) = o; }
    LDS_WAIT(); asm volatile("" ::: "memory");
}
struct WSrc { const float *w_in, *w_vres, *w_out, *w_gu, *w_dn, *wlb, *alb, *glb, *vlb; };
__device__ __forceinline__ void phase_wconv(const Ctx& C, int layer, const WSrc& W) {
    LAS float* scr = (LAS float*)(C.lds + C.wave * 16384);
    const int gw = C.bid * NWAVES + C.wave, NGW = C.G * NWAVES;
    const float* w_in = W.w_in + (size_t)layer * DM * N_IN; const float* w_vres = W.w_vres;
    const float* w_out = W.w_out + (size_t)layer * DM * DM; const float* w_gu = W.w_gu + (size_t)layer * DM * 2 * DFF; const float* w_dn = W.w_dn + (size_t)layer * DFF * DM;
    constexpr int I_IN = (DM / 64) * (N_INP / 32), I_OUT = (DM / 64) * (DM / 32), I_GU = (DM / 64) * (2 * DFF / 32), I_DN = (DFF / 64) * (DM / 32);
    for (int it = gw; it < I_IN + I_OUT + I_GU + I_DN; it += NGW) {
        int r = it;
        if (r < I_IN) { wconv_item<1>(w_in, N_IN, w_vres, DM, (bf16*)(C.ws + WS_WIN), scr, r, N_INP / 32, C.lane, layer); continue; } r -= I_IN;
        if (r < I_OUT) { wconv_item<0>(w_out, DM, nullptr, DM, (bf16*)(C.ws + WS_WOUT), scr, r, DM / 32, C.lane, layer); continue; } r -= I_OUT;
        if (r < I_GU) { wconv_item<2>(w_gu, 2 * DFF, nullptr, DM, (bf16*)(C.ws + WS_WGU), scr, r, 2 * DFF / 32, C.lane, layer); continue; } r -= I_GU;
        wconv_item<0>(w_dn, DM, nullptr, DFF, (bf16*)(C.ws + WS_WDN), scr, r, DM / 32, C.lane, layer);
    }
    const int gt = C.bid * NTHR + C.tid, NGT = C.G * NTHR;
    const float* wlb = W.wlb + (size_t)layer * 96 * 512; const float* alb = W.alb + (size_t)layer * 96 * 512; const float* glb = W.glb + (size_t)layer * 256 * 512;
    const float* vlb = W.vlb;
    bf16* LW = (bf16*)(C.ws + WS_LORA + LO_W); bf16* LA = (bf16*)(C.ws + WS_LORA + LO_A); bf16* LV = (bf16*)(C.ws + WS_LORA + LO_V); bf16* LG = (bf16*)(C.ws + WS_LORA + LO_G);
    for (int i = gt; i < 512 * 96; i += NGT) { const int n = i / 96, k = i % 96; LW[i] = (bf16)f2bf(wlb[k * 512 + n]); LA[i] = (bf16)f2bf(alb[k * 512 + n]); }
    for (int i = gt; i < 512 * 64; i += NGT) { const int n = i / 64, k = i % 64; LV[i] = (bf16)f2bf(layer > 0 ? vlb[k * 512 + n] : 0.f); }
    for (int i = gt; i < 512 * 256; i += NGT) { const int n = i / 256, k = i % 256; LG[i] = (bf16)f2bf(glb[k * 512 + n]); }
    if (layer == 0) {
        float2* TA = (float2*)(C.ws + WS_TAB + TAB_A); float2* TI = (float2*)(C.ws + WS_TAB + TAB_I); float2* TR = (float2*)(C.ws + WS_TAB + TAB_R);
        const float l2a = 18.931568569324174f  , l2r = 13.287712379549449f  ;
        for (int i = gt; i < T * 56; i += NGT) {
            const int pos = i / 56, j = i % 56; float fr; float2* dst;
            if (j < 16) { fr = exp2f(-(float)j * (1.0f / 16.0f) * l2a); dst = TA + pos * 16 + j; }
            else if (j < 24) { fr = exp2f(-(float)(j - 16) * (1.0f / 8.0f) * l2a); dst = TI + pos * 8 + (j - 16); }
            else { fr = exp2f(-(float)(j - 24) * (1.0f / 32.0f) * l2r); dst = TR + pos * 32 + (j - 24); }
            const float ang = (float)pos * fr; *dst = make_float2(cosf(ang), sinf(ang));
        }
    }
}
__device__ __forceinline__ void phase_norm_bf16(const Ctx& C, const float* x, const float* g, bf16* out) {
    const int gw = C.bid * NWAVES + C.wave, NGW = C.G * NWAVES;
    f32x4 gv[8];
#pragma unroll
    for (int j = 0; j < 8; ++j) gv[j] = *(const f32x4*)(g + 4 * (C.lane + 64 * j));
    for (int m = gw; m < M; m += NGW) {
        const f32x4* xr = (const f32x4*)(x + (size_t)m * DM) + C.lane; f32x4 v[8]; float s = 0.f;
#pragma unroll
        for (int j = 0; j < 8; ++j) { v[j] = xr[64 * j]; s += (v[j].x * v[j].x + v[j].y * v[j].y) + (v[j].z * v[j].z + v[j].w * v[j].w); }
        const float rs = rsqrtf(wave_sum(s) * (1.0f / DM) + 1e-5f);
        u32x2* o = (u32x2*)(out + (size_t)m * DM) + C.lane;
#pragma unroll
        for (int j = 0; j < 8; ++j) { u32x2 w; w.x = pk2(v[j].x * rs * gv[j].x, v[j].y * rs * gv[j].y); w.y = pk2(v[j].z * rs * gv[j].z, v[j].w * rs * gv[j].w); o[64 * j] = w; }
    }
}
__device__ __forceinline__ void phase_final_norm(const Ctx& C, float* x, const float* g) {
    const int gw = C.bid * NWAVES + C.wave, NGW = C.G * NWAVES;
    f32x4 gv[8];
#pragma unroll
    for (int j = 0; j < 8; ++j) gv[j] = *(const f32x4*)(g + 4 * (C.lane + 64 * j));
    for (int m = gw; m < M; m += NGW) {
        f32x4* xr = (f32x4*)(x + (size_t)m * DM) + C.lane; f32x4 v[8]; float s = 0.f;
#pragma unroll
        for (int j = 0; j < 8; ++j) { v[j] = xr[64 * j]; s += (v[j].x * v[j].x + v[j].y * v[j].y) + (v[j].z * v[j].z + v[j].w * v[j].w); }
        const float rs = rsqrtf(wave_sum(s) * (1.0f / DM) + 1e-5f);
#pragma unroll
        for (int j = 0; j < 8; ++j) xr[64 * j] = v[j] * rs * gv[j];
    }
}
__device__ __forceinline__ void phase_prep_a(const Ctx& C) {
    const long gt = (long)C.bid * NTHR + C.tid, NGT = (long)C.G * NTHR;
    for (int cfg = 0; cfg < 6; ++cfg) {
        size_t off; int ld, nh, hd, half; size_t tab;
        if (cfg == 0) { off = WS_Q; ld = 1024; nh = 8; hd = 128; half = 16; tab = TAB_A; }
        else if (cfg == 1) { off = WS_K; ld = 1024; nh = 8; hd = 128; half = 16; tab = TAB_A; }
        else if (cfg == 2) { off = WS_QI; ld = 1024; nh = 16; hd = 64; half = 8; tab = TAB_I; }
        else if (cfg == 3) { off = WS_KW; ld = 256; nh = 1; hd = 64; half = 8; tab = TAB_I; }
        else if (cfg == 4) { off = WS_BQ; ld = 256; nh = 4; hd = 64; half = 32; tab = TAB_R; }
        else { off = WS_BK; ld = 256; nh = 4; hd = 64; half = 32; tab = TAB_R; }
        bf16* buf = (bf16*)(C.ws + off); const float2* tb = (const float2*)(C.ws + WS_TAB + tab);
        const int cpp = half >> 3; const long total = (long)M * nh * cpp;
        for (long it = gt; it < total; it += NGT) {
            const int c = (int)(it % cpp); const long r2 = it / cpp; const int h = (int)(r2 % nh); const int row = (int)(r2 / nh); const int pos = row & (T - 1);
            bf16* p1 = buf + (size_t)row * ld + h * hd + 8 * c; bf16* p2 = p1 + half;
            const u32x4 a = *(const u32x4*)p1, b = *(const u32x4*)p2; const float2* tp = tb + (size_t)pos * half + 8 * c;
            float x1[8], x2[8];
#pragma unroll
            for (int e = 0; e < 4; ++e) { x1[2 * e] = bflo(a[e]); x1[2 * e + 1] = bfhi(a[e]); x2[2 * e] = bflo(b[e]); x2[2 * e + 1] = bfhi(b[e]); }
            u32x4 oa, ob;
#pragma unroll
            for (int e = 0; e < 4; ++e) {
                const float2 t0 = tp[2 * e], t1 = tp[2 * e + 1];
                oa[e] = pk2(x1[2 * e] * t0.x - x2[2 * e] * t0.y, x1[2 * e + 1] * t1.x - x2[2 * e + 1] * t1.y);
                ob[e] = pk2(x2[2 * e] * t0.x + x1[2 * e] * t0.y, x2[2 * e + 1] * t1.x + x1[2 * e + 1] * t1.y);
            }
            *(u32x4*)p1 = oa; *(u32x4*)p2 = ob;
        }
    }
    {
        LAS unsigned short* scr = (LAS unsigned short*)(C.lds + C.wave * 8704);
        const bf16* V = (const bf16*)(C.ws + WS_V); bf16* Vt = (bf16*)(C.ws + WS_VT);
        const int gw = C.bid * NWAVES + C.wave, NGW = C.G * NWAVES;
        for (int it = gw; it < NB * 128 * 16; it += NGW) {
            const int ct = it & 15, tt = (it >> 4) & 127, b = it >> 11;
            const int t0 = tt * 64, c0 = ct * 64;
#pragma unroll 4
            for (int i = 0; i < 32; ++i) { const int tr = 2 * i + (C.lane >> 5), cc = 2 * (C.lane & 31);
                const unsigned w = *(const unsigned*)(V + (size_t)(b * T + t0 + tr) * 1024 + c0 + cc); scr[tr * 66 + cc] = (unsigned short)(w & 0xffffu); scr[tr * 66 + cc + 1] = (unsigned short)(w >> 16); }
            LDS_WAIT(); asm volatile("" ::: "memory");
#pragma unroll 4
            for (int i = 0; i < 32; ++i) { const int cr = 2 * i + (C.lane >> 5), tp = 2 * (C.lane & 31);
                const unsigned w = (unsigned)scr[tp * 66 + cr] | ((unsigned)scr[(tp + 1) * 66 + cr] << 16);
                *(unsigned*)(Vt + ((size_t)b * 1024 + c0 + cr) * T + t0 + tp) = w; }
            LDS_WAIT(); asm volatile("" ::: "memory");
        }
    }
}
#ifndef IDX_REP_T
#define IDX_REP_T 1
#endif
#ifndef IDX_REP_S
#define IDX_REP_S 1
#endif
__device__ __forceinline__ void phase_indexer(const Ctx& C) {
    LAS unsigned short* sc = (LAS unsigned short*)C.lds;
    LAS unsigned* hist = (LAS unsigned*)(C.lds + 131072) + C.wave * 256;
    LAS float* wvl = (LAS float*)(C.lds + 131072 + 8192);
    LAS unsigned short* qbl = (LAS unsigned short*)(C.lds + 131072 + 8192 + 512);
    const bf16* QI = (const bf16*)(C.ws + WS_QI); const bf16* KW = (const bf16*)(C.ws + WS_KW); u64* MASK = (u64*)(C.ws + WS_MASK);
    const int lane = C.lane, r32 = lane & 31, hi = lane >> 5;
    for (int it = C.bid; it < NB * (T / 8); it += C.G) {
        const int b = it & 3, qg = it >> 2, q0 = qg * 8, qchunk = q0 >> 6, nadm = 64 * (qchunk + 1);
        const int qrow = b * T + q0 + C.wave;
        if (qchunk < 4) {
            MASK[(size_t)qrow * 128 + lane] = lane <= qchunk ? ~0ull : 0ull; MASK[(size_t)qrow * 128 + 64 + lane] = 0ull;
            continue;
        }
        bf16x8 af[4][4];
        {
            const int qq = (r32 >> 2) & 1, hh = (r32 & 3) + 4 * (r32 >> 3);
#pragma unroll
            for (int pr = 0; pr < 4; ++pr) {
                const bf16* qp = QI + (size_t)(b * T + q0 + 2 * pr + qq) * 1024 + hh * 64 + 8 * hi;
#pragma unroll
                for (int kk = 0; kk < 4; ++kk) af[pr][kk] = *(const bf16x8*)(qp + 16 * kk);
            }
            if (C.tid < 128) wvl[C.tid] = bf2f(KW[(size_t)(b * T + q0 + (C.tid >> 4)) * 256 + 64 + (C.tid & 15)]) * 0.015625f;
        }
        __syncthreads();
        { const int qx = C.tid >> 6, dx = C.tid & 63; const bf16* qp = QI + (size_t)(b * T + q0 + qx) * 1024 + dx; float acc = 0.f;
#pragma unroll
          for (int h = 0; h < 16; ++h) acc += wvl[qx * 16 + h] * bf2f(qp[h * 64]);
          qbl[qx * 64 + dx] = (unsigned short)f2bf(acc); }
        __syncthreads();
        bf16x8 afl[4];
        { const int qsel = 2 * (r32 & 3) + ((r32 >> 2) & 1);
#pragma unroll
          for (int kk = 0; kk < 4; ++kk) { const u32x4 z = {0u, 0u, 0u, 0u}; afl[kk] = r32 < 8 ? *(const LAS bf16x8*)(qbl + qsel * 64 + 16 * kk + 8 * hi) : __builtin_bit_cast(bf16x8, z); } }
        for (int rep_t = 0; rep_t < IDX_REP_T; ++rep_t) {
            const int ntile = nadm / 32;
            bf16x8 bfr[4], bnx[4];
            { const bf16* kp = KW + (size_t)(b * T + 32 * C.wave + r32) * 256 + 8 * hi;
#pragma unroll
              for (int kk = 0; kk < 4; ++kk) bnx[kk] = *(const bf16x8*)(kp + 16 * kk); }
            for (int tile = C.wave; tile < ntile; tile += NWAVES) {
                const int key0 = 32 * tile;
#pragma unroll
                for (int kk = 0; kk < 4; ++kk) bfr[kk] = bnx[kk];
                if (tile + NWAVES < ntile) { const bf16* kp = KW + (size_t)(b * T + key0 + 32 * NWAVES + r32) * 256 + 8 * hi;
#pragma unroll
                    for (int kk = 0; kk < 4; ++kk) bnx[kk] = *(const bf16x8*)(kp + 16 * kk); }
                const int kpos = (key0 & ~127) + 2 * ((key0 & 63) + r32) + ((key0 >> 6) & 1);
                f32x16 dl = {0.f, 0.f, 0.f, 0.f, 0.f, 0.f, 0.f, 0.f, 0.f, 0.f, 0.f, 0.f, 0.f, 0.f, 0.f, 0.f};
#pragma unroll
                for (int kk = 0; kk < 4; ++kk) dl = __builtin_amdgcn_mfma_f32_32x32x16_bf16(afl[kk], bfr[kk], dl, 0, 0, 0);
#pragma unroll
                for (int pr = 0; pr < 4; ++pr) {
                    f32x16 d = {0.f, 0.f, 0.f, 0.f, 0.f, 0.f, 0.f, 0.f, 0.f, 0.f, 0.f, 0.f, 0.f, 0.f, 0.f, 0.f};
#pragma unroll
                    for (int kk = 0; kk < 4; ++kk) d = __builtin_amdgcn_mfma_f32_32x32x16_bf16(af[pr][kk], bfr[kk], d, 0, 0, 0);
                    float s0 = dl[pr];
#pragma unroll
                    for (int g = 0; g < 4; ++g) { const f32x4 w4 = *(const LAS f32x4*)(wvl + (2 * pr + hi) * 16 + 4 * g);
                        s0 = __builtin_fmaf(__builtin_fabsf(d[4 * g]), w4.x, s0); s0 = __builtin_fmaf(__builtin_fabsf(d[4 * g + 1]), w4.y, s0); s0 = __builtin_fmaf(__builtin_fabsf(d[4 * g + 2]), w4.z, s0); s0 = __builtin_fmaf(__builtin_fabsf(d[4 * g + 3]), w4.w, s0); }
                    const unsigned short hb = __half_as_ushort(__float2half_rn(s0));
                    const unsigned short key = (hb & 0x8000u) ? (unsigned short)~hb : (unsigned short)(hb | 0x8000u);
                    sc[(2 * pr + hi) * 8192 + kpos] = key;
                }
            }
        }
        __syncthreads();
        const LAS unsigned* my = (const LAS unsigned*)(sc + C.wave * 8192);
        const int nit = nadm / 128;
        const bool tail = (nadm & 64) != 0;
        unsigned thr = 0;
        for (int rep_s = 0; rep_s < IDX_REP_S; ++rep_s) {
            unsigned want = 256u, prefix = 0u;
#pragma unroll 1
            for (int lvl = 0; lvl < 2; ++lvl) {
                hist[lane] = 0u; hist[64 + lane] = 0u; hist[128 + lane] = 0u; hist[192 + lane] = 0u;
                LDS_WAIT(); asm volatile("" ::: "memory");
                int i = 0;
                for (; i + 4 <= nit; i += 4) { unsigned kv[4];
#pragma unroll
                    for (int u = 0; u < 4; ++u) kv[u] = my[64 * (i + u) + lane];
#pragma unroll
                    for (int u = 0; u < 4; ++u) { const unsigned k0 = kv[u] & 0xffffu, k1 = kv[u] >> 16;
                        if (lvl == 0) { atomicAdd((unsigned*)&hist[k0 >> 8], 1u); atomicAdd((unsigned*)&hist[k1 >> 8], 1u); }
                        else { if ((k0 >> 8) == prefix) atomicAdd((unsigned*)&hist[k0 & 255u], 1u); if ((k1 >> 8) == prefix) atomicAdd((unsigned*)&hist[k1 & 255u], 1u); } } }
                for (; i < nit + (tail ? 1 : 0); ++i) { const unsigned kvv = my[64 * i + lane]; const unsigned k0 = kvv & 0xffffu, k1 = kvv >> 16; const bool two = i < nit;
                    if (lvl == 0) { atomicAdd((unsigned*)&hist[k0 >> 8], 1u); if (two) atomicAdd((unsigned*)&hist[k1 >> 8], 1u); }
                    else { if ((k0 >> 8) == prefix) atomicAdd((unsigned*)&hist[k0 & 255u], 1u); if (two && (k1 >> 8) == prefix) atomicAdd((unsigned*)&hist[k1 & 255u], 1u); } }
                LDS_WAIT(); asm volatile("" ::: "memory");
                const unsigned c0 = hist[4 * lane], c1 = hist[4 * lane + 1], c2 = hist[4 * lane + 2], c3 = hist[4 * lane + 3];
                const unsigned tl = c0 + c1 + c2 + c3; unsigned inc = tl;
#pragma unroll
                for (int o = 1; o < 64; o <<= 1) { const unsigned v = __shfl_down(inc, o); if (lane + o < 64) inc += v; }
                const unsigned ab3 = inc - tl, ab2 = ab3 + c3, ab1 = ab2 + c2, ab0 = ab1 + c1;
                int selb = -1; unsigned rem = 0;
                if (ab3 < want && ab3 + c3 >= want) { selb = 3; rem = want - ab3; }
                else if (ab2 < want && ab2 + c2 >= want) { selb = 2; rem = want - ab2; }
                else if (ab1 < want && ab1 + c1 >= want) { selb = 1; rem = want - ab1; }
                else if (ab0 < want && ab0 + c0 >= want) { selb = 0; rem = want - ab0; }
                const u64 bal = __ballot(selb >= 0); const int src = bal ? (int)__ffsll((long long)bal) - 1 : 0;
                const unsigned bin = (unsigned)__shfl(4 * lane + (selb < 0 ? 0 : selb), src); want = (unsigned)__shfl((int)rem, src);
                if (lvl == 0) prefix = bin; else thr = (prefix << 8) | bin;
                LDS_WAIT(); asm volatile("" ::: "memory");
            }
        }
        u64 w0 = 0, w1 = 0;
        for (int i = 0; i < nit + (tail ? 1 : 0); ++i) { const unsigned kvv = my[64 * i + lane]; const u64 b0 = __ballot((kvv & 0xffffu) >= thr), b1 = (i < nit) ? __ballot((kvv >> 16) >= thr) : 0ull;
            if (i < 32) { if (lane == 2 * i) w0 = b0; if (lane == 2 * i + 1) w0 = b1; } else { if (lane == 2 * i - 64) w1 = b0; if (lane == 2 * i - 63) w1 = b1; } }
        MASK[(size_t)qrow * 128 + lane] = w0; MASK[(size_t)qrow * 128 + 64 + lane] = w1;
        __syncthreads();
    }
}
constexpr int AT_KROW = 272, AT_VROW = 136, AT_KB = 64 * AT_KROW, AT_VB = 128 * AT_VROW, AT_BUF = AT_KB + AT_VB;
__device__ __forceinline__ void attn_unit(const Ctx& C, int b, int head, int qb) {
    const bf16* Q = (const bf16*)(C.ws + WS_Q); const bf16* K = (const bf16*)(C.ws + WS_K); const bf16* Vt = (const bf16*)(C.ws + WS_VT);
    const u64* MASK = (const u64*)(C.ws + WS_MASK); bf16* CAT = (bf16*)(C.ws + WS_CAT);
    const int tid = C.tid, lane = C.lane, wid = C.wave, r32 = lane & 31, hi = lane >> 5;
    const int q = 256 * qb + 32 * wid + r32; const size_t row = (size_t)b * T + q;
    const int nt = 4 * qb + 4, myc = 4 * qb + (wid >> 1);
    bf16x8 qf[8];
#pragma unroll
    for (int d0 = 0; d0 < 8; ++d0) qf[d0] = *(const bf16x8*)(Q + row * 1024 + head * 128 + 16 * d0 + 8 * hi);
    const bf16* kg[2]; const bf16* vg[2]; int kl[2], vl[2];
#pragma unroll
    for (int i = 0; i < 2; ++i) { const int c = tid + 512 * i;
        kg[i] = K + ((size_t)b * T + (c >> 4)) * 1024 + head * 128 + (c & 15) * 8; kl[i] = (c >> 4) * AT_KROW + (c & 15) * 16;
        vg[i] = Vt + ((size_t)(b * 8 + head) * 128 + (c >> 3)) * T + (c & 7) * 8; vl[i] = AT_KB + (c >> 3) * AT_VROW + (c & 7) * 16; }
    u32x4 kr[2], vr[2];
#pragma unroll
    for (int i = 0; i < 2; ++i) { kr[i] = *(const u32x4*)kg[i]; vr[i] = *(const u32x4*)vg[i]; }
#pragma unroll
    for (int i = 0; i < 2; ++i) { *(LAS u32x4*)(C.lds + kl[i]) = kr[i]; *(LAS u32x2*)(C.lds + vl[i]) = (u32x2){vr[i].x, vr[i].y}; *(LAS u32x2*)(C.lds + vl[i] + 8) = (u32x2){vr[i].z, vr[i].w}; }
    __syncthreads();
    float lrun = 0.f; f32x16 o[4];
#pragma unroll
    for (int db = 0; db < 4; ++db)
#pragma unroll
        for (int r = 0; r < 16; ++r) o[db][r] = 0.f;
    for (int t = 0; t < nt; ++t) {
        const int cur = (t & 1) * AT_BUF, nxt = ((t + 1) & 1) * AT_BUF;
        if (t + 1 < nt) {
#pragma unroll
            for (int i = 0; i < 2; ++i) { kr[i] = *(const u32x4*)(kg[i] + (size_t)(t + 1) * 64 * 1024); vr[i] = *(const u32x4*)(vg[i] + (t + 1) * 64); }
        }
        if (t <= myc) {
            const u64 mw = MASK[row * 128 + t];
            const LAS unsigned char* Ks = C.lds + cur; const LAS unsigned char* Vs = C.lds + cur + AT_KB;
            f32x16 p0, p1;
#pragma unroll
            for (int r = 0; r < 16; ++r) { p0[r] = 0.f; p1[r] = 0.f; }
#pragma unroll
            for (int d0 = 0; d0 < 8; ++d0) {
                const bf16x8 k0 = *(const LAS bf16x8*)(Ks + r32 * AT_KROW + (16 * d0 + 8 * hi) * 2);
                const bf16x8 k1 = *(const LAS bf16x8*)(Ks + (32 + r32) * AT_KROW + (16 * d0 + 8 * hi) * 2);
                p0 = __builtin_amdgcn_mfma_f32_32x32x16_bf16(k0, qf[d0], p0, 0, 0, 0);
                p1 = __builtin_amdgcn_mfma_f32_32x32x16_bf16(k1, qf[d0], p1, 0, 0, 0);
            }
            const int mlo = (int)((unsigned)mw >> (4 * hi)), mhi = (int)((unsigned)(mw >> 32) >> (4 * hi));
            float ls0 = 0.f, ls1 = 0.f;
#pragma unroll
            for (int r = 0; r < 16; ++r) { const int c = (r & 3) + 8 * (r >> 2);
                const unsigned e0 = __float_as_uint(__builtin_amdgcn_exp2f(p0[r])) & (unsigned)__builtin_amdgcn_sbfe(mlo, c, 1);
                const unsigned e1 = __float_as_uint(__builtin_amdgcn_exp2f(p1[r])) & (unsigned)__builtin_amdgcn_sbfe(mhi, c, 1);
                p0[r] = __uint_as_float(e0); p1[r] = __uint_as_float(e1); ls0 += p0[r]; ls1 += p1[r]; }
            lrun += ls0 + ls1;
            bf16x8 pb[4];
#pragma unroll
            for (int kk = 0; kk < 4; ++kk) { u32x4 w;
#pragma unroll
                for (int e = 0; e < 4; ++e) { const int r = 8 * (kk & 1) + 2 * e; w[e] = (kk < 2) ? pg8::cvt_pk_bf16(p0[r], p0[r + 1]) : pg8::cvt_pk_bf16(p1[r], p1[r + 1]); }
                pb[kk] = __builtin_bit_cast(bf16x8, w); }
#pragma unroll
            for (int db = 0; db < 4; ++db)
#pragma unroll
                for (int kk = 0; kk < 4; ++kk) {
                    const LAS unsigned char* vp = Vs + (32 * db + r32) * AT_VROW + (16 * kk + 4 * hi) * 2;
                    const u32x2 a0 = *(const LAS u32x2*)vp, a1 = *(const LAS u32x2*)(vp + 16);
                    const u32x4 w = {a0.x, a0.y, a1.x, a1.y};
                    o[db] = __builtin_amdgcn_mfma_f32_32x32x16_bf16(__builtin_bit_cast(bf16x8, w), pb[kk], o[db], 0, 0, 0);
                }
        }
        if (t + 1 < nt) {
#pragma unroll
            for (int i = 0; i < 2; ++i) { *(LAS u32x4*)(C.lds + nxt + kl[i]) = kr[i]; *(LAS u32x2*)(C.lds + nxt + vl[i]) = (u32x2){vr[i].x, vr[i].y}; *(LAS u32x2*)(C.lds + nxt + vl[i] + 8) = (u32x2){vr[i].z, vr[i].w}; }
        }
        __syncthreads();
    }
    lrun += __shfl_xor(lrun, 32);
    const float inv = 1.0f / lrun;
    bf16* op = CAT + row * 2048 + head * 128 + 4 * hi;
#pragma unroll
    for (int db = 0; db < 4; ++db)
#pragma unroll
        for (int g = 0; g < 4; ++g) { u32x2 w; w.x = pk2(o[db][4 * g] * inv, o[db][4 * g + 1] * inv); w.y = pk2(o[db][4 * g + 2] * inv, o[db][4 * g + 3] * inv);
            *(u32x2*)(op + 32 * db + 8 * g) = w; }
}
__device__ __forceinline__ void phase_attn(const Ctx& C) {
    for (int i = C.bid; i < 1024; i += C.G) {
        const int w = i & 255, k = i >> 8, combo = w >> 3, j = w & 7;
        const int qb = k == 0 ? j : k == 1 ? 15 - j : k == 2 ? 16 + j : 31 - j;
        attn_unit(C, combo >> 3, combo & 7, qb);
        __syncthreads();
    }
}
__device__ __forceinline__ float ret_logg(int h) { return log1pf(-exp2f(-5.0f - (float)h)); }
constexpr int RT_KS = 68;
__device__ __forceinline__ void phase_ret1(const Ctx& C) {
    LAS float* Ks = (LAS float*)C.lds;
    LAS float* Vs = (LAS float*)(C.lds + 64 * RT_KS * 4);
    const bf16* BK = (const bf16*)(C.ws + WS_BK); const bf16* BV = (const bf16*)(C.ws + WS_BV); float* KV = (float*)(C.ws + WS_KVST);
    const int tid = C.tid;
    for (int u = C.bid; u < NB * 128 * 4; u += C.G) {
        const int h = u & 3, c = (u >> 2) & 127, b = u >> 9; const size_t row0 = (size_t)b * T + 64 * c; const float lg = ret_logg(h);
        { const int m = tid >> 3, d8 = (tid & 7) * 8; const u32x4 w = *(const u32x4*)(BK + (row0 + m) * 256 + h * 64 + d8); const float z = __expf((63.0f - (float)m) * lg) * 0.125f;
#pragma unroll
          for (int e = 0; e < 4; ++e) { Ks[m * RT_KS + d8 + 2 * e] = bflo(w[e]) * z; Ks[m * RT_KS + d8 + 2 * e + 1] = bfhi(w[e]) * z; } }
#pragma unroll
        for (int i = 0; i < 2; ++i) { const int cidx = tid + 512 * i, m = cidx >> 4, e8 = (cidx & 15) * 8; const u32x4 w = *(const u32x4*)(BV + (row0 + m) * 512 + h * 128 + e8);
#pragma unroll
          for (int e = 0; e < 4; ++e) { Vs[m * 128 + e8 + 2 * e] = bflo(w[e]); Vs[m * 128 + e8 + 2 * e + 1] = bfhi(w[e]); } }
        __syncthreads();
        const int d = tid & 63, eg = tid >> 6; float acc[16];
#pragma unroll
        for (int e = 0; e < 16; ++e) acc[e] = 0.f;
        for (int m = 0; m < 64; ++m) { const float kv = Ks[m * RT_KS + d];
#pragma unroll
            for (int e4 = 0; e4 < 4; ++e4) { const f32x4 v = *(const LAS f32x4*)(Vs + m * 128 + 16 * eg + 4 * e4); acc[4 * e4] += kv * v.x; acc[4 * e4 + 1] += kv * v.y; acc[4 * e4 + 2] += kv * v.z; acc[4 * e4 + 3] += kv * v.w; } }
        float* dst = KV + (size_t)u * 8192 + d * 128 + 16 * eg;
#pragma unroll
        for (int e4 = 0; e4 < 4; ++e4) *(f32x4*)(dst + 4 * e4) = (f32x4){acc[4 * e4], acc[4 * e4 + 1], acc[4 * e4 + 2], acc[4 * e4 + 3]};
        __syncthreads();
    }
}
__device__ __forceinline__ void phase_ret2(const Ctx& C) {
    float* KV = (float*)(C.ws + WS_KVST);
    for (int g = C.bid * NTHR + C.tid; g < NB * 4 * 8192; g += C.G * NTHR) {
        const int el = g & 8191, h = (g >> 13) & 3, b = g >> 15; const float gc = __expf(64.0f * ret_logg(h));
        float* p = KV + ((size_t)b * 512 + h) * 8192 + el;
        float st = 0.f;
        for (int c0 = 0; c0 < 128; c0 += 8) { float x[8];
#pragma unroll
            for (int i = 0; i < 8; ++i) x[i] = p[(size_t)(c0 + i) * 4 * 8192];
#pragma unroll
            for (int i = 0; i < 8; ++i) { p[(size_t)(c0 + i) * 4 * 8192] = st; st = st * gc + x[i]; } }
    }
}
__device__ __forceinline__ void phase_ret3(const Ctx& C) {
    LAS float* Qs = (LAS float*)C.lds;
    LAS float* Ks = Qs + 64 * RT_KS;
    LAS float* Sc = Ks + 64 * RT_KS;
    LAS float* Vs = Sc + 64 * RT_KS;
    LAS float* Ps = Vs + 64 * 128;
    const bf16* BQ = (const bf16*)(C.ws + WS_BQ); const bf16* BK = (const bf16*)(C.ws + WS_BK); const bf16* BV = (const bf16*)(C.ws + WS_BV); const bf16* BG = (const bf16*)(C.ws + WS_BG);
    const float* KV = (const float*)(C.ws + WS_KVST); bf16* CAT = (bf16*)(C.ws + WS_CAT);
    const int tid = C.tid;
    for (int u = C.bid; u < NB * 128 * 4; u += C.G) {
        const int h = u & 3, c = (u >> 2) & 127, b = u >> 9; const size_t row0 = (size_t)b * T + 64 * c; const float lg = ret_logg(h);
        { const int m = tid >> 3, d8 = (tid & 7) * 8; const u32x4 wq = *(const u32x4*)(BQ + (row0 + m) * 256 + h * 64 + d8), wk = *(const u32x4*)(BK + (row0 + m) * 256 + h * 64 + d8);
#pragma unroll
          for (int e = 0; e < 4; ++e) { Qs[m * RT_KS + d8 + 2 * e] = bflo(wq[e]); Qs[m * RT_KS + d8 + 2 * e + 1] = bfhi(wq[e]); Ks[m * RT_KS + d8 + 2 * e] = bflo(wk[e]) * 0.125f; Ks[m * RT_KS + d8 + 2 * e + 1] = bfhi(wk[e]) * 0.125f; } }
#pragma unroll
        for (int i = 0; i < 2; ++i) { const int cidx = tid + 512 * i, m = cidx >> 4, e8 = (cidx & 15) * 8; const u32x4 w = *(const u32x4*)(BV + (row0 + m) * 512 + h * 128 + e8);
#pragma unroll
          for (int e = 0; e < 4; ++e) { Vs[m * 128 + e8 + 2 * e] = bflo(w[e]); Vs[m * 128 + e8 + 2 * e + 1] = bfhi(w[e]); } }
#pragma unroll
        for (int i = 0; i < 4; ++i) { const int cidx = tid + 512 * i; *(LAS f32x4*)(Ps + 4 * cidx) = *(const f32x4*)(KV + (size_t)u * 8192 + 4 * cidx); }
        __syncthreads();
        {
            const int n = tid >> 3, mg = tid & 7; float s[8];
#pragma unroll
            for (int j = 0; j < 8; ++j) s[j] = 0.f;
            for (int d4 = 0; d4 < 16; ++d4) { const f32x4 qv = *(const LAS f32x4*)(Qs + n * RT_KS + 4 * d4);
#pragma unroll
                for (int j = 0; j < 8; ++j) { const f32x4 kv = *(const LAS f32x4*)(Ks + (mg + 8 * j) * RT_KS + 4 * d4); s[j] += (qv.x * kv.x + qv.y * kv.y) + (qv.z * kv.z + qv.w * kv.w); } }
#pragma unroll
            for (int j = 0; j < 8; ++j) { const int m = mg + 8 * j; Sc[n * RT_KS + m] = (m <= n) ? s[j] * __expf((float)(n - m) * lg) : 0.f; }
        }
        __syncthreads();
        {
            const int n = tid >> 3, eg = tid & 7; float acc[16], cr[16];
#pragma unroll
            for (int e = 0; e < 16; ++e) { acc[e] = 0.f; cr[e] = 0.f; }
            for (int m = 0; m <= n; ++m) { const float sv = Sc[n * RT_KS + m];
#pragma unroll
                for (int e4 = 0; e4 < 4; ++e4) { const f32x4 v = *(const LAS f32x4*)(Vs + m * 128 + 16 * eg + 4 * e4); acc[4 * e4] += sv * v.x; acc[4 * e4 + 1] += sv * v.y; acc[4 * e4 + 2] += sv * v.z; acc[4 * e4 + 3] += sv * v.w; } }
            for (int d = 0; d < 64; ++d) { const float qv = Qs[n * RT_KS + d];
#pragma unroll
                for (int e4 = 0; e4 < 4; ++e4) { const f32x4 v = *(const LAS f32x4*)(Ps + d * 128 + 16 * eg + 4 * e4); cr[4 * e4] += qv * v.x; cr[4 * e4 + 1] += qv * v.y; cr[4 * e4 + 2] += qv * v.z; cr[4 * e4 + 3] += qv * v.w; } }
            const float xi = __expf((float)(n + 1) * lg); float sum = 0.f;
#pragma unroll
            for (int e = 0; e < 16; ++e) { acc[e] += xi * cr[e]; sum += acc[e]; }
            sum += __shfl_xor(sum, 1); sum += __shfl_xor(sum, 2); sum += __shfl_xor(sum, 4);
            const float mu = sum * (1.0f / 128.0f); float var = 0.f;
#pragma unroll
            for (int e = 0; e < 16; ++e) { const float dlt = acc[e] - mu; var += dlt * dlt; }
            var += __shfl_xor(var, 1); var += __shfl_xor(var, 2); var += __shfl_xor(var, 4);
            const float rstd = rsqrtf(var * (1.0f / 128.0f) + 1e-5f);
            const bf16* gp = BG + (row0 + n) * 512 + h * 128 + 16 * eg; const u32x4 g0 = *(const u32x4*)gp, g1 = *(const u32x4*)(gp + 8);
            float gv[16];
#pragma unroll
            for (int e = 0; e < 4; ++e) { gv[2 * e] = bflo(g0[e]); gv[2 * e + 1] = bfhi(g0[e]); gv[8 + 2 * e] = bflo(g1[e]); gv[8 + 2 * e + 1] = bfhi(g1[e]); }
            float ov[16];
#pragma unroll
            for (int e = 0; e < 16; ++e) { const float gg = gv[e]; const float sl = gg * __builtin_amdgcn_rcpf(1.0f + __expf(-gg)); ov[e] = (acc[e] - mu) * rstd * sl; }
            bf16* op = CAT + (row0 + n) * 2048 + 1024 + h * 128 + 16 * eg;
            u32x4 w0, w1;
#pragma unroll
            for (int e = 0; e < 4; ++e) { w0[e] = pk2(ov[2 * e], ov[2 * e + 1]); w1[e] = pk2(ov[8 + 2 * e], ov[8 + 2 * e + 1]); }
            *(u32x4*)op = w0; *(u32x4*)(op + 8) = w1;
        }
        __syncthreads();
    }
}
__device__ __forceinline__ float sigmoidf_(float x) { return __builtin_amdgcn_rcpf(1.0f + __expf(-x)); }
constexpr int RW_AW = 104, RW_AV = 72, RW_AG = 264;
constexpr int RW1_BUF = 32 * RW_AW * 2 + 32 * RW_AV;
struct RwP { const float *mu, *mu_v, *w0, *a0, *v0, *k_k, *k_a, *r_k, *lnx_g, *lnx_b; };
template <class TT> __device__ __forceinline__ GAS TT* opaque_g(const TT* p) {
    unsigned lo = (unsigned)(uintptr_t)p, hi = (unsigned)((uintptr_t)p >> 32); asm volatile("" : "+v"(lo), "+v"(hi));
    lo = __builtin_amdgcn_readfirstlane(lo); hi = __builtin_amdgcn_readfirstlane(hi); return (GAS TT*)(((uintptr_t)hi << 32) | lo);
}
__device__ __forceinline__ int tokr(int r, int hi) { return (r & 3) + 8 * (r >> 2) + 4 * hi; }
template <class TT> __device__ __forceinline__ GAS TT* at_b(GAS TT* ub, unsigned boff) { return (GAS TT*)((GAS char*)ub + boff); }
__device__ __forceinline__ void shifted16(GAS bf16* ub, const unsigned (&off)[16], int cbo, bool first_unit, int hi, float mu, float (&x)[16]) {
    float cur[16], prv[4];
#pragma unroll
    for (int r = 0; r < 16; ++r) cur[r] = bf2f(at_b(ub, off[r])[cbo]);
#pragma unroll
    for (int g = 0; g < 4; ++g) { const bool first = (g == 0) && (hi == 0) && first_unit; prv[g] = first ? 0.f : bf2f(at_b(ub, off[4 * g])[cbo - 512]); }
#pragma unroll
    for (int r = 0; r < 16; ++r) { const float p = (r & 3) == 0 ? prv[r >> 2] : cur[r - 1]; x[r] = cur[r] + (p - cur[r]) * mu; }
}
__device__ __forceinline__ float half_sum32(float v) { v += __shfl_xor(v, 1); v += __shfl_xor(v, 2); v += __shfl_xor(v, 4); v += __shfl_xor(v, 8); v += __shfl_xor(v, 16); return v; }
__device__ __forceinline__ void phase_rw1(const Ctx& C, int layer, const RwP& P) {
    LAS bf16* ACT = (LAS bf16*)C.lds;
    const bf16* CR = (const bf16*)(C.ws + WS_CR); const bf16* CK = (const bf16*)(C.ws + WS_CK); const bf16* CV = (const bf16*)(C.ws + WS_CV); const bf16* CL = (const bf16*)(C.ws + WS_CL);
    const bf16* LW = (const bf16*)(C.ws + WS_LORA + LO_W); const bf16* LA = (const bf16*)(C.ws + WS_LORA + LO_A); const bf16* LV = (const bf16*)(C.ws + WS_LORA + LO_V);
    bf16* VF = (bf16*)(C.ws + WS_VFIRST);
    bf16* RR = (bf16*)(C.ws + WS_RR); bf16* RU = (bf16*)(C.ws + WS_RW); bf16* RKH = (bf16*)(C.ws + WS_RKH); bf16* RV = (bf16*)(C.ws + WS_RV); bf16* RA = (bf16*)(C.ws + WS_RA); bf16* RB = (bf16*)(C.ws + WS_RB);
    const float* mu = P.mu + (size_t)layer * 1984; const float* mu_v = P.mu_v;
    const float* w0 = P.w0 + layer * 512; const float* a0 = P.a0 + layer * 512; const float* v0 = P.v0; const float* k_k = P.k_k + layer * 512; const float* k_a = P.k_a + layer * 512;
    const int tid = C.tid, lane = C.lane, wid = C.wave;
    constexpr int NU = M / 32;
    u32x4 ncur[2], nprv[2];
#define RW1_LOAD(uu) do { _Pragma("unroll") for (int j = 0; j < 2; ++j) { const int ci = tid + 512 * j, tok = ci >> 5, c8 = (ci & 31) * 8; const size_t mm = (size_t)(uu) * 32 + tok; \
        ncur[j] = *(const u32x4*)(CL + mm * 256 + c8); const u32x4 z4 = {0u, 0u, 0u, 0u}; nprv[j] = (mm & (T - 1)) == 0 ? z4 : *(const u32x4*)(CL + (mm - 1) * 256 + c8); } } while (0)
#define RW1_STORE(bufi) do { _Pragma("unroll") for (int j = 0; j < 2; ++j) { const int ci = tid + 512 * j, tok = ci >> 5, c8 = (ci & 31) * 8; \
        const float* mp = c8 < 192 ? mu + 1536 + c8 : mu_v + (c8 - 192); f32x4 m0v = {0.f, 0.f, 0.f, 0.f}, m1v = m0v; if (c8 < 192 || layer > 0) { m0v = *(const f32x4*)mp; m1v = *(const f32x4*)(mp + 4); } \
        float xs[8]; _Pragma("unroll") for (int e = 0; e < 4; ++e) { const float c0 = bflo(ncur[j][e]), c1 = bfhi(ncur[j][e]), p0 = bflo(nprv[j][e]), p1 = bfhi(nprv[j][e]); \
            const float ma = e < 2 ? m0v[2 * e] : m1v[2 * e - 4], mb = e < 2 ? m0v[2 * e + 1] : m1v[2 * e - 3]; xs[2 * e] = c0 + (p0 - c0) * ma; xs[2 * e + 1] = c1 + (p1 - c1) * mb; } \
        if (c8 < 96) { _Pragma("unroll") for (int e = 0; e < 8; ++e) xs[e] = 1.0f - 2.0f * __builtin_amdgcn_rcpf(__expf(2.0f * xs[e]) + 1.0f); }     \
        u32x4 o; o.x = pk2(xs[0], xs[1]); o.y = pk2(xs[2], xs[3]); o.z = pk2(xs[4], xs[5]); o.w = pk2(xs[6], xs[7]); \
        LAS bf16* dst = ACT + (bufi) * RW1_BUF + (c8 < 96 ? tok * RW_AW + c8 : c8 < 192 ? 32 * RW_AW + tok * RW_AW + (c8 - 96) : 64 * RW_AW + tok * RW_AV + (c8 - 192)); \
        *(LAS u32x4*)dst = o; } } while (0)
    int u = C.bid; if (u >= NU) return;
    RW1_LOAD(u); RW1_STORE(0); __syncthreads();
    for (int kbuf = 0; ; kbuf ^= 1) {
        const int un = u + C.G; const bool has_next = un < NU;
        if (has_next) RW1_LOAD(un);
        {
            int r32 = lane & 31, hi = lane >> 5; asm volatile("" : "+v"(r32), "+v"(hi));
            const size_t m0 = (size_t)u * 32; const bool first_unit = (m0 & (T - 1)) == 0;
            const LAS bf16* AW = ACT + kbuf * RW1_BUF; const LAS bf16* AA = AW + 32 * RW_AW; const LAS bf16* AV = AA + 32 * RW_AW;
            unsigned off[16];
#pragma unroll
            for (int r = 0; r < 16; ++r) off[r] = (unsigned)(tokr(r, hi) * 512 + 64 * wid + r32) * 2u;
            GAS bf16* CRu = opaque_g(CR + m0 * 512); GAS bf16* CKu = opaque_g(CK + m0 * 512); GAS bf16* CVu = opaque_g(CV + m0 * 512); GAS bf16* VFu = opaque_g(VF + m0 * 512);
            GAS bf16* RRu = opaque_g(RR + m0 * 512); GAS bf16* RUu = opaque_g(RU + m0 * 512); GAS bf16* RKHu = opaque_g(RKH + m0 * 512); GAS bf16* RVu = opaque_g(RV + m0 * 512); GAS bf16* RAu = opaque_g(RA + m0 * 512); GAS bf16* RBu = opaque_g(RB + m0 * 512);
            float ks[2][16], inv[16];
            {
                float ssr[16];
#pragma unroll
                for (int r = 0; r < 16; ++r) ssr[r] = 0.f;
#pragma unroll
                for (int cb = 0; cb < 2; ++cb) { const int c = 64 * wid + 32 * cb + r32; const float kkc = k_k[c]; shifted16(CKu, off, 32 * cb, first_unit, hi, mu[512 + c], ks[cb]);
#pragma unroll
                    for (int r = 0; r < 16; ++r) { const float kr = ks[cb][r] * kkc; ssr[r] += kr * kr; } }
#pragma unroll
                for (int r = 0; r < 16; ++r) inv[r] = 1.0f / fmaxf(sqrtf(half_sum32(ssr[r])), 1e-12f);
            }
#pragma unroll
            for (int cb = 0; cb < 2; ++cb) {
                const int c = 64 * wid + 32 * cb + r32; const int ci = 32 * cb;
                asm volatile("" : "+v"(off[0]), "+v"(off[1]), "+v"(off[2]), "+v"(off[3]), "+v"(off[4]), "+v"(off[5]), "+v"(off[6]), "+v"(off[7]), "+v"(off[8]), "+v"(off[9]), "+v"(off[10]), "+v"(off[11]), "+v"(off[12]), "+v"(off[13]), "+v"(off[14]), "+v"(off[15]));
                {
                    float rs[16]; shifted16(CRu, off, ci, first_unit, hi, mu[c], rs);
#pragma unroll
                    for (int r = 0; r < 16; ++r) at_b(RRu, off[r])[ci] = (bf16)f2bf(rs[r]);
                }
                asm volatile("" ::: "memory");
                {
                    float vs[16]; shifted16(CVu, off, ci, first_unit, hi, mu[1024 + c], vs);
                    if (layer > 0) {
                        f32x16 dv;
#pragma unroll
                        for (int r = 0; r < 16; ++r) dv[r] = 0.f;
#pragma unroll
                        for (int kk = 0; kk < 4; ++kk) { const bf16x8 wv = *(const bf16x8*)(LV + c * 64 + 16 * kk + 8 * hi); const bf16x8 xv = *(const LAS bf16x8*)(AV + r32 * RW_AV + 16 * kk + 8 * hi);
                            dv = __builtin_amdgcn_mfma_f32_32x32x16_bf16(xv, wv, dv, 0, 0, 0); }
                        const float v0c = v0[c];
#pragma unroll
                        for (int r = 0; r < 16; ++r) { const float vf = bf2f(at_b(VFu, off[r])[ci]); at_b(RVu, off[r])[ci] = (bf16)f2bf(vs[r] + (vf - vs[r]) * sigmoidf_(v0c + dv[r])); }
                    } else {
#pragma unroll
                        for (int r = 0; r < 16; ++r) { const bf16 vb = (bf16)f2bf(vs[r]); at_b(VFu, off[r])[ci] = vb; at_b(RVu, off[r])[ci] = vb; }
                    }
                }
                asm volatile("" ::: "memory");
                {
                    f32x16 dw;
#pragma unroll
                    for (int r = 0; r < 16; ++r) dw[r] = 0.f;
#pragma unroll
                    for (int kk = 0; kk < 6; ++kk) { const bf16x8 ww = *(const bf16x8*)(LW + c * 96 + 16 * kk + 8 * hi); const bf16x8 xw = *(const LAS bf16x8*)(AW + r32 * RW_AW + 16 * kk + 8 * hi);
                        dw = __builtin_amdgcn_mfma_f32_32x32x16_bf16(xw, ww, dw, 0, 0, 0); }
                    const float w0c = w0[c];
#pragma unroll
                    for (int r = 0; r < 16; ++r) { const float z = -(w0c + dw[r]); const float sp = fmaxf(z, 0.f) + __logf(1.0f + __expf(-fabsf(z)));
                        at_b(RUu, off[r])[ci] = (bf16)f2bf(1.0f - __expf(-__expf(-sp - 0.5f))); }
                }
                asm volatile("" ::: "memory");
                {
                    f32x16 da;
#pragma unroll
                    for (int r = 0; r < 16; ++r) da[r] = 0.f;
#pragma unroll
                    for (int kk = 0; kk < 6; ++kk) { const bf16x8 wa = *(const bf16x8*)(LA + c * 96 + 16 * kk + 8 * hi); const bf16x8 xa = *(const LAS bf16x8*)(AA + r32 * RW_AW + 16 * kk + 8 * hi);
                        da = __builtin_amdgcn_mfma_f32_32x32x16_bf16(xa, wa, da, 0, 0, 0); }
                    const float a0c = a0[c], kkc = k_k[c], kac = k_a[c];
#pragma unroll
                    for (int r = 0; r < 16; ++r) { const float a = sigmoidf_(a0c + da[r]); const float ksx = ks[cb][r]; const float kk = ksx * kkc * inv[r];
                        at_b(RKHu, off[r])[ci] = (bf16)f2bf(ksx * (1.0f + (a - 1.0f) * kac)); at_b(RAu, off[r])[ci] = (bf16)f2bf(-kk); at_b(RBu, off[r])[ci] = (bf16)f2bf(kk * a); }
                }
                asm volatile("" ::: "memory");
            }
        }
        if (has_next) RW1_STORE(kbuf ^ 1);
        __syncthreads();
        if (!has_next) break;
        u = un;
    }
#undef RW1_LOAD
#undef RW1_STORE
}
constexpr int RW_L = 128, RW_NC = T / RW_L;
constexpr int RW_TB = 8, RW_STG = 6 * RW_TB * 64;
__device__ __forceinline__ float xhalf_sum(float x) { const auto rr = __builtin_amdgcn_permlane32_swap(__float_as_uint(x), __float_as_uint(x), false, false); return __uint_as_float(rr[0]) + __uint_as_float(rr[1]); }
template <int NS, bool OUT>
__device__ __forceinline__ void rwkv_chunk(f32x16 (&D)[NS][2][2], LAS float* stg, const bf16* RWd, const bf16* RA, const bf16* RB, const bf16* RKH, const bf16* RV, const bf16* RR, float* Y, size_t base0, int nsteps, int lane) {
    const int r32 = lane & 31, hi = lane >> 5;
    for (int t0 = 0; t0 < nsteps; t0 += RW_TB) {
        {
            float tw[RW_TB], ta[RW_TB], tr[RW_TB], tb[RW_TB], tk[RW_TB], tv[RW_TB];
#pragma unroll
            for (int s = 0; s < RW_TB; ++s) { const size_t o = base0 + (size_t)(t0 + s) * 512 + lane; tw[s] = 1.0f - bf2f(RWd[o]); ta[s] = bf2f(RA[o]); tr[s] = OUT ? bf2f(RR[o]) : 0.f; tb[s] = bf2f(RB[o]); tk[s] = bf2f(RKH[o]); tv[s] = bf2f(RV[o]); }
#pragma unroll
            for (int s = 0; s < RW_TB; ++s) { stg[(0 * RW_TB + s) * 64 + lane] = tw[s]; stg[(1 * RW_TB + s) * 64 + lane] = ta[s]; if (OUT) stg[(2 * RW_TB + s) * 64 + lane] = tr[s];
                stg[(3 * RW_TB + s) * 64 + lane] = tb[s]; stg[(4 * RW_TB + s) * 64 + lane] = tk[s]; stg[(5 * RW_TB + s) * 64 + lane] = tv[s]; }
        }
        LDS_WAIT(); asm volatile("" ::: "memory");
#pragma unroll 1
        for (int s = 0; s < RW_TB; ++s) {
            const LAS float* sw = stg + (0 * RW_TB + s) * 64 + 4 * hi; const LAS float* sa_ = stg + (1 * RW_TB + s) * 64 + 4 * hi; const LAS float* sr = stg + (2 * RW_TB + s) * 64 + 4 * hi;
            const LAS float* sbk = stg + ((hi ? 4 : 3) * RW_TB + s) * 64 + r32; const LAS float* sv = stg + (5 * RW_TB + s) * 64 + r32;
            const float bk0 = sbk[0], bk1 = sbk[32], v0 = sv[0], v1 = sv[32];
            float sav[NS][2];
            {
                f32x4 av[2][4];
#pragma unroll
                for (int jb = 0; jb < 2; ++jb)
#pragma unroll
                    for (int g = 0; g < 4; ++g) av[jb][g] = *(const LAS f32x4*)(sa_ + 32 * jb + 8 * g);
#pragma unroll
                for (int st = 0; st < NS; ++st)
#pragma unroll
                    for (int ib = 0; ib < 2; ++ib) { float p0 = 0.f, p1 = 0.f;
#pragma unroll
                        for (int jb = 0; jb < 2; ++jb)
#pragma unroll
                            for (int g = 0; g < 4; ++g) { const f32x16& d = D[st][jb][ib]; p0 += d[4 * g] * av[jb][g].x; p1 += d[4 * g + 1] * av[jb][g].y; p0 += d[4 * g + 2] * av[jb][g].z; p1 += d[4 * g + 3] * av[jb][g].w; }
                        sav[st][ib] = xhalf_sum(p0 + p1); }
            }
            {
                f32x4 wv[2][4];
#pragma unroll
                for (int jb = 0; jb < 2; ++jb)
#pragma unroll
                    for (int g = 0; g < 4; ++g) wv[jb][g] = *(const LAS f32x4*)(sw + 32 * jb + 8 * g);
#pragma unroll
                for (int st = 0; st < NS; ++st)
#pragma unroll
                    for (int jb = 0; jb < 2; ++jb)
#pragma unroll
                        for (int ib = 0; ib < 2; ++ib)
#pragma unroll
                            for (int g = 0; g < 4; ++g) { f32x16& d = D[st][jb][ib]; d[4 * g] *= wv[jb][g].x; d[4 * g + 1] *= wv[jb][g].y; d[4 * g + 2] *= wv[jb][g].z; d[4 * g + 3] *= wv[jb][g].w; }
            }
#pragma unroll
            for (int st = 0; st < NS; ++st) {
                const bool inject = (NS == 1) || (st == 1);
#pragma unroll
                for (int jb = 0; jb < 2; ++jb) { const float bkj = jb == 0 ? bk0 : bk1; const float A = inject ? bkj : (hi ? 0.f : bkj);
#pragma unroll
                    for (int ib = 0; ib < 2; ++ib) { const float B = hi ? (ib == 0 ? v0 : v1) : sav[st][ib];
                        D[st][jb][ib] = __builtin_amdgcn_mfma_f32_32x32x2f32(A, B, D[st][jb][ib], 0, 0, 0); } }
            }
            if (OUT) {
                f32x4 rv[2][4];
#pragma unroll
                for (int jb = 0; jb < 2; ++jb)
#pragma unroll
                    for (int g = 0; g < 4; ++g) rv[jb][g] = *(const LAS f32x4*)(sr + 32 * jb + 8 * g);
#pragma unroll
                for (int ib = 0; ib < 2; ++ib) { float p0 = 0.f, p1 = 0.f;
#pragma unroll
                    for (int jb = 0; jb < 2; ++jb)
#pragma unroll
                        for (int g = 0; g < 4; ++g) { const f32x16& d = D[NS - 1][jb][ib]; p0 += d[4 * g] * rv[jb][g].x; p1 += d[4 * g + 1] * rv[jb][g].y; p0 += d[4 * g + 2] * rv[jb][g].z; p1 += d[4 * g + 3] * rv[jb][g].w; }
                    const float y = xhalf_sum(p0 + p1);
                    if (hi == 0) Y[base0 + (size_t)(t0 + s) * 512 + 32 * ib + r32] = y; }
            }
        }
        LDS_WAIT(); asm volatile("" ::: "memory");
    }
}
__device__ __forceinline__ void phase_rw2(const Ctx& C) {
    const bf16* RWd = (const bf16*)(C.ws + WS_RW); const bf16* RA = (const bf16*)(C.ws + WS_RA); const bf16* RB = (const bf16*)(C.ws + WS_RB); const bf16* RKH = (const bf16*)(C.ws + WS_RKH); const bf16* RV = (const bf16*)(C.ws + WS_RV);
    float* PHI = (float*)(C.ws + WS_PHI); float* PSI = (float*)(C.ws + WS_PSI);
    LAS float* stg = (LAS float*)C.lds + C.wave * RW_STG;
    const int ntask = NB * 8 * RW_NC, r32 = C.lane & 31, hi = C.lane >> 5;
    for (int task = C.wave * C.G + C.bid; task < ntask; task += C.G * NWAVES) {
        const int ck = task % RW_NC, bh = task / RW_NC, h = bh & 7, b = bh >> 3;
        const size_t base0 = ((size_t)b * T + (size_t)ck * RW_L) * 512 + h * 64;
        f32x16 D[2][2][2];
#pragma unroll
        for (int jb = 0; jb < 2; ++jb)
#pragma unroll
            for (int ib = 0; ib < 2; ++ib)
#pragma unroll
                for (int r = 0; r < 16; ++r) { D[0][jb][ib][r] = (jb == ib && ((r & 3) + 8 * (r >> 2) + 4 * hi) == r32) ? 1.f : 0.f; D[1][jb][ib][r] = 0.f; }
        rwkv_chunk<2, false>(D, stg, RWd, RA, RB, RKH, RV, nullptr, nullptr, base0, RW_L, C.lane);
#pragma unroll
        for (int st = 0; st < 2; ++st) { float* dst = (st == 0 ? PHI : PSI) + (size_t)task * 4096;
#pragma unroll
            for (int jb = 0; jb < 2; ++jb)
#pragma unroll
                for (int ib = 0; ib < 2; ++ib)
#pragma unroll
                    for (int g = 0; g < 4; ++g) *(f32x4*)(dst + (32 * ib + r32) * 64 + 32 * jb + 8 * g + 4 * hi) = (f32x4){D[st][jb][ib][4 * g], D[st][jb][ib][4 * g + 1], D[st][jb][ib][4 * g + 2], D[st][jb][ib][4 * g + 3]}; }
    }
}
constexpr int R3_P = 65;
__device__ __forceinline__ void phase_rw3(const Ctx& C) {
    const float* PHI = (const float*)(C.ws + WS_PHI); const float* PSI = (const float*)(C.ws + WS_PSI); float* SST = (float*)(C.ws + WS_SST);
    const int half = C.wave >> 2, w4 = C.wave & 3, ibo = w4 >> 1, kb = w4 & 1, r32 = C.lane & 31, hi = C.lane >> 5;
    LAS float* Sl = (LAS float*)C.lds + half * (2 * 64 * R3_P);
    for (int pr = C.bid; pr < NB * 8 / 2; pr += C.G) {
        const int bh = 2 * pr + half;
        f32x16 acc;
#pragma unroll
        for (int r = 0; r < 16; ++r) acc[r] = 0.f;
        for (int ck = 0; ck < RW_NC; ++ck) {
            const size_t task = (size_t)bh * RW_NC + ck; LAS float* Sb = Sl + (ck & 1) * (64 * R3_P);
            float* dst = SST + task * 4096;
#pragma unroll
            for (int r = 0; r < 16; ++r) { const int i = 32 * ibo + (r & 3) + 8 * (r >> 2) + 4 * hi; dst[i * 64 + 32 * kb + r32] = acc[r]; Sb[i * R3_P + 32 * kb + r32] = acc[r]; }
            if (ck + 1 == RW_NC) break;
            float ph[32];
#pragma unroll
            for (int s = 0; s < 32; ++s) ph[s] = PHI[task * 4096 + (2 * s + hi) * 64 + 32 * kb + r32];
#pragma unroll
            for (int r = 0; r < 16; ++r) { const int i = 32 * ibo + (r & 3) + 8 * (r >> 2) + 4 * hi; acc[r] = PSI[task * 4096 + i * 64 + 32 * kb + r32]; }
            __syncthreads();
#pragma unroll
            for (int s = 0; s < 32; ++s) { const float a = Sb[(32 * ibo + r32) * R3_P + 2 * s + hi]; acc = __builtin_amdgcn_mfma_f32_32x32x2f32(a, ph[s], acc, 0, 0, 0); }
        }
        __syncthreads();
    }
}
__device__ __forceinline__ void phase_rw4(const Ctx& C) {
    const bf16* RWd = (const bf16*)(C.ws + WS_RW); const bf16* RA = (const bf16*)(C.ws + WS_RA); const bf16* RB = (const bf16*)(C.ws + WS_RB); const bf16* RKH = (const bf16*)(C.ws + WS_RKH); const bf16* RV = (const bf16*)(C.ws + WS_RV); const bf16* RR = (const bf16*)(C.ws + WS_RR);
    const float* SST = (const float*)(C.ws + WS_SST); float* Y = (float*)(C.ws + WS_Y);
    LAS float* stg = (LAS float*)C.lds + C.wave * RW_STG;
    const int ntask = NB * 8 * RW_NC, r32 = C.lane & 31, hi = C.lane >> 5;
    for (int task = C.wave * C.G + C.bid; task < ntask; task += C.G * NWAVES) {
        const int ck = task % RW_NC, bh = task / RW_NC, h = bh & 7, b = bh >> 3;
        const size_t base0 = ((size_t)b * T + (size_t)ck * RW_L) * 512 + h * 64;
        f32x16 D[1][2][2]; const float* src = SST + (size_t)task * 4096;
#pragma unroll
        for (int jb = 0; jb < 2; ++jb)
#pragma unroll
            for (int ib = 0; ib < 2; ++ib)
#pragma unroll
                for (int g = 0; g < 4; ++g) { const f32x4 v = *(const f32x4*)(src + (32 * ib + r32) * 64 + 32 * jb + 8 * g + 4 * hi); D[0][jb][ib][4 * g] = v.x; D[0][jb][ib][4 * g + 1] = v.y; D[0][jb][ib][4 * g + 2] = v.z; D[0][jb][ib][4 * g + 3] = v.w; }
        rwkv_chunk<1, true>(D, stg, RWd, RA, RB, RKH, RV, RR, Y, base0, RW_L, C.lane);
    }
}
__device__ __forceinline__ void phase_rw5(const Ctx& C, int layer, const RwP& P) {
    LAS bf16* ACT = (LAS bf16*)C.lds;
    const bf16* CG = (const bf16*)(C.ws + WS_CG); const bf16* LG = (const bf16*)(C.ws + WS_LORA + LO_G);
    const float* Y = (const float*)(C.ws + WS_Y); const bf16* RR = (const bf16*)(C.ws + WS_RR); const bf16* RKH = (const bf16*)(C.ws + WS_RKH); const bf16* RV = (const bf16*)(C.ws + WS_RV);
    bf16* CAT = (bf16*)(C.ws + WS_CAT);
    const float* mu = P.mu + (size_t)layer * 1984 + 1728; const float* r_k = P.r_k + layer * 512; const float* lnx_g = P.lnx_g + layer * 512; const float* lnx_b = P.lnx_b + layer * 512;
    const int tid = C.tid, lane = C.lane, wid = C.wave;
    constexpr int NU = M / 32;
    u32x4 ncur[2], nprv[2];
#define RW5_LOAD(uu) do { _Pragma("unroll") for (int j = 0; j < 2; ++j) { const int ci = tid + 512 * j, tok = ci >> 5, c8 = (ci & 31) * 8; const size_t mm = (size_t)(uu) * 32 + tok; \
        ncur[j] = *(const u32x4*)(CG + mm * 256 + c8); const u32x4 z4 = {0u, 0u, 0u, 0u}; nprv[j] = (mm & (T - 1)) == 0 ? z4 : *(const u32x4*)(CG + (mm - 1) * 256 + c8); } } while (0)
#define RW5_STORE(bufi) do { _Pragma("unroll") for (int j = 0; j < 2; ++j) { const int ci = tid + 512 * j, tok = ci >> 5, c8 = (ci & 31) * 8; \
        const f32x4 m0v = *(const f32x4*)(mu + c8), m1v = *(const f32x4*)(mu + c8 + 4); \
        float xs[8]; _Pragma("unroll") for (int e = 0; e < 4; ++e) { const float c0 = bflo(ncur[j][e]), c1 = bfhi(ncur[j][e]), p0 = bflo(nprv[j][e]), p1 = bfhi(nprv[j][e]); \
            const float ma = e < 2 ? m0v[2 * e] : m1v[2 * e - 4], mb = e < 2 ? m0v[2 * e + 1] : m1v[2 * e - 3]; xs[2 * e] = sigmoidf_(c0 + (p0 - c0) * ma); xs[2 * e + 1] = sigmoidf_(c1 + (p1 - c1) * mb); } \
        u32x4 o; o.x = pk2(xs[0], xs[1]); o.y = pk2(xs[2], xs[3]); o.z = pk2(xs[4], xs[5]); o.w = pk2(xs[6], xs[7]); \
        *(LAS u32x4*)(ACT + (bufi) * (32 * RW_AG) + tok * RW_AG + c8) = o; } } while (0)
    int u = C.bid; if (u >= NU) return;
    RW5_LOAD(u); RW5_STORE(0); __syncthreads();
    for (int kbuf = 0; ; kbuf ^= 1) {
        const int un = u + C.G; const bool has_next = un < NU;
        if (has_next) RW5_LOAD(un);
        {
            int r32 = lane & 31, hi = lane >> 5; asm volatile("" : "+v"(r32), "+v"(hi));
            const size_t m0 = (size_t)u * 32; const LAS bf16* AG = ACT + kbuf * (32 * RW_AG);
            unsigned off[16];
#pragma unroll
            for (int r = 0; r < 16; ++r) off[r] = (unsigned)(tokr(r, hi) * 512 + 64 * wid + r32) * 2u;
            GAS float* Yu = opaque_g(Y + m0 * 512); GAS bf16* RRu = opaque_g(RR + m0 * 512); GAS bf16* RKHu = opaque_g(RKH + m0 * 512); GAS bf16* RVu = opaque_g(RV + m0 * 512); GAS bf16* CATu = opaque_g(CAT + m0 * 2048 + 1536);
            float yv[2][16], sy[16], sq[16], sb[16];
#pragma unroll
            for (int r = 0; r < 16; ++r) { sy[r] = 0.f; sq[r] = 0.f; sb[r] = 0.f; }
#pragma unroll
            for (int cb = 0; cb < 2; ++cb) { const int c = 64 * wid + 32 * cb + r32; const float rkc = r_k[c];
                asm volatile("" : "+v"(off[0]), "+v"(off[1]), "+v"(off[2]), "+v"(off[3]), "+v"(off[4]), "+v"(off[5]), "+v"(off[6]), "+v"(off[7]), "+v"(off[8]), "+v"(off[9]), "+v"(off[10]), "+v"(off[11]), "+v"(off[12]), "+v"(off[13]), "+v"(off[14]), "+v"(off[15]));
#pragma unroll
                for (int r = 0; r < 16; ++r) { const unsigned o = off[r]; const int ci = 32 * cb; const float y = at_b(Yu, 2u * o)[ci]; yv[cb][r] = y; sy[r] += y; sq[r] += y * y; sb[r] += bf2f(at_b(RRu, o)[ci]) * bf2f(at_b(RKHu, o)[ci]) * rkc; } }
#pragma unroll
            for (int r = 0; r < 16; ++r) { const float mean = half_sum32(sy[r]) * (1.0f / 64.0f); const float ex2 = half_sum32(sq[r]) * (1.0f / 64.0f); sb[r] = half_sum32(sb[r]);
                sy[r] = mean; sq[r] = rsqrtf(fmaxf(ex2 - mean * mean, 0.f) + 64e-5f); }
#pragma unroll
            for (int cb = 0; cb < 2; ++cb) { const int c = 64 * wid + 32 * cb + r32;
                f32x16 dg;
#pragma unroll
                for (int r = 0; r < 16; ++r) dg[r] = 0.f;
#pragma unroll
                for (int kk = 0; kk < 16; ++kk) { const bf16x8 wg = *(const bf16x8*)(LG + c * 256 + 16 * kk + 8 * hi); const bf16x8 xg = *(const LAS bf16x8*)(AG + r32 * RW_AG + 16 * kk + 8 * hi);
                    dg = __builtin_amdgcn_mfma_f32_32x32x16_bf16(xg, wg, dg, 0, 0, 0); }
                const float lgc = lnx_g[c], lbc = lnx_b[c];
#pragma unroll
                for (int r = 0; r < 16; ++r) { const unsigned o = off[r]; const int ci = 32 * cb; const float v = bf2f(at_b(RVu, o)[ci]);
                    at_b(CATu, (unsigned)(tokr(r, hi) * 2048 + 64 * wid + r32) * 2u)[ci] = (bf16)f2bf(((yv[cb][r] - sy[r]) * sq[r] * lgc + lbc + sb[r] * v) * dg[r]); }
            }
        }
        if (has_next) RW5_STORE(kbuf ^ 1);
        __syncthreads();
        if (!has_next) break;
        u = un;
    }
#undef RW5_LOAD
#undef RW5_STORE
}
__device__ __forceinline__ void* launder_ptr(const void* p) {
    unsigned lo = (unsigned)(uintptr_t)p, hi = (unsigned)((uintptr_t)p >> 32); asm volatile("" : "+v"(lo), "+v"(hi));
    lo = __builtin_amdgcn_readfirstlane(lo); hi = __builtin_amdgcn_readfirstlane(hi); return (void*)(((uintptr_t)hi << 32) | lo);
}
#ifndef MK_PER_PHASE
#define MK_PER_PHASE 0
#endif
constexpr int PH_PER_LAYER = 17, N_PHASES = DEPTH * PH_PER_LAYER + 1;
struct Args { const float* in[23]; float* out; unsigned char* ws; int ph_lo, ph_hi; };
#define FRESH() do { KA = (const CAS Args*)launder_ptr((const void*)(uintptr_t)__builtin_amdgcn_kernarg_segment_ptr()); C.ws = KA->ws; C.out = KA->out; ctl = (unsigned*)(C.ws + WS_CTL); asm volatile("" : "+v"(C.tid)); C.lane = C.tid & 63; C.wave = __builtin_amdgcn_readfirstlane(C.tid >> 6); C.lds = (LAS unsigned char*)lds_raw; } while (0)
#ifndef REP_MASK
#define REP_MASK 0u
#endif
#ifndef ONLY_PH
#define ONLY_PH -1
#endif
#ifndef PH_MASK
#define PH_MASK 0xFFFFFFFFu
#endif
#define IN(k) (lo <= (k) && (k) < hi && (ONLY_PH < 0 || ((k) % PH_PER_LAYER) == ONLY_PH) && ((PH_MASK >> ((k) % PH_PER_LAYER)) & 1u))
#define SEAM(k) do { if (IN(k) && IN((k) + 1)) { bar.bar = ctl + CW_BAR; xcd_barrier(bar); } } while (0)
template <int layer>
__device__ __forceinline__ void layer_phases(Ctx& C, const CAS Args*& KA, XcdBarrier& bar, unsigned*& ctl, unsigned char* lds_raw, const int lo, const int hi) {
        const int p0 = layer * PH_PER_LAYER;
        const float* xin = layer == 0 ? KA->in[0] : C.out;
        FRESH(); if (IN(p0 + 0)) { { { const WSrc W{KA->in[2], KA->in[3], KA->in[18], KA->in[20], KA->in[21], KA->in[7], KA->in[9], KA->in[12], KA->in[11]}; phase_wconv(C, layer, W); } phase_norm_bf16(C, xin, KA->in[1] + layer * DM, (bf16*)(C.ws + WS_H)); }
            if ((REP_MASK >> 0) & 1u) { xcd_barrier(bar); FRESH(); { { const WSrc W{KA->in[2], KA->in[3], KA->in[18], KA->in[20], KA->in[21], KA->in[7], KA->in[9], KA->in[12], KA->in[11]}; phase_wconv(C, layer, W); } phase_norm_bf16(C, xin, KA->in[1] + layer * DM, (bf16*)(C.ws + WS_H)); } } }
        SEAM(p0 + 0);
        FRESH(); if (IN(p0 + 1)) { { pg8::Gemm g{(const pg8::bf16_t*)(C.ws + WS_H), (const pg8::bf16_t*)(C.ws + WS_WIN), M, N_INP, DM}; pg8::StaticOrder S; S.init(M, N_INP, C.G, C.bid);
            pg8::EpiProj E{C.ws}; pg8::gemm_phase<pg8::EpiProj, pg8::StaticOrder, true, true>(C.lds, g, S, E); }
            if ((REP_MASK >> 1) & 1u) { xcd_barrier(bar); FRESH(); { pg8::Gemm g{(const pg8::bf16_t*)(C.ws + WS_H), (const pg8::bf16_t*)(C.ws + WS_WIN), M, N_INP, DM}; pg8::StaticOrder S; S.init(M, N_INP, C.G, C.bid);
            pg8::EpiProj E{C.ws}; pg8::gemm_phase<pg8::EpiProj, pg8::StaticOrder, true, true>(C.lds, g, S, E); } } }
        SEAM(p0 + 1);
        FRESH(); if (IN(p0 + 2)) { phase_prep_a(C);
            if ((REP_MASK >> 2) & 1u) { xcd_barrier(bar); FRESH(); phase_prep_a(C); } }
        SEAM(p0 + 2);
        FRESH(); if (IN(p0 + 3)) { phase_indexer(C);
            if ((REP_MASK >> 3) & 1u) { xcd_barrier(bar); FRESH(); phase_indexer(C); } }
        SEAM(p0 + 3);
        FRESH(); if (IN(p0 + 4)) { phase_attn(C);
            if ((REP_MASK >> 4) & 1u) { xcd_barrier(bar); FRESH(); phase_attn(C); } }
        SEAM(p0 + 4);
        FRESH(); if (IN(p0 + 5)) { phase_ret1(C);
            if ((REP_MASK >> 5) & 1u) { xcd_barrier(bar); FRESH(); phase_ret1(C); } }
        SEAM(p0 + 5);
        FRESH(); if (IN(p0 + 6)) { phase_ret2(C);
            if ((REP_MASK >> 6) & 1u) { xcd_barrier(bar); FRESH(); phase_ret2(C); } }
        SEAM(p0 + 6);
        FRESH(); if (IN(p0 + 7)) { phase_ret3(C);
            if ((REP_MASK >> 7) & 1u) { xcd_barrier(bar); FRESH(); phase_ret3(C); } }
        SEAM(p0 + 7);
        FRESH(); if (IN(p0 + 8)) { { const RwP P{KA->in[4], KA->in[5], KA->in[6], KA->in[8], KA->in[10], KA->in[13], KA->in[14], KA->in[15], KA->in[16], KA->in[17]}; phase_rw1(C, layer, P); }
            if ((REP_MASK >> 8) & 1u) { xcd_barrier(bar); FRESH(); { const RwP P{KA->in[4], KA->in[5], KA->in[6], KA->in[8], KA->in[10], KA->in[13], KA->in[14], KA->in[15], KA->in[16], KA->in[17]}; phase_rw1(C, layer, P); } } }
        SEAM(p0 + 8);
        FRESH(); if (IN(p0 + 9)) { phase_rw2(C);
            if ((REP_MASK >> 9) & 1u) { xcd_barrier(bar); FRESH(); phase_rw2(C); } }
        SEAM(p0 + 9);
        FRESH(); if (IN(p0 + 10)) { phase_rw3(C);
            if ((REP_MASK >> 10) & 1u) { xcd_barrier(bar); FRESH(); phase_rw3(C); } }
        SEAM(p0 + 10);
        FRESH(); if (IN(p0 + 11)) { phase_rw4(C);
            if ((REP_MASK >> 11) & 1u) { xcd_barrier(bar); FRESH(); phase_rw4(C); } }
        SEAM(p0 + 11);
        FRESH(); if (IN(p0 + 12)) { { const RwP P{KA->in[4], KA->in[5], KA->in[6], KA->in[8], KA->in[10], KA->in[13], KA->in[14], KA->in[15], KA->in[16], KA->in[17]}; phase_rw5(C, layer, P); }
            if ((REP_MASK >> 12) & 1u) { xcd_barrier(bar); FRESH(); { const RwP P{KA->in[4], KA->in[5], KA->in[6], KA->in[8], KA->in[10], KA->in[13], KA->in[14], KA->in[15], KA->in[16], KA->in[17]}; phase_rw5(C, layer, P); } } }
        SEAM(p0 + 12);
        FRESH(); if (IN(p0 + 13)) { { pg8::Gemm g{(const pg8::bf16_t*)(C.ws + WS_CAT), (const pg8::bf16_t*)(C.ws + WS_WOUT), M, DM, DM}; pg8::StaticOrder S; S.init(M, DM, C.G, C.bid);
            pg8::EpiResid E{xin, C.out, DM}; pg8::gemm_phase<pg8::EpiResid, pg8::StaticOrder, true, true>(C.lds, g, S, E); }
            if ((REP_MASK >> 13) & 1u) { xcd_barrier(bar); FRESH(); { pg8::Gemm g{(const pg8::bf16_t*)(C.ws + WS_CAT), (const pg8::bf16_t*)(C.ws + WS_WOUT), M, DM, DM}; pg8::StaticOrder S; S.init(M, DM, C.G, C.bid);
            pg8::EpiResid E{xin, C.out, DM}; pg8::gemm_phase<pg8::EpiResid, pg8::StaticOrder, true, true>(C.lds, g, S, E); } } }
        SEAM(p0 + 13);
        FRESH(); if (IN(p0 + 14)) { phase_norm_bf16(C, C.out, KA->in[19] + layer * DM, (bf16*)(C.ws + WS_H2));
            if ((REP_MASK >> 14) & 1u) { xcd_barrier(bar); FRESH(); phase_norm_bf16(C, C.out, KA->in[19] + layer * DM, (bf16*)(C.ws + WS_H2)); } }
        SEAM(p0 + 14);
        FRESH(); if (IN(p0 + 15)) { { pg8::Gemm g{(const pg8::bf16_t*)(C.ws + WS_H2), (const pg8::bf16_t*)(C.ws + WS_WGU), M, 2 * DFF, DM}; pg8::StaticOrder S; S.init(M, 2 * DFF, C.G, C.bid);
            pg8::EpiSwiGLU E{(pg8::bf16_t*)(C.ws + WS_ACT), DFF}; pg8::gemm_phase<pg8::EpiSwiGLU, pg8::StaticOrder, true, true>(C.lds, g, S, E); }
            if ((REP_MASK >> 15) & 1u) { xcd_barrier(bar); FRESH(); { pg8::Gemm g{(const pg8::bf16_t*)(C.ws + WS_H2), (const pg8::bf16_t*)(C.ws + WS_WGU), M, 2 * DFF, DM}; pg8::StaticOrder S; S.init(M, 2 * DFF, C.G, C.bid);
            pg8::EpiSwiGLU E{(pg8::bf16_t*)(C.ws + WS_ACT), DFF}; pg8::gemm_phase<pg8::EpiSwiGLU, pg8::StaticOrder, true, true>(C.lds, g, S, E); } } }
        SEAM(p0 + 15);
        FRESH(); if (IN(p0 + 16)) { { pg8::Gemm g{(const pg8::bf16_t*)(C.ws + WS_ACT), (const pg8::bf16_t*)(C.ws + WS_WDN), M, DM, DFF}; pg8::StaticOrder S; S.init(M, DM, C.G, C.bid);
            pg8::EpiResid E{C.out, C.out, DM}; pg8::gemm_phase<pg8::EpiResid, pg8::StaticOrder, true, true>(C.lds, g, S, E); }
            if ((REP_MASK >> 16) & 1u) { xcd_barrier(bar); FRESH(); { pg8::Gemm g{(const pg8::bf16_t*)(C.ws + WS_ACT), (const pg8::bf16_t*)(C.ws + WS_WDN), M, DM, DFF}; pg8::StaticOrder S; S.init(M, DM, C.G, C.bid);
            pg8::EpiResid E{C.out, C.out, DM}; pg8::gemm_phase<pg8::EpiResid, pg8::StaticOrder, true, true>(C.lds, g, S, E); } } }
        SEAM(p0 + 16);
    }
__global__ void __launch_bounds__(NTHR, 2) fwd_kernel(Args args) {
    extern __shared__ __attribute__((aligned(16))) unsigned char lds_raw[];
    Ctx C;
    C.lds = (LAS unsigned char*)lds_raw; C.tid = threadIdx.x; C.lane = C.tid & 63; C.wave = __builtin_amdgcn_readfirstlane(C.tid >> 6);
    C.G = gridDim.x; C.bid = blockIdx.x;
    const CAS Args* KA = (const CAS Args*)launder_ptr((const void*)(uintptr_t)__builtin_amdgcn_kernarg_segment_ptr());
    C.ws = KA->ws; C.out = KA->out;
    volatile LAS unsigned* MISC = (volatile LAS unsigned*)(C.lds + MISC_OFF);
    if (C.tid < 32) MISC[C.tid] = 0u;
    __syncthreads();
    unsigned* ctl = (unsigned*)(C.ws + WS_CTL);
    XcdBarrier bar; bar.bar = ctl + CW_BAR; bar.x = 0; bar.st = nullptr;
    if (!MK_PER_PHASE) bar = xcd_barrier_post(ctl + CW_BAR, MISC + 8);
    const int lo = KA->ph_lo, hi = KA->ph_hi;
    layer_phases<0>(C, KA, bar, ctl, lds_raw, lo, hi);
    layer_phases<1>(C, KA, bar, ctl, lds_raw, lo, hi);
    if (IN(N_PHASES - 1)) phase_final_norm(C, C.out, KA->in[22]);
#undef IN
#undef SEAM
}

extern "C" void kernel_launch(void* const* d_in, const int* in_sizes, int n_in, void* d_out, int out_size, void* d_ws, size_t ws_size, hipStream_t stream) {
    static int grid = 0;
    if (grid == 0) {
        if (n_in != 23 || out_size != M * DM || ws_size < WS_NEED) { fprintf(stderr, "kernel_launch: unexpected problem (n_in %d, out %d, ws %zu); nothing launched\n", n_in, out_size, ws_size); grid = -1; return; }
        int dev = 0, cus = 0, per_cu = 0;
        if (hipGetDevice(&dev) != hipSuccess || hipDeviceGetAttribute(&cus, hipDeviceAttributeMultiprocessorCount, dev) != hipSuccess) { grid = -1; return; }
        if (hipFuncSetAttribute((const void*)fwd_kernel, hipFuncAttributeMaxDynamicSharedMemorySize, LDS_BYTES) != hipSuccess) { fprintf(stderr, "kernel_launch: hipFuncSetAttribute failed\n"); grid = -1; return; }
        if (hipOccupancyMaxActiveBlocksPerMultiprocessor(&per_cu, (const void*)fwd_kernel, NTHR, LDS_BYTES) != hipSuccess || per_cu < 1) { fprintf(stderr, "kernel_launch: occupancy query says %d blocks per CU\n", per_cu); }
        (void)hipGetLastError();
        grid = cus;
    }
    if (grid < 0) return;
    (void)hipMemsetAsync((char*)d_ws + WS_CTL, 0, CTL_ZERO_BYTES, stream);
    Args a{};
    for (int i = 0; i < 23; ++i) a.in[i] = (const float*)d_in[i];
    a.out = (float*)d_out; a.ws = (unsigned char*)d_ws;
#if MK_PER_PHASE
    for (int p = 0; p < N_PHASES; ++p) { a.ph_lo = p; a.ph_hi = p + 1; hipLaunchKernelGGL(fwd_kernel, dim3(grid), dim3(NTHR), LDS_BYTES, stream, a); }
#else
    a.ph_lo = 0; a.ph_hi = N_PHASES;
    hipLaunchKernelGGL(fwd_kernel, dim3(grid), dim3(NTHR), LDS_BYTES, stream, a);
#endif
    const hipError_t le = hipPeekAtLastError();
    if (le != hipSuccess) fprintf(stderr, "kernel_launch: launch failed: %s\n", hipGetErrorName(le));
}
```

```cpp
#include <hip/hip_runtime.h>
#include <hip/hip_fp16.h>
#include <cstdio>
#include <cstdint>
namespace pg8 {
#define PG8_LAS __attribute__((address_space(3)))
typedef unsigned short bf16_t;
typedef short bf16x8 __attribute__((ext_vector_type(8)));
typedef float f32x4 __attribute__((ext_vector_type(4)));
typedef unsigned u32x4 __attribute__((ext_vector_type(4)));
constexpr int BM = 256, BK = 64, HALF = 128, HTB = HALF * BK * 2  , STAGE_BYTES = 8 * HTB, NXCD = 8, WGM = 8;

__host__ __device__ __forceinline__ int lds_byte(int r, int c) { const int st = (r >> 4) * 2 + (c >> 5), rr = r & 15, cc = c & 31, ob = rr * 64 + cc * 2; return st * 1024 + (ob ^ (((ob >> 9) & 1) << 5)); }
__host__ __device__ __forceinline__ void stage_rc(int b, int& R, int& C) { const int st = b / 1024, sb = b % 1024, swz = sb ^ (((sb >> 9) & 1) << 5); R = (st >> 1) * 16 + swz / 64; C = (st & 1) * 32 + (swz % 64) / 2; }
__host__ __device__ __forceinline__ int perm32(int rho) { const int n = rho >> 4, i = rho & 15; return 8 * (i >> 2) + 4 * n + (i & 3); }

struct Unit { int pm, pn; };
struct Gemm { const bf16_t* A; const bf16_t* Bt; int M, N, K; };

struct StaticOrder {
    int nM, nN, nwg, G, c;
    __host__ __device__ void init(int M, int N, int G_, int c_) { nM = M / BM; nN = N / BM; nwg = nM * nN; G = G_; c = c_; }
    __host__ __device__ bool next(int i, Unit& u) const {
        const long L = (long)i * G + c; if (L >= nwg) return false;
        int wgid = (int)L; { const int q = nwg / NXCD, r = nwg % NXCD, xcd = wgid % NXCD, off = wgid / NXCD; wgid = (xcd < r ? xcd * (q + 1) : r * (q + 1) + (xcd - r) * q) + off; }
        const int nig = WGM * nN, gid = wgid / nig, fm = gid * WGM, gsz = (nM - fm) < WGM ? (nM - fm) : WGM;
        u.pm = fm + ((wgid % nig) % gsz); u.pn = (wgid % nig) / gsz; return true;
    }
    __device__ __forceinline__ void a_ready(const Unit&) const {}
    __device__ __forceinline__ void done(const Unit&) const {}
};

__device__ __forceinline__ unsigned cvt_pk_bf16(float lo, float hi) { unsigned r; asm volatile("v_cvt_pk_bf16_f32 %0, %1, %2" : "=v"(r) : "v"(lo), "v"(hi)); return r; }
typedef float f32x2 __attribute__((ext_vector_type(2)));
__device__ __forceinline__ f32x2 gelu_pk(f32x2 v) {
    const f32x2 av = __builtin_elementwise_abs(v), d = av * 0.2316418882f + 1.0f;
    f32x2 t; t.x = __builtin_amdgcn_rcpf(d.x); t.y = __builtin_amdgcn_rcpf(d.y);
    f32x2 q = t * 0.5307027145f + (-0.7265760135f); q = q * t + 0.7107068705f; q = q * t + (-0.142248368f); q = q * t + 0.127414796f; q = q * t;
    const f32x2 s = (v * v) * (-0.72134752044f);
    f32x2 e; e.x = __builtin_amdgcn_exp2f(s.x); e.y = __builtin_amdgcn_exp2f(s.y);
    const f32x2 m = v * (q * e), r = v - m;
    f32x2 o; o.x = v.x < 0.f ? m.x : r.x; o.y = v.y < 0.f ? m.y : r.y; return o;
}

template <int ACT  > struct EpiBf16 {
    static constexpr bool PERM = true, AFTER_DRAIN = false; static_assert(ACT == 0 || ACT == 1, "EpiBf16: ACT is 0 (none) or 1 (gelu_pk)");
    bf16_t* O; int ldc; const float* bias; int split_cols; size_t split_stride; float scale0;
    __device__ __forceinline__ void operator()(const f32x4 (&acc)[2][2][4][2], const Unit& u, int wr, int wc, int fr, int fq) const {
        const int row0 = u.pm * BM + wr * 64 + fr; int colt = u.pn * BM; bf16_t* base = O;
        float sc = 1.f; if (split_cols) { const int t = colt / split_cols; base += (size_t)t * split_stride; colt -= t * split_cols; if (t == 0) sc = scale0; }
        const int col0 = colt + wc * 32 + 8 * fq, bcol0 = u.pn * BM + wc * 32 + 8 * fq;
        f32x4 bv[2][2];
#pragma unroll
        for (int bj = 0; bj < 2; ++bj)
#pragma unroll
            for (int n = 0; n < 2; ++n) bv[bj][n] = bias ? *(const f32x4*)(bias + bcol0 + bj * HALF + 4 * n) : (f32x4){0.f, 0.f, 0.f, 0.f};
#pragma unroll
        for (int ai = 0; ai < 2; ++ai)
#pragma unroll
            for (int m = 0; m < 4; ++m) { bf16_t* rowp = base + (size_t)(row0 + ai * HALF + m * 16) * ldc + col0;
#pragma unroll
                for (int bj = 0; bj < 2; ++bj) { f32x4 v0 = acc[ai][bj][m][0] + bv[bj][0], v1 = acc[ai][bj][m][1] + bv[bj][1];
                    if (ACT == 1) { f32x2 a = gelu_pk((f32x2){v0[0], v0[1]}), b = gelu_pk((f32x2){v0[2], v0[3]}), c = gelu_pk((f32x2){v1[0], v1[1]}), d = gelu_pk((f32x2){v1[2], v1[3]});
                        v0 = (f32x4){a.x, a.y, b.x, b.y}; v1 = (f32x4){c.x, c.y, d.x, d.y}; }
                    v0 = v0 * sc; v1 = v1 * sc; u32x4 w; w.x = cvt_pk_bf16(v0[0], v0[1]); w.y = cvt_pk_bf16(v0[2], v0[3]); w.z = cvt_pk_bf16(v1[0], v1[1]); w.w = cvt_pk_bf16(v1[2], v1[3]);
                    *(u32x4*)(rowp + bj * HALF) = w; } }
    }
};

__device__ __forceinline__ void tile_dest(int pn, size_t& off, int& ld, int& colt);
__device__ __forceinline__ float row_rstd(const float* ss, int row) { return rsqrtf(ss[row] * (1.0f / 2048.0f) + 1e-5f); }
struct EpiProj {
    static constexpr bool PERM = true, AFTER_DRAIN = false;
    unsigned char* ws; const float* ss;
    __device__ __forceinline__ void operator()(const f32x4 (&acc)[2][2][4][2], const Unit& u, int wr, int wc, int fr, int fq) const {
        size_t off; int ld, colt; tile_dest(u.pn, off, ld, colt);
        bf16_t* base = (bf16_t*)(ws + off);
        const int row0 = u.pm * BM + wr * 64 + fr, col0 = colt + wc * 32 + 8 * fq;
        const float sc = u.pn < 4 ? 0.12751743074602467f : 1.0f;
#pragma unroll
        for (int ai = 0; ai < 2; ++ai)
#pragma unroll
            for (int m = 0; m < 4; ++m) { const int row = row0 + ai * HALF + m * 16; bf16_t* rowp = base + (size_t)row * ld + col0; const float rs = row_rstd(ss, row) * sc;
#pragma unroll
                for (int bj = 0; bj < 2; ++bj) { const f32x4 v0 = acc[ai][bj][m][0] * rs, v1 = acc[ai][bj][m][1] * rs;
                    u32x4 w; w.x = cvt_pk_bf16(v0[0], v0[1]); w.y = cvt_pk_bf16(v0[2], v0[3]); w.z = cvt_pk_bf16(v1[0], v1[1]); w.w = cvt_pk_bf16(v1[2], v1[3]);
                    *(u32x4*)(rowp + bj * HALF) = w; } }
    }
};
struct EpiResid {
    static constexpr bool PERM = false, AFTER_DRAIN = false;
    const float* base; float* out; int ldc; const float* g; bf16_t* xg; float* ss;
    __device__ __forceinline__ void operator()(const f32x4 (&acc)[2][2][4][2], const Unit& u, int wr, int wc, int fr, int fq) const {
        const int row0 = u.pm * BM + wr * 64 + fr, col0 = u.pn * BM + wc * 32 + 4 * fq;
        f32x4 gv[2][2];
#pragma unroll
        for (int bj = 0; bj < 2; ++bj)
#pragma unroll
            for (int n = 0; n < 2; ++n) gv[bj][n] = *(const f32x4*)(g + col0 + bj * HALF + n * 16);
#pragma unroll
        for (int ai = 0; ai < 2; ++ai)
#pragma unroll
            for (int m = 0; m < 4; ++m) { const int row = row0 + ai * HALF + m * 16; const size_t off = (size_t)row * ldc + col0; float sq = 0.f;
#pragma unroll
                for (int bj = 0; bj < 2; ++bj)
#pragma unroll
                    for (int n = 0; n < 2; ++n) { const size_t p = off + bj * HALF + n * 16; const f32x4 x = *(const f32x4*)(base + p) + acc[ai][bj][m][n]; *(f32x4*)(out + p) = x;
                        sq += (x[0] * x[0] + x[1] * x[1]) + (x[2] * x[2] + x[3] * x[3]);
                        if (xg) { const f32x4 y = x * gv[bj][n]; typedef unsigned u32x2_t __attribute__((ext_vector_type(2))); u32x2_t w; w.x = cvt_pk_bf16(y[0], y[1]); w.y = cvt_pk_bf16(y[2], y[3]); *(u32x2_t*)(xg + p) = w; } }
                sq += __shfl_xor(sq, 16); sq += __shfl_xor(sq, 32);
                if (fq == 0) unsafeAtomicAdd(ss + row, sq); }
    }
};
struct EpiSwiGLU {
    static constexpr bool PERM = true, AFTER_DRAIN = false;
    bf16_t* O; int ldc; const float* ss;
    __device__ __forceinline__ static float silu_mul(float g, float u) { return g * u * __builtin_amdgcn_rcpf(1.0f + __expf(-g)); }
    __device__ __forceinline__ void operator()(const f32x4 (&acc)[2][2][4][2], const Unit& u, int wr, int wc, int fr, int fq) const {
        const int row0 = u.pm * BM + wr * 64 + fr, col0 = u.pn * HALF + wc * 32 + 8 * fq;
#pragma unroll
        for (int ai = 0; ai < 2; ++ai)
#pragma unroll
            for (int m = 0; m < 4; ++m) { const int row = row0 + ai * HALF + m * 16; bf16_t* rowp = O + (size_t)row * ldc + col0; const float rs = row_rstd(ss, row);
                const f32x4 g0 = acc[ai][0][m][0] * rs, g1 = acc[ai][0][m][1] * rs, u0 = acc[ai][1][m][0] * rs, u1 = acc[ai][1][m][1] * rs;
                u32x4 w; w.x = cvt_pk_bf16(silu_mul(g0[0], u0[0]), silu_mul(g0[1], u0[1])); w.y = cvt_pk_bf16(silu_mul(g0[2], u0[2]), silu_mul(g0[3], u0[3]));
                w.z = cvt_pk_bf16(silu_mul(g1[0], u1[0]), silu_mul(g1[1], u1[1])); w.w = cvt_pk_bf16(silu_mul(g1[2], u1[2]), silu_mul(g1[3], u1[3]));
                *(u32x4*)rowp = w; }
    }
};
template <class Epi, class Sched, bool ALIGN_EPI = false, bool SP2 = false>
__device__ __forceinline__ void gemm_phase(PG8_LAS unsigned char* lds, const Gemm g, const Sched& S, const Epi& E) {
    int tid_ = threadIdx.x; asm volatile("" : "+v"(tid_));
    const int tid = tid_, wid = __builtin_amdgcn_readfirstlane(tid >> 6), lane = tid & 63, wr = wid >> 2, wc = wid & 3, fr = lane & 15, fq = lane >> 4;
    const int K = g.K, nt = K / BK;
    unsigned voffA[2], voffB[2];
#pragma unroll
    for (int i = 0; i < 2; ++i) { int R, C; stage_rc(tid * 16 + i * 8192, R, C); const int Rb = Epi::PERM ? ((R & ~31) + perm32(R & 31)) : R;
        voffA[i] = (unsigned)(R * K + C) * 2u; voffB[i] = (unsigned)(Rb * K + C) * 2u; }
    const size_t kstep = (size_t)(BK * 2);
    const size_t hstep = (size_t)HALF * K * 2;
    const size_t tstep = 2 * hstep;
    const unsigned ldsw = (unsigned)wid * 1024u;
    const int aoff = lds_byte(wr * 64 + fr, fq * 8), boff = lds_byte(wc * 32 + fr, fq * 8);
#define PG8_SA(b, h) (((b) * 2 + (h)) * HTB)
#define PG8_SB(b, h) ((4 + (b) * 2 + (h)) * HTB)
#define PG8_STAGE(bufoff, gbase, voff) do { _Pragma("unroll") for (int _i = 0; _i < 2; ++_i) \
        __builtin_amdgcn_global_load_lds((const unsigned*)((const char*)(gbase) + (voff)[_i]), (PG8_LAS unsigned*)(lds + (bufoff) + ldsw + _i * 8192), 16, 0, 0); } while (0)
#define PG8_LDA(dst, b, h) do { _Pragma("unroll") for (int m = 0; m < 4; ++m) _Pragma("unroll") for (int k = 0; k < 2; ++k) dst[m][k] = *(const PG8_LAS bf16x8*)(lds + PG8_SA(b, h) + aoff + m * 2048 + k * 1024); } while (0)
#define PG8_LDB(dst, b, h) do { _Pragma("unroll") for (int n = 0; n < 2; ++n) _Pragma("unroll") for (int k = 0; k < 2; ++k) dst[n][k] = *(const PG8_LAS bf16x8*)(lds + PG8_SB(b, h) + boff + n * 2048 + k * 1024); } while (0)
#define PG8_MMA(ai, bj, At, Bt) do { __builtin_amdgcn_s_setprio(1); _Pragma("unroll") for (int m = 0; m < 4; ++m) _Pragma("unroll") for (int n = 0; n < 2; ++n) _Pragma("unroll") for (int k = 0; k < 2; ++k) \
        acc[ai][bj][m][n] = __builtin_amdgcn_mfma_f32_16x16x32_bf16(Bt[n][k], At[m][k], acc[ai][bj][m][n], 0, 0, 0); __builtin_amdgcn_s_setprio(0); } while (0)
#define PG8_WAIT_V(n) asm volatile("s_waitcnt vmcnt(" #n ")" ::: "memory")
#define PG8_WAIT_L(n) asm volatile("s_waitcnt lgkmcnt(" #n ")" ::: "memory")
#define PG8_BAR __builtin_amdgcn_s_barrier()
#define PG8_SCHED __builtin_amdgcn_sched_barrier(0)
    Unit cur, nxt; int ui = 0;
    if (!S.next(0, cur)) return;
    f32x4 acc[2][2][4][2];
#pragma unroll
    for (int a = 0; a < 2; ++a)
#pragma unroll
        for (int b = 0; b < 2; ++b)
#pragma unroll
            for (int m = 0; m < 4; ++m)
#pragma unroll
                for (int n = 0; n < 2; ++n) acc[a][b][m][n] = (f32x4){0.f, 0.f, 0.f, 0.f};
    bf16x8 At[4][2], B0[2][2], B1[2][2];
    const char* cA = (const char*)g.A + (size_t)cur.pm * tstep; const char* cB = (const char*)g.Bt + (size_t)cur.pn * tstep;
    S.a_ready(cur);
    if constexpr (SP2) {
        PG8_STAGE(PG8_SB(0, 0), cB, voffB); PG8_STAGE(PG8_SB(0, 1), cB + hstep, voffB); PG8_STAGE(PG8_SA(0, 0), cA, voffA); PG8_STAGE(PG8_SA(0, 1), cA + hstep, voffA);
        if (wr == 1) PG8_BAR;
        PG8_WAIT_V(2); PG8_BAR;
        PG8_STAGE(PG8_SB(1, 0), cB + kstep, voffB); PG8_STAGE(PG8_SA(1, 0), cA + kstep, voffA); PG8_STAGE(PG8_SB(1, 1), cB + hstep + kstep, voffB);
        PG8_WAIT_V(6); PG8_BAR;
    } else {
        PG8_STAGE(PG8_SB(0, 0), cB, voffB); PG8_STAGE(PG8_SA(0, 0), cA, voffA); PG8_STAGE(PG8_SB(0, 1), cB + hstep, voffB); PG8_STAGE(PG8_SA(0, 1), cA + hstep, voffA);
        if (wr == 1) PG8_BAR;
        PG8_WAIT_V(4); PG8_BAR;
        PG8_STAGE(PG8_SB(1, 0), cB + kstep, voffB); PG8_STAGE(PG8_SA(1, 0), cA + kstep, voffA); PG8_STAGE(PG8_SB(1, 1), cB + hstep + kstep, voffB);
        PG8_WAIT_V(6); PG8_BAR;
    }
    for (;;) {
        const bool has_next = S.next(ui + 1, nxt);
        const char* nA = has_next ? (const char*)g.A + (size_t)nxt.pm * tstep : cA; const char* nB = has_next ? (const char*)g.Bt + (size_t)nxt.pn * tstep : cB;
        for (int t = 0; t < nt; t += 2) {
            const bool last = (t == nt - 2);
            const char* a1 = cA + (size_t)(t + 1) * kstep;
            const char* a2 = last ? nA : cA + (size_t)(t + 2) * kstep; const char* b2 = last ? nB : cB + (size_t)(t + 2) * kstep;
            const char* a3 = a2 + kstep; const char* b3 = b2 + kstep;
            if (last && has_next) S.a_ready(nxt);
            if constexpr (SP2) {
            PG8_LDB(B0, 0, 0); PG8_LDB(B1, 0, 1); PG8_SCHED; PG8_LDA(At, 0, 0); PG8_STAGE(PG8_SA(1, 1), a1 + hstep, voffA);
            PG8_WAIT_V(8); PG8_WAIT_L(0); PG8_BAR; PG8_MMA(0, 0, At, B0); PG8_MMA(0, 1, At, B1); PG8_BAR; PG8_SCHED;
            PG8_LDA(At, 0, 1); PG8_STAGE(PG8_SB(0, 0), b2, voffB); PG8_STAGE(PG8_SB(0, 1), b2 + hstep, voffB); PG8_STAGE(PG8_SA(0, 0), a2, voffA);
            PG8_WAIT_V(8); PG8_WAIT_L(0); PG8_BAR; PG8_MMA(1, 0, At, B0); PG8_MMA(1, 1, At, B1); PG8_BAR; PG8_SCHED;
            PG8_LDB(B0, 1, 0); PG8_LDB(B1, 1, 1); PG8_SCHED; PG8_LDA(At, 1, 0); PG8_STAGE(PG8_SA(0, 1), a2 + hstep, voffA);
            PG8_WAIT_V(8); PG8_WAIT_L(0); PG8_BAR; PG8_MMA(0, 0, At, B0); PG8_MMA(0, 1, At, B1); PG8_BAR; PG8_SCHED;
            PG8_LDA(At, 1, 1); PG8_STAGE(PG8_SB(1, 0), b3, voffB); PG8_STAGE(PG8_SB(1, 1), b3 + hstep, voffB); PG8_STAGE(PG8_SA(1, 0), a3, voffA);
            PG8_WAIT_V(8); PG8_WAIT_L(0); PG8_BAR; PG8_MMA(1, 0, At, B0); PG8_MMA(1, 1, At, B1); PG8_BAR; PG8_SCHED;
            } else {
            PG8_LDB(B0, 0, 0); PG8_SCHED; PG8_LDA(At, 0, 0); PG8_STAGE(PG8_SA(1, 1), a1 + hstep, voffA);
            PG8_WAIT_L(8); PG8_BAR; PG8_WAIT_L(0); PG8_MMA(0, 0, At, B0); PG8_BAR; PG8_SCHED;
            PG8_LDB(B1, 0, 1); PG8_STAGE(PG8_SB(0, 0), b2, voffB);
            PG8_BAR; PG8_WAIT_L(0); PG8_MMA(0, 1, At, B1); PG8_BAR;
            PG8_LDA(At, 0, 1); PG8_STAGE(PG8_SA(0, 0), a2, voffA);
            PG8_BAR; PG8_WAIT_L(0); PG8_MMA(1, 0, At, B0); PG8_BAR; PG8_SCHED;
            PG8_STAGE(PG8_SB(0, 1), b2 + hstep, voffB);
            PG8_WAIT_V(6); PG8_BAR; PG8_MMA(1, 1, At, B1); PG8_BAR;
            PG8_LDB(B0, 1, 0); PG8_SCHED; PG8_LDA(At, 1, 0); PG8_STAGE(PG8_SA(0, 1), a2 + hstep, voffA);
            PG8_WAIT_L(8); PG8_BAR; PG8_WAIT_L(0); PG8_MMA(0, 0, At, B0); PG8_BAR; PG8_SCHED;
            PG8_LDB(B1, 1, 1); PG8_STAGE(PG8_SB(1, 0), b3, voffB);
            PG8_BAR; PG8_WAIT_L(0); PG8_MMA(0, 1, At, B1); PG8_BAR;
            PG8_LDA(At, 1, 1); PG8_STAGE(PG8_SA(1, 0), a3, voffA);
            PG8_BAR; PG8_WAIT_L(0); PG8_MMA(1, 0, At, B0); PG8_BAR; PG8_SCHED;
            PG8_STAGE(PG8_SB(1, 1), b3 + hstep, voffB);
            PG8_WAIT_V(6); PG8_BAR; PG8_MMA(1, 1, At, B1); PG8_BAR;
            }
        }
        if constexpr (ALIGN_EPI) { if (wr == 0) PG8_BAR; }
        if constexpr (!Epi::AFTER_DRAIN) { E(acc, cur, wr, wc, fr, fq); S.done(cur); }
        if (!has_next) break;
#pragma unroll
        for (int a = 0; a < 2; ++a)
#pragma unroll
            for (int b = 0; b < 2; ++b)
#pragma unroll
                for (int m = 0; m < 4; ++m)
#pragma unroll
                    for (int n = 0; n < 2; ++n) acc[a][b][m][n] = (f32x4){0.f, 0.f, 0.f, 0.f};
        cur = nxt; cA = nA; cB = nB; ++ui;
        if constexpr (ALIGN_EPI) { if (wr == 1) PG8_BAR; }
    }
    PG8_WAIT_V(0);
    if constexpr (!ALIGN_EPI) { if (wr == 0) PG8_BAR; }
    PG8_BAR;
    if constexpr (Epi::AFTER_DRAIN) { E.fused(acc, cur, wr, wc, fr, fq, lds, wid, lane); S.done(cur); }
#undef PG8_SA
#undef PG8_SB
#undef PG8_STAGE
#undef PG8_LDA
#undef PG8_LDB
#undef PG8_MMA
#undef PG8_WAIT_V
#undef PG8_WAIT_L
#undef PG8_BAR
#undef PG8_SCHED
}
}
constexpr int NB = 4, T = 8192, M = NB * T, DM = 2048, DFF = 5632, DEPTH = 2;
constexpr int N_IN = 7696, N_INP = 7936;
constexpr int NWAVES = 8, NTHR = NWAVES * 64;
#define LAS __attribute__((address_space(3)))
#define GAS __attribute__((address_space(1)))
#define CAS __attribute__((address_space(4)))
typedef unsigned short bf16;
typedef short bf16x8 __attribute__((ext_vector_type(8)));
typedef float f32x4 __attribute__((ext_vector_type(4)));
typedef float f32x16 __attribute__((ext_vector_type(16)));
typedef unsigned u32x4 __attribute__((ext_vector_type(4)));
typedef unsigned u32x2 __attribute__((ext_vector_type(2)));
typedef unsigned long long u64;

constexpr size_t MiB = 1u << 20;
constexpr size_t WS_CTL = 0, CTL_ZERO_BYTES = 1 * MiB;
constexpr size_t WS_WIN = 1 * MiB, WS_WOUT = 32 * MiB, WS_WGU = 40 * MiB, WS_WDN = 84 * MiB;
constexpr size_t WS_LORA = 106 * MiB;
constexpr size_t LO_W = 0, LO_A = 512 * 96 * 2, LO_V = 2 * 512 * 96 * 2, LO_G = LO_V + 512 * 64 * 2;
constexpr size_t WS_VFIRST = 107 * MiB;
constexpr size_t WS_H = 139 * MiB;
constexpr size_t WS_VT = 139 * MiB, WS_MASK = 203 * MiB;
constexpr size_t WS_Q = 267 * MiB, WS_K = 331 * MiB, WS_QI = 395 * MiB, WS_V = 459 * MiB, WS_KW = 523 * MiB, WS_BQ = 539 * MiB, WS_BK = 555 * MiB, WS_BV = 571 * MiB, WS_BG = 603 * MiB;
constexpr size_t WS_CR = 635 * MiB, WS_CK = 667 * MiB, WS_CV = 699 * MiB, WS_CL = 731 * MiB, WS_CG = 747 * MiB;
constexpr size_t WS_CAT = 763 * MiB;
constexpr size_t WS_KVST = 891 * MiB;
constexpr size_t WS_TAB = 955 * MiB;
constexpr size_t WS_SS1 = 959 * MiB, WS_SS2 = 959 * MiB + 256 * 1024;
constexpr size_t TAB_A = 0, TAB_I = (size_t)T * 16 * 8, TAB_R = TAB_I + (size_t)T * 8 * 8, TAB_END = TAB_R + (size_t)T * 32 * 8;
constexpr size_t WS_RR = 139 * MiB, WS_RW = 171 * MiB, WS_RKH = 203 * MiB, WS_RV = 235 * MiB, WS_RA = 267 * MiB, WS_RB = 299 * MiB;
constexpr size_t WS_PHI = 523 * MiB, WS_PSI = 555 * MiB, WS_SST = 587 * MiB, WS_Y = 635 * MiB;
constexpr size_t WS_H2 = 139 * MiB, WS_ACT = 267 * MiB;
constexpr size_t WS_NEED = 1024 * MiB;
static_assert(WS_TAB + TAB_END <= WS_NEED && WS_ACT + (size_t)M * DFF * 2 <= WS_CR && WS_SST + 32 * MiB <= WS_CR && WS_Y + (size_t)M * 512 * 4 <= WS_CV, "ws map");

constexpr int LDS_BYTES = 147456, MISC_OFF = 143360;
constexpr int CW_BAR = 4096;

__device__ __forceinline__ unsigned f2bf(float f) { unsigned u = __builtin_bit_cast(unsigned, f); return (u + 0x7fffu + ((u >> 16) & 1u)) >> 16; }
__device__ __forceinline__ unsigned pk2(float lo, float hi) { return f2bf(lo) | (f2bf(hi) << 16); }
__device__ __forceinline__ float bf2f(unsigned short b) { return __builtin_bit_cast(float, (unsigned)b << 16); }
__device__ __forceinline__ float bflo(unsigned w) { return __builtin_bit_cast(float, w << 16); }
__device__ __forceinline__ float bfhi(unsigned w) { return __builtin_bit_cast(float, w & 0xffff0000u); }
__device__ __forceinline__ float wave_sum(float v) {
#pragma unroll
    for (int o = 1; o < 64; o <<= 1) v += __shfl_xor(v, o);
    return v;
}
#define LDS_WAIT() asm volatile("s_waitcnt lgkmcnt(0)" ::: "memory")

namespace pg8 {
__device__ __forceinline__ void tile_dest(int pn, size_t& off, int& ld, int& colt) {
    if (pn < 16) { const int g = pn >> 2; off = g == 0 ? WS_Q : g == 1 ? WS_K : g == 2 ? WS_V : WS_QI; ld = 1024; colt = (pn & 3) * 256; }
    else if (pn == 16) { off = WS_BQ; ld = 256; colt = 0; }
    else if (pn == 17) { off = WS_BK; ld = 256; colt = 0; }
    else if (pn < 20) { off = WS_BV; ld = 512; colt = (pn - 18) * 256; }
    else if (pn < 22) { off = WS_BG; ld = 512; colt = (pn - 20) * 256; }
    else if (pn == 22) { off = WS_KW; ld = 256; colt = 0; }
    else if (pn < 25) { off = WS_CR; ld = 512; colt = (pn - 23) * 256; }
    else if (pn < 27) { off = WS_CK; ld = 512; colt = (pn - 25) * 256; }
    else if (pn < 29) { off = WS_CV; ld = 512; colt = (pn - 27) * 256; }
    else if (pn == 29) { off = WS_CL; ld = 256; colt = 0; }
    else { off = WS_CG; ld = 256; colt = 0; }
}
}
__device__ __forceinline__ int win_src(int n, int layer) {
    if (n < 4096) return n;
    if (n < 4352) return 4176 + (n - 4096);
    if (n < 4608) return 4432 + (n - 4352);
    if (n < 5120) return 4688 + (n - 4608);
    if (n < 5632) return 5200 + (n - 5120);
    if (n < 5888) { const int j = n - 5632; return j < 64 ? 4096 + j : (j < 80 ? 4160 + (j - 64) : -1); }
    if (n < 7424) return 5712 + (n - 5888);
    if (n < 7680) { const int j = n - 7424; return j < 96 ? 7248 + j : (j < 192 ? 7344 + (j - 96) : (layer > 0 ? -2 - (j - 192) : -1)); }
    return 7440 + (n - 7680);
}
#define XB_TMO      128
#define XB_XCNT(j)  (256  + 64 * (j))
#define XB_XSUB(j)  (1280 + 64 * (j))
#define XB_XGEN(j)  (2304 + 64 * (j))
#define XB_TOP      3328
#define XB_TOPGEN   3392
#define XCD_BAR_WORDS 3456
#define XB_SPIN_CAP (1u << 18)

__device__ __forceinline__ unsigned xb_ld(unsigned* p)              { return __hip_atomic_load(p, __ATOMIC_RELAXED, __HIP_MEMORY_SCOPE_AGENT); }
__device__ __forceinline__ unsigned xb_add(unsigned* p, unsigned v) { return __hip_atomic_fetch_add(p, v, __ATOMIC_RELAXED, __HIP_MEMORY_SCOPE_AGENT); }
__device__ __forceinline__ unsigned xb_xcc_id() { return (unsigned)__builtin_amdgcn_s_getreg((3 << 11) | 20) & 0xFu; }
#define XB_SPIN(cond, bar) do { unsigned _sp = 0; while (cond) { __builtin_amdgcn_s_sleep(1); \
    if ((++_sp & 255u) == 0u) { if (xb_ld(&(bar)[XB_TMO])) break; if (_sp > XB_SPIN_CAP) { atomicAdd(&(bar)[XB_TMO], 1u); break; } } } } while (0)

struct XcdBarrier {
    unsigned* bar; unsigned x;
    volatile LAS unsigned* st;
};

__device__ __forceinline__ XcdBarrier xcd_barrier_post(unsigned* bar, volatile LAS unsigned* st) {
    XcdBarrier b; b.bar = bar; b.x = xb_xcc_id(); b.st = st;
    if (threadIdx.x == 0) (void)xb_add(&bar[XB_XCNT(b.x)], 1u);
    return b;
}
__device__ __forceinline__ void xcd_barrier_complete(unsigned* bar, unsigned x, unsigned& nloc, unsigned& nx) {
    const unsigned G = gridDim.x * gridDim.y * gridDim.z;
    unsigned sum, cnt, mine, sp = 0u;
    for (;;) {
        sum = 0u; cnt = 0u; mine = 0u;
#pragma unroll
        for (unsigned j = 0; j < 16; ++j) { const unsigned c = xb_ld(&bar[XB_XCNT(j)]); sum += c; cnt += (c > 0u) ? 1u : 0u; mine = (j == x) ? c : mine; }
        if (sum == G) break;
        __builtin_amdgcn_s_sleep(1);
        if ((++sp & 255u) == 0u) { if (xb_ld(&bar[XB_TMO])) break; if (sp > XB_SPIN_CAP) { atomicAdd(&bar[XB_TMO], 1u); break; } }
    }
    nloc = mine > 0u ? mine : 1u; nx = cnt > 0u ? cnt : 1u;
}

__device__ __forceinline__ void xcd_barrier(const XcdBarrier& b) {
    asm volatile("s_waitcnt vmcnt(0)" ::: "memory");
    __syncthreads();
    if (threadIdx.x == 0) {
        unsigned* bar = b.bar;
        __builtin_amdgcn_s_waitcnt(0);
        unsigned nloc = b.st[0], nx = b.st[1];
        if (nloc == 0u) { xcd_barrier_complete(bar, b.x, nloc, nx); b.st[0] = nloc; b.st[1] = nx; }
        const unsigned old = xb_add(&bar[XB_XSUB(b.x)], 1u);
        const unsigned gen = old / nloc;
        if (old + 1u == (gen + 1u) * nloc) {
            __builtin_amdgcn_fence(__ATOMIC_RELEASE, "agent");
            asm volatile("s_waitcnt vmcnt(0)" ::: "memory");
            const unsigned og = xb_add(&bar[XB_TOP], 1u);
            const unsigned tg = og / nx;
            if (og + 1u == (tg + 1u) * nx) xb_add(&bar[XB_TOPGEN], 1u);
            else XB_SPIN(xb_ld(&bar[XB_TOPGEN]) == tg, bar);
            __builtin_amdgcn_fence(__ATOMIC_ACQUIRE, "agent");
            xb_add(&bar[XB_XGEN(b.x)], 1u);
            asm volatile("s_waitcnt vmcnt(0)" ::: "memory");
        } else {
            XB_SPIN(xb_ld(&bar[XB_XGEN(b.x)]) == gen, bar);
            __builtin_amdgcn_fence(__ATOMIC_ACQUIRE, "agent");
            asm volatile("s_waitcnt vmcnt(0)" ::: "memory");
        }
    }
    __syncthreads();
}

struct Ctx {
    LAS unsigned char* lds; int tid, lane, wave, G, bid; unsigned char* ws; float* out;
};

template <int MAP>
__device__ __forceinline__ void wconv_item(const float* W, int ldw, const float* W2, int K, bf16* WT, LAS float* scr, int item, int nblk, int lane, int layer) {
    const int kb = item / nblk, nb = item % nblk, k0 = 64 * kb, n0 = 32 * nb;
    const int n = n0 + (lane & 31);
    const float* src = nullptr; int ld = ldw;
    if (MAP == 0) src = W + n;
    else if (MAP == 1) { const int s = win_src(n, layer); if (s >= 0) src = W + s; else if (s <= -2) { src = W2 + (-2 - s); ld = 64; } }
    else { const int tl = n >> 8, j = n & 255; src = W + (j < 128 ? tl * 128 + j : DFF + tl * 128 + (j - 128)); }
#pragma unroll 8
    for (int i = 0; i < 32; ++i) { const int kk = 2 * i + (lane >> 5); scr[kk * 33 + (lane & 31)] = src ? src[(size_t)(k0 + kk) * ld] : 0.f; }
    LDS_WAIT(); asm volatile("" ::: "memory");
    const int c = lane & 7;
#pragma unroll
    for (int j = 0; j < 4; ++j) { const int nn = (lane >> 3) + 8 * j; const LAS float* s = scr + (8 * c) * 33 + nn;
        u32x4 o; o.x = pk2(s[0 * 33], s[1 * 33]); o.y = pk2(s[2 * 33], s[3 * 33]); o.z = pk2(s[4 * 33], s[5 * 33]); o.w = pk2(s[6 * 33], s[7 * 33]);
        *(u32x4*)(WT + (size_t)(n0 + nn) * K + k0 + 8 * c) = o; }
    LDS_WAIT(); asm volatile("" ::: "memory");
}
struct WSrc { const float *w_in, *w_vres, *w_out, *w_gu, *w_dn, *wlb, *alb, *glb, *vlb; };
__device__ __forceinline__ void phase_wconv(const Ctx& C, int layer, const WSrc& W) {
    LAS float* scr = (LAS float*)(C.lds + C.wave * 16384);
    const int gw = C.bid * NWAVES + C.wave, NGW = C.G * NWAVES;
    const float* w_in = W.w_in + (size_t)layer * DM * N_IN; const float* w_vres = W.w_vres;
    const float* w_out = W.w_out + (size_t)layer * DM * DM; const float* w_gu = W.w_gu + (size_t)layer * DM * 2 * DFF; const float* w_dn = W.w_dn + (size_t)layer * DFF * DM;
    constexpr int I_IN = (DM / 64) * (N_INP / 32), I_OUT = (DM / 64) * (DM / 32), I_GU = (DM / 64) * (2 * DFF / 32), I_DN = (DFF / 64) * (DM / 32);
    for (int it = gw; it < I_IN + I_OUT + I_GU + I_DN; it += NGW) {
        int r = it;
        if (r < I_IN) { wconv_item<1>(w_in, N_IN, w_vres, DM, (bf16*)(C.ws + WS_WIN), scr, r, N_INP / 32, C.lane, layer); continue; } r -= I_IN;
        if (r < I_OUT) { wconv_item<0>(w_out, DM, nullptr, DM, (bf16*)(C.ws + WS_WOUT), scr, r, DM / 32, C.lane, layer); continue; } r -= I_OUT;
        if (r < I_GU) { wconv_item<2>(w_gu, 2 * DFF, nullptr, DM, (bf16*)(C.ws + WS_WGU), scr, r, 2 * DFF / 32, C.lane, layer); continue; } r -= I_GU;
        wconv_item<0>(w_dn, DM, nullptr, DFF, (bf16*)(C.ws + WS_WDN), scr, r, DM / 32, C.lane, layer);
    }
    const int gt = C.bid * NTHR + C.tid, NGT = C.G * NTHR;
    const float* wlb = W.wlb + (size_t)layer * 96 * 512; const float* alb = W.alb + (size_t)layer * 96 * 512; const float* glb = W.glb + (size_t)layer * 256 * 512;
    const float* vlb = W.vlb;
    bf16* LW = (bf16*)(C.ws + WS_LORA + LO_W); bf16* LA = (bf16*)(C.ws + WS_LORA + LO_A); bf16* LV = (bf16*)(C.ws + WS_LORA + LO_V); bf16* LG = (bf16*)(C.ws + WS_LORA + LO_G);
    for (int i = gt; i < 512 * 96; i += NGT) { const int n = i / 96, k = i % 96; LW[i] = (bf16)f2bf(wlb[k * 512 + n]); LA[i] = (bf16)f2bf(alb[k * 512 + n]); }
    for (int i = gt; i < 512 * 64; i += NGT) { const int n = i / 64, k = i % 64; LV[i] = (bf16)f2bf(layer > 0 ? vlb[k * 512 + n] : 0.f); }
    for (int i = gt; i < 512 * 256; i += NGT) { const int n = i / 256, k = i % 256; LG[i] = (bf16)f2bf(glb[k * 512 + n]); }
    if (layer == 0) {
        float2* TA = (float2*)(C.ws + WS_TAB + TAB_A); float2* TI = (float2*)(C.ws + WS_TAB + TAB_I); float2* TR = (float2*)(C.ws + WS_TAB + TAB_R);
        const float l2a = 18.931568569324174f  , l2r = 13.287712379549449f  ;
        for (int i = gt; i < T * 56; i += NGT) {
            const int pos = i / 56, j = i % 56; float fr; float2* dst;
            if (j < 16) { fr = exp2f(-(float)j * (1.0f / 16.0f) * l2a); dst = TA + pos * 16 + j; }
            else if (j < 24) { fr = exp2f(-(float)(j - 16) * (1.0f / 8.0f) * l2a); dst = TI + pos * 8 + (j - 16); }
            else { fr = exp2f(-(float)(j - 24) * (1.0f / 32.0f) * l2r); dst = TR + pos * 32 + (j - 24); }
            const float ang = (float)pos * fr; *dst = make_float2(cosf(ang), sinf(ang));
        }
    }
}
__device__ __forceinline__ void phase_xg(const Ctx& C, const float* x, const float* g, bf16* out, float* ss) {
    const int gw = C.bid * NWAVES + C.wave, NGW = C.G * NWAVES;
    f32x4 gv[8];
#pragma unroll
    for (int j = 0; j < 8; ++j) gv[j] = *(const f32x4*)(g + 4 * (C.lane + 64 * j));
    for (int m = gw; m < M; m += NGW) {
        const f32x4* xr = (const f32x4*)(x + (size_t)m * DM) + C.lane; f32x4 v[8]; float s = 0.f;
#pragma unroll
        for (int j = 0; j < 8; ++j) { v[j] = xr[64 * j]; s += (v[j].x * v[j].x + v[j].y * v[j].y) + (v[j].z * v[j].z + v[j].w * v[j].w); }
        s = wave_sum(s); if (C.lane == 0) ss[m] = s;
        u32x2* o = (u32x2*)(out + (size_t)m * DM) + C.lane;
#pragma unroll
        for (int j = 0; j < 8; ++j) { u32x2 w; w.x = pk2(v[j].x * gv[j].x, v[j].y * gv[j].y); w.y = pk2(v[j].z * gv[j].z, v[j].w * gv[j].w); o[64 * j] = w; }
    }
}
__device__ __forceinline__ void phase_final_norm(const Ctx& C, float* x, const float* g, const float* ss) {
    const int gw = C.bid * NWAVES + C.wave, NGW = C.G * NWAVES;
    f32x4 gv[8];
#pragma unroll
    for (int j = 0; j < 8; ++j) gv[j] = *(const f32x4*)(g + 4 * (C.lane + 64 * j));
    for (int m = gw; m < M; m += NGW) {
        f32x4* xr = (f32x4*)(x + (size_t)m * DM) + C.lane; const float rs = rsqrtf(ss[m] * (1.0f / DM) + 1e-5f);
#pragma unroll
        for (int j = 0; j < 8; ++j) xr[64 * j] = xr[64 * j] * rs * gv[j];
    }
}
__device__ __forceinline__ void phase_prep_a(const Ctx& C) {
    const long gt = (long)C.bid * NTHR + C.tid, NGT = (long)C.G * NTHR;
    { float* s1 = (float*)(C.ws + WS_SS1); float* s2 = (float*)(C.ws + WS_SS2); for (long i = gt; i < M; i += NGT) { s1[i] = 0.f; s2[i] = 0.f; } }
    for (int cfg = 0; cfg < 6; ++cfg) {
        size_t off; int ld, nh, hd, half; size_t tab;
        if (cfg == 0) { off = WS_Q; ld = 1024; nh = 8; hd = 128; half = 16; tab = TAB_A; }
        else if (cfg == 1) { off = WS_K; ld = 1024; nh = 8; hd = 128; half = 16; tab = TAB_A; }
        else if (cfg == 2) { off = WS_QI; ld = 1024; nh = 16; hd = 64; half = 8; tab = TAB_I; }
        else if (cfg == 3) { off = WS_KW; ld = 256; nh = 1; hd = 64; half = 8; tab = TAB_I; }
        else if (cfg == 4) { off = WS_BQ; ld = 256; nh = 4; hd = 64; half = 32; tab = TAB_R; }
        else { off = WS_BK; ld = 256; nh = 4; hd = 64; half = 32; tab = TAB_R; }
        bf16* buf = (bf16*)(C.ws + off); const float2* tb = (const float2*)(C.ws + WS_TAB + tab);
        const int cpp = half >> 3; const long total = (long)M * nh * cpp;
        for (long it = gt; it < total; it += NGT) {
            const int c = (int)(it % cpp); const long r2 = it / cpp; const int h = (int)(r2 % nh); const int row = (int)(r2 / nh); const int pos = row & (T - 1);
            bf16* p1 = buf + (size_t)row * ld + h * hd + 8 * c; bf16* p2 = p1 + half;
            const u32x4 a = *(const u32x4*)p1, b = *(const u32x4*)p2; const float2* tp = tb + (size_t)pos * half + 8 * c;
            float x1[8], x2[8];
#pragma unroll
            for (int e = 0; e < 4; ++e) { x1[2 * e] = bflo(a[e]); x1[2 * e + 1] = bfhi(a[e]); x2[2 * e] = bflo(b[e]); x2[2 * e + 1] = bfhi(b[e]); }
            u32x4 oa, ob;
#pragma unroll
            for (int e = 0; e < 4; ++e) {
                const float2 t0 = tp[2 * e], t1 = tp[2 * e + 1];
                oa[e] = pk2(x1[2 * e] * t0.x - x2[2 * e] * t0.y, x1[2 * e + 1] * t1.x - x2[2 * e + 1] * t1.y);
                ob[e] = pk2(x2[2 * e] * t0.x + x1[2 * e] * t0.y, x2[2 * e + 1] * t1.x + x1[2 * e + 1] * t1.y);
            }
            *(u32x4*)p1 = oa; *(u32x4*)p2 = ob;
        }
    }
    {
        LAS unsigned short* scr = (LAS unsigned short*)(C.lds + C.wave * 8704);
        const bf16* V = (const bf16*)(C.ws + WS_V); bf16* Vt = (bf16*)(C.ws + WS_VT);
        const int gw = C.bid * NWAVES + C.wave, NGW = C.G * NWAVES;
        for (int it = gw; it < NB * 128 * 16; it += NGW) {
            const int ct = it & 15, tt = (it >> 4) & 127, b = it >> 11;
            const int t0 = tt * 64, c0 = ct * 64;
#pragma unroll 4
            for (int i = 0; i < 32; ++i) { const int tr = 2 * i + (C.lane >> 5), cc = 2 * (C.lane & 31);
                const unsigned w = *(const unsigned*)(V + (size_t)(b * T + t0 + tr) * 1024 + c0 + cc); scr[tr * 66 + cc] = (unsigned short)(w & 0xffffu); scr[tr * 66 + cc + 1] = (unsigned short)(w >> 16); }
            LDS_WAIT(); asm volatile("" ::: "memory");
#pragma unroll 4
            for (int i = 0; i < 32; ++i) { const int cr = 2 * i + (C.lane >> 5), tp = 2 * (C.lane & 31);
                const unsigned w = (unsigned)scr[tp * 66 + cr] | ((unsigned)scr[(tp + 1) * 66 + cr] << 16);
                *(unsigned*)(Vt + ((size_t)b * 1024 + c0 + cr) * T + t0 + tp) = w; }
            LDS_WAIT(); asm volatile("" ::: "memory");
        }
    }
}
#ifndef IDX_REP_T
#define IDX_REP_T 1
#endif
#ifndef IDX_REP_S
#define IDX_REP_S 1
#endif
__device__ __forceinline__ void phase_indexer(const Ctx& C) {
    LAS unsigned short* sc = (LAS unsigned short*)C.lds;
    LAS unsigned* hist = (LAS unsigned*)(C.lds + 131072) + C.wave * 256;
    LAS float* wvl = (LAS float*)(C.lds + 131072 + 8192);
    LAS unsigned short* qbl = (LAS unsigned short*)(C.lds + 131072 + 8192 + 512);
    const bf16* QI = (const bf16*)(C.ws + WS_QI); const bf16* KW = (const bf16*)(C.ws + WS_KW); u64* MASK = (u64*)(C.ws + WS_MASK);
    const int lane = C.lane, r32 = lane & 31, hi = lane >> 5;
    for (int it = C.bid; it < NB * (T / 8); it += C.G) {
        const int b = it & 3, qg = it >> 2, q0 = qg * 8, qchunk = q0 >> 6, nadm = 64 * (qchunk + 1);
        const int qrow = b * T + q0 + C.wave;
        if (qchunk < 4) {
            MASK[(size_t)qrow * 128 + lane] = lane <= qchunk ? ~0ull : 0ull; MASK[(size_t)qrow * 128 + 64 + lane] = 0ull;
            continue;
        }
        bf16x8 af[4][4];
        {
            const int qq = (r32 >> 2) & 1, hh = (r32 & 3) + 4 * (r32 >> 3);
#pragma unroll
            for (int pr = 0; pr < 4; ++pr) {
                const bf16* qp = QI + (size_t)(b * T + q0 + 2 * pr + qq) * 1024 + hh * 64 + 8 * hi;
#pragma unroll
                for (int kk = 0; kk < 4; ++kk) af[pr][kk] = *(const bf16x8*)(qp + 16 * kk);
            }
            if (C.tid < 128) wvl[C.tid] = bf2f(KW[(size_t)(b * T + q0 + (C.tid >> 4)) * 256 + 64 + (C.tid & 15)]) * 0.015625f;
        }
        __syncthreads();
        { const int qx = C.tid >> 6, dx = C.tid & 63; const bf16* qp = QI + (size_t)(b * T + q0 + qx) * 1024 + dx; float acc = 0.f;
#pragma unroll
          for (int h = 0; h < 16; ++h) acc += wvl[qx * 16 + h] * bf2f(qp[h * 64]);
          qbl[qx * 64 + dx] = (unsigned short)f2bf(acc); }
        __syncthreads();
        bf16x8 afl[4];
        { const int qsel = 2 * (r32 & 3) + ((r32 >> 2) & 1);
#pragma unroll
          for (int kk = 0; kk < 4; ++kk) { const u32x4 z = {0u, 0u, 0u, 0u}; afl[kk] = r32 < 8 ? *(const LAS bf16x8*)(qbl + qsel * 64 + 16 * kk + 8 * hi) : __builtin_bit_cast(bf16x8, z); } }
        for (int rep_t = 0; rep_t < IDX_REP_T; ++rep_t) {
            const int ntile = nadm / 32;
            bf16x8 bfr[4], bnx[4];
            { const bf16* kp = KW + (size_t)(b * T + 32 * C.wave + r32) * 256 + 8 * hi;
#pragma unroll
              for (int kk = 0; kk < 4; ++kk) bnx[kk] = *(const bf16x8*)(kp + 16 * kk); }
            for (int tile = C.wave; tile < ntile; tile += NWAVES) {
                const int key0 = 32 * tile;
#pragma unroll
                for (int kk = 0; kk < 4; ++kk) bfr[kk] = bnx[kk];
                if (tile + NWAVES < ntile) { const bf16* kp = KW + (size_t)(b * T + key0 + 32 * NWAVES + r32) * 256 + 8 * hi;
#pragma unroll
                    for (int kk = 0; kk < 4; ++kk) bnx[kk] = *(const bf16x8*)(kp + 16 * kk); }
                const int kpos = (key0 & ~127) + 2 * ((key0 & 63) + r32) + ((key0 >> 6) & 1);
                f32x16 dl = {0.f, 0.f, 0.f, 0.f, 0.f, 0.f, 0.f, 0.f, 0.f, 0.f, 0.f, 0.f, 0.f, 0.f, 0.f, 0.f};
#pragma unroll
                for (int kk = 0; kk < 4; ++kk) dl = __builtin_amdgcn_mfma_f32_32x32x16_bf16(afl[kk], bfr[kk], dl, 0, 0, 0);
#pragma unroll
                for (int pr = 0; pr < 4; ++pr) {
                    f32x16 d = {0.f, 0.f, 0.f, 0.f, 0.f, 0.f, 0.f, 0.f, 0.f, 0.f, 0.f, 0.f, 0.f, 0.f, 0.f, 0.f};
#pragma unroll
                    for (int kk = 0; kk < 4; ++kk) d = __builtin_amdgcn_mfma_f32_32x32x16_bf16(af[pr][kk], bfr[kk], d, 0, 0, 0);
                    float s0 = dl[pr];
#pragma unroll
                    for (int g = 0; g < 4; ++g) { const f32x4 w4 = *(const LAS f32x4*)(wvl + (2 * pr + hi) * 16 + 4 * g);
                        s0 = __builtin_fmaf(__builtin_fabsf(d[4 * g]), w4.x, s0); s0 = __builtin_fmaf(__builtin_fabsf(d[4 * g + 1]), w4.y, s0); s0 = __builtin_fmaf(__builtin_fabsf(d[4 * g + 2]), w4.z, s0); s0 = __builtin_fmaf(__builtin_fabsf(d[4 * g + 3]), w4.w, s0); }
                    const unsigned short hb = __half_as_ushort(__float2half_rn(s0));
                    const unsigned short key = (hb & 0x8000u) ? (unsigned short)~hb : (unsigned short)(hb | 0x8000u);
                    sc[(2 * pr + hi) * 8192 + kpos] = key;
                }
            }
        }
        __syncthreads();
        const LAS unsigned* my = (const LAS unsigned*)(sc + C.wave * 8192);
        const int nit = nadm / 128;
        const bool tail = (nadm & 64) != 0;
        unsigned thr = 0;
        for (int rep_s = 0; rep_s < IDX_REP_S; ++rep_s) {
            unsigned want = 256u, prefix = 0u;
#pragma unroll 1
            for (int lvl = 0; lvl < 2; ++lvl) {
                hist[lane] = 0u; hist[64 + lane] = 0u; hist[128 + lane] = 0u; hist[192 + lane] = 0u;
                LDS_WAIT(); asm volatile("" ::: "memory");
                int i = 0;
                for (; i + 4 <= nit; i += 4) { unsigned kv[4];
#pragma unroll
                    for (int u = 0; u < 4; ++u) kv[u] = my[64 * (i + u) + lane];
#pragma unroll
                    for (int u = 0; u < 4; ++u) { const unsigned k0 = kv[u] & 0xffffu, k1 = kv[u] >> 16;
                        if (lvl == 0) { atomicAdd((unsigned*)&hist[k0 >> 8], 1u); atomicAdd((unsigned*)&hist[k1 >> 8], 1u); }
                        else { if ((k0 >> 8) == prefix) atomicAdd((unsigned*)&hist[k0 & 255u], 1u); if ((k1 >> 8) == prefix) atomicAdd((unsigned*)&hist[k1 & 255u], 1u); } } }
                for (; i < nit + (tail ? 1 : 0); ++i) { const unsigned kvv = my[64 * i + lane]; const unsigned k0 = kvv & 0xffffu, k1 = kvv >> 16; const bool two = i < nit;
                    if (lvl == 0) { atomicAdd((unsigned*)&hist[k0 >> 8], 1u); if (two) atomicAdd((unsigned*)&hist[k1 >> 8], 1u); }
                    else { if ((k0 >> 8) == prefix) atomicAdd((unsigned*)&hist[k0 & 255u], 1u); if (two && (k1 >> 8) == prefix) atomicAdd((unsigned*)&hist[k1 & 255u], 1u); } }
                LDS_WAIT(); asm volatile("" ::: "memory");
                const unsigned c0 = hist[4 * lane], c1 = hist[4 * lane + 1], c2 = hist[4 * lane + 2], c3 = hist[4 * lane + 3];
                const unsigned tl = c0 + c1 + c2 + c3; unsigned inc = tl;
#pragma unroll
                for (int o = 1; o < 64; o <<= 1) { const unsigned v = __shfl_down(inc, o); if (lane + o < 64) inc += v; }
                const unsigned ab3 = inc - tl, ab2 = ab3 + c3, ab1 = ab2 + c2, ab0 = ab1 + c1;
                int selb = -1; unsigned rem = 0;
                if (ab3 < want && ab3 + c3 >= want) { selb = 3; rem = want - ab3; }
                else if (ab2 < want && ab2 + c2 >= want) { selb = 2; rem = want - ab2; }
                else if (ab1 < want && ab1 + c1 >= want) { selb = 1; rem = want - ab1; }
                else if (ab0 < want && ab0 + c0 >= want) { selb = 0; rem = want - ab0; }
                const u64 bal = __ballot(selb >= 0); const int src = bal ? (int)__ffsll((long long)bal) - 1 : 0;
                const unsigned bin = (unsigned)__shfl(4 * lane + (selb < 0 ? 0 : selb), src); want = (unsigned)__shfl((int)rem, src);
                if (lvl == 0) prefix = bin; else thr = (prefix << 8) | bin;
                LDS_WAIT(); asm volatile("" ::: "memory");
            }
        }
        u64 w0 = 0, w1 = 0;
        for (int i = 0; i < nit + (tail ? 1 : 0); ++i) { const unsigned kvv = my[64 * i + lane]; const u64 b0 = __ballot((kvv & 0xffffu) >= thr), b1 = (i < nit) ? __ballot((kvv >> 16) >= thr) : 0ull;
            if (i < 32) { if (lane == 2 * i) w0 = b0; if (lane == 2 * i + 1) w0 = b1; } else { if (lane == 2 * i - 64) w1 = b0; if (lane == 2 * i - 63) w1 = b1; } }
        MASK[(size_t)qrow * 128 + lane] = w0; MASK[(size_t)qrow * 128 + 64 + lane] = w1;
        __syncthreads();
    }
}
constexpr int AT_KROW = 272, AT_VROW = 136, AT_KB = 64 * AT_KROW, AT_VB = 128 * AT_VROW, AT_BUF = AT_KB + AT_VB;
__device__ __forceinline__ void attn_unit(const Ctx& C, int b, int head, int qb) {
    const bf16* Q = (const bf16*)(C.ws + WS_Q); const bf16* K = (const bf16*)(C.ws + WS_K); const bf16* Vt = (const bf16*)(C.ws + WS_VT);
    const u64* MASK = (const u64*)(C.ws + WS_MASK); bf16* CAT = (bf16*)(C.ws + WS_CAT);
    const int tid = C.tid, lane = C.lane, wid = C.wave, r32 = lane & 31, hi = lane >> 5;
    const int q = 256 * qb + 32 * wid + r32; const size_t row = (size_t)b * T + q;
    const int nt = 4 * qb + 4, myc = 4 * qb + (wid >> 1);
    bf16x8 qf[8];
#pragma unroll
    for (int d0 = 0; d0 < 8; ++d0) qf[d0] = *(const bf16x8*)(Q + row * 1024 + head * 128 + 16 * d0 + 8 * hi);
    const bf16* kg[2]; const bf16* vg[2]; int kl[2], vl[2];
#pragma unroll
    for (int i = 0; i < 2; ++i) { const int c = tid + 512 * i;
        kg[i] = K + ((size_t)b * T + (c >> 4)) * 1024 + head * 128 + (c & 15) * 8; kl[i] = (c >> 4) * AT_KROW + (c & 15) * 16;
        vg[i] = Vt + ((size_t)(b * 8 + head) * 128 + (c >> 3)) * T + (c & 7) * 8; vl[i] = AT_KB + (c >> 3) * AT_VROW + (c & 7) * 16; }
    u32x4 kr[2], vr[2];
#pragma unroll
    for (int i = 0; i < 2; ++i) { kr[i] = *(const u32x4*)kg[i]; vr[i] = *(const u32x4*)vg[i]; }
#pragma unroll
    for (int i = 0; i < 2; ++i) { *(LAS u32x4*)(C.lds + kl[i]) = kr[i]; *(LAS u32x2*)(C.lds + vl[i]) = (u32x2){vr[i].x, vr[i].y}; *(LAS u32x2*)(C.lds + vl[i] + 8) = (u32x2){vr[i].z, vr[i].w}; }
    __syncthreads();
    float lrun = 0.f; f32x16 o[4];
#pragma unroll
    for (int db = 0; db < 4; ++db)
#pragma unroll
        for (int r = 0; r < 16; ++r) o[db][r] = 0.f;
    for (int t = 0; t < nt; ++t) {
        const int cur = (t & 1) * AT_BUF, nxt = ((t + 1) & 1) * AT_BUF;
        if (t + 1 < nt) {
#pragma unroll
            for (int i = 0; i < 2; ++i) { kr[i] = *(const u32x4*)(kg[i] + (size_t)(t + 1) * 64 * 1024); vr[i] = *(const u32x4*)(vg[i] + (t + 1) * 64); }
        }
        if (t <= myc) {
            const u64 mw = MASK[row * 128 + t];
            const LAS unsigned char* Ks = C.lds + cur; const LAS unsigned char* Vs = C.lds + cur + AT_KB;
            f32x16 p0, p1;
#pragma unroll
            for (int r = 0; r < 16; ++r) { p0[r] = 0.f; p1[r] = 0.f; }
#pragma unroll
            for (int d0 = 0; d0 < 8; ++d0) {
                const bf16x8 k0 = *(const LAS bf16x8*)(Ks + r32 * AT_KROW + (16 * d0 + 8 * hi) * 2);
                const bf16x8 k1 = *(const LAS bf16x8*)(Ks + (32 + r32) * AT_KROW + (16 * d0 + 8 * hi) * 2);
                p0 = __builtin_amdgcn_mfma_f32_32x32x16_bf16(k0, qf[d0], p0, 0, 0, 0);
                p1 = __builtin_amdgcn_mfma_f32_32x32x16_bf16(k1, qf[d0], p1, 0, 0, 0);
            }
            const int mlo = (int)((unsigned)mw >> (4 * hi)), mhi = (int)((unsigned)(mw >> 32) >> (4 * hi));
            float ls0 = 0.f, ls1 = 0.f;
#pragma unroll
            for (int r = 0; r < 16; ++r) { const int c = (r & 3) + 8 * (r >> 2);
                const unsigned e0 = __float_as_uint(__builtin_amdgcn_exp2f(p0[r])) & (unsigned)__builtin_amdgcn_sbfe(mlo, c, 1);
                const unsigned e1 = __float_as_uint(__builtin_amdgcn_exp2f(p1[r])) & (unsigned)__builtin_amdgcn_sbfe(mhi, c, 1);
                p0[r] = __uint_as_float(e0); p1[r] = __uint_as_float(e1); ls0 += p0[r]; ls1 += p1[r]; }
            lrun += ls0 + ls1;
            bf16x8 pb[4];
#pragma unroll
            for (int kk = 0; kk < 4; ++kk) { u32x4 w;
#pragma unroll
                for (int e = 0; e < 4; ++e) { const int r = 8 * (kk & 1) + 2 * e; w[e] = (kk < 2) ? pg8::cvt_pk_bf16(p0[r], p0[r + 1]) : pg8::cvt_pk_bf16(p1[r], p1[r + 1]); }
                pb[kk] = __builtin_bit_cast(bf16x8, w); }
#pragma unroll
            for (int db = 0; db < 4; ++db)
#pragma unroll
                for (int kk = 0; kk < 4; ++kk) {
                    const LAS unsigned char* vp = Vs + (32 * db + r32) * AT_VROW + (16 * kk + 4 * hi) * 2;
                    const u32x2 a0 = *(const LAS u32x2*)vp, a1 = *(const LAS u32x2*)(vp + 16);
                    const u32x4 w = {a0.x, a0.y, a1.x, a1.y};
                    o[db] = __builtin_amdgcn_mfma_f32_32x32x16_bf16(__builtin_bit_cast(bf16x8, w), pb[kk], o[db], 0, 0, 0);
                }
        }
        if (t + 1 < nt) {
#pragma unroll
            for (int i = 0; i < 2; ++i) { *(LAS u32x4*)(C.lds + nxt + kl[i]) = kr[i]; *(LAS u32x2*)(C.lds + nxt + vl[i]) = (u32x2){vr[i].x, vr[i].y}; *(LAS u32x2*)(C.lds + nxt + vl[i] + 8) = (u32x2){vr[i].z, vr[i].w}; }
        }
        __syncthreads();
    }
    lrun += __shfl_xor(lrun, 32);
    const float inv = 1.0f / lrun;
    bf16* op = CAT + row * 2048 + head * 128 + 4 * hi;
#pragma unroll
    for (int db = 0; db < 4; ++db)
#pragma unroll
        for (int g = 0; g < 4; ++g) { u32x2 w; w.x = pk2(o[db][4 * g] * inv, o[db][4 * g + 1] * inv); w.y = pk2(o[db][4 * g + 2] * inv, o[db][4 * g + 3] * inv);
            *(u32x2*)(op + 32 * db + 8 * g) = w; }
}
__device__ __forceinline__ void phase_attn(const Ctx& C) {
    for (int i = C.bid; i < 1024; i += C.G) {
        const int w = i & 255, k = i >> 8, combo = w >> 3, j = w & 7;
        const int qb = k == 0 ? j : k == 1 ? 15 - j : k == 2 ? 16 + j : 31 - j;
        attn_unit(C, combo >> 3, combo & 7, qb);
        __syncthreads();
    }
}
__device__ __forceinline__ float ret_logg(int h) { return log1pf(-exp2f(-5.0f - (float)h)); }
constexpr int RT_KS = 68;
__device__ __forceinline__ void phase_ret1(const Ctx& C) {
    LAS float* Ks = (LAS float*)C.lds;
    LAS float* Vs = (LAS float*)(C.lds + 64 * RT_KS * 4);
    const bf16* BK = (const bf16*)(C.ws + WS_BK); const bf16* BV = (const bf16*)(C.ws + WS_BV); float* KV = (float*)(C.ws + WS_KVST);
    const int tid = C.tid;
    for (int u = C.bid; u < NB * 128 * 4; u += C.G) {
        const int h = u & 3, c = (u >> 2) & 127, b = u >> 9; const size_t row0 = (size_t)b * T + 64 * c; const float lg = ret_logg(h);
        { const int m = tid >> 3, d8 = (tid & 7) * 8; const u32x4 w = *(const u32x4*)(BK + (row0 + m) * 256 + h * 64 + d8); const float z = __expf((63.0f - (float)m) * lg) * 0.125f;
#pragma unroll
          for (int e = 0; e < 4; ++e) { Ks[m * RT_KS + d8 + 2 * e] = bflo(w[e]) * z; Ks[m * RT_KS + d8 + 2 * e + 1] = bfhi(w[e]) * z; } }
#pragma unroll
        for (int i = 0; i < 2; ++i) { const int cidx = tid + 512 * i, m = cidx >> 4, e8 = (cidx & 15) * 8; const u32x4 w = *(const u32x4*)(BV + (row0 + m) * 512 + h * 128 + e8);
#pragma unroll
          for (int e = 0; e < 4; ++e) { Vs[m * 128 + e8 + 2 * e] = bflo(w[e]); Vs[m * 128 + e8 + 2 * e + 1] = bfhi(w[e]); } }
        __syncthreads();
        const int d = tid & 63, eg = tid >> 6; float acc[16];
#pragma unroll
        for (int e = 0; e < 16; ++e) acc[e] = 0.f;
        for (int m = 0; m < 64; ++m) { const float kv = Ks[m * RT_KS + d];
#pragma unroll
            for (int e4 = 0; e4 < 4; ++e4) { const f32x4 v = *(const LAS f32x4*)(Vs + m * 128 + 16 * eg + 4 * e4); acc[4 * e4] += kv * v.x; acc[4 * e4 + 1] += kv * v.y; acc[4 * e4 + 2] += kv * v.z; acc[4 * e4 + 3] += kv * v.w; } }
        float* dst = KV + (size_t)u * 8192 + d * 128 + 16 * eg;
#pragma unroll
        for (int e4 = 0; e4 < 4; ++e4) *(f32x4*)(dst + 4 * e4) = (f32x4){acc[4 * e4], acc[4 * e4 + 1], acc[4 * e4 + 2], acc[4 * e4 + 3]};
        __syncthreads();
    }
}
__device__ __forceinline__ void phase_ret2(const Ctx& C) {
    float* KV = (float*)(C.ws + WS_KVST);
    for (int g = C.bid * NTHR + C.tid; g < NB * 4 * 8192; g += C.G * NTHR) {
        const int el = g & 8191, h = (g >> 13) & 3, b = g >> 15; const float gc = __expf(64.0f * ret_logg(h));
        float* p = KV + ((size_t)b * 512 + h) * 8192 + el;
        float st = 0.f;
        for (int c0 = 0; c0 < 128; c0 += 8) { float x[8];
#pragma unroll
            for (int i = 0; i < 8; ++i) x[i] = p[(size_t)(c0 + i) * 4 * 8192];
#pragma unroll
            for (int i = 0; i < 8; ++i) { p[(size_t)(c0 + i) * 4 * 8192] = st; st = st * gc + x[i]; } }
    }
}
__device__ __forceinline__ void phase_ret3(const Ctx& C) {
    LAS float* Qs = (LAS float*)C.lds;
    LAS float* Ks = Qs + 64 * RT_KS;
    LAS float* Sc = Ks + 64 * RT_KS;
    LAS float* Vs = Sc + 64 * RT_KS;
    LAS float* Ps = Vs + 64 * 128;
    const bf16* BQ = (const bf16*)(C.ws + WS_BQ); const bf16* BK = (const bf16*)(C.ws + WS_BK); const bf16* BV = (const bf16*)(C.ws + WS_BV); const bf16* BG = (const bf16*)(C.ws + WS_BG);
    const float* KV = (const float*)(C.ws + WS_KVST); bf16* CAT = (bf16*)(C.ws + WS_CAT);
    const int tid = C.tid;
    for (int u = C.bid; u < NB * 128 * 4; u += C.G) {
        const int h = u & 3, c = (u >> 2) & 127, b = u >> 9; const size_t row0 = (size_t)b * T + 64 * c; const float lg = ret_logg(h);
        { const int m = tid >> 3, d8 = (tid & 7) * 8; const u32x4 wq = *(const u32x4*)(BQ + (row0 + m) * 256 + h * 64 + d8), wk = *(const u32x4*)(BK + (row0 + m) * 256 + h * 64 + d8);
#pragma unroll
          for (int e = 0; e < 4; ++e) { Qs[m * RT_KS + d8 + 2 * e] = bflo(wq[e]); Qs[m * RT_KS + d8 + 2 * e + 1] = bfhi(wq[e]); Ks[m * RT_KS + d8 + 2 * e] = bflo(wk[e]) * 0.125f; Ks[m * RT_KS + d8 + 2 * e + 1] = bfhi(wk[e]) * 0.125f; } }
#pragma unroll
        for (int i = 0; i < 2; ++i) { const int cidx = tid + 512 * i, m = cidx >> 4, e8 = (cidx & 15) * 8; const u32x4 w = *(const u32x4*)(BV + (row0 + m) * 512 + h * 128 + e8);
#pragma unroll
          for (int e = 0; e < 4; ++e) { Vs[m * 128 + e8 + 2 * e] = bflo(w[e]); Vs[m * 128 + e8 + 2 * e + 1] = bfhi(w[e]); } }
#pragma unroll
        for (int i = 0; i < 4; ++i) { const int cidx = tid + 512 * i; *(LAS f32x4*)(Ps + 4 * cidx) = *(const f32x4*)(KV + (size_t)u * 8192 + 4 * cidx); }
        __syncthreads();
        {
            const int n = tid >> 3, mg = tid & 7; float s[8];
#pragma unroll
            for (int j = 0; j < 8; ++j) s[j] = 0.f;
            for (int d4 = 0; d4 < 16; ++d4) { const f32x4 qv = *(const LAS f32x4*)(Qs + n * RT_KS + 4 * d4);
#pragma unroll
                for (int j = 0; j < 8; ++j) { const f32x4 kv = *(const LAS f32x4*)(Ks + (mg + 8 * j) * RT_KS + 4 * d4); s[j] += (qv.x * kv.x + qv.y * kv.y) + (qv.z * kv.z + qv.w * kv.w); } }
#pragma unroll
            for (int j = 0; j < 8; ++j) { const int m = mg + 8 * j; Sc[n * RT_KS + m] = (m <= n) ? s[j] * __expf((float)(n - m) * lg) : 0.f; }
        }
        __syncthreads();
        {
            const int n = tid >> 3, eg = tid & 7; float acc[16], cr[16];
#pragma unroll
            for (int e = 0; e < 16; ++e) { acc[e] = 0.f; cr[e] = 0.f; }
            for (int m = 0; m <= n; ++m) { const float sv = Sc[n * RT_KS + m];
#pragma unroll
                for (int e4 = 0; e4 < 4; ++e4) { const f32x4 v = *(const LAS f32x4*)(Vs + m * 128 + 16 * eg + 4 * e4); acc[4 * e4] += sv * v.x; acc[4 * e4 + 1] += sv * v.y; acc[4 * e4 + 2] += sv * v.z; acc[4 * e4 + 3] += sv * v.w; } }
            for (int d = 0; d < 64; ++d) { const float qv = Qs[n * RT_KS + d];
#pragma unroll
                for (int e4 = 0; e4 < 4; ++e4) { const f32x4 v = *(const LAS f32x4*)(Ps + d * 128 + 16 * eg + 4 * e4); cr[4 * e4] += qv * v.x; cr[4 * e4 + 1] += qv * v.y; cr[4 * e4 + 2] += qv * v.z; cr[4 * e4 + 3] += qv * v.w; } }
            const float xi = __expf((float)(n + 1) * lg); float sum = 0.f;
#pragma unroll
            for (int e = 0; e < 16; ++e) { acc[e] += xi * cr[e]; sum += acc[e]; }
            sum += __shfl_xor(sum, 1); sum += __shfl_xor(sum, 2); sum += __shfl_xor(sum, 4);
            const float mu = sum * (1.0f / 128.0f); float var = 0.f;
#pragma unroll
            for (int e = 0; e < 16; ++e) { const float dlt = acc[e] - mu; var += dlt * dlt; }
            var += __shfl_xor(var, 1); var += __shfl_xor(var, 2); var += __shfl_xor(var, 4);
            const float rstd = rsqrtf(var * (1.0f / 128.0f) + 1e-5f);
            const bf16* gp = BG + (row0 + n) * 512 + h * 128 + 16 * eg; const u32x4 g0 = *(const u32x4*)gp, g1 = *(const u32x4*)(gp + 8);
            float gv[16];
#pragma unroll
            for (int e = 0; e < 4; ++e) { gv[2 * e] = bflo(g0[e]); gv[2 * e + 1] = bfhi(g0[e]); gv[8 + 2 * e] = bflo(g1[e]); gv[8 + 2 * e + 1] = bfhi(g1[e]); }
            float ov[16];
#pragma unroll
            for (int e = 0; e < 16; ++e) { const float gg = gv[e]; const float sl = gg * __builtin_amdgcn_rcpf(1.0f + __expf(-gg)); ov[e] = (acc[e] - mu) * rstd * sl; }
            bf16* op = CAT + (row0 + n) * 2048 + 1024 + h * 128 + 16 * eg;
            u32x4 w0, w1;
#pragma unroll
            for (int e = 0; e < 4; ++e) { w0[e] = pk2(ov[2 * e], ov[2 * e + 1]); w1[e] = pk2(ov[8 + 2 * e], ov[8 + 2 * e + 1]); }
            *(u32x4*)op = w0; *(u32x4*)(op + 8) = w1;
        }
        __syncthreads();
    }
}
__device__ __forceinline__ float sigmoidf_(float x) { return __builtin_amdgcn_rcpf(1.0f + __expf(-x)); }
constexpr int RW_AW = 104, RW_AV = 72, RW_AG = 264;
constexpr int RW1_BUF = 32 * RW_AW * 2 + 32 * RW_AV;
struct RwP { const float *mu, *mu_v, *w0, *a0, *v0, *k_k, *k_a, *r_k, *lnx_g, *lnx_b; };
template <class TT> __device__ __forceinline__ GAS TT* opaque_g(const TT* p) {
    unsigned lo = (unsigned)(uintptr_t)p, hi = (unsigned)((uintptr_t)p >> 32); asm volatile("" : "+v"(lo), "+v"(hi));
    lo = __builtin_amdgcn_readfirstlane(lo); hi = __builtin_amdgcn_readfirstlane(hi); return (GAS TT*)(((uintptr_t)hi << 32) | lo);
}
__device__ __forceinline__ int tokr(int r, int hi) { return (r & 3) + 8 * (r >> 2) + 4 * hi; }
template <class TT> __device__ __forceinline__ GAS TT* at_b(GAS TT* ub, unsigned boff) { return (GAS TT*)((GAS char*)ub + boff); }
__device__ __forceinline__ void shifted16(GAS bf16* ub, const unsigned (&off)[16], int cbo, bool first_unit, int hi, float mu, float (&x)[16]) {
    float cur[16], prv[4];
#pragma unroll
    for (int r = 0; r < 16; ++r) cur[r] = bf2f(at_b(ub, off[r])[cbo]);
#pragma unroll
    for (int g = 0; g < 4; ++g) { const bool first = (g == 0) && (hi == 0) && first_unit; prv[g] = first ? 0.f : bf2f(at_b(ub, off[4 * g])[cbo - 512]); }
#pragma unroll
    for (int r = 0; r < 16; ++r) { const float p = (r & 3) == 0 ? prv[r >> 2] : cur[r - 1]; x[r] = cur[r] + (p - cur[r]) * mu; }
}
__device__ __forceinline__ float half_sum32(float v) { v += __shfl_xor(v, 1); v += __shfl_xor(v, 2); v += __shfl_xor(v, 4); v += __shfl_xor(v, 8); v += __shfl_xor(v, 16); return v; }
__device__ __forceinline__ void phase_rw1(const Ctx& C, int layer, const RwP& P) {
    LAS bf16* ACT = (LAS bf16*)C.lds;
    const bf16* CR = (const bf16*)(C.ws + WS_CR); const bf16* CK = (const bf16*)(C.ws + WS_CK); const bf16* CV = (const bf16*)(C.ws + WS_CV); const bf16* CL = (const bf16*)(C.ws + WS_CL);
    const bf16* LW = (const bf16*)(C.ws + WS_LORA + LO_W); const bf16* LA = (const bf16*)(C.ws + WS_LORA + LO_A); const bf16* LV = (const bf16*)(C.ws + WS_LORA + LO_V);
    bf16* VF = (bf16*)(C.ws + WS_VFIRST);
    bf16* RR = (bf16*)(C.ws + WS_RR); bf16* RU = (bf16*)(C.ws + WS_RW); bf16* RKH = (bf16*)(C.ws + WS_RKH); bf16* RV = (bf16*)(C.ws + WS_RV); bf16* RA = (bf16*)(C.ws + WS_RA); bf16* RB = (bf16*)(C.ws + WS_RB);
    const float* mu = P.mu + (size_t)layer * 1984; const float* mu_v = P.mu_v;
    const float* w0 = P.w0 + layer * 512; const float* a0 = P.a0 + layer * 512; const float* v0 = P.v0; const float* k_k = P.k_k + layer * 512; const float* k_a = P.k_a + layer * 512;
    const int tid = C.tid, lane = C.lane, wid = C.wave;
    constexpr int NU = M / 32;
    u32x4 ncur[2], nprv[2];
#define RW1_LOAD(uu) do { _Pragma("unroll") for (int j = 0; j < 2; ++j) { const int ci = tid + 512 * j, tok = ci >> 5, c8 = (ci & 31) * 8; const size_t mm = (size_t)(uu) * 32 + tok; \
        ncur[j] = *(const u32x4*)(CL + mm * 256 + c8); const u32x4 z4 = {0u, 0u, 0u, 0u}; nprv[j] = (mm & (T - 1)) == 0 ? z4 : *(const u32x4*)(CL + (mm - 1) * 256 + c8); } } while (0)
#define RW1_STORE(bufi) do { _Pragma("unroll") for (int j = 0; j < 2; ++j) { const int ci = tid + 512 * j, tok = ci >> 5, c8 = (ci & 31) * 8; \
        const float* mp = c8 < 192 ? mu + 1536 + c8 : mu_v + (c8 - 192); f32x4 m0v = {0.f, 0.f, 0.f, 0.f}, m1v = m0v; if (c8 < 192 || layer > 0) { m0v = *(const f32x4*)mp; m1v = *(const f32x4*)(mp + 4); } \
        float xs[8]; _Pragma("unroll") for (int e = 0; e < 4; ++e) { const float c0 = bflo(ncur[j][e]), c1 = bfhi(ncur[j][e]), p0 = bflo(nprv[j][e]), p1 = bfhi(nprv[j][e]); \
            const float ma = e < 2 ? m0v[2 * e] : m1v[2 * e - 4], mb = e < 2 ? m0v[2 * e + 1] : m1v[2 * e - 3]; xs[2 * e] = c0 + (p0 - c0) * ma; xs[2 * e + 1] = c1 + (p1 - c1) * mb; } \
        if (c8 < 96) { _Pragma("unroll") for (int e = 0; e < 8; ++e) xs[e] = 1.0f - 2.0f * __builtin_amdgcn_rcpf(__expf(2.0f * xs[e]) + 1.0f); }     \
        u32x4 o; o.x = pk2(xs[0], xs[1]); o.y = pk2(xs[2], xs[3]); o.z = pk2(xs[4], xs[5]); o.w = pk2(xs[6], xs[7]); \
        LAS bf16* dst = ACT + (bufi) * RW1_BUF + (c8 < 96 ? tok * RW_AW + c8 : c8 < 192 ? 32 * RW_AW + tok * RW_AW + (c8 - 96) : 64 * RW_AW + tok * RW_AV + (c8 - 192)); \
        *(LAS u32x4*)dst = o; } } while (0)
    int u = C.bid; if (u >= NU) return;
    RW1_LOAD(u); RW1_STORE(0); __syncthreads();
    for (int kbuf = 0; ; kbuf ^= 1) {
        const int un = u + C.G; const bool has_next = un < NU;
        if (has_next) RW1_LOAD(un);
        {
            int r32 = lane & 31, hi = lane >> 5; asm volatile("" : "+v"(r32), "+v"(hi));
            const size_t m0 = (size_t)u * 32; const bool first_unit = (m0 & (T - 1)) == 0;
            const LAS bf16* AW = ACT + kbuf * RW1_BUF; const LAS bf16* AA = AW + 32 * RW_AW; const LAS bf16* AV = AA + 32 * RW_AW;
            unsigned off[16];
#pragma unroll
            for (int r = 0; r < 16; ++r) off[r] = (unsigned)(tokr(r, hi) * 512 + 64 * wid + r32) * 2u;
            GAS bf16* CRu = opaque_g(CR + m0 * 512); GAS bf16* CKu = opaque_g(CK + m0 * 512); GAS bf16* CVu = opaque_g(CV + m0 * 512); GAS bf16* VFu = opaque_g(VF + m0 * 512);
            GAS bf16* RRu = opaque_g(RR + m0 * 512); GAS bf16* RUu = opaque_g(RU + m0 * 512); GAS bf16* RKHu = opaque_g(RKH + m0 * 512); GAS bf16* RVu = opaque_g(RV + m0 * 512); GAS bf16* RAu = opaque_g(RA + m0 * 512); GAS bf16* RBu = opaque_g(RB + m0 * 512);
            float ks[2][16], inv[16];
            {
                float ssr[16];
#pragma unroll
                for (int r = 0; r < 16; ++r) ssr[r] = 0.f;
#pragma unroll
                for (int cb = 0; cb < 2; ++cb) { const int c = 64 * wid + 32 * cb + r32; const float kkc = k_k[c]; shifted16(CKu, off, 32 * cb, first_unit, hi, mu[512 + c], ks[cb]);
#pragma unroll
                    for (int r = 0; r < 16; ++r) { const float kr = ks[cb][r] * kkc; ssr[r] += kr * kr; } }
#pragma unroll
                for (int r = 0; r < 16; ++r) inv[r] = 1.0f / fmaxf(sqrtf(half_sum32(ssr[r])), 1e-12f);
            }
#pragma unroll
            for (int cb = 0; cb < 2; ++cb) {
                const int c = 64 * wid + 32 * cb + r32; const int ci = 32 * cb;
                asm volatile("" : "+v"(off[0]), "+v"(off[1]), "+v"(off[2]), "+v"(off[3]), "+v"(off[4]), "+v"(off[5]), "+v"(off[6]), "+v"(off[7]), "+v"(off[8]), "+v"(off[9]), "+v"(off[10]), "+v"(off[11]), "+v"(off[12]), "+v"(off[13]), "+v"(off[14]), "+v"(off[15]));
                {
                    float rs[16]; shifted16(CRu, off, ci, first_unit, hi, mu[c], rs);
#pragma unroll
                    for (int r = 0; r < 16; ++r) at_b(RRu, off[r])[ci] = (bf16)f2bf(rs[r]);
                }
                asm volatile("" ::: "memory");
                {
                    float vs[16]; shifted16(CVu, off, ci, first_unit, hi, mu[1024 + c], vs);
                    if (layer > 0) {
                        f32x16 dv;
#pragma unroll
                        for (int r = 0; r < 16; ++r) dv[r] = 0.f;
#pragma unroll
                        for (int kk = 0; kk < 4; ++kk) { const bf16x8 wv = *(const bf16x8*)(LV + c * 64 + 16 * kk + 8 * hi); const bf16x8 xv = *(const LAS bf16x8*)(AV + r32 * RW_AV + 16 * kk + 8 * hi);
                            dv = __builtin_amdgcn_mfma_f32_32x32x16_bf16(xv, wv, dv, 0, 0, 0); }
                        const float v0c = v0[c];
#pragma unroll
                        for (int r = 0; r < 16; ++r) { const float vf = bf2f(at_b(VFu, off[r])[ci]); at_b(RVu, off[r])[ci] = (bf16)f2bf(vs[r] + (vf - vs[r]) * sigmoidf_(v0c + dv[r])); }
                    } else {
#pragma unroll
                        for (int r = 0; r < 16; ++r) { const bf16 vb = (bf16)f2bf(vs[r]); at_b(VFu, off[r])[ci] = vb; at_b(RVu, off[r])[ci] = vb; }
                    }
                }
                asm volatile("" ::: "memory");
                {
                    f32x16 dw;
#pragma unroll
                    for (int r = 0; r < 16; ++r) dw[r] = 0.f;
#pragma unroll
                    for (int kk = 0; kk < 6; ++kk) { const bf16x8 ww = *(const bf16x8*)(LW + c * 96 + 16 * kk + 8 * hi); const bf16x8 xw = *(const LAS bf16x8*)(AW + r32 * RW_AW + 16 * kk + 8 * hi);
                        dw = __builtin_amdgcn_mfma_f32_32x32x16_bf16(xw, ww, dw, 0, 0, 0); }
                    const float w0c = w0[c];
#pragma unroll
                    for (int r = 0; r < 16; ++r) { const float z = -(w0c + dw[r]); const float sp = fmaxf(z, 0.f) + __logf(1.0f + __expf(-fabsf(z)));
                        at_b(RUu, off[r])[ci] = (bf16)f2bf(1.0f - __expf(-__expf(-sp - 0.5f))); }
                }
                asm volatile("" ::: "memory");
                {
                    f32x16 da;
#pragma unroll
                    for (int r = 0; r < 16; ++r) da[r] = 0.f;
#pragma unroll
                    for (int kk = 0; kk < 6; ++kk) { const bf16x8 wa = *(const bf16x8*)(LA + c * 96 + 16 * kk + 8 * hi); const bf16x8 xa = *(const LAS bf16x8*)(AA + r32 * RW_AW + 16 * kk + 8 * hi);
                        da = __builtin_amdgcn_mfma_f32_32x32x16_bf16(xa, wa, da, 0, 0, 0); }
                    const float a0c = a0[c], kkc = k_k[c], kac = k_a[c];
#pragma unroll
                    for (int r = 0; r < 16; ++r) { const float a = sigmoidf_(a0c + da[r]); const float ksx = ks[cb][r]; const float kk = ksx * kkc * inv[r];
                        at_b(RKHu, off[r])[ci] = (bf16)f2bf(ksx * (1.0f + (a - 1.0f) * kac)); at_b(RAu, off[r])[ci] = (bf16)f2bf(-kk); at_b(RBu, off[r])[ci] = (bf16)f2bf(kk * a); }
                }
                asm volatile("" ::: "memory");
            }
        }
        if (has_next) RW1_STORE(kbuf ^ 1);
        __syncthreads();
        if (!has_next) break;
        u = un;
    }
#undef RW1_LOAD
#undef RW1_STORE
}
constexpr int RW_L = 128, RW_NC = T / RW_L;
constexpr int RW_TB = 8, RW_STG = 5 * RW_TB * 64 + 64;
typedef float f32x2 __attribute__((ext_vector_type(2)));
__device__ __forceinline__ float xhalf_sum(float x) { const auto rr = __builtin_amdgcn_permlane32_swap(__float_as_uint(x), __float_as_uint(x), false, false); return __uint_as_float(rr[0]) + __uint_as_float(rr[1]); }
__device__ __forceinline__ float dot32(const f32x16& d0, const f32x16& d1, const f32x4 (&v)[2][4]) {
    f32x2 acc = {0.f, 0.f};
#pragma unroll
    for (int g = 0; g < 4; ++g) { acc += (f32x2){d0[4 * g], d0[4 * g + 1]} * (f32x2){v[0][g].x, v[0][g].y}; acc += (f32x2){d0[4 * g + 2], d0[4 * g + 3]} * (f32x2){v[0][g].z, v[0][g].w};
        acc += (f32x2){d1[4 * g], d1[4 * g + 1]} * (f32x2){v[1][g].x, v[1][g].y}; acc += (f32x2){d1[4 * g + 2], d1[4 * g + 3]} * (f32x2){v[1][g].z, v[1][g].w}; }
    return acc.x + acc.y;
}
template <int NS, bool OUT>
__device__ __forceinline__ void rwkv_chunk(f32x16 (&D)[NS][2][2], LAS float* stg, const bf16* RWd, const bf16* RA, const bf16* RB, const bf16* RKH, const bf16* RV, const bf16* RR, float* Y, size_t base0, int nsteps, int lane) {
    const int r32 = lane & 31, hi = lane >> 5;
    unsigned short qw[RW_TB], qa[RW_TB], qr[RW_TB], qb[RW_TB], qk[RW_TB], qv[RW_TB];
#define RWC_LOAD(tt) do { _Pragma("unroll") for (int s = 0; s < RW_TB; ++s) { const size_t o = base0 + (size_t)((tt) + s) * 512 + lane; qw[s] = RWd[o]; qa[s] = RA[o]; if (OUT) qr[s] = RR[o]; qb[s] = RB[o]; qk[s] = RKH[o]; qv[s] = RV[o]; } } while (0)
    RWC_LOAD(0);
    float G = 1.0f;
    for (int t0 = 0; t0 < nsteps; t0 += RW_TB) {
#pragma unroll
        for (int s = 0; s < RW_TB; ++s) { const float w = 1.0f - bf2f(qw[s]); stg[(0 * RW_TB + s) * 64 + lane] = bf2f(qa[s]) * G; G *= w; const float ig = __builtin_amdgcn_rcpf(G);
            if (OUT) stg[(1 * RW_TB + s) * 64 + lane] = bf2f(qr[s]) * G; stg[(2 * RW_TB + s) * 64 + lane] = bf2f(qb[s]) * ig; stg[(3 * RW_TB + s) * 64 + lane] = bf2f(qk[s]) * ig; stg[(4 * RW_TB + s) * 64 + lane] = bf2f(qv[s]); }
        if (t0 + RW_TB < nsteps) RWC_LOAD(t0 + RW_TB);
        LDS_WAIT(); asm volatile("" ::: "memory");
#pragma unroll 1
        for (int s = 0; s < RW_TB; ++s) {
            const LAS float* sa_ = stg + (0 * RW_TB + s) * 64 + 4 * hi; const LAS float* sr = stg + (1 * RW_TB + s) * 64 + 4 * hi;
            const LAS float* sbk = stg + ((hi ? 3 : 2) * RW_TB + s) * 64 + r32; const LAS float* sv = stg + (4 * RW_TB + s) * 64 + r32;
            const float bk0 = sbk[0], bk1 = sbk[32], v0 = sv[0], v1 = sv[32];
            float sav[NS][2];
            {
                f32x4 av[2][4];
#pragma unroll
                for (int jb = 0; jb < 2; ++jb)
#pragma unroll
                    for (int g = 0; g < 4; ++g) av[jb][g] = *(const LAS f32x4*)(sa_ + 32 * jb + 8 * g);
#pragma unroll
                for (int st = 0; st < NS; ++st)
#pragma unroll
                    for (int ib = 0; ib < 2; ++ib) sav[st][ib] = xhalf_sum(dot32(D[st][0][ib], D[st][1][ib], av));
            }
#pragma unroll
            for (int st = 0; st < NS; ++st) {
                const bool inject = (NS == 1) || (st == 1);
#pragma unroll
                for (int jb = 0; jb < 2; ++jb) { const float bkj = jb == 0 ? bk0 : bk1; const float A = inject ? bkj : (hi ? 0.f : bkj);
#pragma unroll
                    for (int ib = 0; ib < 2; ++ib) { const float B = hi ? (ib == 0 ? v0 : v1) : sav[st][ib];
                        D[st][jb][ib] = __builtin_amdgcn_mfma_f32_32x32x2f32(A, B, D[st][jb][ib], 0, 0, 0); } }
            }
            if (OUT) {
                f32x4 rv[2][4];
#pragma unroll
                for (int jb = 0; jb < 2; ++jb)
#pragma unroll
                    for (int g = 0; g < 4; ++g) rv[jb][g] = *(const LAS f32x4*)(sr + 32 * jb + 8 * g);
#pragma unroll
                for (int ib = 0; ib < 2; ++ib) { const float y = xhalf_sum(dot32(D[NS - 1][0][ib], D[NS - 1][1][ib], rv));
                    if (hi == 0) Y[base0 + (size_t)(t0 + s) * 512 + 32 * ib + r32] = y; }
            }
        }
        LDS_WAIT(); asm volatile("" ::: "memory");
    }
#undef RWC_LOAD
    stg[5 * RW_TB * 64 + lane] = G;
    LDS_WAIT(); asm volatile("" ::: "memory");
    {
        f32x4 gv[2][4];
#pragma unroll
        for (int jb = 0; jb < 2; ++jb)
#pragma unroll
            for (int g = 0; g < 4; ++g) gv[jb][g] = *(const LAS f32x4*)(stg + 5 * RW_TB * 64 + 4 * hi + 32 * jb + 8 * g);
#pragma unroll
        for (int st = 0; st < NS; ++st)
#pragma unroll
            for (int jb = 0; jb < 2; ++jb)
#pragma unroll
                for (int ib = 0; ib < 2; ++ib)
#pragma unroll
                    for (int g = 0; g < 4; ++g) { f32x16& d = D[st][jb][ib]; d[4 * g] *= gv[jb][g].x; d[4 * g + 1] *= gv[jb][g].y; d[4 * g + 2] *= gv[jb][g].z; d[4 * g + 3] *= gv[jb][g].w; }
    }
    LDS_WAIT(); asm volatile("" ::: "memory");
}
__device__ __forceinline__ void phase_rw2(const Ctx& C) {
    const bf16* RWd = (const bf16*)(C.ws + WS_RW); const bf16* RA = (const bf16*)(C.ws + WS_RA); const bf16* RB = (const bf16*)(C.ws + WS_RB); const bf16* RKH = (const bf16*)(C.ws + WS_RKH); const bf16* RV = (const bf16*)(C.ws + WS_RV);
    float* PHI = (float*)(C.ws + WS_PHI); float* PSI = (float*)(C.ws + WS_PSI);
    LAS float* stg = (LAS float*)C.lds + C.wave * RW_STG;
    const int ntask = NB * 8 * RW_NC, r32 = C.lane & 31, hi = C.lane >> 5;
    for (int task = C.wave * C.G + C.bid; task < ntask; task += C.G * NWAVES) {
        const int ck = task % RW_NC, bh = task / RW_NC, h = bh & 7, b = bh >> 3;
        const size_t base0 = ((size_t)b * T + (size_t)ck * RW_L) * 512 + h * 64;
        f32x16 D[2][2][2];
#pragma unroll
        for (int jb = 0; jb < 2; ++jb)
#pragma unroll
            for (int ib = 0; ib < 2; ++ib)
#pragma unroll
                for (int r = 0; r < 16; ++r) { D[0][jb][ib][r] = (jb == ib && ((r & 3) + 8 * (r >> 2) + 4 * hi) == r32) ? 1.f : 0.f; D[1][jb][ib][r] = 0.f; }
        rwkv_chunk<2, false>(D, stg, RWd, RA, RB, RKH, RV, nullptr, nullptr, base0, RW_L, C.lane);
#pragma unroll
        for (int st = 0; st < 2; ++st) { float* dst = (st == 0 ? PHI : PSI) + (size_t)task * 4096;
#pragma unroll
            for (int jb = 0; jb < 2; ++jb)
#pragma unroll
                for (int ib = 0; ib < 2; ++ib)
#pragma unroll
                    for (int g = 0; g < 4; ++g) *(f32x4*)(dst + (32 * ib + r32) * 64 + 32 * jb + 8 * g + 4 * hi) = (f32x4){D[st][jb][ib][4 * g], D[st][jb][ib][4 * g + 1], D[st][jb][ib][4 * g + 2], D[st][jb][ib][4 * g + 3]}; }
    }
}
constexpr int R3_P = 65;
__device__ __forceinline__ void phase_rw3(const Ctx& C) {
    const float* PHI = (const float*)(C.ws + WS_PHI); const float* PSI = (const float*)(C.ws + WS_PSI); float* SST = (float*)(C.ws + WS_SST);
    const int half = C.wave >> 2, w4 = C.wave & 3, ibo = w4 >> 1, kb = w4 & 1, r32 = C.lane & 31, hi = C.lane >> 5;
    LAS float* Sl = (LAS float*)C.lds + half * (2 * 64 * R3_P);
    for (int pr = C.bid; pr < NB * 8 / 2; pr += C.G) {
        const int bh = 2 * pr + half;
        f32x16 acc;
#pragma unroll
        for (int r = 0; r < 16; ++r) acc[r] = 0.f;
        float ph[32], psn[16];
#define R3_LOAD(tk) do { _Pragma("unroll") for (int s = 0; s < 32; ++s) ph[s] = PHI[(tk) * 4096 + (2 * s + hi) * 64 + 32 * kb + r32]; \
        _Pragma("unroll") for (int r = 0; r < 16; ++r) psn[r] = PSI[(tk) * 4096 + (32 * ibo + (r & 3) + 8 * (r >> 2) + 4 * hi) * 64 + 32 * kb + r32]; } while (0)
        R3_LOAD((size_t)bh * RW_NC);
        for (int ck = 0; ck < RW_NC; ++ck) {
            const size_t task = (size_t)bh * RW_NC + ck; LAS float* Sb = Sl + (ck & 1) * (64 * R3_P);
            float* dst = SST + task * 4096;
#pragma unroll
            for (int r = 0; r < 16; ++r) { const int i = 32 * ibo + (r & 3) + 8 * (r >> 2) + 4 * hi; dst[i * 64 + 32 * kb + r32] = acc[r]; Sb[i * R3_P + 32 * kb + r32] = acc[r]; }
            if (ck + 1 == RW_NC) break;
            float pc[32];
#pragma unroll
            for (int s = 0; s < 32; ++s) pc[s] = ph[s];
#pragma unroll
            for (int r = 0; r < 16; ++r) acc[r] = psn[r];
            if (ck + 2 < RW_NC) R3_LOAD(task + 1);
            __syncthreads();
#pragma unroll
            for (int s = 0; s < 32; ++s) { const float a = Sb[(32 * ibo + r32) * R3_P + 2 * s + hi]; acc = __builtin_amdgcn_mfma_f32_32x32x2f32(a, pc[s], acc, 0, 0, 0); }
        }
#undef R3_LOAD
        __syncthreads();
    }
}
__device__ __forceinline__ void phase_rw4(const Ctx& C) {
    const bf16* RWd = (const bf16*)(C.ws + WS_RW); const bf16* RA = (const bf16*)(C.ws + WS_RA); const bf16* RB = (const bf16*)(C.ws + WS_RB); const bf16* RKH = (const bf16*)(C.ws + WS_RKH); const bf16* RV = (const bf16*)(C.ws + WS_RV); const bf16* RR = (const bf16*)(C.ws + WS_RR);
    const float* SST = (const float*)(C.ws + WS_SST); float* Y = (float*)(C.ws + WS_Y);
    LAS float* stg = (LAS float*)C.lds + C.wave * RW_STG;
    const int ntask = NB * 8 * RW_NC, r32 = C.lane & 31, hi = C.lane >> 5;
    for (int task = C.wave * C.G + C.bid; task < ntask; task += C.G * NWAVES) {
        const int ck = task % RW_NC, bh = task / RW_NC, h = bh & 7, b = bh >> 3;
        const size_t base0 = ((size_t)b * T + (size_t)ck * RW_L) * 512 + h * 64;
        f32x16 D[1][2][2]; const float* src = SST + (size_t)task * 4096;
#pragma unroll
        for (int jb = 0; jb < 2; ++jb)
#pragma unroll
            for (int ib = 0; ib < 2; ++ib)
#pragma unroll
                for (int g = 0; g < 4; ++g) { const f32x4 v = *(const f32x4*)(src + (32 * ib + r32) * 64 + 32 * jb + 8 * g + 4 * hi); D[0][jb][ib][4 * g] = v.x; D[0][jb][ib][4 * g + 1] = v.y; D[0][jb][ib][4 * g + 2] = v.z; D[0][jb][ib][4 * g + 3] = v.w; }
        rwkv_chunk<1, true>(D, stg, RWd, RA, RB, RKH, RV, RR, Y, base0, RW_L, C.lane);
    }
}
__device__ __forceinline__ void phase_rw5(const Ctx& C, int layer, const RwP& P) {
    LAS bf16* ACT = (LAS bf16*)C.lds;
    const bf16* CG = (const bf16*)(C.ws + WS_CG); const bf16* LG = (const bf16*)(C.ws + WS_LORA + LO_G);
    const float* Y = (const float*)(C.ws + WS_Y); const bf16* RR = (const bf16*)(C.ws + WS_RR); const bf16* RKH = (const bf16*)(C.ws + WS_RKH); const bf16* RV = (const bf16*)(C.ws + WS_RV);
    bf16* CAT = (bf16*)(C.ws + WS_CAT);
    const float* mu = P.mu + (size_t)layer * 1984 + 1728; const float* r_k = P.r_k + layer * 512; const float* lnx_g = P.lnx_g + layer * 512; const float* lnx_b = P.lnx_b + layer * 512;
    const int tid = C.tid, lane = C.lane, wid = C.wave;
    constexpr int NU = M / 32;
    u32x4 ncur[2], nprv[2];
#define RW5_LOAD(uu) do { _Pragma("unroll") for (int j = 0; j < 2; ++j) { const int ci = tid + 512 * j, tok = ci >> 5, c8 = (ci & 31) * 8; const size_t mm = (size_t)(uu) * 32 + tok; \
        ncur[j] = *(const u32x4*)(CG + mm * 256 + c8); const u32x4 z4 = {0u, 0u, 0u, 0u}; nprv[j] = (mm & (T - 1)) == 0 ? z4 : *(const u32x4*)(CG + (mm - 1) * 256 + c8); } } while (0)
#define RW5_STORE(bufi) do { _Pragma("unroll") for (int j = 0; j < 2; ++j) { const int ci = tid + 512 * j, tok = ci >> 5, c8 = (ci & 31) * 8; \
        const f32x4 m0v = *(const f32x4*)(mu + c8), m1v = *(const f32x4*)(mu + c8 + 4); \
        float xs[8]; _Pragma("unroll") for (int e = 0; e < 4; ++e) { const float c0 = bflo(ncur[j][e]), c1 = bfhi(ncur[j][e]), p0 = bflo(nprv[j][e]), p1 = bfhi(nprv[j][e]); \
            const float ma = e < 2 ? m0v[2 * e] : m1v[2 * e - 4], mb = e < 2 ? m0v[2 * e + 1] : m1v[2 * e - 3]; xs[2 * e] = sigmoidf_(c0 + (p0 - c0) * ma); xs[2 * e + 1] = sigmoidf_(c1 + (p1 - c1) * mb); } \
        u32x4 o; o.x = pk2(xs[0], xs[1]); o.y = pk2(xs[2], xs[3]); o.z = pk2(xs[4], xs[5]); o.w = pk2(xs[6], xs[7]); \
        *(LAS u32x4*)(ACT + (bufi) * (32 * RW_AG) + tok * RW_AG + c8) = o; } } while (0)
    int u = C.bid; if (u >= NU) return;
    RW5_LOAD(u); RW5_STORE(0); __syncthreads();
    for (int kbuf = 0; ; kbuf ^= 1) {
        const int un = u + C.G; const bool has_next = un < NU;
        if (has_next) RW5_LOAD(un);
        {
            int r32 = lane & 31, hi = lane >> 5; asm volatile("" : "+v"(r32), "+v"(hi));
            const size_t m0 = (size_t)u * 32; const LAS bf16* AG = ACT + kbuf * (32 * RW_AG);
            unsigned off[16];
#pragma unroll
            for (int r = 0; r < 16; ++r) off[r] = (unsigned)(tokr(r, hi) * 512 + 64 * wid + r32) * 2u;
            GAS float* Yu = opaque_g(Y + m0 * 512); GAS bf16* RRu = opaque_g(RR + m0 * 512); GAS bf16* RKHu = opaque_g(RKH + m0 * 512); GAS bf16* RVu = opaque_g(RV + m0 * 512); GAS bf16* CATu = opaque_g(CAT + m0 * 2048 + 1536);
            float yv[2][16], sy[16], sq[16], sb[16];
#pragma unroll
            for (int r = 0; r < 16; ++r) { sy[r] = 0.f; sq[r] = 0.f; sb[r] = 0.f; }
#pragma unroll
            for (int cb = 0; cb < 2; ++cb) { const int c = 64 * wid + 32 * cb + r32; const float rkc = r_k[c];
                asm volatile("" : "+v"(off[0]), "+v"(off[1]), "+v"(off[2]), "+v"(off[3]), "+v"(off[4]), "+v"(off[5]), "+v"(off[6]), "+v"(off[7]), "+v"(off[8]), "+v"(off[9]), "+v"(off[10]), "+v"(off[11]), "+v"(off[12]), "+v"(off[13]), "+v"(off[14]), "+v"(off[15]));
#pragma unroll
                for (int r = 0; r < 16; ++r) { const unsigned o = off[r]; const int ci = 32 * cb; const float y = at_b(Yu, 2u * o)[ci]; yv[cb][r] = y; sy[r] += y; sq[r] += y * y; sb[r] += bf2f(at_b(RRu, o)[ci]) * bf2f(at_b(RKHu, o)[ci]) * rkc; } }
#pragma unroll
            for (int r = 0; r < 16; ++r) { const float mean = half_sum32(sy[r]) * (1.0f / 64.0f); const float ex2 = half_sum32(sq[r]) * (1.0f / 64.0f); sb[r] = half_sum32(sb[r]);
                sy[r] = mean; sq[r] = rsqrtf(fmaxf(ex2 - mean * mean, 0.f) + 64e-5f); }
#pragma unroll
            for (int cb = 0; cb < 2; ++cb) { const int c = 64 * wid + 32 * cb + r32;
                f32x16 dg;
#pragma unroll
                for (int r = 0; r < 16; ++r) dg[r] = 0.f;
#pragma unroll
                for (int kk = 0; kk < 16; ++kk) { const bf16x8 wg = *(const bf16x8*)(LG + c * 256 + 16 * kk + 8 * hi); const bf16x8 xg = *(const LAS bf16x8*)(AG + r32 * RW_AG + 16 * kk + 8 * hi);
                    dg = __builtin_amdgcn_mfma_f32_32x32x16_bf16(xg, wg, dg, 0, 0, 0); }
                const float lgc = lnx_g[c], lbc = lnx_b[c];
#pragma unroll
                for (int r = 0; r < 16; ++r) { const unsigned o = off[r]; const int ci = 32 * cb; const float v = bf2f(at_b(RVu, o)[ci]);
                    at_b(CATu, (unsigned)(tokr(r, hi) * 2048 + 64 * wid + r32) * 2u)[ci] = (bf16)f2bf(((yv[cb][r] - sy[r]) * sq[r] * lgc + lbc + sb[r] * v) * dg[r]); }
            }
        }
        if (has_next) RW5_STORE(kbuf ^ 1);
        __syncthreads();
        if (!has_next) break;
        u = un;
    }
#undef RW5_LOAD
#undef RW5_STORE
}
__device__ __forceinline__ void* launder_ptr(const void* p) {
    unsigned lo = (unsigned)(uintptr_t)p, hi = (unsigned)((uintptr_t)p >> 32); asm volatile("" : "+v"(lo), "+v"(hi));
    lo = __builtin_amdgcn_readfirstlane(lo); hi = __builtin_amdgcn_readfirstlane(hi); return (void*)(((uintptr_t)hi << 32) | lo);
}
#ifndef MK_PER_PHASE
#define MK_PER_PHASE 0
#endif
constexpr int PH_PER_LAYER = 13, N_PHASES = DEPTH * PH_PER_LAYER + 1;
struct Args { const float* in[23]; float* out; unsigned char* ws; int ph_lo, ph_hi; };
#define FRESH() do { KA = (const CAS Args*)launder_ptr((const void*)(uintptr_t)__builtin_amdgcn_kernarg_segment_ptr()); C.ws = KA->ws; C.out = KA->out; ctl = (unsigned*)(C.ws + WS_CTL); asm volatile("" : "+v"(C.tid)); C.lane = C.tid & 63; C.wave = __builtin_amdgcn_readfirstlane(C.tid >> 6); C.lds = (LAS unsigned char*)lds_raw; } while (0)
#ifndef REP_MASK
#define REP_MASK 0u
#endif
#ifndef ONLY_PH
#define ONLY_PH -1
#endif
#ifndef PH_MASK
#define PH_MASK 0xFFFFFFFFu
#endif
#define IN(k) (lo <= (k) && (k) < hi && (ONLY_PH < 0 || ((k) % PH_PER_LAYER) == ONLY_PH) && ((PH_MASK >> ((k) % PH_PER_LAYER)) & 1u))
#define SEAM(k) do { if (IN(k) && IN((k) + 1)) { bar.bar = ctl + CW_BAR; xcd_barrier(bar); } } while (0)
#define PH_BODY(k, ...) do { FRESH(); if (IN(p0 + (k))) { __VA_ARGS__; if ((REP_MASK >> (k)) & 1u) { xcd_barrier(bar); FRESH(); __VA_ARGS__; } } SEAM(p0 + (k)); } while (0)
template <int layer>
__device__ __forceinline__ void layer_phases(Ctx& C, const CAS Args*& KA, XcdBarrier& bar, unsigned*& ctl, unsigned char* lds_raw, const int lo, const int hi) {
    const int p0 = layer * PH_PER_LAYER;
    PH_BODY(0, { const WSrc W{KA->in[2], KA->in[3], KA->in[18], KA->in[20], KA->in[21], KA->in[7], KA->in[9], KA->in[12], KA->in[11]}; phase_wconv(C, layer, W);
                 if (layer == 0) phase_xg(C, KA->in[0], KA->in[1], (bf16*)(C.ws + WS_H), (float*)(C.ws + WS_SS1)); });
    PH_BODY(1, { pg8::Gemm g{(const pg8::bf16_t*)(C.ws + WS_H), (const pg8::bf16_t*)(C.ws + WS_WIN), M, N_INP, DM}; pg8::StaticOrder S; S.init(M, N_INP, C.G, C.bid);
                 pg8::EpiProj E{C.ws, (const float*)(C.ws + WS_SS1)}; pg8::gemm_phase<pg8::EpiProj, pg8::StaticOrder, true, true>(C.lds, g, S, E); });
    FRESH(); if (IN(p0 + 2)) phase_prep_a(C); SEAM(p0 + 2);
    PH_BODY(3, { phase_indexer(C); __syncthreads(); phase_ret1(C); });
    FRESH(); if (IN(p0 + 4)) { phase_attn(C); __syncthreads(); phase_ret2(C); } SEAM(p0 + 4);
    PH_BODY(5, { phase_ret3(C); __syncthreads(); const RwP P{KA->in[4], KA->in[5], KA->in[6], KA->in[8], KA->in[10], KA->in[13], KA->in[14], KA->in[15], KA->in[16], KA->in[17]}; phase_rw1(C, layer, P); });
    PH_BODY(6, { phase_rw2(C); });
    PH_BODY(7, { phase_rw3(C); });
    PH_BODY(8, { phase_rw4(C); });
    PH_BODY(9, { const RwP P{KA->in[4], KA->in[5], KA->in[6], KA->in[8], KA->in[10], KA->in[13], KA->in[14], KA->in[15], KA->in[16], KA->in[17]}; phase_rw5(C, layer, P); });
    FRESH(); if (IN(p0 + 10)) { const float* xin = layer == 0 ? KA->in[0] : C.out;
        pg8::Gemm g{(const pg8::bf16_t*)(C.ws + WS_CAT), (const pg8::bf16_t*)(C.ws + WS_WOUT), M, DM, DM}; pg8::StaticOrder S; S.init(M, DM, C.G, C.bid);
        pg8::EpiResid E{xin, C.out, DM, KA->in[19] + layer * DM, (pg8::bf16_t*)(C.ws + WS_H2), (float*)(C.ws + WS_SS2)}; pg8::gemm_phase<pg8::EpiResid, pg8::StaticOrder, true, true>(C.lds, g, S, E); }
    SEAM(p0 + 10);
    PH_BODY(11, { pg8::Gemm g{(const pg8::bf16_t*)(C.ws + WS_H2), (const pg8::bf16_t*)(C.ws + WS_WGU), M, 2 * DFF, DM}; pg8::StaticOrder S; S.init(M, 2 * DFF, C.G, C.bid);
                  pg8::EpiSwiGLU E{(pg8::bf16_t*)(C.ws + WS_ACT), DFF, (const float*)(C.ws + WS_SS2)}; pg8::gemm_phase<pg8::EpiSwiGLU, pg8::StaticOrder, true, true>(C.lds, g, S, E); });
    FRESH(); if (IN(p0 + 12)) { pg8::Gemm g{(const pg8::bf16_t*)(C.ws + WS_ACT), (const pg8::bf16_t*)(C.ws + WS_WDN), M, DM, DFF}; pg8::StaticOrder S; S.init(M, DM, C.G, C.bid);
        pg8::EpiResid E{C.out, C.out, DM, layer + 1 < DEPTH ? KA->in[1] + (layer + 1) * DM : KA->in[22], layer + 1 < DEPTH ? (pg8::bf16_t*)(C.ws + WS_H) : nullptr, (float*)(C.ws + WS_SS1)};
        pg8::gemm_phase<pg8::EpiResid, pg8::StaticOrder, true, true>(C.lds, g, S, E); }
    SEAM(p0 + 12);
}
__global__ void __launch_bounds__(NTHR, 2) fwd_kernel(Args args) {
    extern __shared__ __attribute__((aligned(16))) unsigned char lds_raw[];
    Ctx C;
    C.lds = (LAS unsigned char*)lds_raw; C.tid = threadIdx.x; C.lane = C.tid & 63; C.wave = __builtin_amdgcn_readfirstlane(C.tid >> 6);
    C.G = gridDim.x; C.bid = blockIdx.x;
    const CAS Args* KA = (const CAS Args*)launder_ptr((const void*)(uintptr_t)__builtin_amdgcn_kernarg_segment_ptr());
    C.ws = KA->ws; C.out = KA->out;
    volatile LAS unsigned* MISC = (volatile LAS unsigned*)(C.lds + MISC_OFF);
    if (C.tid < 32) MISC[C.tid] = 0u;
    __syncthreads();
    unsigned* ctl = (unsigned*)(C.ws + WS_CTL);
    XcdBarrier bar; bar.bar = ctl + CW_BAR; bar.x = 0; bar.st = nullptr;
    if (!MK_PER_PHASE) bar = xcd_barrier_post(ctl + CW_BAR, MISC + 8);
    const int lo = KA->ph_lo, hi = KA->ph_hi;
    layer_phases<0>(C, KA, bar, ctl, lds_raw, lo, hi);
    layer_phases<1>(C, KA, bar, ctl, lds_raw, lo, hi);
    FRESH(); if (IN(N_PHASES - 1)) phase_final_norm(C, C.out, KA->in[22], (const float*)(C.ws + WS_SS1));
#undef IN
#undef SEAM
}

extern "C" void kernel_launch(void* const* d_in, const int* in_sizes, int n_in, void* d_out, int out_size, void* d_ws, size_t ws_size, hipStream_t stream) {
    static int grid = 0;
    if (grid == 0) {
        if (n_in != 23 || out_size != M * DM || ws_size < WS_NEED) { fprintf(stderr, "kernel_launch: unexpected problem (n_in %d, out %d, ws %zu); nothing launched\n", n_in, out_size, ws_size); grid = -1; return; }
        int dev = 0, cus = 0, per_cu = 0;
        if (hipGetDevice(&dev) != hipSuccess || hipDeviceGetAttribute(&cus, hipDeviceAttributeMultiprocessorCount, dev) != hipSuccess) { grid = -1; return; }
        if (hipFuncSetAttribute((const void*)fwd_kernel, hipFuncAttributeMaxDynamicSharedMemorySize, LDS_BYTES) != hipSuccess) { fprintf(stderr, "kernel_launch: hipFuncSetAttribute failed\n"); grid = -1; return; }
        if (hipOccupancyMaxActiveBlocksPerMultiprocessor(&per_cu, (const void*)fwd_kernel, NTHR, LDS_BYTES) != hipSuccess || per_cu < 1) { fprintf(stderr, "kernel_launch: occupancy query says %d blocks per CU\n", per_cu); }
        (void)hipGetLastError();
        grid = cus;
    }
    if (grid < 0) return;
    (void)hipMemsetAsync((char*)d_ws + WS_CTL, 0, CTL_ZERO_BYTES, stream);
    Args a{};
    for (int i = 0; i < 23; ++i) a.in[i] = (const float*)d_in[i];
    a.out = (float*)d_out; a.ws = (unsigned char*)d_ws;
#if MK_PER_PHASE
    for (int p = 0; p < N_PHASES; ++p) { a.ph_lo = p; a.ph_hi = p + 1; hipLaunchKernelGGL(fwd_kernel, dim3(grid), dim3(NTHR), LDS_BYTES, stream, a); }
#else
    a.ph_lo = 0; a.ph_hi = N_PHASES;
    hipLaunchKernelGGL(fwd_kernel, dim3(grid), dim3(NTHR), LDS_BYTES, stream, a);
#endif
    const hipError_t le = hipPeekAtLastError();
    if (le != hipSuccess) fprintf(stderr, "kernel_launch: launch failed: %s\n", hipGetErrorName(le));
}
```

```cpp
#include <hip/hip_runtime.h>
#include <hip/hip_fp16.h>
#include <cstdio>
#include <cstdint>
namespace pg8 {
#define PG8_LAS __attribute__((address_space(3)))
typedef unsigned short bf16_t;
typedef short bf16x8 __attribute__((ext_vector_type(8)));
typedef float f32x4 __attribute__((ext_vector_type(4)));
typedef unsigned u32x4 __attribute__((ext_vector_type(4)));
constexpr int BM = 256, BK = 64, HALF = 128, HTB = HALF * BK * 2  , STAGE_BYTES = 8 * HTB, NXCD = 8, WGM = 8;

__host__ __device__ __forceinline__ int lds_byte(int r, int c) { const int st = (r >> 4) * 2 + (c >> 5), rr = r & 15, cc = c & 31, ob = rr * 64 + cc * 2; return st * 1024 + (ob ^ (((ob >> 9) & 1) << 5)); }
__host__ __device__ __forceinline__ void stage_rc(int b, int& R, int& C) { const int st = b / 1024, sb = b % 1024, swz = sb ^ (((sb >> 9) & 1) << 5); R = (st >> 1) * 16 + swz / 64; C = (st & 1) * 32 + (swz % 64) / 2; }
__host__ __device__ __forceinline__ int perm32(int rho) { const int n = rho >> 4, i = rho & 15; return 8 * (i >> 2) + 4 * n + (i & 3); }

struct Unit { int pm, pn; };
struct Gemm { const bf16_t* A; const bf16_t* Bt; int M, N, K; };

struct StaticOrder {
    int nM, nN, nwg, G, c;
    __host__ __device__ void init(int M, int N, int G_, int c_) { nM = M / BM; nN = N / BM; nwg = nM * nN; G = G_; c = c_; }
    __host__ __device__ bool next(int i, Unit& u) const {
        const long L = (long)i * G + c; if (L >= nwg) return false;
        int wgid = (int)L; { const int q = nwg / NXCD, r = nwg % NXCD, xcd = wgid % NXCD, off = wgid / NXCD; wgid = (xcd < r ? xcd * (q + 1) : r * (q + 1) + (xcd - r) * q) + off; }
        const int nig = WGM * nN, gid = wgid / nig, fm = gid * WGM, gsz = (nM - fm) < WGM ? (nM - fm) : WGM;
        u.pm = fm + ((wgid % nig) % gsz); u.pn = (wgid % nig) / gsz; return true;
    }
    __device__ __forceinline__ void a_ready(const Unit&) const {}
    __device__ __forceinline__ void done(const Unit&) const {}
};

__device__ __forceinline__ unsigned cvt_pk_bf16(float lo, float hi) { unsigned r; asm volatile("v_cvt_pk_bf16_f32 %0, %1, %2" : "=v"(r) : "v"(lo), "v"(hi)); return r; }
typedef float f32x2 __attribute__((ext_vector_type(2)));
__device__ __forceinline__ f32x2 gelu_pk(f32x2 v) {
    const f32x2 av = __builtin_elementwise_abs(v), d = av * 0.2316418882f + 1.0f;
    f32x2 t; t.x = __builtin_amdgcn_rcpf(d.x); t.y = __builtin_amdgcn_rcpf(d.y);
    f32x2 q = t * 0.5307027145f + (-0.7265760135f); q = q * t + 0.7107068705f; q = q * t + (-0.142248368f); q = q * t + 0.127414796f; q = q * t;
    const f32x2 s = (v * v) * (-0.72134752044f);
    f32x2 e; e.x = __builtin_amdgcn_exp2f(s.x); e.y = __builtin_amdgcn_exp2f(s.y);
    const f32x2 m = v * (q * e), r = v - m;
    f32x2 o; o.x = v.x < 0.f ? m.x : r.x; o.y = v.y < 0.f ? m.y : r.y; return o;
}

template <int ACT  > struct EpiBf16 {
    static constexpr bool PERM = true, AFTER_DRAIN = false; static_assert(ACT == 0 || ACT == 1, "EpiBf16: ACT is 0 (none) or 1 (gelu_pk)");
    bf16_t* O; int ldc; const float* bias; int split_cols; size_t split_stride; float scale0;
    __device__ __forceinline__ void operator()(const f32x4 (&acc)[2][2][4][2], const Unit& u, int wr, int wc, int fr, int fq) const {
        const int row0 = u.pm * BM + wr * 64 + fr; int colt = u.pn * BM; bf16_t* base = O;
        float sc = 1.f; if (split_cols) { const int t = colt / split_cols; base += (size_t)t * split_stride; colt -= t * split_cols; if (t == 0) sc = scale0; }
        const int col0 = colt + wc * 32 + 8 * fq, bcol0 = u.pn * BM + wc * 32 + 8 * fq;
        f32x4 bv[2][2];
#pragma unroll
        for (int bj = 0; bj < 2; ++bj)
#pragma unroll
            for (int n = 0; n < 2; ++n) bv[bj][n] = bias ? *(const f32x4*)(bias + bcol0 + bj * HALF + 4 * n) : (f32x4){0.f, 0.f, 0.f, 0.f};
#pragma unroll
        for (int ai = 0; ai < 2; ++ai)
#pragma unroll
            for (int m = 0; m < 4; ++m) { bf16_t* rowp = base + (size_t)(row0 + ai * HALF + m * 16) * ldc + col0;
#pragma unroll
                for (int bj = 0; bj < 2; ++bj) { f32x4 v0 = acc[ai][bj][m][0] + bv[bj][0], v1 = acc[ai][bj][m][1] + bv[bj][1];
                    if (ACT == 1) { f32x2 a = gelu_pk((f32x2){v0[0], v0[1]}), b = gelu_pk((f32x2){v0[2], v0[3]}), c = gelu_pk((f32x2){v1[0], v1[1]}), d = gelu_pk((f32x2){v1[2], v1[3]});
                        v0 = (f32x4){a.x, a.y, b.x, b.y}; v1 = (f32x4){c.x, c.y, d.x, d.y}; }
                    v0 = v0 * sc; v1 = v1 * sc; u32x4 w; w.x = cvt_pk_bf16(v0[0], v0[1]); w.y = cvt_pk_bf16(v0[2], v0[3]); w.z = cvt_pk_bf16(v1[0], v1[1]); w.w = cvt_pk_bf16(v1[2], v1[3]);
                    *(u32x4*)(rowp + bj * HALF) = w; } }
    }
};

__device__ __forceinline__ void tile_dest(int pn, size_t& off, int& ld, int& colt);
__device__ __forceinline__ float row_rstd(const float* ss, int row) { return rsqrtf(ss[row] * (1.0f / 2048.0f) + 1e-5f); }
struct EpiProj {
    static constexpr bool PERM = true, AFTER_DRAIN = false;
    unsigned char* ws; const float* ss;
    __device__ __forceinline__ void operator()(const f32x4 (&acc)[2][2][4][2], const Unit& u, int wr, int wc, int fr, int fq) const {
        size_t off; int ld, colt; tile_dest(u.pn, off, ld, colt);
        bf16_t* base = (bf16_t*)(ws + off);
        const int row0 = u.pm * BM + wr * 64 + fr, col0 = colt + wc * 32 + 8 * fq;
        const float sc = u.pn < 4 ? 0.12751743074602467f : 1.0f;
#pragma unroll
        for (int ai = 0; ai < 2; ++ai)
#pragma unroll
            for (int m = 0; m < 4; ++m) { const int row = row0 + ai * HALF + m * 16; bf16_t* rowp = base + (size_t)row * ld + col0; const float rs = row_rstd(ss, row) * sc;
#pragma unroll
                for (int bj = 0; bj < 2; ++bj) { const f32x4 v0 = acc[ai][bj][m][0] * rs, v1 = acc[ai][bj][m][1] * rs;
                    u32x4 w; w.x = cvt_pk_bf16(v0[0], v0[1]); w.y = cvt_pk_bf16(v0[2], v0[3]); w.z = cvt_pk_bf16(v1[0], v1[1]); w.w = cvt_pk_bf16(v1[2], v1[3]);
                    *(u32x4*)(rowp + bj * HALF) = w; } }
    }
};
struct EpiResid {
    static constexpr bool PERM = false, AFTER_DRAIN = false;
    const float* base; float* out; int ldc; const float* g; bf16_t* xg; float* ss;
    __device__ __forceinline__ void operator()(const f32x4 (&acc)[2][2][4][2], const Unit& u, int wr, int wc, int fr, int fq) const {
        const int row0 = u.pm * BM + wr * 64 + fr, col0 = u.pn * BM + wc * 32 + 4 * fq;
        f32x4 gv[2][2];
#pragma unroll
        for (int bj = 0; bj < 2; ++bj)
#pragma unroll
            for (int n = 0; n < 2; ++n) gv[bj][n] = *(const f32x4*)(g + col0 + bj * HALF + n * 16);
#pragma unroll
        for (int ai = 0; ai < 2; ++ai)
#pragma unroll
            for (int m = 0; m < 4; ++m) { const int row = row0 + ai * HALF + m * 16; const size_t off = (size_t)row * ldc + col0; float sq = 0.f;
#pragma unroll
                for (int bj = 0; bj < 2; ++bj)
#pragma unroll
                    for (int n = 0; n < 2; ++n) { const size_t p = off + bj * HALF + n * 16; const f32x4 x = *(const f32x4*)(base + p) + acc[ai][bj][m][n]; *(f32x4*)(out + p) = x;
                        sq += (x[0] * x[0] + x[1] * x[1]) + (x[2] * x[2] + x[3] * x[3]);
                        if (xg) { const f32x4 y = x * gv[bj][n]; typedef unsigned u32x2_t __attribute__((ext_vector_type(2))); u32x2_t w; w.x = cvt_pk_bf16(y[0], y[1]); w.y = cvt_pk_bf16(y[2], y[3]); *(u32x2_t*)(xg + p) = w; } }
                sq += __shfl_xor(sq, 16); sq += __shfl_xor(sq, 32);
                if (fq == 0) unsafeAtomicAdd(ss + row, sq); }
    }
};
struct EpiSwiGLU {
    static constexpr bool PERM = true, AFTER_DRAIN = false;
    bf16_t* O; int ldc; const float* ss;
    __device__ __forceinline__ static float silu_mul(float g, float u) { return g * u * __builtin_amdgcn_rcpf(1.0f + __expf(-g)); }
    __device__ __forceinline__ void operator()(const f32x4 (&acc)[2][2][4][2], const Unit& u, int wr, int wc, int fr, int fq) const {
        const int row0 = u.pm * BM + wr * 64 + fr, col0 = u.pn * HALF + wc * 32 + 8 * fq;
#pragma unroll
        for (int ai = 0; ai < 2; ++ai)
#pragma unroll
            for (int m = 0; m < 4; ++m) { const int row = row0 + ai * HALF + m * 16; bf16_t* rowp = O + (size_t)row * ldc + col0; const float rs = row_rstd(ss, row);
                const f32x4 g0 = acc[ai][0][m][0] * rs, g1 = acc[ai][0][m][1] * rs, u0 = acc[ai][1][m][0] * rs, u1 = acc[ai][1][m][1] * rs;
                u32x4 w; w.x = cvt_pk_bf16(silu_mul(g0[0], u0[0]), silu_mul(g0[1], u0[1])); w.y = cvt_pk_bf16(silu_mul(g0[2], u0[2]), silu_mul(g0[3], u0[3]));
                w.z = cvt_pk_bf16(silu_mul(g1[0], u1[0]), silu_mul(g1[1], u1[1])); w.w = cvt_pk_bf16(silu_mul(g1[2], u1[2]), silu_mul(g1[3], u1[3]));
                *(u32x4*)rowp = w; }
    }
};
template <class Epi, class Sched, bool ALIGN_EPI = false, bool SP2 = false>
__device__ __forceinline__ void gemm_phase(PG8_LAS unsigned char* lds, const Gemm g, const Sched& S, const Epi& E) {
    int tid_ = threadIdx.x; asm volatile("" : "+v"(tid_));
    const int tid = tid_, wid = __builtin_amdgcn_readfirstlane(tid >> 6), lane = tid & 63, wr = wid >> 2, wc = wid & 3, fr = lane & 15, fq = lane >> 4;
    const int K = g.K, nt = K / BK;
    unsigned voffA[2], voffB[2];
#pragma unroll
    for (int i = 0; i < 2; ++i) { int R, C; stage_rc(tid * 16 + i * 8192, R, C); const int Rb = Epi::PERM ? ((R & ~31) + perm32(R & 31)) : R;
        voffA[i] = (unsigned)(R * K + C) * 2u; voffB[i] = (unsigned)(Rb * K + C) * 2u; }
    const size_t kstep = (size_t)(BK * 2);
    const size_t hstep = (size_t)HALF * K * 2;
    const size_t tstep = 2 * hstep;
    const unsigned ldsw = (unsigned)wid * 1024u;
    const int aoff = lds_byte(wr * 64 + fr, fq * 8), boff = lds_byte(wc * 32 + fr, fq * 8);
#define PG8_SA(b, h) (((b) * 2 + (h)) * HTB)
#define PG8_SB(b, h) ((4 + (b) * 2 + (h)) * HTB)
#define PG8_STAGE(bufoff, gbase, voff) do { _Pragma("unroll") for (int _i = 0; _i < 2; ++_i) \
        __builtin_amdgcn_global_load_lds((const unsigned*)((const char*)(gbase) + (voff)[_i]), (PG8_LAS unsigned*)(lds + (bufoff) + ldsw + _i * 8192), 16, 0, 0); } while (0)
#define PG8_LDA(dst, b, h) do { _Pragma("unroll") for (int m = 0; m < 4; ++m) _Pragma("unroll") for (int k = 0; k < 2; ++k) dst[m][k] = *(const PG8_LAS bf16x8*)(lds + PG8_SA(b, h) + aoff + m * 2048 + k * 1024); } while (0)
#define PG8_LDB(dst, b, h) do { _Pragma("unroll") for (int n = 0; n < 2; ++n) _Pragma("unroll") for (int k = 0; k < 2; ++k) dst[n][k] = *(const PG8_LAS bf16x8*)(lds + PG8_SB(b, h) + boff + n * 2048 + k * 1024); } while (0)
#define PG8_MMA(ai, bj, At, Bt) do { __builtin_amdgcn_s_setprio(1); _Pragma("unroll") for (int m = 0; m < 4; ++m) _Pragma("unroll") for (int n = 0; n < 2; ++n) _Pragma("unroll") for (int k = 0; k < 2; ++k) \
        acc[ai][bj][m][n] = __builtin_amdgcn_mfma_f32_16x16x32_bf16(Bt[n][k], At[m][k], acc[ai][bj][m][n], 0, 0, 0); __builtin_amdgcn_s_setprio(0); } while (0)
#define PG8_WAIT_V(n) asm volatile("s_waitcnt vmcnt(" #n ")" ::: "memory")
#define PG8_WAIT_L(n) asm volatile("s_waitcnt lgkmcnt(" #n ")" ::: "memory")
#define PG8_BAR __builtin_amdgcn_s_barrier()
#define PG8_SCHED __builtin_amdgcn_sched_barrier(0)
    Unit cur, nxt; int ui = 0;
    if (!S.next(0, cur)) return;
    f32x4 acc[2][2][4][2];
#pragma unroll
    for (int a = 0; a < 2; ++a)
#pragma unroll
        for (int b = 0; b < 2; ++b)
#pragma unroll
            for (int m = 0; m < 4; ++m)
#pragma unroll
                for (int n = 0; n < 2; ++n) acc[a][b][m][n] = (f32x4){0.f, 0.f, 0.f, 0.f};
    bf16x8 At[4][2], B0[2][2], B1[2][2];
    const char* cA = (const char*)g.A + (size_t)cur.pm * tstep; const char* cB = (const char*)g.Bt + (size_t)cur.pn * tstep;
    S.a_ready(cur);
    if constexpr (SP2) {
        PG8_STAGE(PG8_SB(0, 0), cB, voffB); PG8_STAGE(PG8_SB(0, 1), cB + hstep, voffB); PG8_STAGE(PG8_SA(0, 0), cA, voffA); PG8_STAGE(PG8_SA(0, 1), cA + hstep, voffA);
        if (wr == 1) PG8_BAR;
        PG8_WAIT_V(2); PG8_BAR;
        PG8_STAGE(PG8_SB(1, 0), cB + kstep, voffB); PG8_STAGE(PG8_SA(1, 0), cA + kstep, voffA); PG8_STAGE(PG8_SB(1, 1), cB + hstep + kstep, voffB);
        PG8_WAIT_V(6); PG8_BAR;
    } else {
        PG8_STAGE(PG8_SB(0, 0), cB, voffB); PG8_STAGE(PG8_SA(0, 0), cA, voffA); PG8_STAGE(PG8_SB(0, 1), cB + hstep, voffB); PG8_STAGE(PG8_SA(0, 1), cA + hstep, voffA);
        if (wr == 1) PG8_BAR;
        PG8_WAIT_V(4); PG8_BAR;
        PG8_STAGE(PG8_SB(1, 0), cB + kstep, voffB); PG8_STAGE(PG8_SA(1, 0), cA + kstep, voffA); PG8_STAGE(PG8_SB(1, 1), cB + hstep + kstep, voffB);
        PG8_WAIT_V(6); PG8_BAR;
    }
    for (;;) {
        const bool has_next = S.next(ui + 1, nxt);
        const char* nA = has_next ? (const char*)g.A + (size_t)nxt.pm * tstep : cA; const char* nB = has_next ? (const char*)g.Bt + (size_t)nxt.pn * tstep : cB;
        for (int t = 0; t < nt; t += 2) {
            const bool last = (t == nt - 2);
            const char* a1 = cA + (size_t)(t + 1) * kstep;
            const char* a2 = last ? nA : cA + (size_t)(t + 2) * kstep; const char* b2 = last ? nB : cB + (size_t)(t + 2) * kstep;
            const char* a3 = a2 + kstep; const char* b3 = b2 + kstep;
            if (last && has_next) S.a_ready(nxt);
            if constexpr (SP2) {
            PG8_LDB(B0, 0, 0); PG8_LDB(B1, 0, 1); PG8_SCHED; PG8_LDA(At, 0, 0); PG8_STAGE(PG8_SA(1, 1), a1 + hstep, voffA);
            PG8_WAIT_V(8); PG8_WAIT_L(0); PG8_BAR; PG8_MMA(0, 0, At, B0); PG8_MMA(0, 1, At, B1); PG8_BAR; PG8_SCHED;
            PG8_LDA(At, 0, 1); PG8_STAGE(PG8_SB(0, 0), b2, voffB); PG8_STAGE(PG8_SB(0, 1), b2 + hstep, voffB); PG8_STAGE(PG8_SA(0, 0), a2, voffA);
            PG8_WAIT_V(8); PG8_WAIT_L(0); PG8_BAR; PG8_MMA(1, 0, At, B0); PG8_MMA(1, 1, At, B1); PG8_BAR; PG8_SCHED;
            PG8_LDB(B0, 1, 0); PG8_LDB(B1, 1, 1); PG8_SCHED; PG8_LDA(At, 1, 0); PG8_STAGE(PG8_SA(0, 1), a2 + hstep, voffA);
            PG8_WAIT_V(8); PG8_WAIT_L(0); PG8_BAR; PG8_MMA(0, 0, At, B0); PG8_MMA(0, 1, At, B1); PG8_BAR; PG8_SCHED;
            PG8_LDA(At, 1, 1); PG8_STAGE(PG8_SB(1, 0), b3, voffB); PG8_STAGE(PG8_SB(1, 1), b3 + hstep, voffB); PG8_STAGE(PG8_SA(1, 0), a3, voffA);
            PG8_WAIT_V(8); PG8_WAIT_L(0); PG8_BAR; PG8_MMA(1, 0, At, B0); PG8_MMA(1, 1, At, B1); PG8_BAR; PG8_SCHED;
            } else {
            PG8_LDB(B0, 0, 0); PG8_SCHED; PG8_LDA(At, 0, 0); PG8_STAGE(PG8_SA(1, 1), a1 + hstep, voffA);
            PG8_WAIT_L(8); PG8_BAR; PG8_WAIT_L(0); PG8_MMA(0, 0, At, B0); PG8_BAR; PG8_SCHED;
            PG8_LDB(B1, 0, 1); PG8_STAGE(PG8_SB(0, 0), b2, voffB);
            PG8_BAR; PG8_WAIT_L(0); PG8_MMA(0, 1, At, B1); PG8_BAR;
            PG8_LDA(At, 0, 1); PG8_STAGE(PG8_SA(0, 0), a2, voffA);
            PG8_BAR; PG8_WAIT_L(0); PG8_MMA(1, 0, At, B0); PG8_BAR; PG8_SCHED;
            PG8_STAGE(PG8_SB(0, 1), b2 + hstep, voffB);
            PG8_WAIT_V(6); PG8_BAR; PG8_MMA(1, 1, At, B1); PG8_BAR;
            PG8_LDB(B0, 1, 0); PG8_SCHED; PG8_LDA(At, 1, 0); PG8_STAGE(PG8_SA(0, 1), a2 + hstep, voffA);
            PG8_WAIT_L(8); PG8_BAR; PG8_WAIT_L(0); PG8_MMA(0, 0, At, B0); PG8_BAR; PG8_SCHED;
            PG8_LDB(B1, 1, 1); PG8_STAGE(PG8_SB(1, 0), b3, voffB);
            PG8_BAR; PG8_WAIT_L(0); PG8_MMA(0, 1, At, B1); PG8_BAR;
            PG8_LDA(At, 1, 1); PG8_STAGE(PG8_SA(1, 0), a3, voffA);
            PG8_BAR; PG8_WAIT_L(0); PG8_MMA(1, 0, At, B0); PG8_BAR; PG8_SCHED;
            PG8_STAGE(PG8_SB(1, 1), b3 + hstep, voffB);
            PG8_WAIT_V(6); PG8_BAR; PG8_MMA(1, 1, At, B1); PG8_BAR;
            }
        }
        if constexpr (ALIGN_EPI) { if (wr == 0) PG8_BAR; }
        if constexpr (!Epi::AFTER_DRAIN) { E(acc, cur, wr, wc, fr, fq); S.done(cur); }
        if (!has_next) break;
#pragma unroll
        for (int a = 0; a < 2; ++a)
#pragma unroll
            for (int b = 0; b < 2; ++b)
#pragma unroll
                for (int m = 0; m < 4; ++m)
#pragma unroll
                    for (int n = 0; n < 2; ++n) acc[a][b][m][n] = (f32x4){0.f, 0.f, 0.f, 0.f};
        cur = nxt; cA = nA; cB = nB; ++ui;
        if constexpr (ALIGN_EPI) { if (wr == 1) PG8_BAR; }
    }
    PG8_WAIT_V(0);
    if constexpr (!ALIGN_EPI) { if (wr == 0) PG8_BAR; }
    PG8_BAR;
    if constexpr (Epi::AFTER_DRAIN) { E.fused(acc, cur, wr, wc, fr, fq, lds, wid, lane); S.done(cur); }
#undef PG8_SA
#undef PG8_SB
#undef PG8_STAGE
#undef PG8_LDA
#undef PG8_LDB
#undef PG8_MMA
#undef PG8_WAIT_V
#undef PG8_WAIT_L
#undef PG8_BAR
#undef PG8_SCHED
}
}
constexpr int NB = 4, T = 8192, M = NB * T, DM = 2048, DFF = 5632, DEPTH = 2;
constexpr int N_IN = 7696, N_INP = 7936;
constexpr int NWAVES = 8, NTHR = NWAVES * 64;
#define LAS __attribute__((address_space(3)))
#define GAS __attribute__((address_space(1)))
#define CAS __attribute__((address_space(4)))
typedef unsigned short bf16;
typedef short bf16x8 __attribute__((ext_vector_type(8)));
typedef float f32x4 __attribute__((ext_vector_type(4)));
typedef float f32x16 __attribute__((ext_vector_type(16)));
typedef unsigned u32x4 __attribute__((ext_vector_type(4)));
typedef unsigned u32x2 __attribute__((ext_vector_type(2)));
typedef unsigned long long u64;

constexpr size_t MiB = 1u << 20;
constexpr size_t WS_CTL = 0, CTL_ZERO_BYTES = 1 * MiB;
constexpr size_t WS_WIN = 1 * MiB, WS_WOUT = 32 * MiB, WS_WGU = 40 * MiB, WS_WDN = 84 * MiB;
constexpr size_t WS_LORA = 106 * MiB;
constexpr size_t LO_W = 0, LO_A = 512 * 96 * 2, LO_V = 2 * 512 * 96 * 2, LO_G = LO_V + 512 * 64 * 2;
constexpr size_t WS_VFIRST = 107 * MiB;
constexpr size_t WS_H = 139 * MiB;
constexpr size_t WS_VT = 139 * MiB, WS_MASK = 203 * MiB;
constexpr size_t WS_Q = 267 * MiB, WS_K = 331 * MiB, WS_QI = 395 * MiB, WS_V = 459 * MiB, WS_KW = 523 * MiB, WS_BQ = 539 * MiB, WS_BK = 555 * MiB, WS_BV = 571 * MiB, WS_BG = 603 * MiB;
constexpr size_t WS_CR = 635 * MiB, WS_CK = 667 * MiB, WS_CV = 699 * MiB, WS_CL = 731 * MiB, WS_CG = 747 * MiB;
constexpr size_t WS_CAT = 763 * MiB;
constexpr size_t WS_KVST = 891 * MiB;
constexpr size_t WS_TAB = 955 * MiB;
constexpr size_t WS_SS1 = 959 * MiB, WS_SS2 = 959 * MiB + 256 * 1024;
constexpr size_t TAB_A = 0, TAB_I = (size_t)T * 16 * 8, TAB_R = TAB_I + (size_t)T * 8 * 8, TAB_END = TAB_R + (size_t)T * 32 * 8;
constexpr size_t WS_RR = 139 * MiB, WS_RW = 171 * MiB, WS_RKH = 203 * MiB, WS_RV = 235 * MiB, WS_RA = 267 * MiB, WS_RB = 299 * MiB;
constexpr size_t WS_PHI = 523 * MiB, WS_PSI = 555 * MiB, WS_SST = 587 * MiB, WS_Y = 635 * MiB;
constexpr size_t WS_H2 = 139 * MiB, WS_ACT = 267 * MiB;
constexpr size_t WS_NEED = 1024 * MiB;
static_assert(WS_TAB + TAB_END <= WS_NEED && WS_ACT + (size_t)M * DFF * 2 <= WS_CR && WS_SST + 32 * MiB <= WS_CR && WS_Y + (size_t)M * 512 * 4 <= WS_CV, "ws map");

constexpr int LDS_BYTES = 147456, MISC_OFF = 143360;
constexpr int CW_BAR = 4096;

__device__ __forceinline__ unsigned f2bf(float f) { unsigned u = __builtin_bit_cast(unsigned, f); return (u + 0x7fffu + ((u >> 16) & 1u)) >> 16; }
__device__ __forceinline__ unsigned pk2(float lo, float hi) { return f2bf(lo) | (f2bf(hi) << 16); }
__device__ __forceinline__ float bf2f(unsigned short b) { return __builtin_bit_cast(float, (unsigned)b << 16); }
__device__ __forceinline__ float bflo(unsigned w) { return __builtin_bit_cast(float, w << 16); }
__device__ __forceinline__ float bfhi(unsigned w) { return __builtin_bit_cast(float, w & 0xffff0000u); }
__device__ __forceinline__ float wave_sum(float v) {
#pragma unroll
    for (int o = 1; o < 64; o <<= 1) v += __shfl_xor(v, o);
    return v;
}
#define LDS_WAIT() asm volatile("s_waitcnt lgkmcnt(0)" ::: "memory")
typedef float f32x2 __attribute__((ext_vector_type(2)));
__device__ __forceinline__ float half_sum32(float v) { v += __shfl_xor(v, 1); v += __shfl_xor(v, 2); v += __shfl_xor(v, 4); v += __shfl_xor(v, 8); v += __shfl_xor(v, 16); return v; }


namespace pg8 {
__device__ __forceinline__ void tile_dest(int pn, size_t& off, int& ld, int& colt) {
    if (pn < 16) { const int g = pn >> 2; off = g == 0 ? WS_Q : g == 1 ? WS_K : g == 2 ? WS_V : WS_QI; ld = 1024; colt = (pn & 3) * 256; }
    else if (pn == 16) { off = WS_BQ; ld = 256; colt = 0; }
    else if (pn == 17) { off = WS_BK; ld = 256; colt = 0; }
    else if (pn < 20) { off = WS_BV; ld = 512; colt = (pn - 18) * 256; }
    else if (pn < 22) { off = WS_BG; ld = 512; colt = (pn - 20) * 256; }
    else if (pn == 22) { off = WS_KW; ld = 256; colt = 0; }
    else if (pn < 25) { off = WS_CR; ld = 512; colt = (pn - 23) * 256; }
    else if (pn < 27) { off = WS_CK; ld = 512; colt = (pn - 25) * 256; }
    else if (pn < 29) { off = WS_CV; ld = 512; colt = (pn - 27) * 256; }
    else if (pn == 29) { off = WS_CL; ld = 256; colt = 0; }
    else { off = WS_CG; ld = 256; colt = 0; }
}
}
__device__ __forceinline__ int win_src(int n, int layer) {
    if (n < 4096) return n;
    if (n < 4352) return 4176 + (n - 4096);
    if (n < 4608) return 4432 + (n - 4352);
    if (n < 5120) return 4688 + (n - 4608);
    if (n < 5632) return 5200 + (n - 5120);
    if (n < 5888) { const int j = n - 5632; return j < 64 ? 4096 + j : (j < 80 ? 4160 + (j - 64) : -1); }
    if (n < 7424) return 5712 + (n - 5888);
    if (n < 7680) { const int j = n - 7424; return j < 96 ? 7248 + j : (j < 192 ? 7344 + (j - 96) : (layer > 0 ? -2 - (j - 192) : -1)); }
    return 7440 + (n - 7680);
}
#define XB_TMO      128
#define XB_XCNT(j)  (256  + 64 * (j))
#define XB_XSUB(j)  (1280 + 64 * (j))
#define XB_XGEN(j)  (2304 + 64 * (j))
#define XB_TOP      3328
#define XB_TOPGEN   3392
#define XCD_BAR_WORDS 3456
#define XB_SPIN_CAP (1u << 18)

__device__ __forceinline__ unsigned xb_ld(unsigned* p)              { return __hip_atomic_load(p, __ATOMIC_RELAXED, __HIP_MEMORY_SCOPE_AGENT); }
__device__ __forceinline__ unsigned xb_add(unsigned* p, unsigned v) { return __hip_atomic_fetch_add(p, v, __ATOMIC_RELAXED, __HIP_MEMORY_SCOPE_AGENT); }
__device__ __forceinline__ unsigned xb_xcc_id() { return (unsigned)__builtin_amdgcn_s_getreg((3 << 11) | 20) & 0xFu; }
#define XB_SPIN(cond, bar) do { unsigned _sp = 0; while (cond) { __builtin_amdgcn_s_sleep(1); \
    if ((++_sp & 255u) == 0u) { if (xb_ld(&(bar)[XB_TMO])) break; if (_sp > XB_SPIN_CAP) { atomicAdd(&(bar)[XB_TMO], 1u); break; } } } } while (0)

struct XcdBarrier {
    unsigned* bar; unsigned x;
    volatile LAS unsigned* st;
};

__device__ __forceinline__ XcdBarrier xcd_barrier_post(unsigned* bar, volatile LAS unsigned* st) {
    XcdBarrier b; b.bar = bar; b.x = xb_xcc_id(); b.st = st;
    if (threadIdx.x == 0) (void)xb_add(&bar[XB_XCNT(b.x)], 1u);
    return b;
}
__device__ __forceinline__ void xcd_barrier_complete(unsigned* bar, unsigned x, unsigned& nloc, unsigned& nx) {
    const unsigned G = gridDim.x * gridDim.y * gridDim.z;
    unsigned sum, cnt, mine, sp = 0u;
    for (;;) {
        sum = 0u; cnt = 0u; mine = 0u;
#pragma unroll
        for (unsigned j = 0; j < 16; ++j) { const unsigned c = xb_ld(&bar[XB_XCNT(j)]); sum += c; cnt += (c > 0u) ? 1u : 0u; mine = (j == x) ? c : mine; }
        if (sum == G) break;
        __builtin_amdgcn_s_sleep(1);
        if ((++sp & 255u) == 0u) { if (xb_ld(&bar[XB_TMO])) break; if (sp > XB_SPIN_CAP) { atomicAdd(&bar[XB_TMO], 1u); break; } }
    }
    nloc = mine > 0u ? mine : 1u; nx = cnt > 0u ? cnt : 1u;
}

__device__ __forceinline__ void xcd_barrier(const XcdBarrier& b) {
    asm volatile("s_waitcnt vmcnt(0)" ::: "memory");
    __syncthreads();
    if (threadIdx.x == 0) {
        unsigned* bar = b.bar;
        __builtin_amdgcn_s_waitcnt(0);
        unsigned nloc = b.st[0], nx = b.st[1];
        if (nloc == 0u) { xcd_barrier_complete(bar, b.x, nloc, nx); b.st[0] = nloc; b.st[1] = nx; }
        const unsigned old = xb_add(&bar[XB_XSUB(b.x)], 1u);
        const unsigned gen = old / nloc;
        if (old + 1u == (gen + 1u) * nloc) {
            __builtin_amdgcn_fence(__ATOMIC_RELEASE, "agent");
            asm volatile("s_waitcnt vmcnt(0)" ::: "memory");
            const unsigned og = xb_add(&bar[XB_TOP], 1u);
            const unsigned tg = og / nx;
            if (og + 1u == (tg + 1u) * nx) xb_add(&bar[XB_TOPGEN], 1u);
            else XB_SPIN(xb_ld(&bar[XB_TOPGEN]) == tg, bar);
            __builtin_amdgcn_fence(__ATOMIC_ACQUIRE, "agent");
            xb_add(&bar[XB_XGEN(b.x)], 1u);
            asm volatile("s_waitcnt vmcnt(0)" ::: "memory");
        } else {
            XB_SPIN(xb_ld(&bar[XB_XGEN(b.x)]) == gen, bar);
            __builtin_amdgcn_fence(__ATOMIC_ACQUIRE, "agent");
            asm volatile("s_waitcnt vmcnt(0)" ::: "memory");
        }
    }
    __syncthreads();
}

struct Ctx {
    LAS unsigned char* lds; int tid, lane, wave, G, bid; unsigned char* ws; float* out;
};

template <int MAP>
__device__ __forceinline__ void wconv_item(const float* W, int ldw, const float* W2, int K, bf16* WT, LAS float* scr, int item, int nblk, int lane, int layer) {
    const int kb = item / nblk, nb = item % nblk, k0 = 64 * kb, n0 = 32 * nb;
    const int n = n0 + (lane & 31);
    const float* src = nullptr; int ld = ldw;
    if (MAP == 0) src = W + n;
    else if (MAP == 1) { const int s = win_src(n, layer); if (s >= 0) src = W + s; else if (s <= -2) { src = W2 + (-2 - s); ld = 64; } }
    else { const int tl = n >> 8, j = n & 255; src = W + (j < 128 ? tl * 128 + j : DFF + tl * 128 + (j - 128)); }
    float tv[32];
#pragma unroll
    for (int i = 0; i < 32; ++i) { const int kk = 2 * i + (lane >> 5); tv[i] = src ? src[(size_t)(k0 + kk) * ld] : 0.f; }
#pragma unroll
    for (int i = 0; i < 32; ++i) { const int kk = 2 * i + (lane >> 5); scr[kk * 33 + (lane & 31)] = tv[i]; }
    LDS_WAIT(); asm volatile("" ::: "memory");
    const int c = lane & 7;
#pragma unroll
    for (int j = 0; j < 4; ++j) { const int nn = (lane >> 3) + 8 * j; const LAS float* s = scr + (8 * c) * 33 + nn;
        u32x4 o; o.x = pk2(s[0 * 33], s[1 * 33]); o.y = pk2(s[2 * 33], s[3 * 33]); o.z = pk2(s[4 * 33], s[5 * 33]); o.w = pk2(s[6 * 33], s[7 * 33]);
        *(u32x4*)(WT + (size_t)(n0 + nn) * K + k0 + 8 * c) = o; }
    LDS_WAIT(); asm volatile("" ::: "memory");
}
struct WSrc { const float *w_in, *w_vres, *w_out, *w_gu, *w_dn, *wlb, *alb, *glb, *vlb; };
__device__ __forceinline__ void phase_wconv(const Ctx& C, int layer, const WSrc& W) {
    LAS float* scr = (LAS float*)(C.lds + C.wave * 16384);
    const int gw = C.bid * NWAVES + C.wave, NGW = C.G * NWAVES;
    const float* w_in = W.w_in + (size_t)layer * DM * N_IN; const float* w_vres = W.w_vres;
    const float* w_out = W.w_out + (size_t)layer * DM * DM; const float* w_gu = W.w_gu + (size_t)layer * DM * 2 * DFF; const float* w_dn = W.w_dn + (size_t)layer * DFF * DM;
    constexpr int I_IN = (DM / 64) * (N_INP / 32), I_OUT = (DM / 64) * (DM / 32), I_GU = (DM / 64) * (2 * DFF / 32), I_DN = (DFF / 64) * (DM / 32);
    for (int it = gw; it < I_IN + I_OUT + I_GU + I_DN; it += NGW) {
        int r = it;
        if (r < I_IN) { wconv_item<1>(w_in, N_IN, w_vres, DM, (bf16*)(C.ws + WS_WIN), scr, r, N_INP / 32, C.lane, layer); continue; } r -= I_IN;
        if (r < I_OUT) { wconv_item<0>(w_out, DM, nullptr, DM, (bf16*)(C.ws + WS_WOUT), scr, r, DM / 32, C.lane, layer); continue; } r -= I_OUT;
        if (r < I_GU) { wconv_item<2>(w_gu, 2 * DFF, nullptr, DM, (bf16*)(C.ws + WS_WGU), scr, r, 2 * DFF / 32, C.lane, layer); continue; } r -= I_GU;
        wconv_item<0>(w_dn, DM, nullptr, DFF, (bf16*)(C.ws + WS_WDN), scr, r, DM / 32, C.lane, layer);
    }
    const int gt = C.bid * NTHR + C.tid, NGT = C.G * NTHR;
    const float* wlb = W.wlb + (size_t)layer * 96 * 512; const float* alb = W.alb + (size_t)layer * 96 * 512; const float* glb = W.glb + (size_t)layer * 256 * 512;
    const float* vlb = W.vlb;
    bf16* LW = (bf16*)(C.ws + WS_LORA + LO_W); bf16* LA = (bf16*)(C.ws + WS_LORA + LO_A); bf16* LV = (bf16*)(C.ws + WS_LORA + LO_V); bf16* LG = (bf16*)(C.ws + WS_LORA + LO_G);
    for (int i = gt; i < 512 * 96; i += NGT) { const int n = i / 96, k = i % 96; LW[i] = (bf16)f2bf(wlb[k * 512 + n]); LA[i] = (bf16)f2bf(alb[k * 512 + n]); }
    for (int i = gt; i < 512 * 64; i += NGT) { const int n = i / 64, k = i % 64; LV[i] = (bf16)f2bf(layer > 0 ? vlb[k * 512 + n] : 0.f); }
    for (int i = gt; i < 512 * 256; i += NGT) { const int n = i / 256, k = i % 256; LG[i] = (bf16)f2bf(glb[k * 512 + n]); }
    if (layer == 0) {
        float2* TA = (float2*)(C.ws + WS_TAB + TAB_A); float2* TI = (float2*)(C.ws + WS_TAB + TAB_I); float2* TR = (float2*)(C.ws + WS_TAB + TAB_R);
        const float l2a = 18.931568569324174f  , l2r = 13.287712379549449f  ;
        for (int i = gt; i < T * 56; i += NGT) {
            const int pos = i / 56, j = i % 56; float fr; float2* dst;
            if (j < 16) { fr = exp2f(-(float)j * (1.0f / 16.0f) * l2a); dst = TA + pos * 16 + j; }
            else if (j < 24) { fr = exp2f(-(float)(j - 16) * (1.0f / 8.0f) * l2a); dst = TI + pos * 8 + (j - 16); }
            else { fr = exp2f(-(float)(j - 24) * (1.0f / 32.0f) * l2r); dst = TR + pos * 32 + (j - 24); }
            const float ang = (float)pos * fr; *dst = make_float2(cosf(ang), sinf(ang));
        }
    }
}
__device__ __forceinline__ void phase_xg(const Ctx& C, const float* x, const float* g, bf16* out, float* ss) {
    const int gw = C.bid * NWAVES + C.wave, NGW = C.G * NWAVES;
    f32x4 gv[8];
#pragma unroll
    for (int j = 0; j < 8; ++j) gv[j] = *(const f32x4*)(g + 4 * (C.lane + 64 * j));
    for (int m = gw; m < M; m += NGW) {
        const f32x4* xr = (const f32x4*)(x + (size_t)m * DM) + C.lane; f32x4 v[8]; float s = 0.f;
#pragma unroll
        for (int j = 0; j < 8; ++j) { v[j] = xr[64 * j]; s += (v[j].x * v[j].x + v[j].y * v[j].y) + (v[j].z * v[j].z + v[j].w * v[j].w); }
        s = wave_sum(s); if (C.lane == 0) ss[m] = s;
        u32x2* o = (u32x2*)(out + (size_t)m * DM) + C.lane;
#pragma unroll
        for (int j = 0; j < 8; ++j) { u32x2 w; w.x = pk2(v[j].x * gv[j].x, v[j].y * gv[j].y); w.y = pk2(v[j].z * gv[j].z, v[j].w * gv[j].w); o[64 * j] = w; }
    }
}
__device__ __forceinline__ void phase_final_norm(const Ctx& C, float* x, const float* g, const float* ss) {
    const int gw = C.bid * NWAVES + C.wave, NGW = C.G * NWAVES;
    f32x4 gv[8];
#pragma unroll
    for (int j = 0; j < 8; ++j) gv[j] = *(const f32x4*)(g + 4 * (C.lane + 64 * j));
    for (int m = gw; m < M; m += NGW) {
        f32x4* xr = (f32x4*)(x + (size_t)m * DM) + C.lane; const float rs = rsqrtf(ss[m] * (1.0f / DM) + 1e-5f);
#pragma unroll
        for (int j = 0; j < 8; ++j) xr[64 * j] = xr[64 * j] * rs * gv[j];
    }
}
__device__ __forceinline__ void phase_prep_a(const Ctx& C) {
    const long gt = (long)C.bid * NTHR + C.tid, NGT = (long)C.G * NTHR;
    { float* s1 = (float*)(C.ws + WS_SS1); float* s2 = (float*)(C.ws + WS_SS2); for (long i = gt; i < M; i += NGT) { s1[i] = 0.f; s2[i] = 0.f; } }
    for (int cfg = 0; cfg < 6; ++cfg) {
        size_t off; int ld, nh, hd, half; size_t tab;
        if (cfg == 0) { off = WS_Q; ld = 1024; nh = 8; hd = 128; half = 16; tab = TAB_A; }
        else if (cfg == 1) { off = WS_K; ld = 1024; nh = 8; hd = 128; half = 16; tab = TAB_A; }
        else if (cfg == 2) { off = WS_QI; ld = 1024; nh = 16; hd = 64; half = 8; tab = TAB_I; }
        else if (cfg == 3) { off = WS_KW; ld = 256; nh = 1; hd = 64; half = 8; tab = TAB_I; }
        else if (cfg == 4) { off = WS_BQ; ld = 256; nh = 4; hd = 64; half = 32; tab = TAB_R; }
        else { off = WS_BK; ld = 256; nh = 4; hd = 64; half = 32; tab = TAB_R; }
        bf16* buf = (bf16*)(C.ws + off); const float2* tb = (const float2*)(C.ws + WS_TAB + tab);
        const int cpp = half >> 3; const long total = (long)M * nh * cpp;
        for (long it = gt; it < total; it += NGT) {
            const int c = (int)(it % cpp); const long r2 = it / cpp; const int h = (int)(r2 % nh); const int row = (int)(r2 / nh); const int pos = row & (T - 1);
            bf16* p1 = buf + (size_t)row * ld + h * hd + 8 * c; bf16* p2 = p1 + half;
            const u32x4 a = *(const u32x4*)p1, b = *(const u32x4*)p2; const float2* tp = tb + (size_t)pos * half + 8 * c;
            float x1[8], x2[8];
#pragma unroll
            for (int e = 0; e < 4; ++e) { x1[2 * e] = bflo(a[e]); x1[2 * e + 1] = bfhi(a[e]); x2[2 * e] = bflo(b[e]); x2[2 * e + 1] = bfhi(b[e]); }
            u32x4 oa, ob;
#pragma unroll
            for (int e = 0; e < 4; ++e) {
                const float2 t0 = tp[2 * e], t1 = tp[2 * e + 1];
                oa[e] = pk2(x1[2 * e] * t0.x - x2[2 * e] * t0.y, x1[2 * e + 1] * t1.x - x2[2 * e + 1] * t1.y);
                ob[e] = pk2(x2[2 * e] * t0.x + x1[2 * e] * t0.y, x2[2 * e + 1] * t1.x + x1[2 * e + 1] * t1.y);
            }
            *(u32x4*)p1 = oa; *(u32x4*)p2 = ob;
        }
    }
    {
        LAS unsigned short* scr = (LAS unsigned short*)(C.lds + C.wave * 8704);
        const bf16* V = (const bf16*)(C.ws + WS_V); bf16* Vt = (bf16*)(C.ws + WS_VT);
        const int gw = C.bid * NWAVES + C.wave, NGW = C.G * NWAVES;
        for (int it = gw; it < NB * 128 * 16; it += NGW) {
            const int ct = it & 15, tt = (it >> 4) & 127, b = it >> 11;
            const int t0 = tt * 64, c0 = ct * 64;
#pragma unroll 4
            for (int i = 0; i < 32; ++i) { const int tr = 2 * i + (C.lane >> 5), cc = 2 * (C.lane & 31);
                const unsigned w = *(const unsigned*)(V + (size_t)(b * T + t0 + tr) * 1024 + c0 + cc); scr[tr * 66 + cc] = (unsigned short)(w & 0xffffu); scr[tr * 66 + cc + 1] = (unsigned short)(w >> 16); }
            LDS_WAIT(); asm volatile("" ::: "memory");
#pragma unroll 4
            for (int i = 0; i < 32; ++i) { const int cr = 2 * i + (C.lane >> 5), tp = 2 * (C.lane & 31);
                const unsigned w = (unsigned)scr[tp * 66 + cr] | ((unsigned)scr[(tp + 1) * 66 + cr] << 16);
                *(unsigned*)(Vt + ((size_t)b * 1024 + c0 + cr) * T + t0 + tp) = w; }
            LDS_WAIT(); asm volatile("" ::: "memory");
        }
    }
}
#ifndef IDX_REP_T
#define IDX_REP_T 1
#endif
#ifndef IDX_REP_S
#define IDX_REP_S 1
#endif
__device__ __forceinline__ void phase_indexer(const Ctx& C) {
    LAS unsigned short* sc = (LAS unsigned short*)C.lds;
    LAS unsigned* hist = (LAS unsigned*)(C.lds + 131072) + C.wave * 256;
    LAS float* wvl = (LAS float*)(C.lds + 131072 + 8192);
    LAS unsigned short* qbl = (LAS unsigned short*)(C.lds + 131072 + 8192 + 512);
    const bf16* QI = (const bf16*)(C.ws + WS_QI); const bf16* KW = (const bf16*)(C.ws + WS_KW); u64* MASK = (u64*)(C.ws + WS_MASK);
    const int lane = C.lane, r32 = lane & 31, hi = lane >> 5;
    for (int it = C.bid; it < NB * (T / 8); it += C.G) {
        const int b = it & 3, qg = it >> 2, q0 = qg * 8, qchunk = q0 >> 6, nadm = 64 * (qchunk + 1);
        const int qrow = b * T + q0 + C.wave;
        if (qchunk < 4) {
            MASK[(size_t)qrow * 128 + lane] = lane <= qchunk ? ~0ull : 0ull; MASK[(size_t)qrow * 128 + 64 + lane] = 0ull;
            continue;
        }
        bf16x8 af[4][4];
        {
            const int qq = (r32 >> 2) & 1, hh = (r32 & 3) + 4 * (r32 >> 3);
#pragma unroll
            for (int pr = 0; pr < 4; ++pr) {
                const bf16* qp = QI + (size_t)(b * T + q0 + 2 * pr + qq) * 1024 + hh * 64 + 8 * hi;
#pragma unroll
                for (int kk = 0; kk < 4; ++kk) af[pr][kk] = *(const bf16x8*)(qp + 16 * kk);
            }
            if (C.tid < 128) wvl[C.tid] = bf2f(KW[(size_t)(b * T + q0 + (C.tid >> 4)) * 256 + 64 + (C.tid & 15)]) * 0.015625f;
        }
        __syncthreads();
        { const int qx = C.tid >> 6, dx = C.tid & 63; const bf16* qp = QI + (size_t)(b * T + q0 + qx) * 1024 + dx; float acc = 0.f;
#pragma unroll
          for (int h = 0; h < 16; ++h) acc += wvl[qx * 16 + h] * bf2f(qp[h * 64]);
          qbl[qx * 64 + dx] = (unsigned short)f2bf(acc); }
        __syncthreads();
        bf16x8 afl[4];
        { const int qsel = 2 * (r32 & 3) + ((r32 >> 2) & 1);
#pragma unroll
          for (int kk = 0; kk < 4; ++kk) { const u32x4 z = {0u, 0u, 0u, 0u}; afl[kk] = r32 < 8 ? *(const LAS bf16x8*)(qbl + qsel * 64 + 16 * kk + 8 * hi) : __builtin_bit_cast(bf16x8, z); } }
        for (int rep_t = 0; rep_t < IDX_REP_T; ++rep_t) {
            const int ntile = nadm / 32;
            bf16x8 bfr[4], bnx[4];
            { const bf16* kp = KW + (size_t)(b * T + 32 * C.wave + r32) * 256 + 8 * hi;
#pragma unroll
              for (int kk = 0; kk < 4; ++kk) bnx[kk] = *(const bf16x8*)(kp + 16 * kk); }
            for (int tile = C.wave; tile < ntile; tile += NWAVES) {
                const int key0 = 32 * tile;
#pragma unroll
                for (int kk = 0; kk < 4; ++kk) bfr[kk] = bnx[kk];
                if (tile + NWAVES < ntile) { const bf16* kp = KW + (size_t)(b * T + key0 + 32 * NWAVES + r32) * 256 + 8 * hi;
#pragma unroll
                    for (int kk = 0; kk < 4; ++kk) bnx[kk] = *(const bf16x8*)(kp + 16 * kk); }
                const int kpos = (key0 & ~127) + 2 * ((key0 & 63) + r32) + ((key0 >> 6) & 1);
                f32x16 dl = {0.f, 0.f, 0.f, 0.f, 0.f, 0.f, 0.f, 0.f, 0.f, 0.f, 0.f, 0.f, 0.f, 0.f, 0.f, 0.f};
#pragma unroll
                for (int kk = 0; kk < 4; ++kk) dl = __builtin_amdgcn_mfma_f32_32x32x16_bf16(afl[kk], bfr[kk], dl, 0, 0, 0);
#pragma unroll
                for (int pr = 0; pr < 4; ++pr) {
                    f32x16 d = {0.f, 0.f, 0.f, 0.f, 0.f, 0.f, 0.f, 0.f, 0.f, 0.f, 0.f, 0.f, 0.f, 0.f, 0.f, 0.f};
#pragma unroll
                    for (int kk = 0; kk < 4; ++kk) d = __builtin_amdgcn_mfma_f32_32x32x16_bf16(af[pr][kk], bfr[kk], d, 0, 0, 0);
                    float s0 = dl[pr];
#pragma unroll
                    for (int g = 0; g < 4; ++g) { const f32x4 w4 = *(const LAS f32x4*)(wvl + (2 * pr + hi) * 16 + 4 * g);
                        s0 = __builtin_fmaf(__builtin_fabsf(d[4 * g]), w4.x, s0); s0 = __builtin_fmaf(__builtin_fabsf(d[4 * g + 1]), w4.y, s0); s0 = __builtin_fmaf(__builtin_fabsf(d[4 * g + 2]), w4.z, s0); s0 = __builtin_fmaf(__builtin_fabsf(d[4 * g + 3]), w4.w, s0); }
                    const unsigned short hb = __half_as_ushort(__float2half_rn(s0));
                    const unsigned short key = (hb & 0x8000u) ? (unsigned short)~hb : (unsigned short)(hb | 0x8000u);
                    sc[(2 * pr + hi) * 8192 + kpos] = key;
                }
            }
        }
        __syncthreads();
        const LAS unsigned* my = (const LAS unsigned*)(sc + C.wave * 8192);
        const int nit = nadm / 128;
        const bool tail = (nadm & 64) != 0;
        unsigned thr = 0;
        for (int rep_s = 0; rep_s < IDX_REP_S; ++rep_s) {
            unsigned want = 256u, prefix = 0u;
#pragma unroll 1
            for (int lvl = 0; lvl < 2; ++lvl) {
                hist[lane] = 0u; hist[64 + lane] = 0u; hist[128 + lane] = 0u; hist[192 + lane] = 0u;
                LDS_WAIT(); asm volatile("" ::: "memory");
                int i = 0;
                for (; i + 4 <= nit; i += 4) { unsigned kv[4];
#pragma unroll
                    for (int u = 0; u < 4; ++u) kv[u] = my[64 * (i + u) + lane];
#pragma unroll
                    for (int u = 0; u < 4; ++u) { const unsigned k0 = kv[u] & 0xffffu, k1 = kv[u] >> 16;
                        if (lvl == 0) { atomicAdd((unsigned*)&hist[k0 >> 8], 1u); atomicAdd((unsigned*)&hist[k1 >> 8], 1u); }
                        else { if ((k0 >> 8) == prefix) atomicAdd((unsigned*)&hist[k0 & 255u], 1u); if ((k1 >> 8) == prefix) atomicAdd((unsigned*)&hist[k1 & 255u], 1u); } } }
                for (; i < nit + (tail ? 1 : 0); ++i) { const unsigned kvv = my[64 * i + lane]; const unsigned k0 = kvv & 0xffffu, k1 = kvv >> 16; const bool two = i < nit;
                    if (lvl == 0) { atomicAdd((unsigned*)&hist[k0 >> 8], 1u); if (two) atomicAdd((unsigned*)&hist[k1 >> 8], 1u); }
                    else { if ((k0 >> 8) == prefix) atomicAdd((unsigned*)&hist[k0 & 255u], 1u); if (two && (k1 >> 8) == prefix) atomicAdd((unsigned*)&hist[k1 & 255u], 1u); } }
                LDS_WAIT(); asm volatile("" ::: "memory");
                const unsigned c0 = hist[4 * lane], c1 = hist[4 * lane + 1], c2 = hist[4 * lane + 2], c3 = hist[4 * lane + 3];
                const unsigned tl = c0 + c1 + c2 + c3; unsigned inc = tl;
#pragma unroll
                for (int o = 1; o < 64; o <<= 1) { const unsigned v = __shfl_down(inc, o); if (lane + o < 64) inc += v; }
                const unsigned ab3 = inc - tl, ab2 = ab3 + c3, ab1 = ab2 + c2, ab0 = ab1 + c1;
                int selb = -1; unsigned rem = 0;
                if (ab3 < want && ab3 + c3 >= want) { selb = 3; rem = want - ab3; }
                else if (ab2 < want && ab2 + c2 >= want) { selb = 2; rem = want - ab2; }
                else if (ab1 < want && ab1 + c1 >= want) { selb = 1; rem = want - ab1; }
                else if (ab0 < want && ab0 + c0 >= want) { selb = 0; rem = want - ab0; }
                const u64 bal = __ballot(selb >= 0); const int src = bal ? (int)__ffsll((long long)bal) - 1 : 0;
                const unsigned bin = (unsigned)__shfl(4 * lane + (selb < 0 ? 0 : selb), src); want = (unsigned)__shfl((int)rem, src);
                if (lvl == 0) prefix = bin; else thr = (prefix << 8) | bin;
                LDS_WAIT(); asm volatile("" ::: "memory");
            }
        }
        u64 w0 = 0, w1 = 0;
        for (int i = 0; i < nit + (tail ? 1 : 0); ++i) { const unsigned kvv = my[64 * i + lane]; const u64 b0 = __ballot((kvv & 0xffffu) >= thr), b1 = (i < nit) ? __ballot((kvv >> 16) >= thr) : 0ull;
            if (i < 32) { if (lane == 2 * i) w0 = b0; if (lane == 2 * i + 1) w0 = b1; } else { if (lane == 2 * i - 64) w1 = b0; if (lane == 2 * i - 63) w1 = b1; } }
        MASK[(size_t)qrow * 128 + lane] = w0; MASK[(size_t)qrow * 128 + 64 + lane] = w1;
        __syncthreads();
    }
}
constexpr int AT_KROW = 272, AT_VROW = 136, AT_KB = 64 * AT_KROW, AT_VB = 128 * AT_VROW, AT_BUF = AT_KB + AT_VB;
__device__ __forceinline__ void attn_unit(const Ctx& C, int b, int head, int qb) {
    const bf16* Q = (const bf16*)(C.ws + WS_Q); const bf16* K = (const bf16*)(C.ws + WS_K); const bf16* Vt = (const bf16*)(C.ws + WS_VT);
    const u64* MASK = (const u64*)(C.ws + WS_MASK); bf16* CAT = (bf16*)(C.ws + WS_CAT);
    const int tid = C.tid, lane = C.lane, wid = C.wave, r32 = lane & 31, hi = lane >> 5;
    const int q = 256 * qb + 32 * wid + r32; const size_t row = (size_t)b * T + q;
    const int nt = 4 * qb + 4, myc = 4 * qb + (wid >> 1);
    bf16x8 qf[8];
#pragma unroll
    for (int d0 = 0; d0 < 8; ++d0) qf[d0] = *(const bf16x8*)(Q + row * 1024 + head * 128 + 16 * d0 + 8 * hi);
    const bf16* kg[2]; const bf16* vg[2]; int kl[2], vl[2];
#pragma unroll
    for (int i = 0; i < 2; ++i) { const int c = tid + 512 * i;
        kg[i] = K + ((size_t)b * T + (c >> 4)) * 1024 + head * 128 + (c & 15) * 8; kl[i] = (c >> 4) * AT_KROW + (c & 15) * 16;
        vg[i] = Vt + ((size_t)(b * 8 + head) * 128 + (c >> 3)) * T + (c & 7) * 8; vl[i] = AT_KB + (c >> 3) * AT_VROW + (c & 7) * 16; }
    u32x4 kr[2], vr[2];
#pragma unroll
    for (int i = 0; i < 2; ++i) { kr[i] = *(const u32x4*)kg[i]; vr[i] = *(const u32x4*)vg[i]; }
#pragma unroll
    for (int i = 0; i < 2; ++i) { *(LAS u32x4*)(C.lds + kl[i]) = kr[i]; *(LAS u32x2*)(C.lds + vl[i]) = (u32x2){vr[i].x, vr[i].y}; *(LAS u32x2*)(C.lds + vl[i] + 8) = (u32x2){vr[i].z, vr[i].w}; }
    __syncthreads();
    float lrun = 0.f; f32x16 o[4];
#pragma unroll
    for (int db = 0; db < 4; ++db)
#pragma unroll
        for (int r = 0; r < 16; ++r) o[db][r] = 0.f;
    for (int t = 0; t < nt; ++t) {
        const int cur = (t & 1) * AT_BUF, nxt = ((t + 1) & 1) * AT_BUF;
        if (t + 1 < nt) {
#pragma unroll
            for (int i = 0; i < 2; ++i) { kr[i] = *(const u32x4*)(kg[i] + (size_t)(t + 1) * 64 * 1024); vr[i] = *(const u32x4*)(vg[i] + (t + 1) * 64); }
        }
        if (t <= myc) {
            const u64 mw = MASK[row * 128 + t];
            const LAS unsigned char* Ks = C.lds + cur; const LAS unsigned char* Vs = C.lds + cur + AT_KB;
            f32x16 p0, p1;
#pragma unroll
            for (int r = 0; r < 16; ++r) { p0[r] = 0.f; p1[r] = 0.f; }
#pragma unroll
            for (int d0 = 0; d0 < 8; ++d0) {
                const bf16x8 k0 = *(const LAS bf16x8*)(Ks + r32 * AT_KROW + (16 * d0 + 8 * hi) * 2);
                const bf16x8 k1 = *(const LAS bf16x8*)(Ks + (32 + r32) * AT_KROW + (16 * d0 + 8 * hi) * 2);
                p0 = __builtin_amdgcn_mfma_f32_32x32x16_bf16(k0, qf[d0], p0, 0, 0, 0);
                p1 = __builtin_amdgcn_mfma_f32_32x32x16_bf16(k1, qf[d0], p1, 0, 0, 0);
            }
            const int mlo = (int)((unsigned)mw >> (4 * hi)), mhi = (int)((unsigned)(mw >> 32) >> (4 * hi));
            float ls0 = 0.f, ls1 = 0.f;
#pragma unroll
            for (int r = 0; r < 16; ++r) { const int c = (r & 3) + 8 * (r >> 2);
                const unsigned e0 = __float_as_uint(__builtin_amdgcn_exp2f(p0[r])) & (unsigned)__builtin_amdgcn_sbfe(mlo, c, 1);
                const unsigned e1 = __float_as_uint(__builtin_amdgcn_exp2f(p1[r])) & (unsigned)__builtin_amdgcn_sbfe(mhi, c, 1);
                p0[r] = __uint_as_float(e0); p1[r] = __uint_as_float(e1); ls0 += p0[r]; ls1 += p1[r]; }
            lrun += ls0 + ls1;
            bf16x8 pb[4];
#pragma unroll
            for (int kk = 0; kk < 4; ++kk) { u32x4 w;
#pragma unroll
                for (int e = 0; e < 4; ++e) { const int r = 8 * (kk & 1) + 2 * e; w[e] = (kk < 2) ? pg8::cvt_pk_bf16(p0[r], p0[r + 1]) : pg8::cvt_pk_bf16(p1[r], p1[r + 1]); }
                pb[kk] = __builtin_bit_cast(bf16x8, w); }
#pragma unroll
            for (int db = 0; db < 4; ++db)
#pragma unroll
                for (int kk = 0; kk < 4; ++kk) {
                    const LAS unsigned char* vp = Vs + (32 * db + r32) * AT_VROW + (16 * kk + 4 * hi) * 2;
                    const u32x2 a0 = *(const LAS u32x2*)vp, a1 = *(const LAS u32x2*)(vp + 16);
                    const u32x4 w = {a0.x, a0.y, a1.x, a1.y};
                    o[db] = __builtin_amdgcn_mfma_f32_32x32x16_bf16(__builtin_bit_cast(bf16x8, w), pb[kk], o[db], 0, 0, 0);
                }
        }
        if (t + 1 < nt) {
#pragma unroll
            for (int i = 0; i < 2; ++i) { *(LAS u32x4*)(C.lds + nxt + kl[i]) = kr[i]; *(LAS u32x2*)(C.lds + nxt + vl[i]) = (u32x2){vr[i].x, vr[i].y}; *(LAS u32x2*)(C.lds + nxt + vl[i] + 8) = (u32x2){vr[i].z, vr[i].w}; }
        }
        __syncthreads();
    }
    lrun += __shfl_xor(lrun, 32);
    const float inv = 1.0f / lrun;
    bf16* op = CAT + row * 2048 + head * 128 + 4 * hi;
#pragma unroll
    for (int db = 0; db < 4; ++db)
#pragma unroll
        for (int g = 0; g < 4; ++g) { u32x2 w; w.x = pk2(o[db][4 * g] * inv, o[db][4 * g + 1] * inv); w.y = pk2(o[db][4 * g + 2] * inv, o[db][4 * g + 3] * inv);
            *(u32x2*)(op + 32 * db + 8 * g) = w; }
}
__device__ __forceinline__ void phase_attn(const Ctx& C) {
    for (int i = C.bid; i < 1024; i += C.G) {
        const int w = i & 255, k = i >> 8, combo = w >> 3, j = w & 7;
        const int qb = k == 0 ? j : k == 1 ? 15 - j : k == 2 ? 16 + j : 31 - j;
        attn_unit(C, combo >> 3, combo & 7, qb);
        __syncthreads();
    }
}
__device__ __forceinline__ float ret_logg(int h) { return log1pf(-exp2f(-5.0f - (float)h)); }
constexpr int RT_KP = 72, RT_VP = 136;
__device__ __forceinline__ bf16x8 lds_col8(const LAS bf16* p, int pitch, const int (&rows)[8]) {
    u32x4 w;
#pragma unroll
    for (int e = 0; e < 4; ++e) w[e] = (unsigned)p[rows[2 * e] * pitch] | ((unsigned)p[rows[2 * e + 1] * pitch] << 16);
    return __builtin_bit_cast(bf16x8, w);
}
__device__ __forceinline__ void phase_ret1(const Ctx& C) {
    LAS bf16* Ks = (LAS bf16*)C.lds;
    LAS bf16* Vs = Ks + 64 * RT_KP;
    const bf16* BK = (const bf16*)(C.ws + WS_BK); const bf16* BV = (const bf16*)(C.ws + WS_BV); float* KV = (float*)(C.ws + WS_KVST);
    const int tid = C.tid, lane = C.lane, r32 = lane & 31, hi = lane >> 5, db = C.wave >> 2, eb = C.wave & 3;
    for (int u = C.bid; u < NB * 128 * 4; u += C.G) {
        const int h = u & 3, c = (u >> 2) & 127, b = u >> 9; const size_t row0 = (size_t)b * T + 64 * c; const float lg = ret_logg(h);
        { const int m = tid >> 3, d8 = (tid & 7) * 8; const u32x4 w = *(const u32x4*)(BK + (row0 + m) * 256 + h * 64 + d8); const float z = __expf((63.0f - (float)m) * lg) * 0.125f;
          u32x4 o;
#pragma unroll
          for (int e = 0; e < 4; ++e) o[e] = pk2(bflo(w[e]) * z, bfhi(w[e]) * z);
          *(LAS u32x4*)(Ks + m * RT_KP + d8) = o; }
#pragma unroll
        for (int i = 0; i < 2; ++i) { const int cidx = tid + 512 * i, m = cidx >> 4, e8 = (cidx & 15) * 8; *(LAS u32x4*)(Vs + m * RT_VP + e8) = *(const u32x4*)(BV + (row0 + m) * 512 + h * 128 + e8); }
        __syncthreads();
        f32x16 acc;
#pragma unroll
        for (int r = 0; r < 16; ++r) acc[r] = 0.f;
#pragma unroll
        for (int kk = 0; kk < 4; ++kk) {
            int rows[8];
#pragma unroll
            for (int j = 0; j < 8; ++j) rows[j] = 16 * kk + 8 * hi + j;
            const bf16x8 af = lds_col8(Ks + 32 * db + r32, RT_KP, rows), bfv = lds_col8(Vs + 32 * eb + r32, RT_VP, rows);
            acc = __builtin_amdgcn_mfma_f32_32x32x16_bf16(af, bfv, acc, 0, 0, 0);
        }
        float* dst = KV + (size_t)u * 8192 + (size_t)(32 * eb + r32) * 64 + 32 * db + 4 * hi;
#pragma unroll
        for (int g = 0; g < 4; ++g) *(f32x4*)(dst + 8 * g) = (f32x4){acc[4 * g], acc[4 * g + 1], acc[4 * g + 2], acc[4 * g + 3]};
        __syncthreads();
    }
}
__device__ __forceinline__ void phase_ret2(const Ctx& C) {
    float* KV = (float*)(C.ws + WS_KVST);
    for (int g = C.bid * NTHR + C.tid; g < NB * 4 * 8192; g += C.G * NTHR) {
        const int el = g & 8191, h = (g >> 13) & 3, b = g >> 15; const float gc = __expf(64.0f * ret_logg(h));
        float* p = KV + ((size_t)b * 512 + h) * 8192 + el;
        float st = 0.f;
        for (int c0 = 0; c0 < 128; c0 += 8) { float x[8];
#pragma unroll
            for (int i = 0; i < 8; ++i) x[i] = p[(size_t)(c0 + i) * 4 * 8192];
#pragma unroll
            for (int i = 0; i < 8; ++i) { p[(size_t)(c0 + i) * 4 * 8192] = st; st = st * gc + x[i]; } }
    }
}
__device__ __forceinline__ void phase_ret3(const Ctx& C) {
    LAS bf16* Qs = (LAS bf16*)C.lds;
    LAS bf16* Ks = Qs + 64 * RT_KP;
    LAS bf16* Vs = Ks + 64 * RT_KP;
    LAS float* Red = (LAS float*)(Vs + 64 * RT_VP);
    const bf16* BQ = (const bf16*)(C.ws + WS_BQ); const bf16* BK = (const bf16*)(C.ws + WS_BK); const bf16* BV = (const bf16*)(C.ws + WS_BV); const bf16* BG = (const bf16*)(C.ws + WS_BG);
    const float* KV = (const float*)(C.ws + WS_KVST); bf16* CAT = (bf16*)(C.ws + WS_CAT);
    const int tid = C.tid, lane = C.lane, r32 = lane & 31, hi = lane >> 5, nb = C.wave >> 2, eb = C.wave & 3;
    for (int u = C.bid; u < NB * 128 * 4; u += C.G) {
        const int h = u & 3, c = (u >> 2) & 127, b = u >> 9; const size_t row0 = (size_t)b * T + 64 * c; const float l2g = ret_logg(h) * 1.4426950408889634f;
        { const int m = tid >> 3, d8 = (tid & 7) * 8; *(LAS u32x4*)(Qs + m * RT_KP + d8) = *(const u32x4*)(BQ + (row0 + m) * 256 + h * 64 + d8);
          const u32x4 w = *(const u32x4*)(BK + (row0 + m) * 256 + h * 64 + d8); u32x4 o;
#pragma unroll
          for (int e = 0; e < 4; ++e) o[e] = pk2(bflo(w[e]) * 0.125f, bfhi(w[e]) * 0.125f);
          *(LAS u32x4*)(Ks + m * RT_KP + d8) = o; }
#pragma unroll
        for (int i = 0; i < 2; ++i) { const int cidx = tid + 512 * i, m = cidx >> 4, e8 = (cidx & 15) * 8; *(LAS u32x4*)(Vs + m * RT_VP + e8) = *(const u32x4*)(BV + (row0 + m) * 512 + h * 128 + e8); }
        bf16x8 pf[4];
        { const float* pp = KV + (size_t)u * 8192 + (size_t)(32 * eb + r32) * 64 + 8 * hi;
#pragma unroll
          for (int kk = 0; kk < 4; ++kk) { const f32x4 a0 = *(const f32x4*)(pp + 16 * kk), a1 = *(const f32x4*)(pp + 16 * kk + 4);
              u32x4 w; w.x = pk2(a0.x, a0.y); w.y = pk2(a0.z, a0.w); w.z = pk2(a1.x, a1.y); w.w = pk2(a1.z, a1.w); pf[kk] = __builtin_bit_cast(bf16x8, w); } }
        __syncthreads();
        bf16x8 qf[4];
#pragma unroll
        for (int kk = 0; kk < 4; ++kk) qf[kk] = *(const LAS bf16x8*)(Qs + (32 * nb + r32) * RT_KP + 16 * kk + 8 * hi);
        f32x16 cr, out;
#pragma unroll
        for (int r = 0; r < 16; ++r) { cr[r] = 0.f; out[r] = 0.f; }
#pragma unroll
        for (int kk = 0; kk < 4; ++kk) cr = __builtin_amdgcn_mfma_f32_32x32x16_bf16(qf[kk], pf[kk], cr, 0, 0, 0);
        const float gn = __builtin_amdgcn_exp2f((float)(32 * nb + r32) * l2g);
#pragma unroll
        for (int mb = 0; mb < 2; ++mb) {
            if (mb > nb) continue;
            f32x16 st;
#pragma unroll
            for (int r = 0; r < 16; ++r) st[r] = 0.f;
#pragma unroll
            for (int kk = 0; kk < 4; ++kk) { const bf16x8 kf = *(const LAS bf16x8*)(Ks + (32 * mb + r32) * RT_KP + 16 * kk + 8 * hi); st = __builtin_amdgcn_mfma_f32_32x32x16_bf16(kf, qf[kk], st, 0, 0, 0); }
            const int nq = 32 * nb + r32;
#pragma unroll
            for (int r = 0; r < 16; ++r) { const int m = 32 * mb + (r & 3) + 8 * (r >> 2) + 4 * hi; st[r] = (m <= nq) ? st[r] * gn * __builtin_amdgcn_exp2f(-(float)m * l2g) : 0.f; }
#pragma unroll
            for (int s2 = 0; s2 < 2; ++s2) {
                u32x4 w;
#pragma unroll
                for (int e = 0; e < 4; ++e) w[e] = pg8::cvt_pk_bf16(st[8 * s2 + 2 * e], st[8 * s2 + 2 * e + 1]);
                int rows[8];
#pragma unroll
                for (int j = 0; j < 8; ++j) rows[j] = 32 * mb + 16 * s2 + 8 * (j >> 2) + 4 * hi + (j & 3);
                const bf16x8 vf = lds_col8(Vs + 32 * eb + r32, RT_VP, rows);
                out = __builtin_amdgcn_mfma_f32_32x32x16_bf16(__builtin_bit_cast(bf16x8, w), vf, out, 0, 0, 0);
            }
        }
        float sv[16], s2v[16];
#pragma unroll
        for (int r = 0; r < 16; ++r) { const int n = 32 * nb + (r & 3) + 8 * (r >> 2) + 4 * hi; out[r] += __builtin_amdgcn_exp2f((float)(n + 1) * l2g) * cr[r]; sv[r] = half_sum32(out[r]); s2v[r] = half_sum32(out[r] * out[r]); }
        if (r32 == 0) {
#pragma unroll
            for (int r = 0; r < 16; ++r) { const int n = 32 * nb + (r & 3) + 8 * (r >> 2) + 4 * hi; *(LAS f32x2*)(Red + (n * 4 + eb) * 2) = (f32x2){sv[r], s2v[r]}; }
        }
        __syncthreads();
#pragma unroll
        for (int r = 0; r < 16; ++r) { const int n = 32 * nb + (r & 3) + 8 * (r >> 2) + 4 * hi;
            const f32x4 p0 = *(const LAS f32x4*)(Red + n * 8), p1 = *(const LAS f32x4*)(Red + n * 8 + 4);
            const float mean = (p0.x + p0.z + p1.x + p1.z) * (1.0f / 128.0f), ex2 = (p0.y + p0.w + p1.y + p1.w) * (1.0f / 128.0f);
            const float rstd = rsqrtf(fmaxf(ex2 - mean * mean, 0.f) + 1e-5f);
            const float gg = bf2f(BG[(row0 + n) * 512 + h * 128 + 32 * eb + r32]); const float sl = gg * __builtin_amdgcn_rcpf(1.0f + __expf(-gg));
            CAT[(row0 + n) * 2048 + 1024 + h * 128 + 32 * eb + r32] = (bf16)f2bf((out[r] - mean) * rstd * sl); }
        __syncthreads();
    }
}
__device__ __forceinline__ float sigmoidf_(float x) { return __builtin_amdgcn_rcpf(1.0f + __expf(-x)); }
constexpr int RW_AW = 104, RW_AV = 72, RW_AG = 264;
constexpr int RW1_BUF = 32 * RW_AW * 2 + 32 * RW_AV;
struct RwP { const float *mu, *mu_v, *w0, *a0, *v0, *k_k, *k_a, *r_k, *lnx_g, *lnx_b; };
template <class TT> __device__ __forceinline__ GAS TT* opaque_g(const TT* p) {
    unsigned lo = (unsigned)(uintptr_t)p, hi = (unsigned)((uintptr_t)p >> 32); asm volatile("" : "+v"(lo), "+v"(hi));
    lo = __builtin_amdgcn_readfirstlane(lo); hi = __builtin_amdgcn_readfirstlane(hi); return (GAS TT*)(((uintptr_t)hi << 32) | lo);
}
__device__ __forceinline__ int tokr(int r, int hi) { return (r & 3) + 8 * (r >> 2) + 4 * hi; }
template <class TT> __device__ __forceinline__ GAS TT* at_b(GAS TT* ub, unsigned boff) { return (GAS TT*)((GAS char*)ub + boff); }
__device__ __forceinline__ void shifted16(GAS bf16* ub, const unsigned (&off)[16], int cbo, bool first_unit, int hi, float mu, float (&x)[16]) {
    float cur[16], prv[4];
#pragma unroll
    for (int r = 0; r < 16; ++r) cur[r] = bf2f(at_b(ub, off[r])[cbo]);
#pragma unroll
    for (int g = 0; g < 4; ++g) { const bool first = (g == 0) && (hi == 0) && first_unit; prv[g] = first ? 0.f : bf2f(at_b(ub, off[4 * g])[cbo - 512]); }
#pragma unroll
    for (int r = 0; r < 16; ++r) { const float p = (r & 3) == 0 ? prv[r >> 2] : cur[r - 1]; x[r] = cur[r] + (p - cur[r]) * mu; }
}
__device__ __forceinline__ void phase_rw1(const Ctx& C, int layer, const RwP& P) {
    LAS bf16* ACT = (LAS bf16*)C.lds;
    const bf16* CR = (const bf16*)(C.ws + WS_CR); const bf16* CK = (const bf16*)(C.ws + WS_CK); const bf16* CV = (const bf16*)(C.ws + WS_CV); const bf16* CL = (const bf16*)(C.ws + WS_CL);
    const bf16* LW = (const bf16*)(C.ws + WS_LORA + LO_W); const bf16* LA = (const bf16*)(C.ws + WS_LORA + LO_A); const bf16* LV = (const bf16*)(C.ws + WS_LORA + LO_V);
    bf16* VF = (bf16*)(C.ws + WS_VFIRST);
    bf16* RR = (bf16*)(C.ws + WS_RR); bf16* RU = (bf16*)(C.ws + WS_RW); bf16* RKH = (bf16*)(C.ws + WS_RKH); bf16* RV = (bf16*)(C.ws + WS_RV); bf16* RA = (bf16*)(C.ws + WS_RA); bf16* RB = (bf16*)(C.ws + WS_RB);
    const float* mu = P.mu + (size_t)layer * 1984; const float* mu_v = P.mu_v;
    const float* w0 = P.w0 + layer * 512; const float* a0 = P.a0 + layer * 512; const float* v0 = P.v0; const float* k_k = P.k_k + layer * 512; const float* k_a = P.k_a + layer * 512;
    const int tid = C.tid, lane = C.lane, wid = C.wave;
    constexpr int NU = M / 32;
    u32x4 ncur[2], nprv[2];
#define RW1_LOAD(uu) do { _Pragma("unroll") for (int j = 0; j < 2; ++j) { const int ci = tid + 512 * j, tok = ci >> 5, c8 = (ci & 31) * 8; const size_t mm = (size_t)(uu) * 32 + tok; \
        ncur[j] = *(const u32x4*)(CL + mm * 256 + c8); const u32x4 z4 = {0u, 0u, 0u, 0u}; nprv[j] = (mm & (T - 1)) == 0 ? z4 : *(const u32x4*)(CL + (mm - 1) * 256 + c8); } } while (0)
#define RW1_STORE(bufi) do { _Pragma("unroll") for (int j = 0; j < 2; ++j) { const int ci = tid + 512 * j, tok = ci >> 5, c8 = (ci & 31) * 8; \
        const float* mp = c8 < 192 ? mu + 1536 + c8 : mu_v + (c8 - 192); f32x4 m0v = {0.f, 0.f, 0.f, 0.f}, m1v = m0v; if (c8 < 192 || layer > 0) { m0v = *(const f32x4*)mp; m1v = *(const f32x4*)(mp + 4); } \
        float xs[8]; _Pragma("unroll") for (int e = 0; e < 4; ++e) { const float c0 = bflo(ncur[j][e]), c1 = bfhi(ncur[j][e]), p0 = bflo(nprv[j][e]), p1 = bfhi(nprv[j][e]); \
            const float ma = e < 2 ? m0v[2 * e] : m1v[2 * e - 4], mb = e < 2 ? m0v[2 * e + 1] : m1v[2 * e - 3]; xs[2 * e] = c0 + (p0 - c0) * ma; xs[2 * e + 1] = c1 + (p1 - c1) * mb; } \
        if (c8 < 96) { _Pragma("unroll") for (int e = 0; e < 8; ++e) xs[e] = 1.0f - 2.0f * __builtin_amdgcn_rcpf(__expf(2.0f * xs[e]) + 1.0f); }     \
        u32x4 o; o.x = pk2(xs[0], xs[1]); o.y = pk2(xs[2], xs[3]); o.z = pk2(xs[4], xs[5]); o.w = pk2(xs[6], xs[7]); \
        LAS bf16* dst = ACT + (bufi) * RW1_BUF + (c8 < 96 ? tok * RW_AW + c8 : c8 < 192 ? 32 * RW_AW + tok * RW_AW + (c8 - 96) : 64 * RW_AW + tok * RW_AV + (c8 - 192)); \
        *(LAS u32x4*)dst = o; } } while (0)
    int u = C.bid; if (u >= NU) return;
    RW1_LOAD(u); RW1_STORE(0); __syncthreads();
    for (int kbuf = 0; ; kbuf ^= 1) {
        const int un = u + C.G; const bool has_next = un < NU;
        if (has_next) RW1_LOAD(un);
        {
            int r32 = lane & 31, hi = lane >> 5; asm volatile("" : "+v"(r32), "+v"(hi));
            const size_t m0 = (size_t)u * 32; const bool first_unit = (m0 & (T - 1)) == 0;
            const LAS bf16* AW = ACT + kbuf * RW1_BUF; const LAS bf16* AA = AW + 32 * RW_AW; const LAS bf16* AV = AA + 32 * RW_AW;
            unsigned off[16];
#pragma unroll
            for (int r = 0; r < 16; ++r) off[r] = (unsigned)(tokr(r, hi) * 512 + 64 * wid + r32) * 2u;
            GAS bf16* CRu = opaque_g(CR + m0 * 512); GAS bf16* CKu = opaque_g(CK + m0 * 512); GAS bf16* CVu = opaque_g(CV + m0 * 512); GAS bf16* VFu = opaque_g(VF + m0 * 512);
            GAS bf16* RRu = opaque_g(RR + m0 * 512); GAS bf16* RUu = opaque_g(RU + m0 * 512); GAS bf16* RKHu = opaque_g(RKH + m0 * 512); GAS bf16* RVu = opaque_g(RV + m0 * 512); GAS bf16* RAu = opaque_g(RA + m0 * 512); GAS bf16* RBu = opaque_g(RB + m0 * 512);
            float ks[2][16], inv[16];
            {
                float ssr[16];
#pragma unroll
                for (int r = 0; r < 16; ++r) ssr[r] = 0.f;
#pragma unroll
                for (int cb = 0; cb < 2; ++cb) { const int c = 64 * wid + 32 * cb + r32; const float kkc = k_k[c]; shifted16(CKu, off, 32 * cb, first_unit, hi, mu[512 + c], ks[cb]);
#pragma unroll
                    for (int r = 0; r < 16; ++r) { const float kr = ks[cb][r] * kkc; ssr[r] += kr * kr; } }
#pragma unroll
                for (int r = 0; r < 16; ++r) inv[r] = 1.0f / fmaxf(sqrtf(half_sum32(ssr[r])), 1e-12f);
            }
#pragma unroll
            for (int cb = 0; cb < 2; ++cb) {
                const int c = 64 * wid + 32 * cb + r32; const int ci = 32 * cb;
                asm volatile("" : "+v"(off[0]), "+v"(off[1]), "+v"(off[2]), "+v"(off[3]), "+v"(off[4]), "+v"(off[5]), "+v"(off[6]), "+v"(off[7]), "+v"(off[8]), "+v"(off[9]), "+v"(off[10]), "+v"(off[11]), "+v"(off[12]), "+v"(off[13]), "+v"(off[14]), "+v"(off[15]));
                {
                    float rs[16]; shifted16(CRu, off, ci, first_unit, hi, mu[c], rs);
#pragma unroll
                    for (int r = 0; r < 16; ++r) at_b(RRu, off[r])[ci] = (bf16)f2bf(rs[r]);
                }
                asm volatile("" ::: "memory");
                {
                    float vs[16]; shifted16(CVu, off, ci, first_unit, hi, mu[1024 + c], vs);
                    if (layer > 0) {
                        f32x16 dv;
#pragma unroll
                        for (int r = 0; r < 16; ++r) dv[r] = 0.f;
#pragma unroll
                        for (int kk = 0; kk < 4; ++kk) { const bf16x8 wv = *(const bf16x8*)(LV + c * 64 + 16 * kk + 8 * hi); const bf16x8 xv = *(const LAS bf16x8*)(AV + r32 * RW_AV + 16 * kk + 8 * hi);
                            dv = __builtin_amdgcn_mfma_f32_32x32x16_bf16(xv, wv, dv, 0, 0, 0); }
                        const float v0c = v0[c];
#pragma unroll
                        for (int r = 0; r < 16; ++r) { const float vf = bf2f(at_b(VFu, off[r])[ci]); at_b(RVu, off[r])[ci] = (bf16)f2bf(vs[r] + (vf - vs[r]) * sigmoidf_(v0c + dv[r])); }
                    } else {
#pragma unroll
                        for (int r = 0; r < 16; ++r) { const bf16 vb = (bf16)f2bf(vs[r]); at_b(VFu, off[r])[ci] = vb; at_b(RVu, off[r])[ci] = vb; }
                    }
                }
                asm volatile("" ::: "memory");
                {
                    f32x16 dw;
#pragma unroll
                    for (int r = 0; r < 16; ++r) dw[r] = 0.f;
#pragma unroll
                    for (int kk = 0; kk < 6; ++kk) { const bf16x8 ww = *(const bf16x8*)(LW + c * 96 + 16 * kk + 8 * hi); const bf16x8 xw = *(const LAS bf16x8*)(AW + r32 * RW_AW + 16 * kk + 8 * hi);
                        dw = __builtin_amdgcn_mfma_f32_32x32x16_bf16(xw, ww, dw, 0, 0, 0); }
                    const float w0c = w0[c];
#pragma unroll
                    for (int r = 0; r < 16; ++r) { const float z = -(w0c + dw[r]); const float sp = fmaxf(z, 0.f) + __logf(1.0f + __expf(-fabsf(z)));
                        at_b(RUu, off[r])[ci] = (bf16)f2bf(1.0f - __expf(-__expf(-sp - 0.5f))); }
                }
                asm volatile("" ::: "memory");
                {
                    f32x16 da;
#pragma unroll
                    for (int r = 0; r < 16; ++r) da[r] = 0.f;
#pragma unroll
                    for (int kk = 0; kk < 6; ++kk) { const bf16x8 wa = *(const bf16x8*)(LA + c * 96 + 16 * kk + 8 * hi); const bf16x8 xa = *(const LAS bf16x8*)(AA + r32 * RW_AW + 16 * kk + 8 * hi);
                        da = __builtin_amdgcn_mfma_f32_32x32x16_bf16(xa, wa, da, 0, 0, 0); }
                    const float a0c = a0[c], kkc = k_k[c], kac = k_a[c];
#pragma unroll
                    for (int r = 0; r < 16; ++r) { const float a = sigmoidf_(a0c + da[r]); const float ksx = ks[cb][r]; const float kk = ksx * kkc * inv[r];
                        at_b(RKHu, off[r])[ci] = (bf16)f2bf(ksx * (1.0f + (a - 1.0f) * kac)); at_b(RAu, off[r])[ci] = (bf16)f2bf(-kk); at_b(RBu, off[r])[ci] = (bf16)f2bf(kk * a); }
                }
                asm volatile("" ::: "memory");
            }
        }
        if (has_next) RW1_STORE(kbuf ^ 1);
        __syncthreads();
        if (!has_next) break;
        u = un;
    }
#undef RW1_LOAD
#undef RW1_STORE
}
constexpr int RW_L = 128, RW_NC = T / RW_L;
constexpr int RW_TB = 8, RW_STG = 5 * RW_TB * 64 + 64;
__device__ __forceinline__ float xhalf_sum(float x) { const auto rr = __builtin_amdgcn_permlane32_swap(__float_as_uint(x), __float_as_uint(x), false, false); return __uint_as_float(rr[0]) + __uint_as_float(rr[1]); }
__device__ __forceinline__ float dot32(const f32x16& d0, const f32x16& d1, const f32x4 (&v)[2][4]) {
    f32x2 acc = {0.f, 0.f};
#pragma unroll
    for (int g = 0; g < 4; ++g) { acc += (f32x2){d0[4 * g], d0[4 * g + 1]} * (f32x2){v[0][g].x, v[0][g].y}; acc += (f32x2){d0[4 * g + 2], d0[4 * g + 3]} * (f32x2){v[0][g].z, v[0][g].w};
        acc += (f32x2){d1[4 * g], d1[4 * g + 1]} * (f32x2){v[1][g].x, v[1][g].y}; acc += (f32x2){d1[4 * g + 2], d1[4 * g + 3]} * (f32x2){v[1][g].z, v[1][g].w}; }
    return acc.x + acc.y;
}
template <int NS, bool OUT>
__device__ __forceinline__ void rwkv_chunk(f32x16 (&D)[NS][2][2], LAS float* stg, const bf16* RWd, const bf16* RA, const bf16* RB, const bf16* RKH, const bf16* RV, const bf16* RR, float* Y, size_t base0, int nsteps, int lane) {
    const int r32 = lane & 31, hi = lane >> 5;
    unsigned short qw[RW_TB], qa[RW_TB], qr[RW_TB], qb[RW_TB], qk[RW_TB], qv[RW_TB];
#define RWC_LOAD(tt) do { _Pragma("unroll") for (int s = 0; s < RW_TB; ++s) { const size_t o = base0 + (size_t)((tt) + s) * 512 + lane; qw[s] = RWd[o]; qa[s] = RA[o]; if (OUT) qr[s] = RR[o]; qb[s] = RB[o]; qk[s] = RKH[o]; qv[s] = RV[o]; } } while (0)
    RWC_LOAD(0);
    float G = 1.0f;
    for (int t0 = 0; t0 < nsteps; t0 += RW_TB) {
#pragma unroll
        for (int s = 0; s < RW_TB; ++s) { const float w = 1.0f - bf2f(qw[s]); stg[(0 * RW_TB + s) * 64 + lane] = bf2f(qa[s]) * G; G *= w; const float ig = __builtin_amdgcn_rcpf(G);
            if (OUT) stg[(1 * RW_TB + s) * 64 + lane] = bf2f(qr[s]) * G; stg[(2 * RW_TB + s) * 64 + lane] = bf2f(qb[s]) * ig; stg[(3 * RW_TB + s) * 64 + lane] = bf2f(qk[s]) * ig; stg[(4 * RW_TB + s) * 64 + lane] = bf2f(qv[s]); }
        if (t0 + RW_TB < nsteps) RWC_LOAD(t0 + RW_TB);
        LDS_WAIT(); asm volatile("" ::: "memory");
#pragma unroll 1
        for (int s = 0; s < RW_TB; ++s) {
            const LAS float* sa_ = stg + (0 * RW_TB + s) * 64 + 4 * hi; const LAS float* sr = stg + (1 * RW_TB + s) * 64 + 4 * hi;
            const LAS float* sbk = stg + ((hi ? 3 : 2) * RW_TB + s) * 64 + r32; const LAS float* sv = stg + (4 * RW_TB + s) * 64 + r32;
            const float bk0 = sbk[0], bk1 = sbk[32], v0 = sv[0], v1 = sv[32];
            float sav[NS][2];
            {
                f32x4 av[2][4];
#pragma unroll
                for (int jb = 0; jb < 2; ++jb)
#pragma unroll
                    for (int g = 0; g < 4; ++g) av[jb][g] = *(const LAS f32x4*)(sa_ + 32 * jb + 8 * g);
#pragma unroll
                for (int st = 0; st < NS; ++st)
#pragma unroll
                    for (int ib = 0; ib < 2; ++ib) sav[st][ib] = xhalf_sum(dot32(D[st][0][ib], D[st][1][ib], av));
            }
#pragma unroll
            for (int st = 0; st < NS; ++st) {
                const bool inject = (NS == 1) || (st == 1);
#pragma unroll
                for (int jb = 0; jb < 2; ++jb) { const float bkj = jb == 0 ? bk0 : bk1; const float A = inject ? bkj : (hi ? 0.f : bkj);
#pragma unroll
                    for (int ib = 0; ib < 2; ++ib) { const float B = hi ? (ib == 0 ? v0 : v1) : sav[st][ib];
                        D[st][jb][ib] = __builtin_amdgcn_mfma_f32_32x32x2f32(A, B, D[st][jb][ib], 0, 0, 0); } }
            }
            if (OUT) {
                f32x4 rv[2][4];
#pragma unroll
                for (int jb = 0; jb < 2; ++jb)
#pragma unroll
                    for (int g = 0; g < 4; ++g) rv[jb][g] = *(const LAS f32x4*)(sr + 32 * jb + 8 * g);
#pragma unroll
                for (int ib = 0; ib < 2; ++ib) { const float y = xhalf_sum(dot32(D[NS - 1][0][ib], D[NS - 1][1][ib], rv));
                    if (hi == 0) Y[base0 + (size_t)(t0 + s) * 512 + 32 * ib + r32] = y; }
            }
        }
        LDS_WAIT(); asm volatile("" ::: "memory");
    }
#undef RWC_LOAD
    stg[5 * RW_TB * 64 + lane] = G;
    LDS_WAIT(); asm volatile("" ::: "memory");
    {
        f32x4 gv[2][4];
#pragma unroll
        for (int jb = 0; jb < 2; ++jb)
#pragma unroll
            for (int g = 0; g < 4; ++g) gv[jb][g] = *(const LAS f32x4*)(stg + 5 * RW_TB * 64 + 4 * hi + 32 * jb + 8 * g);
#pragma unroll
        for (int st = 0; st < NS; ++st)
#pragma unroll
            for (int jb = 0; jb < 2; ++jb)
#pragma unroll
                for (int ib = 0; ib < 2; ++ib)
#pragma unroll
                    for (int g = 0; g < 4; ++g) { f32x16& d = D[st][jb][ib]; d[4 * g] *= gv[jb][g].x; d[4 * g + 1] *= gv[jb][g].y; d[4 * g + 2] *= gv[jb][g].z; d[4 * g + 3] *= gv[jb][g].w; }
    }
    LDS_WAIT(); asm volatile("" ::: "memory");
}
__device__ __forceinline__ void phase_rw2(const Ctx& C) {
    const bf16* RWd = (const bf16*)(C.ws + WS_RW); const bf16* RA = (const bf16*)(C.ws + WS_RA); const bf16* RB = (const bf16*)(C.ws + WS_RB); const bf16* RKH = (const bf16*)(C.ws + WS_RKH); const bf16* RV = (const bf16*)(C.ws + WS_RV);
    float* PHI = (float*)(C.ws + WS_PHI); float* PSI = (float*)(C.ws + WS_PSI);
    LAS float* stg = (LAS float*)C.lds + C.wave * RW_STG;
    const int ntask = NB * 8 * RW_NC, r32 = C.lane & 31, hi = C.lane >> 5;
    for (int task = C.wave * C.G + C.bid; task < ntask; task += C.G * NWAVES) {
        const int ck = task % RW_NC, bh = task / RW_NC, h = bh & 7, b = bh >> 3;
        const size_t base0 = ((size_t)b * T + (size_t)ck * RW_L) * 512 + h * 64;
        f32x16 D[2][2][2];
#pragma unroll
        for (int jb = 0; jb < 2; ++jb)
#pragma unroll
            for (int ib = 0; ib < 2; ++ib)
#pragma unroll
                for (int r = 0; r < 16; ++r) { D[0][jb][ib][r] = (jb == ib && ((r & 3) + 8 * (r >> 2) + 4 * hi) == r32) ? 1.f : 0.f; D[1][jb][ib][r] = 0.f; }
        rwkv_chunk<2, false>(D, stg, RWd, RA, RB, RKH, RV, nullptr, nullptr, base0, RW_L, C.lane);
#pragma unroll
        for (int st = 0; st < 2; ++st) { float* dst = (st == 0 ? PHI : PSI) + (size_t)task * 4096;
#pragma unroll
            for (int jb = 0; jb < 2; ++jb)
#pragma unroll
                for (int ib = 0; ib < 2; ++ib)
#pragma unroll
                    for (int g = 0; g < 4; ++g) *(f32x4*)(dst + (32 * ib + r32) * 64 + 32 * jb + 8 * g + 4 * hi) = (f32x4){D[st][jb][ib][4 * g], D[st][jb][ib][4 * g + 1], D[st][jb][ib][4 * g + 2], D[st][jb][ib][4 * g + 3]}; }
    }
}
constexpr int R3_P = 65;
__device__ __forceinline__ void phase_rw3(const Ctx& C) {
    const float* PHI = (const float*)(C.ws + WS_PHI); const float* PSI = (const float*)(C.ws + WS_PSI); float* SST = (float*)(C.ws + WS_SST);
    const int half = C.wave >> 2, w4 = C.wave & 3, ibo = w4 >> 1, kb = w4 & 1, r32 = C.lane & 31, hi = C.lane >> 5;
    LAS float* Sl = (LAS float*)C.lds + half * (2 * 64 * R3_P);
    for (int pr = C.bid; pr < NB * 8 / 2; pr += C.G) {
        const int bh = 2 * pr + half;
        f32x16 acc;
#pragma unroll
        for (int r = 0; r < 16; ++r) acc[r] = 0.f;
        float ph[32], psn[16];
#define R3_LOAD(tk) do { _Pragma("unroll") for (int s = 0; s < 32; ++s) ph[s] = PHI[(tk) * 4096 + (2 * s + hi) * 64 + 32 * kb + r32]; \
        _Pragma("unroll") for (int r = 0; r < 16; ++r) psn[r] = PSI[(tk) * 4096 + (32 * ibo + (r & 3) + 8 * (r >> 2) + 4 * hi) * 64 + 32 * kb + r32]; } while (0)
        R3_LOAD((size_t)bh * RW_NC);
        for (int ck = 0; ck < RW_NC; ++ck) {
            const size_t task = (size_t)bh * RW_NC + ck; LAS float* Sb = Sl + (ck & 1) * (64 * R3_P);
            float* dst = SST + task * 4096;
#pragma unroll
            for (int r = 0; r < 16; ++r) { const int i = 32 * ibo + (r & 3) + 8 * (r >> 2) + 4 * hi; dst[i * 64 + 32 * kb + r32] = acc[r]; Sb[i * R3_P + 32 * kb + r32] = acc[r]; }
            if (ck + 1 == RW_NC) break;
            float pc[32];
#pragma unroll
            for (int s = 0; s < 32; ++s) pc[s] = ph[s];
#pragma unroll
            for (int r = 0; r < 16; ++r) acc[r] = psn[r];
            if (ck + 2 < RW_NC) R3_LOAD(task + 1);
            __syncthreads();
#pragma unroll
            for (int s = 0; s < 32; ++s) { const float a = Sb[(32 * ibo + r32) * R3_P + 2 * s + hi]; acc = __builtin_amdgcn_mfma_f32_32x32x2f32(a, pc[s], acc, 0, 0, 0); }
        }
#undef R3_LOAD
        __syncthreads();
    }
}
__device__ __forceinline__ void phase_rw4(const Ctx& C) {
    const bf16* RWd = (const bf16*)(C.ws + WS_RW); const bf16* RA = (const bf16*)(C.ws + WS_RA); const bf16* RB = (const bf16*)(C.ws + WS_RB); const bf16* RKH = (const bf16*)(C.ws + WS_RKH); const bf16* RV = (const bf16*)(C.ws + WS_RV); const bf16* RR = (const bf16*)(C.ws + WS_RR);
    const float* SST = (const float*)(C.ws + WS_SST); float* Y = (float*)(C.ws + WS_Y);
    LAS float* stg = (LAS float*)C.lds + C.wave * RW_STG;
    const int ntask = NB * 8 * RW_NC, r32 = C.lane & 31, hi = C.lane >> 5;
    for (int task = C.wave * C.G + C.bid; task < ntask; task += C.G * NWAVES) {
        const int ck = task % RW_NC, bh = task / RW_NC, h = bh & 7, b = bh >> 3;
        const size_t base0 = ((size_t)b * T + (size_t)ck * RW_L) * 512 + h * 64;
        f32x16 D[1][2][2]; const float* src = SST + (size_t)task * 4096;
#pragma unroll
        for (int jb = 0; jb < 2; ++jb)
#pragma unroll
            for (int ib = 0; ib < 2; ++ib)
#pragma unroll
                for (int g = 0; g < 4; ++g) { const f32x4 v = *(const f32x4*)(src + (32 * ib + r32) * 64 + 32 * jb + 8 * g + 4 * hi); D[0][jb][ib][4 * g] = v.x; D[0][jb][ib][4 * g + 1] = v.y; D[0][jb][ib][4 * g + 2] = v.z; D[0][jb][ib][4 * g + 3] = v.w; }
        rwkv_chunk<1, true>(D, stg, RWd, RA, RB, RKH, RV, RR, Y, base0, RW_L, C.lane);
    }
}
__device__ __forceinline__ void phase_rw5(const Ctx& C, int layer, const RwP& P) {
    LAS bf16* ACT = (LAS bf16*)C.lds;
    const bf16* CG = (const bf16*)(C.ws + WS_CG); const bf16* LG = (const bf16*)(C.ws + WS_LORA + LO_G);
    const float* Y = (const float*)(C.ws + WS_Y); const bf16* RR = (const bf16*)(C.ws + WS_RR); const bf16* RKH = (const bf16*)(C.ws + WS_RKH); const bf16* RV = (const bf16*)(C.ws + WS_RV);
    bf16* CAT = (bf16*)(C.ws + WS_CAT);
    const float* mu = P.mu + (size_t)layer * 1984 + 1728; const float* r_k = P.r_k + layer * 512; const float* lnx_g = P.lnx_g + layer * 512; const float* lnx_b = P.lnx_b + layer * 512;
    const int tid = C.tid, lane = C.lane, wid = C.wave;
    constexpr int NU = M / 32;
    u32x4 ncur[2], nprv[2];
#define RW5_LOAD(uu) do { _Pragma("unroll") for (int j = 0; j < 2; ++j) { const int ci = tid + 512 * j, tok = ci >> 5, c8 = (ci & 31) * 8; const size_t mm = (size_t)(uu) * 32 + tok; \
        ncur[j] = *(const u32x4*)(CG + mm * 256 + c8); const u32x4 z4 = {0u, 0u, 0u, 0u}; nprv[j] = (mm & (T - 1)) == 0 ? z4 : *(const u32x4*)(CG + (mm - 1) * 256 + c8); } } while (0)
#define RW5_STORE(bufi) do { _Pragma("unroll") for (int j = 0; j < 2; ++j) { const int ci = tid + 512 * j, tok = ci >> 5, c8 = (ci & 31) * 8; \
        const f32x4 m0v = *(const f32x4*)(mu + c8), m1v = *(const f32x4*)(mu + c8 + 4); \
        float xs[8]; _Pragma("unroll") for (int e = 0; e < 4; ++e) { const float c0 = bflo(ncur[j][e]), c1 = bfhi(ncur[j][e]), p0 = bflo(nprv[j][e]), p1 = bfhi(nprv[j][e]); \
            const float ma = e < 2 ? m0v[2 * e] : m1v[2 * e - 4], mb = e < 2 ? m0v[2 * e + 1] : m1v[2 * e - 3]; xs[2 * e] = sigmoidf_(c0 + (p0 - c0) * ma); xs[2 * e + 1] = sigmoidf_(c1 + (p1 - c1) * mb); } \
        u32x4 o; o.x = pk2(xs[0], xs[1]); o.y = pk2(xs[2], xs[3]); o.z = pk2(xs[4], xs[5]); o.w = pk2(xs[6], xs[7]); \
        *(LAS u32x4*)(ACT + (bufi) * (32 * RW_AG) + tok * RW_AG + c8) = o; } } while (0)
    int u = C.bid; if (u >= NU) return;
    RW5_LOAD(u); RW5_STORE(0); __syncthreads();
    for (int kbuf = 0; ; kbuf ^= 1) {
        const int un = u + C.G; const bool has_next = un < NU;
        if (has_next) RW5_LOAD(un);
        {
            int r32 = lane & 31, hi = lane >> 5; asm volatile("" : "+v"(r32), "+v"(hi));
            const size_t m0 = (size_t)u * 32; const LAS bf16* AG = ACT + kbuf * (32 * RW_AG);
            unsigned off[16];
#pragma unroll
            for (int r = 0; r < 16; ++r) off[r] = (unsigned)(tokr(r, hi) * 512 + 64 * wid + r32) * 2u;
            GAS float* Yu = opaque_g(Y + m0 * 512); GAS bf16* RRu = opaque_g(RR + m0 * 512); GAS bf16* RKHu = opaque_g(RKH + m0 * 512); GAS bf16* RVu = opaque_g(RV + m0 * 512); GAS bf16* CATu = opaque_g(CAT + m0 * 2048 + 1536);
            float yv[2][16], sy[16], sq[16], sb[16];
#pragma unroll
            for (int r = 0; r < 16; ++r) { sy[r] = 0.f; sq[r] = 0.f; sb[r] = 0.f; }
#pragma unroll
            for (int cb = 0; cb < 2; ++cb) { const int c = 64 * wid + 32 * cb + r32; const float rkc = r_k[c];
                asm volatile("" : "+v"(off[0]), "+v"(off[1]), "+v"(off[2]), "+v"(off[3]), "+v"(off[4]), "+v"(off[5]), "+v"(off[6]), "+v"(off[7]), "+v"(off[8]), "+v"(off[9]), "+v"(off[10]), "+v"(off[11]), "+v"(off[12]), "+v"(off[13]), "+v"(off[14]), "+v"(off[15]));
#pragma unroll
                for (int r = 0; r < 16; ++r) { const unsigned o = off[r]; const int ci = 32 * cb; const float y = at_b(Yu, 2u * o)[ci]; yv[cb][r] = y; sy[r] += y; sq[r] += y * y; sb[r] += bf2f(at_b(RRu, o)[ci]) * bf2f(at_b(RKHu, o)[ci]) * rkc; } }
#pragma unroll
            for (int r = 0; r < 16; ++r) { const float mean = half_sum32(sy[r]) * (1.0f / 64.0f); const float ex2 = half_sum32(sq[r]) * (1.0f / 64.0f); sb[r] = half_sum32(sb[r]);
                sy[r] = mean; sq[r] = rsqrtf(fmaxf(ex2 - mean * mean, 0.f) + 64e-5f); }
#pragma unroll
            for (int cb = 0; cb < 2; ++cb) { const int c = 64 * wid + 32 * cb + r32;
                f32x16 dg;
#pragma unroll
                for (int r = 0; r < 16; ++r) dg[r] = 0.f;
#pragma unroll
                for (int kk = 0; kk < 16; ++kk) { const bf16x8 wg = *(const bf16x8*)(LG + c * 256 + 16 * kk + 8 * hi); const bf16x8 xg = *(const LAS bf16x8*)(AG + r32 * RW_AG + 16 * kk + 8 * hi);
                    dg = __builtin_amdgcn_mfma_f32_32x32x16_bf16(xg, wg, dg, 0, 0, 0); }
                const float lgc = lnx_g[c], lbc = lnx_b[c];
#pragma unroll
                for (int r = 0; r < 16; ++r) { const unsigned o = off[r]; const int ci = 32 * cb; const float v = bf2f(at_b(RVu, o)[ci]);
                    at_b(CATu, (unsigned)(tokr(r, hi) * 2048 + 64 * wid + r32) * 2u)[ci] = (bf16)f2bf(((yv[cb][r] - sy[r]) * sq[r] * lgc + lbc + sb[r] * v) * dg[r]); }
            }
        }
        if (has_next) RW5_STORE(kbuf ^ 1);
        __syncthreads();
        if (!has_next) break;
        u = un;
    }
#undef RW5_LOAD
#undef RW5_STORE
}
__device__ __forceinline__ void* launder_ptr(const void* p) {
    unsigned lo = (unsigned)(uintptr_t)p, hi = (unsigned)((uintptr_t)p >> 32); asm volatile("" : "+v"(lo), "+v"(hi));
    lo = __builtin_amdgcn_readfirstlane(lo); hi = __builtin_amdgcn_readfirstlane(hi); return (void*)(((uintptr_t)hi << 32) | lo);
}
#ifndef MK_PER_PHASE
#define MK_PER_PHASE 0
#endif
constexpr int PH_PER_LAYER = 13, N_PHASES = DEPTH * PH_PER_LAYER + 1;
struct Args { const float* in[23]; float* out; unsigned char* ws; int ph_lo, ph_hi; };
#define FRESH() do { KA = (const CAS Args*)launder_ptr((const void*)(uintptr_t)__builtin_amdgcn_kernarg_segment_ptr()); C.ws = KA->ws; C.out = KA->out; ctl = (unsigned*)(C.ws + WS_CTL); asm volatile("" : "+v"(C.tid)); C.lane = C.tid & 63; C.wave = __builtin_amdgcn_readfirstlane(C.tid >> 6); C.lds = (LAS unsigned char*)lds_raw; } while (0)
#ifndef REP_MASK
#define REP_MASK 0u
#endif
#ifndef ONLY_PH
#define ONLY_PH -1
#endif
#ifndef PH_MASK
#define PH_MASK 0xFFFFFFFFu
#endif
#define IN(k) (lo <= (k) && (k) < hi && (ONLY_PH < 0 || ((k) % PH_PER_LAYER) == ONLY_PH) && ((PH_MASK >> ((k) % PH_PER_LAYER)) & 1u))
#define SEAM(k) do { if (IN(k) && IN((k) + 1)) { bar.bar = ctl + CW_BAR; xcd_barrier(bar); } } while (0)
#define PH_BODY(k, ...) do { FRESH(); if (IN(p0 + (k))) { __VA_ARGS__; if ((REP_MASK >> (k)) & 1u) { xcd_barrier(bar); FRESH(); __VA_ARGS__; } } SEAM(p0 + (k)); } while (0)
template <int layer>
__device__ __forceinline__ void layer_phases(Ctx& C, const CAS Args*& KA, XcdBarrier& bar, unsigned*& ctl, unsigned char* lds_raw, const int lo, const int hi) {
    const int p0 = layer * PH_PER_LAYER;
    PH_BODY(0, { const WSrc W{KA->in[2], KA->in[3], KA->in[18], KA->in[20], KA->in[21], KA->in[7], KA->in[9], KA->in[12], KA->in[11]}; phase_wconv(C, layer, W);
                 if (layer == 0) phase_xg(C, KA->in[0], KA->in[1], (bf16*)(C.ws + WS_H), (float*)(C.ws + WS_SS1)); });
    PH_BODY(1, { pg8::Gemm g{(const pg8::bf16_t*)(C.ws + WS_H), (const pg8::bf16_t*)(C.ws + WS_WIN), M, N_INP, DM}; pg8::StaticOrder S; S.init(M, N_INP, C.G, C.bid);
                 pg8::EpiProj E{C.ws, (const float*)(C.ws + WS_SS1)}; pg8::gemm_phase<pg8::EpiProj, pg8::StaticOrder, true, true>(C.lds, g, S, E); });
    FRESH(); if (IN(p0 + 2)) phase_prep_a(C); SEAM(p0 + 2);
    PH_BODY(3, { phase_indexer(C); __syncthreads(); phase_ret1(C); });
    FRESH(); if (IN(p0 + 4)) { phase_attn(C); __syncthreads(); phase_ret2(C); } SEAM(p0 + 4);
    PH_BODY(5, { phase_ret3(C); __syncthreads(); const RwP P{KA->in[4], KA->in[5], KA->in[6], KA->in[8], KA->in[10], KA->in[13], KA->in[14], KA->in[15], KA->in[16], KA->in[17]}; phase_rw1(C, layer, P); });
    PH_BODY(6, { phase_rw2(C); });
    PH_BODY(7, { phase_rw3(C); });
    PH_BODY(8, { phase_rw4(C); });
    PH_BODY(9, { const RwP P{KA->in[4], KA->in[5], KA->in[6], KA->in[8], KA->in[10], KA->in[13], KA->in[14], KA->in[15], KA->in[16], KA->in[17]}; phase_rw5(C, layer, P); });
    FRESH(); if (IN(p0 + 10)) { const float* xin = layer == 0 ? KA->in[0] : C.out;
        pg8::Gemm g{(const pg8::bf16_t*)(C.ws + WS_CAT), (const pg8::bf16_t*)(C.ws + WS_WOUT), M, DM, DM}; pg8::StaticOrder S; S.init(M, DM, C.G, C.bid);
        pg8::EpiResid E{xin, C.out, DM, KA->in[19] + layer * DM, (pg8::bf16_t*)(C.ws + WS_H2), (float*)(C.ws + WS_SS2)}; pg8::gemm_phase<pg8::EpiResid, pg8::StaticOrder, true, true>(C.lds, g, S, E); }
    SEAM(p0 + 10);
    PH_BODY(11, { pg8::Gemm g{(const pg8::bf16_t*)(C.ws + WS_H2), (const pg8::bf16_t*)(C.ws + WS_WGU), M, 2 * DFF, DM}; pg8::StaticOrder S; S.init(M, 2 * DFF, C.G, C.bid);
                  pg8::EpiSwiGLU E{(pg8::bf16_t*)(C.ws + WS_ACT), DFF, (const float*)(C.ws + WS_SS2)}; pg8::gemm_phase<pg8::EpiSwiGLU, pg8::StaticOrder, true, true>(C.lds, g, S, E); });
    FRESH(); if (IN(p0 + 12)) { pg8::Gemm g{(const pg8::bf16_t*)(C.ws + WS_ACT), (const pg8::bf16_t*)(C.ws + WS_WDN), M, DM, DFF}; pg8::StaticOrder S; S.init(M, DM, C.G, C.bid);
        pg8::EpiResid E{C.out, C.out, DM, layer + 1 < DEPTH ? KA->in[1] + (layer + 1) * DM : KA->in[22], layer + 1 < DEPTH ? (pg8::bf16_t*)(C.ws + WS_H) : nullptr, (float*)(C.ws + WS_SS1)};
        pg8::gemm_phase<pg8::EpiResid, pg8::StaticOrder, true, true>(C.lds, g, S, E); }
    SEAM(p0 + 12);
}
__global__ void __launch_bounds__(NTHR, 2) fwd_kernel(Args args) {
    extern __shared__ __attribute__((aligned(16))) unsigned char lds_raw[];
    Ctx C;
    C.lds = (LAS unsigned char*)lds_raw; C.tid = threadIdx.x; C.lane = C.tid & 63; C.wave = __builtin_amdgcn_readfirstlane(C.tid >> 6);
    C.G = gridDim.x; C.bid = blockIdx.x;
    const CAS Args* KA = (const CAS Args*)launder_ptr((const void*)(uintptr_t)__builtin_amdgcn_kernarg_segment_ptr());
    C.ws = KA->ws; C.out = KA->out;
    volatile LAS unsigned* MISC = (volatile LAS unsigned*)(C.lds + MISC_OFF);
    if (C.tid < 32) MISC[C.tid] = 0u;
    __syncthreads();
    unsigned* ctl = (unsigned*)(C.ws + WS_CTL);
    XcdBarrier bar; bar.bar = ctl + CW_BAR; bar.x = 0; bar.st = nullptr;
    if (!MK_PER_PHASE) bar = xcd_barrier_post(ctl + CW_BAR, MISC + 8);
    const int lo = KA->ph_lo, hi = KA->ph_hi;
    layer_phases<0>(C, KA, bar, ctl, lds_raw, lo, hi);
    layer_phases<1>(C, KA, bar, ctl, lds_raw, lo, hi);
    FRESH(); if (IN(N_PHASES - 1)) phase_final_norm(C, C.out, KA->in[22], (const float*)(C.ws + WS_SS1));
#undef IN
#undef SEAM
}

extern "C" void kernel_launch(void* const* d_in, const int* in_sizes, int n_in, void* d_out, int out_size, void* d_ws, size_t ws_size, hipStream_t stream) {
    static int grid = 0;
    if (grid == 0) {
        if (n_in != 23 || out_size != M * DM || ws_size < WS_NEED) { fprintf(stderr, "kernel_launch: unexpected problem (n_in %d, out %d, ws %zu); nothing launched\n", n_in, out_size, ws_size); grid = -1; return; }
        int dev = 0, cus = 0, per_cu = 0;
        if (hipGetDevice(&dev) != hipSuccess || hipDeviceGetAttribute(&cus, hipDeviceAttributeMultiprocessorCount, dev) != hipSuccess) { grid = -1; return; }
        if (hipFuncSetAttribute((const void*)fwd_kernel, hipFuncAttributeMaxDynamicSharedMemorySize, LDS_BYTES) != hipSuccess) { fprintf(stderr, "kernel_launch: hipFuncSetAttribute failed\n"); grid = -1; return; }
        if (hipOccupancyMaxActiveBlocksPerMultiprocessor(&per_cu, (const void*)fwd_kernel, NTHR, LDS_BYTES) != hipSuccess || per_cu < 1) { fprintf(stderr, "kernel_launch: occupancy query says %d blocks per CU\n", per_cu); }
        (void)hipGetLastError();
        grid = cus;
    }
    if (grid < 0) return;
    (void)hipMemsetAsync((char*)d_ws + WS_CTL, 0, CTL_ZERO_BYTES, stream);
    Args a{};
    for (int i = 0; i < 23; ++i) a.in[i] = (const float*)d_in[i];
    a.out = (float*)d_out; a.ws = (unsigned char*)d_ws;
#if MK_PER_PHASE
    for (int p = 0; p < N_PHASES; ++p) { a.ph_lo = p; a.ph_hi = p + 1; hipLaunchKernelGGL(fwd_kernel, dim3(grid), dim3(NTHR), LDS_BYTES, stream, a); }
#else
    a.ph_lo = 0; a.ph_hi = N_PHASES;
    hipLaunchKernelGGL(fwd_kernel, dim3(grid), dim3(NTHR), LDS_BYTES, stream, a);
#endif
    const hipError_t le = hipPeekAtLastError();
    if (le != hipSuccess) fprintf(stderr, "kernel_launch: launch failed: %s\n", hipGetErrorName(le));
}
```

```cpp
#include <hip/hip_runtime.h>
#include <hip/hip_fp16.h>
#include <cstdio>
#include <cstdint>
namespace pg8 {
#define PG8_LAS __attribute__((address_space(3)))
typedef unsigned short bf16_t;
typedef short bf16x8 __attribute__((ext_vector_type(8)));
typedef float f32x4 __attribute__((ext_vector_type(4)));
typedef unsigned u32x4 __attribute__((ext_vector_type(4)));
constexpr int BM = 256, BK = 64, HALF = 128, HTB = HALF * BK * 2  , STAGE_BYTES = 8 * HTB, NXCD = 8, WGM = 8;

__host__ __device__ __forceinline__ int lds_byte(int r, int c) { const int st = (r >> 4) * 2 + (c >> 5), rr = r & 15, cc = c & 31, ob = rr * 64 + cc * 2; return st * 1024 + (ob ^ (((ob >> 9) & 1) << 5)); }
__host__ __device__ __forceinline__ void stage_rc(int b, int& R, int& C) { const int st = b / 1024, sb = b % 1024, swz = sb ^ (((sb >> 9) & 1) << 5); R = (st >> 1) * 16 + swz / 64; C = (st & 1) * 32 + (swz % 64) / 2; }
__host__ __device__ __forceinline__ int perm32(int rho) { const int n = rho >> 4, i = rho & 15; return 8 * (i >> 2) + 4 * n + (i & 3); }

struct Unit { int pm, pn; };
struct Gemm { const bf16_t* A; const bf16_t* Bt; int M, N, K; };

struct StaticOrder {
    int nM, nN, nwg, G, c;
    __host__ __device__ void init(int M, int N, int G_, int c_) { nM = M / BM; nN = N / BM; nwg = nM * nN; G = G_; c = c_; }
    __host__ __device__ bool next(int i, Unit& u) const {
        const long L = (long)i * G + c; if (L >= nwg) return false;
        int wgid = (int)L; { const int q = nwg / NXCD, r = nwg % NXCD, xcd = wgid % NXCD, off = wgid / NXCD; wgid = (xcd < r ? xcd * (q + 1) : r * (q + 1) + (xcd - r) * q) + off; }
        const int nig = WGM * nN, gid = wgid / nig, fm = gid * WGM, gsz = (nM - fm) < WGM ? (nM - fm) : WGM;
        u.pm = fm + ((wgid % nig) % gsz); u.pn = (wgid % nig) / gsz; return true;
    }
    __device__ __forceinline__ void a_ready(const Unit&) const {}
    __device__ __forceinline__ void done(const Unit&) const {}
};

__device__ __forceinline__ unsigned cvt_pk_bf16(float lo, float hi) { unsigned r; asm volatile("v_cvt_pk_bf16_f32 %0, %1, %2" : "=v"(r) : "v"(lo), "v"(hi)); return r; }
typedef float f32x2 __attribute__((ext_vector_type(2)));
__device__ __forceinline__ f32x2 gelu_pk(f32x2 v) {
    const f32x2 av = __builtin_elementwise_abs(v), d = av * 0.2316418882f + 1.0f;
    f32x2 t; t.x = __builtin_amdgcn_rcpf(d.x); t.y = __builtin_amdgcn_rcpf(d.y);
    f32x2 q = t * 0.5307027145f + (-0.7265760135f); q = q * t + 0.7107068705f; q = q * t + (-0.142248368f); q = q * t + 0.127414796f; q = q * t;
    const f32x2 s = (v * v) * (-0.72134752044f);
    f32x2 e; e.x = __builtin_amdgcn_exp2f(s.x); e.y = __builtin_amdgcn_exp2f(s.y);
    const f32x2 m = v * (q * e), r = v - m;
    f32x2 o; o.x = v.x < 0.f ? m.x : r.x; o.y = v.y < 0.f ? m.y : r.y; return o;
}

template <int ACT  > struct EpiBf16 {
    static constexpr bool PERM = true, AFTER_DRAIN = false; static_assert(ACT == 0 || ACT == 1, "EpiBf16: ACT is 0 (none) or 1 (gelu_pk)");
    bf16_t* O; int ldc; const float* bias; int split_cols; size_t split_stride; float scale0;
    __device__ __forceinline__ void operator()(const f32x4 (&acc)[2][2][4][2], const Unit& u, int wr, int wc, int fr, int fq) const {
        const int row0 = u.pm * BM + wr * 64 + fr; int colt = u.pn * BM; bf16_t* base = O;
        float sc = 1.f; if (split_cols) { const int t = colt / split_cols; base += (size_t)t * split_stride; colt -= t * split_cols; if (t == 0) sc = scale0; }
        const int col0 = colt + wc * 32 + 8 * fq, bcol0 = u.pn * BM + wc * 32 + 8 * fq;
        f32x4 bv[2][2];
#pragma unroll
        for (int bj = 0; bj < 2; ++bj)
#pragma unroll
            for (int n = 0; n < 2; ++n) bv[bj][n] = bias ? *(const f32x4*)(bias + bcol0 + bj * HALF + 4 * n) : (f32x4){0.f, 0.f, 0.f, 0.f};
#pragma unroll
        for (int ai = 0; ai < 2; ++ai)
#pragma unroll
            for (int m = 0; m < 4; ++m) { bf16_t* rowp = base + (size_t)(row0 + ai * HALF + m * 16) * ldc + col0;
#pragma unroll
                for (int bj = 0; bj < 2; ++bj) { f32x4 v0 = acc[ai][bj][m][0] + bv[bj][0], v1 = acc[ai][bj][m][1] + bv[bj][1];
                    if (ACT == 1) { f32x2 a = gelu_pk((f32x2){v0[0], v0[1]}), b = gelu_pk((f32x2){v0[2], v0[3]}), c = gelu_pk((f32x2){v1[0], v1[1]}), d = gelu_pk((f32x2){v1[2], v1[3]});
                        v0 = (f32x4){a.x, a.y, b.x, b.y}; v1 = (f32x4){c.x, c.y, d.x, d.y}; }
                    v0 = v0 * sc; v1 = v1 * sc; u32x4 w; w.x = cvt_pk_bf16(v0[0], v0[1]); w.y = cvt_pk_bf16(v0[2], v0[3]); w.z = cvt_pk_bf16(v1[0], v1[1]); w.w = cvt_pk_bf16(v1[2], v1[3]);
                    *(u32x4*)(rowp + bj * HALF) = w; } }
    }
};

__device__ __forceinline__ void tile_dest(int pn, size_t& off, int& ld, int& colt);
__device__ __forceinline__ float row_rstd(const float* ss, int row) { return rsqrtf(ss[row] * (1.0f / 2048.0f) + 1e-5f); }
struct EpiProj {
    static constexpr bool PERM = true, AFTER_DRAIN = false;
    unsigned char* ws; const float* ss;
    __device__ __forceinline__ void operator()(const f32x4 (&acc)[2][2][4][2], const Unit& u, int wr, int wc, int fr, int fq) const {
        size_t off; int ld, colt; tile_dest(u.pn, off, ld, colt);
        bf16_t* base = (bf16_t*)(ws + off);
        const int row0 = u.pm * BM + wr * 64 + fr, col0 = colt + wc * 32 + 8 * fq;
        const float sc = u.pn < 4 ? 0.12751743074602467f : 1.0f;
#pragma unroll
        for (int ai = 0; ai < 2; ++ai)
#pragma unroll
            for (int m = 0; m < 4; ++m) { const int row = row0 + ai * HALF + m * 16; bf16_t* rowp = base + (size_t)row * ld + col0; const float rs = row_rstd(ss, row) * sc;
#pragma unroll
                for (int bj = 0; bj < 2; ++bj) { const f32x4 v0 = acc[ai][bj][m][0] * rs, v1 = acc[ai][bj][m][1] * rs;
                    u32x4 w; w.x = cvt_pk_bf16(v0[0], v0[1]); w.y = cvt_pk_bf16(v0[2], v0[3]); w.z = cvt_pk_bf16(v1[0], v1[1]); w.w = cvt_pk_bf16(v1[2], v1[3]);
                    *(u32x4*)(rowp + bj * HALF) = w; } }
    }
};
struct EpiResid {
    static constexpr bool PERM = false, AFTER_DRAIN = false;
    const float* base; float* out; int ldc; const float* g; bf16_t* xg; float* ss;
    __device__ __forceinline__ void operator()(const f32x4 (&acc)[2][2][4][2], const Unit& u, int wr, int wc, int fr, int fq) const {
        const int row0 = u.pm * BM + wr * 64 + fr, col0 = u.pn * BM + wc * 32 + 4 * fq;
        f32x4 gv[2][2];
#pragma unroll
        for (int bj = 0; bj < 2; ++bj)
#pragma unroll
            for (int n = 0; n < 2; ++n) gv[bj][n] = *(const f32x4*)(g + col0 + bj * HALF + n * 16);
#pragma unroll
        for (int ai = 0; ai < 2; ++ai)
#pragma unroll
            for (int m = 0; m < 4; ++m) { const int row = row0 + ai * HALF + m * 16; const size_t off = (size_t)row * ldc + col0; float sq = 0.f;
#pragma unroll
                for (int bj = 0; bj < 2; ++bj)
#pragma unroll
                    for (int n = 0; n < 2; ++n) { const size_t p = off + bj * HALF + n * 16; const f32x4 x = *(const f32x4*)(base + p) + acc[ai][bj][m][n]; *(f32x4*)(out + p) = x;
                        sq += (x[0] * x[0] + x[1] * x[1]) + (x[2] * x[2] + x[3] * x[3]);
                        if (xg) { const f32x4 y = x * gv[bj][n]; typedef unsigned u32x2_t __attribute__((ext_vector_type(2))); u32x2_t w; w.x = cvt_pk_bf16(y[0], y[1]); w.y = cvt_pk_bf16(y[2], y[3]); *(u32x2_t*)(xg + p) = w; } }
                sq += __shfl_xor(sq, 16); sq += __shfl_xor(sq, 32);
                if (fq == 0) unsafeAtomicAdd(ss + row, sq); }
    }
};
struct EpiSwiGLU {
    static constexpr bool PERM = true, AFTER_DRAIN = false;
    bf16_t* O; int ldc; const float* ss;
    __device__ __forceinline__ static float silu_mul(float g, float u) { return g * u * __builtin_amdgcn_rcpf(1.0f + __expf(-g)); }
    __device__ __forceinline__ void operator()(const f32x4 (&acc)[2][2][4][2], const Unit& u, int wr, int wc, int fr, int fq) const {
        const int row0 = u.pm * BM + wr * 64 + fr, col0 = u.pn * HALF + wc * 32 + 8 * fq;
#pragma unroll
        for (int ai = 0; ai < 2; ++ai)
#pragma unroll
            for (int m = 0; m < 4; ++m) { const int row = row0 + ai * HALF + m * 16; bf16_t* rowp = O + (size_t)row * ldc + col0; const float rs = row_rstd(ss, row);
                const f32x4 g0 = acc[ai][0][m][0] * rs, g1 = acc[ai][0][m][1] * rs, u0 = acc[ai][1][m][0] * rs, u1 = acc[ai][1][m][1] * rs;
                u32x4 w; w.x = cvt_pk_bf16(silu_mul(g0[0], u0[0]), silu_mul(g0[1], u0[1])); w.y = cvt_pk_bf16(silu_mul(g0[2], u0[2]), silu_mul(g0[3], u0[3]));
                w.z = cvt_pk_bf16(silu_mul(g1[0], u1[0]), silu_mul(g1[1], u1[1])); w.w = cvt_pk_bf16(silu_mul(g1[2], u1[2]), silu_mul(g1[3], u1[3]));
                *(u32x4*)rowp = w; }
    }
};
template <class Epi, class Sched, bool ALIGN_EPI = false, bool SP2 = false>
__device__ __forceinline__ void gemm_phase(PG8_LAS unsigned char* lds, const Gemm g, const Sched& S, const Epi& E) {
    int tid_ = threadIdx.x; asm volatile("" : "+v"(tid_));
    const int tid = tid_, wid = __builtin_amdgcn_readfirstlane(tid >> 6), lane = tid & 63, wr = wid >> 2, wc = wid & 3, fr = lane & 15, fq = lane >> 4;
    const int K = g.K, nt = K / BK;
    unsigned voffA[2], voffB[2];
#pragma unroll
    for (int i = 0; i < 2; ++i) { int R, C; stage_rc(tid * 16 + i * 8192, R, C); const int Rb = Epi::PERM ? ((R & ~31) + perm32(R & 31)) : R;
        voffA[i] = (unsigned)(R * K + C) * 2u; voffB[i] = (unsigned)(Rb * K + C) * 2u; }
    const size_t kstep = (size_t)(BK * 2);
    const size_t hstep = (size_t)HALF * K * 2;
    const size_t tstep = 2 * hstep;
    const unsigned ldsw = (unsigned)wid * 1024u;
    const int aoff = lds_byte(wr * 64 + fr, fq * 8), boff = lds_byte(wc * 32 + fr, fq * 8);
#define PG8_SA(b, h) (((b) * 2 + (h)) * HTB)
#define PG8_SB(b, h) ((4 + (b) * 2 + (h)) * HTB)
#define PG8_STAGE(bufoff, gbase, voff) do { _Pragma("unroll") for (int _i = 0; _i < 2; ++_i) \
        __builtin_amdgcn_global_load_lds((const unsigned*)((const char*)(gbase) + (voff)[_i]), (PG8_LAS unsigned*)(lds + (bufoff) + ldsw + _i * 8192), 16, 0, 0); } while (0)
#define PG8_LDA(dst, b, h) do { _Pragma("unroll") for (int m = 0; m < 4; ++m) _Pragma("unroll") for (int k = 0; k < 2; ++k) dst[m][k] = *(const PG8_LAS bf16x8*)(lds + PG8_SA(b, h) + aoff + m * 2048 + k * 1024); } while (0)
#define PG8_LDB(dst, b, h) do { _Pragma("unroll") for (int n = 0; n < 2; ++n) _Pragma("unroll") for (int k = 0; k < 2; ++k) dst[n][k] = *(const PG8_LAS bf16x8*)(lds + PG8_SB(b, h) + boff + n * 2048 + k * 1024); } while (0)
#define PG8_MMA(ai, bj, At, Bt) do { __builtin_amdgcn_s_setprio(1); _Pragma("unroll") for (int m = 0; m < 4; ++m) _Pragma("unroll") for (int n = 0; n < 2; ++n) _Pragma("unroll") for (int k = 0; k < 2; ++k) \
        acc[ai][bj][m][n] = __builtin_amdgcn_mfma_f32_16x16x32_bf16(Bt[n][k], At[m][k], acc[ai][bj][m][n], 0, 0, 0); __builtin_amdgcn_s_setprio(0); } while (0)
#define PG8_WAIT_V(n) asm volatile("s_waitcnt vmcnt(" #n ")" ::: "memory")
#define PG8_WAIT_L(n) asm volatile("s_waitcnt lgkmcnt(" #n ")" ::: "memory")
#define PG8_BAR __builtin_amdgcn_s_barrier()
#define PG8_SCHED __builtin_amdgcn_sched_barrier(0)
    Unit cur, nxt; int ui = 0;
    if (!S.next(0, cur)) return;
    f32x4 acc[2][2][4][2];
#pragma unroll
    for (int a = 0; a < 2; ++a)
#pragma unroll
        for (int b = 0; b < 2; ++b)
#pragma unroll
            for (int m = 0; m < 4; ++m)
#pragma unroll
                for (int n = 0; n < 2; ++n) acc[a][b][m][n] = (f32x4){0.f, 0.f, 0.f, 0.f};
    bf16x8 At[4][2], B0[2][2], B1[2][2];
    const char* cA = (const char*)g.A + (size_t)cur.pm * tstep; const char* cB = (const char*)g.Bt + (size_t)cur.pn * tstep;
    S.a_ready(cur);
    if constexpr (SP2) {
        PG8_STAGE(PG8_SB(0, 0), cB, voffB); PG8_STAGE(PG8_SB(0, 1), cB + hstep, voffB); PG8_STAGE(PG8_SA(0, 0), cA, voffA); PG8_STAGE(PG8_SA(0, 1), cA + hstep, voffA);
        if (wr == 1) PG8_BAR;
        PG8_WAIT_V(2); PG8_BAR;
        PG8_STAGE(PG8_SB(1, 0), cB + kstep, voffB); PG8_STAGE(PG8_SA(1, 0), cA + kstep, voffA); PG8_STAGE(PG8_SB(1, 1), cB + hstep + kstep, voffB);
        PG8_WAIT_V(6); PG8_BAR;
    } else {
        PG8_STAGE(PG8_SB(0, 0), cB, voffB); PG8_STAGE(PG8_SA(0, 0), cA, voffA); PG8_STAGE(PG8_SB(0, 1), cB + hstep, voffB); PG8_STAGE(PG8_SA(0, 1), cA + hstep, voffA);
        if (wr == 1) PG8_BAR;
        PG8_WAIT_V(4); PG8_BAR;
        PG8_STAGE(PG8_SB(1, 0), cB + kstep, voffB); PG8_STAGE(PG8_SA(1, 0), cA + kstep, voffA); PG8_STAGE(PG8_SB(1, 1), cB + hstep + kstep, voffB);
        PG8_WAIT_V(6); PG8_BAR;
    }
    for (;;) {
        const bool has_next = S.next(ui + 1, nxt);
        const char* nA = has_next ? (const char*)g.A + (size_t)nxt.pm * tstep : cA; const char* nB = has_next ? (const char*)g.Bt + (size_t)nxt.pn * tstep : cB;
        for (int t = 0; t < nt; t += 2) {
            const bool last = (t == nt - 2);
            const char* a1 = cA + (size_t)(t + 1) * kstep;
            const char* a2 = last ? nA : cA + (size_t)(t + 2) * kstep; const char* b2 = last ? nB : cB + (size_t)(t + 2) * kstep;
            const char* a3 = a2 + kstep; const char* b3 = b2 + kstep;
            if (last && has_next) S.a_ready(nxt);
            if constexpr (SP2) {
            PG8_LDB(B0, 0, 0); PG8_LDB(B1, 0, 1); PG8_SCHED; PG8_LDA(At, 0, 0); PG8_STAGE(PG8_SA(1, 1), a1 + hstep, voffA);
            PG8_WAIT_V(8); PG8_WAIT_L(0); PG8_BAR; PG8_MMA(0, 0, At, B0); PG8_MMA(0, 1, At, B1); PG8_BAR; PG8_SCHED;
            PG8_LDA(At, 0, 1); PG8_STAGE(PG8_SB(0, 0), b2, voffB); PG8_STAGE(PG8_SB(0, 1), b2 + hstep, voffB); PG8_STAGE(PG8_SA(0, 0), a2, voffA);
            PG8_WAIT_V(8); PG8_WAIT_L(0); PG8_BAR; PG8_MMA(1, 0, At, B0); PG8_MMA(1, 1, At, B1); PG8_BAR; PG8_SCHED;
            PG8_LDB(B0, 1, 0); PG8_LDB(B1, 1, 1); PG8_SCHED; PG8_LDA(At, 1, 0); PG8_STAGE(PG8_SA(0, 1), a2 + hstep, voffA);
            PG8_WAIT_V(8); PG8_WAIT_L(0); PG8_BAR; PG8_MMA(0, 0, At, B0); PG8_MMA(0, 1, At, B1); PG8_BAR; PG8_SCHED;
            PG8_LDA(At, 1, 1); PG8_STAGE(PG8_SB(1, 0), b3, voffB); PG8_STAGE(PG8_SB(1, 1), b3 + hstep, voffB); PG8_STAGE(PG8_SA(1, 0), a3, voffA);
            PG8_WAIT_V(8); PG8_WAIT_L(0); PG8_BAR; PG8_MMA(1, 0, At, B0); PG8_MMA(1, 1, At, B1); PG8_BAR; PG8_SCHED;
            } else {
            PG8_LDB(B0, 0, 0); PG8_SCHED; PG8_LDA(At, 0, 0); PG8_STAGE(PG8_SA(1, 1), a1 + hstep, voffA);
            PG8_WAIT_L(8); PG8_BAR; PG8_WAIT_L(0); PG8_MMA(0, 0, At, B0); PG8_BAR; PG8_SCHED;
            PG8_LDB(B1, 0, 1); PG8_STAGE(PG8_SB(0, 0), b2, voffB);
            PG8_BAR; PG8_WAIT_L(0); PG8_MMA(0, 1, At, B1); PG8_BAR;
            PG8_LDA(At, 0, 1); PG8_STAGE(PG8_SA(0, 0), a2, voffA);
            PG8_BAR; PG8_WAIT_L(0); PG8_MMA(1, 0, At, B0); PG8_BAR; PG8_SCHED;
            PG8_STAGE(PG8_SB(0, 1), b2 + hstep, voffB);
            PG8_WAIT_V(6); PG8_BAR; PG8_MMA(1, 1, At, B1); PG8_BAR;
            PG8_LDB(B0, 1, 0); PG8_SCHED; PG8_LDA(At, 1, 0); PG8_STAGE(PG8_SA(0, 1), a2 + hstep, voffA);
            PG8_WAIT_L(8); PG8_BAR; PG8_WAIT_L(0); PG8_MMA(0, 0, At, B0); PG8_BAR; PG8_SCHED;
            PG8_LDB(B1, 1, 1); PG8_STAGE(PG8_SB(1, 0), b3, voffB);
            PG8_BAR; PG8_WAIT_L(0); PG8_MMA(0, 1, At, B1); PG8_BAR;
            PG8_LDA(At, 1, 1); PG8_STAGE(PG8_SA(1, 0), a3, voffA);
            PG8_BAR; PG8_WAIT_L(0); PG8_MMA(1, 0, At, B0); PG8_BAR; PG8_SCHED;
            PG8_STAGE(PG8_SB(1, 1), b3 + hstep, voffB);
            PG8_WAIT_V(6); PG8_BAR; PG8_MMA(1, 1, At, B1); PG8_BAR;
            }
        }
        if constexpr (ALIGN_EPI) { if (wr == 0) PG8_BAR; }
        if constexpr (!Epi::AFTER_DRAIN) { E(acc, cur, wr, wc, fr, fq); S.done(cur); }
        if (!has_next) break;
#pragma unroll
        for (int a = 0; a < 2; ++a)
#pragma unroll
            for (int b = 0; b < 2; ++b)
#pragma unroll
                for (int m = 0; m < 4; ++m)
#pragma unroll
                    for (int n = 0; n < 2; ++n) acc[a][b][m][n] = (f32x4){0.f, 0.f, 0.f, 0.f};
        cur = nxt; cA = nA; cB = nB; ++ui;
        if constexpr (ALIGN_EPI) { if (wr == 1) PG8_BAR; }
    }
    PG8_WAIT_V(0);
    if constexpr (!ALIGN_EPI) { if (wr == 0) PG8_BAR; }
    PG8_BAR;
    if constexpr (Epi::AFTER_DRAIN) { E.fused(acc, cur, wr, wc, fr, fq, lds, wid, lane); S.done(cur); }
#undef PG8_SA
#undef PG8_SB
#undef PG8_STAGE
#undef PG8_LDA
#undef PG8_LDB
#undef PG8_MMA
#undef PG8_WAIT_V
#undef PG8_WAIT_L
#undef PG8_BAR
#undef PG8_SCHED
}
}
constexpr int NB = 4, T = 8192, M = NB * T, DM = 2048, DFF = 5632, DEPTH = 2;
constexpr int N_IN = 7696, N_INP = 7936;
constexpr int NWAVES = 8, NTHR = NWAVES * 64;
#define LAS __attribute__((address_space(3)))
#define GAS __attribute__((address_space(1)))
#define CAS __attribute__((address_space(4)))
typedef unsigned short bf16;
typedef short bf16x8 __attribute__((ext_vector_type(8)));
typedef float f32x4 __attribute__((ext_vector_type(4)));
typedef float f32x16 __attribute__((ext_vector_type(16)));
typedef unsigned u32x4 __attribute__((ext_vector_type(4)));
typedef unsigned u32x2 __attribute__((ext_vector_type(2)));
typedef unsigned long long u64;

constexpr size_t MiB = 1u << 20;
constexpr size_t WS_CTL = 0, CTL_ZERO_BYTES = 1 * MiB;
constexpr size_t WS_WIN = 1 * MiB, WS_WOUT = 32 * MiB, WS_WGU = 40 * MiB, WS_WDN = 84 * MiB;
constexpr size_t WS_LORA = 106 * MiB;
constexpr size_t LO_W = 0, LO_A = 512 * 96 * 2, LO_V = 2 * 512 * 96 * 2, LO_G = LO_V + 512 * 64 * 2;
constexpr size_t WS_VFIRST = 107 * MiB;
constexpr size_t WS_H = 139 * MiB;
constexpr size_t WS_VT = 139 * MiB, WS_MASK = 203 * MiB;
constexpr size_t WS_Q = 267 * MiB, WS_K = 331 * MiB, WS_QI = 395 * MiB, WS_V = 459 * MiB, WS_KW = 523 * MiB, WS_BQ = 539 * MiB, WS_BK = 555 * MiB, WS_BV = 571 * MiB, WS_BG = 603 * MiB;
constexpr size_t WS_CR = 635 * MiB, WS_CK = 667 * MiB, WS_CV = 699 * MiB, WS_CL = 731 * MiB, WS_CG = 747 * MiB;
constexpr size_t WS_CAT = 763 * MiB;
constexpr size_t WS_KVST = 891 * MiB;
constexpr size_t WS_TAB = 955 * MiB;
constexpr size_t WS_SS1 = 959 * MiB, WS_SS2 = 959 * MiB + 256 * 1024;
constexpr size_t TAB_A = 0, TAB_I = (size_t)T * 16 * 8, TAB_R = TAB_I + (size_t)T * 8 * 8, TAB_END = TAB_R + (size_t)T * 32 * 8;
constexpr size_t WS_RR = 139 * MiB, WS_RW = 171 * MiB, WS_RKH = 203 * MiB, WS_RV = 235 * MiB, WS_RA = 267 * MiB, WS_RB = 299 * MiB;
constexpr size_t WS_PHI = 523 * MiB, WS_PSI = 555 * MiB, WS_SST = 587 * MiB, WS_Y = 635 * MiB;
constexpr size_t WS_H2 = 139 * MiB, WS_ACT = 267 * MiB;
constexpr size_t WS_NEED = 1024 * MiB;
static_assert(WS_TAB + TAB_END <= WS_NEED && WS_ACT + (size_t)M * DFF * 2 <= WS_CR && WS_SST + 32 * MiB <= WS_CR && WS_Y + (size_t)M * 512 * 4 <= WS_CV, "ws map");

constexpr int LDS_BYTES = 147456, MISC_OFF = 143360;
constexpr int CW_BAR = 4096;

__device__ __forceinline__ unsigned f2bf(float f) { unsigned u = __builtin_bit_cast(unsigned, f); return (u + 0x7fffu + ((u >> 16) & 1u)) >> 16; }
__device__ __forceinline__ unsigned pk2(float lo, float hi) { return f2bf(lo) | (f2bf(hi) << 16); }
__device__ __forceinline__ float bf2f(unsigned short b) { return __builtin_bit_cast(float, (unsigned)b << 16); }
__device__ __forceinline__ float bflo(unsigned w) { return __builtin_bit_cast(float, w << 16); }
__device__ __forceinline__ float bfhi(unsigned w) { return __builtin_bit_cast(float, w & 0xffff0000u); }
__device__ __forceinline__ float wave_sum(float v) {
#pragma unroll
    for (int o = 1; o < 64; o <<= 1) v += __shfl_xor(v, o);
    return v;
}
#define LDS_WAIT() asm volatile("s_waitcnt lgkmcnt(0)" ::: "memory")
typedef float f32x2 __attribute__((ext_vector_type(2)));
template <class TT> __device__ __forceinline__ GAS TT* at_b(GAS TT* ub, unsigned boff) { return (GAS TT*)((GAS char*)ub + boff); }
__device__ __forceinline__ float half_sum32(float v) { v += __shfl_xor(v, 1); v += __shfl_xor(v, 2); v += __shfl_xor(v, 4); v += __shfl_xor(v, 8); v += __shfl_xor(v, 16); return v; }


namespace pg8 {
__device__ __forceinline__ void tile_dest(int pn, size_t& off, int& ld, int& colt) {
    if (pn < 16) { const int g = pn >> 2; off = g == 0 ? WS_Q : g == 1 ? WS_K : g == 2 ? WS_V : WS_QI; ld = 1024; colt = (pn & 3) * 256; }
    else if (pn == 16) { off = WS_BQ; ld = 256; colt = 0; }
    else if (pn == 17) { off = WS_BK; ld = 256; colt = 0; }
    else if (pn < 20) { off = WS_BV; ld = 512; colt = (pn - 18) * 256; }
    else if (pn < 22) { off = WS_BG; ld = 512; colt = (pn - 20) * 256; }
    else if (pn == 22) { off = WS_KW; ld = 256; colt = 0; }
    else if (pn < 25) { off = WS_CR; ld = 512; colt = (pn - 23) * 256; }
    else if (pn < 27) { off = WS_CK; ld = 512; colt = (pn - 25) * 256; }
    else if (pn < 29) { off = WS_CV; ld = 512; colt = (pn - 27) * 256; }
    else if (pn == 29) { off = WS_CL; ld = 256; colt = 0; }
    else { off = WS_CG; ld = 256; colt = 0; }
}
}
__device__ __forceinline__ int win_src(int n, int layer) {
    if (n < 4096) return n;
    if (n < 4352) return 4176 + (n - 4096);
    if (n < 4608) return 4432 + (n - 4352);
    if (n < 5120) return 4688 + (n - 4608);
    if (n < 5632) return 5200 + (n - 5120);
    if (n < 5888) { const int j = n - 5632; return j < 64 ? 4096 + j : (j < 80 ? 4160 + (j - 64) : -1); }
    if (n < 7424) return 5712 + (n - 5888);
    if (n < 7680) { const int j = n - 7424; return j < 96 ? 7248 + j : (j < 192 ? 7344 + (j - 96) : (layer > 0 ? -2 - (j - 192) : -1)); }
    return 7440 + (n - 7680);
}
#define XB_TMO      128
#define XB_XCNT(j)  (256  + 64 * (j))
#define XB_XSUB(j)  (1280 + 64 * (j))
#define XB_XGEN(j)  (2304 + 64 * (j))
#define XB_TOP      3328
#define XB_TOPGEN   3392
#define XCD_BAR_WORDS 3456
#define XB_SPIN_CAP (1u << 18)

__device__ __forceinline__ unsigned xb_ld(unsigned* p)              { return __hip_atomic_load(p, __ATOMIC_RELAXED, __HIP_MEMORY_SCOPE_AGENT); }
__device__ __forceinline__ unsigned xb_add(unsigned* p, unsigned v) { return __hip_atomic_fetch_add(p, v, __ATOMIC_RELAXED, __HIP_MEMORY_SCOPE_AGENT); }
__device__ __forceinline__ unsigned xb_xcc_id() { return (unsigned)__builtin_amdgcn_s_getreg((3 << 11) | 20) & 0xFu; }
#define XB_SPIN(cond, bar) do { unsigned _sp = 0; while (cond) { __builtin_amdgcn_s_sleep(1); \
    if ((++_sp & 255u) == 0u) { if (xb_ld(&(bar)[XB_TMO])) break; if (_sp > XB_SPIN_CAP) { atomicAdd(&(bar)[XB_TMO], 1u); break; } } } } while (0)

struct XcdBarrier {
    unsigned* bar; unsigned x;
    volatile LAS unsigned* st;
};

__device__ __forceinline__ XcdBarrier xcd_barrier_post(unsigned* bar, volatile LAS unsigned* st) {
    XcdBarrier b; b.bar = bar; b.x = xb_xcc_id(); b.st = st;
    if (threadIdx.x == 0) (void)xb_add(&bar[XB_XCNT(b.x)], 1u);
    return b;
}
__device__ __forceinline__ void xcd_barrier_complete(unsigned* bar, unsigned x, unsigned& nloc, unsigned& nx) {
    const unsigned G = gridDim.x * gridDim.y * gridDim.z;
    unsigned sum, cnt, mine, sp = 0u;
    for (;;) {
        sum = 0u; cnt = 0u; mine = 0u;
#pragma unroll
        for (unsigned j = 0; j < 16; ++j) { const unsigned c = xb_ld(&bar[XB_XCNT(j)]); sum += c; cnt += (c > 0u) ? 1u : 0u; mine = (j == x) ? c : mine; }
        if (sum == G) break;
        __builtin_amdgcn_s_sleep(1);
        if ((++sp & 255u) == 0u) { if (xb_ld(&bar[XB_TMO])) break; if (sp > XB_SPIN_CAP) { atomicAdd(&bar[XB_TMO], 1u); break; } }
    }
    nloc = mine > 0u ? mine : 1u; nx = cnt > 0u ? cnt : 1u;
}

__device__ __forceinline__ void xcd_barrier(const XcdBarrier& b) {
    asm volatile("s_waitcnt vmcnt(0)" ::: "memory");
    __syncthreads();
    if (threadIdx.x == 0) {
        unsigned* bar = b.bar;
        __builtin_amdgcn_s_waitcnt(0);
        unsigned nloc = b.st[0], nx = b.st[1];
        if (nloc == 0u) { xcd_barrier_complete(bar, b.x, nloc, nx); b.st[0] = nloc; b.st[1] = nx; }
        const unsigned old = xb_add(&bar[XB_XSUB(b.x)], 1u);
        const unsigned gen = old / nloc;
        if (old + 1u == (gen + 1u) * nloc) {
            __builtin_amdgcn_fence(__ATOMIC_RELEASE, "agent");
            asm volatile("s_waitcnt vmcnt(0)" ::: "memory");
            const unsigned og = xb_add(&bar[XB_TOP], 1u);
            const unsigned tg = og / nx;
            if (og + 1u == (tg + 1u) * nx) xb_add(&bar[XB_TOPGEN], 1u);
            else XB_SPIN(xb_ld(&bar[XB_TOPGEN]) == tg, bar);
            __builtin_amdgcn_fence(__ATOMIC_ACQUIRE, "agent");
            xb_add(&bar[XB_XGEN(b.x)], 1u);
            asm volatile("s_waitcnt vmcnt(0)" ::: "memory");
        } else {
            XB_SPIN(xb_ld(&bar[XB_XGEN(b.x)]) == gen, bar);
            __builtin_amdgcn_fence(__ATOMIC_ACQUIRE, "agent");
            asm volatile("s_waitcnt vmcnt(0)" ::: "memory");
        }
    }
    __syncthreads();
}

struct Ctx {
    LAS unsigned char* lds; int tid, lane, wave, G, bid; unsigned char* ws; float* out;
};

template <int MAP>
__device__ __forceinline__ void wconv_item(const float* W, int ldw, const float* W2, int K, bf16* WT, LAS float* scr, int item, int nblk, int lane, int layer) {
    const int kb = item / nblk, nb = item % nblk, k0 = 64 * kb, n0 = 32 * nb;
    const int n = n0 + (lane & 31);
    const float* src = nullptr; int ld = ldw;
    if (MAP == 0) src = W + n;
    else if (MAP == 1) { const int s = win_src(n, layer); if (s >= 0) src = W + s; else if (s <= -2) { src = W2 + (-2 - s); ld = 64; } }
    else { const int tl = n >> 8, j = n & 255; src = W + (j < 128 ? tl * 128 + j : DFF + tl * 128 + (j - 128)); }
    float tv[32];
#pragma unroll
    for (int i = 0; i < 32; ++i) { const int kk = 2 * i + (lane >> 5); tv[i] = src ? src[(size_t)(k0 + kk) * ld] : 0.f; }
#pragma unroll
    for (int i = 0; i < 32; ++i) { const int kk = 2 * i + (lane >> 5); scr[kk * 33 + (lane & 31)] = tv[i]; }
    LDS_WAIT(); asm volatile("" ::: "memory");
    const int c = lane & 7;
#pragma unroll
    for (int j = 0; j < 4; ++j) { const int nn = (lane >> 3) + 8 * j; const LAS float* s = scr + (8 * c) * 33 + nn;
        u32x4 o; o.x = pk2(s[0 * 33], s[1 * 33]); o.y = pk2(s[2 * 33], s[3 * 33]); o.z = pk2(s[4 * 33], s[5 * 33]); o.w = pk2(s[6 * 33], s[7 * 33]);
        *(u32x4*)(WT + (size_t)(n0 + nn) * K + k0 + 8 * c) = o; }
    LDS_WAIT(); asm volatile("" ::: "memory");
}
struct WSrc { const float *w_in, *w_vres, *w_out, *w_gu, *w_dn, *wlb, *alb, *glb, *vlb; };
__device__ __forceinline__ void phase_wconv(const Ctx& C, int layer, const WSrc& W) {
    LAS float* scr = (LAS float*)(C.lds + C.wave * 16384);
    const int gw = C.bid * NWAVES + C.wave, NGW = C.G * NWAVES;
    const float* w_in = W.w_in + (size_t)layer * DM * N_IN; const float* w_vres = W.w_vres;
    const float* w_out = W.w_out + (size_t)layer * DM * DM; const float* w_gu = W.w_gu + (size_t)layer * DM * 2 * DFF; const float* w_dn = W.w_dn + (size_t)layer * DFF * DM;
    constexpr int I_IN = (DM / 64) * (N_INP / 32), I_OUT = (DM / 64) * (DM / 32), I_GU = (DM / 64) * (2 * DFF / 32), I_DN = (DFF / 64) * (DM / 32);
    for (int it = gw; it < I_IN + I_OUT + I_GU + I_DN; it += NGW) {
        int r = it;
        if (r < I_IN) { wconv_item<1>(w_in, N_IN, w_vres, DM, (bf16*)(C.ws + WS_WIN), scr, r, N_INP / 32, C.lane, layer); continue; } r -= I_IN;
        if (r < I_OUT) { wconv_item<0>(w_out, DM, nullptr, DM, (bf16*)(C.ws + WS_WOUT), scr, r, DM / 32, C.lane, layer); continue; } r -= I_OUT;
        if (r < I_GU) { wconv_item<2>(w_gu, 2 * DFF, nullptr, DM, (bf16*)(C.ws + WS_WGU), scr, r, 2 * DFF / 32, C.lane, layer); continue; } r -= I_GU;
        wconv_item<0>(w_dn, DM, nullptr, DFF, (bf16*)(C.ws + WS_WDN), scr, r, DM / 32, C.lane, layer);
    }
    const int gt = C.bid * NTHR + C.tid, NGT = C.G * NTHR;
    const float* wlb = W.wlb + (size_t)layer * 96 * 512; const float* alb = W.alb + (size_t)layer * 96 * 512; const float* glb = W.glb + (size_t)layer * 256 * 512;
    const float* vlb = W.vlb;
    bf16* LW = (bf16*)(C.ws + WS_LORA + LO_W); bf16* LA = (bf16*)(C.ws + WS_LORA + LO_A); bf16* LV = (bf16*)(C.ws + WS_LORA + LO_V); bf16* LG = (bf16*)(C.ws + WS_LORA + LO_G);
    for (int i = gt; i < 512 * 96; i += NGT) { const int n = i / 96, k = i % 96; LW[i] = (bf16)f2bf(wlb[k * 512 + n]); LA[i] = (bf16)f2bf(alb[k * 512 + n]); }
    for (int i = gt; i < 512 * 64; i += NGT) { const int n = i / 64, k = i % 64; LV[i] = (bf16)f2bf(layer > 0 ? vlb[k * 512 + n] : 0.f); }
    for (int i = gt; i < 512 * 256; i += NGT) { const int n = i / 256, k = i % 256; LG[i] = (bf16)f2bf(glb[k * 512 + n]); }
    if (layer == 0) {
        float2* TA = (float2*)(C.ws + WS_TAB + TAB_A); float2* TI = (float2*)(C.ws + WS_TAB + TAB_I); float2* TR = (float2*)(C.ws + WS_TAB + TAB_R);
        const float l2a = 18.931568569324174f  , l2r = 13.287712379549449f  ;
        for (int i = gt; i < T * 56; i += NGT) {
            const int pos = i / 56, j = i % 56; float fr; float2* dst;
            if (j < 16) { fr = exp2f(-(float)j * (1.0f / 16.0f) * l2a); dst = TA + pos * 16 + j; }
            else if (j < 24) { fr = exp2f(-(float)(j - 16) * (1.0f / 8.0f) * l2a); dst = TI + pos * 8 + (j - 16); }
            else { fr = exp2f(-(float)(j - 24) * (1.0f / 32.0f) * l2r); dst = TR + pos * 32 + (j - 24); }
            const float ang = (float)pos * fr; *dst = make_float2(cosf(ang), sinf(ang));
        }
    }
}
__device__ __forceinline__ void phase_xg(const Ctx& C, const float* x, const float* g, bf16* out, float* ss) {
    const int gw = C.bid * NWAVES + C.wave, NGW = C.G * NWAVES;
    f32x4 gv[8];
#pragma unroll
    for (int j = 0; j < 8; ++j) gv[j] = *(const f32x4*)(g + 4 * (C.lane + 64 * j));
    for (int m = gw; m < M; m += NGW) {
        const f32x4* xr = (const f32x4*)(x + (size_t)m * DM) + C.lane; f32x4 v[8]; float s = 0.f;
#pragma unroll
        for (int j = 0; j < 8; ++j) { v[j] = xr[64 * j]; s += (v[j].x * v[j].x + v[j].y * v[j].y) + (v[j].z * v[j].z + v[j].w * v[j].w); }
        s = wave_sum(s); if (C.lane == 0) ss[m] = s;
        u32x2* o = (u32x2*)(out + (size_t)m * DM) + C.lane;
#pragma unroll
        for (int j = 0; j < 8; ++j) { u32x2 w; w.x = pk2(v[j].x * gv[j].x, v[j].y * gv[j].y); w.y = pk2(v[j].z * gv[j].z, v[j].w * gv[j].w); o[64 * j] = w; }
    }
}
__device__ __forceinline__ void phase_final_norm(const Ctx& C, float* x, const float* g, const float* ss) {
    const int gw = C.bid * NWAVES + C.wave, NGW = C.G * NWAVES;
    f32x4 gv[8];
#pragma unroll
    for (int j = 0; j < 8; ++j) gv[j] = *(const f32x4*)(g + 4 * (C.lane + 64 * j));
    for (int m = gw; m < M; m += NGW) {
        f32x4* xr = (f32x4*)(x + (size_t)m * DM) + C.lane; const float rs = rsqrtf(ss[m] * (1.0f / DM) + 1e-5f);
#pragma unroll
        for (int j = 0; j < 8; ++j) xr[64 * j] = xr[64 * j] * rs * gv[j];
    }
}
__device__ __forceinline__ void phase_prep_a(const Ctx& C) {
    const long gt = (long)C.bid * NTHR + C.tid, NGT = (long)C.G * NTHR;
    { float* s1 = (float*)(C.ws + WS_SS1); float* s2 = (float*)(C.ws + WS_SS2); for (long i = gt; i < M; i += NGT) { s1[i] = 0.f; s2[i] = 0.f; } }
    for (int cfg = 0; cfg < 6; ++cfg) {
        size_t off; int ld, nh, hd, half; size_t tab;
        if (cfg == 0) { off = WS_Q; ld = 1024; nh = 8; hd = 128; half = 16; tab = TAB_A; }
        else if (cfg == 1) { off = WS_K; ld = 1024; nh = 8; hd = 128; half = 16; tab = TAB_A; }
        else if (cfg == 2) { off = WS_QI; ld = 1024; nh = 16; hd = 64; half = 8; tab = TAB_I; }
        else if (cfg == 3) { off = WS_KW; ld = 256; nh = 1; hd = 64; half = 8; tab = TAB_I; }
        else if (cfg == 4) { off = WS_BQ; ld = 256; nh = 4; hd = 64; half = 32; tab = TAB_R; }
        else { off = WS_BK; ld = 256; nh = 4; hd = 64; half = 32; tab = TAB_R; }
        bf16* buf = (bf16*)(C.ws + off); const float2* tb = (const float2*)(C.ws + WS_TAB + tab);
        const int cpp = half >> 3; const long total = (long)M * nh * cpp;
        for (long it0 = gt; it0 < total; it0 += 4 * NGT) {
            bf16* p1[4]; u32x4 a[4], b[4]; f32x4 tcs[4][4]; bool ok[4];
#pragma unroll
            for (int q = 0; q < 4; ++q) { const long it = it0 + q * NGT; ok[q] = it < total; const long itc = ok[q] ? it : gt;
                const int c = (int)(itc % cpp); const long r2 = itc / cpp; const int h = (int)(r2 % nh); const int row = (int)(r2 / nh); const int pos = row & (T - 1);
                p1[q] = buf + (size_t)row * ld + h * hd + 8 * c; a[q] = *(const u32x4*)p1[q]; b[q] = *(const u32x4*)(p1[q] + half);
                const f32x4* tp = (const f32x4*)(tb + (size_t)pos * half + 8 * c);
#pragma unroll
                for (int e = 0; e < 4; ++e) tcs[q][e] = tp[e]; }
#pragma unroll
            for (int q = 0; q < 4; ++q) { if (!ok[q]) continue; u32x4 oa, ob;
#pragma unroll
                for (int e = 0; e < 4; ++e) { const float x10 = bflo(a[q][e]), x11 = bfhi(a[q][e]), x20 = bflo(b[q][e]), x21 = bfhi(b[q][e]); const f32x4 t = tcs[q][e];
                    oa[e] = pk2(x10 * t.x - x20 * t.y, x11 * t.z - x21 * t.w); ob[e] = pk2(x20 * t.x + x10 * t.y, x21 * t.z + x11 * t.w); }
                *(u32x4*)p1[q] = oa; *(u32x4*)(p1[q] + half) = ob; }
        }
    }
    {
        LAS unsigned short* scr = (LAS unsigned short*)(C.lds + C.wave * 9216);
        const bf16* V = (const bf16*)(C.ws + WS_V); bf16* Vt = (bf16*)(C.ws + WS_VT);
        const int gw = C.bid * NWAVES + C.wave, NGW = C.G * NWAVES, lane = C.lane;
        for (int it = gw; it < NB * 128 * 16; it += NGW) {
            const int ct = it & 15, tt = (it >> 4) & 127, b = it >> 11;
            const int t0 = tt * 64, c0 = ct * 64;
            u32x4 v[8];
#pragma unroll
            for (int i = 0; i < 8; ++i) { const int tr = 8 * i + (lane >> 3), c8 = (lane & 7) * 8; v[i] = *(const u32x4*)(V + (size_t)(b * T + t0 + tr) * 1024 + c0 + c8); }
#pragma unroll
            for (int i = 0; i < 8; ++i) { const int tr = 8 * i + (lane >> 3), c8 = (lane & 7) * 8; *(LAS u32x4*)(scr + tr * 72 + c8) = v[i]; }
            LDS_WAIT(); asm volatile("" ::: "memory");
#pragma unroll
            for (int i = 0; i < 8; ++i) { const int cr = 8 * i + (lane >> 3), t8 = (lane & 7) * 8; u32x4 w;
#pragma unroll
                for (int e = 0; e < 4; ++e) w[e] = (unsigned)scr[(t8 + 2 * e) * 72 + cr] | ((unsigned)scr[(t8 + 2 * e + 1) * 72 + cr] << 16);
                *(u32x4*)(Vt + ((size_t)b * 1024 + c0 + cr) * T + t0 + t8) = w; }
            LDS_WAIT(); asm volatile("" ::: "memory");
        }
    }
}
#ifndef IDX_REP_T
#define IDX_REP_T 1
#endif
#ifndef IDX_REP_S
#define IDX_REP_S 1
#endif
__device__ __forceinline__ void phase_indexer(const Ctx& C) {
    LAS unsigned short* sc = (LAS unsigned short*)C.lds;
    LAS unsigned* hist = (LAS unsigned*)(C.lds + 131072) + C.wave * 256;
    LAS float* wvl = (LAS float*)(C.lds + 131072 + 8192);
    LAS unsigned short* qbl = (LAS unsigned short*)(C.lds + 131072 + 8192 + 512);
    const bf16* QI = (const bf16*)(C.ws + WS_QI); const bf16* KW = (const bf16*)(C.ws + WS_KW); u64* MASK = (u64*)(C.ws + WS_MASK);
    const int lane = C.lane, r32 = lane & 31, hi = lane >> 5;
    for (int it = C.bid; it < NB * (T / 8); it += C.G) {
        const int b = it & 3, qg = it >> 2, q0 = qg * 8, qchunk = q0 >> 6, nadm = 64 * (qchunk + 1);
        const int qrow = b * T + q0 + C.wave;
        if (qchunk < 4) {
            MASK[(size_t)qrow * 128 + lane] = lane <= qchunk ? ~0ull : 0ull; MASK[(size_t)qrow * 128 + 64 + lane] = 0ull;
            continue;
        }
        bf16x8 af[4][4];
        {
            const int qq = (r32 >> 2) & 1, hh = (r32 & 3) + 4 * (r32 >> 3);
#pragma unroll
            for (int pr = 0; pr < 4; ++pr) {
                const bf16* qp = QI + (size_t)(b * T + q0 + 2 * pr + qq) * 1024 + hh * 64 + 8 * hi;
#pragma unroll
                for (int kk = 0; kk < 4; ++kk) af[pr][kk] = *(const bf16x8*)(qp + 16 * kk);
            }
            if (C.tid < 128) wvl[C.tid] = bf2f(KW[(size_t)(b * T + q0 + (C.tid >> 4)) * 256 + 64 + (C.tid & 15)]) * 0.015625f;
        }
        __syncthreads();
        { const int qx = C.tid >> 6, dx = C.tid & 63; const bf16* qp = QI + (size_t)(b * T + q0 + qx) * 1024 + dx; float acc = 0.f;
#pragma unroll
          for (int h = 0; h < 16; ++h) acc += wvl[qx * 16 + h] * bf2f(qp[h * 64]);
          qbl[qx * 64 + dx] = (unsigned short)f2bf(acc); }
        __syncthreads();
        bf16x8 afl[4];
        { const int qsel = 2 * (r32 & 3) + ((r32 >> 2) & 1);
#pragma unroll
          for (int kk = 0; kk < 4; ++kk) { const u32x4 z = {0u, 0u, 0u, 0u}; afl[kk] = r32 < 8 ? *(const LAS bf16x8*)(qbl + qsel * 64 + 16 * kk + 8 * hi) : __builtin_bit_cast(bf16x8, z); } }
        for (int rep_t = 0; rep_t < IDX_REP_T; ++rep_t) {
            const int ntile = nadm / 32;
            bf16x8 bfr[4], bnx[4];
            { const bf16* kp = KW + (size_t)(b * T + 32 * C.wave + r32) * 256 + 8 * hi;
#pragma unroll
              for (int kk = 0; kk < 4; ++kk) bnx[kk] = *(const bf16x8*)(kp + 16 * kk); }
            for (int tile = C.wave; tile < ntile; tile += NWAVES) {
                const int key0 = 32 * tile;
#pragma unroll
                for (int kk = 0; kk < 4; ++kk) bfr[kk] = bnx[kk];
                if (tile + NWAVES < ntile) { const bf16* kp = KW + (size_t)(b * T + key0 + 32 * NWAVES + r32) * 256 + 8 * hi;
#pragma unroll
                    for (int kk = 0; kk < 4; ++kk) bnx[kk] = *(const bf16x8*)(kp + 16 * kk); }
                const int kpos = (key0 & ~127) + 2 * ((key0 & 63) + r32) + ((key0 >> 6) & 1);
                f32x16 dl = {0.f, 0.f, 0.f, 0.f, 0.f, 0.f, 0.f, 0.f, 0.f, 0.f, 0.f, 0.f, 0.f, 0.f, 0.f, 0.f};
#pragma unroll
                for (int kk = 0; kk < 4; ++kk) dl = __builtin_amdgcn_mfma_f32_32x32x16_bf16(afl[kk], bfr[kk], dl, 0, 0, 0);
#pragma unroll
                for (int pr = 0; pr < 4; ++pr) {
                    f32x16 d = {0.f, 0.f, 0.f, 0.f, 0.f, 0.f, 0.f, 0.f, 0.f, 0.f, 0.f, 0.f, 0.f, 0.f, 0.f, 0.f};
#pragma unroll
                    for (int kk = 0; kk < 4; ++kk) d = __builtin_amdgcn_mfma_f32_32x32x16_bf16(af[pr][kk], bfr[kk], d, 0, 0, 0);
                    float s0 = dl[pr];
#pragma unroll
                    for (int g = 0; g < 4; ++g) { const f32x4 w4 = *(const LAS f32x4*)(wvl + (2 * pr + hi) * 16 + 4 * g);
                        s0 = __builtin_fmaf(__builtin_fabsf(d[4 * g]), w4.x, s0); s0 = __builtin_fmaf(__builtin_fabsf(d[4 * g + 1]), w4.y, s0); s0 = __builtin_fmaf(__builtin_fabsf(d[4 * g + 2]), w4.z, s0); s0 = __builtin_fmaf(__builtin_fabsf(d[4 * g + 3]), w4.w, s0); }
                    const unsigned short hb = __half_as_ushort(__float2half_rn(s0));
                    const unsigned short key = (hb & 0x8000u) ? (unsigned short)~hb : (unsigned short)(hb | 0x8000u);
                    sc[(2 * pr + hi) * 8192 + kpos] = key;
                }
            }
        }
        __syncthreads();
        const LAS unsigned* my = (const LAS unsigned*)(sc + C.wave * 8192);
        const int nit = nadm / 128;
        const bool tail = (nadm & 64) != 0;
        unsigned thr = 0;
        for (int rep_s = 0; rep_s < IDX_REP_S; ++rep_s) {
            unsigned want = 256u, prefix = 0u;
#pragma unroll 1
            for (int lvl = 0; lvl < 2; ++lvl) {
                hist[lane] = 0u; hist[64 + lane] = 0u; hist[128 + lane] = 0u; hist[192 + lane] = 0u;
                LDS_WAIT(); asm volatile("" ::: "memory");
                int i = 0;
                for (; i + 4 <= nit; i += 4) { unsigned kv[4];
#pragma unroll
                    for (int u = 0; u < 4; ++u) kv[u] = my[64 * (i + u) + lane];
#pragma unroll
                    for (int u = 0; u < 4; ++u) { const unsigned k0 = kv[u] & 0xffffu, k1 = kv[u] >> 16;
                        if (lvl == 0) { atomicAdd((unsigned*)&hist[k0 >> 8], 1u); atomicAdd((unsigned*)&hist[k1 >> 8], 1u); }
                        else { if ((k0 >> 8) == prefix) atomicAdd((unsigned*)&hist[k0 & 255u], 1u); if ((k1 >> 8) == prefix) atomicAdd((unsigned*)&hist[k1 & 255u], 1u); } } }
                for (; i < nit + (tail ? 1 : 0); ++i) { const unsigned kvv = my[64 * i + lane]; const unsigned k0 = kvv & 0xffffu, k1 = kvv >> 16; const bool two = i < nit;
                    if (lvl == 0) { atomicAdd((unsigned*)&hist[k0 >> 8], 1u); if (two) atomicAdd((unsigned*)&hist[k1 >> 8], 1u); }
                    else { if ((k0 >> 8) == prefix) atomicAdd((unsigned*)&hist[k0 & 255u], 1u); if (two && (k1 >> 8) == prefix) atomicAdd((unsigned*)&hist[k1 & 255u], 1u); } }
                LDS_WAIT(); asm volatile("" ::: "memory");
                const unsigned c0 = hist[4 * lane], c1 = hist[4 * lane + 1], c2 = hist[4 * lane + 2], c3 = hist[4 * lane + 3];
                const unsigned tl = c0 + c1 + c2 + c3; unsigned inc = tl;
#pragma unroll
                for (int o = 1; o < 64; o <<= 1) { const unsigned v = __shfl_down(inc, o); if (lane + o < 64) inc += v; }
                const unsigned ab3 = inc - tl, ab2 = ab3 + c3, ab1 = ab2 + c2, ab0 = ab1 + c1;
                int selb = -1; unsigned rem = 0;
                if (ab3 < want && ab3 + c3 >= want) { selb = 3; rem = want - ab3; }
                else if (ab2 < want && ab2 + c2 >= want) { selb = 2; rem = want - ab2; }
                else if (ab1 < want && ab1 + c1 >= want) { selb = 1; rem = want - ab1; }
                else if (ab0 < want && ab0 + c0 >= want) { selb = 0; rem = want - ab0; }
                const u64 bal = __ballot(selb >= 0); const int src = bal ? (int)__ffsll((long long)bal) - 1 : 0;
                const unsigned bin = (unsigned)__shfl(4 * lane + (selb < 0 ? 0 : selb), src); want = (unsigned)__shfl((int)rem, src);
                if (lvl == 0) prefix = bin; else thr = (prefix << 8) | bin;
                LDS_WAIT(); asm volatile("" ::: "memory");
            }
        }
        u64 w0 = 0, w1 = 0;
        for (int i = 0; i < nit + (tail ? 1 : 0); ++i) { const unsigned kvv = my[64 * i + lane]; const u64 b0 = __ballot((kvv & 0xffffu) >= thr), b1 = (i < nit) ? __ballot((kvv >> 16) >= thr) : 0ull;
            if (i < 32) { if (lane == 2 * i) w0 = b0; if (lane == 2 * i + 1) w0 = b1; } else { if (lane == 2 * i - 64) w1 = b0; if (lane == 2 * i - 63) w1 = b1; } }
        MASK[(size_t)qrow * 128 + lane] = w0; MASK[(size_t)qrow * 128 + 64 + lane] = w1;
        __syncthreads();
    }
}
constexpr int AT_KROW = 272, AT_VROW = 136, AT_KB = 64 * AT_KROW, AT_VB = 128 * AT_VROW, AT_BUF = AT_KB + AT_VB;
__device__ __forceinline__ void attn_unit(const Ctx& C, int b, int head, int qb) {
    const bf16* Q = (const bf16*)(C.ws + WS_Q); const bf16* K = (const bf16*)(C.ws + WS_K); const bf16* Vt = (const bf16*)(C.ws + WS_VT);
    const u64* MASK = (const u64*)(C.ws + WS_MASK); bf16* CAT = (bf16*)(C.ws + WS_CAT);
    const int tid = C.tid, lane = C.lane, wid = C.wave, r32 = lane & 31, hi = lane >> 5;
    const int q = 256 * qb + 32 * wid + r32; const size_t row = (size_t)b * T + q;
    const int nt = 4 * qb + 4, myc = 4 * qb + (wid >> 1);
    bf16x8 qf[8];
#pragma unroll
    for (int d0 = 0; d0 < 8; ++d0) qf[d0] = *(const bf16x8*)(Q + row * 1024 + head * 128 + 16 * d0 + 8 * hi);
    const bf16* kg[2]; const bf16* vg[2]; int kl[2], vl[2];
#pragma unroll
    for (int i = 0; i < 2; ++i) { const int c = tid + 512 * i;
        kg[i] = K + ((size_t)b * T + (c >> 4)) * 1024 + head * 128 + (c & 15) * 8; kl[i] = (c >> 4) * AT_KROW + (c & 15) * 16;
        vg[i] = Vt + ((size_t)(b * 8 + head) * 128 + (c >> 3)) * T + (c & 7) * 8; vl[i] = AT_KB + (c >> 3) * AT_VROW + (c & 7) * 16; }
    u32x4 kr[2], vr[2];
#pragma unroll
    for (int i = 0; i < 2; ++i) { kr[i] = *(const u32x4*)kg[i]; vr[i] = *(const u32x4*)vg[i]; }
#pragma unroll
    for (int i = 0; i < 2; ++i) { *(LAS u32x4*)(C.lds + kl[i]) = kr[i]; *(LAS u32x2*)(C.lds + vl[i]) = (u32x2){vr[i].x, vr[i].y}; *(LAS u32x2*)(C.lds + vl[i] + 8) = (u32x2){vr[i].z, vr[i].w}; }
    __syncthreads();
    float lrun = 0.f; f32x16 o[4];
#pragma unroll
    for (int db = 0; db < 4; ++db)
#pragma unroll
        for (int r = 0; r < 16; ++r) o[db][r] = 0.f;
    for (int t = 0; t < nt; ++t) {
        const int cur = (t & 1) * AT_BUF, nxt = ((t + 1) & 1) * AT_BUF;
        if (t + 1 < nt) {
#pragma unroll
            for (int i = 0; i < 2; ++i) { kr[i] = *(const u32x4*)(kg[i] + (size_t)(t + 1) * 64 * 1024); vr[i] = *(const u32x4*)(vg[i] + (t + 1) * 64); }
        }
        if (t <= myc) {
            const u64 mw = MASK[row * 128 + t];
            const LAS unsigned char* Ks = C.lds + cur; const LAS unsigned char* Vs = C.lds + cur + AT_KB;
            f32x16 p0, p1;
#pragma unroll
            for (int r = 0; r < 16; ++r) { p0[r] = 0.f; p1[r] = 0.f; }
#pragma unroll
            for (int d0 = 0; d0 < 8; ++d0) {
                const bf16x8 k0 = *(const LAS bf16x8*)(Ks + r32 * AT_KROW + (16 * d0 + 8 * hi) * 2);
                const bf16x8 k1 = *(const LAS bf16x8*)(Ks + (32 + r32) * AT_KROW + (16 * d0 + 8 * hi) * 2);
                p0 = __builtin_amdgcn_mfma_f32_32x32x16_bf16(k0, qf[d0], p0, 0, 0, 0);
                p1 = __builtin_amdgcn_mfma_f32_32x32x16_bf16(k1, qf[d0], p1, 0, 0, 0);
            }
            const int mlo = (int)((unsigned)mw >> (4 * hi)), mhi = (int)((unsigned)(mw >> 32) >> (4 * hi));
            float ls0 = 0.f, ls1 = 0.f;
#pragma unroll
            for (int r = 0; r < 16; ++r) { const int c = (r & 3) + 8 * (r >> 2);
                const unsigned e0 = __float_as_uint(__builtin_amdgcn_exp2f(p0[r])) & (unsigned)__builtin_amdgcn_sbfe(mlo, c, 1);
                const unsigned e1 = __float_as_uint(__builtin_amdgcn_exp2f(p1[r])) & (unsigned)__builtin_amdgcn_sbfe(mhi, c, 1);
                p0[r] = __uint_as_float(e0); p1[r] = __uint_as_float(e1); ls0 += p0[r]; ls1 += p1[r]; }
            lrun += ls0 + ls1;
            bf16x8 pb[4];
#pragma unroll
            for (int kk = 0; kk < 4; ++kk) { u32x4 w;
#pragma unroll
                for (int e = 0; e < 4; ++e) { const int r = 8 * (kk & 1) + 2 * e; w[e] = (kk < 2) ? pg8::cvt_pk_bf16(p0[r], p0[r + 1]) : pg8::cvt_pk_bf16(p1[r], p1[r + 1]); }
                pb[kk] = __builtin_bit_cast(bf16x8, w); }
#pragma unroll
            for (int db = 0; db < 4; ++db)
#pragma unroll
                for (int kk = 0; kk < 4; ++kk) {
                    const LAS unsigned char* vp = Vs + (32 * db + r32) * AT_VROW + (16 * kk + 4 * hi) * 2;
                    const u32x2 a0 = *(const LAS u32x2*)vp, a1 = *(const LAS u32x2*)(vp + 16);
                    const u32x4 w = {a0.x, a0.y, a1.x, a1.y};
                    o[db] = __builtin_amdgcn_mfma_f32_32x32x16_bf16(__builtin_bit_cast(bf16x8, w), pb[kk], o[db], 0, 0, 0);
                }
        }
        if (t + 1 < nt) {
#pragma unroll
            for (int i = 0; i < 2; ++i) { *(LAS u32x4*)(C.lds + nxt + kl[i]) = kr[i]; *(LAS u32x2*)(C.lds + nxt + vl[i]) = (u32x2){vr[i].x, vr[i].y}; *(LAS u32x2*)(C.lds + nxt + vl[i] + 8) = (u32x2){vr[i].z, vr[i].w}; }
        }
        __syncthreads();
    }
    lrun += __shfl_xor(lrun, 32);
    const float inv = 1.0f / lrun;
    bf16* op = CAT + row * 2048 + head * 128 + 4 * hi;
#pragma unroll
    for (int db = 0; db < 4; ++db)
#pragma unroll
        for (int g = 0; g < 4; ++g) { u32x2 w; w.x = pk2(o[db][4 * g] * inv, o[db][4 * g + 1] * inv); w.y = pk2(o[db][4 * g + 2] * inv, o[db][4 * g + 3] * inv);
            *(u32x2*)(op + 32 * db + 8 * g) = w; }
}
__device__ __forceinline__ void phase_attn(const Ctx& C) {
    for (int i = C.bid; i < 1024; i += C.G) {
        const int w = i & 255, k = i >> 8, combo = w >> 3, j = w & 7;
        const int qb = k == 0 ? j : k == 1 ? 15 - j : k == 2 ? 16 + j : 31 - j;
        attn_unit(C, combo >> 3, combo & 7, qb);
        __syncthreads();
    }
}
__device__ __forceinline__ float ret_logg(int h) { return log1pf(-exp2f(-5.0f - (float)h)); }
constexpr int RT_KP = 72, RT_VP = 136;
__device__ __forceinline__ bf16x8 lds_col8(const LAS bf16* p, int pitch, const int (&rows)[8]) {
    u32x4 w;
#pragma unroll
    for (int e = 0; e < 4; ++e) w[e] = (unsigned)p[rows[2 * e] * pitch] | ((unsigned)p[rows[2 * e + 1] * pitch] << 16);
    return __builtin_bit_cast(bf16x8, w);
}
__device__ __forceinline__ void phase_ret1(const Ctx& C) {
    LAS bf16* Ks = (LAS bf16*)C.lds;
    LAS bf16* Vs = Ks + 64 * RT_KP;
    const bf16* BK = (const bf16*)(C.ws + WS_BK); const bf16* BV = (const bf16*)(C.ws + WS_BV); float* KV = (float*)(C.ws + WS_KVST);
    const int tid = C.tid, lane = C.lane, r32 = lane & 31, hi = lane >> 5, db = C.wave >> 2, eb = C.wave & 3;
    for (int u = C.bid; u < NB * 128 * 4; u += C.G) {
        const int h = u & 3, c = (u >> 2) & 127, b = u >> 9; const size_t row0 = (size_t)b * T + 64 * c; const float lg = ret_logg(h);
        { const int m = tid >> 3, d8 = (tid & 7) * 8; const u32x4 w = *(const u32x4*)(BK + (row0 + m) * 256 + h * 64 + d8); const float z = __expf((63.0f - (float)m) * lg) * 0.125f;
          u32x4 o;
#pragma unroll
          for (int e = 0; e < 4; ++e) o[e] = pk2(bflo(w[e]) * z, bfhi(w[e]) * z);
          *(LAS u32x4*)(Ks + m * RT_KP + d8) = o; }
#pragma unroll
        for (int i = 0; i < 2; ++i) { const int cidx = tid + 512 * i, m = cidx >> 4, e8 = (cidx & 15) * 8; *(LAS u32x4*)(Vs + m * RT_VP + e8) = *(const u32x4*)(BV + (row0 + m) * 512 + h * 128 + e8); }
        __syncthreads();
        f32x16 acc;
#pragma unroll
        for (int r = 0; r < 16; ++r) acc[r] = 0.f;
#pragma unroll
        for (int kk = 0; kk < 4; ++kk) {
            int rows[8];
#pragma unroll
            for (int j = 0; j < 8; ++j) rows[j] = 16 * kk + 8 * hi + j;
            const bf16x8 af = lds_col8(Ks + 32 * db + r32, RT_KP, rows), bfv = lds_col8(Vs + 32 * eb + r32, RT_VP, rows);
            acc = __builtin_amdgcn_mfma_f32_32x32x16_bf16(af, bfv, acc, 0, 0, 0);
        }
        float* dst = KV + (size_t)u * 8192 + (size_t)(32 * eb + r32) * 64 + 32 * db + 4 * hi;
#pragma unroll
        for (int g = 0; g < 4; ++g) *(f32x4*)(dst + 8 * g) = (f32x4){acc[4 * g], acc[4 * g + 1], acc[4 * g + 2], acc[4 * g + 3]};
        __syncthreads();
    }
}
__device__ __forceinline__ void phase_ret2(const Ctx& C) {
    float* KV = (float*)(C.ws + WS_KVST);
    for (int g = C.bid * NTHR + C.tid; g < NB * 4 * 8192; g += C.G * NTHR) {
        const int el = g & 8191, h = (g >> 13) & 3, b = g >> 15; const float gc = __expf(64.0f * ret_logg(h));
        float* p = KV + ((size_t)b * 512 + h) * 8192 + el;
        float st = 0.f;
        for (int c0 = 0; c0 < 128; c0 += 8) { float x[8];
#pragma unroll
            for (int i = 0; i < 8; ++i) x[i] = p[(size_t)(c0 + i) * 4 * 8192];
#pragma unroll
            for (int i = 0; i < 8; ++i) { p[(size_t)(c0 + i) * 4 * 8192] = st; st = st * gc + x[i]; } }
    }
}
__device__ __forceinline__ void phase_ret3(const Ctx& C) {
    LAS bf16* Qs = (LAS bf16*)C.lds;
    LAS bf16* Ks = Qs + 64 * RT_KP;
    LAS bf16* Vs = Ks + 64 * RT_KP;
    LAS float* Red = (LAS float*)(Vs + 64 * RT_VP);
    const bf16* BQ = (const bf16*)(C.ws + WS_BQ); const bf16* BK = (const bf16*)(C.ws + WS_BK); const bf16* BV = (const bf16*)(C.ws + WS_BV); const bf16* BG = (const bf16*)(C.ws + WS_BG);
    const float* KV = (const float*)(C.ws + WS_KVST); bf16* CAT = (bf16*)(C.ws + WS_CAT);
    const int tid = C.tid, lane = C.lane, r32 = lane & 31, hi = lane >> 5, nb = C.wave >> 2, eb = C.wave & 3;
    for (int u = C.bid; u < NB * 128 * 4; u += C.G) {
        const int h = u & 3, c = (u >> 2) & 127, b = u >> 9; const size_t row0 = (size_t)b * T + 64 * c; const float l2g = ret_logg(h) * 1.4426950408889634f;
        { const int m = tid >> 3, d8 = (tid & 7) * 8; *(LAS u32x4*)(Qs + m * RT_KP + d8) = *(const u32x4*)(BQ + (row0 + m) * 256 + h * 64 + d8);
          const u32x4 w = *(const u32x4*)(BK + (row0 + m) * 256 + h * 64 + d8); u32x4 o;
#pragma unroll
          for (int e = 0; e < 4; ++e) o[e] = pk2(bflo(w[e]) * 0.125f, bfhi(w[e]) * 0.125f);
          *(LAS u32x4*)(Ks + m * RT_KP + d8) = o; }
#pragma unroll
        for (int i = 0; i < 2; ++i) { const int cidx = tid + 512 * i, m = cidx >> 4, e8 = (cidx & 15) * 8; *(LAS u32x4*)(Vs + m * RT_VP + e8) = *(const u32x4*)(BV + (row0 + m) * 512 + h * 128 + e8); }
        bf16x8 pf[4];
        { const float* pp = KV + (size_t)u * 8192 + (size_t)(32 * eb + r32) * 64 + 8 * hi;
#pragma unroll
          for (int kk = 0; kk < 4; ++kk) { const f32x4 a0 = *(const f32x4*)(pp + 16 * kk), a1 = *(const f32x4*)(pp + 16 * kk + 4);
              u32x4 w; w.x = pk2(a0.x, a0.y); w.y = pk2(a0.z, a0.w); w.z = pk2(a1.x, a1.y); w.w = pk2(a1.z, a1.w); pf[kk] = __builtin_bit_cast(bf16x8, w); } }
        __syncthreads();
        bf16x8 qf[4];
#pragma unroll
        for (int kk = 0; kk < 4; ++kk) qf[kk] = *(const LAS bf16x8*)(Qs + (32 * nb + r32) * RT_KP + 16 * kk + 8 * hi);
        f32x16 cr, out;
#pragma unroll
        for (int r = 0; r < 16; ++r) { cr[r] = 0.f; out[r] = 0.f; }
#pragma unroll
        for (int kk = 0; kk < 4; ++kk) cr = __builtin_amdgcn_mfma_f32_32x32x16_bf16(qf[kk], pf[kk], cr, 0, 0, 0);
        const float gn = __builtin_amdgcn_exp2f((float)(32 * nb + r32) * l2g);
#pragma unroll
        for (int mb = 0; mb < 2; ++mb) {
            if (mb > nb) continue;
            f32x16 st;
#pragma unroll
            for (int r = 0; r < 16; ++r) st[r] = 0.f;
#pragma unroll
            for (int kk = 0; kk < 4; ++kk) { const bf16x8 kf = *(const LAS bf16x8*)(Ks + (32 * mb + r32) * RT_KP + 16 * kk + 8 * hi); st = __builtin_amdgcn_mfma_f32_32x32x16_bf16(kf, qf[kk], st, 0, 0, 0); }
            const int nq = 32 * nb + r32;
#pragma unroll
            for (int r = 0; r < 16; ++r) { const int m = 32 * mb + (r & 3) + 8 * (r >> 2) + 4 * hi; st[r] = (m <= nq) ? st[r] * gn * __builtin_amdgcn_exp2f(-(float)m * l2g) : 0.f; }
#pragma unroll
            for (int s2 = 0; s2 < 2; ++s2) {
                u32x4 w;
#pragma unroll
                for (int e = 0; e < 4; ++e) w[e] = pg8::cvt_pk_bf16(st[8 * s2 + 2 * e], st[8 * s2 + 2 * e + 1]);
                int rows[8];
#pragma unroll
                for (int j = 0; j < 8; ++j) rows[j] = 32 * mb + 16 * s2 + 8 * (j >> 2) + 4 * hi + (j & 3);
                const bf16x8 vf = lds_col8(Vs + 32 * eb + r32, RT_VP, rows);
                out = __builtin_amdgcn_mfma_f32_32x32x16_bf16(__builtin_bit_cast(bf16x8, w), vf, out, 0, 0, 0);
            }
        }
        float sv[16], s2v[16];
#pragma unroll
        for (int r = 0; r < 16; ++r) { const int n = 32 * nb + (r & 3) + 8 * (r >> 2) + 4 * hi; out[r] += __builtin_amdgcn_exp2f((float)(n + 1) * l2g) * cr[r]; sv[r] = half_sum32(out[r]); s2v[r] = half_sum32(out[r] * out[r]); }
        if (r32 == 0) {
#pragma unroll
            for (int r = 0; r < 16; ++r) { const int n = 32 * nb + (r & 3) + 8 * (r >> 2) + 4 * hi; *(LAS f32x2*)(Red + (n * 4 + eb) * 2) = (f32x2){sv[r], s2v[r]}; }
        }
        __syncthreads();
#pragma unroll
        for (int r = 0; r < 16; ++r) { const int n = 32 * nb + (r & 3) + 8 * (r >> 2) + 4 * hi;
            const f32x4 p0 = *(const LAS f32x4*)(Red + n * 8), p1 = *(const LAS f32x4*)(Red + n * 8 + 4);
            const float mean = (p0.x + p0.z + p1.x + p1.z) * (1.0f / 128.0f), ex2 = (p0.y + p0.w + p1.y + p1.w) * (1.0f / 128.0f);
            const float rstd = rsqrtf(fmaxf(ex2 - mean * mean, 0.f) + 1e-5f);
            const float gg = bf2f(BG[(row0 + n) * 512 + h * 128 + 32 * eb + r32]); const float sl = gg * __builtin_amdgcn_rcpf(1.0f + __expf(-gg));
            CAT[(row0 + n) * 2048 + 1024 + h * 128 + 32 * eb + r32] = (bf16)f2bf((out[r] - mean) * rstd * sl); }
        __syncthreads();
    }
}
__device__ __forceinline__ float sigmoidf_(float x) { return __builtin_amdgcn_rcpf(1.0f + __expf(-x)); }
constexpr int RW_AW = 104, RW_AV = 72, RW_AG = 264;
constexpr int RW1_BUF = 32 * RW_AW * 2 + 32 * RW_AV;
struct RwP { const float *mu, *mu_v, *w0, *a0, *v0, *k_k, *k_a, *r_k, *lnx_g, *lnx_b; };
template <class TT> __device__ __forceinline__ GAS TT* opaque_g(const TT* p) {
    unsigned lo = (unsigned)(uintptr_t)p, hi = (unsigned)((uintptr_t)p >> 32); asm volatile("" : "+v"(lo), "+v"(hi));
    lo = __builtin_amdgcn_readfirstlane(lo); hi = __builtin_amdgcn_readfirstlane(hi); return (GAS TT*)(((uintptr_t)hi << 32) | lo);
}
__device__ __forceinline__ int tokr(int r, int hi) { return (r & 3) + 8 * (r >> 2) + 4 * hi; }
__device__ __forceinline__ void shifted16(GAS bf16* ub, const unsigned (&off)[16], int cbo, bool first_unit, int hi, float mu, float (&x)[16]) {
    float cur[16], prv[4];
#pragma unroll
    for (int r = 0; r < 16; ++r) cur[r] = bf2f(at_b(ub, off[r])[cbo]);
#pragma unroll
    for (int g = 0; g < 4; ++g) { const bool first = (g == 0) && (hi == 0) && first_unit; prv[g] = first ? 0.f : bf2f(at_b(ub, off[4 * g])[cbo - 512]); }
#pragma unroll
    for (int r = 0; r < 16; ++r) { const float p = (r & 3) == 0 ? prv[r >> 2] : cur[r - 1]; x[r] = cur[r] + (p - cur[r]) * mu; }
}
__device__ __forceinline__ void phase_rw1(const Ctx& C, int layer, const RwP& P) {
    LAS bf16* ACT = (LAS bf16*)C.lds;
    const bf16* CR = (const bf16*)(C.ws + WS_CR); const bf16* CK = (const bf16*)(C.ws + WS_CK); const bf16* CV = (const bf16*)(C.ws + WS_CV); const bf16* CL = (const bf16*)(C.ws + WS_CL);
    const bf16* LW = (const bf16*)(C.ws + WS_LORA + LO_W); const bf16* LA = (const bf16*)(C.ws + WS_LORA + LO_A); const bf16* LV = (const bf16*)(C.ws + WS_LORA + LO_V);
    bf16* VF = (bf16*)(C.ws + WS_VFIRST);
    bf16* RR = (bf16*)(C.ws + WS_RR); bf16* RU = (bf16*)(C.ws + WS_RW); bf16* RKH = (bf16*)(C.ws + WS_RKH); bf16* RV = (bf16*)(C.ws + WS_RV); bf16* RA = (bf16*)(C.ws + WS_RA); bf16* RB = (bf16*)(C.ws + WS_RB);
    const float* mu = P.mu + (size_t)layer * 1984; const float* mu_v = P.mu_v;
    const float* w0 = P.w0 + layer * 512; const float* a0 = P.a0 + layer * 512; const float* v0 = P.v0; const float* k_k = P.k_k + layer * 512; const float* k_a = P.k_a + layer * 512;
    const int tid = C.tid, lane = C.lane, wid = C.wave;
    constexpr int NU = M / 32;
    u32x4 ncur[2], nprv[2];
#define RW1_LOAD(uu) do { _Pragma("unroll") for (int j = 0; j < 2; ++j) { const int ci = tid + 512 * j, tok = ci >> 5, c8 = (ci & 31) * 8; const size_t mm = (size_t)(uu) * 32 + tok; \
        ncur[j] = *(const u32x4*)(CL + mm * 256 + c8); const u32x4 z4 = {0u, 0u, 0u, 0u}; nprv[j] = (mm & (T - 1)) == 0 ? z4 : *(const u32x4*)(CL + (mm - 1) * 256 + c8); } } while (0)
#define RW1_STORE(bufi) do { _Pragma("unroll") for (int j = 0; j < 2; ++j) { const int ci = tid + 512 * j, tok = ci >> 5, c8 = (ci & 31) * 8; \
        const float* mp = c8 < 192 ? mu + 1536 + c8 : mu_v + (c8 - 192); f32x4 m0v = {0.f, 0.f, 0.f, 0.f}, m1v = m0v; if (c8 < 192 || layer > 0) { m0v = *(const f32x4*)mp; m1v = *(const f32x4*)(mp + 4); } \
        float xs[8]; _Pragma("unroll") for (int e = 0; e < 4; ++e) { const float c0 = bflo(ncur[j][e]), c1 = bfhi(ncur[j][e]), p0 = bflo(nprv[j][e]), p1 = bfhi(nprv[j][e]); \
            const float ma = e < 2 ? m0v[2 * e] : m1v[2 * e - 4], mb = e < 2 ? m0v[2 * e + 1] : m1v[2 * e - 3]; xs[2 * e] = c0 + (p0 - c0) * ma; xs[2 * e + 1] = c1 + (p1 - c1) * mb; } \
        if (c8 < 96) { _Pragma("unroll") for (int e = 0; e < 8; ++e) xs[e] = 1.0f - 2.0f * __builtin_amdgcn_rcpf(__expf(2.0f * xs[e]) + 1.0f); }     \
        u32x4 o; o.x = pk2(xs[0], xs[1]); o.y = pk2(xs[2], xs[3]); o.z = pk2(xs[4], xs[5]); o.w = pk2(xs[6], xs[7]); \
        LAS bf16* dst = ACT + (bufi) * RW1_BUF + (c8 < 96 ? tok * RW_AW + c8 : c8 < 192 ? 32 * RW_AW + tok * RW_AW + (c8 - 96) : 64 * RW_AW + tok * RW_AV + (c8 - 192)); \
        *(LAS u32x4*)dst = o; } } while (0)
    int u = C.bid; if (u >= NU) return;
    RW1_LOAD(u); RW1_STORE(0); __syncthreads();
    for (int kbuf = 0; ; kbuf ^= 1) {
        const int un = u + C.G; const bool has_next = un < NU;
        if (has_next) RW1_LOAD(un);
        {
            int r32 = lane & 31, hi = lane >> 5; asm volatile("" : "+v"(r32), "+v"(hi));
            const size_t m0 = (size_t)u * 32; const bool first_unit = (m0 & (T - 1)) == 0;
            const LAS bf16* AW = ACT + kbuf * RW1_BUF; const LAS bf16* AA = AW + 32 * RW_AW; const LAS bf16* AV = AA + 32 * RW_AW;
            unsigned off[16];
#pragma unroll
            for (int r = 0; r < 16; ++r) off[r] = (unsigned)(tokr(r, hi) * 512 + 64 * wid + r32) * 2u;
            GAS bf16* CRu = opaque_g(CR + m0 * 512); GAS bf16* CKu = opaque_g(CK + m0 * 512); GAS bf16* CVu = opaque_g(CV + m0 * 512); GAS bf16* VFu = opaque_g(VF + m0 * 512);
            GAS bf16* RRu = opaque_g(RR + m0 * 512); GAS bf16* RUu = opaque_g(RU + m0 * 512); GAS bf16* RKHu = opaque_g(RKH + m0 * 512); GAS bf16* RVu = opaque_g(RV + m0 * 512); GAS bf16* RAu = opaque_g(RA + m0 * 512); GAS bf16* RBu = opaque_g(RB + m0 * 512);
            float ks[2][16], inv[16];
            {
                float ssr[16];
#pragma unroll
                for (int r = 0; r < 16; ++r) ssr[r] = 0.f;
#pragma unroll
                for (int cb = 0; cb < 2; ++cb) { const int c = 64 * wid + 32 * cb + r32; const float kkc = k_k[c]; shifted16(CKu, off, 32 * cb, first_unit, hi, mu[512 + c], ks[cb]);
#pragma unroll
                    for (int r = 0; r < 16; ++r) { const float kr = ks[cb][r] * kkc; ssr[r] += kr * kr; } }
#pragma unroll
                for (int r = 0; r < 16; ++r) inv[r] = 1.0f / fmaxf(sqrtf(half_sum32(ssr[r])), 1e-12f);
            }
#pragma unroll
            for (int cb = 0; cb < 2; ++cb) {
                const int c = 64 * wid + 32 * cb + r32; const int ci = 32 * cb;
                asm volatile("" : "+v"(off[0]), "+v"(off[1]), "+v"(off[2]), "+v"(off[3]), "+v"(off[4]), "+v"(off[5]), "+v"(off[6]), "+v"(off[7]), "+v"(off[8]), "+v"(off[9]), "+v"(off[10]), "+v"(off[11]), "+v"(off[12]), "+v"(off[13]), "+v"(off[14]), "+v"(off[15]));
                {
                    float rs[16]; shifted16(CRu, off, ci, first_unit, hi, mu[c], rs);
#pragma unroll
                    for (int r = 0; r < 16; ++r) at_b(RRu, off[r])[ci] = (bf16)f2bf(rs[r]);
                }
                asm volatile("" ::: "memory");
                {
                    float vs[16]; shifted16(CVu, off, ci, first_unit, hi, mu[1024 + c], vs);
                    if (layer > 0) {
                        f32x16 dv;
#pragma unroll
                        for (int r = 0; r < 16; ++r) dv[r] = 0.f;
#pragma unroll
                        for (int kk = 0; kk < 4; ++kk) { const bf16x8 wv = *(const bf16x8*)(LV + c * 64 + 16 * kk + 8 * hi); const bf16x8 xv = *(const LAS bf16x8*)(AV + r32 * RW_AV + 16 * kk + 8 * hi);
                            dv = __builtin_amdgcn_mfma_f32_32x32x16_bf16(xv, wv, dv, 0, 0, 0); }
                        const float v0c = v0[c];
#pragma unroll
                        for (int r = 0; r < 16; ++r) { const float vf = bf2f(at_b(VFu, off[r])[ci]); at_b(RVu, off[r])[ci] = (bf16)f2bf(vs[r] + (vf - vs[r]) * sigmoidf_(v0c + dv[r])); }
                    } else {
#pragma unroll
                        for (int r = 0; r < 16; ++r) { const bf16 vb = (bf16)f2bf(vs[r]); at_b(VFu, off[r])[ci] = vb; at_b(RVu, off[r])[ci] = vb; }
                    }
                }
                asm volatile("" ::: "memory");
                {
                    f32x16 dw;
#pragma unroll
                    for (int r = 0; r < 16; ++r) dw[r] = 0.f;
#pragma unroll
                    for (int kk = 0; kk < 6; ++kk) { const bf16x8 ww = *(const bf16x8*)(LW + c * 96 + 16 * kk + 8 * hi); const bf16x8 xw = *(const LAS bf16x8*)(AW + r32 * RW_AW + 16 * kk + 8 * hi);
                        dw = __builtin_amdgcn_mfma_f32_32x32x16_bf16(xw, ww, dw, 0, 0, 0); }
                    const float w0c = w0[c];
#pragma unroll
                    for (int r = 0; r < 16; ++r) { const float z = -(w0c + dw[r]); const float sp = fmaxf(z, 0.f) + __logf(1.0f + __expf(-fabsf(z)));
                        at_b(RUu, off[r])[ci] = (bf16)f2bf(1.0f - __expf(-__expf(-sp - 0.5f))); }
                }
                asm volatile("" ::: "memory");
                {
                    f32x16 da;
#pragma unroll
                    for (int r = 0; r < 16; ++r) da[r] = 0.f;
#pragma unroll
                    for (int kk = 0; kk < 6; ++kk) { const bf16x8 wa = *(const bf16x8*)(LA + c * 96 + 16 * kk + 8 * hi); const bf16x8 xa = *(const LAS bf16x8*)(AA + r32 * RW_AW + 16 * kk + 8 * hi);
                        da = __builtin_amdgcn_mfma_f32_32x32x16_bf16(xa, wa, da, 0, 0, 0); }
                    const float a0c = a0[c], kkc = k_k[c], kac = k_a[c];
#pragma unroll
                    for (int r = 0; r < 16; ++r) { const float a = sigmoidf_(a0c + da[r]); const float ksx = ks[cb][r]; const float kk = ksx * kkc * inv[r];
                        at_b(RKHu, off[r])[ci] = (bf16)f2bf(ksx * (1.0f + (a - 1.0f) * kac)); at_b(RAu, off[r])[ci] = (bf16)f2bf(-kk); at_b(RBu, off[r])[ci] = (bf16)f2bf(kk * a); }
                }
                asm volatile("" ::: "memory");
            }
        }
        if (has_next) RW1_STORE(kbuf ^ 1);
        __syncthreads();
        if (!has_next) break;
        u = un;
    }
#undef RW1_LOAD
#undef RW1_STORE
}
constexpr int RW_L = 128, RW_NC = T / RW_L;
constexpr int RW_TB = 8, RW_STG = 5 * RW_TB * 64 + 64;
__device__ __forceinline__ float xhalf_sum(float x) { const auto rr = __builtin_amdgcn_permlane32_swap(__float_as_uint(x), __float_as_uint(x), false, false); return __uint_as_float(rr[0]) + __uint_as_float(rr[1]); }
__device__ __forceinline__ float dot32(const f32x16& d0, const f32x16& d1, const f32x4 (&v)[2][4]) {
    f32x2 acc = {0.f, 0.f};
#pragma unroll
    for (int g = 0; g < 4; ++g) { acc += (f32x2){d0[4 * g], d0[4 * g + 1]} * (f32x2){v[0][g].x, v[0][g].y}; acc += (f32x2){d0[4 * g + 2], d0[4 * g + 3]} * (f32x2){v[0][g].z, v[0][g].w};
        acc += (f32x2){d1[4 * g], d1[4 * g + 1]} * (f32x2){v[1][g].x, v[1][g].y}; acc += (f32x2){d1[4 * g + 2], d1[4 * g + 3]} * (f32x2){v[1][g].z, v[1][g].w}; }
    return acc.x + acc.y;
}
template <int NS, bool OUT>
__device__ __forceinline__ void rwkv_chunk(f32x16 (&D)[NS][2][2], LAS float* stg, const bf16* RWd, const bf16* RA, const bf16* RB, const bf16* RKH, const bf16* RV, const bf16* RR, float* Y, size_t base0, int nsteps, int lane) {
    const int r32 = lane & 31, hi = lane >> 5;
    unsigned short qw[RW_TB], qa[RW_TB], qr[RW_TB], qb[RW_TB], qk[RW_TB], qv[RW_TB];
#define RWC_LOAD(tt) do { _Pragma("unroll") for (int s = 0; s < RW_TB; ++s) { const size_t o = base0 + (size_t)((tt) + s) * 512 + lane; qw[s] = RWd[o]; qa[s] = RA[o]; if (OUT) qr[s] = RR[o]; qb[s] = RB[o]; qk[s] = RKH[o]; qv[s] = RV[o]; } } while (0)
    RWC_LOAD(0);
    float G = 1.0f;
    for (int t0 = 0; t0 < nsteps; t0 += RW_TB) {
#pragma unroll
        for (int s = 0; s < RW_TB; ++s) { const float w = 1.0f - bf2f(qw[s]); stg[(0 * RW_TB + s) * 64 + lane] = bf2f(qa[s]) * G; G *= w; const float ig = __builtin_amdgcn_rcpf(G);
            if (OUT) stg[(1 * RW_TB + s) * 64 + lane] = bf2f(qr[s]) * G; stg[(2 * RW_TB + s) * 64 + lane] = bf2f(qb[s]) * ig; stg[(3 * RW_TB + s) * 64 + lane] = bf2f(qk[s]) * ig; stg[(4 * RW_TB + s) * 64 + lane] = bf2f(qv[s]); }
        if (t0 + RW_TB < nsteps) RWC_LOAD(t0 + RW_TB);
        LDS_WAIT(); asm volatile("" ::: "memory");
#pragma unroll 1
        for (int s = 0; s < RW_TB; ++s) {
            const LAS float* sa_ = stg + (0 * RW_TB + s) * 64 + 4 * hi; const LAS float* sr = stg + (1 * RW_TB + s) * 64 + 4 * hi;
            const LAS float* sbk = stg + ((hi ? 3 : 2) * RW_TB + s) * 64 + r32; const LAS float* sv = stg + (4 * RW_TB + s) * 64 + r32;
            const float bk0 = sbk[0], bk1 = sbk[32], v0 = sv[0], v1 = sv[32];
            float sav[NS][2];
            {
                f32x4 av[2][4];
#pragma unroll
                for (int jb = 0; jb < 2; ++jb)
#pragma unroll
                    for (int g = 0; g < 4; ++g) av[jb][g] = *(const LAS f32x4*)(sa_ + 32 * jb + 8 * g);
#pragma unroll
                for (int st = 0; st < NS; ++st)
#pragma unroll
                    for (int ib = 0; ib < 2; ++ib) sav[st][ib] = xhalf_sum(dot32(D[st][0][ib], D[st][1][ib], av));
            }
#pragma unroll
            for (int st = 0; st < NS; ++st) {
                const bool inject = (NS == 1) || (st == 1);
#pragma unroll
                for (int jb = 0; jb < 2; ++jb) { const float bkj = jb == 0 ? bk0 : bk1; const float A = inject ? bkj : (hi ? 0.f : bkj);
#pragma unroll
                    for (int ib = 0; ib < 2; ++ib) { const float B = hi ? (ib == 0 ? v0 : v1) : sav[st][ib];
                        D[st][jb][ib] = __builtin_amdgcn_mfma_f32_32x32x2f32(A, B, D[st][jb][ib], 0, 0, 0); } }
            }
            if (OUT) {
                f32x4 rv[2][4];
#pragma unroll
                for (int jb = 0; jb < 2; ++jb)
#pragma unroll
                    for (int g = 0; g < 4; ++g) rv[jb][g] = *(const LAS f32x4*)(sr + 32 * jb + 8 * g);
#pragma unroll
                for (int ib = 0; ib < 2; ++ib) { const float y = xhalf_sum(dot32(D[NS - 1][0][ib], D[NS - 1][1][ib], rv));
                    if (hi == 0) Y[base0 + (size_t)(t0 + s) * 512 + 32 * ib + r32] = y; }
            }
        }
        LDS_WAIT(); asm volatile("" ::: "memory");
    }
#undef RWC_LOAD
    stg[5 * RW_TB * 64 + lane] = G;
    LDS_WAIT(); asm volatile("" ::: "memory");
    {
        f32x4 gv[2][4];
#pragma unroll
        for (int jb = 0; jb < 2; ++jb)
#pragma unroll
            for (int g = 0; g < 4; ++g) gv[jb][g] = *(const LAS f32x4*)(stg + 5 * RW_TB * 64 + 4 * hi + 32 * jb + 8 * g);
#pragma unroll
        for (int st = 0; st < NS; ++st)
#pragma unroll
            for (int jb = 0; jb < 2; ++jb)
#pragma unroll
                for (int ib = 0; ib < 2; ++ib)
#pragma unroll
                    for (int g = 0; g < 4; ++g) { f32x16& d = D[st][jb][ib]; d[4 * g] *= gv[jb][g].x; d[4 * g + 1] *= gv[jb][g].y; d[4 * g + 2] *= gv[jb][g].z; d[4 * g + 3] *= gv[jb][g].w; }
    }
    LDS_WAIT(); asm volatile("" ::: "memory");
}
__device__ __forceinline__ void phase_rw2(const Ctx& C) {
    const bf16* RWd = (const bf16*)(C.ws + WS_RW); const bf16* RA = (const bf16*)(C.ws + WS_RA); const bf16* RB = (const bf16*)(C.ws + WS_RB); const bf16* RKH = (const bf16*)(C.ws + WS_RKH); const bf16* RV = (const bf16*)(C.ws + WS_RV);
    float* PHI = (float*)(C.ws + WS_PHI); float* PSI = (float*)(C.ws + WS_PSI);
    LAS float* stg = (LAS float*)C.lds + C.wave * RW_STG;
    const int ntask = NB * 8 * RW_NC, r32 = C.lane & 31, hi = C.lane >> 5;
    for (int task = C.wave * C.G + C.bid; task < ntask; task += C.G * NWAVES) {
        const int ck = task % RW_NC, bh = task / RW_NC, h = bh & 7, b = bh >> 3;
        const size_t base0 = ((size_t)b * T + (size_t)ck * RW_L) * 512 + h * 64;
        f32x16 D[2][2][2];
#pragma unroll
        for (int jb = 0; jb < 2; ++jb)
#pragma unroll
            for (int ib = 0; ib < 2; ++ib)
#pragma unroll
                for (int r = 0; r < 16; ++r) { D[0][jb][ib][r] = (jb == ib && ((r & 3) + 8 * (r >> 2) + 4 * hi) == r32) ? 1.f : 0.f; D[1][jb][ib][r] = 0.f; }
        rwkv_chunk<2, false>(D, stg, RWd, RA, RB, RKH, RV, nullptr, nullptr, base0, RW_L, C.lane);
#pragma unroll
        for (int st = 0; st < 2; ++st) { float* dst = (st == 0 ? PHI : PSI) + (size_t)task * 4096;
#pragma unroll
            for (int jb = 0; jb < 2; ++jb)
#pragma unroll
                for (int ib = 0; ib < 2; ++ib)
#pragma unroll
                    for (int g = 0; g < 4; ++g) *(f32x4*)(dst + (32 * ib + r32) * 64 + 32 * jb + 8 * g + 4 * hi) = (f32x4){D[st][jb][ib][4 * g], D[st][jb][ib][4 * g + 1], D[st][jb][ib][4 * g + 2], D[st][jb][ib][4 * g + 3]}; }
    }
}
constexpr int R3_P = 65;
__device__ __forceinline__ void phase_rw3(const Ctx& C) {
    const float* PHI = (const float*)(C.ws + WS_PHI); const float* PSI = (const float*)(C.ws + WS_PSI); float* SST = (float*)(C.ws + WS_SST);
    const int half = C.wave >> 2, w4 = C.wave & 3, ibo = w4 >> 1, kb = w4 & 1, r32 = C.lane & 31, hi = C.lane >> 5;
    LAS float* Sl = (LAS float*)C.lds + half * (2 * 64 * R3_P);
    for (int pr = C.bid; pr < NB * 8 / 2; pr += C.G) {
        const int bh = 2 * pr + half;
        f32x16 acc;
#pragma unroll
        for (int r = 0; r < 16; ++r) acc[r] = 0.f;
        float ph[32], psn[16];
#define R3_LOAD(tk) do { _Pragma("unroll") for (int s = 0; s < 32; ++s) ph[s] = PHI[(tk) * 4096 + (2 * s + hi) * 64 + 32 * kb + r32]; \
        _Pragma("unroll") for (int r = 0; r < 16; ++r) psn[r] = PSI[(tk) * 4096 + (32 * ibo + (r & 3) + 8 * (r >> 2) + 4 * hi) * 64 + 32 * kb + r32]; } while (0)
        R3_LOAD((size_t)bh * RW_NC);
        for (int ck = 0; ck < RW_NC; ++ck) {
            const size_t task = (size_t)bh * RW_NC + ck; LAS float* Sb = Sl + (ck & 1) * (64 * R3_P);
            float* dst = SST + task * 4096;
#pragma unroll
            for (int r = 0; r < 16; ++r) { const int i = 32 * ibo + (r & 3) + 8 * (r >> 2) + 4 * hi; dst[i * 64 + 32 * kb + r32] = acc[r]; Sb[i * R3_P + 32 * kb + r32] = acc[r]; }
            if (ck + 1 == RW_NC) break;
            float pc[32];
#pragma unroll
            for (int s = 0; s < 32; ++s) pc[s] = ph[s];
#pragma unroll
            for (int r = 0; r < 16; ++r) acc[r] = psn[r];
            if (ck + 2 < RW_NC) R3_LOAD(task + 1);
            __syncthreads();
#pragma unroll
            for (int s = 0; s < 32; ++s) { const float a = Sb[(32 * ibo + r32) * R3_P + 2 * s + hi]; acc = __builtin_amdgcn_mfma_f32_32x32x2f32(a, pc[s], acc, 0, 0, 0); }
        }
#undef R3_LOAD
        __syncthreads();
    }
}
__device__ __forceinline__ void phase_rw4(const Ctx& C) {
    const bf16* RWd = (const bf16*)(C.ws + WS_RW); const bf16* RA = (const bf16*)(C.ws + WS_RA); const bf16* RB = (const bf16*)(C.ws + WS_RB); const bf16* RKH = (const bf16*)(C.ws + WS_RKH); const bf16* RV = (const bf16*)(C.ws + WS_RV); const bf16* RR = (const bf16*)(C.ws + WS_RR);
    const float* SST = (const float*)(C.ws + WS_SST); float* Y = (float*)(C.ws + WS_Y);
    LAS float* stg = (LAS float*)C.lds + C.wave * RW_STG;
    const int ntask = NB * 8 * RW_NC, r32 = C.lane & 31, hi = C.lane >> 5;
    for (int task = C.wave * C.G + C.bid; task < ntask; task += C.G * NWAVES) {
        const int ck = task % RW_NC, bh = task / RW_NC, h = bh & 7, b = bh >> 3;
        const size_t base0 = ((size_t)b * T + (size_t)ck * RW_L) * 512 + h * 64;
        f32x16 D[1][2][2]; const float* src = SST + (size_t)task * 4096;
#pragma unroll
        for (int jb = 0; jb < 2; ++jb)
#pragma unroll
            for (int ib = 0; ib < 2; ++ib)
#pragma unroll
                for (int g = 0; g < 4; ++g) { const f32x4 v = *(const f32x4*)(src + (32 * ib + r32) * 64 + 32 * jb + 8 * g + 4 * hi); D[0][jb][ib][4 * g] = v.x; D[0][jb][ib][4 * g + 1] = v.y; D[0][jb][ib][4 * g + 2] = v.z; D[0][jb][ib][4 * g + 3] = v.w; }
        rwkv_chunk<1, true>(D, stg, RWd, RA, RB, RKH, RV, RR, Y, base0, RW_L, C.lane);
    }
}
__device__ __forceinline__ void phase_rw5(const Ctx& C, int layer, const RwP& P) {
    LAS bf16* ACT = (LAS bf16*)C.lds;
    const bf16* CG = (const bf16*)(C.ws + WS_CG); const bf16* LG = (const bf16*)(C.ws + WS_LORA + LO_G);
    const float* Y = (const float*)(C.ws + WS_Y); const bf16* RR = (const bf16*)(C.ws + WS_RR); const bf16* RKH = (const bf16*)(C.ws + WS_RKH); const bf16* RV = (const bf16*)(C.ws + WS_RV);
    bf16* CAT = (bf16*)(C.ws + WS_CAT);
    const float* mu = P.mu + (size_t)layer * 1984 + 1728; const float* r_k = P.r_k + layer * 512; const float* lnx_g = P.lnx_g + layer * 512; const float* lnx_b = P.lnx_b + layer * 512;
    const int tid = C.tid, lane = C.lane, wid = C.wave;
    constexpr int NU = M / 32;
    u32x4 ncur[2], nprv[2];
#define RW5_LOAD(uu) do { _Pragma("unroll") for (int j = 0; j < 2; ++j) { const int ci = tid + 512 * j, tok = ci >> 5, c8 = (ci & 31) * 8; const size_t mm = (size_t)(uu) * 32 + tok; \
        ncur[j] = *(const u32x4*)(CG + mm * 256 + c8); const u32x4 z4 = {0u, 0u, 0u, 0u}; nprv[j] = (mm & (T - 1)) == 0 ? z4 : *(const u32x4*)(CG + (mm - 1) * 256 + c8); } } while (0)
#define RW5_STORE(bufi) do { _Pragma("unroll") for (int j = 0; j < 2; ++j) { const int ci = tid + 512 * j, tok = ci >> 5, c8 = (ci & 31) * 8; \
        const f32x4 m0v = *(const f32x4*)(mu + c8), m1v = *(const f32x4*)(mu + c8 + 4); \
        float xs[8]; _Pragma("unroll") for (int e = 0; e < 4; ++e) { const float c0 = bflo(ncur[j][e]), c1 = bfhi(ncur[j][e]), p0 = bflo(nprv[j][e]), p1 = bfhi(nprv[j][e]); \
            const float ma = e < 2 ? m0v[2 * e] : m1v[2 * e - 4], mb = e < 2 ? m0v[2 * e + 1] : m1v[2 * e - 3]; xs[2 * e] = sigmoidf_(c0 + (p0 - c0) * ma); xs[2 * e + 1] = sigmoidf_(c1 + (p1 - c1) * mb); } \
        u32x4 o; o.x = pk2(xs[0], xs[1]); o.y = pk2(xs[2], xs[3]); o.z = pk2(xs[4], xs[5]); o.w = pk2(xs[6], xs[7]); \
        *(LAS u32x4*)(ACT + (bufi) * (32 * RW_AG) + tok * RW_AG + c8) = o; } } while (0)
    int u = C.bid; if (u >= NU) return;
    RW5_LOAD(u); RW5_STORE(0); __syncthreads();
    for (int kbuf = 0; ; kbuf ^= 1) {
        const int un = u + C.G; const bool has_next = un < NU;
        if (has_next) RW5_LOAD(un);
        {
            int r32 = lane & 31, hi = lane >> 5; asm volatile("" : "+v"(r32), "+v"(hi));
            const size_t m0 = (size_t)u * 32; const LAS bf16* AG = ACT + kbuf * (32 * RW_AG);
            unsigned off[16];
#pragma unroll
            for (int r = 0; r < 16; ++r) off[r] = (unsigned)(tokr(r, hi) * 512 + 64 * wid + r32) * 2u;
            GAS float* Yu = opaque_g(Y + m0 * 512); GAS bf16* RRu = opaque_g(RR + m0 * 512); GAS bf16* RKHu = opaque_g(RKH + m0 * 512); GAS bf16* RVu = opaque_g(RV + m0 * 512); GAS bf16* CATu = opaque_g(CAT + m0 * 2048 + 1536);
            float yv[2][16], sy[16], sq[16], sb[16];
#pragma unroll
            for (int r = 0; r < 16; ++r) { sy[r] = 0.f; sq[r] = 0.f; sb[r] = 0.f; }
#pragma unroll
            for (int cb = 0; cb < 2; ++cb) { const int c = 64 * wid + 32 * cb + r32; const float rkc = r_k[c];
                asm volatile("" : "+v"(off[0]), "+v"(off[1]), "+v"(off[2]), "+v"(off[3]), "+v"(off[4]), "+v"(off[5]), "+v"(off[6]), "+v"(off[7]), "+v"(off[8]), "+v"(off[9]), "+v"(off[10]), "+v"(off[11]), "+v"(off[12]), "+v"(off[13]), "+v"(off[14]), "+v"(off[15]));
#pragma unroll
                for (int r = 0; r < 16; ++r) { const unsigned o = off[r]; const int ci = 32 * cb; const float y = at_b(Yu, 2u * o)[ci]; yv[cb][r] = y; sy[r] += y; sq[r] += y * y; sb[r] += bf2f(at_b(RRu, o)[ci]) * bf2f(at_b(RKHu, o)[ci]) * rkc; } }
#pragma unroll
            for (int r = 0; r < 16; ++r) { const float mean = half_sum32(sy[r]) * (1.0f / 64.0f); const float ex2 = half_sum32(sq[r]) * (1.0f / 64.0f); sb[r] = half_sum32(sb[r]);
                sy[r] = mean; sq[r] = rsqrtf(fmaxf(ex2 - mean * mean, 0.f) + 64e-5f); }
#pragma unroll
            for (int cb = 0; cb < 2; ++cb) { const int c = 64 * wid + 32 * cb + r32;
                f32x16 dg;
#pragma unroll
                for (int r = 0; r < 16; ++r) dg[r] = 0.f;
#pragma unroll
                for (int kk = 0; kk < 16; ++kk) { const bf16x8 wg = *(const bf16x8*)(LG + c * 256 + 16 * kk + 8 * hi); const bf16x8 xg = *(const LAS bf16x8*)(AG + r32 * RW_AG + 16 * kk + 8 * hi);
                    dg = __builtin_amdgcn_mfma_f32_32x32x16_bf16(xg, wg, dg, 0, 0, 0); }
                const float lgc = lnx_g[c], lbc = lnx_b[c];
#pragma unroll
                for (int r = 0; r < 16; ++r) { const unsigned o = off[r]; const int ci = 32 * cb; const float v = bf2f(at_b(RVu, o)[ci]);
                    at_b(CATu, (unsigned)(tokr(r, hi) * 2048 + 64 * wid + r32) * 2u)[ci] = (bf16)f2bf(((yv[cb][r] - sy[r]) * sq[r] * lgc + lbc + sb[r] * v) * dg[r]); }
            }
        }
        if (has_next) RW5_STORE(kbuf ^ 1);
        __syncthreads();
        if (!has_next) break;
        u = un;
    }
#undef RW5_LOAD
#undef RW5_STORE
}
__device__ __forceinline__ void* launder_ptr(const void* p) {
    unsigned lo = (unsigned)(uintptr_t)p, hi = (unsigned)((uintptr_t)p >> 32); asm volatile("" : "+v"(lo), "+v"(hi));
    lo = __builtin_amdgcn_readfirstlane(lo); hi = __builtin_amdgcn_readfirstlane(hi); return (void*)(((uintptr_t)hi << 32) | lo);
}
#ifndef MK_PER_PHASE
#define MK_PER_PHASE 0
#endif
constexpr int PH_PER_LAYER = 13, N_PHASES = DEPTH * PH_PER_LAYER + 1;
struct Args { const float* in[23]; float* out; unsigned char* ws; int ph_lo, ph_hi; };
#define FRESH() do { KA = (const CAS Args*)launder_ptr((const void*)(uintptr_t)__builtin_amdgcn_kernarg_segment_ptr()); C.ws = KA->ws; C.out = KA->out; ctl = (unsigned*)(C.ws + WS_CTL); asm volatile("" : "+v"(C.tid)); C.lane = C.tid & 63; C.wave = __builtin_amdgcn_readfirstlane(C.tid >> 6); C.lds = (LAS unsigned char*)lds_raw; } while (0)
#ifndef ATT_REP
#define ATT_REP 1
#endif
#ifndef REP_MASK
#define REP_MASK 0u
#endif
#ifndef ONLY_PH
#define ONLY_PH -1
#endif
#ifndef PH_MASK
#define PH_MASK 0xFFFFFFFFu
#endif
#define IN(k) (lo <= (k) && (k) < hi && (ONLY_PH < 0 || ((k) % PH_PER_LAYER) == ONLY_PH) && ((PH_MASK >> ((k) % PH_PER_LAYER)) & 1u))
#define SEAM(k) do { if (IN(k) && IN((k) + 1)) { bar.bar = ctl + CW_BAR; xcd_barrier(bar); } } while (0)
#define PH_BODY(k, ...) do { FRESH(); if (IN(p0 + (k))) { __VA_ARGS__; if ((REP_MASK >> (k)) & 1u) { xcd_barrier(bar); FRESH(); __VA_ARGS__; } } SEAM(p0 + (k)); } while (0)
template <int layer>
__device__ __forceinline__ void layer_phases(Ctx& C, const CAS Args*& KA, XcdBarrier& bar, unsigned*& ctl, unsigned char* lds_raw, const int lo, const int hi) {
    const int p0 = layer * PH_PER_LAYER;
    PH_BODY(0, { const WSrc W{KA->in[2], KA->in[3], KA->in[18], KA->in[20], KA->in[21], KA->in[7], KA->in[9], KA->in[12], KA->in[11]}; phase_wconv(C, layer, W);
                 if (layer == 0) phase_xg(C, KA->in[0], KA->in[1], (bf16*)(C.ws + WS_H), (float*)(C.ws + WS_SS1)); });
    PH_BODY(1, { pg8::Gemm g{(const pg8::bf16_t*)(C.ws + WS_H), (const pg8::bf16_t*)(C.ws + WS_WIN), M, N_INP, DM}; pg8::StaticOrder S; S.init(M, N_INP, C.G, C.bid);
                 pg8::EpiProj E{C.ws, (const float*)(C.ws + WS_SS1)}; pg8::gemm_phase<pg8::EpiProj, pg8::StaticOrder, true, true>(C.lds, g, S, E); });
    FRESH(); if (IN(p0 + 2)) phase_prep_a(C); SEAM(p0 + 2);
    PH_BODY(3, { phase_indexer(C); __syncthreads(); phase_ret1(C); });
    FRESH(); if (IN(p0 + 4)) { for (int rep_a = 0; rep_a < ATT_REP; ++rep_a) { phase_attn(C); __syncthreads(); } phase_ret2(C); } SEAM(p0 + 4);
    PH_BODY(5, { phase_ret3(C); __syncthreads(); const RwP P{KA->in[4], KA->in[5], KA->in[6], KA->in[8], KA->in[10], KA->in[13], KA->in[14], KA->in[15], KA->in[16], KA->in[17]}; phase_rw1(C, layer, P); });
    PH_BODY(6, { phase_rw2(C); });
    PH_BODY(7, { phase_rw3(C); });
    PH_BODY(8, { phase_rw4(C); });
    PH_BODY(9, { const RwP P{KA->in[4], KA->in[5], KA->in[6], KA->in[8], KA->in[10], KA->in[13], KA->in[14], KA->in[15], KA->in[16], KA->in[17]}; phase_rw5(C, layer, P); });
    FRESH(); if (IN(p0 + 10)) { const float* xin = layer == 0 ? KA->in[0] : C.out;
        pg8::Gemm g{(const pg8::bf16_t*)(C.ws + WS_CAT), (const pg8::bf16_t*)(C.ws + WS_WOUT), M, DM, DM}; pg8::StaticOrder S; S.init(M, DM, C.G, C.bid);
        pg8::EpiResid E{xin, C.out, DM, KA->in[19] + layer * DM, (pg8::bf16_t*)(C.ws + WS_H2), (float*)(C.ws + WS_SS2)}; pg8::gemm_phase<pg8::EpiResid, pg8::StaticOrder, true, true>(C.lds, g, S, E); }
    SEAM(p0 + 10);
    PH_BODY(11, { pg8::Gemm g{(const pg8::bf16_t*)(C.ws + WS_H2), (const pg8::bf16_t*)(C.ws + WS_WGU), M, 2 * DFF, DM}; pg8::StaticOrder S; S.init(M, 2 * DFF, C.G, C.bid);
                  pg8::EpiSwiGLU E{(pg8::bf16_t*)(C.ws + WS_ACT), DFF, (const float*)(C.ws + WS_SS2)}; pg8::gemm_phase<pg8::EpiSwiGLU, pg8::StaticOrder, true, true>(C.lds, g, S, E); });
    FRESH(); if (IN(p0 + 12)) { pg8::Gemm g{(const pg8::bf16_t*)(C.ws + WS_ACT), (const pg8::bf16_t*)(C.ws + WS_WDN), M, DM, DFF}; pg8::StaticOrder S; S.init(M, DM, C.G, C.bid);
        pg8::EpiResid E{C.out, C.out, DM, layer + 1 < DEPTH ? KA->in[1] + (layer + 1) * DM : KA->in[22], layer + 1 < DEPTH ? (pg8::bf16_t*)(C.ws + WS_H) : nullptr, (float*)(C.ws + WS_SS1)};
        pg8::gemm_phase<pg8::EpiResid, pg8::StaticOrder, true, true>(C.lds, g, S, E); }
    SEAM(p0 + 12);
}
__global__ void __launch_bounds__(NTHR, 2) fwd_kernel(Args args) {
    extern __shared__ __attribute__((aligned(16))) unsigned char lds_raw[];
    Ctx C;
    C.lds = (LAS unsigned char*)lds_raw; C.tid = threadIdx.x; C.lane = C.tid & 63; C.wave = __builtin_amdgcn_readfirstlane(C.tid >> 6);
    C.G = gridDim.x; C.bid = blockIdx.x;
    const CAS Args* KA = (const CAS Args*)launder_ptr((const void*)(uintptr_t)__builtin_amdgcn_kernarg_segment_ptr());
    C.ws = KA->ws; C.out = KA->out;
    volatile LAS unsigned* MISC = (volatile LAS unsigned*)(C.lds + MISC_OFF);
    if (C.tid < 32) MISC[C.tid] = 0u;
    __syncthreads();
    unsigned* ctl = (unsigned*)(C.ws + WS_CTL);
    XcdBarrier bar; bar.bar = ctl + CW_BAR; bar.x = 0; bar.st = nullptr;
    if (!MK_PER_PHASE) bar = xcd_barrier_post(ctl + CW_BAR, MISC + 8);
    const int lo = KA->ph_lo, hi = KA->ph_hi;
    layer_phases<0>(C, KA, bar, ctl, lds_raw, lo, hi);
    layer_phases<1>(C, KA, bar, ctl, lds_raw, lo, hi);
    FRESH(); if (IN(N_PHASES - 1)) phase_final_norm(C, C.out, KA->in[22], (const float*)(C.ws + WS_SS1));
#undef IN
#undef SEAM
}

extern "C" void kernel_launch(void* const* d_in, const int* in_sizes, int n_in, void* d_out, int out_size, void* d_ws, size_t ws_size, hipStream_t stream) {
    static int grid = 0;
    if (grid == 0) {
        if (n_in != 23 || out_size != M * DM || ws_size < WS_NEED) { fprintf(stderr, "kernel_launch: unexpected problem (n_in %d, out %d, ws %zu); nothing launched\n", n_in, out_size, ws_size); grid = -1; return; }
        int dev = 0, cus = 0, per_cu = 0;
        if (hipGetDevice(&dev) != hipSuccess || hipDeviceGetAttribute(&cus, hipDeviceAttributeMultiprocessorCount, dev) != hipSuccess) { grid = -1; return; }
        if (hipFuncSetAttribute((const void*)fwd_kernel, hipFuncAttributeMaxDynamicSharedMemorySize, LDS_BYTES) != hipSuccess) { fprintf(stderr, "kernel_launch: hipFuncSetAttribute failed\n"); grid = -1; return; }
        if (hipOccupancyMaxActiveBlocksPerMultiprocessor(&per_cu, (const void*)fwd_kernel, NTHR, LDS_BYTES) != hipSuccess || per_cu < 1) { fprintf(stderr, "kernel_launch: occupancy query says %d blocks per CU\n", per_cu); }
        (void)hipGetLastError();
        grid = cus;
    }
    if (grid < 0) return;
    (void)hipMemsetAsync((char*)d_ws + WS_CTL, 0, CTL_ZERO_BYTES, stream);
    Args a{};
    for (int i = 0; i < 23; ++i) a.in[i] = (const float*)d_in[i];
    a.out = (float*)d_out; a.ws = (unsigned char*)d_ws;
#if MK_PER_PHASE
    for (int p = 0; p < N_PHASES; ++p) { a.ph_lo = p; a.ph_hi = p + 1; hipLaunchKernelGGL(fwd_kernel, dim3(grid), dim3(NTHR), LDS_BYTES, stream, a); }
#else
    a.ph_lo = 0; a.ph_hi = N_PHASES;
    hipLaunchKernelGGL(fwd_kernel, dim3(grid), dim3(NTHR), LDS_BYTES, stream, a);
#endif
    const hipError_t le = hipPeekAtLastError();
    if (le != hipSuccess) fprintf(stderr, "kernel_launch: launch failed: %s\n", hipGetErrorName(le));
}
```

```cpp
#include <hip/hip_runtime.h>
#include <hip/hip_fp16.h>
#include <cstdio>
#include <cstdint>
namespace pg8 {
#define PG8_LAS __attribute__((address_space(3)))
typedef unsigned short bf16_t;
typedef short bf16x8 __attribute__((ext_vector_type(8)));
typedef float f32x4 __attribute__((ext_vector_type(4)));
typedef unsigned u32x4 __attribute__((ext_vector_type(4)));
constexpr int BM = 256, BK = 64, HALF = 128, HTB = HALF * BK * 2  , STAGE_BYTES = 8 * HTB, NXCD = 8, WGM = 8;

__host__ __device__ __forceinline__ int lds_byte(int r, int c) { const int st = (r >> 4) * 2 + (c >> 5), rr = r & 15, cc = c & 31, ob = rr * 64 + cc * 2; return st * 1024 + (ob ^ (((ob >> 9) & 1) << 5)); }
__host__ __device__ __forceinline__ void stage_rc(int b, int& R, int& C) { const int st = b / 1024, sb = b % 1024, swz = sb ^ (((sb >> 9) & 1) << 5); R = (st >> 1) * 16 + swz / 64; C = (st & 1) * 32 + (swz % 64) / 2; }
__host__ __device__ __forceinline__ int perm32(int rho) { const int n = rho >> 4, i = rho & 15; return 8 * (i >> 2) + 4 * n + (i & 3); }

struct Unit { int pm, pn; };
struct Gemm { const bf16_t* A; const bf16_t* Bt; int M, N, K; };

struct StaticOrder {
    int nM, nN, nwg, G, c;
    __host__ __device__ void init(int M, int N, int G_, int c_) { nM = M / BM; nN = N / BM; nwg = nM * nN; G = G_; c = c_; }
    __host__ __device__ bool next(int i, Unit& u) const {
        const long L = (long)i * G + c; if (L >= nwg) return false;
        int wgid = (int)L; { const int q = nwg / NXCD, r = nwg % NXCD, xcd = wgid % NXCD, off = wgid / NXCD; wgid = (xcd < r ? xcd * (q + 1) : r * (q + 1) + (xcd - r) * q) + off; }
        const int nig = WGM * nN, gid = wgid / nig, fm = gid * WGM, gsz = (nM - fm) < WGM ? (nM - fm) : WGM;
        u.pm = fm + ((wgid % nig) % gsz); u.pn = (wgid % nig) / gsz; return true;
    }
    __device__ __forceinline__ void a_ready(const Unit&) const {}
    __device__ __forceinline__ void done(const Unit&) const {}
};

__device__ __forceinline__ unsigned cvt_pk_bf16(float lo, float hi) { unsigned r; asm volatile("v_cvt_pk_bf16_f32 %0, %1, %2" : "=v"(r) : "v"(lo), "v"(hi)); return r; }
typedef float f32x2 __attribute__((ext_vector_type(2)));
__device__ __forceinline__ f32x2 gelu_pk(f32x2 v) {
    const f32x2 av = __builtin_elementwise_abs(v), d = av * 0.2316418882f + 1.0f;
    f32x2 t; t.x = __builtin_amdgcn_rcpf(d.x); t.y = __builtin_amdgcn_rcpf(d.y);
    f32x2 q = t * 0.5307027145f + (-0.7265760135f); q = q * t + 0.7107068705f; q = q * t + (-0.142248368f); q = q * t + 0.127414796f; q = q * t;
    const f32x2 s = (v * v) * (-0.72134752044f);
    f32x2 e; e.x = __builtin_amdgcn_exp2f(s.x); e.y = __builtin_amdgcn_exp2f(s.y);
    const f32x2 m = v * (q * e), r = v - m;
    f32x2 o; o.x = v.x < 0.f ? m.x : r.x; o.y = v.y < 0.f ? m.y : r.y; return o;
}

template <int ACT  > struct EpiBf16 {
    static constexpr bool PERM = true, AFTER_DRAIN = false; static_assert(ACT == 0 || ACT == 1, "EpiBf16: ACT is 0 (none) or 1 (gelu_pk)");
    bf16_t* O; int ldc; const float* bias; int split_cols; size_t split_stride; float scale0;
    __device__ __forceinline__ void operator()(const f32x4 (&acc)[2][2][4][2], const Unit& u, int wr, int wc, int fr, int fq) const {
        const int row0 = u.pm * BM + wr * 64 + fr; int colt = u.pn * BM; bf16_t* base = O;
        float sc = 1.f; if (split_cols) { const int t = colt / split_cols; base += (size_t)t * split_stride; colt -= t * split_cols; if (t == 0) sc = scale0; }
        const int col0 = colt + wc * 32 + 8 * fq, bcol0 = u.pn * BM + wc * 32 + 8 * fq;
        f32x4 bv[2][2];
#pragma unroll
        for (int bj = 0; bj < 2; ++bj)
#pragma unroll
            for (int n = 0; n < 2; ++n) bv[bj][n] = bias ? *(const f32x4*)(bias + bcol0 + bj * HALF + 4 * n) : (f32x4){0.f, 0.f, 0.f, 0.f};
#pragma unroll
        for (int ai = 0; ai < 2; ++ai)
#pragma unroll
            for (int m = 0; m < 4; ++m) { bf16_t* rowp = base + (size_t)(row0 + ai * HALF + m * 16) * ldc + col0;
#pragma unroll
                for (int bj = 0; bj < 2; ++bj) { f32x4 v0 = acc[ai][bj][m][0] + bv[bj][0], v1 = acc[ai][bj][m][1] + bv[bj][1];
                    if (ACT == 1) { f32x2 a = gelu_pk((f32x2){v0[0], v0[1]}), b = gelu_pk((f32x2){v0[2], v0[3]}), c = gelu_pk((f32x2){v1[0], v1[1]}), d = gelu_pk((f32x2){v1[2], v1[3]});
                        v0 = (f32x4){a.x, a.y, b.x, b.y}; v1 = (f32x4){c.x, c.y, d.x, d.y}; }
                    v0 = v0 * sc; v1 = v1 * sc; u32x4 w; w.x = cvt_pk_bf16(v0[0], v0[1]); w.y = cvt_pk_bf16(v0[2], v0[3]); w.z = cvt_pk_bf16(v1[0], v1[1]); w.w = cvt_pk_bf16(v1[2], v1[3]);
                    *(u32x4*)(rowp + bj * HALF) = w; } }
    }
};

__device__ __forceinline__ void tile_dest(int pn, size_t& off, int& ld, int& colt);
__device__ __forceinline__ float row_rstd(const float* ss, int row) { return rsqrtf(ss[row] * (1.0f / 2048.0f) + 1e-5f); }
struct EpiProj {
    static constexpr bool PERM = true, AFTER_DRAIN = false;
    unsigned char* ws; const float* ss;
    __device__ __forceinline__ void operator()(const f32x4 (&acc)[2][2][4][2], const Unit& u, int wr, int wc, int fr, int fq) const {
        size_t off; int ld, colt; tile_dest(u.pn, off, ld, colt);
        bf16_t* base = (bf16_t*)(ws + off);
        const int row0 = u.pm * BM + wr * 64 + fr, col0 = colt + wc * 32 + 8 * fq;
        const float sc = u.pn < 4 ? 0.12751743074602467f : 1.0f;
#pragma unroll
        for (int ai = 0; ai < 2; ++ai)
#pragma unroll
            for (int m = 0; m < 4; ++m) { const int row = row0 + ai * HALF + m * 16; bf16_t* rowp = base + (size_t)row * ld + col0; const float rs = row_rstd(ss, row) * sc;
#pragma unroll
                for (int bj = 0; bj < 2; ++bj) { const f32x4 v0 = acc[ai][bj][m][0] * rs, v1 = acc[ai][bj][m][1] * rs;
                    u32x4 w; w.x = cvt_pk_bf16(v0[0], v0[1]); w.y = cvt_pk_bf16(v0[2], v0[3]); w.z = cvt_pk_bf16(v1[0], v1[1]); w.w = cvt_pk_bf16(v1[2], v1[3]);
                    *(u32x4*)(rowp + bj * HALF) = w; } }
    }
};
struct EpiResid {
    static constexpr bool PERM = false, AFTER_DRAIN = false;
    const float* base; float* out; int ldc; const float* g; bf16_t* xg; float* ss;
    __device__ __forceinline__ void operator()(const f32x4 (&acc)[2][2][4][2], const Unit& u, int wr, int wc, int fr, int fq) const {
        const int row0 = u.pm * BM + wr * 64 + fr, col0 = u.pn * BM + wc * 32 + 4 * fq;
        f32x4 gv[2][2];
#pragma unroll
        for (int bj = 0; bj < 2; ++bj)
#pragma unroll
            for (int n = 0; n < 2; ++n) gv[bj][n] = *(const f32x4*)(g + col0 + bj * HALF + n * 16);
#pragma unroll
        for (int ai = 0; ai < 2; ++ai)
#pragma unroll
            for (int m = 0; m < 4; ++m) { const int row = row0 + ai * HALF + m * 16; const size_t off = (size_t)row * ldc + col0; float sq = 0.f;
#pragma unroll
                for (int bj = 0; bj < 2; ++bj)
#pragma unroll
                    for (int n = 0; n < 2; ++n) { const size_t p = off + bj * HALF + n * 16; const f32x4 x = *(const f32x4*)(base + p) + acc[ai][bj][m][n]; *(f32x4*)(out + p) = x;
                        sq += (x[0] * x[0] + x[1] * x[1]) + (x[2] * x[2] + x[3] * x[3]);
                        if (xg) { const f32x4 y = x * gv[bj][n]; typedef unsigned u32x2_t __attribute__((ext_vector_type(2))); u32x2_t w; w.x = cvt_pk_bf16(y[0], y[1]); w.y = cvt_pk_bf16(y[2], y[3]); *(u32x2_t*)(xg + p) = w; } }
                sq += __shfl_xor(sq, 16); sq += __shfl_xor(sq, 32);
                if (fq == 0) unsafeAtomicAdd(ss + row, sq); }
    }
};
struct EpiSwiGLU {
    static constexpr bool PERM = true, AFTER_DRAIN = false;
    bf16_t* O; int ldc; const float* ss;
    __device__ __forceinline__ static float silu_mul(float g, float u) { return g * u * __builtin_amdgcn_rcpf(1.0f + __expf(-g)); }
    __device__ __forceinline__ void operator()(const f32x4 (&acc)[2][2][4][2], const Unit& u, int wr, int wc, int fr, int fq) const {
        const int row0 = u.pm * BM + wr * 64 + fr, col0 = u.pn * HALF + wc * 32 + 8 * fq;
#pragma unroll
        for (int ai = 0; ai < 2; ++ai)
#pragma unroll
            for (int m = 0; m < 4; ++m) { const int row = row0 + ai * HALF + m * 16; bf16_t* rowp = O + (size_t)row * ldc + col0; const float rs = row_rstd(ss, row);
                const f32x4 g0 = acc[ai][0][m][0] * rs, g1 = acc[ai][0][m][1] * rs, u0 = acc[ai][1][m][0] * rs, u1 = acc[ai][1][m][1] * rs;
                u32x4 w; w.x = cvt_pk_bf16(silu_mul(g0[0], u0[0]), silu_mul(g0[1], u0[1])); w.y = cvt_pk_bf16(silu_mul(g0[2], u0[2]), silu_mul(g0[3], u0[3]));
                w.z = cvt_pk_bf16(silu_mul(g1[0], u1[0]), silu_mul(g1[1], u1[1])); w.w = cvt_pk_bf16(silu_mul(g1[2], u1[2]), silu_mul(g1[3], u1[3]));
                *(u32x4*)rowp = w; }
    }
};
template <class Epi, class Sched, bool ALIGN_EPI = false, bool SP2 = false>
__device__ __forceinline__ void gemm_phase(PG8_LAS unsigned char* lds, const Gemm g, const Sched& S, const Epi& E) {
    int tid_ = threadIdx.x; asm volatile("" : "+v"(tid_));
    const int tid = tid_, wid = __builtin_amdgcn_readfirstlane(tid >> 6), lane = tid & 63, wr = wid >> 2, wc = wid & 3, fr = lane & 15, fq = lane >> 4;
    const int K = g.K, nt = K / BK;
    unsigned voffA[2], voffB[2];
#pragma unroll
    for (int i = 0; i < 2; ++i) { int R, C; stage_rc(tid * 16 + i * 8192, R, C); const int Rb = Epi::PERM ? ((R & ~31) + perm32(R & 31)) : R;
        voffA[i] = (unsigned)(R * K + C) * 2u; voffB[i] = (unsigned)(Rb * K + C) * 2u; }
    const size_t kstep = (size_t)(BK * 2);
    const size_t hstep = (size_t)HALF * K * 2;
    const size_t tstep = 2 * hstep;
    const unsigned ldsw = (unsigned)wid * 1024u;
    const int aoff = lds_byte(wr * 64 + fr, fq * 8), boff = lds_byte(wc * 32 + fr, fq * 8);
#define PG8_SA(b, h) (((b) * 2 + (h)) * HTB)
#define PG8_SB(b, h) ((4 + (b) * 2 + (h)) * HTB)
#define PG8_STAGE(bufoff, gbase, voff) do { _Pragma("unroll") for (int _i = 0; _i < 2; ++_i) \
        __builtin_amdgcn_global_load_lds((const unsigned*)((const char*)(gbase) + (voff)[_i]), (PG8_LAS unsigned*)(lds + (bufoff) + ldsw + _i * 8192), 16, 0, 0); } while (0)
#define PG8_LDA(dst, b, h) do { _Pragma("unroll") for (int m = 0; m < 4; ++m) _Pragma("unroll") for (int k = 0; k < 2; ++k) dst[m][k] = *(const PG8_LAS bf16x8*)(lds + PG8_SA(b, h) + aoff + m * 2048 + k * 1024); } while (0)
#define PG8_LDB(dst, b, h) do { _Pragma("unroll") for (int n = 0; n < 2; ++n) _Pragma("unroll") for (int k = 0; k < 2; ++k) dst[n][k] = *(const PG8_LAS bf16x8*)(lds + PG8_SB(b, h) + boff + n * 2048 + k * 1024); } while (0)
#define PG8_MMA(ai, bj, At, Bt) do { __builtin_amdgcn_s_setprio(1); _Pragma("unroll") for (int m = 0; m < 4; ++m) _Pragma("unroll") for (int n = 0; n < 2; ++n) _Pragma("unroll") for (int k = 0; k < 2; ++k) \
        acc[ai][bj][m][n] = __builtin_amdgcn_mfma_f32_16x16x32_bf16(Bt[n][k], At[m][k], acc[ai][bj][m][n], 0, 0, 0); __builtin_amdgcn_s_setprio(0); } while (0)
#define PG8_WAIT_V(n) asm volatile("s_waitcnt vmcnt(" #n ")" ::: "memory")
#define PG8_WAIT_L(n) asm volatile("s_waitcnt lgkmcnt(" #n ")" ::: "memory")
#define PG8_BAR __builtin_amdgcn_s_barrier()
#define PG8_SCHED __builtin_amdgcn_sched_barrier(0)
    Unit cur, nxt; int ui = 0;
    if (!S.next(0, cur)) return;
    f32x4 acc[2][2][4][2];
#pragma unroll
    for (int a = 0; a < 2; ++a)
#pragma unroll
        for (int b = 0; b < 2; ++b)
#pragma unroll
            for (int m = 0; m < 4; ++m)
#pragma unroll
                for (int n = 0; n < 2; ++n) acc[a][b][m][n] = (f32x4){0.f, 0.f, 0.f, 0.f};
    bf16x8 At[4][2], B0[2][2], B1[2][2];
    const char* cA = (const char*)g.A + (size_t)cur.pm * tstep; const char* cB = (const char*)g.Bt + (size_t)cur.pn * tstep;
    S.a_ready(cur);
    if constexpr (SP2) {
        PG8_STAGE(PG8_SB(0, 0), cB, voffB); PG8_STAGE(PG8_SB(0, 1), cB + hstep, voffB); PG8_STAGE(PG8_SA(0, 0), cA, voffA); PG8_STAGE(PG8_SA(0, 1), cA + hstep, voffA);
        if (wr == 1) PG8_BAR;
        PG8_WAIT_V(2); PG8_BAR;
        PG8_STAGE(PG8_SB(1, 0), cB + kstep, voffB); PG8_STAGE(PG8_SA(1, 0), cA + kstep, voffA); PG8_STAGE(PG8_SB(1, 1), cB + hstep + kstep, voffB);
        PG8_WAIT_V(6); PG8_BAR;
    } else {
        PG8_STAGE(PG8_SB(0, 0), cB, voffB); PG8_STAGE(PG8_SA(0, 0), cA, voffA); PG8_STAGE(PG8_SB(0, 1), cB + hstep, voffB); PG8_STAGE(PG8_SA(0, 1), cA + hstep, voffA);
        if (wr == 1) PG8_BAR;
        PG8_WAIT_V(4); PG8_BAR;
        PG8_STAGE(PG8_SB(1, 0), cB + kstep, voffB); PG8_STAGE(PG8_SA(1, 0), cA + kstep, voffA); PG8_STAGE(PG8_SB(1, 1), cB + hstep + kstep, voffB);
        PG8_WAIT_V(6); PG8_BAR;
    }
    for (;;) {
        const bool has_next = S.next(ui + 1, nxt);
        const char* nA = has_next ? (const char*)g.A + (size_t)nxt.pm * tstep : cA; const char* nB = has_next ? (const char*)g.Bt + (size_t)nxt.pn * tstep : cB;
        for (int t = 0; t < nt; t += 2) {
            const bool last = (t == nt - 2);
            const char* a1 = cA + (size_t)(t + 1) * kstep;
            const char* a2 = last ? nA : cA + (size_t)(t + 2) * kstep; const char* b2 = last ? nB : cB + (size_t)(t + 2) * kstep;
            const char* a3 = a2 + kstep; const char* b3 = b2 + kstep;
            if (last && has_next) S.a_ready(nxt);
            if constexpr (SP2) {
            PG8_LDB(B0, 0, 0); PG8_LDB(B1, 0, 1); PG8_SCHED; PG8_LDA(At, 0, 0); PG8_STAGE(PG8_SA(1, 1), a1 + hstep, voffA);
            PG8_WAIT_V(8); PG8_WAIT_L(0); PG8_BAR; PG8_MMA(0, 0, At, B0); PG8_MMA(0, 1, At, B1); PG8_BAR; PG8_SCHED;
            PG8_LDA(At, 0, 1); PG8_STAGE(PG8_SB(0, 0), b2, voffB); PG8_STAGE(PG8_SB(0, 1), b2 + hstep, voffB); PG8_STAGE(PG8_SA(0, 0), a2, voffA);
            PG8_WAIT_V(8); PG8_WAIT_L(0); PG8_BAR; PG8_MMA(1, 0, At, B0); PG8_MMA(1, 1, At, B1); PG8_BAR; PG8_SCHED;
            PG8_LDB(B0, 1, 0); PG8_LDB(B1, 1, 1); PG8_SCHED; PG8_LDA(At, 1, 0); PG8_STAGE(PG8_SA(0, 1), a2 + hstep, voffA);
            PG8_WAIT_V(8); PG8_WAIT_L(0); PG8_BAR; PG8_MMA(0, 0, At, B0); PG8_MMA(0, 1, At, B1); PG8_BAR; PG8_SCHED;
            PG8_LDA(At, 1, 1); PG8_STAGE(PG8_SB(1, 0), b3, voffB); PG8_STAGE(PG8_SB(1, 1), b3 + hstep, voffB); PG8_STAGE(PG8_SA(1, 0), a3, voffA);
            PG8_WAIT_V(8); PG8_WAIT_L(0); PG8_BAR; PG8_MMA(1, 0, At, B0); PG8_MMA(1, 1, At, B1); PG8_BAR; PG8_SCHED;
            } else {
            PG8_LDB(B0, 0, 0); PG8_SCHED; PG8_LDA(At, 0, 0); PG8_STAGE(PG8_SA(1, 1), a1 + hstep, voffA);
            PG8_WAIT_L(8); PG8_BAR; PG8_WAIT_L(0); PG8_MMA(0, 0, At, B0); PG8_BAR; PG8_SCHED;
            PG8_LDB(B1, 0, 1); PG8_STAGE(PG8_SB(0, 0), b2, voffB);
            PG8_BAR; PG8_WAIT_L(0); PG8_MMA(0, 1, At, B1); PG8_BAR;
            PG8_LDA(At, 0, 1); PG8_STAGE(PG8_SA(0, 0), a2, voffA);
            PG8_BAR; PG8_WAIT_L(0); PG8_MMA(1, 0, At, B0); PG8_BAR; PG8_SCHED;
            PG8_STAGE(PG8_SB(0, 1), b2 + hstep, voffB);
            PG8_WAIT_V(6); PG8_BAR; PG8_MMA(1, 1, At, B1); PG8_BAR;
            PG8_LDB(B0, 1, 0); PG8_SCHED; PG8_LDA(At, 1, 0); PG8_STAGE(PG8_SA(0, 1), a2 + hstep, voffA);
            PG8_WAIT_L(8); PG8_BAR; PG8_WAIT_L(0); PG8_MMA(0, 0, At, B0); PG8_BAR; PG8_SCHED;
            PG8_LDB(B1, 1, 1); PG8_STAGE(PG8_SB(1, 0), b3, voffB);
            PG8_BAR; PG8_WAIT_L(0); PG8_MMA(0, 1, At, B1); PG8_BAR;
            PG8_LDA(At, 1, 1); PG8_STAGE(PG8_SA(1, 0), a3, voffA);
            PG8_BAR; PG8_WAIT_L(0); PG8_MMA(1, 0, At, B0); PG8_BAR; PG8_SCHED;
            PG8_STAGE(PG8_SB(1, 1), b3 + hstep, voffB);
            PG8_WAIT_V(6); PG8_BAR; PG8_MMA(1, 1, At, B1); PG8_BAR;
            }
        }
        if constexpr (ALIGN_EPI) { if (wr == 0) PG8_BAR; }
        if constexpr (!Epi::AFTER_DRAIN) { E(acc, cur, wr, wc, fr, fq); S.done(cur); }
        if (!has_next) break;
#pragma unroll
        for (int a = 0; a < 2; ++a)
#pragma unroll
            for (int b = 0; b < 2; ++b)
#pragma unroll
                for (int m = 0; m < 4; ++m)
#pragma unroll
                    for (int n = 0; n < 2; ++n) acc[a][b][m][n] = (f32x4){0.f, 0.f, 0.f, 0.f};
        cur = nxt; cA = nA; cB = nB; ++ui;
        if constexpr (ALIGN_EPI) { if (wr == 1) PG8_BAR; }
    }
    PG8_WAIT_V(0);
    if constexpr (!ALIGN_EPI) { if (wr == 0) PG8_BAR; }
    PG8_BAR;
    if constexpr (Epi::AFTER_DRAIN) { E.fused(acc, cur, wr, wc, fr, fq, lds, wid, lane); S.done(cur); }
#undef PG8_SA
#undef PG8_SB
#undef PG8_STAGE
#undef PG8_LDA
#undef PG8_LDB
#undef PG8_MMA
#undef PG8_WAIT_V
#undef PG8_WAIT_L
#undef PG8_BAR
#undef PG8_SCHED
}
}
constexpr int NB = 4, T = 8192, M = NB * T, DM = 2048, DFF = 5632, DEPTH = 2;
constexpr int N_IN = 7696, N_INP = 7936;
constexpr int NWAVES = 8, NTHR = NWAVES * 64;
#define LAS __attribute__((address_space(3)))
#define GAS __attribute__((address_space(1)))
#define CAS __attribute__((address_space(4)))
typedef unsigned short bf16;
typedef short bf16x8 __attribute__((ext_vector_type(8)));
typedef float f32x4 __attribute__((ext_vector_type(4)));
typedef float f32x16 __attribute__((ext_vector_type(16)));
typedef unsigned u32x4 __attribute__((ext_vector_type(4)));
typedef unsigned u32x2 __attribute__((ext_vector_type(2)));
typedef unsigned long long u64;

constexpr size_t MiB = 1u << 20;
constexpr size_t WS_CTL = 0, CTL_ZERO_BYTES = 1 * MiB;
constexpr size_t WS_WIN = 1 * MiB, WS_WOUT = 32 * MiB, WS_WGU = 40 * MiB, WS_WDN = 84 * MiB;
constexpr size_t WS_LORA = 106 * MiB;
constexpr size_t LO_W = 0, LO_A = 512 * 96 * 2, LO_V = 2 * 512 * 96 * 2, LO_G = LO_V + 512 * 64 * 2;
constexpr size_t WS_VFIRST = 107 * MiB;
constexpr size_t WS_H = 139 * MiB;
constexpr size_t WS_VT = 139 * MiB, WS_MASK = 203 * MiB;
constexpr size_t WS_Q = 267 * MiB, WS_K = 331 * MiB, WS_QI = 395 * MiB, WS_V = 459 * MiB, WS_KW = 523 * MiB, WS_BQ = 539 * MiB, WS_BK = 555 * MiB, WS_BV = 571 * MiB, WS_BG = 603 * MiB;
constexpr size_t WS_CR = 635 * MiB, WS_CK = 667 * MiB, WS_CV = 699 * MiB, WS_CL = 731 * MiB, WS_CG = 747 * MiB;
constexpr size_t WS_CAT = 763 * MiB;
constexpr size_t WS_KVST = 891 * MiB;
constexpr size_t WS_TAB = 955 * MiB;
constexpr size_t WS_SS1 = 959 * MiB, WS_SS2 = 959 * MiB + 256 * 1024;
constexpr size_t TAB_A = 0, TAB_I = (size_t)T * 16 * 8, TAB_R = TAB_I + (size_t)T * 8 * 8, TAB_END = TAB_R + (size_t)T * 32 * 8;
constexpr size_t WS_RR = 139 * MiB, WS_RW = 171 * MiB, WS_RKH = 203 * MiB, WS_RV = 235 * MiB, WS_RA = 267 * MiB, WS_RB = 299 * MiB;
constexpr size_t WS_PHI = 331 * MiB, WS_PSI = 363 * MiB, WS_SST = 395 * MiB, WS_Y = 635 * MiB;
constexpr size_t WS_H2 = 139 * MiB, WS_ACT = 267 * MiB;
constexpr size_t WS_NEED = 1024 * MiB;
static_assert(WS_TAB + TAB_END <= WS_NEED && WS_ACT + (size_t)M * DFF * 2 <= WS_CR && WS_SST + 32 * MiB <= WS_V && WS_RB + 32 * MiB <= WS_PHI && WS_Y + (size_t)M * 512 * 4 <= WS_CV, "ws map");

constexpr int LDS_BYTES = 147456, MISC_OFF = 143360;
constexpr int CW_BAR = 4096;

__device__ __forceinline__ unsigned f2bf(float f) { unsigned u = __builtin_bit_cast(unsigned, f); return (u + 0x7fffu + ((u >> 16) & 1u)) >> 16; }
__device__ __forceinline__ unsigned pk2(float lo, float hi) { return f2bf(lo) | (f2bf(hi) << 16); }
__device__ __forceinline__ float bf2f(unsigned short b) { return __builtin_bit_cast(float, (unsigned)b << 16); }
__device__ __forceinline__ float bflo(unsigned w) { return __builtin_bit_cast(float, w << 16); }
__device__ __forceinline__ float bfhi(unsigned w) { return __builtin_bit_cast(float, w & 0xffff0000u); }
__device__ __forceinline__ float wave_sum(float v) {
#pragma unroll
    for (int o = 1; o < 64; o <<= 1) v += __shfl_xor(v, o);
    return v;
}
#define LDS_WAIT() asm volatile("s_waitcnt lgkmcnt(0)" ::: "memory")
typedef float f32x2 __attribute__((ext_vector_type(2)));
template <class TT> __device__ __forceinline__ GAS TT* at_b(GAS TT* ub, unsigned boff) { return (GAS TT*)((GAS char*)ub + boff); }
__device__ __forceinline__ float half_sum32(float v) { v += __shfl_xor(v, 1); v += __shfl_xor(v, 2); v += __shfl_xor(v, 4); v += __shfl_xor(v, 8); v += __shfl_xor(v, 16); return v; }


namespace pg8 {
__device__ __forceinline__ void tile_dest(int pn, size_t& off, int& ld, int& colt) {
    if (pn < 16) { const int g = pn >> 2; off = g == 0 ? WS_Q : g == 1 ? WS_K : g == 2 ? WS_V : WS_QI; ld = 1024; colt = (pn & 3) * 256; }
    else if (pn == 16) { off = WS_BQ; ld = 256; colt = 0; }
    else if (pn == 17) { off = WS_BK; ld = 256; colt = 0; }
    else if (pn < 20) { off = WS_BV; ld = 512; colt = (pn - 18) * 256; }
    else if (pn < 22) { off = WS_BG; ld = 512; colt = (pn - 20) * 256; }
    else if (pn == 22) { off = WS_KW; ld = 256; colt = 0; }
    else if (pn < 25) { off = WS_CR; ld = 512; colt = (pn - 23) * 256; }
    else if (pn < 27) { off = WS_CK; ld = 512; colt = (pn - 25) * 256; }
    else if (pn < 29) { off = WS_CV; ld = 512; colt = (pn - 27) * 256; }
    else if (pn == 29) { off = WS_CL; ld = 256; colt = 0; }
    else { off = WS_CG; ld = 256; colt = 0; }
}
}
__device__ __forceinline__ int win_src(int n, int layer) {
    if (n < 4096) return n;
    if (n < 4352) return 4176 + (n - 4096);
    if (n < 4608) return 4432 + (n - 4352);
    if (n < 5120) return 4688 + (n - 4608);
    if (n < 5632) return 5200 + (n - 5120);
    if (n < 5888) { const int j = n - 5632; return j < 64 ? 4096 + j : (j < 80 ? 4160 + (j - 64) : -1); }
    if (n < 7424) return 5712 + (n - 5888);
    if (n < 7680) { const int j = n - 7424; return j < 96 ? 7248 + j : (j < 192 ? 7344 + (j - 96) : (layer > 0 ? -2 - (j - 192) : -1)); }
    return 7440 + (n - 7680);
}
#define XB_TMO      128
#define XB_XCNT(j)  (256  + 64 * (j))
#define XB_XSUB(j)  (1280 + 64 * (j))
#define XB_XGEN(j)  (2304 + 64 * (j))
#define XB_TOP      3328
#define XB_TOPGEN   3392
#define XCD_BAR_WORDS 3456
#define XB_SPIN_CAP (1u << 18)

__device__ __forceinline__ unsigned xb_ld(unsigned* p)              { return __hip_atomic_load(p, __ATOMIC_RELAXED, __HIP_MEMORY_SCOPE_AGENT); }
__device__ __forceinline__ unsigned xb_add(unsigned* p, unsigned v) { return __hip_atomic_fetch_add(p, v, __ATOMIC_RELAXED, __HIP_MEMORY_SCOPE_AGENT); }
__device__ __forceinline__ unsigned xb_xcc_id() { return (unsigned)__builtin_amdgcn_s_getreg((3 << 11) | 20) & 0xFu; }
#define XB_SPIN(cond, bar) do { unsigned _sp = 0; while (cond) { __builtin_amdgcn_s_sleep(1); \
    if ((++_sp & 255u) == 0u) { if (xb_ld(&(bar)[XB_TMO])) break; if (_sp > XB_SPIN_CAP) { atomicAdd(&(bar)[XB_TMO], 1u); break; } } } } while (0)

struct XcdBarrier {
    unsigned* bar; unsigned x;
    volatile LAS unsigned* st;
};

__device__ __forceinline__ XcdBarrier xcd_barrier_post(unsigned* bar, volatile LAS unsigned* st) {
    XcdBarrier b; b.bar = bar; b.x = xb_xcc_id(); b.st = st;
    if (threadIdx.x == 0) (void)xb_add(&bar[XB_XCNT(b.x)], 1u);
    return b;
}
__device__ __forceinline__ void xcd_barrier_complete(unsigned* bar, unsigned x, unsigned& nloc, unsigned& nx) {
    const unsigned G = gridDim.x * gridDim.y * gridDim.z;
    unsigned sum, cnt, mine, sp = 0u;
    for (;;) {
        sum = 0u; cnt = 0u; mine = 0u;
#pragma unroll
        for (unsigned j = 0; j < 16; ++j) { const unsigned c = xb_ld(&bar[XB_XCNT(j)]); sum += c; cnt += (c > 0u) ? 1u : 0u; mine = (j == x) ? c : mine; }
        if (sum == G) break;
        __builtin_amdgcn_s_sleep(1);
        if ((++sp & 255u) == 0u) { if (xb_ld(&bar[XB_TMO])) break; if (sp > XB_SPIN_CAP) { atomicAdd(&bar[XB_TMO], 1u); break; } }
    }
    nloc = mine > 0u ? mine : 1u; nx = cnt > 0u ? cnt : 1u;
}

__device__ __forceinline__ void xcd_barrier(const XcdBarrier& b) {
    asm volatile("s_waitcnt vmcnt(0)" ::: "memory");
    __syncthreads();
    if (threadIdx.x == 0) {
        unsigned* bar = b.bar;
        __builtin_amdgcn_s_waitcnt(0);
        unsigned nloc = b.st[0], nx = b.st[1];
        if (nloc == 0u) { xcd_barrier_complete(bar, b.x, nloc, nx); b.st[0] = nloc; b.st[1] = nx; }
        const unsigned old = xb_add(&bar[XB_XSUB(b.x)], 1u);
        const unsigned gen = old / nloc;
        if (old + 1u == (gen + 1u) * nloc) {
            __builtin_amdgcn_fence(__ATOMIC_RELEASE, "agent");
            asm volatile("s_waitcnt vmcnt(0)" ::: "memory");
            const unsigned og = xb_add(&bar[XB_TOP], 1u);
            const unsigned tg = og / nx;
            if (og + 1u == (tg + 1u) * nx) xb_add(&bar[XB_TOPGEN], 1u);
            else XB_SPIN(xb_ld(&bar[XB_TOPGEN]) == tg, bar);
            __builtin_amdgcn_fence(__ATOMIC_ACQUIRE, "agent");
            xb_add(&bar[XB_XGEN(b.x)], 1u);
            asm volatile("s_waitcnt vmcnt(0)" ::: "memory");
        } else {
            XB_SPIN(xb_ld(&bar[XB_XGEN(b.x)]) == gen, bar);
            __builtin_amdgcn_fence(__ATOMIC_ACQUIRE, "agent");
            asm volatile("s_waitcnt vmcnt(0)" ::: "memory");
        }
    }
    __syncthreads();
}

struct Ctx {
    LAS unsigned char* lds; int tid, lane, wave, G, bid; unsigned char* ws; float* out;
};

template <int MAP>
__device__ __forceinline__ void wconv_item(const float* W, int ldw, const float* W2, int K, bf16* WT, LAS float* scr, int item, int nblk, int lane, int layer) {
    const int kb = item / nblk, nb = item % nblk, k0 = 64 * kb, n0 = 32 * nb;
    const int n = n0 + (lane & 31);
    const float* src = nullptr; int ld = ldw;
    if (MAP == 0) src = W + n;
    else if (MAP == 1) { const int s = win_src(n, layer); if (s >= 0) src = W + s; else if (s <= -2) { src = W2 + (-2 - s); ld = 64; } }
    else { const int tl = n >> 8, j = n & 255; src = W + (j < 128 ? tl * 128 + j : DFF + tl * 128 + (j - 128)); }
    float tv[32];
#pragma unroll
    for (int i = 0; i < 32; ++i) { const int kk = 2 * i + (lane >> 5); tv[i] = src ? src[(size_t)(k0 + kk) * ld] : 0.f; }
#pragma unroll
    for (int i = 0; i < 32; ++i) { const int kk = 2 * i + (lane >> 5); scr[kk * 33 + (lane & 31)] = tv[i]; }
    LDS_WAIT(); asm volatile("" ::: "memory");
    const int c = lane & 7;
#pragma unroll
    for (int j = 0; j < 4; ++j) { const int nn = (lane >> 3) + 8 * j; const LAS float* s = scr + (8 * c) * 33 + nn;
        u32x4 o; o.x = pk2(s[0 * 33], s[1 * 33]); o.y = pk2(s[2 * 33], s[3 * 33]); o.z = pk2(s[4 * 33], s[5 * 33]); o.w = pk2(s[6 * 33], s[7 * 33]);
        *(u32x4*)(WT + (size_t)(n0 + nn) * K + k0 + 8 * c) = o; }
    LDS_WAIT(); asm volatile("" ::: "memory");
}
struct WSrc { const float *w_in, *w_vres, *w_out, *w_gu, *w_dn, *wlb, *alb, *glb, *vlb; };
__device__ __forceinline__ void phase_wconv(const Ctx& C, int layer, const WSrc& W) {
    LAS float* scr = (LAS float*)(C.lds + C.wave * 16384);
    const int gw = C.bid * NWAVES + C.wave, NGW = C.G * NWAVES;
    const float* w_in = W.w_in + (size_t)layer * DM * N_IN; const float* w_vres = W.w_vres;
    const float* w_out = W.w_out + (size_t)layer * DM * DM; const float* w_gu = W.w_gu + (size_t)layer * DM * 2 * DFF; const float* w_dn = W.w_dn + (size_t)layer * DFF * DM;
    constexpr int I_IN = (DM / 64) * (N_INP / 32), I_OUT = (DM / 64) * (DM / 32), I_GU = (DM / 64) * (2 * DFF / 32), I_DN = (DFF / 64) * (DM / 32);
    for (int it = gw; it < I_IN + I_OUT + I_GU + I_DN; it += NGW) {
        int r = it;
        if (r < I_IN) { wconv_item<1>(w_in, N_IN, w_vres, DM, (bf16*)(C.ws + WS_WIN), scr, r, N_INP / 32, C.lane, layer); continue; } r -= I_IN;
        if (r < I_OUT) { wconv_item<0>(w_out, DM, nullptr, DM, (bf16*)(C.ws + WS_WOUT), scr, r, DM / 32, C.lane, layer); continue; } r -= I_OUT;
        if (r < I_GU) { wconv_item<2>(w_gu, 2 * DFF, nullptr, DM, (bf16*)(C.ws + WS_WGU), scr, r, 2 * DFF / 32, C.lane, layer); continue; } r -= I_GU;
        wconv_item<0>(w_dn, DM, nullptr, DFF, (bf16*)(C.ws + WS_WDN), scr, r, DM / 32, C.lane, layer);
    }
    const int gt = C.bid * NTHR + C.tid, NGT = C.G * NTHR;
    const float* wlb = W.wlb + (size_t)layer * 96 * 512; const float* alb = W.alb + (size_t)layer * 96 * 512; const float* glb = W.glb + (size_t)layer * 256 * 512;
    const float* vlb = W.vlb;
    bf16* LW = (bf16*)(C.ws + WS_LORA + LO_W); bf16* LA = (bf16*)(C.ws + WS_LORA + LO_A); bf16* LV = (bf16*)(C.ws + WS_LORA + LO_V); bf16* LG = (bf16*)(C.ws + WS_LORA + LO_G);
    for (int i = gt; i < 512 * 96; i += NGT) { const int n = i / 96, k = i % 96; LW[i] = (bf16)f2bf(wlb[k * 512 + n]); LA[i] = (bf16)f2bf(alb[k * 512 + n]); }
    for (int i = gt; i < 512 * 64; i += NGT) { const int n = i / 64, k = i % 64; LV[i] = (bf16)f2bf(layer > 0 ? vlb[k * 512 + n] : 0.f); }
    for (int i = gt; i < 512 * 256; i += NGT) { const int n = i / 256, k = i % 256; LG[i] = (bf16)f2bf(glb[k * 512 + n]); }
    if (layer == 0) {
        float2* TA = (float2*)(C.ws + WS_TAB + TAB_A); float2* TI = (float2*)(C.ws + WS_TAB + TAB_I); float2* TR = (float2*)(C.ws + WS_TAB + TAB_R);
        const float l2a = 18.931568569324174f  , l2r = 13.287712379549449f  ;
        for (int i = gt; i < T * 56; i += NGT) {
            const int pos = i / 56, j = i % 56; float fr; float2* dst;
            if (j < 16) { fr = exp2f(-(float)j * (1.0f / 16.0f) * l2a); dst = TA + pos * 16 + j; }
            else if (j < 24) { fr = exp2f(-(float)(j - 16) * (1.0f / 8.0f) * l2a); dst = TI + pos * 8 + (j - 16); }
            else { fr = exp2f(-(float)(j - 24) * (1.0f / 32.0f) * l2r); dst = TR + pos * 32 + (j - 24); }
            const float ang = (float)pos * fr; *dst = make_float2(cosf(ang), sinf(ang));
        }
    }
}
__device__ __forceinline__ void phase_xg(const Ctx& C, const float* x, const float* g, bf16* out, float* ss) {
    const int gw = C.bid * NWAVES + C.wave, NGW = C.G * NWAVES;
    f32x4 gv[8];
#pragma unroll
    for (int j = 0; j < 8; ++j) gv[j] = *(const f32x4*)(g + 4 * (C.lane + 64 * j));
    for (int m = gw; m < M; m += NGW) {
        const f32x4* xr = (const f32x4*)(x + (size_t)m * DM) + C.lane; f32x4 v[8]; float s = 0.f;
#pragma unroll
        for (int j = 0; j < 8; ++j) { v[j] = xr[64 * j]; s += (v[j].x * v[j].x + v[j].y * v[j].y) + (v[j].z * v[j].z + v[j].w * v[j].w); }
        s = wave_sum(s); if (C.lane == 0) ss[m] = s;
        u32x2* o = (u32x2*)(out + (size_t)m * DM) + C.lane;
#pragma unroll
        for (int j = 0; j < 8; ++j) { u32x2 w; w.x = pk2(v[j].x * gv[j].x, v[j].y * gv[j].y); w.y = pk2(v[j].z * gv[j].z, v[j].w * gv[j].w); o[64 * j] = w; }
    }
}
__device__ __forceinline__ void phase_final_norm(const Ctx& C, float* x, const float* g, const float* ss) {
    const int gw = C.bid * NWAVES + C.wave, NGW = C.G * NWAVES;
    f32x4 gv[8];
#pragma unroll
    for (int j = 0; j < 8; ++j) gv[j] = *(const f32x4*)(g + 4 * (C.lane + 64 * j));
    for (int m = gw; m < M; m += NGW) {
        f32x4* xr = (f32x4*)(x + (size_t)m * DM) + C.lane; const float rs = rsqrtf(ss[m] * (1.0f / DM) + 1e-5f);
#pragma unroll
        for (int j = 0; j < 8; ++j) xr[64 * j] = xr[64 * j] * rs * gv[j];
    }
}
__device__ __forceinline__ void phase_prep_a(const Ctx& C) {
    const long gt = (long)C.bid * NTHR + C.tid, NGT = (long)C.G * NTHR;
    { float* s1 = (float*)(C.ws + WS_SS1); float* s2 = (float*)(C.ws + WS_SS2); for (long i = gt; i < M; i += NGT) { s1[i] = 0.f; s2[i] = 0.f; } }
    for (int cfg = 0; cfg < 6; ++cfg) {
        size_t off; int ld, nh, hd, half; size_t tab;
        if (cfg == 0) { off = WS_Q; ld = 1024; nh = 8; hd = 128; half = 16; tab = TAB_A; }
        else if (cfg == 1) { off = WS_K; ld = 1024; nh = 8; hd = 128; half = 16; tab = TAB_A; }
        else if (cfg == 2) { off = WS_QI; ld = 1024; nh = 16; hd = 64; half = 8; tab = TAB_I; }
        else if (cfg == 3) { off = WS_KW; ld = 256; nh = 1; hd = 64; half = 8; tab = TAB_I; }
        else if (cfg == 4) { off = WS_BQ; ld = 256; nh = 4; hd = 64; half = 32; tab = TAB_R; }
        else { off = WS_BK; ld = 256; nh = 4; hd = 64; half = 32; tab = TAB_R; }
        bf16* buf = (bf16*)(C.ws + off); const float2* tb = (const float2*)(C.ws + WS_TAB + tab);
        const int cpp = half >> 3; const long total = (long)M * nh * cpp;
        for (long it0 = gt; it0 < total; it0 += 4 * NGT) {
            bf16* p1[4]; u32x4 a[4], b[4]; f32x4 tcs[4][4]; bool ok[4];
#pragma unroll
            for (int q = 0; q < 4; ++q) { const long it = it0 + q * NGT; ok[q] = it < total; const long itc = ok[q] ? it : gt;
                const int c = (int)(itc % cpp); const long r2 = itc / cpp; const int h = (int)(r2 % nh); const int row = (int)(r2 / nh); const int pos = row & (T - 1);
                p1[q] = buf + (size_t)row * ld + h * hd + 8 * c; a[q] = *(const u32x4*)p1[q]; b[q] = *(const u32x4*)(p1[q] + half);
                const f32x4* tp = (const f32x4*)(tb + (size_t)pos * half + 8 * c);
#pragma unroll
                for (int e = 0; e < 4; ++e) tcs[q][e] = tp[e]; }
#pragma unroll
            for (int q = 0; q < 4; ++q) { if (!ok[q]) continue; u32x4 oa, ob;
#pragma unroll
                for (int e = 0; e < 4; ++e) { const float x10 = bflo(a[q][e]), x11 = bfhi(a[q][e]), x20 = bflo(b[q][e]), x21 = bfhi(b[q][e]); const f32x4 t = tcs[q][e];
                    oa[e] = pk2(x10 * t.x - x20 * t.y, x11 * t.z - x21 * t.w); ob[e] = pk2(x20 * t.x + x10 * t.y, x21 * t.z + x11 * t.w); }
                *(u32x4*)p1[q] = oa; *(u32x4*)(p1[q] + half) = ob; }
        }
    }
    {
        LAS unsigned short* scr = (LAS unsigned short*)(C.lds + C.wave * 9216);
        const bf16* V = (const bf16*)(C.ws + WS_V); bf16* Vt = (bf16*)(C.ws + WS_VT);
        const int gw = C.bid * NWAVES + C.wave, NGW = C.G * NWAVES, lane = C.lane;
        for (int it = gw; it < NB * 128 * 16; it += NGW) {
            const int ct = it & 15, tt = (it >> 4) & 127, b = it >> 11;
            const int t0 = tt * 64, c0 = ct * 64;
            u32x4 v[8];
#pragma unroll
            for (int i = 0; i < 8; ++i) { const int tr = 8 * i + (lane >> 3), c8 = (lane & 7) * 8; v[i] = *(const u32x4*)(V + (size_t)(b * T + t0 + tr) * 1024 + c0 + c8); }
#pragma unroll
            for (int i = 0; i < 8; ++i) { const int tr = 8 * i + (lane >> 3), c8 = (lane & 7) * 8; *(LAS u32x4*)(scr + tr * 72 + c8) = v[i]; }
            LDS_WAIT(); asm volatile("" ::: "memory");
#pragma unroll
            for (int i = 0; i < 8; ++i) { const int cr = 8 * i + (lane >> 3), t8 = (lane & 7) * 8; u32x4 w;
#pragma unroll
                for (int e = 0; e < 4; ++e) w[e] = (unsigned)scr[(t8 + 2 * e) * 72 + cr] | ((unsigned)scr[(t8 + 2 * e + 1) * 72 + cr] << 16);
                *(u32x4*)(Vt + ((size_t)b * 1024 + c0 + cr) * T + t0 + t8) = w; }
            LDS_WAIT(); asm volatile("" ::: "memory");
        }
    }
}
#ifndef IDX_REP_T
#define IDX_REP_T 1
#endif
#ifndef IDX_REP_S
#define IDX_REP_S 1
#endif
__device__ __forceinline__ void phase_indexer(const Ctx& C) {
    LAS unsigned short* sc = (LAS unsigned short*)C.lds;
    LAS unsigned* hist = (LAS unsigned*)(C.lds + 131072) + C.wave * 256;
    LAS float* wvl = (LAS float*)(C.lds + 131072 + 8192);
    LAS unsigned short* qbl = (LAS unsigned short*)(C.lds + 131072 + 8192 + 512);
    const bf16* QI = (const bf16*)(C.ws + WS_QI); const bf16* KW = (const bf16*)(C.ws + WS_KW); u64* MASK = (u64*)(C.ws + WS_MASK);
    const int lane = C.lane, r32 = lane & 31, hi = lane >> 5;
    for (int it = C.bid; it < NB * (T / 8); it += C.G) {
        const int b = it & 3, qg = it >> 2, q0 = qg * 8, qchunk = q0 >> 6, nadm = 64 * (qchunk + 1);
        const int qrow = b * T + q0 + C.wave;
        if (qchunk < 4) {
            MASK[(size_t)qrow * 128 + lane] = lane <= qchunk ? ~0ull : 0ull; MASK[(size_t)qrow * 128 + 64 + lane] = 0ull;
            continue;
        }
        bf16x8 af[4][4];
        {
            const int qq = (r32 >> 2) & 1, hh = (r32 & 3) + 4 * (r32 >> 3);
#pragma unroll
            for (int pr = 0; pr < 4; ++pr) {
                const bf16* qp = QI + (size_t)(b * T + q0 + 2 * pr + qq) * 1024 + hh * 64 + 8 * hi;
#pragma unroll
                for (int kk = 0; kk < 4; ++kk) af[pr][kk] = *(const bf16x8*)(qp + 16 * kk);
            }
            if (C.tid < 128) wvl[C.tid] = bf2f(KW[(size_t)(b * T + q0 + (C.tid >> 4)) * 256 + 64 + (C.tid & 15)]) * 0.015625f;
        }
        __syncthreads();
        { const int qx = C.tid >> 6, dx = C.tid & 63; const bf16* qp = QI + (size_t)(b * T + q0 + qx) * 1024 + dx; float acc = 0.f;
#pragma unroll
          for (int h = 0; h < 16; ++h) acc += wvl[qx * 16 + h] * bf2f(qp[h * 64]);
          qbl[qx * 64 + dx] = (unsigned short)f2bf(acc); }
        __syncthreads();
        bf16x8 afl[4];
        { const int qsel = 2 * (r32 & 3) + ((r32 >> 2) & 1);
#pragma unroll
          for (int kk = 0; kk < 4; ++kk) { const u32x4 z = {0u, 0u, 0u, 0u}; afl[kk] = r32 < 8 ? *(const LAS bf16x8*)(qbl + qsel * 64 + 16 * kk + 8 * hi) : __builtin_bit_cast(bf16x8, z); } }
        for (int rep_t = 0; rep_t < IDX_REP_T; ++rep_t) {
            const int ntile = nadm / 32;
            bf16x8 bfr[4], bnx[4];
            { const bf16* kp = KW + (size_t)(b * T + 32 * C.wave + r32) * 256 + 8 * hi;
#pragma unroll
              for (int kk = 0; kk < 4; ++kk) bnx[kk] = *(const bf16x8*)(kp + 16 * kk); }
            for (int tile = C.wave; tile < ntile; tile += NWAVES) {
                const int key0 = 32 * tile;
#pragma unroll
                for (int kk = 0; kk < 4; ++kk) bfr[kk] = bnx[kk];
                if (tile + NWAVES < ntile) { const bf16* kp = KW + (size_t)(b * T + key0 + 32 * NWAVES + r32) * 256 + 8 * hi;
#pragma unroll
                    for (int kk = 0; kk < 4; ++kk) bnx[kk] = *(const bf16x8*)(kp + 16 * kk); }
                const int kpos = (key0 & ~127) + 2 * ((key0 & 63) + r32) + ((key0 >> 6) & 1);
                f32x16 dl = {0.f, 0.f, 0.f, 0.f, 0.f, 0.f, 0.f, 0.f, 0.f, 0.f, 0.f, 0.f, 0.f, 0.f, 0.f, 0.f};
#pragma unroll
                for (int kk = 0; kk < 4; ++kk) dl = __builtin_amdgcn_mfma_f32_32x32x16_bf16(afl[kk], bfr[kk], dl, 0, 0, 0);
#pragma unroll
                for (int pr = 0; pr < 4; ++pr) {
                    f32x16 d = {0.f, 0.f, 0.f, 0.f, 0.f, 0.f, 0.f, 0.f, 0.f, 0.f, 0.f, 0.f, 0.f, 0.f, 0.f, 0.f};
#pragma unroll
                    for (int kk = 0; kk < 4; ++kk) d = __builtin_amdgcn_mfma_f32_32x32x16_bf16(af[pr][kk], bfr[kk], d, 0, 0, 0);
                    float s0 = dl[pr];
#pragma unroll
                    for (int g = 0; g < 4; ++g) { const f32x4 w4 = *(const LAS f32x4*)(wvl + (2 * pr + hi) * 16 + 4 * g);
                        s0 = __builtin_fmaf(__builtin_fabsf(d[4 * g]), w4.x, s0); s0 = __builtin_fmaf(__builtin_fabsf(d[4 * g + 1]), w4.y, s0); s0 = __builtin_fmaf(__builtin_fabsf(d[4 * g + 2]), w4.z, s0); s0 = __builtin_fmaf(__builtin_fabsf(d[4 * g + 3]), w4.w, s0); }
                    const unsigned short hb = __half_as_ushort(__float2half_rn(s0));
                    const unsigned short key = (hb & 0x8000u) ? (unsigned short)~hb : (unsigned short)(hb | 0x8000u);
                    sc[(2 * pr + hi) * 8192 + kpos] = key;
                }
            }
        }
        __syncthreads();
        const LAS unsigned* my = (const LAS unsigned*)(sc + C.wave * 8192);
        const int nit = nadm / 128;
        const bool tail = (nadm & 64) != 0;
        unsigned thr = 0;
        for (int rep_s = 0; rep_s < IDX_REP_S; ++rep_s) {
            unsigned want = 256u, prefix = 0u;
#pragma unroll 1
            for (int lvl = 0; lvl < 2; ++lvl) {
                hist[lane] = 0u; hist[64 + lane] = 0u; hist[128 + lane] = 0u; hist[192 + lane] = 0u;
                LDS_WAIT(); asm volatile("" ::: "memory");
                int i = 0;
                for (; i + 4 <= nit; i += 4) { unsigned kv[4];
#pragma unroll
                    for (int u = 0; u < 4; ++u) kv[u] = my[64 * (i + u) + lane];
#pragma unroll
                    for (int u = 0; u < 4; ++u) { const unsigned k0 = kv[u] & 0xffffu, k1 = kv[u] >> 16;
                        if (lvl == 0) { atomicAdd((unsigned*)&hist[k0 >> 8], 1u); atomicAdd((unsigned*)&hist[k1 >> 8], 1u); }
                        else { if ((k0 >> 8) == prefix) atomicAdd((unsigned*)&hist[k0 & 255u], 1u); if ((k1 >> 8) == prefix) atomicAdd((unsigned*)&hist[k1 & 255u], 1u); } } }
                for (; i < nit + (tail ? 1 : 0); ++i) { const unsigned kvv = my[64 * i + lane]; const unsigned k0 = kvv & 0xffffu, k1 = kvv >> 16; const bool two = i < nit;
                    if (lvl == 0) { atomicAdd((unsigned*)&hist[k0 >> 8], 1u); if (two) atomicAdd((unsigned*)&hist[k1 >> 8], 1u); }
                    else { if ((k0 >> 8) == prefix) atomicAdd((unsigned*)&hist[k0 & 255u], 1u); if (two && (k1 >> 8) == prefix) atomicAdd((unsigned*)&hist[k1 & 255u], 1u); } }
                LDS_WAIT(); asm volatile("" ::: "memory");
                const unsigned c0 = hist[4 * lane], c1 = hist[4 * lane + 1], c2 = hist[4 * lane + 2], c3 = hist[4 * lane + 3];
                const unsigned tl = c0 + c1 + c2 + c3; unsigned inc = tl;
#pragma unroll
                for (int o = 1; o < 64; o <<= 1) { const unsigned v = __shfl_down(inc, o); if (lane + o < 64) inc += v; }
                const unsigned ab3 = inc - tl, ab2 = ab3 + c3, ab1 = ab2 + c2, ab0 = ab1 + c1;
                int selb = -1; unsigned rem = 0;
                if (ab3 < want && ab3 + c3 >= want) { selb = 3; rem = want - ab3; }
                else if (ab2 < want && ab2 + c2 >= want) { selb = 2; rem = want - ab2; }
                else if (ab1 < want && ab1 + c1 >= want) { selb = 1; rem = want - ab1; }
                else if (ab0 < want && ab0 + c0 >= want) { selb = 0; rem = want - ab0; }
                const u64 bal = __ballot(selb >= 0); const int src = bal ? (int)__ffsll((long long)bal) - 1 : 0;
                const unsigned bin = (unsigned)__shfl(4 * lane + (selb < 0 ? 0 : selb), src); want = (unsigned)__shfl((int)rem, src);
                if (lvl == 0) prefix = bin; else thr = (prefix << 8) | bin;
                LDS_WAIT(); asm volatile("" ::: "memory");
            }
        }
        u64 w0 = 0, w1 = 0;
        for (int i = 0; i < nit + (tail ? 1 : 0); ++i) { const unsigned kvv = my[64 * i + lane]; const u64 b0 = __ballot((kvv & 0xffffu) >= thr), b1 = (i < nit) ? __ballot((kvv >> 16) >= thr) : 0ull;
            if (i < 32) { if (lane == 2 * i) w0 = b0; if (lane == 2 * i + 1) w0 = b1; } else { if (lane == 2 * i - 64) w1 = b0; if (lane == 2 * i - 63) w1 = b1; } }
        MASK[(size_t)qrow * 128 + lane] = w0; MASK[(size_t)qrow * 128 + 64 + lane] = w1;
        __syncthreads();
    }
}
constexpr int AT_KROW = 272, AT_VROW = 136, AT_KB = 64 * AT_KROW, AT_VB = 128 * AT_VROW, AT_BUF = AT_KB + AT_VB;
__device__ __forceinline__ void attn_unit(const Ctx& C, int b, int head, int qb) {
    const bf16* Q = (const bf16*)(C.ws + WS_Q); const bf16* K = (const bf16*)(C.ws + WS_K); const bf16* Vt = (const bf16*)(C.ws + WS_VT);
    const u64* MASK = (const u64*)(C.ws + WS_MASK); bf16* CAT = (bf16*)(C.ws + WS_CAT);
    const int tid = C.tid, lane = C.lane, wid = C.wave, r32 = lane & 31, hi = lane >> 5;
    const int q = 256 * qb + 32 * wid + r32; const size_t row = (size_t)b * T + q;
    const int nt = 4 * qb + 4, myc = 4 * qb + (wid >> 1);
    bf16x8 qf[8];
#pragma unroll
    for (int d0 = 0; d0 < 8; ++d0) qf[d0] = *(const bf16x8*)(Q + row * 1024 + head * 128 + 16 * d0 + 8 * hi);
    const bf16* kg[2]; const bf16* vg[2]; int kl[2], vl[2];
#pragma unroll
    for (int i = 0; i < 2; ++i) { const int c = tid + 512 * i;
        kg[i] = K + ((size_t)b * T + (c >> 4)) * 1024 + head * 128 + (c & 15) * 8; kl[i] = (c >> 4) * AT_KROW + (c & 15) * 16;
        vg[i] = Vt + ((size_t)(b * 8 + head) * 128 + (c >> 3)) * T + (c & 7) * 8; vl[i] = AT_KB + (c >> 3) * AT_VROW + (c & 7) * 16; }
    u32x4 kr[2], vr[2];
#pragma unroll
    for (int i = 0; i < 2; ++i) { kr[i] = *(const u32x4*)kg[i]; vr[i] = *(const u32x4*)vg[i]; }
#pragma unroll
    for (int i = 0; i < 2; ++i) { *(LAS u32x4*)(C.lds + kl[i]) = kr[i]; *(LAS u32x2*)(C.lds + vl[i]) = (u32x2){vr[i].x, vr[i].y}; *(LAS u32x2*)(C.lds + vl[i] + 8) = (u32x2){vr[i].z, vr[i].w}; }
    __syncthreads();
    float lrun = 0.f; f32x16 o[4];
#pragma unroll
    for (int db = 0; db < 4; ++db)
#pragma unroll
        for (int r = 0; r < 16; ++r) o[db][r] = 0.f;
    for (int t = 0; t < nt; ++t) {
        const int cur = (t & 1) * AT_BUF, nxt = ((t + 1) & 1) * AT_BUF;
        if (t + 1 < nt) {
#pragma unroll
            for (int i = 0; i < 2; ++i) { kr[i] = *(const u32x4*)(kg[i] + (size_t)(t + 1) * 64 * 1024); vr[i] = *(const u32x4*)(vg[i] + (t + 1) * 64); }
        }
        if (t <= myc) {
            const u64 mw = MASK[row * 128 + t];
            const LAS unsigned char* Ks = C.lds + cur; const LAS unsigned char* Vs = C.lds + cur + AT_KB;
            f32x16 p0, p1;
#pragma unroll
            for (int r = 0; r < 16; ++r) { p0[r] = 0.f; p1[r] = 0.f; }
#pragma unroll
            for (int d0 = 0; d0 < 8; ++d0) {
                const bf16x8 k0 = *(const LAS bf16x8*)(Ks + r32 * AT_KROW + (16 * d0 + 8 * hi) * 2);
                const bf16x8 k1 = *(const LAS bf16x8*)(Ks + (32 + r32) * AT_KROW + (16 * d0 + 8 * hi) * 2);
                p0 = __builtin_amdgcn_mfma_f32_32x32x16_bf16(k0, qf[d0], p0, 0, 0, 0);
                p1 = __builtin_amdgcn_mfma_f32_32x32x16_bf16(k1, qf[d0], p1, 0, 0, 0);
            }
            const int mlo = (int)((unsigned)mw >> (4 * hi)), mhi = (int)((unsigned)(mw >> 32) >> (4 * hi));
            float ls0 = 0.f, ls1 = 0.f;
#pragma unroll
            for (int r = 0; r < 16; ++r) { const int c = (r & 3) + 8 * (r >> 2);
                const unsigned e0 = __float_as_uint(__builtin_amdgcn_exp2f(p0[r])) & (unsigned)__builtin_amdgcn_sbfe(mlo, c, 1);
                const unsigned e1 = __float_as_uint(__builtin_amdgcn_exp2f(p1[r])) & (unsigned)__builtin_amdgcn_sbfe(mhi, c, 1);
                p0[r] = __uint_as_float(e0); p1[r] = __uint_as_float(e1); ls0 += p0[r]; ls1 += p1[r]; }
            lrun += ls0 + ls1;
            bf16x8 pb[4];
#pragma unroll
            for (int kk = 0; kk < 4; ++kk) { u32x4 w;
#pragma unroll
                for (int e = 0; e < 4; ++e) { const int r = 8 * (kk & 1) + 2 * e; w[e] = (kk < 2) ? pg8::cvt_pk_bf16(p0[r], p0[r + 1]) : pg8::cvt_pk_bf16(p1[r], p1[r + 1]); }
                pb[kk] = __builtin_bit_cast(bf16x8, w); }
#pragma unroll
            for (int db = 0; db < 4; ++db)
#pragma unroll
                for (int kk = 0; kk < 4; ++kk) {
                    const LAS unsigned char* vp = Vs + (32 * db + r32) * AT_VROW + (16 * kk + 4 * hi) * 2;
                    const u32x2 a0 = *(const LAS u32x2*)vp, a1 = *(const LAS u32x2*)(vp + 16);
                    const u32x4 w = {a0.x, a0.y, a1.x, a1.y};
                    o[db] = __builtin_amdgcn_mfma_f32_32x32x16_bf16(__builtin_bit_cast(bf16x8, w), pb[kk], o[db], 0, 0, 0);
                }
        }
        if (t + 1 < nt) {
#pragma unroll
            for (int i = 0; i < 2; ++i) { *(LAS u32x4*)(C.lds + nxt + kl[i]) = kr[i]; *(LAS u32x2*)(C.lds + nxt + vl[i]) = (u32x2){vr[i].x, vr[i].y}; *(LAS u32x2*)(C.lds + nxt + vl[i] + 8) = (u32x2){vr[i].z, vr[i].w}; }
        }
        __syncthreads();
    }
    lrun += __shfl_xor(lrun, 32);
    const float inv = 1.0f / lrun;
    bf16* op = CAT + row * 2048 + head * 128 + 4 * hi;
#pragma unroll
    for (int db = 0; db < 4; ++db)
#pragma unroll
        for (int g = 0; g < 4; ++g) { u32x2 w; w.x = pk2(o[db][4 * g] * inv, o[db][4 * g + 1] * inv); w.y = pk2(o[db][4 * g + 2] * inv, o[db][4 * g + 3] * inv);
            *(u32x2*)(op + 32 * db + 8 * g) = w; }
}
__device__ __forceinline__ void phase_attn(const Ctx& C) {
    for (int i = C.bid; i < 1024; i += C.G) {
        const int w = i & 255, k = i >> 8, combo = w >> 3, j = w & 7;
        const int qb = k == 0 ? j : k == 1 ? 15 - j : k == 2 ? 16 + j : 31 - j;
        attn_unit(C, combo >> 3, combo & 7, qb);
        __syncthreads();
    }
}
__device__ __forceinline__ float ret_logg(int h) { return log1pf(-exp2f(-5.0f - (float)h)); }
constexpr int RT_KP = 72, RT_VP = 136;
__device__ __forceinline__ bf16x8 lds_col8(const LAS bf16* p, int pitch, const int (&rows)[8]) {
    u32x4 w;
#pragma unroll
    for (int e = 0; e < 4; ++e) w[e] = (unsigned)p[rows[2 * e] * pitch] | ((unsigned)p[rows[2 * e + 1] * pitch] << 16);
    return __builtin_bit_cast(bf16x8, w);
}
__device__ __forceinline__ void phase_ret1(const Ctx& C) {
    LAS bf16* Ks = (LAS bf16*)C.lds;
    LAS bf16* Vs = Ks + 64 * RT_KP;
    const bf16* BK = (const bf16*)(C.ws + WS_BK); const bf16* BV = (const bf16*)(C.ws + WS_BV); float* KV = (float*)(C.ws + WS_KVST);
    const int tid = C.tid, lane = C.lane, r32 = lane & 31, hi = lane >> 5, db = C.wave >> 2, eb = C.wave & 3;
    for (int u = C.bid; u < NB * 128 * 4; u += C.G) {
        const int h = u & 3, c = (u >> 2) & 127, b = u >> 9; const size_t row0 = (size_t)b * T + 64 * c; const float lg = ret_logg(h);
        { const int m = tid >> 3, d8 = (tid & 7) * 8; const u32x4 w = *(const u32x4*)(BK + (row0 + m) * 256 + h * 64 + d8); const float z = __expf((63.0f - (float)m) * lg) * 0.125f;
          u32x4 o;
#pragma unroll
          for (int e = 0; e < 4; ++e) o[e] = pk2(bflo(w[e]) * z, bfhi(w[e]) * z);
          *(LAS u32x4*)(Ks + m * RT_KP + d8) = o; }
#pragma unroll
        for (int i = 0; i < 2; ++i) { const int cidx = tid + 512 * i, m = cidx >> 4, e8 = (cidx & 15) * 8; *(LAS u32x4*)(Vs + m * RT_VP + e8) = *(const u32x4*)(BV + (row0 + m) * 512 + h * 128 + e8); }
        __syncthreads();
        f32x16 acc;
#pragma unroll
        for (int r = 0; r < 16; ++r) acc[r] = 0.f;
#pragma unroll
        for (int kk = 0; kk < 4; ++kk) {
            int rows[8];
#pragma unroll
            for (int j = 0; j < 8; ++j) rows[j] = 16 * kk + 8 * hi + j;
            const bf16x8 af = lds_col8(Ks + 32 * db + r32, RT_KP, rows), bfv = lds_col8(Vs + 32 * eb + r32, RT_VP, rows);
            acc = __builtin_amdgcn_mfma_f32_32x32x16_bf16(af, bfv, acc, 0, 0, 0);
        }
        float* dst = KV + (size_t)u * 8192 + (size_t)(32 * eb + r32) * 64 + 32 * db + 4 * hi;
#pragma unroll
        for (int g = 0; g < 4; ++g) *(f32x4*)(dst + 8 * g) = (f32x4){acc[4 * g], acc[4 * g + 1], acc[4 * g + 2], acc[4 * g + 3]};
        __syncthreads();
    }
}
__device__ __forceinline__ void phase_ret2(const Ctx& C) {
    float* KV = (float*)(C.ws + WS_KVST);
    for (int g = C.bid * NTHR + C.tid; g < NB * 4 * 8192; g += C.G * NTHR) {
        const int el = g & 8191, h = (g >> 13) & 3, b = g >> 15; const float gc = __expf(64.0f * ret_logg(h));
        float* p = KV + ((size_t)b * 512 + h) * 8192 + el;
        float st = 0.f;
        for (int c0 = 0; c0 < 128; c0 += 8) { float x[8];
#pragma unroll
            for (int i = 0; i < 8; ++i) x[i] = p[(size_t)(c0 + i) * 4 * 8192];
#pragma unroll
            for (int i = 0; i < 8; ++i) { p[(size_t)(c0 + i) * 4 * 8192] = st; st = st * gc + x[i]; } }
    }
}
__device__ __forceinline__ void phase_ret3(const Ctx& C) {
    LAS bf16* Qs = (LAS bf16*)C.lds;
    LAS bf16* Ks = Qs + 64 * RT_KP;
    LAS bf16* Vs = Ks + 64 * RT_KP;
    LAS float* Red = (LAS float*)(Vs + 64 * RT_VP);
    const bf16* BQ = (const bf16*)(C.ws + WS_BQ); const bf16* BK = (const bf16*)(C.ws + WS_BK); const bf16* BV = (const bf16*)(C.ws + WS_BV); const bf16* BG = (const bf16*)(C.ws + WS_BG);
    const float* KV = (const float*)(C.ws + WS_KVST); bf16* CAT = (bf16*)(C.ws + WS_CAT);
    const int tid = C.tid, lane = C.lane, r32 = lane & 31, hi = lane >> 5, nb = C.wave >> 2, eb = C.wave & 3;
    for (int u = C.bid; u < NB * 128 * 4; u += C.G) {
        const int h = u & 3, c = (u >> 2) & 127, b = u >> 9; const size_t row0 = (size_t)b * T + 64 * c; const float l2g = ret_logg(h) * 1.4426950408889634f;
        { const int m = tid >> 3, d8 = (tid & 7) * 8; *(LAS u32x4*)(Qs + m * RT_KP + d8) = *(const u32x4*)(BQ + (row0 + m) * 256 + h * 64 + d8);
          const u32x4 w = *(const u32x4*)(BK + (row0 + m) * 256 + h * 64 + d8); u32x4 o;
#pragma unroll
          for (int e = 0; e < 4; ++e) o[e] = pk2(bflo(w[e]) * 0.125f, bfhi(w[e]) * 0.125f);
          *(LAS u32x4*)(Ks + m * RT_KP + d8) = o; }
#pragma unroll
        for (int i = 0; i < 2; ++i) { const int cidx = tid + 512 * i, m = cidx >> 4, e8 = (cidx & 15) * 8; *(LAS u32x4*)(Vs + m * RT_VP + e8) = *(const u32x4*)(BV + (row0 + m) * 512 + h * 128 + e8); }
        bf16x8 pf[4];
        { const float* pp = KV + (size_t)u * 8192 + (size_t)(32 * eb + r32) * 64 + 8 * hi;
#pragma unroll
          for (int kk = 0; kk < 4; ++kk) { const f32x4 a0 = *(const f32x4*)(pp + 16 * kk), a1 = *(const f32x4*)(pp + 16 * kk + 4);
              u32x4 w; w.x = pk2(a0.x, a0.y); w.y = pk2(a0.z, a0.w); w.z = pk2(a1.x, a1.y); w.w = pk2(a1.z, a1.w); pf[kk] = __builtin_bit_cast(bf16x8, w); } }
        __syncthreads();
        bf16x8 qf[4];
#pragma unroll
        for (int kk = 0; kk < 4; ++kk) qf[kk] = *(const LAS bf16x8*)(Qs + (32 * nb + r32) * RT_KP + 16 * kk + 8 * hi);
        f32x16 cr, out;
#pragma unroll
        for (int r = 0; r < 16; ++r) { cr[r] = 0.f; out[r] = 0.f; }
#pragma unroll
        for (int kk = 0; kk < 4; ++kk) cr = __builtin_amdgcn_mfma_f32_32x32x16_bf16(qf[kk], pf[kk], cr, 0, 0, 0);
        const float gn = __builtin_amdgcn_exp2f((float)(32 * nb + r32) * l2g);
#pragma unroll
        for (int mb = 0; mb < 2; ++mb) {
            if (mb > nb) continue;
            f32x16 st;
#pragma unroll
            for (int r = 0; r < 16; ++r) st[r] = 0.f;
#pragma unroll
            for (int kk = 0; kk < 4; ++kk) { const bf16x8 kf = *(const LAS bf16x8*)(Ks + (32 * mb + r32) * RT_KP + 16 * kk + 8 * hi); st = __builtin_amdgcn_mfma_f32_32x32x16_bf16(kf, qf[kk], st, 0, 0, 0); }
            const int nq = 32 * nb + r32;
#pragma unroll
            for (int r = 0; r < 16; ++r) { const int m = 32 * mb + (r & 3) + 8 * (r >> 2) + 4 * hi; st[r] = (m <= nq) ? st[r] * gn * __builtin_amdgcn_exp2f(-(float)m * l2g) : 0.f; }
#pragma unroll
            for (int s2 = 0; s2 < 2; ++s2) {
                u32x4 w;
#pragma unroll
                for (int e = 0; e < 4; ++e) w[e] = pg8::cvt_pk_bf16(st[8 * s2 + 2 * e], st[8 * s2 + 2 * e + 1]);
                int rows[8];
#pragma unroll
                for (int j = 0; j < 8; ++j) rows[j] = 32 * mb + 16 * s2 + 8 * (j >> 2) + 4 * hi + (j & 3);
                const bf16x8 vf = lds_col8(Vs + 32 * eb + r32, RT_VP, rows);
                out = __builtin_amdgcn_mfma_f32_32x32x16_bf16(__builtin_bit_cast(bf16x8, w), vf, out, 0, 0, 0);
            }
        }
        float sv[16], s2v[16];
#pragma unroll
        for (int r = 0; r < 16; ++r) { const int n = 32 * nb + (r & 3) + 8 * (r >> 2) + 4 * hi; out[r] += __builtin_amdgcn_exp2f((float)(n + 1) * l2g) * cr[r]; sv[r] = half_sum32(out[r]); s2v[r] = half_sum32(out[r] * out[r]); }
        if (r32 == 0) {
#pragma unroll
            for (int r = 0; r < 16; ++r) { const int n = 32 * nb + (r & 3) + 8 * (r >> 2) + 4 * hi; *(LAS f32x2*)(Red + (n * 4 + eb) * 2) = (f32x2){sv[r], s2v[r]}; }
        }
        __syncthreads();
#pragma unroll
        for (int r = 0; r < 16; ++r) { const int n = 32 * nb + (r & 3) + 8 * (r >> 2) + 4 * hi;
            const f32x4 p0 = *(const LAS f32x4*)(Red + n * 8), p1 = *(const LAS f32x4*)(Red + n * 8 + 4);
            const float mean = (p0.x + p0.z + p1.x + p1.z) * (1.0f / 128.0f), ex2 = (p0.y + p0.w + p1.y + p1.w) * (1.0f / 128.0f);
            const float rstd = rsqrtf(fmaxf(ex2 - mean * mean, 0.f) + 1e-5f);
            const float gg = bf2f(BG[(row0 + n) * 512 + h * 128 + 32 * eb + r32]); const float sl = gg * __builtin_amdgcn_rcpf(1.0f + __expf(-gg));
            CAT[(row0 + n) * 2048 + 1024 + h * 128 + 32 * eb + r32] = (bf16)f2bf((out[r] - mean) * rstd * sl); }
        __syncthreads();
    }
}
__device__ __forceinline__ float sigmoidf_(float x) { return __builtin_amdgcn_rcpf(1.0f + __expf(-x)); }
constexpr int RW_AW = 104, RW_AV = 72, RW_AG = 264;
constexpr int RW1_BUF = 32 * RW_AW * 2 + 32 * RW_AV;
struct RwP { const float *mu, *mu_v, *w0, *a0, *v0, *k_k, *k_a, *r_k, *lnx_g, *lnx_b; };
template <class TT> __device__ __forceinline__ GAS TT* opaque_g(const TT* p) {
    unsigned lo = (unsigned)(uintptr_t)p, hi = (unsigned)((uintptr_t)p >> 32); asm volatile("" : "+v"(lo), "+v"(hi));
    lo = __builtin_amdgcn_readfirstlane(lo); hi = __builtin_amdgcn_readfirstlane(hi); return (GAS TT*)(((uintptr_t)hi << 32) | lo);
}
__device__ __forceinline__ int tokr(int r, int hi) { return (r & 3) + 8 * (r >> 2) + 4 * hi; }
__device__ __forceinline__ void shifted16(GAS bf16* ub, const unsigned (&off)[16], int cbo, bool first_unit, int hi, float mu, float (&x)[16]) {
    float cur[16], prv[4];
#pragma unroll
    for (int r = 0; r < 16; ++r) cur[r] = bf2f(at_b(ub, off[r])[cbo]);
#pragma unroll
    for (int g = 0; g < 4; ++g) { const bool first = (g == 0) && (hi == 0) && first_unit; prv[g] = first ? 0.f : bf2f(at_b(ub, off[4 * g])[cbo - 512]); }
#pragma unroll
    for (int r = 0; r < 16; ++r) { const float p = (r & 3) == 0 ? prv[r >> 2] : cur[r - 1]; x[r] = cur[r] + (p - cur[r]) * mu; }
}
__device__ __forceinline__ void phase_rw1(const Ctx& C, int layer, const RwP& P) {
    LAS bf16* ACT = (LAS bf16*)C.lds;
    const bf16* CR = (const bf16*)(C.ws + WS_CR); const bf16* CK = (const bf16*)(C.ws + WS_CK); const bf16* CV = (const bf16*)(C.ws + WS_CV); const bf16* CL = (const bf16*)(C.ws + WS_CL);
    const bf16* LW = (const bf16*)(C.ws + WS_LORA + LO_W); const bf16* LA = (const bf16*)(C.ws + WS_LORA + LO_A); const bf16* LV = (const bf16*)(C.ws + WS_LORA + LO_V);
    bf16* VF = (bf16*)(C.ws + WS_VFIRST);
    bf16* RR = (bf16*)(C.ws + WS_RR); bf16* RU = (bf16*)(C.ws + WS_RW); bf16* RKH = (bf16*)(C.ws + WS_RKH); bf16* RV = (bf16*)(C.ws + WS_RV); bf16* RA = (bf16*)(C.ws + WS_RA); bf16* RB = (bf16*)(C.ws + WS_RB);
    const float* mu = P.mu + (size_t)layer * 1984; const float* mu_v = P.mu_v;
    const float* w0 = P.w0 + layer * 512; const float* a0 = P.a0 + layer * 512; const float* v0 = P.v0; const float* k_k = P.k_k + layer * 512; const float* k_a = P.k_a + layer * 512;
    const int tid = C.tid, lane = C.lane, wid = C.wave;
    constexpr int NU = M / 32;
    u32x4 ncur[2], nprv[2];
#define RW1_LOAD(uu) do { _Pragma("unroll") for (int j = 0; j < 2; ++j) { const int ci = tid + 512 * j, tok = ci >> 5, c8 = (ci & 31) * 8; const size_t mm = (size_t)(uu) * 32 + tok; \
        ncur[j] = *(const u32x4*)(CL + mm * 256 + c8); const u32x4 z4 = {0u, 0u, 0u, 0u}; nprv[j] = (mm & (T - 1)) == 0 ? z4 : *(const u32x4*)(CL + (mm - 1) * 256 + c8); } } while (0)
#define RW1_STORE(bufi) do { _Pragma("unroll") for (int j = 0; j < 2; ++j) { const int ci = tid + 512 * j, tok = ci >> 5, c8 = (ci & 31) * 8; \
        const float* mp = c8 < 192 ? mu + 1536 + c8 : mu_v + (c8 - 192); f32x4 m0v = {0.f, 0.f, 0.f, 0.f}, m1v = m0v; if (c8 < 192 || layer > 0) { m0v = *(const f32x4*)mp; m1v = *(const f32x4*)(mp + 4); } \
        float xs[8]; _Pragma("unroll") for (int e = 0; e < 4; ++e) { const float c0 = bflo(ncur[j][e]), c1 = bfhi(ncur[j][e]), p0 = bflo(nprv[j][e]), p1 = bfhi(nprv[j][e]); \
            const float ma = e < 2 ? m0v[2 * e] : m1v[2 * e - 4], mb = e < 2 ? m0v[2 * e + 1] : m1v[2 * e - 3]; xs[2 * e] = c0 + (p0 - c0) * ma; xs[2 * e + 1] = c1 + (p1 - c1) * mb; } \
        if (c8 < 96) { _Pragma("unroll") for (int e = 0; e < 8; ++e) xs[e] = 1.0f - 2.0f * __builtin_amdgcn_rcpf(__expf(2.0f * xs[e]) + 1.0f); }     \
        u32x4 o; o.x = pk2(xs[0], xs[1]); o.y = pk2(xs[2], xs[3]); o.z = pk2(xs[4], xs[5]); o.w = pk2(xs[6], xs[7]); \
        LAS bf16* dst = ACT + (bufi) * RW1_BUF + (c8 < 96 ? tok * RW_AW + c8 : c8 < 192 ? 32 * RW_AW + tok * RW_AW + (c8 - 96) : 64 * RW_AW + tok * RW_AV + (c8 - 192)); \
        *(LAS u32x4*)dst = o; } } while (0)
    int u = C.bid; if (u >= NU) return;
    RW1_LOAD(u); RW1_STORE(0); __syncthreads();
    for (int kbuf = 0; ; kbuf ^= 1) {
        const int un = u + C.G; const bool has_next = un < NU;
        if (has_next) RW1_LOAD(un);
        {
            int r32 = lane & 31, hi = lane >> 5; asm volatile("" : "+v"(r32), "+v"(hi));
            const size_t m0 = (size_t)u * 32; const bool first_unit = (m0 & (T - 1)) == 0;
            const LAS bf16* AW = ACT + kbuf * RW1_BUF; const LAS bf16* AA = AW + 32 * RW_AW; const LAS bf16* AV = AA + 32 * RW_AW;
            unsigned off[16];
#pragma unroll
            for (int r = 0; r < 16; ++r) off[r] = (unsigned)(tokr(r, hi) * 512 + 64 * wid + r32) * 2u;
            GAS bf16* CRu = opaque_g(CR + m0 * 512); GAS bf16* CKu = opaque_g(CK + m0 * 512); GAS bf16* CVu = opaque_g(CV + m0 * 512); GAS bf16* VFu = opaque_g(VF + m0 * 512);
            GAS bf16* RRu = opaque_g(RR + m0 * 512); GAS bf16* RUu = opaque_g(RU + m0 * 512); GAS bf16* RKHu = opaque_g(RKH + m0 * 512); GAS bf16* RVu = opaque_g(RV + m0 * 512); GAS bf16* RAu = opaque_g(RA + m0 * 512); GAS bf16* RBu = opaque_g(RB + m0 * 512);
            float ks[2][16], inv[16];
            {
                float ssr[16];
#pragma unroll
                for (int r = 0; r < 16; ++r) ssr[r] = 0.f;
#pragma unroll
                for (int cb = 0; cb < 2; ++cb) { const int c = 64 * wid + 32 * cb + r32; const float kkc = k_k[c]; shifted16(CKu, off, 32 * cb, first_unit, hi, mu[512 + c], ks[cb]);
#pragma unroll
                    for (int r = 0; r < 16; ++r) { const float kr = ks[cb][r] * kkc; ssr[r] += kr * kr; } }
#pragma unroll
                for (int r = 0; r < 16; ++r) inv[r] = 1.0f / fmaxf(sqrtf(half_sum32(ssr[r])), 1e-12f);
            }
#pragma unroll
            for (int cb = 0; cb < 2; ++cb) {
                const int c = 64 * wid + 32 * cb + r32; const int ci = 32 * cb;
                asm volatile("" : "+v"(off[0]), "+v"(off[1]), "+v"(off[2]), "+v"(off[3]), "+v"(off[4]), "+v"(off[5]), "+v"(off[6]), "+v"(off[7]), "+v"(off[8]), "+v"(off[9]), "+v"(off[10]), "+v"(off[11]), "+v"(off[12]), "+v"(off[13]), "+v"(off[14]), "+v"(off[15]));
                {
                    float rs[16]; shifted16(CRu, off, ci, first_unit, hi, mu[c], rs);
#pragma unroll
                    for (int r = 0; r < 16; ++r) at_b(RRu, off[r])[ci] = (bf16)f2bf(rs[r]);
                }
                asm volatile("" ::: "memory");
                {
                    float vs[16]; shifted16(CVu, off, ci, first_unit, hi, mu[1024 + c], vs);
                    if (layer > 0) {
                        f32x16 dv;
#pragma unroll
                        for (int r = 0; r < 16; ++r) dv[r] = 0.f;
#pragma unroll
                        for (int kk = 0; kk < 4; ++kk) { const bf16x8 wv = *(const bf16x8*)(LV + c * 64 + 16 * kk + 8 * hi); const bf16x8 xv = *(const LAS bf16x8*)(AV + r32 * RW_AV + 16 * kk + 8 * hi);
                            dv = __builtin_amdgcn_mfma_f32_32x32x16_bf16(xv, wv, dv, 0, 0, 0); }
                        const float v0c = v0[c];
#pragma unroll
                        for (int r = 0; r < 16; ++r) { const float vf = bf2f(at_b(VFu, off[r])[ci]); at_b(RVu, off[r])[ci] = (bf16)f2bf(vs[r] + (vf - vs[r]) * sigmoidf_(v0c + dv[r])); }
                    } else {
#pragma unroll
                        for (int r = 0; r < 16; ++r) { const bf16 vb = (bf16)f2bf(vs[r]); at_b(VFu, off[r])[ci] = vb; at_b(RVu, off[r])[ci] = vb; }
                    }
                }
                asm volatile("" ::: "memory");
                {
                    f32x16 dw;
#pragma unroll
                    for (int r = 0; r < 16; ++r) dw[r] = 0.f;
#pragma unroll
                    for (int kk = 0; kk < 6; ++kk) { const bf16x8 ww = *(const bf16x8*)(LW + c * 96 + 16 * kk + 8 * hi); const bf16x8 xw = *(const LAS bf16x8*)(AW + r32 * RW_AW + 16 * kk + 8 * hi);
                        dw = __builtin_amdgcn_mfma_f32_32x32x16_bf16(xw, ww, dw, 0, 0, 0); }
                    const float w0c = w0[c];
#pragma unroll
                    for (int r = 0; r < 16; ++r) { const float z = -(w0c + dw[r]); const float sp = fmaxf(z, 0.f) + __logf(1.0f + __expf(-fabsf(z)));
                        at_b(RUu, off[r])[ci] = (bf16)f2bf(1.0f - __expf(-__expf(-sp - 0.5f))); }
                }
                asm volatile("" ::: "memory");
                {
                    f32x16 da;
#pragma unroll
                    for (int r = 0; r < 16; ++r) da[r] = 0.f;
#pragma unroll
                    for (int kk = 0; kk < 6; ++kk) { const bf16x8 wa = *(const bf16x8*)(LA + c * 96 + 16 * kk + 8 * hi); const bf16x8 xa = *(const LAS bf16x8*)(AA + r32 * RW_AW + 16 * kk + 8 * hi);
                        da = __builtin_amdgcn_mfma_f32_32x32x16_bf16(xa, wa, da, 0, 0, 0); }
                    const float a0c = a0[c], kkc = k_k[c], kac = k_a[c];
#pragma unroll
                    for (int r = 0; r < 16; ++r) { const float a = sigmoidf_(a0c + da[r]); const float ksx = ks[cb][r]; const float kk = ksx * kkc * inv[r];
                        at_b(RKHu, off[r])[ci] = (bf16)f2bf(ksx * (1.0f + (a - 1.0f) * kac)); at_b(RAu, off[r])[ci] = (bf16)f2bf(-kk); at_b(RBu, off[r])[ci] = (bf16)f2bf(kk * a); }
                }
                asm volatile("" ::: "memory");
            }
        }
        if (has_next) RW1_STORE(kbuf ^ 1);
        __syncthreads();
        if (!has_next) break;
        u = un;
    }
#undef RW1_LOAD
#undef RW1_STORE
}
constexpr int RW_L = 128, RW_NC = T / RW_L;
constexpr int RW_TB = 8, RW_STG = 5 * RW_TB * 64 + 64;
__device__ __forceinline__ float xhalf_sum(float x) { const auto rr = __builtin_amdgcn_permlane32_swap(__float_as_uint(x), __float_as_uint(x), false, false); return __uint_as_float(rr[0]) + __uint_as_float(rr[1]); }
__device__ __forceinline__ float dot32(const f32x16& d0, const f32x16& d1, const f32x4 (&v)[2][4]) {
    f32x2 acc = {0.f, 0.f};
#pragma unroll
    for (int g = 0; g < 4; ++g) { acc += (f32x2){d0[4 * g], d0[4 * g + 1]} * (f32x2){v[0][g].x, v[0][g].y}; acc += (f32x2){d0[4 * g + 2], d0[4 * g + 3]} * (f32x2){v[0][g].z, v[0][g].w};
        acc += (f32x2){d1[4 * g], d1[4 * g + 1]} * (f32x2){v[1][g].x, v[1][g].y}; acc += (f32x2){d1[4 * g + 2], d1[4 * g + 3]} * (f32x2){v[1][g].z, v[1][g].w}; }
    return acc.x + acc.y;
}
template <int NS, bool OUT>
__device__ __forceinline__ void rwkv_chunk(f32x16 (&D)[NS][2][2], LAS float* stg, const bf16* RWd, const bf16* RA, const bf16* RB, const bf16* RKH, const bf16* RV, const bf16* RR, float* Y, size_t base0, int nsteps, int lane) {
    const int r32 = lane & 31, hi = lane >> 5;
    unsigned short qw[RW_TB], qa[RW_TB], qr[RW_TB], qb[RW_TB], qk[RW_TB], qv[RW_TB];
#define RWC_LOAD(tt) do { _Pragma("unroll") for (int s = 0; s < RW_TB; ++s) { const size_t o = base0 + (size_t)((tt) + s) * 512 + lane; qw[s] = RWd[o]; qa[s] = RA[o]; if (OUT) qr[s] = RR[o]; qb[s] = RB[o]; qk[s] = RKH[o]; qv[s] = RV[o]; } } while (0)
    RWC_LOAD(0);
    float G = 1.0f;
    for (int t0 = 0; t0 < nsteps; t0 += RW_TB) {
#pragma unroll
        for (int s = 0; s < RW_TB; ++s) { const float w = 1.0f - bf2f(qw[s]); stg[(0 * RW_TB + s) * 64 + lane] = bf2f(qa[s]) * G; G *= w; const float ig = __builtin_amdgcn_rcpf(G);
            if (OUT) stg[(1 * RW_TB + s) * 64 + lane] = bf2f(qr[s]) * G; stg[(2 * RW_TB + s) * 64 + lane] = bf2f(qb[s]) * ig; stg[(3 * RW_TB + s) * 64 + lane] = bf2f(qk[s]) * ig; stg[(4 * RW_TB + s) * 64 + lane] = bf2f(qv[s]); }
        if (t0 + RW_TB < nsteps) RWC_LOAD(t0 + RW_TB);
        LDS_WAIT(); asm volatile("" ::: "memory");
#pragma unroll 1
        for (int s = 0; s < RW_TB; ++s) {
            const LAS float* sa_ = stg + (0 * RW_TB + s) * 64 + 4 * hi; const LAS float* sr = stg + (1 * RW_TB + s) * 64 + 4 * hi;
            const LAS float* sbk = stg + ((hi ? 3 : 2) * RW_TB + s) * 64 + r32; const LAS float* sv = stg + (4 * RW_TB + s) * 64 + r32;
            const float bk0 = sbk[0], bk1 = sbk[32], v0 = sv[0], v1 = sv[32];
            float sav[NS][2];
            {
                f32x4 av[2][4];
#pragma unroll
                for (int jb = 0; jb < 2; ++jb)
#pragma unroll
                    for (int g = 0; g < 4; ++g) av[jb][g] = *(const LAS f32x4*)(sa_ + 32 * jb + 8 * g);
#pragma unroll
                for (int st = 0; st < NS; ++st)
#pragma unroll
                    for (int ib = 0; ib < 2; ++ib) sav[st][ib] = xhalf_sum(dot32(D[st][0][ib], D[st][1][ib], av));
            }
#pragma unroll
            for (int st = 0; st < NS; ++st) {
                const bool inject = (NS == 1) || (st == 1);
#pragma unroll
                for (int jb = 0; jb < 2; ++jb) { const float bkj = jb == 0 ? bk0 : bk1; const float A = inject ? bkj : (hi ? 0.f : bkj);
#pragma unroll
                    for (int ib = 0; ib < 2; ++ib) { const float B = hi ? (ib == 0 ? v0 : v1) : sav[st][ib];
                        D[st][jb][ib] = __builtin_amdgcn_mfma_f32_32x32x2f32(A, B, D[st][jb][ib], 0, 0, 0); } }
            }
            if (OUT) {
                f32x4 rv[2][4];
#pragma unroll
                for (int jb = 0; jb < 2; ++jb)
#pragma unroll
                    for (int g = 0; g < 4; ++g) rv[jb][g] = *(const LAS f32x4*)(sr + 32 * jb + 8 * g);
#pragma unroll
                for (int ib = 0; ib < 2; ++ib) { const float y = xhalf_sum(dot32(D[NS - 1][0][ib], D[NS - 1][1][ib], rv));
                    if (hi == 0) Y[base0 + (size_t)(t0 + s) * 512 + 32 * ib + r32] = y; }
            }
        }
        LDS_WAIT(); asm volatile("" ::: "memory");
    }
#undef RWC_LOAD
    stg[5 * RW_TB * 64 + lane] = G;
    LDS_WAIT(); asm volatile("" ::: "memory");
    {
        f32x4 gv[2][4];
#pragma unroll
        for (int jb = 0; jb < 2; ++jb)
#pragma unroll
            for (int g = 0; g < 4; ++g) gv[jb][g] = *(const LAS f32x4*)(stg + 5 * RW_TB * 64 + 4 * hi + 32 * jb + 8 * g);
#pragma unroll
        for (int st = 0; st < NS; ++st)
#pragma unroll
            for (int jb = 0; jb < 2; ++jb)
#pragma unroll
                for (int ib = 0; ib < 2; ++ib)
#pragma unroll
                    for (int g = 0; g < 4; ++g) { f32x16& d = D[st][jb][ib]; d[4 * g] *= gv[jb][g].x; d[4 * g + 1] *= gv[jb][g].y; d[4 * g + 2] *= gv[jb][g].z; d[4 * g + 3] *= gv[jb][g].w; }
    }
    LDS_WAIT(); asm volatile("" ::: "memory");
}
__device__ __forceinline__ void phase_rw2(const Ctx& C) {
    const bf16* RWd = (const bf16*)(C.ws + WS_RW); const bf16* RA = (const bf16*)(C.ws + WS_RA); const bf16* RB = (const bf16*)(C.ws + WS_RB); const bf16* RKH = (const bf16*)(C.ws + WS_RKH); const bf16* RV = (const bf16*)(C.ws + WS_RV);
    float* PHI = (float*)(C.ws + WS_PHI); float* PSI = (float*)(C.ws + WS_PSI);
    LAS float* stg = (LAS float*)C.lds + C.wave * RW_STG;
    const int ntask = NB * 8 * RW_NC, r32 = C.lane & 31, hi = C.lane >> 5;
    for (int task = C.wave * C.G + C.bid; task < ntask; task += C.G * NWAVES) {
        const int ck = task % RW_NC, bh = task / RW_NC, h = bh & 7, b = bh >> 3;
        const size_t base0 = ((size_t)b * T + (size_t)ck * RW_L) * 512 + h * 64;
        f32x16 D[2][2][2];
#pragma unroll
        for (int jb = 0; jb < 2; ++jb)
#pragma unroll
            for (int ib = 0; ib < 2; ++ib)
#pragma unroll
                for (int r = 0; r < 16; ++r) { D[0][jb][ib][r] = (jb == ib && ((r & 3) + 8 * (r >> 2) + 4 * hi) == r32) ? 1.f : 0.f; D[1][jb][ib][r] = 0.f; }
        rwkv_chunk<2, false>(D, stg, RWd, RA, RB, RKH, RV, nullptr, nullptr, base0, RW_L, C.lane);
#pragma unroll
        for (int st = 0; st < 2; ++st) { float* dst = (st == 0 ? PHI : PSI) + (size_t)task * 4096;
#pragma unroll
            for (int jb = 0; jb < 2; ++jb)
#pragma unroll
                for (int ib = 0; ib < 2; ++ib)
#pragma unroll
                    for (int g = 0; g < 4; ++g) *(f32x4*)(dst + (32 * ib + r32) * 64 + 32 * jb + 8 * g + 4 * hi) = (f32x4){D[st][jb][ib][4 * g], D[st][jb][ib][4 * g + 1], D[st][jb][ib][4 * g + 2], D[st][jb][ib][4 * g + 3]}; }
    }
}
constexpr int R3_P = 65;
__device__ __forceinline__ void phase_rw3(const Ctx& C) {
    const float* PHI = (const float*)(C.ws + WS_PHI); const float* PSI = (const float*)(C.ws + WS_PSI); float* SST = (float*)(C.ws + WS_SST);
    const int half = C.wave >> 2, w4 = C.wave & 3, ibo = w4 >> 1, kb = w4 & 1, r32 = C.lane & 31, hi = C.lane >> 5;
    LAS float* Sl = (LAS float*)C.lds + half * (2 * 64 * R3_P);
    for (int pr = C.bid; pr < NB * 8 / 2; pr += C.G) {
        const int bh = 2 * pr + half;
        f32x16 acc;
#pragma unroll
        for (int r = 0; r < 16; ++r) acc[r] = 0.f;
        float ph[32], psn[16];
#define R3_LOAD(tk) do { _Pragma("unroll") for (int s = 0; s < 32; ++s) ph[s] = PHI[(tk) * 4096 + (2 * s + hi) * 64 + 32 * kb + r32]; \
        _Pragma("unroll") for (int r = 0; r < 16; ++r) psn[r] = PSI[(tk) * 4096 + (32 * ibo + (r & 3) + 8 * (r >> 2) + 4 * hi) * 64 + 32 * kb + r32]; } while (0)
        R3_LOAD((size_t)bh * RW_NC);
        for (int ck = 0; ck < RW_NC; ++ck) {
            const size_t task = (size_t)bh * RW_NC + ck; LAS float* Sb = Sl + (ck & 1) * (64 * R3_P);
            float* dst = SST + task * 4096;
#pragma unroll
            for (int r = 0; r < 16; ++r) { const int i = 32 * ibo + (r & 3) + 8 * (r >> 2) + 4 * hi; dst[i * 64 + 32 * kb + r32] = acc[r]; Sb[i * R3_P + 32 * kb + r32] = acc[r]; }
            if (ck + 1 == RW_NC) break;
            float pc[32];
#pragma unroll
            for (int s = 0; s < 32; ++s) pc[s] = ph[s];
#pragma unroll
            for (int r = 0; r < 16; ++r) acc[r] = psn[r];
            if (ck + 2 < RW_NC) R3_LOAD(task + 1);
            __syncthreads();
#pragma unroll
            for (int s = 0; s < 32; ++s) { const float a = Sb[(32 * ibo + r32) * R3_P + 2 * s + hi]; acc = __builtin_amdgcn_mfma_f32_32x32x2f32(a, pc[s], acc, 0, 0, 0); }
        }
#undef R3_LOAD
        __syncthreads();
    }
}
__device__ __forceinline__ void phase_rw4(const Ctx& C) {
    const bf16* RWd = (const bf16*)(C.ws + WS_RW); const bf16* RA = (const bf16*)(C.ws + WS_RA); const bf16* RB = (const bf16*)(C.ws + WS_RB); const bf16* RKH = (const bf16*)(C.ws + WS_RKH); const bf16* RV = (const bf16*)(C.ws + WS_RV); const bf16* RR = (const bf16*)(C.ws + WS_RR);
    const float* SST = (const float*)(C.ws + WS_SST); float* Y = (float*)(C.ws + WS_Y);
    LAS float* stg = (LAS float*)C.lds + C.wave * RW_STG;
    const int ntask = NB * 8 * RW_NC, r32 = C.lane & 31, hi = C.lane >> 5;
    for (int task = C.wave * C.G + C.bid; task < ntask; task += C.G * NWAVES) {
        const int ck = task % RW_NC, bh = task / RW_NC, h = bh & 7, b = bh >> 3;
        const size_t base0 = ((size_t)b * T + (size_t)ck * RW_L) * 512 + h * 64;
        f32x16 D[1][2][2]; const float* src = SST + (size_t)task * 4096;
#pragma unroll
        for (int jb = 0; jb < 2; ++jb)
#pragma unroll
            for (int ib = 0; ib < 2; ++ib)
#pragma unroll
                for (int g = 0; g < 4; ++g) { const f32x4 v = *(const f32x4*)(src + (32 * ib + r32) * 64 + 32 * jb + 8 * g + 4 * hi); D[0][jb][ib][4 * g] = v.x; D[0][jb][ib][4 * g + 1] = v.y; D[0][jb][ib][4 * g + 2] = v.z; D[0][jb][ib][4 * g + 3] = v.w; }
        rwkv_chunk<1, true>(D, stg, RWd, RA, RB, RKH, RV, RR, Y, base0, RW_L, C.lane);
    }
}
__device__ __forceinline__ void phase_rw5(const Ctx& C, int layer, const RwP& P) {
    LAS bf16* ACT = (LAS bf16*)C.lds;
    const bf16* CG = (const bf16*)(C.ws + WS_CG); const bf16* LG = (const bf16*)(C.ws + WS_LORA + LO_G);
    const float* Y = (const float*)(C.ws + WS_Y); const bf16* RR = (const bf16*)(C.ws + WS_RR); const bf16* RKH = (const bf16*)(C.ws + WS_RKH); const bf16* RV = (const bf16*)(C.ws + WS_RV);
    bf16* CAT = (bf16*)(C.ws + WS_CAT);
    const float* mu = P.mu + (size_t)layer * 1984 + 1728; const float* r_k = P.r_k + layer * 512; const float* lnx_g = P.lnx_g + layer * 512; const float* lnx_b = P.lnx_b + layer * 512;
    const int tid = C.tid, lane = C.lane, wid = C.wave;
    constexpr int NU = M / 32;
    u32x4 ncur[2], nprv[2];
#define RW5_LOAD(uu) do { _Pragma("unroll") for (int j = 0; j < 2; ++j) { const int ci = tid + 512 * j, tok = ci >> 5, c8 = (ci & 31) * 8; const size_t mm = (size_t)(uu) * 32 + tok; \
        ncur[j] = *(const u32x4*)(CG + mm * 256 + c8); const u32x4 z4 = {0u, 0u, 0u, 0u}; nprv[j] = (mm & (T - 1)) == 0 ? z4 : *(const u32x4*)(CG + (mm - 1) * 256 + c8); } } while (0)
#define RW5_STORE(bufi) do { _Pragma("unroll") for (int j = 0; j < 2; ++j) { const int ci = tid + 512 * j, tok = ci >> 5, c8 = (ci & 31) * 8; \
        const f32x4 m0v = *(const f32x4*)(mu + c8), m1v = *(const f32x4*)(mu + c8 + 4); \
        float xs[8]; _Pragma("unroll") for (int e = 0; e < 4; ++e) { const float c0 = bflo(ncur[j][e]), c1 = bfhi(ncur[j][e]), p0 = bflo(nprv[j][e]), p1 = bfhi(nprv[j][e]); \
            const float ma = e < 2 ? m0v[2 * e] : m1v[2 * e - 4], mb = e < 2 ? m0v[2 * e + 1] : m1v[2 * e - 3]; xs[2 * e] = sigmoidf_(c0 + (p0 - c0) * ma); xs[2 * e + 1] = sigmoidf_(c1 + (p1 - c1) * mb); } \
        u32x4 o; o.x = pk2(xs[0], xs[1]); o.y = pk2(xs[2], xs[3]); o.z = pk2(xs[4], xs[5]); o.w = pk2(xs[6], xs[7]); \
        *(LAS u32x4*)(ACT + (bufi) * (32 * RW_AG) + tok * RW_AG + c8) = o; } } while (0)
    int u = C.bid; if (u >= NU) return;
    RW5_LOAD(u); RW5_STORE(0); __syncthreads();
    for (int kbuf = 0; ; kbuf ^= 1) {
        const int un = u + C.G; const bool has_next = un < NU;
        if (has_next) RW5_LOAD(un);
        {
            int r32 = lane & 31, hi = lane >> 5; asm volatile("" : "+v"(r32), "+v"(hi));
            const size_t m0 = (size_t)u * 32; const LAS bf16* AG = ACT + kbuf * (32 * RW_AG);
            unsigned off[16];
#pragma unroll
            for (int r = 0; r < 16; ++r) off[r] = (unsigned)(tokr(r, hi) * 512 + 64 * wid + r32) * 2u;
            GAS float* Yu = opaque_g(Y + m0 * 512); GAS bf16* RRu = opaque_g(RR + m0 * 512); GAS bf16* RKHu = opaque_g(RKH + m0 * 512); GAS bf16* RVu = opaque_g(RV + m0 * 512); GAS bf16* CATu = opaque_g(CAT + m0 * 2048 + 1536);
            float yv[2][16], sy[16], sq[16], sb[16];
#pragma unroll
            for (int r = 0; r < 16; ++r) { sy[r] = 0.f; sq[r] = 0.f; sb[r] = 0.f; }
#pragma unroll
            for (int cb = 0; cb < 2; ++cb) { const int c = 64 * wid + 32 * cb + r32; const float rkc = r_k[c];
                asm volatile("" : "+v"(off[0]), "+v"(off[1]), "+v"(off[2]), "+v"(off[3]), "+v"(off[4]), "+v"(off[5]), "+v"(off[6]), "+v"(off[7]), "+v"(off[8]), "+v"(off[9]), "+v"(off[10]), "+v"(off[11]), "+v"(off[12]), "+v"(off[13]), "+v"(off[14]), "+v"(off[15]));
#pragma unroll
                for (int r = 0; r < 16; ++r) { const unsigned o = off[r]; const int ci = 32 * cb; const float y = at_b(Yu, 2u * o)[ci]; yv[cb][r] = y; sy[r] += y; sq[r] += y * y; sb[r] += bf2f(at_b(RRu, o)[ci]) * bf2f(at_b(RKHu, o)[ci]) * rkc; } }
#pragma unroll
            for (int r = 0; r < 16; ++r) { const float mean = half_sum32(sy[r]) * (1.0f / 64.0f); const float ex2 = half_sum32(sq[r]) * (1.0f / 64.0f); sb[r] = half_sum32(sb[r]);
                sy[r] = mean; sq[r] = rsqrtf(fmaxf(ex2 - mean * mean, 0.f) + 64e-5f); }
#pragma unroll
            for (int cb = 0; cb < 2; ++cb) { const int c = 64 * wid + 32 * cb + r32;
                f32x16 dg;
#pragma unroll
                for (int r = 0; r < 16; ++r) dg[r] = 0.f;
#pragma unroll
                for (int kk = 0; kk < 16; ++kk) { const bf16x8 wg = *(const bf16x8*)(LG + c * 256 + 16 * kk + 8 * hi); const bf16x8 xg = *(const LAS bf16x8*)(AG + r32 * RW_AG + 16 * kk + 8 * hi);
                    dg = __builtin_amdgcn_mfma_f32_32x32x16_bf16(xg, wg, dg, 0, 0, 0); }
                const float lgc = lnx_g[c], lbc = lnx_b[c];
#pragma unroll
                for (int r = 0; r < 16; ++r) { const unsigned o = off[r]; const int ci = 32 * cb; const float v = bf2f(at_b(RVu, o)[ci]);
                    at_b(CATu, (unsigned)(tokr(r, hi) * 2048 + 64 * wid + r32) * 2u)[ci] = (bf16)f2bf(((yv[cb][r] - sy[r]) * sq[r] * lgc + lbc + sb[r] * v) * dg[r]); }
            }
        }
        if (has_next) RW5_STORE(kbuf ^ 1);
        __syncthreads();
        if (!has_next) break;
        u = un;
    }
#undef RW5_LOAD
#undef RW5_STORE
}
__device__ __forceinline__ void* launder_ptr(const void* p) {
    unsigned lo = (unsigned)(uintptr_t)p, hi = (unsigned)((uintptr_t)p >> 32); asm volatile("" : "+v"(lo), "+v"(hi));
    lo = __builtin_amdgcn_readfirstlane(lo); hi = __builtin_amdgcn_readfirstlane(hi); return (void*)(((uintptr_t)hi << 32) | lo);
}
#ifndef MK_PER_PHASE
#define MK_PER_PHASE 0
#endif
constexpr int PH_PER_LAYER = 13, N_PHASES = DEPTH * PH_PER_LAYER + 1;
struct Args { const float* in[23]; float* out; unsigned char* ws; int ph_lo, ph_hi; };
#define FRESH() do { KA = (const CAS Args*)launder_ptr((const void*)(uintptr_t)__builtin_amdgcn_kernarg_segment_ptr()); C.ws = KA->ws; C.out = KA->out; ctl = (unsigned*)(C.ws + WS_CTL); asm volatile("" : "+v"(C.tid)); C.lane = C.tid & 63; C.wave = __builtin_amdgcn_readfirstlane(C.tid >> 6); C.lds = (LAS unsigned char*)lds_raw; } while (0)
#ifndef ATT_REP
#define ATT_REP 1
#endif
#ifndef REP_MASK
#define REP_MASK 0u
#endif
#ifndef ONLY_PH
#define ONLY_PH -1
#endif
#ifndef PH_MASK
#define PH_MASK 0xFFFFFFFFu
#endif
#define IN(k) (lo <= (k) && (k) < hi && (ONLY_PH < 0 || ((k) % PH_PER_LAYER) == ONLY_PH) && ((PH_MASK >> ((k) % PH_PER_LAYER)) & 1u))
#define SEAM(k) do { if (IN(k) && IN((k) + 1)) { bar.bar = ctl + CW_BAR; xcd_barrier(bar); } } while (0)
#define PH_BODY(k, ...) do { FRESH(); if (IN(p0 + (k))) { __VA_ARGS__; if ((REP_MASK >> (k)) & 1u) { xcd_barrier(bar); FRESH(); __VA_ARGS__; } } SEAM(p0 + (k)); } while (0)
template <int layer>
__device__ __forceinline__ void layer_phases(Ctx& C, const CAS Args*& KA, XcdBarrier& bar, unsigned*& ctl, unsigned char* lds_raw, const int lo, const int hi) {
    const int p0 = layer * PH_PER_LAYER;
    PH_BODY(0, { const WSrc W{KA->in[2], KA->in[3], KA->in[18], KA->in[20], KA->in[21], KA->in[7], KA->in[9], KA->in[12], KA->in[11]}; phase_wconv(C, layer, W);
                 if (layer == 0) phase_xg(C, KA->in[0], KA->in[1], (bf16*)(C.ws + WS_H), (float*)(C.ws + WS_SS1)); });
    PH_BODY(1, { pg8::Gemm g{(const pg8::bf16_t*)(C.ws + WS_H), (const pg8::bf16_t*)(C.ws + WS_WIN), M, N_INP, DM}; pg8::StaticOrder S; S.init(M, N_INP, C.G, C.bid);
                 pg8::EpiProj E{C.ws, (const float*)(C.ws + WS_SS1)}; pg8::gemm_phase<pg8::EpiProj, pg8::StaticOrder, true, true>(C.lds, g, S, E); });
    FRESH(); if (IN(p0 + 2)) phase_prep_a(C); SEAM(p0 + 2);
    PH_BODY(3, { phase_indexer(C); __syncthreads(); phase_ret1(C); });
    FRESH(); if (IN(p0 + 4)) { for (int rep_a = 0; rep_a < ATT_REP; ++rep_a) { phase_attn(C); __syncthreads(); } phase_ret2(C); } SEAM(p0 + 4);
    PH_BODY(5, { const RwP P{KA->in[4], KA->in[5], KA->in[6], KA->in[8], KA->in[10], KA->in[13], KA->in[14], KA->in[15], KA->in[16], KA->in[17]}; phase_rw1(C, layer, P); });
    PH_BODY(6, { phase_rw2(C); });
    PH_BODY(7, { if (C.G > 32) { if (C.bid < 16) phase_rw3(C); else { Ctx C2 = C; C2.bid = C.bid - 16; C2.G = C.G - 16; phase_ret3(C2); } } else { phase_rw3(C); __syncthreads(); phase_ret3(C); } });
    PH_BODY(8, { phase_rw4(C); });
    PH_BODY(9, { const RwP P{KA->in[4], KA->in[5], KA->in[6], KA->in[8], KA->in[10], KA->in[13], KA->in[14], KA->in[15], KA->in[16], KA->in[17]}; phase_rw5(C, layer, P); });
    FRESH(); if (IN(p0 + 10)) { const float* xin = layer == 0 ? KA->in[0] : C.out;
        pg8::Gemm g{(const pg8::bf16_t*)(C.ws + WS_CAT), (const pg8::bf16_t*)(C.ws + WS_WOUT), M, DM, DM}; pg8::StaticOrder S; S.init(M, DM, C.G, C.bid);
        pg8::EpiResid E{xin, C.out, DM, KA->in[19] + layer * DM, (pg8::bf16_t*)(C.ws + WS_H2), (float*)(C.ws + WS_SS2)}; pg8::gemm_phase<pg8::EpiResid, pg8::StaticOrder, true, true>(C.lds, g, S, E); }
    SEAM(p0 + 10);
    PH_BODY(11, { pg8::Gemm g{(const pg8::bf16_t*)(C.ws + WS_H2), (const pg8::bf16_t*)(C.ws + WS_WGU), M, 2 * DFF, DM}; pg8::StaticOrder S; S.init(M, 2 * DFF, C.G, C.bid);
                  pg8::EpiSwiGLU E{(pg8::bf16_t*)(C.ws + WS_ACT), DFF, (const float*)(C.ws + WS_SS2)}; pg8::gemm_phase<pg8::EpiSwiGLU, pg8::StaticOrder, true, true>(C.lds, g, S, E); });
    FRESH(); if (IN(p0 + 12)) { pg8::Gemm g{(const pg8::bf16_t*)(C.ws + WS_ACT), (const pg8::bf16_t*)(C.ws + WS_WDN), M, DM, DFF}; pg8::StaticOrder S; S.init(M, DM, C.G, C.bid);
        pg8::EpiResid E{C.out, C.out, DM, layer + 1 < DEPTH ? KA->in[1] + (layer + 1) * DM : KA->in[22], layer + 1 < DEPTH ? (pg8::bf16_t*)(C.ws + WS_H) : nullptr, (float*)(C.ws + WS_SS1)};
        pg8::gemm_phase<pg8::EpiResid, pg8::StaticOrder, true, true>(C.lds, g, S, E); }
    SEAM(p0 + 12);
}
__global__ void __launch_bounds__(NTHR, 2) fwd_kernel(Args args) {
    extern __shared__ __attribute__((aligned(16))) unsigned char lds_raw[];
    Ctx C;
    C.lds = (LAS unsigned char*)lds_raw; C.tid = threadIdx.x; C.lane = C.tid & 63; C.wave = __builtin_amdgcn_readfirstlane(C.tid >> 6);
    C.G = gridDim.x; C.bid = blockIdx.x;
    const CAS Args* KA = (const CAS Args*)launder_ptr((const void*)(uintptr_t)__builtin_amdgcn_kernarg_segment_ptr());
    C.ws = KA->ws; C.out = KA->out;
    volatile LAS unsigned* MISC = (volatile LAS unsigned*)(C.lds + MISC_OFF);
    if (C.tid < 32) MISC[C.tid] = 0u;
    __syncthreads();
    unsigned* ctl = (unsigned*)(C.ws + WS_CTL);
    XcdBarrier bar; bar.bar = ctl + CW_BAR; bar.x = 0; bar.st = nullptr;
    if (!MK_PER_PHASE) bar = xcd_barrier_post(ctl + CW_BAR, MISC + 8);
    const int lo = KA->ph_lo, hi = KA->ph_hi;
    layer_phases<0>(C, KA, bar, ctl, lds_raw, lo, hi);
    layer_phases<1>(C, KA, bar, ctl, lds_raw, lo, hi);
    FRESH(); if (IN(N_PHASES - 1)) phase_final_norm(C, C.out, KA->in[22], (const float*)(C.ws + WS_SS1));
#undef IN
#undef SEAM
}

extern "C" void kernel_launch(void* const* d_in, const int* in_sizes, int n_in, void* d_out, int out_size, void* d_ws, size_t ws_size, hipStream_t stream) {
    static int grid = 0;
    if (grid == 0) {
        if (n_in != 23 || out_size != M * DM || ws_size < WS_NEED) { fprintf(stderr, "kernel_launch: unexpected problem (n_in %d, out %d, ws %zu); nothing launched\n", n_in, out_size, ws_size); grid = -1; return; }
        int dev = 0, cus = 0, per_cu = 0;
        if (hipGetDevice(&dev) != hipSuccess || hipDeviceGetAttribute(&cus, hipDeviceAttributeMultiprocessorCount, dev) != hipSuccess) { grid = -1; return; }
        if (hipFuncSetAttribute((const void*)fwd_kernel, hipFuncAttributeMaxDynamicSharedMemorySize, LDS_BYTES) != hipSuccess) { fprintf(stderr, "kernel_launch: hipFuncSetAttribute failed\n"); grid = -1; return; }
        if (hipOccupancyMaxActiveBlocksPerMultiprocessor(&per_cu, (const void*)fwd_kernel, NTHR, LDS_BYTES) != hipSuccess || per_cu < 1) { fprintf(stderr, "kernel_launch: occupancy query says %d blocks per CU\n", per_cu); }
        (void)hipGetLastError();
        grid = cus;
    }
    if (grid < 0) return;
    (void)hipMemsetAsync((char*)d_ws + WS_CTL, 0, CTL_ZERO_BYTES, stream);
    Args a{};
    for (int i = 0; i < 23; ++i) a.in[i] = (const float*)d_in[i];
    a.out = (float*)d_out; a.ws = (unsigned char*)d_ws;
#if MK_PER_PHASE
    for (int p = 0; p < N_PHASES; ++p) { a.ph_lo = p; a.ph_hi = p + 1; hipLaunchKernelGGL(fwd_kernel, dim3(grid), dim3(NTHR), LDS_BYTES, stream, a); }
#else
    a.ph_lo = 0; a.ph_hi = N_PHASES;
    hipLaunchKernelGGL(fwd_kernel, dim3(grid), dim3(NTHR), LDS_BYTES, stream, a);
#endif
    const hipError_t le = hipPeekAtLastError();
    if (le != hipSuccess) fprintf(stderr, "kernel_launch: launch failed: %s\n", hipGetErrorName(le));
}
```

```cpp
#include <hip/hip_runtime.h>
#include <hip/hip_fp16.h>
#include <cstdio>
#include <cstdint>
namespace pg8 {
#define PG8_LAS __attribute__((address_space(3)))
typedef unsigned short bf16_t;
typedef short bf16x8 __attribute__((ext_vector_type(8)));
typedef float f32x4 __attribute__((ext_vector_type(4)));
typedef unsigned u32x4 __attribute__((ext_vector_type(4)));
constexpr int BM = 256, BK = 64, HALF = 128, HTB = HALF * BK * 2  , STAGE_BYTES = 8 * HTB, NXCD = 8, WGM = 8;

__host__ __device__ __forceinline__ int lds_byte(int r, int c) { const int st = (r >> 4) * 2 + (c >> 5), rr = r & 15, cc = c & 31, ob = rr * 64 + cc * 2; return st * 1024 + (ob ^ (((ob >> 9) & 1) << 5)); }
__host__ __device__ __forceinline__ void stage_rc(int b, int& R, int& C) { const int st = b / 1024, sb = b % 1024, swz = sb ^ (((sb >> 9) & 1) << 5); R = (st >> 1) * 16 + swz / 64; C = (st & 1) * 32 + (swz % 64) / 2; }
__host__ __device__ __forceinline__ int perm32(int rho) { const int n = rho >> 4, i = rho & 15; return 8 * (i >> 2) + 4 * n + (i & 3); }

struct Unit { int pm, pn; };
struct Gemm { const bf16_t* A; const bf16_t* Bt; int M, N, K; };

struct StaticOrder {
    int nM, nN, nwg, G, c;
    __host__ __device__ void init(int M, int N, int G_, int c_) { nM = M / BM; nN = N / BM; nwg = nM * nN; G = G_; c = c_; }
    __host__ __device__ bool next(int i, Unit& u) const {
        const long L = (long)i * G + c; if (L >= nwg) return false;
        int wgid = (int)L; { const int q = nwg / NXCD, r = nwg % NXCD, xcd = wgid % NXCD, off = wgid / NXCD; wgid = (xcd < r ? xcd * (q + 1) : r * (q + 1) + (xcd - r) * q) + off; }
        const int nig = WGM * nN, gid = wgid / nig, fm = gid * WGM, gsz = (nM - fm) < WGM ? (nM - fm) : WGM;
        u.pm = fm + ((wgid % nig) % gsz); u.pn = (wgid % nig) / gsz; return true;
    }
    __device__ __forceinline__ void a_ready(const Unit&) const {}
    __device__ __forceinline__ void done(const Unit&) const {}
};

__device__ __forceinline__ unsigned cvt_pk_bf16(float lo, float hi) { unsigned r; asm volatile("v_cvt_pk_bf16_f32 %0, %1, %2" : "=v"(r) : "v"(lo), "v"(hi)); return r; }
typedef float f32x2 __attribute__((ext_vector_type(2)));
__device__ __forceinline__ f32x2 gelu_pk(f32x2 v) {
    const f32x2 av = __builtin_elementwise_abs(v), d = av * 0.2316418882f + 1.0f;
    f32x2 t; t.x = __builtin_amdgcn_rcpf(d.x); t.y = __builtin_amdgcn_rcpf(d.y);
    f32x2 q = t * 0.5307027145f + (-0.7265760135f); q = q * t + 0.7107068705f; q = q * t + (-0.142248368f); q = q * t + 0.127414796f; q = q * t;
    const f32x2 s = (v * v) * (-0.72134752044f);
    f32x2 e; e.x = __builtin_amdgcn_exp2f(s.x); e.y = __builtin_amdgcn_exp2f(s.y);
    const f32x2 m = v * (q * e), r = v - m;
    f32x2 o; o.x = v.x < 0.f ? m.x : r.x; o.y = v.y < 0.f ? m.y : r.y; return o;
}

template <int ACT  > struct EpiBf16 {
    static constexpr bool PERM = true, AFTER_DRAIN = false; static_assert(ACT == 0 || ACT == 1, "EpiBf16: ACT is 0 (none) or 1 (gelu_pk)");
    bf16_t* O; int ldc; const float* bias; int split_cols; size_t split_stride; float scale0;
    __device__ __forceinline__ void operator()(const f32x4 (&acc)[2][2][4][2], const Unit& u, int wr, int wc, int fr, int fq) const {
        const int row0 = u.pm * BM + wr * 64 + fr; int colt = u.pn * BM; bf16_t* base = O;
        float sc = 1.f; if (split_cols) { const int t = colt / split_cols; base += (size_t)t * split_stride; colt -= t * split_cols; if (t == 0) sc = scale0; }
        const int col0 = colt + wc * 32 + 8 * fq, bcol0 = u.pn * BM + wc * 32 + 8 * fq;
        f32x4 bv[2][2];
#pragma unroll
        for (int bj = 0; bj < 2; ++bj)
#pragma unroll
            for (int n = 0; n < 2; ++n) bv[bj][n] = bias ? *(const f32x4*)(bias + bcol0 + bj * HALF + 4 * n) : (f32x4){0.f, 0.f, 0.f, 0.f};
#pragma unroll
        for (int ai = 0; ai < 2; ++ai)
#pragma unroll
            for (int m = 0; m < 4; ++m) { bf16_t* rowp = base + (size_t)(row0 + ai * HALF + m * 16) * ldc + col0;
#pragma unroll
                for (int bj = 0; bj < 2; ++bj) { f32x4 v0 = acc[ai][bj][m][0] + bv[bj][0], v1 = acc[ai][bj][m][1] + bv[bj][1];
                    if (ACT == 1) { f32x2 a = gelu_pk((f32x2){v0[0], v0[1]}), b = gelu_pk((f32x2){v0[2], v0[3]}), c = gelu_pk((f32x2){v1[0], v1[1]}), d = gelu_pk((f32x2){v1[2], v1[3]});
                        v0 = (f32x4){a.x, a.y, b.x, b.y}; v1 = (f32x4){c.x, c.y, d.x, d.y}; }
                    v0 = v0 * sc; v1 = v1 * sc; u32x4 w; w.x = cvt_pk_bf16(v0[0], v0[1]); w.y = cvt_pk_bf16(v0[2], v0[3]); w.z = cvt_pk_bf16(v1[0], v1[1]); w.w = cvt_pk_bf16(v1[2], v1[3]);
                    *(u32x4*)(rowp + bj * HALF) = w; } }
    }
};

__device__ __forceinline__ void tile_dest(int pn, size_t& off, int& ld, int& colt);
__device__ __forceinline__ float row_rstd(const float* ss, int row) { return rsqrtf(ss[row] * (1.0f / 2048.0f) + 1e-5f); }
struct EpiProj {
    static constexpr bool PERM = true, AFTER_DRAIN = false;
    unsigned char* ws; const float* ss;
    __device__ __forceinline__ void operator()(const f32x4 (&acc)[2][2][4][2], const Unit& u, int wr, int wc, int fr, int fq) const {
        size_t off; int ld, colt; tile_dest(u.pn, off, ld, colt);
        bf16_t* base = (bf16_t*)(ws + off);
        const int row0 = u.pm * BM + wr * 64 + fr, col0 = colt + wc * 32 + 8 * fq;
        const float sc = u.pn < 4 ? 0.12751743074602467f : 1.0f;
#pragma unroll
        for (int ai = 0; ai < 2; ++ai)
#pragma unroll
            for (int m = 0; m < 4; ++m) { const int row = row0 + ai * HALF + m * 16; bf16_t* rowp = base + (size_t)row * ld + col0; const float rs = row_rstd(ss, row) * sc;
#pragma unroll
                for (int bj = 0; bj < 2; ++bj) { const f32x4 v0 = acc[ai][bj][m][0] * rs, v1 = acc[ai][bj][m][1] * rs;
                    u32x4 w; w.x = cvt_pk_bf16(v0[0], v0[1]); w.y = cvt_pk_bf16(v0[2], v0[3]); w.z = cvt_pk_bf16(v1[0], v1[1]); w.w = cvt_pk_bf16(v1[2], v1[3]);
                    *(u32x4*)(rowp + bj * HALF) = w; } }
    }
};
struct EpiResid {
    static constexpr bool PERM = false, AFTER_DRAIN = false;
    const float* base; float* out; int ldc; const float* g; bf16_t* xg; float* ss;
    __device__ __forceinline__ void operator()(const f32x4 (&acc)[2][2][4][2], const Unit& u, int wr, int wc, int fr, int fq) const {
        const int row0 = u.pm * BM + wr * 64 + fr, col0 = u.pn * BM + wc * 32 + 4 * fq;
        f32x4 gv[2][2];
#pragma unroll
        for (int bj = 0; bj < 2; ++bj)
#pragma unroll
            for (int n = 0; n < 2; ++n) gv[bj][n] = *(const f32x4*)(g + col0 + bj * HALF + n * 16);
#pragma unroll
        for (int ai = 0; ai < 2; ++ai)
#pragma unroll
            for (int m = 0; m < 4; ++m) { const int row = row0 + ai * HALF + m * 16; const size_t off = (size_t)row * ldc + col0; float sq = 0.f;
#pragma unroll
                for (int bj = 0; bj < 2; ++bj)
#pragma unroll
                    for (int n = 0; n < 2; ++n) { const size_t p = off + bj * HALF + n * 16; const f32x4 x = *(const f32x4*)(base + p) + acc[ai][bj][m][n]; *(f32x4*)(out + p) = x;
                        sq += (x[0] * x[0] + x[1] * x[1]) + (x[2] * x[2] + x[3] * x[3]);
                        if (xg) { const f32x4 y = x * gv[bj][n]; typedef unsigned u32x2_t __attribute__((ext_vector_type(2))); u32x2_t w; w.x = cvt_pk_bf16(y[0], y[1]); w.y = cvt_pk_bf16(y[2], y[3]); *(u32x2_t*)(xg + p) = w; } }
                sq += __shfl_xor(sq, 16); sq += __shfl_xor(sq, 32);
                if (fq == 0) unsafeAtomicAdd(ss + row, sq); }
    }
};
struct EpiSwiGLU {
    static constexpr bool PERM = true, AFTER_DRAIN = false;
    bf16_t* O; int ldc; const float* ss;
    __device__ __forceinline__ static float silu_mul(float g, float u) { return g * u * __builtin_amdgcn_rcpf(1.0f + __expf(-g)); }
    __device__ __forceinline__ void operator()(const f32x4 (&acc)[2][2][4][2], const Unit& u, int wr, int wc, int fr, int fq) const {
        const int row0 = u.pm * BM + wr * 64 + fr, col0 = u.pn * HALF + wc * 32 + 8 * fq;
#pragma unroll
        for (int ai = 0; ai < 2; ++ai)
#pragma unroll
            for (int m = 0; m < 4; ++m) { const int row = row0 + ai * HALF + m * 16; bf16_t* rowp = O + (size_t)row * ldc + col0; const float rs = row_rstd(ss, row);
                const f32x4 g0 = acc[ai][0][m][0] * rs, g1 = acc[ai][0][m][1] * rs, u0 = acc[ai][1][m][0] * rs, u1 = acc[ai][1][m][1] * rs;
                u32x4 w; w.x = cvt_pk_bf16(silu_mul(g0[0], u0[0]), silu_mul(g0[1], u0[1])); w.y = cvt_pk_bf16(silu_mul(g0[2], u0[2]), silu_mul(g0[3], u0[3]));
                w.z = cvt_pk_bf16(silu_mul(g1[0], u1[0]), silu_mul(g1[1], u1[1])); w.w = cvt_pk_bf16(silu_mul(g1[2], u1[2]), silu_mul(g1[3], u1[3]));
                *(u32x4*)rowp = w; }
    }
};
template <class Epi, class Sched, bool ALIGN_EPI = false, bool SP2 = false>
__device__ __forceinline__ void gemm_phase(PG8_LAS unsigned char* lds, const Gemm g, const Sched& S, const Epi& E) {
    int tid_ = threadIdx.x; asm volatile("" : "+v"(tid_));
    const int tid = tid_, wid = __builtin_amdgcn_readfirstlane(tid >> 6), lane = tid & 63, wr = wid >> 2, wc = wid & 3, fr = lane & 15, fq = lane >> 4;
    const int K = g.K, nt = K / BK;
    unsigned voffA[2], voffB[2];
#pragma unroll
    for (int i = 0; i < 2; ++i) { int R, C; stage_rc(tid * 16 + i * 8192, R, C); const int Rb = Epi::PERM ? ((R & ~31) + perm32(R & 31)) : R;
        voffA[i] = (unsigned)(R * K + C) * 2u; voffB[i] = (unsigned)(Rb * K + C) * 2u; }
    const size_t kstep = (size_t)(BK * 2);
    const size_t hstep = (size_t)HALF * K * 2;
    const size_t tstep = 2 * hstep;
    const unsigned ldsw = (unsigned)wid * 1024u;
    const int aoff = lds_byte(wr * 64 + fr, fq * 8), boff = lds_byte(wc * 32 + fr, fq * 8);
#define PG8_SA(b, h) (((b) * 2 + (h)) * HTB)
#define PG8_SB(b, h) ((4 + (b) * 2 + (h)) * HTB)
#define PG8_STAGE(bufoff, gbase, voff) do { _Pragma("unroll") for (int _i = 0; _i < 2; ++_i) \
        __builtin_amdgcn_global_load_lds((const unsigned*)((const char*)(gbase) + (voff)[_i]), (PG8_LAS unsigned*)(lds + (bufoff) + ldsw + _i * 8192), 16, 0, 0); } while (0)
#define PG8_LDA(dst, b, h) do { _Pragma("unroll") for (int m = 0; m < 4; ++m) _Pragma("unroll") for (int k = 0; k < 2; ++k) dst[m][k] = *(const PG8_LAS bf16x8*)(lds + PG8_SA(b, h) + aoff + m * 2048 + k * 1024); } while (0)
#define PG8_LDB(dst, b, h) do { _Pragma("unroll") for (int n = 0; n < 2; ++n) _Pragma("unroll") for (int k = 0; k < 2; ++k) dst[n][k] = *(const PG8_LAS bf16x8*)(lds + PG8_SB(b, h) + boff + n * 2048 + k * 1024); } while (0)
#define PG8_MMA(ai, bj, At, Bt) do { __builtin_amdgcn_s_setprio(1); _Pragma("unroll") for (int m = 0; m < 4; ++m) _Pragma("unroll") for (int n = 0; n < 2; ++n) _Pragma("unroll") for (int k = 0; k < 2; ++k) \
        acc[ai][bj][m][n] = __builtin_amdgcn_mfma_f32_16x16x32_bf16(Bt[n][k], At[m][k], acc[ai][bj][m][n], 0, 0, 0); __builtin_amdgcn_s_setprio(0); } while (0)
#define PG8_WAIT_V(n) asm volatile("s_waitcnt vmcnt(" #n ")" ::: "memory")
#define PG8_WAIT_L(n) asm volatile("s_waitcnt lgkmcnt(" #n ")" ::: "memory")
#define PG8_BAR __builtin_amdgcn_s_barrier()
#define PG8_SCHED __builtin_amdgcn_sched_barrier(0)
    Unit cur, nxt; int ui = 0;
    if (!S.next(0, cur)) return;
    f32x4 acc[2][2][4][2];
#pragma unroll
    for (int a = 0; a < 2; ++a)
#pragma unroll
        for (int b = 0; b < 2; ++b)
#pragma unroll
            for (int m = 0; m < 4; ++m)
#pragma unroll
                for (int n = 0; n < 2; ++n) acc[a][b][m][n] = (f32x4){0.f, 0.f, 0.f, 0.f};
    bf16x8 At[4][2], B0[2][2], B1[2][2];
    const char* cA = (const char*)g.A + (size_t)cur.pm * tstep; const char* cB = (const char*)g.Bt + (size_t)cur.pn * tstep;
    S.a_ready(cur);
    if constexpr (SP2) {
        PG8_STAGE(PG8_SB(0, 0), cB, voffB); PG8_STAGE(PG8_SB(0, 1), cB + hstep, voffB); PG8_STAGE(PG8_SA(0, 0), cA, voffA); PG8_STAGE(PG8_SA(0, 1), cA + hstep, voffA);
        if (wr == 1) PG8_BAR;
        PG8_WAIT_V(2); PG8_BAR;
        PG8_STAGE(PG8_SB(1, 0), cB + kstep, voffB); PG8_STAGE(PG8_SA(1, 0), cA + kstep, voffA); PG8_STAGE(PG8_SB(1, 1), cB + hstep + kstep, voffB);
        PG8_WAIT_V(6); PG8_BAR;
    } else {
        PG8_STAGE(PG8_SB(0, 0), cB, voffB); PG8_STAGE(PG8_SA(0, 0), cA, voffA); PG8_STAGE(PG8_SB(0, 1), cB + hstep, voffB); PG8_STAGE(PG8_SA(0, 1), cA + hstep, voffA);
        if (wr == 1) PG8_BAR;
        PG8_WAIT_V(4); PG8_BAR;
        PG8_STAGE(PG8_SB(1, 0), cB + kstep, voffB); PG8_STAGE(PG8_SA(1, 0), cA + kstep, voffA); PG8_STAGE(PG8_SB(1, 1), cB + hstep + kstep, voffB);
        PG8_WAIT_V(6); PG8_BAR;
    }
    for (;;) {
        const bool has_next = S.next(ui + 1, nxt);
        const char* nA = has_next ? (const char*)g.A + (size_t)nxt.pm * tstep : cA; const char* nB = has_next ? (const char*)g.Bt + (size_t)nxt.pn * tstep : cB;
        for (int t = 0; t < nt; t += 2) {
            const bool last = (t == nt - 2);
            const char* a1 = cA + (size_t)(t + 1) * kstep;
            const char* a2 = last ? nA : cA + (size_t)(t + 2) * kstep; const char* b2 = last ? nB : cB + (size_t)(t + 2) * kstep;
            const char* a3 = a2 + kstep; const char* b3 = b2 + kstep;
            if (last && has_next) S.a_ready(nxt);
            if constexpr (SP2) {
            PG8_LDB(B0, 0, 0); PG8_LDB(B1, 0, 1); PG8_SCHED; PG8_LDA(At, 0, 0); PG8_STAGE(PG8_SA(1, 1), a1 + hstep, voffA);
            PG8_WAIT_V(8); PG8_WAIT_L(0); PG8_BAR; PG8_MMA(0, 0, At, B0); PG8_MMA(0, 1, At, B1); PG8_BAR; PG8_SCHED;
            PG8_LDA(At, 0, 1); PG8_STAGE(PG8_SB(0, 0), b2, voffB); PG8_STAGE(PG8_SB(0, 1), b2 + hstep, voffB); PG8_STAGE(PG8_SA(0, 0), a2, voffA);
            PG8_WAIT_V(8); PG8_WAIT_L(0); PG8_BAR; PG8_MMA(1, 0, At, B0); PG8_MMA(1, 1, At, B1); PG8_BAR; PG8_SCHED;
            PG8_LDB(B0, 1, 0); PG8_LDB(B1, 1, 1); PG8_SCHED; PG8_LDA(At, 1, 0); PG8_STAGE(PG8_SA(0, 1), a2 + hstep, voffA);
            PG8_WAIT_V(8); PG8_WAIT_L(0); PG8_BAR; PG8_MMA(0, 0, At, B0); PG8_MMA(0, 1, At, B1); PG8_BAR; PG8_SCHED;
            PG8_LDA(At, 1, 1); PG8_STAGE(PG8_SB(1, 0), b3, voffB); PG8_STAGE(PG8_SB(1, 1), b3 + hstep, voffB); PG8_STAGE(PG8_SA(1, 0), a3, voffA);
            PG8_WAIT_V(8); PG8_WAIT_L(0); PG8_BAR; PG8_MMA(1, 0, At, B0); PG8_MMA(1, 1, At, B1); PG8_BAR; PG8_SCHED;
            } else {
            PG8_LDB(B0, 0, 0); PG8_SCHED; PG8_LDA(At, 0, 0); PG8_STAGE(PG8_SA(1, 1), a1 + hstep, voffA);
            PG8_WAIT_L(8); PG8_BAR; PG8_WAIT_L(0); PG8_MMA(0, 0, At, B0); PG8_BAR; PG8_SCHED;
            PG8_LDB(B1, 0, 1); PG8_STAGE(PG8_SB(0, 0), b2, voffB);
            PG8_BAR; PG8_WAIT_L(0); PG8_MMA(0, 1, At, B1); PG8_BAR;
            PG8_LDA(At, 0, 1); PG8_STAGE(PG8_SA(0, 0), a2, voffA);
            PG8_BAR; PG8_WAIT_L(0); PG8_MMA(1, 0, At, B0); PG8_BAR; PG8_SCHED;
            PG8_STAGE(PG8_SB(0, 1), b2 + hstep, voffB);
            PG8_WAIT_V(6); PG8_BAR; PG8_MMA(1, 1, At, B1); PG8_BAR;
            PG8_LDB(B0, 1, 0); PG8_SCHED; PG8_LDA(At, 1, 0); PG8_STAGE(PG8_SA(0, 1), a2 + hstep, voffA);
            PG8_WAIT_L(8); PG8_BAR; PG8_WAIT_L(0); PG8_MMA(0, 0, At, B0); PG8_BAR; PG8_SCHED;
            PG8_LDB(B1, 1, 1); PG8_STAGE(PG8_SB(1, 0), b3, voffB);
            PG8_BAR; PG8_WAIT_L(0); PG8_MMA(0, 1, At, B1); PG8_BAR;
            PG8_LDA(At, 1, 1); PG8_STAGE(PG8_SA(1, 0), a3, voffA);
            PG8_BAR; PG8_WAIT_L(0); PG8_MMA(1, 0, At, B0); PG8_BAR; PG8_SCHED;
            PG8_STAGE(PG8_SB(1, 1), b3 + hstep, voffB);
            PG8_WAIT_V(6); PG8_BAR; PG8_MMA(1, 1, At, B1); PG8_BAR;
            }
        }
        if constexpr (ALIGN_EPI) { if (wr == 0) PG8_BAR; }
        if constexpr (!Epi::AFTER_DRAIN) { E(acc, cur, wr, wc, fr, fq); S.done(cur); }
        if (!has_next) break;
#pragma unroll
        for (int a = 0; a < 2; ++a)
#pragma unroll
            for (int b = 0; b < 2; ++b)
#pragma unroll
                for (int m = 0; m < 4; ++m)
#pragma unroll
                    for (int n = 0; n < 2; ++n) acc[a][b][m][n] = (f32x4){0.f, 0.f, 0.f, 0.f};
        cur = nxt; cA = nA; cB = nB; ++ui;
        if constexpr (ALIGN_EPI) { if (wr == 1) PG8_BAR; }
    }
    PG8_WAIT_V(0);
    if constexpr (!ALIGN_EPI) { if (wr == 0) PG8_BAR; }
    PG8_BAR;
    if constexpr (Epi::AFTER_DRAIN) { E.fused(acc, cur, wr, wc, fr, fq, lds, wid, lane); S.done(cur); }
#undef PG8_SA
#undef PG8_SB
#undef PG8_STAGE
#undef PG8_LDA
#undef PG8_LDB
#undef PG8_MMA
#undef PG8_WAIT_V
#undef PG8_WAIT_L
#undef PG8_BAR
#undef PG8_SCHED
}
}
constexpr int NB = 4, T = 8192, M = NB * T, DM = 2048, DFF = 5632, DEPTH = 2;
constexpr int N_IN = 7696, N_INP = 7936;
constexpr int NWAVES = 8, NTHR = NWAVES * 64;
#define LAS __attribute__((address_space(3)))
#define GAS __attribute__((address_space(1)))
#define CAS __attribute__((address_space(4)))
typedef unsigned short bf16;
typedef short bf16x8 __attribute__((ext_vector_type(8)));
typedef float f32x4 __attribute__((ext_vector_type(4)));
typedef float f32x16 __attribute__((ext_vector_type(16)));
typedef unsigned u32x4 __attribute__((ext_vector_type(4)));
typedef unsigned u32x2 __attribute__((ext_vector_type(2)));
typedef unsigned long long u64;

constexpr size_t MiB = 1u << 20;
constexpr size_t WS_CTL = 0, CTL_ZERO_BYTES = 1 * MiB;
constexpr size_t WS_WIN = 1 * MiB, WS_WOUT = 32 * MiB, WS_WGU = 40 * MiB, WS_WDN = 84 * MiB;
constexpr size_t WS_LORA = 106 * MiB;
constexpr size_t LO_W = 0, LO_A = 512 * 96 * 2, LO_V = 2 * 512 * 96 * 2, LO_G = LO_V + 512 * 64 * 2;
constexpr size_t WS_VFIRST = 107 * MiB;
constexpr size_t WS_H = 139 * MiB;
constexpr size_t WS_VT = 139 * MiB, WS_MASK = 203 * MiB;
constexpr size_t WS_Q = 267 * MiB, WS_K = 331 * MiB, WS_QI = 395 * MiB, WS_V = 459 * MiB, WS_KW = 523 * MiB, WS_BQ = 539 * MiB, WS_BK = 555 * MiB, WS_BV = 571 * MiB, WS_BG = 603 * MiB;
constexpr size_t WS_CR = 635 * MiB, WS_CK = 667 * MiB, WS_CV = 699 * MiB, WS_CL = 731 * MiB, WS_CG = 747 * MiB;
constexpr size_t WS_CAT = 763 * MiB;
constexpr size_t WS_KVST = 891 * MiB;
constexpr size_t WS_TAB = 955 * MiB;
constexpr size_t WS_SS1 = 959 * MiB, WS_SS2 = 959 * MiB + 256 * 1024;
constexpr size_t TAB_A = 0, TAB_I = (size_t)T * 16 * 8, TAB_R = TAB_I + (size_t)T * 8 * 8, TAB_END = TAB_R + (size_t)T * 32 * 8;
constexpr size_t WS_RR = 139 * MiB, WS_RW = 171 * MiB, WS_RKH = 203 * MiB, WS_RV = 235 * MiB, WS_RA = 267 * MiB, WS_RB = 299 * MiB;
constexpr size_t WS_PHI = 331 * MiB, WS_PSI = 363 * MiB, WS_SST = 395 * MiB, WS_Y = 635 * MiB;
constexpr size_t WS_H2 = 139 * MiB, WS_ACT = 267 * MiB;
constexpr size_t WS_NEED = 1024 * MiB;
static_assert(WS_TAB + TAB_END <= WS_NEED && WS_ACT + (size_t)M * DFF * 2 <= WS_CR && WS_SST + 32 * MiB <= WS_V && WS_RB + 32 * MiB <= WS_PHI && WS_Y + (size_t)M * 512 * 4 <= WS_CV, "ws map");

constexpr int LDS_BYTES = 147456, MISC_OFF = 143360;
constexpr int CW_BAR = 4096;

__device__ __forceinline__ unsigned f2bf(float f) { unsigned u = __builtin_bit_cast(unsigned, f); return (u + 0x7fffu + ((u >> 16) & 1u)) >> 16; }
__device__ __forceinline__ unsigned pk2(float lo, float hi) { return f2bf(lo) | (f2bf(hi) << 16); }
__device__ __forceinline__ float bf2f(unsigned short b) { return __builtin_bit_cast(float, (unsigned)b << 16); }
__device__ __forceinline__ float bflo(unsigned w) { return __builtin_bit_cast(float, w << 16); }
__device__ __forceinline__ float bfhi(unsigned w) { return __builtin_bit_cast(float, w & 0xffff0000u); }
__device__ __forceinline__ float wave_sum(float v) {
#pragma unroll
    for (int o = 1; o < 64; o <<= 1) v += __shfl_xor(v, o);
    return v;
}
#define LDS_WAIT() asm volatile("s_waitcnt lgkmcnt(0)" ::: "memory")
typedef float f32x2 __attribute__((ext_vector_type(2)));
template <class TT> __device__ __forceinline__ GAS TT* at_b(GAS TT* ub, unsigned boff) { return (GAS TT*)((GAS char*)ub + boff); }
__device__ __forceinline__ float half_sum32(float v) { v += __shfl_xor(v, 1); v += __shfl_xor(v, 2); v += __shfl_xor(v, 4); v += __shfl_xor(v, 8); v += __shfl_xor(v, 16); return v; }


namespace pg8 {
__device__ __forceinline__ void tile_dest(int pn, size_t& off, int& ld, int& colt) {
    if (pn < 16) { const int g = pn >> 2; off = g == 0 ? WS_Q : g == 1 ? WS_K : g == 2 ? WS_V : WS_QI; ld = 1024; colt = (pn & 3) * 256; }
    else if (pn == 16) { off = WS_BQ; ld = 256; colt = 0; }
    else if (pn == 17) { off = WS_BK; ld = 256; colt = 0; }
    else if (pn < 20) { off = WS_BV; ld = 512; colt = (pn - 18) * 256; }
    else if (pn < 22) { off = WS_BG; ld = 512; colt = (pn - 20) * 256; }
    else if (pn == 22) { off = WS_KW; ld = 256; colt = 0; }
    else if (pn < 25) { off = WS_CR; ld = 512; colt = (pn - 23) * 256; }
    else if (pn < 27) { off = WS_CK; ld = 512; colt = (pn - 25) * 256; }
    else if (pn < 29) { off = WS_CV; ld = 512; colt = (pn - 27) * 256; }
    else if (pn == 29) { off = WS_CL; ld = 256; colt = 0; }
    else { off = WS_CG; ld = 256; colt = 0; }
}
}
__device__ __forceinline__ int win_src(int n, int layer) {
    if (n < 4096) return n;
    if (n < 4352) return 4176 + (n - 4096);
    if (n < 4608) return 4432 + (n - 4352);
    if (n < 5120) return 4688 + (n - 4608);
    if (n < 5632) return 5200 + (n - 5120);
    if (n < 5888) { const int j = n - 5632; return j < 64 ? 4096 + j : (j < 80 ? 4160 + (j - 64) : -1); }
    if (n < 7424) return 5712 + (n - 5888);
    if (n < 7680) { const int j = n - 7424; return j < 96 ? 7248 + j : (j < 192 ? 7344 + (j - 96) : (layer > 0 ? -2 - (j - 192) : -1)); }
    return 7440 + (n - 7680);
}
#define XB_TMO      128
#define XB_XCNT(j)  (256  + 64 * (j))
#define XB_XSUB(j)  (1280 + 64 * (j))
#define XB_XGEN(j)  (2304 + 64 * (j))
#define XB_TOP      3328
#define XB_TOPGEN   3392
#define XCD_BAR_WORDS 3456
#define XB_SPIN_CAP (1u << 18)

__device__ __forceinline__ unsigned xb_ld(unsigned* p)              { return __hip_atomic_load(p, __ATOMIC_RELAXED, __HIP_MEMORY_SCOPE_AGENT); }
__device__ __forceinline__ unsigned xb_add(unsigned* p, unsigned v) { return __hip_atomic_fetch_add(p, v, __ATOMIC_RELAXED, __HIP_MEMORY_SCOPE_AGENT); }
__device__ __forceinline__ unsigned xb_xcc_id() { return (unsigned)__builtin_amdgcn_s_getreg((3 << 11) | 20) & 0xFu; }
#define XB_SPIN(cond, bar) do { unsigned _sp = 0; while (cond) { __builtin_amdgcn_s_sleep(1); \
    if ((++_sp & 255u) == 0u) { if (xb_ld(&(bar)[XB_TMO])) break; if (_sp > XB_SPIN_CAP) { atomicAdd(&(bar)[XB_TMO], 1u); break; } } } } while (0)

struct XcdBarrier {
    unsigned* bar; unsigned x;
    volatile LAS unsigned* st;
};

__device__ __forceinline__ XcdBarrier xcd_barrier_post(unsigned* bar, volatile LAS unsigned* st) {
    XcdBarrier b; b.bar = bar; b.x = xb_xcc_id(); b.st = st;
    if (threadIdx.x == 0) (void)xb_add(&bar[XB_XCNT(b.x)], 1u);
    return b;
}
__device__ __forceinline__ void xcd_barrier_complete(unsigned* bar, unsigned x, unsigned& nloc, unsigned& nx) {
    const unsigned G = gridDim.x * gridDim.y * gridDim.z;
    unsigned sum, cnt, mine, sp = 0u;
    for (;;) {
        sum = 0u; cnt = 0u; mine = 0u;
#pragma unroll
        for (unsigned j = 0; j < 16; ++j) { const unsigned c = xb_ld(&bar[XB_XCNT(j)]); sum += c; cnt += (c > 0u) ? 1u : 0u; mine = (j == x) ? c : mine; }
        if (sum == G) break;
        __builtin_amdgcn_s_sleep(1);
        if ((++sp & 255u) == 0u) { if (xb_ld(&bar[XB_TMO])) break; if (sp > XB_SPIN_CAP) { atomicAdd(&bar[XB_TMO], 1u); break; } }
    }
    nloc = mine > 0u ? mine : 1u; nx = cnt > 0u ? cnt : 1u;
}

__device__ __forceinline__ void xcd_barrier(const XcdBarrier& b) {
    asm volatile("s_waitcnt vmcnt(0)" ::: "memory");
    __syncthreads();
    if (threadIdx.x == 0) {
        unsigned* bar = b.bar;
        __builtin_amdgcn_s_waitcnt(0);
        unsigned nloc = b.st[0], nx = b.st[1];
        if (nloc == 0u) { xcd_barrier_complete(bar, b.x, nloc, nx); b.st[0] = nloc; b.st[1] = nx; }
        const unsigned old = xb_add(&bar[XB_XSUB(b.x)], 1u);
        const unsigned gen = old / nloc;
        if (old + 1u == (gen + 1u) * nloc) {
            __builtin_amdgcn_fence(__ATOMIC_RELEASE, "agent");
            asm volatile("s_waitcnt vmcnt(0)" ::: "memory");
            const unsigned og = xb_add(&bar[XB_TOP], 1u);
            const unsigned tg = og / nx;
            if (og + 1u == (tg + 1u) * nx) xb_add(&bar[XB_TOPGEN], 1u);
            else XB_SPIN(xb_ld(&bar[XB_TOPGEN]) == tg, bar);
            __builtin_amdgcn_fence(__ATOMIC_ACQUIRE, "agent");
            xb_add(&bar[XB_XGEN(b.x)], 1u);
            asm volatile("s_waitcnt vmcnt(0)" ::: "memory");
        } else {
            XB_SPIN(xb_ld(&bar[XB_XGEN(b.x)]) == gen, bar);
            __builtin_amdgcn_fence(__ATOMIC_ACQUIRE, "agent");
            asm volatile("s_waitcnt vmcnt(0)" ::: "memory");
        }
    }
    __syncthreads();
}

struct Ctx {
    LAS unsigned char* lds; int tid, lane, wave, G, bid; unsigned char* ws; float* out;
};

template <int MAP>
__device__ __forceinline__ void wconv_item(const float* W, int ldw, const float* W2, int K, bf16* WT, LAS float* scr, int item, int nblk, int lane, int layer) {
    const int kb = item / nblk, nb = item % nblk, k0 = 64 * kb, n0 = 32 * nb;
    const int n = n0 + (lane & 31);
    const float* src = nullptr; int ld = ldw;
    if (MAP == 0) src = W + n;
    else if (MAP == 1) { const int s = win_src(n, layer); if (s >= 0) src = W + s; else if (s <= -2) { src = W2 + (-2 - s); ld = 64; } }
    else { const int tl = n >> 8, j = n & 255; src = W + (j < 128 ? tl * 128 + j : DFF + tl * 128 + (j - 128)); }
    float tv[32];
#pragma unroll
    for (int i = 0; i < 32; ++i) { const int kk = 2 * i + (lane >> 5); tv[i] = src ? src[(size_t)(k0 + kk) * ld] : 0.f; }
#pragma unroll
    for (int i = 0; i < 32; ++i) { const int kk = 2 * i + (lane >> 5); scr[kk * 33 + (lane & 31)] = tv[i]; }
    LDS_WAIT(); asm volatile("" ::: "memory");
    const int c = lane & 7;
#pragma unroll
    for (int j = 0; j < 4; ++j) { const int nn = (lane >> 3) + 8 * j; const LAS float* s = scr + (8 * c) * 33 + nn;
        u32x4 o; o.x = pk2(s[0 * 33], s[1 * 33]); o.y = pk2(s[2 * 33], s[3 * 33]); o.z = pk2(s[4 * 33], s[5 * 33]); o.w = pk2(s[6 * 33], s[7 * 33]);
        *(u32x4*)(WT + (size_t)(n0 + nn) * K + k0 + 8 * c) = o; }
    LDS_WAIT(); asm volatile("" ::: "memory");
}
struct WSrc { const float *w_in, *w_vres, *w_out, *w_gu, *w_dn, *wlb, *alb, *glb, *vlb; };
__device__ __forceinline__ void phase_wconv(const Ctx& C, int layer, const WSrc& W) {
    LAS float* scr = (LAS float*)(C.lds + C.wave * 16384);
    const int gw = C.bid * NWAVES + C.wave, NGW = C.G * NWAVES;
    const float* w_in = W.w_in + (size_t)layer * DM * N_IN; const float* w_vres = W.w_vres;
    const float* w_out = W.w_out + (size_t)layer * DM * DM; const float* w_gu = W.w_gu + (size_t)layer * DM * 2 * DFF; const float* w_dn = W.w_dn + (size_t)layer * DFF * DM;
    constexpr int I_IN = (DM / 64) * (N_INP / 32), I_OUT = (DM / 64) * (DM / 32), I_GU = (DM / 64) * (2 * DFF / 32), I_DN = (DFF / 64) * (DM / 32);
    for (int it = gw; it < I_IN + I_OUT + I_GU + I_DN; it += NGW) {
        int r = it;
        if (r < I_IN) { wconv_item<1>(w_in, N_IN, w_vres, DM, (bf16*)(C.ws + WS_WIN), scr, r, N_INP / 32, C.lane, layer); continue; } r -= I_IN;
        if (r < I_OUT) { wconv_item<0>(w_out, DM, nullptr, DM, (bf16*)(C.ws + WS_WOUT), scr, r, DM / 32, C.lane, layer); continue; } r -= I_OUT;
        if (r < I_GU) { wconv_item<2>(w_gu, 2 * DFF, nullptr, DM, (bf16*)(C.ws + WS_WGU), scr, r, 2 * DFF / 32, C.lane, layer); continue; } r -= I_GU;
        wconv_item<0>(w_dn, DM, nullptr, DFF, (bf16*)(C.ws + WS_WDN), scr, r, DM / 32, C.lane, layer);
    }
    const int gt = C.bid * NTHR + C.tid, NGT = C.G * NTHR;
    const float* wlb = W.wlb + (size_t)layer * 96 * 512; const float* alb = W.alb + (size_t)layer * 96 * 512; const float* glb = W.glb + (size_t)layer * 256 * 512;
    const float* vlb = W.vlb;
    bf16* LW = (bf16*)(C.ws + WS_LORA + LO_W); bf16* LA = (bf16*)(C.ws + WS_LORA + LO_A); bf16* LV = (bf16*)(C.ws + WS_LORA + LO_V); bf16* LG = (bf16*)(C.ws + WS_LORA + LO_G);
    for (int i = gt; i < 512 * 96; i += NGT) { const int n = i / 96, k = i % 96; LW[i] = (bf16)f2bf(wlb[k * 512 + n]); LA[i] = (bf16)f2bf(alb[k * 512 + n]); }
    for (int i = gt; i < 512 * 64; i += NGT) { const int n = i / 64, k = i % 64; LV[i] = (bf16)f2bf(layer > 0 ? vlb[k * 512 + n] : 0.f); }
    for (int i = gt; i < 512 * 256; i += NGT) { const int n = i / 256, k = i % 256; LG[i] = (bf16)f2bf(glb[k * 512 + n]); }
    if (layer == 0) {
        float2* TA = (float2*)(C.ws + WS_TAB + TAB_A); float2* TI = (float2*)(C.ws + WS_TAB + TAB_I); float2* TR = (float2*)(C.ws + WS_TAB + TAB_R);
        const float l2a = 18.931568569324174f  , l2r = 13.287712379549449f  ;
        for (int i = gt; i < T * 56; i += NGT) {
            const int pos = i / 56, j = i % 56; float fr; float2* dst;
            if (j < 16) { fr = exp2f(-(float)j * (1.0f / 16.0f) * l2a); dst = TA + pos * 16 + j; }
            else if (j < 24) { fr = exp2f(-(float)(j - 16) * (1.0f / 8.0f) * l2a); dst = TI + pos * 8 + (j - 16); }
            else { fr = exp2f(-(float)(j - 24) * (1.0f / 32.0f) * l2r); dst = TR + pos * 32 + (j - 24); }
            const float ang = (float)pos * fr; *dst = make_float2(cosf(ang), sinf(ang));
        }
    }
}
__device__ __forceinline__ void phase_xg(const Ctx& C, const float* x, const float* g, bf16* out, float* ss) {
    const int gw = C.bid * NWAVES + C.wave, NGW = C.G * NWAVES;
    f32x4 gv[8];
#pragma unroll
    for (int j = 0; j < 8; ++j) gv[j] = *(const f32x4*)(g + 4 * (C.lane + 64 * j));
    for (int m = gw; m < M; m += NGW) {
        const f32x4* xr = (const f32x4*)(x + (size_t)m * DM) + C.lane; f32x4 v[8]; float s = 0.f;
#pragma unroll
        for (int j = 0; j < 8; ++j) { v[j] = xr[64 * j]; s += (v[j].x * v[j].x + v[j].y * v[j].y) + (v[j].z * v[j].z + v[j].w * v[j].w); }
        s = wave_sum(s); if (C.lane == 0) ss[m] = s;
        u32x2* o = (u32x2*)(out + (size_t)m * DM) + C.lane;
#pragma unroll
        for (int j = 0; j < 8; ++j) { u32x2 w; w.x = pk2(v[j].x * gv[j].x, v[j].y * gv[j].y); w.y = pk2(v[j].z * gv[j].z, v[j].w * gv[j].w); o[64 * j] = w; }
    }
}
__device__ __forceinline__ void phase_final_norm(const Ctx& C, float* x, const float* g, const float* ss) {
    const int gw = C.bid * NWAVES + C.wave, NGW = C.G * NWAVES;
    f32x4 gv[8];
#pragma unroll
    for (int j = 0; j < 8; ++j) gv[j] = *(const f32x4*)(g + 4 * (C.lane + 64 * j));
    for (int m = gw; m < M; m += NGW) {
        f32x4* xr = (f32x4*)(x + (size_t)m * DM) + C.lane; const float rs = rsqrtf(ss[m] * (1.0f / DM) + 1e-5f);
#pragma unroll
        for (int j = 0; j < 8; ++j) xr[64 * j] = xr[64 * j] * rs * gv[j];
    }
}
__device__ __forceinline__ void phase_prep_a(const Ctx& C) {
    const long gt = (long)C.bid * NTHR + C.tid, NGT = (long)C.G * NTHR;
    { float* s1 = (float*)(C.ws + WS_SS1); float* s2 = (float*)(C.ws + WS_SS2); for (long i = gt; i < M; i += NGT) { s1[i] = 0.f; s2[i] = 0.f; } }
    for (int cfg = 0; cfg < 6; ++cfg) {
        size_t off; int ld, nh, hd, half; size_t tab;
        if (cfg == 0) { off = WS_Q; ld = 1024; nh = 8; hd = 128; half = 16; tab = TAB_A; }
        else if (cfg == 1) { off = WS_K; ld = 1024; nh = 8; hd = 128; half = 16; tab = TAB_A; }
        else if (cfg == 2) { off = WS_QI; ld = 1024; nh = 16; hd = 64; half = 8; tab = TAB_I; }
        else if (cfg == 3) { off = WS_KW; ld = 256; nh = 1; hd = 64; half = 8; tab = TAB_I; }
        else if (cfg == 4) { off = WS_BQ; ld = 256; nh = 4; hd = 64; half = 32; tab = TAB_R; }
        else { off = WS_BK; ld = 256; nh = 4; hd = 64; half = 32; tab = TAB_R; }
        bf16* buf = (bf16*)(C.ws + off); const float2* tb = (const float2*)(C.ws + WS_TAB + tab);
        const int cpp = half >> 3; const long total = (long)M * nh * cpp;
        for (long it0 = gt; it0 < total; it0 += 4 * NGT) {
            bf16* p1[4]; u32x4 a[4], b[4]; f32x4 tcs[4][4]; bool ok[4];
#pragma unroll
            for (int q = 0; q < 4; ++q) { const long it = it0 + q * NGT; ok[q] = it < total; const long itc = ok[q] ? it : gt;
                const int c = (int)(itc % cpp); const long r2 = itc / cpp; const int h = (int)(r2 % nh); const int row = (int)(r2 / nh); const int pos = row & (T - 1);
                p1[q] = buf + (size_t)row * ld + h * hd + 8 * c; a[q] = *(const u32x4*)p1[q]; b[q] = *(const u32x4*)(p1[q] + half);
                const f32x4* tp = (const f32x4*)(tb + (size_t)pos * half + 8 * c);
#pragma unroll
                for (int e = 0; e < 4; ++e) tcs[q][e] = tp[e]; }
#pragma unroll
            for (int q = 0; q < 4; ++q) { if (!ok[q]) continue; u32x4 oa, ob;
#pragma unroll
                for (int e = 0; e < 4; ++e) { const float x10 = bflo(a[q][e]), x11 = bfhi(a[q][e]), x20 = bflo(b[q][e]), x21 = bfhi(b[q][e]); const f32x4 t = tcs[q][e];
                    oa[e] = pk2(x10 * t.x - x20 * t.y, x11 * t.z - x21 * t.w); ob[e] = pk2(x20 * t.x + x10 * t.y, x21 * t.z + x11 * t.w); }
                *(u32x4*)p1[q] = oa; *(u32x4*)(p1[q] + half) = ob; }
        }
    }
    {
        LAS unsigned short* scr = (LAS unsigned short*)(C.lds + C.wave * 9216);
        const bf16* V = (const bf16*)(C.ws + WS_V); bf16* Vt = (bf16*)(C.ws + WS_VT);
        const int gw = C.bid * NWAVES + C.wave, NGW = C.G * NWAVES, lane = C.lane;
        for (int it = gw; it < NB * 128 * 16; it += NGW) {
            const int ct = it & 15, tt = (it >> 4) & 127, b = it >> 11;
            const int t0 = tt * 64, c0 = ct * 64;
            u32x4 v[8];
#pragma unroll
            for (int i = 0; i < 8; ++i) { const int tr = 8 * i + (lane >> 3), c8 = (lane & 7) * 8; v[i] = *(const u32x4*)(V + (size_t)(b * T + t0 + tr) * 1024 + c0 + c8); }
#pragma unroll
            for (int i = 0; i < 8; ++i) { const int tr = 8 * i + (lane >> 3), c8 = (lane & 7) * 8; *(LAS u32x4*)(scr + tr * 72 + c8) = v[i]; }
            LDS_WAIT(); asm volatile("" ::: "memory");
#pragma unroll
            for (int i = 0; i < 8; ++i) { const int cr = 8 * i + (lane >> 3), t8 = (lane & 7) * 8; u32x4 w;
#pragma unroll
                for (int e = 0; e < 4; ++e) w[e] = (unsigned)scr[(t8 + 2 * e) * 72 + cr] | ((unsigned)scr[(t8 + 2 * e + 1) * 72 + cr] << 16);
                *(u32x4*)(Vt + ((size_t)b * 1024 + c0 + cr) * T + t0 + t8) = w; }
            LDS_WAIT(); asm volatile("" ::: "memory");
        }
    }
}
#ifndef IDX_REP_T
#define IDX_REP_T 1
#endif
#ifndef IDX_REP_S
#define IDX_REP_S 1
#endif
__device__ __forceinline__ void phase_indexer(const Ctx& C) {
    LAS unsigned short* sc = (LAS unsigned short*)C.lds;
    LAS unsigned* hist = (LAS unsigned*)(C.lds + 131072) + C.wave * 256;
    LAS float* wvl = (LAS float*)(C.lds + 131072 + 8192);
    LAS unsigned short* qbl = (LAS unsigned short*)(C.lds + 131072 + 8192 + 512);
    const bf16* QI = (const bf16*)(C.ws + WS_QI); const bf16* KW = (const bf16*)(C.ws + WS_KW); u64* MASK = (u64*)(C.ws + WS_MASK);
    const int lane = C.lane, r32 = lane & 31, hi = lane >> 5;
    for (int it = C.bid; it < NB * (T / 8); it += C.G) {
        const int b = it & 3, qg = it >> 2, q0 = qg * 8, qchunk = q0 >> 6, nadm = 64 * (qchunk + 1);
        const int qrow = b * T + q0 + C.wave;
        if (qchunk < 4) {
            MASK[(size_t)qrow * 128 + lane] = lane <= qchunk ? ~0ull : 0ull; MASK[(size_t)qrow * 128 + 64 + lane] = 0ull;
            continue;
        }
        bf16x8 af[4][4];
        {
            const int qq = (r32 >> 2) & 1, hh = (r32 & 3) + 4 * (r32 >> 3);
#pragma unroll
            for (int pr = 0; pr < 4; ++pr) {
                const bf16* qp = QI + (size_t)(b * T + q0 + 2 * pr + qq) * 1024 + hh * 64 + 8 * hi;
#pragma unroll
                for (int kk = 0; kk < 4; ++kk) af[pr][kk] = *(const bf16x8*)(qp + 16 * kk);
            }
            if (C.tid < 128) wvl[C.tid] = bf2f(KW[(size_t)(b * T + q0 + (C.tid >> 4)) * 256 + 64 + (C.tid & 15)]) * 0.015625f;
        }
        __syncthreads();
        { const int qx = C.tid >> 6, dx = C.tid & 63; const bf16* qp = QI + (size_t)(b * T + q0 + qx) * 1024 + dx; float acc = 0.f;
#pragma unroll
          for (int h = 0; h < 16; ++h) acc += wvl[qx * 16 + h] * bf2f(qp[h * 64]);
          qbl[qx * 64 + dx] = (unsigned short)f2bf(acc); }
        __syncthreads();
        bf16x8 afl[4];
        { const int qsel = 2 * (r32 & 3) + ((r32 >> 2) & 1);
#pragma unroll
          for (int kk = 0; kk < 4; ++kk) { const u32x4 z = {0u, 0u, 0u, 0u}; afl[kk] = r32 < 8 ? *(const LAS bf16x8*)(qbl + qsel * 64 + 16 * kk + 8 * hi) : __builtin_bit_cast(bf16x8, z); } }
        for (int rep_t = 0; rep_t < IDX_REP_T; ++rep_t) {
            const int ntile = nadm / 32;
            bf16x8 bfr[4], bnx[4];
            { const bf16* kp = KW + (size_t)(b * T + 32 * C.wave + r32) * 256 + 8 * hi;
#pragma unroll
              for (int kk = 0; kk < 4; ++kk) bnx[kk] = *(const bf16x8*)(kp + 16 * kk); }
            for (int tile = C.wave; tile < ntile; tile += NWAVES) {
                const int key0 = 32 * tile;
#pragma unroll
                for (int kk = 0; kk < 4; ++kk) bfr[kk] = bnx[kk];
                if (tile + NWAVES < ntile) { const bf16* kp = KW + (size_t)(b * T + key0 + 32 * NWAVES + r32) * 256 + 8 * hi;
#pragma unroll
                    for (int kk = 0; kk < 4; ++kk) bnx[kk] = *(const bf16x8*)(kp + 16 * kk); }
                const int kpos = (key0 & ~127) + 2 * ((key0 & 63) + r32) + ((key0 >> 6) & 1);
                f32x16 dl = {0.f, 0.f, 0.f, 0.f, 0.f, 0.f, 0.f, 0.f, 0.f, 0.f, 0.f, 0.f, 0.f, 0.f, 0.f, 0.f};
#pragma unroll
                for (int kk = 0; kk < 4; ++kk) dl = __builtin_amdgcn_mfma_f32_32x32x16_bf16(afl[kk], bfr[kk], dl, 0, 0, 0);
#pragma unroll
                for (int pr = 0; pr < 4; ++pr) {
                    f32x16 d = {0.f, 0.f, 0.f, 0.f, 0.f, 0.f, 0.f, 0.f, 0.f, 0.f, 0.f, 0.f, 0.f, 0.f, 0.f, 0.f};
#pragma unroll
                    for (int kk = 0; kk < 4; ++kk) d = __builtin_amdgcn_mfma_f32_32x32x16_bf16(af[pr][kk], bfr[kk], d, 0, 0, 0);
                    float s0 = dl[pr];
#pragma unroll
                    for (int g = 0; g < 4; ++g) { const f32x4 w4 = *(const LAS f32x4*)(wvl + (2 * pr + hi) * 16 + 4 * g);
                        s0 = __builtin_fmaf(__builtin_fabsf(d[4 * g]), w4.x, s0); s0 = __builtin_fmaf(__builtin_fabsf(d[4 * g + 1]), w4.y, s0); s0 = __builtin_fmaf(__builtin_fabsf(d[4 * g + 2]), w4.z, s0); s0 = __builtin_fmaf(__builtin_fabsf(d[4 * g + 3]), w4.w, s0); }
                    const unsigned short hb = __half_as_ushort(__float2half_rn(s0));
                    const unsigned short key = (hb & 0x8000u) ? (unsigned short)~hb : (unsigned short)(hb | 0x8000u);
                    sc[(2 * pr + hi) * 8192 + kpos] = key;
                }
            }
        }
        __syncthreads();
        const LAS unsigned* my = (const LAS unsigned*)(sc + C.wave * 8192);
        const int nit = nadm / 128;
        const bool tail = (nadm & 64) != 0;
        unsigned thr = 0;
        for (int rep_s = 0; rep_s < IDX_REP_S; ++rep_s) {
            unsigned want = 256u, prefix = 0u;
#pragma unroll 1
            for (int lvl = 0; lvl < 2; ++lvl) {
                hist[lane] = 0u; hist[64 + lane] = 0u; hist[128 + lane] = 0u; hist[192 + lane] = 0u;
                LDS_WAIT(); asm volatile("" ::: "memory");
                int i = 0;
                for (; i + 4 <= nit; i += 4) { unsigned kv[4];
#pragma unroll
                    for (int u = 0; u < 4; ++u) kv[u] = my[64 * (i + u) + lane];
#pragma unroll
                    for (int u = 0; u < 4; ++u) { const unsigned k0 = kv[u] & 0xffffu, k1 = kv[u] >> 16;
                        if (lvl == 0) { atomicAdd((unsigned*)&hist[k0 >> 8], 1u); atomicAdd((unsigned*)&hist[k1 >> 8], 1u); }
                        else { if ((k0 >> 8) == prefix) atomicAdd((unsigned*)&hist[k0 & 255u], 1u); if ((k1 >> 8) == prefix) atomicAdd((unsigned*)&hist[k1 & 255u], 1u); } } }
                for (; i < nit + (tail ? 1 : 0); ++i) { const unsigned kvv = my[64 * i + lane]; const unsigned k0 = kvv & 0xffffu, k1 = kvv >> 16; const bool two = i < nit;
                    if (lvl == 0) { atomicAdd((unsigned*)&hist[k0 >> 8], 1u); if (two) atomicAdd((unsigned*)&hist[k1 >> 8], 1u); }
                    else { if ((k0 >> 8) == prefix) atomicAdd((unsigned*)&hist[k0 & 255u], 1u); if (two && (k1 >> 8) == prefix) atomicAdd((unsigned*)&hist[k1 & 255u], 1u); } }
                LDS_WAIT(); asm volatile("" ::: "memory");
                const unsigned c0 = hist[4 * lane], c1 = hist[4 * lane + 1], c2 = hist[4 * lane + 2], c3 = hist[4 * lane + 3];
                const unsigned tl = c0 + c1 + c2 + c3; unsigned inc = tl;
#pragma unroll
                for (int o = 1; o < 64; o <<= 1) { const unsigned v = __shfl_down(inc, o); if (lane + o < 64) inc += v; }
                const unsigned ab3 = inc - tl, ab2 = ab3 + c3, ab1 = ab2 + c2, ab0 = ab1 + c1;
                int selb = -1; unsigned rem = 0;
                if (ab3 < want && ab3 + c3 >= want) { selb = 3; rem = want - ab3; }
                else if (ab2 < want && ab2 + c2 >= want) { selb = 2; rem = want - ab2; }
                else if (ab1 < want && ab1 + c1 >= want) { selb = 1; rem = want - ab1; }
                else if (ab0 < want && ab0 + c0 >= want) { selb = 0; rem = want - ab0; }
                const u64 bal = __ballot(selb >= 0); const int src = bal ? (int)__ffsll((long long)bal) - 1 : 0;
                const unsigned bin = (unsigned)__shfl(4 * lane + (selb < 0 ? 0 : selb), src); want = (unsigned)__shfl((int)rem, src);
                if (lvl == 0) prefix = bin; else thr = (prefix << 8) | bin;
                LDS_WAIT(); asm volatile("" ::: "memory");
            }
        }
        u64 w0 = 0, w1 = 0;
        for (int i = 0; i < nit + (tail ? 1 : 0); ++i) { const unsigned kvv = my[64 * i + lane]; const u64 b0 = __ballot((kvv & 0xffffu) >= thr), b1 = (i < nit) ? __ballot((kvv >> 16) >= thr) : 0ull;
            if (i < 32) { if (lane == 2 * i) w0 = b0; if (lane == 2 * i + 1) w0 = b1; } else { if (lane == 2 * i - 64) w1 = b0; if (lane == 2 * i - 63) w1 = b1; } }
        MASK[(size_t)qrow * 128 + lane] = w0; MASK[(size_t)qrow * 128 + 64 + lane] = w1;
        __syncthreads();
    }
}
constexpr int AT_KROW = 272, AT_VROW = 136, AT_KB = 64 * AT_KROW, AT_VB = 128 * AT_VROW, AT_BUF = AT_KB + AT_VB;
__device__ __forceinline__ void attn_unit(const Ctx& C, int b, int head, int qb) {
    const bf16* Q = (const bf16*)(C.ws + WS_Q); const bf16* K = (const bf16*)(C.ws + WS_K); const bf16* Vt = (const bf16*)(C.ws + WS_VT);
    const u64* MASK = (const u64*)(C.ws + WS_MASK); bf16* CAT = (bf16*)(C.ws + WS_CAT);
    const int tid = C.tid, lane = C.lane, wid = C.wave, r32 = lane & 31, hi = lane >> 5;
    const int q = 256 * qb + 32 * wid + r32; const size_t row = (size_t)b * T + q;
    const int nt = 4 * qb + 4, myc = 4 * qb + (wid >> 1);
    bf16x8 qf[8];
#pragma unroll
    for (int d0 = 0; d0 < 8; ++d0) qf[d0] = *(const bf16x8*)(Q + row * 1024 + head * 128 + 16 * d0 + 8 * hi);
    const bf16* kg[2]; const bf16* vg[2]; int kl[2], vl[2];
#pragma unroll
    for (int i = 0; i < 2; ++i) { const int c = tid + 512 * i;
        kg[i] = K + ((size_t)b * T + (c >> 4)) * 1024 + head * 128 + (c & 15) * 8; kl[i] = (c >> 4) * AT_KROW + (c & 15) * 16;
        vg[i] = Vt + ((size_t)(b * 8 + head) * 128 + (c >> 3)) * T + (c & 7) * 8; vl[i] = AT_KB + (c >> 3) * AT_VROW + (c & 7) * 16; }
    u32x4 kr[2], vr[2];
#pragma unroll
    for (int i = 0; i < 2; ++i) { kr[i] = *(const u32x4*)kg[i]; vr[i] = *(const u32x4*)vg[i]; }
#pragma unroll
    for (int i = 0; i < 2; ++i) { *(LAS u32x4*)(C.lds + kl[i]) = kr[i]; *(LAS u32x2*)(C.lds + vl[i]) = (u32x2){vr[i].x, vr[i].y}; *(LAS u32x2*)(C.lds + vl[i] + 8) = (u32x2){vr[i].z, vr[i].w}; }
    __syncthreads();
    float lrun = 0.f; f32x16 o[4];
#pragma unroll
    for (int db = 0; db < 4; ++db)
#pragma unroll
        for (int r = 0; r < 16; ++r) o[db][r] = 0.f;
    for (int t = 0; t < nt; ++t) {
        const int cur = (t & 1) * AT_BUF, nxt = ((t + 1) & 1) * AT_BUF;
        if (t + 1 < nt) {
#pragma unroll
            for (int i = 0; i < 2; ++i) { kr[i] = *(const u32x4*)(kg[i] + (size_t)(t + 1) * 64 * 1024); vr[i] = *(const u32x4*)(vg[i] + (t + 1) * 64); }
        }
        if (t <= myc) {
            const u64 mw = MASK[row * 128 + t];
            const LAS unsigned char* Ks = C.lds + cur; const LAS unsigned char* Vs = C.lds + cur + AT_KB;
            f32x16 p0, p1;
#pragma unroll
            for (int r = 0; r < 16; ++r) { p0[r] = 0.f; p1[r] = 0.f; }
            {
                const LAS unsigned char* kp0 = Ks + r32 * AT_KROW + 16 * hi; const LAS unsigned char* kp1 = kp0 + 32 * AT_KROW;
                bf16x8 ka = *(const LAS bf16x8*)kp0, kb = *(const LAS bf16x8*)kp1;
#pragma unroll
                for (int d0 = 0; d0 < 8; ++d0) {
                    bf16x8 na = ka, nb = kb;
                    if (d0 < 7) { na = *(const LAS bf16x8*)(kp0 + 32 * (d0 + 1)); nb = *(const LAS bf16x8*)(kp1 + 32 * (d0 + 1)); }
                    __builtin_amdgcn_sched_barrier(0);
                    p0 = __builtin_amdgcn_mfma_f32_32x32x16_bf16(ka, qf[d0], p0, 0, 0, 0);
                    p1 = __builtin_amdgcn_mfma_f32_32x32x16_bf16(kb, qf[d0], p1, 0, 0, 0);
                    __builtin_amdgcn_sched_barrier(0);
                    ka = na; kb = nb;
                }
            }
            const int mlo = (int)((unsigned)mw >> (4 * hi)), mhi = (int)((unsigned)(mw >> 32) >> (4 * hi));
            float ls0 = 0.f, ls1 = 0.f;
#pragma unroll
            for (int r = 0; r < 16; ++r) { const int c = (r & 3) + 8 * (r >> 2);
                unsigned s0, s1;
                asm("v_bfe_i32 %0, %1, %2, 1" : "=v"(s0) : "v"(mlo), "n"(c)); asm("v_bfe_i32 %0, %1, %2, 1" : "=v"(s1) : "v"(mhi), "n"(c));
                const unsigned e0 = __float_as_uint(__builtin_amdgcn_exp2f(p0[r])) & s0;
                const unsigned e1 = __float_as_uint(__builtin_amdgcn_exp2f(p1[r])) & s1;
                p0[r] = __uint_as_float(e0); p1[r] = __uint_as_float(e1); ls0 += p0[r]; ls1 += p1[r]; }
            lrun += ls0 + ls1;
            bf16x8 pb[4];
#pragma unroll
            for (int kk = 0; kk < 4; ++kk) { u32x4 w;
#pragma unroll
                for (int e = 0; e < 4; ++e) { const int r = 8 * (kk & 1) + 2 * e; w[e] = (kk < 2) ? pg8::cvt_pk_bf16(p0[r], p0[r + 1]) : pg8::cvt_pk_bf16(p1[r], p1[r + 1]); }
                pb[kk] = __builtin_bit_cast(bf16x8, w); }
            {
                const LAS unsigned char* vp0 = Vs + r32 * AT_VROW + 8 * hi;
                u32x4 va[4], vn[4];
#pragma unroll
                for (int kk = 0; kk < 4; ++kk) { const u32x2 a0 = *(const LAS u32x2*)(vp0 + 32 * kk), a1 = *(const LAS u32x2*)(vp0 + 32 * kk + 16); va[kk] = (u32x4){a0.x, a0.y, a1.x, a1.y}; }
#pragma unroll
                for (int db = 0; db < 4; ++db) {
                    if (db < 3) {
#pragma unroll
                        for (int kk = 0; kk < 4; ++kk) { const LAS unsigned char* vp = vp0 + 32 * (db + 1) * AT_VROW + 32 * kk; const u32x2 a0 = *(const LAS u32x2*)vp, a1 = *(const LAS u32x2*)(vp + 16); vn[kk] = (u32x4){a0.x, a0.y, a1.x, a1.y}; }
                    }
                    __builtin_amdgcn_sched_barrier(0);
#pragma unroll
                    for (int kk = 0; kk < 4; ++kk) o[db] = __builtin_amdgcn_mfma_f32_32x32x16_bf16(__builtin_bit_cast(bf16x8, va[kk]), pb[kk], o[db], 0, 0, 0);
                    __builtin_amdgcn_sched_barrier(0);
#pragma unroll
                    for (int kk = 0; kk < 4; ++kk) va[kk] = vn[kk];
                }
            }
        }
        if (t + 1 < nt) {
#pragma unroll
            for (int i = 0; i < 2; ++i) { *(LAS u32x4*)(C.lds + nxt + kl[i]) = kr[i]; *(LAS u32x2*)(C.lds + nxt + vl[i]) = (u32x2){vr[i].x, vr[i].y}; *(LAS u32x2*)(C.lds + nxt + vl[i] + 8) = (u32x2){vr[i].z, vr[i].w}; }
        }
        __syncthreads();
    }
    lrun += __shfl_xor(lrun, 32);
    const float inv = 1.0f / lrun;
    bf16* op = CAT + row * 2048 + head * 128 + 4 * hi;
#pragma unroll
    for (int db = 0; db < 4; ++db)
#pragma unroll
        for (int g = 0; g < 4; ++g) { u32x2 w; w.x = pk2(o[db][4 * g] * inv, o[db][4 * g + 1] * inv); w.y = pk2(o[db][4 * g + 2] * inv, o[db][4 * g + 3] * inv);
            *(u32x2*)(op + 32 * db + 8 * g) = w; }
}
__device__ __forceinline__ void phase_attn(const Ctx& C) {
    for (int i = C.bid; i < 1024; i += C.G) {
        const int w = i & 255, k = i >> 8, combo = w >> 3, j = w & 7;
        const int qb = k == 0 ? j : k == 1 ? 15 - j : k == 2 ? 16 + j : 31 - j;
        attn_unit(C, combo >> 3, combo & 7, qb);
        __syncthreads();
    }
}
__device__ __forceinline__ float ret_logg(int h) { return log1pf(-exp2f(-5.0f - (float)h)); }
constexpr int RT_KP = 72, RT_VP = 136;
__device__ __forceinline__ bf16x8 lds_col8(const LAS bf16* p, int pitch, const int (&rows)[8]) {
    u32x4 w;
#pragma unroll
    for (int e = 0; e < 4; ++e) w[e] = (unsigned)p[rows[2 * e] * pitch] | ((unsigned)p[rows[2 * e + 1] * pitch] << 16);
    return __builtin_bit_cast(bf16x8, w);
}
__device__ __forceinline__ void phase_ret1(const Ctx& C) {
    LAS bf16* Ks = (LAS bf16*)C.lds;
    LAS bf16* Vs = Ks + 64 * RT_KP;
    const bf16* BK = (const bf16*)(C.ws + WS_BK); const bf16* BV = (const bf16*)(C.ws + WS_BV); float* KV = (float*)(C.ws + WS_KVST);
    const int tid = C.tid, lane = C.lane, r32 = lane & 31, hi = lane >> 5, db = C.wave >> 2, eb = C.wave & 3;
    for (int u = C.bid; u < NB * 128 * 4; u += C.G) {
        const int h = u & 3, c = (u >> 2) & 127, b = u >> 9; const size_t row0 = (size_t)b * T + 64 * c; const float lg = ret_logg(h);
        { const int m = tid >> 3, d8 = (tid & 7) * 8; const u32x4 w = *(const u32x4*)(BK + (row0 + m) * 256 + h * 64 + d8); const float z = __expf((63.0f - (float)m) * lg) * 0.125f;
          u32x4 o;
#pragma unroll
          for (int e = 0; e < 4; ++e) o[e] = pk2(bflo(w[e]) * z, bfhi(w[e]) * z);
          *(LAS u32x4*)(Ks + m * RT_KP + d8) = o; }
#pragma unroll
        for (int i = 0; i < 2; ++i) { const int cidx = tid + 512 * i, m = cidx >> 4, e8 = (cidx & 15) * 8; *(LAS u32x4*)(Vs + m * RT_VP + e8) = *(const u32x4*)(BV + (row0 + m) * 512 + h * 128 + e8); }
        __syncthreads();
        f32x16 acc;
#pragma unroll
        for (int r = 0; r < 16; ++r) acc[r] = 0.f;
#pragma unroll
        for (int kk = 0; kk < 4; ++kk) {
            int rows[8];
#pragma unroll
            for (int j = 0; j < 8; ++j) rows[j] = 16 * kk + 8 * hi + j;
            const bf16x8 af = lds_col8(Ks + 32 * db + r32, RT_KP, rows), bfv = lds_col8(Vs + 32 * eb + r32, RT_VP, rows);
            acc = __builtin_amdgcn_mfma_f32_32x32x16_bf16(af, bfv, acc, 0, 0, 0);
        }
        float* dst = KV + (size_t)u * 8192 + (size_t)(32 * eb + r32) * 64 + 32 * db + 4 * hi;
#pragma unroll
        for (int g = 0; g < 4; ++g) *(f32x4*)(dst + 8 * g) = (f32x4){acc[4 * g], acc[4 * g + 1], acc[4 * g + 2], acc[4 * g + 3]};
        __syncthreads();
    }
}
__device__ __forceinline__ void phase_ret2(const Ctx& C) {
    float* KV = (float*)(C.ws + WS_KVST);
    for (int g = C.bid * NTHR + C.tid; g < NB * 4 * 8192; g += C.G * NTHR) {
        const int el = g & 8191, h = (g >> 13) & 3, b = g >> 15; const float gc = __expf(64.0f * ret_logg(h));
        float* p = KV + ((size_t)b * 512 + h) * 8192 + el;
        float st = 0.f;
        for (int c0 = 0; c0 < 128; c0 += 8) { float x[8];
#pragma unroll
            for (int i = 0; i < 8; ++i) x[i] = p[(size_t)(c0 + i) * 4 * 8192];
#pragma unroll
            for (int i = 0; i < 8; ++i) { p[(size_t)(c0 + i) * 4 * 8192] = st; st = st * gc + x[i]; } }
    }
}
__device__ __forceinline__ void phase_ret3(const Ctx& C) {
    LAS bf16* Qs = (LAS bf16*)C.lds;
    LAS bf16* Ks = Qs + 64 * RT_KP;
    LAS bf16* Vs = Ks + 64 * RT_KP;
    LAS float* Red = (LAS float*)(Vs + 64 * RT_VP);
    const bf16* BQ = (const bf16*)(C.ws + WS_BQ); const bf16* BK = (const bf16*)(C.ws + WS_BK); const bf16* BV = (const bf16*)(C.ws + WS_BV); const bf16* BG = (const bf16*)(C.ws + WS_BG);
    const float* KV = (const float*)(C.ws + WS_KVST); bf16* CAT = (bf16*)(C.ws + WS_CAT);
    const int tid = C.tid, lane = C.lane, r32 = lane & 31, hi = lane >> 5, nb = C.wave >> 2, eb = C.wave & 3;
    for (int u = C.bid; u < NB * 128 * 4; u += C.G) {
        const int h = u & 3, c = (u >> 2) & 127, b = u >> 9; const size_t row0 = (size_t)b * T + 64 * c; const float l2g = ret_logg(h) * 1.4426950408889634f;
        { const int m = tid >> 3, d8 = (tid & 7) * 8; *(LAS u32x4*)(Qs + m * RT_KP + d8) = *(const u32x4*)(BQ + (row0 + m) * 256 + h * 64 + d8);
          const u32x4 w = *(const u32x4*)(BK + (row0 + m) * 256 + h * 64 + d8); u32x4 o;
#pragma unroll
          for (int e = 0; e < 4; ++e) o[e] = pk2(bflo(w[e]) * 0.125f, bfhi(w[e]) * 0.125f);
          *(LAS u32x4*)(Ks + m * RT_KP + d8) = o; }
#pragma unroll
        for (int i = 0; i < 2; ++i) { const int cidx = tid + 512 * i, m = cidx >> 4, e8 = (cidx & 15) * 8; *(LAS u32x4*)(Vs + m * RT_VP + e8) = *(const u32x4*)(BV + (row0 + m) * 512 + h * 128 + e8); }
        bf16x8 pf[4];
        { const float* pp = KV + (size_t)u * 8192 + (size_t)(32 * eb + r32) * 64 + 8 * hi;
#pragma unroll
          for (int kk = 0; kk < 4; ++kk) { const f32x4 a0 = *(const f32x4*)(pp + 16 * kk), a1 = *(const f32x4*)(pp + 16 * kk + 4);
              u32x4 w; w.x = pk2(a0.x, a0.y); w.y = pk2(a0.z, a0.w); w.z = pk2(a1.x, a1.y); w.w = pk2(a1.z, a1.w); pf[kk] = __builtin_bit_cast(bf16x8, w); } }
        __syncthreads();
        bf16x8 qf[4];
#pragma unroll
        for (int kk = 0; kk < 4; ++kk) qf[kk] = *(const LAS bf16x8*)(Qs + (32 * nb + r32) * RT_KP + 16 * kk + 8 * hi);
        f32x16 cr, out;
#pragma unroll
        for (int r = 0; r < 16; ++r) { cr[r] = 0.f; out[r] = 0.f; }
#pragma unroll
        for (int kk = 0; kk < 4; ++kk) cr = __builtin_amdgcn_mfma_f32_32x32x16_bf16(qf[kk], pf[kk], cr, 0, 0, 0);
        const float gn = __builtin_amdgcn_exp2f((float)(32 * nb + r32) * l2g);
#pragma unroll
        for (int mb = 0; mb < 2; ++mb) {
            if (mb > nb) continue;
            f32x16 st;
#pragma unroll
            for (int r = 0; r < 16; ++r) st[r] = 0.f;
#pragma unroll
            for (int kk = 0; kk < 4; ++kk) { const bf16x8 kf = *(const LAS bf16x8*)(Ks + (32 * mb + r32) * RT_KP + 16 * kk + 8 * hi); st = __builtin_amdgcn_mfma_f32_32x32x16_bf16(kf, qf[kk], st, 0, 0, 0); }
            const int nq = 32 * nb + r32;
#pragma unroll
            for (int r = 0; r < 16; ++r) { const int m = 32 * mb + (r & 3) + 8 * (r >> 2) + 4 * hi; st[r] = (m <= nq) ? st[r] * gn * __builtin_amdgcn_exp2f(-(float)m * l2g) : 0.f; }
#pragma unroll
            for (int s2 = 0; s2 < 2; ++s2) {
                u32x4 w;
#pragma unroll
                for (int e = 0; e < 4; ++e) w[e] = pg8::cvt_pk_bf16(st[8 * s2 + 2 * e], st[8 * s2 + 2 * e + 1]);
                int rows[8];
#pragma unroll
                for (int j = 0; j < 8; ++j) rows[j] = 32 * mb + 16 * s2 + 8 * (j >> 2) + 4 * hi + (j & 3);
                const bf16x8 vf = lds_col8(Vs + 32 * eb + r32, RT_VP, rows);
                out = __builtin_amdgcn_mfma_f32_32x32x16_bf16(__builtin_bit_cast(bf16x8, w), vf, out, 0, 0, 0);
            }
        }
        float sv[16], s2v[16];
#pragma unroll
        for (int r = 0; r < 16; ++r) { const int n = 32 * nb + (r & 3) + 8 * (r >> 2) + 4 * hi; out[r] += __builtin_amdgcn_exp2f((float)(n + 1) * l2g) * cr[r]; sv[r] = half_sum32(out[r]); s2v[r] = half_sum32(out[r] * out[r]); }
        if (r32 == 0) {
#pragma unroll
            for (int r = 0; r < 16; ++r) { const int n = 32 * nb + (r & 3) + 8 * (r >> 2) + 4 * hi; *(LAS f32x2*)(Red + (n * 4 + eb) * 2) = (f32x2){sv[r], s2v[r]}; }
        }
        __syncthreads();
#pragma unroll
        for (int r = 0; r < 16; ++r) { const int n = 32 * nb + (r & 3) + 8 * (r >> 2) + 4 * hi;
            const f32x4 p0 = *(const LAS f32x4*)(Red + n * 8), p1 = *(const LAS f32x4*)(Red + n * 8 + 4);
            const float mean = (p0.x + p0.z + p1.x + p1.z) * (1.0f / 128.0f), ex2 = (p0.y + p0.w + p1.y + p1.w) * (1.0f / 128.0f);
            const float rstd = rsqrtf(fmaxf(ex2 - mean * mean, 0.f) + 1e-5f);
            const float gg = bf2f(BG[(row0 + n) * 512 + h * 128 + 32 * eb + r32]); const float sl = gg * __builtin_amdgcn_rcpf(1.0f + __expf(-gg));
            CAT[(row0 + n) * 2048 + 1024 + h * 128 + 32 * eb + r32] = (bf16)f2bf((out[r] - mean) * rstd * sl); }
        __syncthreads();
    }
}
__device__ __forceinline__ float sigmoidf_(float x) { return __builtin_amdgcn_rcpf(1.0f + __expf(-x)); }
constexpr int RW_AW = 104, RW_AV = 72, RW_AG = 264;
constexpr int RW1_BUF = 32 * RW_AW * 2 + 32 * RW_AV;
struct RwP { const float *mu, *mu_v, *w0, *a0, *v0, *k_k, *k_a, *r_k, *lnx_g, *lnx_b; };
template <class TT> __device__ __forceinline__ GAS TT* opaque_g(const TT* p) {
    unsigned lo = (unsigned)(uintptr_t)p, hi = (unsigned)((uintptr_t)p >> 32); asm volatile("" : "+v"(lo), "+v"(hi));
    lo = __builtin_amdgcn_readfirstlane(lo); hi = __builtin_amdgcn_readfirstlane(hi); return (GAS TT*)(((uintptr_t)hi << 32) | lo);
}
__device__ __forceinline__ int tokr(int r, int hi) { return (r & 3) + 8 * (r >> 2) + 4 * hi; }
__device__ __forceinline__ void shifted16(GAS bf16* ub, const unsigned (&off)[16], int cbo, bool first_unit, int hi, float mu, float (&x)[16]) {
    float cur[16], prv[4];
#pragma unroll
    for (int r = 0; r < 16; ++r) cur[r] = bf2f(at_b(ub, off[r])[cbo]);
#pragma unroll
    for (int g = 0; g < 4; ++g) { const bool first = (g == 0) && (hi == 0) && first_unit; prv[g] = first ? 0.f : bf2f(at_b(ub, off[4 * g])[cbo - 512]); }
#pragma unroll
    for (int r = 0; r < 16; ++r) { const float p = (r & 3) == 0 ? prv[r >> 2] : cur[r - 1]; x[r] = cur[r] + (p - cur[r]) * mu; }
}
__device__ __forceinline__ void phase_rw1(const Ctx& C, int layer, const RwP& P) {
    LAS bf16* ACT = (LAS bf16*)C.lds;
    const bf16* CR = (const bf16*)(C.ws + WS_CR); const bf16* CK = (const bf16*)(C.ws + WS_CK); const bf16* CV = (const bf16*)(C.ws + WS_CV); const bf16* CL = (const bf16*)(C.ws + WS_CL);
    const bf16* LW = (const bf16*)(C.ws + WS_LORA + LO_W); const bf16* LA = (const bf16*)(C.ws + WS_LORA + LO_A); const bf16* LV = (const bf16*)(C.ws + WS_LORA + LO_V);
    bf16* VF = (bf16*)(C.ws + WS_VFIRST);
    bf16* RR = (bf16*)(C.ws + WS_RR); bf16* RU = (bf16*)(C.ws + WS_RW); bf16* RKH = (bf16*)(C.ws + WS_RKH); bf16* RV = (bf16*)(C.ws + WS_RV); bf16* RA = (bf16*)(C.ws + WS_RA); bf16* RB = (bf16*)(C.ws + WS_RB);
    const float* mu = P.mu + (size_t)layer * 1984; const float* mu_v = P.mu_v;
    const float* w0 = P.w0 + layer * 512; const float* a0 = P.a0 + layer * 512; const float* v0 = P.v0; const float* k_k = P.k_k + layer * 512; const float* k_a = P.k_a + layer * 512;
    const int tid = C.tid, lane = C.lane, wid = C.wave;
    constexpr int NU = M / 32;
    u32x4 ncur[2], nprv[2];
#define RW1_LOAD(uu) do { _Pragma("unroll") for (int j = 0; j < 2; ++j) { const int ci = tid + 512 * j, tok = ci >> 5, c8 = (ci & 31) * 8; const size_t mm = (size_t)(uu) * 32 + tok; \
        ncur[j] = *(const u32x4*)(CL + mm * 256 + c8); const u32x4 z4 = {0u, 0u, 0u, 0u}; nprv[j] = (mm & (T - 1)) == 0 ? z4 : *(const u32x4*)(CL + (mm - 1) * 256 + c8); } } while (0)
#define RW1_STORE(bufi) do { _Pragma("unroll") for (int j = 0; j < 2; ++j) { const int ci = tid + 512 * j, tok = ci >> 5, c8 = (ci & 31) * 8; \
        const float* mp = c8 < 192 ? mu + 1536 + c8 : mu_v + (c8 - 192); f32x4 m0v = {0.f, 0.f, 0.f, 0.f}, m1v = m0v; if (c8 < 192 || layer > 0) { m0v = *(const f32x4*)mp; m1v = *(const f32x4*)(mp + 4); } \
        float xs[8]; _Pragma("unroll") for (int e = 0; e < 4; ++e) { const float c0 = bflo(ncur[j][e]), c1 = bfhi(ncur[j][e]), p0 = bflo(nprv[j][e]), p1 = bfhi(nprv[j][e]); \
            const float ma = e < 2 ? m0v[2 * e] : m1v[2 * e - 4], mb = e < 2 ? m0v[2 * e + 1] : m1v[2 * e - 3]; xs[2 * e] = c0 + (p0 - c0) * ma; xs[2 * e + 1] = c1 + (p1 - c1) * mb; } \
        if (c8 < 96) { _Pragma("unroll") for (int e = 0; e < 8; ++e) xs[e] = 1.0f - 2.0f * __builtin_amdgcn_rcpf(__expf(2.0f * xs[e]) + 1.0f); }     \
        u32x4 o; o.x = pk2(xs[0], xs[1]); o.y = pk2(xs[2], xs[3]); o.z = pk2(xs[4], xs[5]); o.w = pk2(xs[6], xs[7]); \
        LAS bf16* dst = ACT + (bufi) * RW1_BUF + (c8 < 96 ? tok * RW_AW + c8 : c8 < 192 ? 32 * RW_AW + tok * RW_AW + (c8 - 96) : 64 * RW_AW + tok * RW_AV + (c8 - 192)); \
        *(LAS u32x4*)dst = o; } } while (0)
    int u = C.bid; if (u >= NU) return;
    RW1_LOAD(u); RW1_STORE(0); __syncthreads();
    for (int kbuf = 0; ; kbuf ^= 1) {
        const int un = u + C.G; const bool has_next = un < NU;
        if (has_next) RW1_LOAD(un);
        {
            int r32 = lane & 31, hi = lane >> 5; asm volatile("" : "+v"(r32), "+v"(hi));
            const size_t m0 = (size_t)u * 32; const bool first_unit = (m0 & (T - 1)) == 0;
            const LAS bf16* AW = ACT + kbuf * RW1_BUF; const LAS bf16* AA = AW + 32 * RW_AW; const LAS bf16* AV = AA + 32 * RW_AW;
            unsigned off[16];
#pragma unroll
            for (int r = 0; r < 16; ++r) off[r] = (unsigned)(tokr(r, hi) * 512 + 64 * wid + r32) * 2u;
            GAS bf16* CRu = opaque_g(CR + m0 * 512); GAS bf16* CKu = opaque_g(CK + m0 * 512); GAS bf16* CVu = opaque_g(CV + m0 * 512); GAS bf16* VFu = opaque_g(VF + m0 * 512);
            GAS bf16* RRu = opaque_g(RR + m0 * 512); GAS bf16* RUu = opaque_g(RU + m0 * 512); GAS bf16* RKHu = opaque_g(RKH + m0 * 512); GAS bf16* RVu = opaque_g(RV + m0 * 512); GAS bf16* RAu = opaque_g(RA + m0 * 512); GAS bf16* RBu = opaque_g(RB + m0 * 512);
            float ks[2][16], inv[16];
            {
                float ssr[16];
#pragma unroll
                for (int r = 0; r < 16; ++r) ssr[r] = 0.f;
#pragma unroll
                for (int cb = 0; cb < 2; ++cb) { const int c = 64 * wid + 32 * cb + r32; const float kkc = k_k[c]; shifted16(CKu, off, 32 * cb, first_unit, hi, mu[512 + c], ks[cb]);
#pragma unroll
                    for (int r = 0; r < 16; ++r) { const float kr = ks[cb][r] * kkc; ssr[r] += kr * kr; } }
#pragma unroll
                for (int r = 0; r < 16; ++r) inv[r] = 1.0f / fmaxf(sqrtf(half_sum32(ssr[r])), 1e-12f);
            }
#pragma unroll
            for (int cb = 0; cb < 2; ++cb) {
                const int c = 64 * wid + 32 * cb + r32; const int ci = 32 * cb;
                asm volatile("" : "+v"(off[0]), "+v"(off[1]), "+v"(off[2]), "+v"(off[3]), "+v"(off[4]), "+v"(off[5]), "+v"(off[6]), "+v"(off[7]), "+v"(off[8]), "+v"(off[9]), "+v"(off[10]), "+v"(off[11]), "+v"(off[12]), "+v"(off[13]), "+v"(off[14]), "+v"(off[15]));
                {
                    float rs[16]; shifted16(CRu, off, ci, first_unit, hi, mu[c], rs);
#pragma unroll
                    for (int r = 0; r < 16; ++r) at_b(RRu, off[r])[ci] = (bf16)f2bf(rs[r]);
                }
                asm volatile("" ::: "memory");
                {
                    float vs[16]; shifted16(CVu, off, ci, first_unit, hi, mu[1024 + c], vs);
                    if (layer > 0) {
                        f32x16 dv;
#pragma unroll
                        for (int r = 0; r < 16; ++r) dv[r] = 0.f;
#pragma unroll
                        for (int kk = 0; kk < 4; ++kk) { const bf16x8 wv = *(const bf16x8*)(LV + c * 64 + 16 * kk + 8 * hi); const bf16x8 xv = *(const LAS bf16x8*)(AV + r32 * RW_AV + 16 * kk + 8 * hi);
                            dv = __builtin_amdgcn_mfma_f32_32x32x16_bf16(xv, wv, dv, 0, 0, 0); }
                        const float v0c = v0[c];
#pragma unroll
                        for (int r = 0; r < 16; ++r) { const float vf = bf2f(at_b(VFu, off[r])[ci]); at_b(RVu, off[r])[ci] = (bf16)f2bf(vs[r] + (vf - vs[r]) * sigmoidf_(v0c + dv[r])); }
                    } else {
#pragma unroll
                        for (int r = 0; r < 16; ++r) { const bf16 vb = (bf16)f2bf(vs[r]); at_b(VFu, off[r])[ci] = vb; at_b(RVu, off[r])[ci] = vb; }
                    }
                }
                asm volatile("" ::: "memory");
                {
                    f32x16 dw;
#pragma unroll
                    for (int r = 0; r < 16; ++r) dw[r] = 0.f;
#pragma unroll
                    for (int kk = 0; kk < 6; ++kk) { const bf16x8 ww = *(const bf16x8*)(LW + c * 96 + 16 * kk + 8 * hi); const bf16x8 xw = *(const LAS bf16x8*)(AW + r32 * RW_AW + 16 * kk + 8 * hi);
                        dw = __builtin_amdgcn_mfma_f32_32x32x16_bf16(xw, ww, dw, 0, 0, 0); }
                    const float w0c = w0[c];
#pragma unroll
                    for (int r = 0; r < 16; ++r) { const float z = -(w0c + dw[r]); const float sp = fmaxf(z, 0.f) + __logf(1.0f + __expf(-fabsf(z)));
                        at_b(RUu, off[r])[ci] = (bf16)f2bf(1.0f - __expf(-__expf(-sp - 0.5f))); }
                }
                asm volatile("" ::: "memory");
                {
                    f32x16 da;
#pragma unroll
                    for (int r = 0; r < 16; ++r) da[r] = 0.f;
#pragma unroll
                    for (int kk = 0; kk < 6; ++kk) { const bf16x8 wa = *(const bf16x8*)(LA + c * 96 + 16 * kk + 8 * hi); const bf16x8 xa = *(const LAS bf16x8*)(AA + r32 * RW_AW + 16 * kk + 8 * hi);
                        da = __builtin_amdgcn_mfma_f32_32x32x16_bf16(xa, wa, da, 0, 0, 0); }
                    const float a0c = a0[c], kkc = k_k[c], kac = k_a[c];
#pragma unroll
                    for (int r = 0; r < 16; ++r) { const float a = sigmoidf_(a0c + da[r]); const float ksx = ks[cb][r]; const float kk = ksx * kkc * inv[r];
                        at_b(RKHu, off[r])[ci] = (bf16)f2bf(ksx * (1.0f + (a - 1.0f) * kac)); at_b(RAu, off[r])[ci] = (bf16)f2bf(-kk); at_b(RBu, off[r])[ci] = (bf16)f2bf(kk * a); }
                }
                asm volatile("" ::: "memory");
            }
        }
        if (has_next) RW1_STORE(kbuf ^ 1);
        __syncthreads();
        if (!has_next) break;
        u = un;
    }
#undef RW1_LOAD
#undef RW1_STORE
}
constexpr int RW_L = 128, RW_NC = T / RW_L;
constexpr int RW_TB = 8, RW_STG = 5 * RW_TB * 64 + 64;
__device__ __forceinline__ float xhalf_sum(float x) { const auto rr = __builtin_amdgcn_permlane32_swap(__float_as_uint(x), __float_as_uint(x), false, false); return __uint_as_float(rr[0]) + __uint_as_float(rr[1]); }
__device__ __forceinline__ float dot32(const f32x16& d0, const f32x16& d1, const f32x4 (&v)[2][4]) {
    f32x2 acc = {0.f, 0.f};
#pragma unroll
    for (int g = 0; g < 4; ++g) { acc += (f32x2){d0[4 * g], d0[4 * g + 1]} * (f32x2){v[0][g].x, v[0][g].y}; acc += (f32x2){d0[4 * g + 2], d0[4 * g + 3]} * (f32x2){v[0][g].z, v[0][g].w};
        acc += (f32x2){d1[4 * g], d1[4 * g + 1]} * (f32x2){v[1][g].x, v[1][g].y}; acc += (f32x2){d1[4 * g + 2], d1[4 * g + 3]} * (f32x2){v[1][g].z, v[1][g].w}; }
    return acc.x + acc.y;
}
template <int NS, bool OUT>
__device__ __forceinline__ void rwkv_chunk(f32x16 (&D)[NS][2][2], LAS float* stg, const bf16* RWd, const bf16* RA, const bf16* RB, const bf16* RKH, const bf16* RV, const bf16* RR, float* Y, size_t base0, int nsteps, int lane) {
    const int r32 = lane & 31, hi = lane >> 5;
    unsigned short qw[RW_TB], qa[RW_TB], qr[RW_TB], qb[RW_TB], qk[RW_TB], qv[RW_TB];
#define RWC_LOAD(tt) do { _Pragma("unroll") for (int s = 0; s < RW_TB; ++s) { const size_t o = base0 + (size_t)((tt) + s) * 512 + lane; qw[s] = RWd[o]; qa[s] = RA[o]; if (OUT) qr[s] = RR[o]; qb[s] = RB[o]; qk[s] = RKH[o]; qv[s] = RV[o]; } } while (0)
    RWC_LOAD(0);
    float G = 1.0f;
    for (int t0 = 0; t0 < nsteps; t0 += RW_TB) {
#pragma unroll
        for (int s = 0; s < RW_TB; ++s) { const float w = 1.0f - bf2f(qw[s]); stg[(0 * RW_TB + s) * 64 + lane] = bf2f(qa[s]) * G; G *= w; const float ig = __builtin_amdgcn_rcpf(G);
            if (OUT) stg[(1 * RW_TB + s) * 64 + lane] = bf2f(qr[s]) * G; stg[(2 * RW_TB + s) * 64 + lane] = bf2f(qb[s]) * ig; stg[(3 * RW_TB + s) * 64 + lane] = bf2f(qk[s]) * ig; stg[(4 * RW_TB + s) * 64 + lane] = bf2f(qv[s]); }
        if (t0 + RW_TB < nsteps) RWC_LOAD(t0 + RW_TB);
        LDS_WAIT(); asm volatile("" ::: "memory");
#pragma unroll 1
        for (int s = 0; s < RW_TB; ++s) {
            const LAS float* sa_ = stg + (0 * RW_TB + s) * 64 + 4 * hi; const LAS float* sr = stg + (1 * RW_TB + s) * 64 + 4 * hi;
            const LAS float* sbk = stg + ((hi ? 3 : 2) * RW_TB + s) * 64 + r32; const LAS float* sv = stg + (4 * RW_TB + s) * 64 + r32;
            const float bk0 = sbk[0], bk1 = sbk[32], v0 = sv[0], v1 = sv[32];
            float sav[NS][2];
            {
                f32x4 av[2][4];
#pragma unroll
                for (int jb = 0; jb < 2; ++jb)
#pragma unroll
                    for (int g = 0; g < 4; ++g) av[jb][g] = *(const LAS f32x4*)(sa_ + 32 * jb + 8 * g);
#pragma unroll
                for (int st = 0; st < NS; ++st)
#pragma unroll
                    for (int ib = 0; ib < 2; ++ib) sav[st][ib] = xhalf_sum(dot32(D[st][0][ib], D[st][1][ib], av));
            }
#pragma unroll
            for (int st = 0; st < NS; ++st) {
                const bool inject = (NS == 1) || (st == 1);
#pragma unroll
                for (int jb = 0; jb < 2; ++jb) { const float bkj = jb == 0 ? bk0 : bk1; const float A = inject ? bkj : (hi ? 0.f : bkj);
#pragma unroll
                    for (int ib = 0; ib < 2; ++ib) { const float B = hi ? (ib == 0 ? v0 : v1) : sav[st][ib];
                        D[st][jb][ib] = __builtin_amdgcn_mfma_f32_32x32x2f32(A, B, D[st][jb][ib], 0, 0, 0); } }
            }
            if (OUT) {
                f32x4 rv[2][4];
#pragma unroll
                for (int jb = 0; jb < 2; ++jb)
#pragma unroll
                    for (int g = 0; g < 4; ++g) rv[jb][g] = *(const LAS f32x4*)(sr + 32 * jb + 8 * g);
#pragma unroll
                for (int ib = 0; ib < 2; ++ib) { const float y = xhalf_sum(dot32(D[NS - 1][0][ib], D[NS - 1][1][ib], rv));
                    if (hi == 0) Y[base0 + (size_t)(t0 + s) * 512 + 32 * ib + r32] = y; }
            }
        }
        LDS_WAIT(); asm volatile("" ::: "memory");
    }
#undef RWC_LOAD
    stg[5 * RW_TB * 64 + lane] = G;
    LDS_WAIT(); asm volatile("" ::: "memory");
    {
        f32x4 gv[2][4];
#pragma unroll
        for (int jb = 0; jb < 2; ++jb)
#pragma unroll
            for (int g = 0; g < 4; ++g) gv[jb][g] = *(const LAS f32x4*)(stg + 5 * RW_TB * 64 + 4 * hi + 32 * jb + 8 * g);
#pragma unroll
        for (int st = 0; st < NS; ++st)
#pragma unroll
            for (int jb = 0; jb < 2; ++jb)
#pragma unroll
                for (int ib = 0; ib < 2; ++ib)
#pragma unroll
                    for (int g = 0; g < 4; ++g) { f32x16& d = D[st][jb][ib]; d[4 * g] *= gv[jb][g].x; d[4 * g + 1] *= gv[jb][g].y; d[4 * g + 2] *= gv[jb][g].z; d[4 * g + 3] *= gv[jb][g].w; }
    }
    LDS_WAIT(); asm volatile("" ::: "memory");
}
__device__ __forceinline__ void phase_rw2(const Ctx& C) {
    const bf16* RWd = (const bf16*)(C.ws + WS_RW); const bf16* RA = (const bf16*)(C.ws + WS_RA); const bf16* RB = (const bf16*)(C.ws + WS_RB); const bf16* RKH = (const bf16*)(C.ws + WS_RKH); const bf16* RV = (const bf16*)(C.ws + WS_RV);
    float* PHI = (float*)(C.ws + WS_PHI); float* PSI = (float*)(C.ws + WS_PSI);
    LAS float* stg = (LAS float*)C.lds + C.wave * RW_STG;
    const int ntask = NB * 8 * RW_NC, r32 = C.lane & 31, hi = C.lane >> 5;
    for (int task = C.wave * C.G + C.bid; task < ntask; task += C.G * NWAVES) {
        const int ck = task % RW_NC, bh = task / RW_NC, h = bh & 7, b = bh >> 3;
        const size_t base0 = ((size_t)b * T + (size_t)ck * RW_L) * 512 + h * 64;
        f32x16 D[2][2][2];
#pragma unroll
        for (int jb = 0; jb < 2; ++jb)
#pragma unroll
            for (int ib = 0; ib < 2; ++ib)
#pragma unroll
                for (int r = 0; r < 16; ++r) { D[0][jb][ib][r] = (jb == ib && ((r & 3) + 8 * (r >> 2) + 4 * hi) == r32) ? 1.f : 0.f; D[1][jb][ib][r] = 0.f; }
        rwkv_chunk<2, false>(D, stg, RWd, RA, RB, RKH, RV, nullptr, nullptr, base0, RW_L, C.lane);
#pragma unroll
        for (int st = 0; st < 2; ++st) { float* dst = (st == 0 ? PHI : PSI) + (size_t)task * 4096;
#pragma unroll
            for (int jb = 0; jb < 2; ++jb)
#pragma unroll
                for (int ib = 0; ib < 2; ++ib)
#pragma unroll
                    for (int g = 0; g < 4; ++g) *(f32x4*)(dst + (32 * ib + r32) * 64 + 32 * jb + 8 * g + 4 * hi) = (f32x4){D[st][jb][ib][4 * g], D[st][jb][ib][4 * g + 1], D[st][jb][ib][4 * g + 2], D[st][jb][ib][4 * g + 3]}; }
    }
}
constexpr int R3_P = 65;
__device__ __forceinline__ void phase_rw3(const Ctx& C) {
    const float* PHI = (const float*)(C.ws + WS_PHI); const float* PSI = (const float*)(C.ws + WS_PSI); float* SST = (float*)(C.ws + WS_SST);
    const int half = C.wave >> 2, w4 = C.wave & 3, ibo = w4 >> 1, kb = w4 & 1, r32 = C.lane & 31, hi = C.lane >> 5;
    LAS float* Sl = (LAS float*)C.lds + half * (2 * 64 * R3_P);
    for (int pr = C.bid; pr < NB * 8 / 2; pr += C.G) {
        const int bh = 2 * pr + half;
        f32x16 acc;
#pragma unroll
        for (int r = 0; r < 16; ++r) acc[r] = 0.f;
        float ph[32], psn[16];
#define R3_LOAD(tk) do { _Pragma("unroll") for (int s = 0; s < 32; ++s) ph[s] = PHI[(tk) * 4096 + (2 * s + hi) * 64 + 32 * kb + r32]; \
        _Pragma("unroll") for (int r = 0; r < 16; ++r) psn[r] = PSI[(tk) * 4096 + (32 * ibo + (r & 3) + 8 * (r >> 2) + 4 * hi) * 64 + 32 * kb + r32]; } while (0)
        R3_LOAD((size_t)bh * RW_NC);
        for (int ck = 0; ck < RW_NC; ++ck) {
            const size_t task = (size_t)bh * RW_NC + ck; LAS float* Sb = Sl + (ck & 1) * (64 * R3_P);
            float* dst = SST + task * 4096;
#pragma unroll
            for (int r = 0; r < 16; ++r) { const int i = 32 * ibo + (r & 3) + 8 * (r >> 2) + 4 * hi; dst[i * 64 + 32 * kb + r32] = acc[r]; Sb[i * R3_P + 32 * kb + r32] = acc[r]; }
            if (ck + 1 == RW_NC) break;
            float pc[32];
#pragma unroll
            for (int s = 0; s < 32; ++s) pc[s] = ph[s];
#pragma unroll
            for (int r = 0; r < 16; ++r) acc[r] = psn[r];
            if (ck + 2 < RW_NC) R3_LOAD(task + 1);
            __syncthreads();
#pragma unroll
            for (int s = 0; s < 32; ++s) { const float a = Sb[(32 * ibo + r32) * R3_P + 2 * s + hi]; acc = __builtin_amdgcn_mfma_f32_32x32x2f32(a, pc[s], acc, 0, 0, 0); }
        }
#undef R3_LOAD
        __syncthreads();
    }
}
__device__ __forceinline__ void phase_rw4(const Ctx& C) {
    const bf16* RWd = (const bf16*)(C.ws + WS_RW); const bf16* RA = (const bf16*)(C.ws + WS_RA); const bf16* RB = (const bf16*)(C.ws + WS_RB); const bf16* RKH = (const bf16*)(C.ws + WS_RKH); const bf16* RV = (const bf16*)(C.ws + WS_RV); const bf16* RR = (const bf16*)(C.ws + WS_RR);
    const float* SST = (const float*)(C.ws + WS_SST); float* Y = (float*)(C.ws + WS_Y);
    LAS float* stg = (LAS float*)C.lds + C.wave * RW_STG;
    const int ntask = NB * 8 * RW_NC, r32 = C.lane & 31, hi = C.lane >> 5;
    for (int task = C.wave * C.G + C.bid; task < ntask; task += C.G * NWAVES) {
        const int ck = task % RW_NC, bh = task / RW_NC, h = bh & 7, b = bh >> 3;
        const size_t base0 = ((size_t)b * T + (size_t)ck * RW_L) * 512 + h * 64;
        f32x16 D[1][2][2]; const float* src = SST + (size_t)task * 4096;
#pragma unroll
        for (int jb = 0; jb < 2; ++jb)
#pragma unroll
            for (int ib = 0; ib < 2; ++ib)
#pragma unroll
                for (int g = 0; g < 4; ++g) { const f32x4 v = *(const f32x4*)(src + (32 * ib + r32) * 64 + 32 * jb + 8 * g + 4 * hi); D[0][jb][ib][4 * g] = v.x; D[0][jb][ib][4 * g + 1] = v.y; D[0][jb][ib][4 * g + 2] = v.z; D[0][jb][ib][4 * g + 3] = v.w; }
        rwkv_chunk<1, true>(D, stg, RWd, RA, RB, RKH, RV, RR, Y, base0, RW_L, C.lane);
    }
}
__device__ __forceinline__ void phase_rw5(const Ctx& C, int layer, const RwP& P) {
    LAS bf16* ACT = (LAS bf16*)C.lds;
    const bf16* CG = (const bf16*)(C.ws + WS_CG); const bf16* LG = (const bf16*)(C.ws + WS_LORA + LO_G);
    const float* Y = (const float*)(C.ws + WS_Y); const bf16* RR = (const bf16*)(C.ws + WS_RR); const bf16* RKH = (const bf16*)(C.ws + WS_RKH); const bf16* RV = (const bf16*)(C.ws + WS_RV);
    bf16* CAT = (bf16*)(C.ws + WS_CAT);
    const float* mu = P.mu + (size_t)layer * 1984 + 1728; const float* r_k = P.r_k + layer * 512; const float* lnx_g = P.lnx_g + layer * 512; const float* lnx_b = P.lnx_b + layer * 512;
    const int tid = C.tid, lane = C.lane, wid = C.wave;
    constexpr int NU = M / 32;
    u32x4 ncur[2], nprv[2];
#define RW5_LOAD(uu) do { _Pragma("unroll") for (int j = 0; j < 2; ++j) { const int ci = tid + 512 * j, tok = ci >> 5, c8 = (ci & 31) * 8; const size_t mm = (size_t)(uu) * 32 + tok; \
        ncur[j] = *(const u32x4*)(CG + mm * 256 + c8); const u32x4 z4 = {0u, 0u, 0u, 0u}; nprv[j] = (mm & (T - 1)) == 0 ? z4 : *(const u32x4*)(CG + (mm - 1) * 256 + c8); } } while (0)
#define RW5_STORE(bufi) do { _Pragma("unroll") for (int j = 0; j < 2; ++j) { const int ci = tid + 512 * j, tok = ci >> 5, c8 = (ci & 31) * 8; \
        const f32x4 m0v = *(const f32x4*)(mu + c8), m1v = *(const f32x4*)(mu + c8 + 4); \
        float xs[8]; _Pragma("unroll") for (int e = 0; e < 4; ++e) { const float c0 = bflo(ncur[j][e]), c1 = bfhi(ncur[j][e]), p0 = bflo(nprv[j][e]), p1 = bfhi(nprv[j][e]); \
            const float ma = e < 2 ? m0v[2 * e] : m1v[2 * e - 4], mb = e < 2 ? m0v[2 * e + 1] : m1v[2 * e - 3]; xs[2 * e] = sigmoidf_(c0 + (p0 - c0) * ma); xs[2 * e + 1] = sigmoidf_(c1 + (p1 - c1) * mb); } \
        u32x4 o; o.x = pk2(xs[0], xs[1]); o.y = pk2(xs[2], xs[3]); o.z = pk2(xs[4], xs[5]); o.w = pk2(xs[6], xs[7]); \
        *(LAS u32x4*)(ACT + (bufi) * (32 * RW_AG) + tok * RW_AG + c8) = o; } } while (0)
    int u = C.bid; if (u >= NU) return;
    RW5_LOAD(u); RW5_STORE(0); __syncthreads();
    for (int kbuf = 0; ; kbuf ^= 1) {
        const int un = u + C.G; const bool has_next = un < NU;
        if (has_next) RW5_LOAD(un);
        {
            int r32 = lane & 31, hi = lane >> 5; asm volatile("" : "+v"(r32), "+v"(hi));
            const size_t m0 = (size_t)u * 32; const LAS bf16* AG = ACT + kbuf * (32 * RW_AG);
            unsigned off[16];
#pragma unroll
            for (int r = 0; r < 16; ++r) off[r] = (unsigned)(tokr(r, hi) * 512 + 64 * wid + r32) * 2u;
            GAS float* Yu = opaque_g(Y + m0 * 512); GAS bf16* RRu = opaque_g(RR + m0 * 512); GAS bf16* RKHu = opaque_g(RKH + m0 * 512); GAS bf16* RVu = opaque_g(RV + m0 * 512); GAS bf16* CATu = opaque_g(CAT + m0 * 2048 + 1536);
            float yv[2][16], sy[16], sq[16], sb[16];
#pragma unroll
            for (int r = 0; r < 16; ++r) { sy[r] = 0.f; sq[r] = 0.f; sb[r] = 0.f; }
#pragma unroll
            for (int cb = 0; cb < 2; ++cb) { const int c = 64 * wid + 32 * cb + r32; const float rkc = r_k[c];
                asm volatile("" : "+v"(off[0]), "+v"(off[1]), "+v"(off[2]), "+v"(off[3]), "+v"(off[4]), "+v"(off[5]), "+v"(off[6]), "+v"(off[7]), "+v"(off[8]), "+v"(off[9]), "+v"(off[10]), "+v"(off[11]), "+v"(off[12]), "+v"(off[13]), "+v"(off[14]), "+v"(off[15]));
#pragma unroll
                for (int r = 0; r < 16; ++r) { const unsigned o = off[r]; const int ci = 32 * cb; const float y = at_b(Yu, 2u * o)[ci]; yv[cb][r] = y; sy[r] += y; sq[r] += y * y; sb[r] += bf2f(at_b(RRu, o)[ci]) * bf2f(at_b(RKHu, o)[ci]) * rkc; } }
#pragma unroll
            for (int r = 0; r < 16; ++r) { const float mean = half_sum32(sy[r]) * (1.0f / 64.0f); const float ex2 = half_sum32(sq[r]) * (1.0f / 64.0f); sb[r] = half_sum32(sb[r]);
                sy[r] = mean; sq[r] = rsqrtf(fmaxf(ex2 - mean * mean, 0.f) + 64e-5f); }
#pragma unroll
            for (int cb = 0; cb < 2; ++cb) { const int c = 64 * wid + 32 * cb + r32;
                f32x16 dg;
#pragma unroll
                for (int r = 0; r < 16; ++r) dg[r] = 0.f;
#pragma unroll
                for (int kk = 0; kk < 16; ++kk) { const bf16x8 wg = *(const bf16x8*)(LG + c * 256 + 16 * kk + 8 * hi); const bf16x8 xg = *(const LAS bf16x8*)(AG + r32 * RW_AG + 16 * kk + 8 * hi);
                    dg = __builtin_amdgcn_mfma_f32_32x32x16_bf16(xg, wg, dg, 0, 0, 0); }
                const float lgc = lnx_g[c], lbc = lnx_b[c];
#pragma unroll
                for (int r = 0; r < 16; ++r) { const unsigned o = off[r]; const int ci = 32 * cb; const float v = bf2f(at_b(RVu, o)[ci]);
                    at_b(CATu, (unsigned)(tokr(r, hi) * 2048 + 64 * wid + r32) * 2u)[ci] = (bf16)f2bf(((yv[cb][r] - sy[r]) * sq[r] * lgc + lbc + sb[r] * v) * dg[r]); }
            }
        }
        if (has_next) RW5_STORE(kbuf ^ 1);
        __syncthreads();
        if (!has_next) break;
        u = un;
    }
#undef RW5_LOAD
#undef RW5_STORE
}
__device__ __forceinline__ void* launder_ptr(const void* p) {
    unsigned lo = (unsigned)(uintptr_t)p, hi = (unsigned)((uintptr_t)p >> 32); asm volatile("" : "+v"(lo), "+v"(hi));
    lo = __builtin_amdgcn_readfirstlane(lo); hi = __builtin_amdgcn_readfirstlane(hi); return (void*)(((uintptr_t)hi << 32) | lo);
}
#ifndef MK_PER_PHASE
#define MK_PER_PHASE 0
#endif
constexpr int PH_PER_LAYER = 13, N_PHASES = DEPTH * PH_PER_LAYER + 1;
struct Args { const float* in[23]; float* out; unsigned char* ws; int ph_lo, ph_hi; };
#define FRESH() do { KA = (const CAS Args*)launder_ptr((const void*)(uintptr_t)__builtin_amdgcn_kernarg_segment_ptr()); C.ws = KA->ws; C.out = KA->out; ctl = (unsigned*)(C.ws + WS_CTL); asm volatile("" : "+v"(C.tid)); C.lane = C.tid & 63; C.wave = __builtin_amdgcn_readfirstlane(C.tid >> 6); C.lds = (LAS unsigned char*)lds_raw; } while (0)
#ifndef ATT_REP
#define ATT_REP 1
#endif
#ifndef REP_MASK
#define REP_MASK 0u
#endif
#ifndef ONLY_PH
#define ONLY_PH -1
#endif
#ifndef PH_MASK
#define PH_MASK 0xFFFFFFFFu
#endif
#define IN(k) (lo <= (k) && (k) < hi && (ONLY_PH < 0 || ((k) % PH_PER_LAYER) == ONLY_PH) && ((PH_MASK >> ((k) % PH_PER_LAYER)) & 1u))
#define SEAM(k) do { if (IN(k) && IN((k) + 1)) { bar.bar = ctl + CW_BAR; xcd_barrier(bar); } } while (0)
#define PH_BODY(k, ...) do { FRESH(); if (IN(p0 + (k))) { __VA_ARGS__; if ((REP_MASK >> (k)) & 1u) { xcd_barrier(bar); FRESH(); __VA_ARGS__; } } SEAM(p0 + (k)); } while (0)
template <int layer>
__device__ __forceinline__ void layer_phases(Ctx& C, const CAS Args*& KA, XcdBarrier& bar, unsigned*& ctl, unsigned char* lds_raw, const int lo, const int hi) {
    const int p0 = layer * PH_PER_LAYER;
    PH_BODY(0, { const WSrc W{KA->in[2], KA->in[3], KA->in[18], KA->in[20], KA->in[21], KA->in[7], KA->in[9], KA->in[12], KA->in[11]}; phase_wconv(C, layer, W);
                 if (layer == 0) phase_xg(C, KA->in[0], KA->in[1], (bf16*)(C.ws + WS_H), (float*)(C.ws + WS_SS1)); });
    PH_BODY(1, { pg8::Gemm g{(const pg8::bf16_t*)(C.ws + WS_H), (const pg8::bf16_t*)(C.ws + WS_WIN), M, N_INP, DM}; pg8::StaticOrder S; S.init(M, N_INP, C.G, C.bid);
                 pg8::EpiProj E{C.ws, (const float*)(C.ws + WS_SS1)}; pg8::gemm_phase<pg8::EpiProj, pg8::StaticOrder, true, true>(C.lds, g, S, E); });
    FRESH(); if (IN(p0 + 2)) phase_prep_a(C); SEAM(p0 + 2);
    PH_BODY(3, { phase_indexer(C); __syncthreads(); phase_ret1(C); });
    FRESH(); if (IN(p0 + 4)) { for (int rep_a = 0; rep_a < ATT_REP; ++rep_a) { phase_attn(C); __syncthreads(); } phase_ret2(C); } SEAM(p0 + 4);
    PH_BODY(5, { const RwP P{KA->in[4], KA->in[5], KA->in[6], KA->in[8], KA->in[10], KA->in[13], KA->in[14], KA->in[15], KA->in[16], KA->in[17]}; phase_rw1(C, layer, P); });
    PH_BODY(6, { phase_rw2(C); });
    PH_BODY(7, { if (C.G > 32) { if (C.bid < 16) phase_rw3(C); else { Ctx C2 = C; C2.bid = C.bid - 16; C2.G = C.G - 16; phase_ret3(C2); } } else { phase_rw3(C); __syncthreads(); phase_ret3(C); } });
    PH_BODY(8, { phase_rw4(C); });
    PH_BODY(9, { const RwP P{KA->in[4], KA->in[5], KA->in[6], KA->in[8], KA->in[10], KA->in[13], KA->in[14], KA->in[15], KA->in[16], KA->in[17]}; phase_rw5(C, layer, P); });
    FRESH(); if (IN(p0 + 10)) { const float* xin = layer == 0 ? KA->in[0] : C.out;
        pg8::Gemm g{(const pg8::bf16_t*)(C.ws + WS_CAT), (const pg8::bf16_t*)(C.ws + WS_WOUT), M, DM, DM}; pg8::StaticOrder S; S.init(M, DM, C.G, C.bid);
        pg8::EpiResid E{xin, C.out, DM, KA->in[19] + layer * DM, (pg8::bf16_t*)(C.ws + WS_H2), (float*)(C.ws + WS_SS2)}; pg8::gemm_phase<pg8::EpiResid, pg8::StaticOrder, true, true>(C.lds, g, S, E); }
    SEAM(p0 + 10);
    PH_BODY(11, { pg8::Gemm g{(const pg8::bf16_t*)(C.ws + WS_H2), (const pg8::bf16_t*)(C.ws + WS_WGU), M, 2 * DFF, DM}; pg8::StaticOrder S; S.init(M, 2 * DFF, C.G, C.bid);
                  pg8::EpiSwiGLU E{(pg8::bf16_t*)(C.ws + WS_ACT), DFF, (const float*)(C.ws + WS_SS2)}; pg8::gemm_phase<pg8::EpiSwiGLU, pg8::StaticOrder, true, true>(C.lds, g, S, E); });
    FRESH(); if (IN(p0 + 12)) { pg8::Gemm g{(const pg8::bf16_t*)(C.ws + WS_ACT), (const pg8::bf16_t*)(C.ws + WS_WDN), M, DM, DFF}; pg8::StaticOrder S; S.init(M, DM, C.G, C.bid);
        pg8::EpiResid E{C.out, C.out, DM, layer + 1 < DEPTH ? KA->in[1] + (layer + 1) * DM : KA->in[22], layer + 1 < DEPTH ? (pg8::bf16_t*)(C.ws + WS_H) : nullptr, (float*)(C.ws + WS_SS1)};
        pg8::gemm_phase<pg8::EpiResid, pg8::StaticOrder, true, true>(C.lds, g, S, E); }
    SEAM(p0 + 12);
}
__global__ void __launch_bounds__(NTHR, 2) fwd_kernel(Args args) {
    extern __shared__ __attribute__((aligned(16))) unsigned char lds_raw[];
    Ctx C;
    C.lds = (LAS unsigned char*)lds_raw; C.tid = threadIdx.x; C.lane = C.tid & 63; C.wave = __builtin_amdgcn_readfirstlane(C.tid >> 6);
    C.G = gridDim.x; C.bid = blockIdx.x;
    const CAS Args* KA = (const CAS Args*)launder_ptr((const void*)(uintptr_t)__builtin_amdgcn_kernarg_segment_ptr());
    C.ws = KA->ws; C.out = KA->out;
    volatile LAS unsigned* MISC = (volatile LAS unsigned*)(C.lds + MISC_OFF);
    if (C.tid < 32) MISC[C.tid] = 0u;
    __syncthreads();
    unsigned* ctl = (unsigned*)(C.ws + WS_CTL);
    XcdBarrier bar; bar.bar = ctl + CW_BAR; bar.x = 0; bar.st = nullptr;
    if (!MK_PER_PHASE) bar = xcd_barrier_post(ctl + CW_BAR, MISC + 8);
    const int lo = KA->ph_lo, hi = KA->ph_hi;
    layer_phases<0>(C, KA, bar, ctl, lds_raw, lo, hi);
    layer_phases<1>(C, KA, bar, ctl, lds_raw, lo, hi);
    FRESH(); if (IN(N_PHASES - 1)) phase_final_norm(C, C.out, KA->in[22], (const float*)(C.ws + WS_SS1));
#undef IN
#undef SEAM
}

extern "C" void kernel_launch(void* const* d_in, const int* in_sizes, int n_in, void* d_out, int out_size, void* d_ws, size_t ws_size, hipStream_t stream) {
    static int grid = 0;
    if (grid == 0) {
        if (n_in != 23 || out_size != M * DM || ws_size < WS_NEED) { fprintf(stderr, "kernel_launch: unexpected problem (n_in %d, out %d, ws %zu); nothing launched\n", n_in, out_size, ws_size); grid = -1; return; }
        int dev = 0, cus = 0, per_cu = 0;
        if (hipGetDevice(&dev) != hipSuccess || hipDeviceGetAttribute(&cus, hipDeviceAttributeMultiprocessorCount, dev) != hipSuccess) { grid = -1; return; }
        if (hipFuncSetAttribute((const void*)fwd_kernel, hipFuncAttributeMaxDynamicSharedMemorySize, LDS_BYTES) != hipSuccess) { fprintf(stderr, "kernel_launch: hipFuncSetAttribute failed\n"); grid = -1; return; }
        if (hipOccupancyMaxActiveBlocksPerMultiprocessor(&per_cu, (const void*)fwd_kernel, NTHR, LDS_BYTES) != hipSuccess || per_cu < 1) { fprintf(stderr, "kernel_launch: occupancy query says %d blocks per CU\n", per_cu); }
        (void)hipGetLastError();
        grid = cus;
    }
    if (grid < 0) return;
    (void)hipMemsetAsync((char*)d_ws + WS_CTL, 0, CTL_ZERO_BYTES, stream);
    Args a{};
    for (int i = 0; i < 23; ++i) a.in[i] = (const float*)d_in[i];
    a.out = (float*)d_out; a.ws = (unsigned char*)d_ws;
#if MK_PER_PHASE
    for (int p = 0; p < N_PHASES; ++p) { a.ph_lo = p; a.ph_hi = p + 1; hipLaunchKernelGGL(fwd_kernel, dim3(grid), dim3(NTHR), LDS_BYTES, stream, a); }
#else
    a.ph_lo = 0; a.ph_hi = N_PHASES;
    hipLaunchKernelGGL(fwd_kernel, dim3(grid), dim3(NTHR), LDS_BYTES, stream, a);
#endif
    const hipError_t le = hipPeekAtLastError();
    if (le != hipSuccess) fprintf(stderr, "kernel_launch: launch failed: %s\n", hipGetErrorName(le));
}
```

```cpp
#include <hip/hip_runtime.h>
#include <hip/hip_fp16.h>
#include <cstdio>
#include <cstdint>
namespace pg8 {
#define PG8_LAS __attribute__((address_space(3)))
typedef unsigned short bf16_t;
typedef short bf16x8 __attribute__((ext_vector_type(8)));
typedef float f32x4 __attribute__((ext_vector_type(4)));
typedef unsigned u32x4 __attribute__((ext_vector_type(4)));
constexpr int BM = 256, BK = 64, HALF = 128, HTB = HALF * BK * 2  , STAGE_BYTES = 8 * HTB, NXCD = 8, WGM = 8;

__host__ __device__ __forceinline__ int lds_byte(int r, int c) { const int st = (r >> 4) * 2 + (c >> 5), rr = r & 15, cc = c & 31, ob = rr * 64 + cc * 2; return st * 1024 + (ob ^ (((ob >> 9) & 1) << 5)); }
__host__ __device__ __forceinline__ void stage_rc(int b, int& R, int& C) { const int st = b / 1024, sb = b % 1024, swz = sb ^ (((sb >> 9) & 1) << 5); R = (st >> 1) * 16 + swz / 64; C = (st & 1) * 32 + (swz % 64) / 2; }
__host__ __device__ __forceinline__ int perm32(int rho) { const int n = rho >> 4, i = rho & 15; return 8 * (i >> 2) + 4 * n + (i & 3); }

struct Unit { int pm, pn; };
struct Gemm { const bf16_t* A; const bf16_t* Bt; int M, N, K; };

struct StaticOrder {
    int nM, nN, nwg, G, c;
    __host__ __device__ void init(int M, int N, int G_, int c_) { nM = M / BM; nN = N / BM; nwg = nM * nN; G = G_; c = c_; }
    __host__ __device__ bool next(int i, Unit& u) const {
        const long L = (long)i * G + c; if (L >= nwg) return false;
        int wgid = (int)L; { const int q = nwg / NXCD, r = nwg % NXCD, xcd = wgid % NXCD, off = wgid / NXCD; wgid = (xcd < r ? xcd * (q + 1) : r * (q + 1) + (xcd - r) * q) + off; }
        const int nig = WGM * nN, gid = wgid / nig, fm = gid * WGM, gsz = (nM - fm) < WGM ? (nM - fm) : WGM;
        u.pm = fm + ((wgid % nig) % gsz); u.pn = (wgid % nig) / gsz; return true;
    }
    __device__ __forceinline__ void a_ready(const Unit&) const {}
    __device__ __forceinline__ void done(const Unit&) const {}
};

__device__ __forceinline__ unsigned cvt_pk_bf16(float lo, float hi) { unsigned r; asm volatile("v_cvt_pk_bf16_f32 %0, %1, %2" : "=v"(r) : "v"(lo), "v"(hi)); return r; }
typedef float f32x2 __attribute__((ext_vector_type(2)));
__device__ __forceinline__ f32x2 gelu_pk(f32x2 v) {
    const f32x2 av = __builtin_elementwise_abs(v), d = av * 0.2316418882f + 1.0f;
    f32x2 t; t.x = __builtin_amdgcn_rcpf(d.x); t.y = __builtin_amdgcn_rcpf(d.y);
    f32x2 q = t * 0.5307027145f + (-0.7265760135f); q = q * t + 0.7107068705f; q = q * t + (-0.142248368f); q = q * t + 0.127414796f; q = q * t;
    const f32x2 s = (v * v) * (-0.72134752044f);
    f32x2 e; e.x = __builtin_amdgcn_exp2f(s.x); e.y = __builtin_amdgcn_exp2f(s.y);
    const f32x2 m = v * (q * e), r = v - m;
    f32x2 o; o.x = v.x < 0.f ? m.x : r.x; o.y = v.y < 0.f ? m.y : r.y; return o;
}

template <int ACT  > struct EpiBf16 {
    static constexpr bool PERM = true, AFTER_DRAIN = false; static_assert(ACT == 0 || ACT == 1, "EpiBf16: ACT is 0 (none) or 1 (gelu_pk)");
    bf16_t* O; int ldc; const float* bias; int split_cols; size_t split_stride; float scale0;
    __device__ __forceinline__ void operator()(const f32x4 (&acc)[2][2][4][2], const Unit& u, int wr, int wc, int fr, int fq) const {
        const int row0 = u.pm * BM + wr * 64 + fr; int colt = u.pn * BM; bf16_t* base = O;
        float sc = 1.f; if (split_cols) { const int t = colt / split_cols; base += (size_t)t * split_stride; colt -= t * split_cols; if (t == 0) sc = scale0; }
        const int col0 = colt + wc * 32 + 8 * fq, bcol0 = u.pn * BM + wc * 32 + 8 * fq;
        f32x4 bv[2][2];
#pragma unroll
        for (int bj = 0; bj < 2; ++bj)
#pragma unroll
            for (int n = 0; n < 2; ++n) bv[bj][n] = bias ? *(const f32x4*)(bias + bcol0 + bj * HALF + 4 * n) : (f32x4){0.f, 0.f, 0.f, 0.f};
#pragma unroll
        for (int ai = 0; ai < 2; ++ai)
#pragma unroll
            for (int m = 0; m < 4; ++m) { bf16_t* rowp = base + (size_t)(row0 + ai * HALF + m * 16) * ldc + col0;
#pragma unroll
                for (int bj = 0; bj < 2; ++bj) { f32x4 v0 = acc[ai][bj][m][0] + bv[bj][0], v1 = acc[ai][bj][m][1] + bv[bj][1];
                    if (ACT == 1) { f32x2 a = gelu_pk((f32x2){v0[0], v0[1]}), b = gelu_pk((f32x2){v0[2], v0[3]}), c = gelu_pk((f32x2){v1[0], v1[1]}), d = gelu_pk((f32x2){v1[2], v1[3]});
                        v0 = (f32x4){a.x, a.y, b.x, b.y}; v1 = (f32x4){c.x, c.y, d.x, d.y}; }
                    v0 = v0 * sc; v1 = v1 * sc; u32x4 w; w.x = cvt_pk_bf16(v0[0], v0[1]); w.y = cvt_pk_bf16(v0[2], v0[3]); w.z = cvt_pk_bf16(v1[0], v1[1]); w.w = cvt_pk_bf16(v1[2], v1[3]);
                    *(u32x4*)(rowp + bj * HALF) = w; } }
    }
};

__device__ __forceinline__ void tile_dest(int pn, size_t& off, int& ld, int& colt);
__device__ __forceinline__ float row_rstd(const float* ss, int row) { return rsqrtf(ss[row] * (1.0f / 2048.0f) + 1e-5f); }
struct EpiProj {
    static constexpr bool PERM = true, AFTER_DRAIN = false;
    unsigned char* ws; const float* ss;
    __device__ __forceinline__ void operator()(const f32x4 (&acc)[2][2][4][2], const Unit& u, int wr, int wc, int fr, int fq) const {
        size_t off; int ld, colt; tile_dest(u.pn, off, ld, colt);
        bf16_t* base = (bf16_t*)(ws + off);
        const int row0 = u.pm * BM + wr * 64 + fr, col0 = colt + wc * 32 + 8 * fq;
        const float sc = u.pn < 4 ? 0.12751743074602467f : 1.0f;
#pragma unroll
        for (int ai = 0; ai < 2; ++ai)
#pragma unroll
            for (int m = 0; m < 4; ++m) { const int row = row0 + ai * HALF + m * 16; bf16_t* rowp = base + (size_t)row * ld + col0; const float rs = row_rstd(ss, row) * sc;
#pragma unroll
                for (int bj = 0; bj < 2; ++bj) { const f32x4 v0 = acc[ai][bj][m][0] * rs, v1 = acc[ai][bj][m][1] * rs;
                    u32x4 w; w.x = cvt_pk_bf16(v0[0], v0[1]); w.y = cvt_pk_bf16(v0[2], v0[3]); w.z = cvt_pk_bf16(v1[0], v1[1]); w.w = cvt_pk_bf16(v1[2], v1[3]);
                    *(u32x4*)(rowp + bj * HALF) = w; } }
    }
};
struct EpiResid {
    static constexpr bool PERM = false, AFTER_DRAIN = false;
    const float* base; float* out; int ldc; const float* g; bf16_t* xg; float* ss;
    __device__ __forceinline__ void operator()(const f32x4 (&acc)[2][2][4][2], const Unit& u, int wr, int wc, int fr, int fq) const {
        const int row0 = u.pm * BM + wr * 64 + fr, col0 = u.pn * BM + wc * 32 + 4 * fq;
        f32x4 gv[2][2];
#pragma unroll
        for (int bj = 0; bj < 2; ++bj)
#pragma unroll
            for (int n = 0; n < 2; ++n) gv[bj][n] = *(const f32x4*)(g + col0 + bj * HALF + n * 16);
#pragma unroll
        for (int ai = 0; ai < 2; ++ai)
#pragma unroll
            for (int m = 0; m < 4; ++m) { const int row = row0 + ai * HALF + m * 16; const size_t off = (size_t)row * ldc + col0; float sq = 0.f;
#pragma unroll
                for (int bj = 0; bj < 2; ++bj)
#pragma unroll
                    for (int n = 0; n < 2; ++n) { const size_t p = off + bj * HALF + n * 16; const f32x4 x = *(const f32x4*)(base + p) + acc[ai][bj][m][n]; *(f32x4*)(out + p) = x;
                        sq += (x[0] * x[0] + x[1] * x[1]) + (x[2] * x[2] + x[3] * x[3]);
                        if (xg) { const f32x4 y = x * gv[bj][n]; typedef unsigned u32x2_t __attribute__((ext_vector_type(2))); u32x2_t w; w.x = cvt_pk_bf16(y[0], y[1]); w.y = cvt_pk_bf16(y[2], y[3]); *(u32x2_t*)(xg + p) = w; } }
                sq += __shfl_xor(sq, 16); sq += __shfl_xor(sq, 32);
                if (fq == 0) unsafeAtomicAdd(ss + row, sq); }
    }
};
struct EpiSwiGLU {
    static constexpr bool PERM = true, AFTER_DRAIN = false;
    bf16_t* O; int ldc; const float* ss;
    __device__ __forceinline__ static float silu_mul(float g, float u) { return g * u * __builtin_amdgcn_rcpf(1.0f + __expf(-g)); }
    __device__ __forceinline__ void operator()(const f32x4 (&acc)[2][2][4][2], const Unit& u, int wr, int wc, int fr, int fq) const {
        const int row0 = u.pm * BM + wr * 64 + fr, col0 = u.pn * HALF + wc * 32 + 8 * fq;
#pragma unroll
        for (int ai = 0; ai < 2; ++ai)
#pragma unroll
            for (int m = 0; m < 4; ++m) { const int row = row0 + ai * HALF + m * 16; bf16_t* rowp = O + (size_t)row * ldc + col0; const float rs = row_rstd(ss, row);
                const f32x4 g0 = acc[ai][0][m][0] * rs, g1 = acc[ai][0][m][1] * rs, u0 = acc[ai][1][m][0] * rs, u1 = acc[ai][1][m][1] * rs;
                u32x4 w; w.x = cvt_pk_bf16(silu_mul(g0[0], u0[0]), silu_mul(g0[1], u0[1])); w.y = cvt_pk_bf16(silu_mul(g0[2], u0[2]), silu_mul(g0[3], u0[3]));
                w.z = cvt_pk_bf16(silu_mul(g1[0], u1[0]), silu_mul(g1[1], u1[1])); w.w = cvt_pk_bf16(silu_mul(g1[2], u1[2]), silu_mul(g1[3], u1[3]));
                *(u32x4*)rowp = w; }
    }
};
template <class Epi, class Sched, bool ALIGN_EPI = false, bool SP2 = false>
__device__ __forceinline__ void gemm_phase(PG8_LAS unsigned char* lds, const Gemm g, const Sched& S, const Epi& E) {
    int tid_ = threadIdx.x; asm volatile("" : "+v"(tid_));
    const int tid = tid_, wid = __builtin_amdgcn_readfirstlane(tid >> 6), lane = tid & 63, wr = wid >> 2, wc = wid & 3, fr = lane & 15, fq = lane >> 4;
    const int K = g.K, nt = K / BK;
    unsigned voffA[2], voffB[2];
#pragma unroll
    for (int i = 0; i < 2; ++i) { int R, C; stage_rc(tid * 16 + i * 8192, R, C); const int Rb = Epi::PERM ? ((R & ~31) + perm32(R & 31)) : R;
        voffA[i] = (unsigned)(R * K + C) * 2u; voffB[i] = (unsigned)(Rb * K + C) * 2u; }
    const size_t kstep = (size_t)(BK * 2);
    const size_t hstep = (size_t)HALF * K * 2;
    const size_t tstep = 2 * hstep;
    const unsigned ldsw = (unsigned)wid * 1024u;
    const int aoff = lds_byte(wr * 64 + fr, fq * 8), boff = lds_byte(wc * 32 + fr, fq * 8);
#define PG8_SA(b, h) (((b) * 2 + (h)) * HTB)
#define PG8_SB(b, h) ((4 + (b) * 2 + (h)) * HTB)
#define PG8_STAGE(bufoff, gbase, voff) do { _Pragma("unroll") for (int _i = 0; _i < 2; ++_i) \
        __builtin_amdgcn_global_load_lds((const unsigned*)((const char*)(gbase) + (voff)[_i]), (PG8_LAS unsigned*)(lds + (bufoff) + ldsw + _i * 8192), 16, 0, 0); } while (0)
#define PG8_LDA(dst, b, h) do { _Pragma("unroll") for (int m = 0; m < 4; ++m) _Pragma("unroll") for (int k = 0; k < 2; ++k) dst[m][k] = *(const PG8_LAS bf16x8*)(lds + PG8_SA(b, h) + aoff + m * 2048 + k * 1024); } while (0)
#define PG8_LDB(dst, b, h) do { _Pragma("unroll") for (int n = 0; n < 2; ++n) _Pragma("unroll") for (int k = 0; k < 2; ++k) dst[n][k] = *(const PG8_LAS bf16x8*)(lds + PG8_SB(b, h) + boff + n * 2048 + k * 1024); } while (0)
#define PG8_MMA(ai, bj, At, Bt) do { __builtin_amdgcn_s_setprio(1); _Pragma("unroll") for (int m = 0; m < 4; ++m) _Pragma("unroll") for (int n = 0; n < 2; ++n) _Pragma("unroll") for (int k = 0; k < 2; ++k) \
        acc[ai][bj][m][n] = __builtin_amdgcn_mfma_f32_16x16x32_bf16(Bt[n][k], At[m][k], acc[ai][bj][m][n], 0, 0, 0); __builtin_amdgcn_s_setprio(0); } while (0)
#define PG8_WAIT_V(n) asm volatile("s_waitcnt vmcnt(" #n ")" ::: "memory")
#define PG8_WAIT_L(n) asm volatile("s_waitcnt lgkmcnt(" #n ")" ::: "memory")
#define PG8_BAR __builtin_amdgcn_s_barrier()
#define PG8_SCHED __builtin_amdgcn_sched_barrier(0)
    Unit cur, nxt; int ui = 0;
    if (!S.next(0, cur)) return;
    f32x4 acc[2][2][4][2];
#pragma unroll
    for (int a = 0; a < 2; ++a)
#pragma unroll
        for (int b = 0; b < 2; ++b)
#pragma unroll
            for (int m = 0; m < 4; ++m)
#pragma unroll
                for (int n = 0; n < 2; ++n) acc[a][b][m][n] = (f32x4){0.f, 0.f, 0.f, 0.f};
    bf16x8 At[4][2], B0[2][2], B1[2][2];
    const char* cA = (const char*)g.A + (size_t)cur.pm * tstep; const char* cB = (const char*)g.Bt + (size_t)cur.pn * tstep;
    S.a_ready(cur);
    if constexpr (SP2) {
        PG8_STAGE(PG8_SB(0, 0), cB, voffB); PG8_STAGE(PG8_SB(0, 1), cB + hstep, voffB); PG8_STAGE(PG8_SA(0, 0), cA, voffA); PG8_STAGE(PG8_SA(0, 1), cA + hstep, voffA);
        if (wr == 1) PG8_BAR;
        PG8_WAIT_V(2); PG8_BAR;
        PG8_STAGE(PG8_SB(1, 0), cB + kstep, voffB); PG8_STAGE(PG8_SA(1, 0), cA + kstep, voffA); PG8_STAGE(PG8_SB(1, 1), cB + hstep + kstep, voffB);
        PG8_WAIT_V(6); PG8_BAR;
    } else {
        PG8_STAGE(PG8_SB(0, 0), cB, voffB); PG8_STAGE(PG8_SA(0, 0), cA, voffA); PG8_STAGE(PG8_SB(0, 1), cB + hstep, voffB); PG8_STAGE(PG8_SA(0, 1), cA + hstep, voffA);
        if (wr == 1) PG8_BAR;
        PG8_WAIT_V(4); PG8_BAR;
        PG8_STAGE(PG8_SB(1, 0), cB + kstep, voffB); PG8_STAGE(PG8_SA(1, 0), cA + kstep, voffA); PG8_STAGE(PG8_SB(1, 1), cB + hstep + kstep, voffB);
        PG8_WAIT_V(6); PG8_BAR;
    }
    for (;;) {
        const bool has_next = S.next(ui + 1, nxt);
        const char* nA = has_next ? (const char*)g.A + (size_t)nxt.pm * tstep : cA; const char* nB = has_next ? (const char*)g.Bt + (size_t)nxt.pn * tstep : cB;
        for (int t = 0; t < nt; t += 2) {
            const bool last = (t == nt - 2);
            const char* a1 = cA + (size_t)(t + 1) * kstep;
            const char* a2 = last ? nA : cA + (size_t)(t + 2) * kstep; const char* b2 = last ? nB : cB + (size_t)(t + 2) * kstep;
            const char* a3 = a2 + kstep; const char* b3 = b2 + kstep;
            if (last && has_next) S.a_ready(nxt);
            if constexpr (SP2) {
            PG8_LDB(B0, 0, 0); PG8_LDB(B1, 0, 1); PG8_SCHED; PG8_LDA(At, 0, 0); PG8_STAGE(PG8_SA(1, 1), a1 + hstep, voffA);
            PG8_WAIT_V(8); PG8_WAIT_L(0); PG8_BAR; PG8_MMA(0, 0, At, B0); PG8_MMA(0, 1, At, B1); PG8_BAR; PG8_SCHED;
            PG8_LDA(At, 0, 1); PG8_STAGE(PG8_SB(0, 0), b2, voffB); PG8_STAGE(PG8_SB(0, 1), b2 + hstep, voffB); PG8_STAGE(PG8_SA(0, 0), a2, voffA);
            PG8_WAIT_V(8); PG8_WAIT_L(0); PG8_BAR; PG8_MMA(1, 0, At, B0); PG8_MMA(1, 1, At, B1); PG8_BAR; PG8_SCHED;
            PG8_LDB(B0, 1, 0); PG8_LDB(B1, 1, 1); PG8_SCHED; PG8_LDA(At, 1, 0); PG8_STAGE(PG8_SA(0, 1), a2 + hstep, voffA);
            PG8_WAIT_V(8); PG8_WAIT_L(0); PG8_BAR; PG8_MMA(0, 0, At, B0); PG8_MMA(0, 1, At, B1); PG8_BAR; PG8_SCHED;
            PG8_LDA(At, 1, 1); PG8_STAGE(PG8_SB(1, 0), b3, voffB); PG8_STAGE(PG8_SB(1, 1), b3 + hstep, voffB); PG8_STAGE(PG8_SA(1, 0), a3, voffA);
            PG8_WAIT_V(8); PG8_WAIT_L(0); PG8_BAR; PG8_MMA(1, 0, At, B0); PG8_MMA(1, 1, At, B1); PG8_BAR; PG8_SCHED;
            } else {
            PG8_LDB(B0, 0, 0); PG8_SCHED; PG8_LDA(At, 0, 0); PG8_STAGE(PG8_SA(1, 1), a1 + hstep, voffA);
            PG8_WAIT_L(8); PG8_BAR; PG8_WAIT_L(0); PG8_MMA(0, 0, At, B0); PG8_BAR; PG8_SCHED;
            PG8_LDB(B1, 0, 1); PG8_STAGE(PG8_SB(0, 0), b2, voffB);
            PG8_BAR; PG8_WAIT_L(0); PG8_MMA(0, 1, At, B1); PG8_BAR;
            PG8_LDA(At, 0, 1); PG8_STAGE(PG8_SA(0, 0), a2, voffA);
            PG8_BAR; PG8_WAIT_L(0); PG8_MMA(1, 0, At, B0); PG8_BAR; PG8_SCHED;
            PG8_STAGE(PG8_SB(0, 1), b2 + hstep, voffB);
            PG8_WAIT_V(6); PG8_BAR; PG8_MMA(1, 1, At, B1); PG8_BAR;
            PG8_LDB(B0, 1, 0); PG8_SCHED; PG8_LDA(At, 1, 0); PG8_STAGE(PG8_SA(0, 1), a2 + hstep, voffA);
            PG8_WAIT_L(8); PG8_BAR; PG8_WAIT_L(0); PG8_MMA(0, 0, At, B0); PG8_BAR; PG8_SCHED;
            PG8_LDB(B1, 1, 1); PG8_STAGE(PG8_SB(1, 0), b3, voffB);
            PG8_BAR; PG8_WAIT_L(0); PG8_MMA(0, 1, At, B1); PG8_BAR;
            PG8_LDA(At, 1, 1); PG8_STAGE(PG8_SA(1, 0), a3, voffA);
            PG8_BAR; PG8_WAIT_L(0); PG8_MMA(1, 0, At, B0); PG8_BAR; PG8_SCHED;
            PG8_STAGE(PG8_SB(1, 1), b3 + hstep, voffB);
            PG8_WAIT_V(6); PG8_BAR; PG8_MMA(1, 1, At, B1); PG8_BAR;
            }
        }
        if constexpr (ALIGN_EPI) { if (wr == 0) PG8_BAR; }
        if constexpr (!Epi::AFTER_DRAIN) { E(acc, cur, wr, wc, fr, fq); S.done(cur); }
        if (!has_next) break;
#pragma unroll
        for (int a = 0; a < 2; ++a)
#pragma unroll
            for (int b = 0; b < 2; ++b)
#pragma unroll
                for (int m = 0; m < 4; ++m)
#pragma unroll
                    for (int n = 0; n < 2; ++n) acc[a][b][m][n] = (f32x4){0.f, 0.f, 0.f, 0.f};
        cur = nxt; cA = nA; cB = nB; ++ui;
        if constexpr (ALIGN_EPI) { if (wr == 1) PG8_BAR; }
    }
    PG8_WAIT_V(0);
    if constexpr (!ALIGN_EPI) { if (wr == 0) PG8_BAR; }
    PG8_BAR;
    if constexpr (Epi::AFTER_DRAIN) { E.fused(acc, cur, wr, wc, fr, fq, lds, wid, lane); S.done(cur); }
#undef PG8_SA
#undef PG8_SB
#undef PG8_STAGE
#undef PG8_LDA
#undef PG8_LDB
#undef PG8_MMA
#undef PG8_WAIT_V
#undef PG8_WAIT_L
#undef PG8_BAR
#undef PG8_SCHED
}
}
constexpr int NB = 4, T = 8192, M = NB * T, DM = 2048, DFF = 5632, DEPTH = 2;
constexpr int N_IN = 7696, N_INP = 7936;
constexpr int NWAVES = 8, NTHR = NWAVES * 64;
#define LAS __attribute__((address_space(3)))
#define GAS __attribute__((address_space(1)))
#define CAS __attribute__((address_space(4)))
typedef unsigned short bf16;
typedef short bf16x8 __attribute__((ext_vector_type(8)));
typedef float f32x4 __attribute__((ext_vector_type(4)));
typedef float f32x16 __attribute__((ext_vector_type(16)));
typedef unsigned u32x4 __attribute__((ext_vector_type(4)));
typedef unsigned u32x2 __attribute__((ext_vector_type(2)));
typedef unsigned long long u64;

constexpr size_t MiB = 1u << 20;
constexpr size_t WS_CTL = 0, CTL_ZERO_BYTES = 1 * MiB;
constexpr size_t WS_WIN = 1 * MiB, WS_WOUT = 32 * MiB, WS_WGU = 40 * MiB, WS_WDN = 84 * MiB;
constexpr size_t WS_LORA = 106 * MiB;
constexpr size_t LO_W = 0, LO_A = 512 * 96 * 2, LO_V = 2 * 512 * 96 * 2, LO_G = LO_V + 512 * 64 * 2;
constexpr size_t WS_VFIRST = 107 * MiB;
constexpr size_t WS_H = 139 * MiB;
constexpr size_t WS_VT = 139 * MiB, WS_MASK = 203 * MiB;
constexpr size_t WS_Q = 267 * MiB, WS_K = 331 * MiB, WS_QI = 395 * MiB, WS_V = 459 * MiB, WS_KW = 523 * MiB, WS_BQ = 539 * MiB, WS_BK = 555 * MiB, WS_BV = 571 * MiB, WS_BG = 603 * MiB;
constexpr size_t WS_CR = 635 * MiB, WS_CK = 667 * MiB, WS_CV = 699 * MiB, WS_CL = 731 * MiB, WS_CG = 747 * MiB;
constexpr size_t WS_CAT = 763 * MiB;
constexpr size_t WS_KVST = 891 * MiB;
constexpr size_t WS_TAB = 955 * MiB;
constexpr size_t WS_SS1 = 959 * MiB, WS_SS2 = 959 * MiB + 256 * 1024;
constexpr size_t TAB_A = 0, TAB_I = (size_t)T * 16 * 8, TAB_R = TAB_I + (size_t)T * 8 * 8, TAB_END = TAB_R + (size_t)T * 32 * 8;
constexpr size_t WS_RR = 139 * MiB, WS_RW = 171 * MiB, WS_RKH = 203 * MiB, WS_RV = 235 * MiB, WS_RA = 267 * MiB, WS_RB = 299 * MiB;
constexpr size_t WS_PHI = 331 * MiB, WS_PSI = 363 * MiB, WS_SST = 395 * MiB, WS_Y = 635 * MiB;
constexpr size_t WS_H2 = 139 * MiB, WS_ACT = 267 * MiB;
constexpr size_t WS_NEED = 1024 * MiB;
static_assert(WS_TAB + TAB_END <= WS_NEED && WS_ACT + (size_t)M * DFF * 2 <= WS_CR && WS_SST + 32 * MiB <= WS_V && WS_RB + 32 * MiB <= WS_PHI && WS_Y + (size_t)M * 512 * 4 <= WS_CV, "ws map");

constexpr int LDS_BYTES = 147456, MISC_OFF = 143360;
constexpr int CW_BAR = 4096;

__device__ __forceinline__ unsigned f2bf(float f) { unsigned u = __builtin_bit_cast(unsigned, f); return (u + 0x7fffu + ((u >> 16) & 1u)) >> 16; }
__device__ __forceinline__ unsigned pk2(float lo, float hi) { return f2bf(lo) | (f2bf(hi) << 16); }
__device__ __forceinline__ float bf2f(unsigned short b) { return __builtin_bit_cast(float, (unsigned)b << 16); }
__device__ __forceinline__ float bflo(unsigned w) { return __builtin_bit_cast(float, w << 16); }
__device__ __forceinline__ float bfhi(unsigned w) { return __builtin_bit_cast(float, w & 0xffff0000u); }
__device__ __forceinline__ float wave_sum(float v) {
#pragma unroll
    for (int o = 1; o < 64; o <<= 1) v += __shfl_xor(v, o);
    return v;
}
#define LDS_WAIT() asm volatile("s_waitcnt lgkmcnt(0)" ::: "memory")
typedef float f32x2 __attribute__((ext_vector_type(2)));
template <class TT> __device__ __forceinline__ GAS TT* at_b(GAS TT* ub, unsigned boff) { return (GAS TT*)((GAS char*)ub + boff); }
__device__ __forceinline__ float half_sum32(float v) { v += __shfl_xor(v, 1); v += __shfl_xor(v, 2); v += __shfl_xor(v, 4); v += __shfl_xor(v, 8); v += __shfl_xor(v, 16); return v; }


namespace pg8 {
__device__ __forceinline__ void tile_dest(int pn, size_t& off, int& ld, int& colt) {
    if (pn < 16) { const int g = pn >> 2; off = g == 0 ? WS_Q : g == 1 ? WS_K : g == 2 ? WS_V : WS_QI; ld = 1024; colt = (pn & 3) * 256; }
    else if (pn == 16) { off = WS_BQ; ld = 256; colt = 0; }
    else if (pn == 17) { off = WS_BK; ld = 256; colt = 0; }
    else if (pn < 20) { off = WS_BV; ld = 512; colt = (pn - 18) * 256; }
    else if (pn < 22) { off = WS_BG; ld = 512; colt = (pn - 20) * 256; }
    else if (pn == 22) { off = WS_KW; ld = 256; colt = 0; }
    else if (pn < 25) { off = WS_CR; ld = 512; colt = (pn - 23) * 256; }
    else if (pn < 27) { off = WS_CK; ld = 512; colt = (pn - 25) * 256; }
    else if (pn < 29) { off = WS_CV; ld = 512; colt = (pn - 27) * 256; }
    else if (pn == 29) { off = WS_CL; ld = 256; colt = 0; }
    else { off = WS_CG; ld = 256; colt = 0; }
}
}
__device__ __forceinline__ int win_src(int n, int layer) {
    if (n < 4096) return n;
    if (n < 4352) return 4176 + (n - 4096);
    if (n < 4608) return 4432 + (n - 4352);
    if (n < 5120) return 4688 + (n - 4608);
    if (n < 5632) return 5200 + (n - 5120);
    if (n < 5888) { const int j = n - 5632; return j < 64 ? 4096 + j : (j < 80 ? 4160 + (j - 64) : -1); }
    if (n < 7424) return 5712 + (n - 5888);
    if (n < 7680) { const int j = n - 7424; return j < 96 ? 7248 + j : (j < 192 ? 7344 + (j - 96) : (layer > 0 ? -2 - (j - 192) : -1)); }
    return 7440 + (n - 7680);
}
#define XB_TMO      128
#define XB_XCNT(j)  (256  + 64 * (j))
#define XB_XSUB(j)  (1280 + 64 * (j))
#define XB_XGEN(j)  (2304 + 64 * (j))
#define XB_TOP      3328
#define XB_TOPGEN   3392
#define XCD_BAR_WORDS 3456
#define XB_SPIN_CAP (1u << 18)

__device__ __forceinline__ unsigned xb_ld(unsigned* p)              { return __hip_atomic_load(p, __ATOMIC_RELAXED, __HIP_MEMORY_SCOPE_AGENT); }
__device__ __forceinline__ unsigned xb_add(unsigned* p, unsigned v) { return __hip_atomic_fetch_add(p, v, __ATOMIC_RELAXED, __HIP_MEMORY_SCOPE_AGENT); }
__device__ __forceinline__ unsigned xb_xcc_id() { return (unsigned)__builtin_amdgcn_s_getreg((3 << 11) | 20) & 0xFu; }
#define XB_SPIN(cond, bar) do { unsigned _sp = 0; while (cond) { __builtin_amdgcn_s_sleep(1); \
    if ((++_sp & 255u) == 0u) { if (xb_ld(&(bar)[XB_TMO])) break; if (_sp > XB_SPIN_CAP) { atomicAdd(&(bar)[XB_TMO], 1u); break; } } } } while (0)

struct XcdBarrier {
    unsigned* bar; unsigned x;
    volatile LAS unsigned* st;
};

__device__ __forceinline__ XcdBarrier xcd_barrier_post(unsigned* bar, volatile LAS unsigned* st) {
    XcdBarrier b; b.bar = bar; b.x = xb_xcc_id(); b.st = st;
    if (threadIdx.x == 0) (void)xb_add(&bar[XB_XCNT(b.x)], 1u);
    return b;
}
__device__ __forceinline__ void xcd_barrier_complete(unsigned* bar, unsigned x, unsigned& nloc, unsigned& nx) {
    const unsigned G = gridDim.x * gridDim.y * gridDim.z;
    unsigned sum, cnt, mine, sp = 0u;
    for (;;) {
        sum = 0u; cnt = 0u; mine = 0u;
#pragma unroll
        for (unsigned j = 0; j < 16; ++j) { const unsigned c = xb_ld(&bar[XB_XCNT(j)]); sum += c; cnt += (c > 0u) ? 1u : 0u; mine = (j == x) ? c : mine; }
        if (sum == G) break;
        __builtin_amdgcn_s_sleep(1);
        if ((++sp & 255u) == 0u) { if (xb_ld(&bar[XB_TMO])) break; if (sp > XB_SPIN_CAP) { atomicAdd(&bar[XB_TMO], 1u); break; } }
    }
    nloc = mine > 0u ? mine : 1u; nx = cnt > 0u ? cnt : 1u;
}

__device__ __forceinline__ void xcd_barrier(const XcdBarrier& b) {
    asm volatile("s_waitcnt vmcnt(0)" ::: "memory");
    __syncthreads();
    if (threadIdx.x == 0) {
        unsigned* bar = b.bar;
        __builtin_amdgcn_s_waitcnt(0);
        unsigned nloc = b.st[0], nx = b.st[1];
        if (nloc == 0u) { xcd_barrier_complete(bar, b.x, nloc, nx); b.st[0] = nloc; b.st[1] = nx; }
        const unsigned old = xb_add(&bar[XB_XSUB(b.x)], 1u);
        const unsigned gen = old / nloc;
        if (old + 1u == (gen + 1u) * nloc) {
            __builtin_amdgcn_fence(__ATOMIC_RELEASE, "agent");
            asm volatile("s_waitcnt vmcnt(0)" ::: "memory");
            const unsigned og = xb_add(&bar[XB_TOP], 1u);
            const unsigned tg = og / nx;
            if (og + 1u == (tg + 1u) * nx) xb_add(&bar[XB_TOPGEN], 1u);
            else XB_SPIN(xb_ld(&bar[XB_TOPGEN]) == tg, bar);
            __builtin_amdgcn_fence(__ATOMIC_ACQUIRE, "agent");
            xb_add(&bar[XB_XGEN(b.x)], 1u);
            asm volatile("s_waitcnt vmcnt(0)" ::: "memory");
        } else {
            XB_SPIN(xb_ld(&bar[XB_XGEN(b.x)]) == gen, bar);
            __builtin_amdgcn_fence(__ATOMIC_ACQUIRE, "agent");
            asm volatile("s_waitcnt vmcnt(0)" ::: "memory");
        }
    }
    __syncthreads();
}

struct Ctx {
    LAS unsigned char* lds; int tid, lane, wave, G, bid; unsigned char* ws; float* out;
};

template <int MAP>
__device__ __forceinline__ void wconv_item(const float* W, int ldw, const float* W2, int K, bf16* WT, LAS float* scr, int item, int nblk, int lane, int layer) {
    const int kb = item / nblk, nb = item % nblk, k0 = 64 * kb, n0 = 32 * nb;
    const int n = n0 + (lane & 31);
    const float* src = nullptr; int ld = ldw;
    if (MAP == 0) src = W + n;
    else if (MAP == 1) { const int s = win_src(n, layer); if (s >= 0) src = W + s; else if (s <= -2) { src = W2 + (-2 - s); ld = 64; } }
    else { const int tl = n >> 8, j = n & 255; src = W + (j < 128 ? tl * 128 + j : DFF + tl * 128 + (j - 128)); }
    float tv[32];
#pragma unroll
    for (int i = 0; i < 32; ++i) { const int kk = 2 * i + (lane >> 5); tv[i] = src ? src[(size_t)(k0 + kk) * ld] : 0.f; }
#pragma unroll
    for (int i = 0; i < 32; ++i) { const int kk = 2 * i + (lane >> 5); scr[kk * 33 + (lane & 31)] = tv[i]; }
    LDS_WAIT(); asm volatile("" ::: "memory");
    const int c = lane & 7;
#pragma unroll
    for (int j = 0; j < 4; ++j) { const int nn = (lane >> 3) + 8 * j; const LAS float* s = scr + (8 * c) * 33 + nn;
        u32x4 o; o.x = pk2(s[0 * 33], s[1 * 33]); o.y = pk2(s[2 * 33], s[3 * 33]); o.z = pk2(s[4 * 33], s[5 * 33]); o.w = pk2(s[6 * 33], s[7 * 33]);
        *(u32x4*)(WT + (size_t)(n0 + nn) * K + k0 + 8 * c) = o; }
    LDS_WAIT(); asm volatile("" ::: "memory");
}
struct WSrc { const float *w_in, *w_vres, *w_out, *w_gu, *w_dn, *wlb, *alb, *glb, *vlb; };
__device__ __forceinline__ void phase_wconv(const Ctx& C, int layer, const WSrc& W) {
    LAS float* scr = (LAS float*)(C.lds + C.wave * 16384);
    const int gw = C.bid * NWAVES + C.wave, NGW = C.G * NWAVES;
    const float* w_in = W.w_in + (size_t)layer * DM * N_IN; const float* w_vres = W.w_vres;
    const float* w_out = W.w_out + (size_t)layer * DM * DM; const float* w_gu = W.w_gu + (size_t)layer * DM * 2 * DFF; const float* w_dn = W.w_dn + (size_t)layer * DFF * DM;
    constexpr int I_IN = (DM / 64) * (N_INP / 32), I_OUT = (DM / 64) * (DM / 32), I_GU = (DM / 64) * (2 * DFF / 32), I_DN = (DFF / 64) * (DM / 32);
    for (int it = gw; it < I_IN + I_OUT + I_GU + I_DN; it += NGW) {
        int r = it;
        if (r < I_IN) { wconv_item<1>(w_in, N_IN, w_vres, DM, (bf16*)(C.ws + WS_WIN), scr, r, N_INP / 32, C.lane, layer); continue; } r -= I_IN;
        if (r < I_OUT) { wconv_item<0>(w_out, DM, nullptr, DM, (bf16*)(C.ws + WS_WOUT), scr, r, DM / 32, C.lane, layer); continue; } r -= I_OUT;
        if (r < I_GU) { wconv_item<2>(w_gu, 2 * DFF, nullptr, DM, (bf16*)(C.ws + WS_WGU), scr, r, 2 * DFF / 32, C.lane, layer); continue; } r -= I_GU;
        wconv_item<0>(w_dn, DM, nullptr, DFF, (bf16*)(C.ws + WS_WDN), scr, r, DM / 32, C.lane, layer);
    }
    const int gt = C.bid * NTHR + C.tid, NGT = C.G * NTHR;
    const float* wlb = W.wlb + (size_t)layer * 96 * 512; const float* alb = W.alb + (size_t)layer * 96 * 512; const float* glb = W.glb + (size_t)layer * 256 * 512;
    const float* vlb = W.vlb;
    bf16* LW = (bf16*)(C.ws + WS_LORA + LO_W); bf16* LA = (bf16*)(C.ws + WS_LORA + LO_A); bf16* LV = (bf16*)(C.ws + WS_LORA + LO_V); bf16* LG = (bf16*)(C.ws + WS_LORA + LO_G);
    for (int i = gt; i < 512 * 96; i += NGT) { const int n = i / 96, k = i % 96; LW[i] = (bf16)f2bf(wlb[k * 512 + n]); LA[i] = (bf16)f2bf(alb[k * 512 + n]); }
    for (int i = gt; i < 512 * 64; i += NGT) { const int n = i / 64, k = i % 64; LV[i] = (bf16)f2bf(layer > 0 ? vlb[k * 512 + n] : 0.f); }
    for (int i = gt; i < 512 * 256; i += NGT) { const int n = i / 256, k = i % 256; LG[i] = (bf16)f2bf(glb[k * 512 + n]); }
    if (layer == 0) {
        float2* TA = (float2*)(C.ws + WS_TAB + TAB_A); float2* TI = (float2*)(C.ws + WS_TAB + TAB_I); float2* TR = (float2*)(C.ws + WS_TAB + TAB_R);
        const float l2a = 18.931568569324174f  , l2r = 13.287712379549449f  ;
        for (int i = gt; i < T * 56; i += NGT) {
            const int pos = i / 56, j = i % 56; float fr; float2* dst;
            if (j < 16) { fr = exp2f(-(float)j * (1.0f / 16.0f) * l2a); dst = TA + pos * 16 + j; }
            else if (j < 24) { fr = exp2f(-(float)(j - 16) * (1.0f / 8.0f) * l2a); dst = TI + pos * 8 + (j - 16); }
            else { fr = exp2f(-(float)(j - 24) * (1.0f / 32.0f) * l2r); dst = TR + pos * 32 + (j - 24); }
            const float ang = (float)pos * fr; *dst = make_float2(cosf(ang), sinf(ang));
        }
    }
}
__device__ __forceinline__ void phase_xg(const Ctx& C, const float* x, const float* g, bf16* out, float* ss) {
    const int gw = C.bid * NWAVES + C.wave, NGW = C.G * NWAVES;
    f32x4 gv[8];
#pragma unroll
    for (int j = 0; j < 8; ++j) gv[j] = *(const f32x4*)(g + 4 * (C.lane + 64 * j));
    for (int m = gw; m < M; m += NGW) {
        const f32x4* xr = (const f32x4*)(x + (size_t)m * DM) + C.lane; f32x4 v[8]; float s = 0.f;
#pragma unroll
        for (int j = 0; j < 8; ++j) { v[j] = xr[64 * j]; s += (v[j].x * v[j].x + v[j].y * v[j].y) + (v[j].z * v[j].z + v[j].w * v[j].w); }
        s = wave_sum(s); if (C.lane == 0) ss[m] = s;
        u32x2* o = (u32x2*)(out + (size_t)m * DM) + C.lane;
#pragma unroll
        for (int j = 0; j < 8; ++j) { u32x2 w; w.x = pk2(v[j].x * gv[j].x, v[j].y * gv[j].y); w.y = pk2(v[j].z * gv[j].z, v[j].w * gv[j].w); o[64 * j] = w; }
    }
}
__device__ __forceinline__ void phase_final_norm(const Ctx& C, float* x, const float* g, const float* ss) {
    const int gw = C.bid * NWAVES + C.wave, NGW = C.G * NWAVES;
    f32x4 gv[8];
#pragma unroll
    for (int j = 0; j < 8; ++j) gv[j] = *(const f32x4*)(g + 4 * (C.lane + 64 * j));
    for (int m = gw; m < M; m += NGW) {
        f32x4* xr = (f32x4*)(x + (size_t)m * DM) + C.lane; const float rs = rsqrtf(ss[m] * (1.0f / DM) + 1e-5f);
#pragma unroll
        for (int j = 0; j < 8; ++j) xr[64 * j] = xr[64 * j] * rs * gv[j];
    }
}
__device__ __forceinline__ void phase_prep_a(const Ctx& C) {
    const long gt = (long)C.bid * NTHR + C.tid, NGT = (long)C.G * NTHR;
    { float* s1 = (float*)(C.ws + WS_SS1); float* s2 = (float*)(C.ws + WS_SS2); for (long i = gt; i < M; i += NGT) { s1[i] = 0.f; s2[i] = 0.f; } }
    for (int cfg = 0; cfg < 6; ++cfg) {
        size_t off; int ld, nh, hd, half; size_t tab;
        if (cfg == 0) { off = WS_Q; ld = 1024; nh = 8; hd = 128; half = 16; tab = TAB_A; }
        else if (cfg == 1) { off = WS_K; ld = 1024; nh = 8; hd = 128; half = 16; tab = TAB_A; }
        else if (cfg == 2) { off = WS_QI; ld = 1024; nh = 16; hd = 64; half = 8; tab = TAB_I; }
        else if (cfg == 3) { off = WS_KW; ld = 256; nh = 1; hd = 64; half = 8; tab = TAB_I; }
        else if (cfg == 4) { off = WS_BQ; ld = 256; nh = 4; hd = 64; half = 32; tab = TAB_R; }
        else { off = WS_BK; ld = 256; nh = 4; hd = 64; half = 32; tab = TAB_R; }
        bf16* buf = (bf16*)(C.ws + off); const float2* tb = (const float2*)(C.ws + WS_TAB + tab);
        const int cpp = half >> 3; const long total = (long)M * nh * cpp;
        for (long it0 = gt; it0 < total; it0 += 4 * NGT) {
            bf16* p1[4]; u32x4 a[4], b[4]; f32x4 tcs[4][4]; bool ok[4];
#pragma unroll
            for (int q = 0; q < 4; ++q) { const long it = it0 + q * NGT; ok[q] = it < total; const long itc = ok[q] ? it : gt;
                const int c = (int)(itc % cpp); const long r2 = itc / cpp; const int h = (int)(r2 % nh); const int row = (int)(r2 / nh); const int pos = row & (T - 1);
                p1[q] = buf + (size_t)row * ld + h * hd + 8 * c; a[q] = *(const u32x4*)p1[q]; b[q] = *(const u32x4*)(p1[q] + half);
                const f32x4* tp = (const f32x4*)(tb + (size_t)pos * half + 8 * c);
#pragma unroll
                for (int e = 0; e < 4; ++e) tcs[q][e] = tp[e]; }
#pragma unroll
            for (int q = 0; q < 4; ++q) { if (!ok[q]) continue; u32x4 oa, ob;
#pragma unroll
                for (int e = 0; e < 4; ++e) { const float x10 = bflo(a[q][e]), x11 = bfhi(a[q][e]), x20 = bflo(b[q][e]), x21 = bfhi(b[q][e]); const f32x4 t = tcs[q][e];
                    oa[e] = pk2(x10 * t.x - x20 * t.y, x11 * t.z - x21 * t.w); ob[e] = pk2(x20 * t.x + x10 * t.y, x21 * t.z + x11 * t.w); }
                *(u32x4*)p1[q] = oa; *(u32x4*)(p1[q] + half) = ob; }
        }
    }
    {
        LAS unsigned short* scr = (LAS unsigned short*)(C.lds + C.wave * 9216);
        const bf16* V = (const bf16*)(C.ws + WS_V); bf16* Vt = (bf16*)(C.ws + WS_VT);
        const int gw = C.bid * NWAVES + C.wave, NGW = C.G * NWAVES, lane = C.lane;
        for (int it = gw; it < NB * 128 * 16; it += NGW) {
            const int ct = it & 15, tt = (it >> 4) & 127, b = it >> 11;
            const int t0 = tt * 64, c0 = ct * 64;
            u32x4 v[8];
#pragma unroll
            for (int i = 0; i < 8; ++i) { const int tr = 8 * i + (lane >> 3), c8 = (lane & 7) * 8; v[i] = *(const u32x4*)(V + (size_t)(b * T + t0 + tr) * 1024 + c0 + c8); }
#pragma unroll
            for (int i = 0; i < 8; ++i) { const int tr = 8 * i + (lane >> 3), c8 = (lane & 7) * 8; *(LAS u32x4*)(scr + tr * 72 + c8) = v[i]; }
            LDS_WAIT(); asm volatile("" ::: "memory");
#pragma unroll
            for (int i = 0; i < 8; ++i) { const int cr = 8 * i + (lane >> 3), t8 = (lane & 7) * 8; u32x4 w;
#pragma unroll
                for (int e = 0; e < 4; ++e) w[e] = (unsigned)scr[(t8 + 2 * e) * 72 + cr] | ((unsigned)scr[(t8 + 2 * e + 1) * 72 + cr] << 16);
                *(u32x4*)(Vt + ((size_t)b * 1024 + c0 + cr) * T + t0 + t8) = w; }
            LDS_WAIT(); asm volatile("" ::: "memory");
        }
    }
}
#ifndef IDX_REP_T
#define IDX_REP_T 1
#endif
#ifndef IDX_REP_S
#define IDX_REP_S 1
#endif
__device__ __forceinline__ void phase_indexer(const Ctx& C) {
    LAS unsigned short* sc = (LAS unsigned short*)C.lds;
    LAS unsigned* hist = (LAS unsigned*)(C.lds + 131072) + C.wave * 256;
    LAS float* wvl = (LAS float*)(C.lds + 131072 + 8192);
    LAS unsigned short* qbl = (LAS unsigned short*)(C.lds + 131072 + 8192 + 512);
    const bf16* QI = (const bf16*)(C.ws + WS_QI); const bf16* KW = (const bf16*)(C.ws + WS_KW); u64* MASK = (u64*)(C.ws + WS_MASK);
    const int lane = C.lane, r32 = lane & 31, hi = lane >> 5;
    for (int it = C.bid; it < NB * (T / 8); it += C.G) {
        const int b = it & 3, qg = it >> 2, q0 = qg * 8, qchunk = q0 >> 6, nadm = 64 * (qchunk + 1);
        const int qrow = b * T + q0 + C.wave;
        if (qchunk < 4) {
            MASK[(size_t)qrow * 128 + lane] = lane <= qchunk ? ~0ull : 0ull; MASK[(size_t)qrow * 128 + 64 + lane] = 0ull;
            continue;
        }
        bf16x8 af[4][4];
        {
            const int qq = (r32 >> 2) & 1, hh = (r32 & 3) + 4 * (r32 >> 3);
#pragma unroll
            for (int pr = 0; pr < 4; ++pr) {
                const bf16* qp = QI + (size_t)(b * T + q0 + 2 * pr + qq) * 1024 + hh * 64 + 8 * hi;
#pragma unroll
                for (int kk = 0; kk < 4; ++kk) af[pr][kk] = *(const bf16x8*)(qp + 16 * kk);
            }
            if (C.tid < 128) wvl[C.tid] = bf2f(KW[(size_t)(b * T + q0 + (C.tid >> 4)) * 256 + 64 + (C.tid & 15)]) * 0.015625f;
        }
        __syncthreads();
        { const int qx = C.tid >> 6, dx = C.tid & 63; const bf16* qp = QI + (size_t)(b * T + q0 + qx) * 1024 + dx; float acc = 0.f;
#pragma unroll
          for (int h = 0; h < 16; ++h) acc += wvl[qx * 16 + h] * bf2f(qp[h * 64]);
          qbl[qx * 64 + dx] = (unsigned short)f2bf(acc); }
        __syncthreads();
        bf16x8 afl[4];
        { const int qsel = 2 * (r32 & 3) + ((r32 >> 2) & 1);
#pragma unroll
          for (int kk = 0; kk < 4; ++kk) { const u32x4 z = {0u, 0u, 0u, 0u}; afl[kk] = r32 < 8 ? *(const LAS bf16x8*)(qbl + qsel * 64 + 16 * kk + 8 * hi) : __builtin_bit_cast(bf16x8, z); } }
        for (int rep_t = 0; rep_t < IDX_REP_T; ++rep_t) {
            const int ntile = nadm / 32;
            bf16x8 bfr[4], bnx[4];
            { const bf16* kp = KW + (size_t)(b * T + 32 * C.wave + r32) * 256 + 8 * hi;
#pragma unroll
              for (int kk = 0; kk < 4; ++kk) bnx[kk] = *(const bf16x8*)(kp + 16 * kk); }
            for (int tile = C.wave; tile < ntile; tile += NWAVES) {
                const int key0 = 32 * tile;
#pragma unroll
                for (int kk = 0; kk < 4; ++kk) bfr[kk] = bnx[kk];
                if (tile + NWAVES < ntile) { const bf16* kp = KW + (size_t)(b * T + key0 + 32 * NWAVES + r32) * 256 + 8 * hi;
#pragma unroll
                    for (int kk = 0; kk < 4; ++kk) bnx[kk] = *(const bf16x8*)(kp + 16 * kk); }
                const int kpos = (key0 & ~127) + 2 * ((key0 & 63) + r32) + ((key0 >> 6) & 1);
                f32x16 dl = {0.f, 0.f, 0.f, 0.f, 0.f, 0.f, 0.f, 0.f, 0.f, 0.f, 0.f, 0.f, 0.f, 0.f, 0.f, 0.f};
#pragma unroll
                for (int kk = 0; kk < 4; ++kk) dl = __builtin_amdgcn_mfma_f32_32x32x16_bf16(afl[kk], bfr[kk], dl, 0, 0, 0);
#pragma unroll
                for (int pr = 0; pr < 4; ++pr) {
                    f32x16 d = {0.f, 0.f, 0.f, 0.f, 0.f, 0.f, 0.f, 0.f, 0.f, 0.f, 0.f, 0.f, 0.f, 0.f, 0.f, 0.f};
#pragma unroll
                    for (int kk = 0; kk < 4; ++kk) d = __builtin_amdgcn_mfma_f32_32x32x16_bf16(af[pr][kk], bfr[kk], d, 0, 0, 0);
                    float s0 = dl[pr];
#pragma unroll
                    for (int g = 0; g < 4; ++g) { const f32x4 w4 = *(const LAS f32x4*)(wvl + (2 * pr + hi) * 16 + 4 * g);
                        s0 = __builtin_fmaf(__builtin_fabsf(d[4 * g]), w4.x, s0); s0 = __builtin_fmaf(__builtin_fabsf(d[4 * g + 1]), w4.y, s0); s0 = __builtin_fmaf(__builtin_fabsf(d[4 * g + 2]), w4.z, s0); s0 = __builtin_fmaf(__builtin_fabsf(d[4 * g + 3]), w4.w, s0); }
                    const unsigned short hb = __half_as_ushort(__float2half_rn(s0));
                    const unsigned short key = (hb & 0x8000u) ? (unsigned short)~hb : (unsigned short)(hb | 0x8000u);
                    sc[(2 * pr + hi) * 8192 + kpos] = key;
                }
            }
        }
        __syncthreads();
        const LAS unsigned* my = (const LAS unsigned*)(sc + C.wave * 8192);
        const int nit = nadm / 128;
        const bool tail = (nadm & 64) != 0;
        unsigned thr = 0;
        for (int rep_s = 0; rep_s < IDX_REP_S; ++rep_s) {
            unsigned want = 256u, prefix = 0u;
#pragma unroll 1
            for (int lvl = 0; lvl < 2; ++lvl) {
                hist[lane] = 0u; hist[64 + lane] = 0u; hist[128 + lane] = 0u; hist[192 + lane] = 0u;
                LDS_WAIT(); asm volatile("" ::: "memory");
                int i = 0;
                for (; i + 4 <= nit; i += 4) { unsigned kv[4];
#pragma unroll
                    for (int u = 0; u < 4; ++u) kv[u] = my[64 * (i + u) + lane];
#pragma unroll
                    for (int u = 0; u < 4; ++u) { const unsigned k0 = kv[u] & 0xffffu, k1 = kv[u] >> 16;
                        if (lvl == 0) { atomicAdd((unsigned*)&hist[k0 >> 8], 1u); atomicAdd((unsigned*)&hist[k1 >> 8], 1u); }
                        else { if ((k0 >> 8) == prefix) atomicAdd((unsigned*)&hist[k0 & 255u], 1u); if ((k1 >> 8) == prefix) atomicAdd((unsigned*)&hist[k1 & 255u], 1u); } } }
                for (; i < nit + (tail ? 1 : 0); ++i) { const unsigned kvv = my[64 * i + lane]; const unsigned k0 = kvv & 0xffffu, k1 = kvv >> 16; const bool two = i < nit;
                    if (lvl == 0) { atomicAdd((unsigned*)&hist[k0 >> 8], 1u); if (two) atomicAdd((unsigned*)&hist[k1 >> 8], 1u); }
                    else { if ((k0 >> 8) == prefix) atomicAdd((unsigned*)&hist[k0 & 255u], 1u); if (two && (k1 >> 8) == prefix) atomicAdd((unsigned*)&hist[k1 & 255u], 1u); } }
                LDS_WAIT(); asm volatile("" ::: "memory");
                const unsigned c0 = hist[4 * lane], c1 = hist[4 * lane + 1], c2 = hist[4 * lane + 2], c3 = hist[4 * lane + 3];
                const unsigned tl = c0 + c1 + c2 + c3; unsigned inc = tl;
#pragma unroll
                for (int o = 1; o < 64; o <<= 1) { const unsigned v = __shfl_down(inc, o); if (lane + o < 64) inc += v; }
                const unsigned ab3 = inc - tl, ab2 = ab3 + c3, ab1 = ab2 + c2, ab0 = ab1 + c1;
                int selb = -1; unsigned rem = 0;
                if (ab3 < want && ab3 + c3 >= want) { selb = 3; rem = want - ab3; }
                else if (ab2 < want && ab2 + c2 >= want) { selb = 2; rem = want - ab2; }
                else if (ab1 < want && ab1 + c1 >= want) { selb = 1; rem = want - ab1; }
                else if (ab0 < want && ab0 + c0 >= want) { selb = 0; rem = want - ab0; }
                const u64 bal = __ballot(selb >= 0); const int src = bal ? (int)__ffsll((long long)bal) - 1 : 0;
                const unsigned bin = (unsigned)__shfl(4 * lane + (selb < 0 ? 0 : selb), src); want = (unsigned)__shfl((int)rem, src);
                if (lvl == 0) prefix = bin; else thr = (prefix << 8) | bin;
                LDS_WAIT(); asm volatile("" ::: "memory");
            }
        }
        u64 w0 = 0, w1 = 0;
        for (int i = 0; i < nit + (tail ? 1 : 0); ++i) { const unsigned kvv = my[64 * i + lane]; const u64 b0 = __ballot((kvv & 0xffffu) >= thr), b1 = (i < nit) ? __ballot((kvv >> 16) >= thr) : 0ull;
            if (i < 32) { if (lane == 2 * i) w0 = b0; if (lane == 2 * i + 1) w0 = b1; } else { if (lane == 2 * i - 64) w1 = b0; if (lane == 2 * i - 63) w1 = b1; } }
        MASK[(size_t)qrow * 128 + lane] = w0; MASK[(size_t)qrow * 128 + 64 + lane] = w1;
        __syncthreads();
    }
}
constexpr int AT_KROW = 272, AT_VROW = 136, AT_KB = 64 * AT_KROW, AT_VB = 128 * AT_VROW, AT_BUF = AT_KB + AT_VB;
__device__ __forceinline__ void attn_unit(const Ctx& C, int b, int head, int qb) {
    const bf16* Q = (const bf16*)(C.ws + WS_Q); const bf16* K = (const bf16*)(C.ws + WS_K); const bf16* Vt = (const bf16*)(C.ws + WS_VT);
    const u64* MASK = (const u64*)(C.ws + WS_MASK); bf16* CAT = (bf16*)(C.ws + WS_CAT);
    const int tid = C.tid, lane = C.lane, wid = C.wave, r32 = lane & 31, hi = lane >> 5;
    const int q = 256 * qb + 32 * wid + r32; const size_t row = (size_t)b * T + q;
    const int nt = 4 * qb + 4, myc = 4 * qb + (wid >> 1); const bool late = wid >= 4;
    bf16x8 qf[8];
#pragma unroll
    for (int d0 = 0; d0 < 8; ++d0) qf[d0] = *(const bf16x8*)(Q + row * 1024 + head * 128 + 16 * d0 + 8 * hi);
    const bf16* kg[2]; const bf16* vg[2]; int kl[2], vl[2];
#pragma unroll
    for (int i = 0; i < 2; ++i) { const int c = tid + 512 * i;
        kg[i] = K + ((size_t)b * T + (c >> 4)) * 1024 + head * 128 + (c & 15) * 8; kl[i] = (c >> 4) * AT_KROW + (c & 15) * 16;
        vg[i] = Vt + ((size_t)(b * 8 + head) * 128 + (c >> 3)) * T + (c & 7) * 8; vl[i] = 2 * AT_KB + (c >> 3) * AT_VROW + (c & 7) * 16; }
    u32x4 kr[2], vr[2];
#pragma unroll
    for (int i = 0; i < 2; ++i) { kr[i] = *(const u32x4*)kg[i]; vr[i] = *(const u32x4*)vg[i]; }
#pragma unroll
    for (int i = 0; i < 2; ++i) { *(LAS u32x4*)(C.lds + kl[i]) = kr[i]; *(LAS u32x2*)(C.lds + vl[i]) = (u32x2){vr[i].x, vr[i].y}; *(LAS u32x2*)(C.lds + vl[i] + 8) = (u32x2){vr[i].z, vr[i].w}; }
    __syncthreads();
    float lrun = 0.f; f32x16 o[4];
#pragma unroll
    for (int db = 0; db < 4; ++db)
#pragma unroll
        for (int r = 0; r < 16; ++r) o[db][r] = 0.f;
    bf16x8 pb[4];
#pragma unroll
    for (int kk = 0; kk < 4; ++kk) { const u32x4 z = {0u, 0u, 0u, 0u}; pb[kk] = __builtin_bit_cast(bf16x8, z); }
    f32x16 p0, p1;
#define AT_QK(Ksp) do { _Pragma("unroll") for (int r = 0; r < 16; ++r) { p0[r] = 0.f; p1[r] = 0.f; } \
        const LAS unsigned char* kp0 = (Ksp) + r32 * AT_KROW + 16 * hi; const LAS unsigned char* kp1 = kp0 + 32 * AT_KROW; \
        bf16x8 ka = *(const LAS bf16x8*)kp0, kb = *(const LAS bf16x8*)kp1; \
        _Pragma("unroll") for (int d0 = 0; d0 < 8; ++d0) { bf16x8 na = ka, nb = kb; \
            if (d0 < 7) { na = *(const LAS bf16x8*)(kp0 + 32 * (d0 + 1)); nb = *(const LAS bf16x8*)(kp1 + 32 * (d0 + 1)); } \
            __builtin_amdgcn_sched_barrier(0); \
            p0 = __builtin_amdgcn_mfma_f32_32x32x16_bf16(ka, qf[d0], p0, 0, 0, 0); p1 = __builtin_amdgcn_mfma_f32_32x32x16_bf16(kb, qf[d0], p1, 0, 0, 0); \
            __builtin_amdgcn_sched_barrier(0); ka = na; kb = nb; } } while (0)
#define AT_SM(mwv) do { const int mlo = (int)((unsigned)(mwv) >> (4 * hi)), mhi = (int)((unsigned)((mwv) >> 32) >> (4 * hi)); float ls0 = 0.f, ls1 = 0.f; \
        _Pragma("unroll") for (int r = 0; r < 16; ++r) { const int c = (r & 3) + 8 * (r >> 2); unsigned s0, s1; \
            asm("v_bfe_i32 %0, %1, %2, 1" : "=v"(s0) : "v"(mlo), "n"(c)); asm("v_bfe_i32 %0, %1, %2, 1" : "=v"(s1) : "v"(mhi), "n"(c));       \
            const unsigned e0 = __float_as_uint(__builtin_amdgcn_exp2f(p0[r])) & s0; const unsigned e1 = __float_as_uint(__builtin_amdgcn_exp2f(p1[r])) & s1; \
            p0[r] = __uint_as_float(e0); p1[r] = __uint_as_float(e1); ls0 += p0[r]; ls1 += p1[r]; } \
        lrun += ls0 + ls1; \
        _Pragma("unroll") for (int kk = 0; kk < 4; ++kk) { u32x4 w; \
            _Pragma("unroll") for (int e = 0; e < 4; ++e) { const int r = 8 * (kk & 1) + 2 * e; w[e] = (kk < 2) ? pg8::cvt_pk_bf16(p0[r], p0[r + 1]) : pg8::cvt_pk_bf16(p1[r], p1[r + 1]); } \
            pb[kk] = __builtin_bit_cast(bf16x8, w); } } while (0)
#define AT_PV(Vsp) do { const LAS unsigned char* vp0 = (Vsp) + r32 * AT_VROW + 8 * hi; u32x4 va[4], vn[4]; \
        _Pragma("unroll") for (int kk = 0; kk < 4; ++kk) { const u32x2 a0 = *(const LAS u32x2*)(vp0 + 32 * kk), a1 = *(const LAS u32x2*)(vp0 + 32 * kk + 16); va[kk] = (u32x4){a0.x, a0.y, a1.x, a1.y}; } \
        _Pragma("unroll") for (int db = 0; db < 4; ++db) { \
            if (db < 3) { _Pragma("unroll") for (int kk = 0; kk < 4; ++kk) { const LAS unsigned char* vp = vp0 + 32 * (db + 1) * AT_VROW + 32 * kk; const u32x2 a0 = *(const LAS u32x2*)vp, a1 = *(const LAS u32x2*)(vp + 16); vn[kk] = (u32x4){a0.x, a0.y, a1.x, a1.y}; } } \
            __builtin_amdgcn_sched_barrier(0); \
            _Pragma("unroll") for (int kk = 0; kk < 4; ++kk) o[db] = __builtin_amdgcn_mfma_f32_32x32x16_bf16(__builtin_bit_cast(bf16x8, va[kk]), pb[kk], o[db], 0, 0, 0); \
            __builtin_amdgcn_sched_barrier(0); \
            _Pragma("unroll") for (int kk = 0; kk < 4; ++kk) va[kk] = vn[kk]; } } while (0)
    for (int t = 0; t < nt; ++t) {
        const int kcur = (t & 1) * AT_KB, knxt = ((t + 1) & 1) * AT_KB, vcur = (t % 3) * AT_VB, vprv = ((t + 2) % 3) * AT_VB, vnxt = ((t + 1) % 3) * AT_VB;
        if (t + 1 < nt) {
#pragma unroll
            for (int i = 0; i < 2; ++i) { kr[i] = *(const u32x4*)(kg[i] + (size_t)(t + 1) * 64 * 1024); vr[i] = *(const u32x4*)(vg[i] + (t + 1) * 64); }
        }
        if (late && t >= 1 && t - 1 <= myc) AT_PV(C.lds + 2 * AT_KB + vprv);
        if (t <= myc) { const u64 mw = MASK[row * 128 + t]; AT_QK(C.lds + kcur); AT_SM(mw); }
        if (!late && t <= myc) AT_PV(C.lds + 2 * AT_KB + vcur);
        if (t + 1 < nt) {
#pragma unroll
            for (int i = 0; i < 2; ++i) { *(LAS u32x4*)(C.lds + knxt + kl[i]) = kr[i]; *(LAS u32x2*)(C.lds + vnxt + vl[i]) = (u32x2){vr[i].x, vr[i].y}; *(LAS u32x2*)(C.lds + vnxt + vl[i] + 8) = (u32x2){vr[i].z, vr[i].w}; }
        }
        __syncthreads();
    }
    if (late && nt - 1 <= myc) AT_PV(C.lds + 2 * AT_KB + ((nt - 1) % 3) * AT_VB);
#undef AT_QK
#undef AT_SM
#undef AT_PV
    lrun += __shfl_xor(lrun, 32);
    const float inv = 1.0f / lrun;
    bf16* op = CAT + row * 2048 + head * 128 + 4 * hi;
#pragma unroll
    for (int db = 0; db < 4; ++db)
#pragma unroll
        for (int g = 0; g < 4; ++g) { u32x2 w; w.x = pk2(o[db][4 * g] * inv, o[db][4 * g + 1] * inv); w.y = pk2(o[db][4 * g + 2] * inv, o[db][4 * g + 3] * inv);
            *(u32x2*)(op + 32 * db + 8 * g) = w; }
}
__device__ __forceinline__ void phase_attn(const Ctx& C) {
    for (int i = C.bid; i < 1024; i += C.G) {
        const int w = i & 255, k = i >> 8, combo = w >> 3, j = w & 7;
        const int qb = k == 0 ? j : k == 1 ? 15 - j : k == 2 ? 16 + j : 31 - j;
        attn_unit(C, combo >> 3, combo & 7, qb);
        __syncthreads();
    }
}
__device__ __forceinline__ float ret_logg(int h) { return log1pf(-exp2f(-5.0f - (float)h)); }
constexpr int RT_KP = 72, RT_VP = 136;
__device__ __forceinline__ bf16x8 lds_col8(const LAS bf16* p, int pitch, const int (&rows)[8]) {
    u32x4 w;
#pragma unroll
    for (int e = 0; e < 4; ++e) w[e] = (unsigned)p[rows[2 * e] * pitch] | ((unsigned)p[rows[2 * e + 1] * pitch] << 16);
    return __builtin_bit_cast(bf16x8, w);
}
__device__ __forceinline__ void phase_ret1(const Ctx& C) {
    LAS bf16* Ks = (LAS bf16*)C.lds;
    LAS bf16* Vs = Ks + 64 * RT_KP;
    const bf16* BK = (const bf16*)(C.ws + WS_BK); const bf16* BV = (const bf16*)(C.ws + WS_BV); float* KV = (float*)(C.ws + WS_KVST);
    const int tid = C.tid, lane = C.lane, r32 = lane & 31, hi = lane >> 5, db = C.wave >> 2, eb = C.wave & 3;
    for (int u = C.bid; u < NB * 128 * 4; u += C.G) {
        const int h = u & 3, c = (u >> 2) & 127, b = u >> 9; const size_t row0 = (size_t)b * T + 64 * c; const float lg = ret_logg(h);
        { const int m = tid >> 3, d8 = (tid & 7) * 8; const u32x4 w = *(const u32x4*)(BK + (row0 + m) * 256 + h * 64 + d8); const float z = __expf((63.0f - (float)m) * lg) * 0.125f;
          u32x4 o;
#pragma unroll
          for (int e = 0; e < 4; ++e) o[e] = pk2(bflo(w[e]) * z, bfhi(w[e]) * z);
          *(LAS u32x4*)(Ks + m * RT_KP + d8) = o; }
#pragma unroll
        for (int i = 0; i < 2; ++i) { const int cidx = tid + 512 * i, m = cidx >> 4, e8 = (cidx & 15) * 8; *(LAS u32x4*)(Vs + m * RT_VP + e8) = *(const u32x4*)(BV + (row0 + m) * 512 + h * 128 + e8); }
        __syncthreads();
        f32x16 acc;
#pragma unroll
        for (int r = 0; r < 16; ++r) acc[r] = 0.f;
#pragma unroll
        for (int kk = 0; kk < 4; ++kk) {
            int rows[8];
#pragma unroll
            for (int j = 0; j < 8; ++j) rows[j] = 16 * kk + 8 * hi + j;
            const bf16x8 af = lds_col8(Ks + 32 * db + r32, RT_KP, rows), bfv = lds_col8(Vs + 32 * eb + r32, RT_VP, rows);
            acc = __builtin_amdgcn_mfma_f32_32x32x16_bf16(af, bfv, acc, 0, 0, 0);
        }
        float* dst = KV + (size_t)u * 8192 + (size_t)(32 * eb + r32) * 64 + 32 * db + 4 * hi;
#pragma unroll
        for (int g = 0; g < 4; ++g) *(f32x4*)(dst + 8 * g) = (f32x4){acc[4 * g], acc[4 * g + 1], acc[4 * g + 2], acc[4 * g + 3]};
        __syncthreads();
    }
}
__device__ __forceinline__ void phase_ret2(const Ctx& C) {
    float* KV = (float*)(C.ws + WS_KVST);
    for (int g = C.bid * NTHR + C.tid; g < NB * 4 * 8192; g += C.G * NTHR) {
        const int el = g & 8191, h = (g >> 13) & 3, b = g >> 15; const float gc = __expf(64.0f * ret_logg(h));
        float* p = KV + ((size_t)b * 512 + h) * 8192 + el;
        float st = 0.f;
        for (int c0 = 0; c0 < 128; c0 += 8) { float x[8];
#pragma unroll
            for (int i = 0; i < 8; ++i) x[i] = p[(size_t)(c0 + i) * 4 * 8192];
#pragma unroll
            for (int i = 0; i < 8; ++i) { p[(size_t)(c0 + i) * 4 * 8192] = st; st = st * gc + x[i]; } }
    }
}
__device__ __forceinline__ void phase_ret3(const Ctx& C) {
    LAS bf16* Qs = (LAS bf16*)C.lds;
    LAS bf16* Ks = Qs + 64 * RT_KP;
    LAS bf16* Vs = Ks + 64 * RT_KP;
    LAS float* Red = (LAS float*)(Vs + 64 * RT_VP);
    const bf16* BQ = (const bf16*)(C.ws + WS_BQ); const bf16* BK = (const bf16*)(C.ws + WS_BK); const bf16* BV = (const bf16*)(C.ws + WS_BV); const bf16* BG = (const bf16*)(C.ws + WS_BG);
    const float* KV = (const float*)(C.ws + WS_KVST); bf16* CAT = (bf16*)(C.ws + WS_CAT);
    const int tid = C.tid, lane = C.lane, r32 = lane & 31, hi = lane >> 5, nb = C.wave >> 2, eb = C.wave & 3;
    for (int u = C.bid; u < NB * 128 * 4; u += C.G) {
        const int h = u & 3, c = (u >> 2) & 127, b = u >> 9; const size_t row0 = (size_t)b * T + 64 * c; const float l2g = ret_logg(h) * 1.4426950408889634f;
        { const int m = tid >> 3, d8 = (tid & 7) * 8; *(LAS u32x4*)(Qs + m * RT_KP + d8) = *(const u32x4*)(BQ + (row0 + m) * 256 + h * 64 + d8);
          const u32x4 w = *(const u32x4*)(BK + (row0 + m) * 256 + h * 64 + d8); u32x4 o;
#pragma unroll
          for (int e = 0; e < 4; ++e) o[e] = pk2(bflo(w[e]) * 0.125f, bfhi(w[e]) * 0.125f);
          *(LAS u32x4*)(Ks + m * RT_KP + d8) = o; }
#pragma unroll
        for (int i = 0; i < 2; ++i) { const int cidx = tid + 512 * i, m = cidx >> 4, e8 = (cidx & 15) * 8; *(LAS u32x4*)(Vs + m * RT_VP + e8) = *(const u32x4*)(BV + (row0 + m) * 512 + h * 128 + e8); }
        bf16x8 pf[4];
        { const float* pp = KV + (size_t)u * 8192 + (size_t)(32 * eb + r32) * 64 + 8 * hi;
#pragma unroll
          for (int kk = 0; kk < 4; ++kk) { const f32x4 a0 = *(const f32x4*)(pp + 16 * kk), a1 = *(const f32x4*)(pp + 16 * kk + 4);
              u32x4 w; w.x = pk2(a0.x, a0.y); w.y = pk2(a0.z, a0.w); w.z = pk2(a1.x, a1.y); w.w = pk2(a1.z, a1.w); pf[kk] = __builtin_bit_cast(bf16x8, w); } }
        __syncthreads();
        bf16x8 qf[4];
#pragma unroll
        for (int kk = 0; kk < 4; ++kk) qf[kk] = *(const LAS bf16x8*)(Qs + (32 * nb + r32) * RT_KP + 16 * kk + 8 * hi);
        f32x16 cr, out;
#pragma unroll
        for (int r = 0; r < 16; ++r) { cr[r] = 0.f; out[r] = 0.f; }
#pragma unroll
        for (int kk = 0; kk < 4; ++kk) cr = __builtin_amdgcn_mfma_f32_32x32x16_bf16(qf[kk], pf[kk], cr, 0, 0, 0);
        const float gn = __builtin_amdgcn_exp2f((float)(32 * nb + r32) * l2g);
#pragma unroll
        for (int mb = 0; mb < 2; ++mb) {
            if (mb > nb) continue;
            f32x16 st;
#pragma unroll
            for (int r = 0; r < 16; ++r) st[r] = 0.f;
#pragma unroll
            for (int kk = 0; kk < 4; ++kk) { const bf16x8 kf = *(const LAS bf16x8*)(Ks + (32 * mb + r32) * RT_KP + 16 * kk + 8 * hi); st = __builtin_amdgcn_mfma_f32_32x32x16_bf16(kf, qf[kk], st, 0, 0, 0); }
            const int nq = 32 * nb + r32;
#pragma unroll
            for (int r = 0; r < 16; ++r) { const int m = 32 * mb + (r & 3) + 8 * (r >> 2) + 4 * hi; st[r] = (m <= nq) ? st[r] * gn * __builtin_amdgcn_exp2f(-(float)m * l2g) : 0.f; }
#pragma unroll
            for (int s2 = 0; s2 < 2; ++s2) {
                u32x4 w;
#pragma unroll
                for (int e = 0; e < 4; ++e) w[e] = pg8::cvt_pk_bf16(st[8 * s2 + 2 * e], st[8 * s2 + 2 * e + 1]);
                int rows[8];
#pragma unroll
                for (int j = 0; j < 8; ++j) rows[j] = 32 * mb + 16 * s2 + 8 * (j >> 2) + 4 * hi + (j & 3);
                const bf16x8 vf = lds_col8(Vs + 32 * eb + r32, RT_VP, rows);
                out = __builtin_amdgcn_mfma_f32_32x32x16_bf16(__builtin_bit_cast(bf16x8, w), vf, out, 0, 0, 0);
            }
        }
        float sv[16], s2v[16];
#pragma unroll
        for (int r = 0; r < 16; ++r) { const int n = 32 * nb + (r & 3) + 8 * (r >> 2) + 4 * hi; out[r] += __builtin_amdgcn_exp2f((float)(n + 1) * l2g) * cr[r]; sv[r] = half_sum32(out[r]); s2v[r] = half_sum32(out[r] * out[r]); }
        if (r32 == 0) {
#pragma unroll
            for (int r = 0; r < 16; ++r) { const int n = 32 * nb + (r & 3) + 8 * (r >> 2) + 4 * hi; *(LAS f32x2*)(Red + (n * 4 + eb) * 2) = (f32x2){sv[r], s2v[r]}; }
        }
        __syncthreads();
#pragma unroll
        for (int r = 0; r < 16; ++r) { const int n = 32 * nb + (r & 3) + 8 * (r >> 2) + 4 * hi;
            const f32x4 p0 = *(const LAS f32x4*)(Red + n * 8), p1 = *(const LAS f32x4*)(Red + n * 8 + 4);
            const float mean = (p0.x + p0.z + p1.x + p1.z) * (1.0f / 128.0f), ex2 = (p0.y + p0.w + p1.y + p1.w) * (1.0f / 128.0f);
            const float rstd = rsqrtf(fmaxf(ex2 - mean * mean, 0.f) + 1e-5f);
            const float gg = bf2f(BG[(row0 + n) * 512 + h * 128 + 32 * eb + r32]); const float sl = gg * __builtin_amdgcn_rcpf(1.0f + __expf(-gg));
            CAT[(row0 + n) * 2048 + 1024 + h * 128 + 32 * eb + r32] = (bf16)f2bf((out[r] - mean) * rstd * sl); }
        __syncthreads();
    }
}
__device__ __forceinline__ float sigmoidf_(float x) { return __builtin_amdgcn_rcpf(1.0f + __expf(-x)); }
constexpr int RW_AW = 104, RW_AV = 72, RW_AG = 264;
constexpr int RW1_BUF = 32 * RW_AW * 2 + 32 * RW_AV;
struct RwP { const float *mu, *mu_v, *w0, *a0, *v0, *k_k, *k_a, *r_k, *lnx_g, *lnx_b; };
template <class TT> __device__ __forceinline__ GAS TT* opaque_g(const TT* p) {
    unsigned lo = (unsigned)(uintptr_t)p, hi = (unsigned)((uintptr_t)p >> 32); asm volatile("" : "+v"(lo), "+v"(hi));
    lo = __builtin_amdgcn_readfirstlane(lo); hi = __builtin_amdgcn_readfirstlane(hi); return (GAS TT*)(((uintptr_t)hi << 32) | lo);
}
__device__ __forceinline__ int tokr(int r, int hi) { return (r & 3) + 8 * (r >> 2) + 4 * hi; }
__device__ __forceinline__ void shifted16(GAS bf16* ub, const unsigned (&off)[16], int cbo, bool first_unit, int hi, float mu, float (&x)[16]) {
    float cur[16], prv[4];
#pragma unroll
    for (int r = 0; r < 16; ++r) cur[r] = bf2f(at_b(ub, off[r])[cbo]);
#pragma unroll
    for (int g = 0; g < 4; ++g) { const bool first = (g == 0) && (hi == 0) && first_unit; prv[g] = first ? 0.f : bf2f(at_b(ub, off[4 * g])[cbo - 512]); }
#pragma unroll
    for (int r = 0; r < 16; ++r) { const float p = (r & 3) == 0 ? prv[r >> 2] : cur[r - 1]; x[r] = cur[r] + (p - cur[r]) * mu; }
}
__device__ __forceinline__ void phase_rw1(const Ctx& C, int layer, const RwP& P) {
    LAS bf16* ACT = (LAS bf16*)C.lds;
    const bf16* CR = (const bf16*)(C.ws + WS_CR); const bf16* CK = (const bf16*)(C.ws + WS_CK); const bf16* CV = (const bf16*)(C.ws + WS_CV); const bf16* CL = (const bf16*)(C.ws + WS_CL);
    const bf16* LW = (const bf16*)(C.ws + WS_LORA + LO_W); const bf16* LA = (const bf16*)(C.ws + WS_LORA + LO_A); const bf16* LV = (const bf16*)(C.ws + WS_LORA + LO_V);
    bf16* VF = (bf16*)(C.ws + WS_VFIRST);
    bf16* RR = (bf16*)(C.ws + WS_RR); bf16* RU = (bf16*)(C.ws + WS_RW); bf16* RKH = (bf16*)(C.ws + WS_RKH); bf16* RV = (bf16*)(C.ws + WS_RV); bf16* RA = (bf16*)(C.ws + WS_RA); bf16* RB = (bf16*)(C.ws + WS_RB);
    const float* mu = P.mu + (size_t)layer * 1984; const float* mu_v = P.mu_v;
    const float* w0 = P.w0 + layer * 512; const float* a0 = P.a0 + layer * 512; const float* v0 = P.v0; const float* k_k = P.k_k + layer * 512; const float* k_a = P.k_a + layer * 512;
    const int tid = C.tid, lane = C.lane, wid = C.wave;
    constexpr int NU = M / 32;
    u32x4 ncur[2], nprv[2];
#define RW1_LOAD(uu) do { _Pragma("unroll") for (int j = 0; j < 2; ++j) { const int ci = tid + 512 * j, tok = ci >> 5, c8 = (ci & 31) * 8; const size_t mm = (size_t)(uu) * 32 + tok; \
        ncur[j] = *(const u32x4*)(CL + mm * 256 + c8); const u32x4 z4 = {0u, 0u, 0u, 0u}; nprv[j] = (mm & (T - 1)) == 0 ? z4 : *(const u32x4*)(CL + (mm - 1) * 256 + c8); } } while (0)
#define RW1_STORE(bufi) do { _Pragma("unroll") for (int j = 0; j < 2; ++j) { const int ci = tid + 512 * j, tok = ci >> 5, c8 = (ci & 31) * 8; \
        const float* mp = c8 < 192 ? mu + 1536 + c8 : mu_v + (c8 - 192); f32x4 m0v = {0.f, 0.f, 0.f, 0.f}, m1v = m0v; if (c8 < 192 || layer > 0) { m0v = *(const f32x4*)mp; m1v = *(const f32x4*)(mp + 4); } \
        float xs[8]; _Pragma("unroll") for (int e = 0; e < 4; ++e) { const float c0 = bflo(ncur[j][e]), c1 = bfhi(ncur[j][e]), p0 = bflo(nprv[j][e]), p1 = bfhi(nprv[j][e]); \
            const float ma = e < 2 ? m0v[2 * e] : m1v[2 * e - 4], mb = e < 2 ? m0v[2 * e + 1] : m1v[2 * e - 3]; xs[2 * e] = c0 + (p0 - c0) * ma; xs[2 * e + 1] = c1 + (p1 - c1) * mb; } \
        if (c8 < 96) { _Pragma("unroll") for (int e = 0; e < 8; ++e) xs[e] = 1.0f - 2.0f * __builtin_amdgcn_rcpf(__expf(2.0f * xs[e]) + 1.0f); }     \
        u32x4 o; o.x = pk2(xs[0], xs[1]); o.y = pk2(xs[2], xs[3]); o.z = pk2(xs[4], xs[5]); o.w = pk2(xs[6], xs[7]); \
        LAS bf16* dst = ACT + (bufi) * RW1_BUF + (c8 < 96 ? tok * RW_AW + c8 : c8 < 192 ? 32 * RW_AW + tok * RW_AW + (c8 - 96) : 64 * RW_AW + tok * RW_AV + (c8 - 192)); \
        *(LAS u32x4*)dst = o; } } while (0)
    int u = C.bid; if (u >= NU) return;
    RW1_LOAD(u); RW1_STORE(0); __syncthreads();
    for (int kbuf = 0; ; kbuf ^= 1) {
        const int un = u + C.G; const bool has_next = un < NU;
        if (has_next) RW1_LOAD(un);
        {
            int r32 = lane & 31, hi = lane >> 5; asm volatile("" : "+v"(r32), "+v"(hi));
            const size_t m0 = (size_t)u * 32; const bool first_unit = (m0 & (T - 1)) == 0;
            const LAS bf16* AW = ACT + kbuf * RW1_BUF; const LAS bf16* AA = AW + 32 * RW_AW; const LAS bf16* AV = AA + 32 * RW_AW;
            unsigned off[16];
#pragma unroll
            for (int r = 0; r < 16; ++r) off[r] = (unsigned)(tokr(r, hi) * 512 + 64 * wid + r32) * 2u;
            GAS bf16* CRu = opaque_g(CR + m0 * 512); GAS bf16* CKu = opaque_g(CK + m0 * 512); GAS bf16* CVu = opaque_g(CV + m0 * 512); GAS bf16* VFu = opaque_g(VF + m0 * 512);
            GAS bf16* RRu = opaque_g(RR + m0 * 512); GAS bf16* RUu = opaque_g(RU + m0 * 512); GAS bf16* RKHu = opaque_g(RKH + m0 * 512); GAS bf16* RVu = opaque_g(RV + m0 * 512); GAS bf16* RAu = opaque_g(RA + m0 * 512); GAS bf16* RBu = opaque_g(RB + m0 * 512);
            float ks[2][16], inv[16];
            {
                float ssr[16];
#pragma unroll
                for (int r = 0; r < 16; ++r) ssr[r] = 0.f;
#pragma unroll
                for (int cb = 0; cb < 2; ++cb) { const int c = 64 * wid + 32 * cb + r32; const float kkc = k_k[c]; shifted16(CKu, off, 32 * cb, first_unit, hi, mu[512 + c], ks[cb]);
#pragma unroll
                    for (int r = 0; r < 16; ++r) { const float kr = ks[cb][r] * kkc; ssr[r] += kr * kr; } }
#pragma unroll
                for (int r = 0; r < 16; ++r) inv[r] = 1.0f / fmaxf(sqrtf(half_sum32(ssr[r])), 1e-12f);
            }
#pragma unroll
            for (int cb = 0; cb < 2; ++cb) {
                const int c = 64 * wid + 32 * cb + r32; const int ci = 32 * cb;
                asm volatile("" : "+v"(off[0]), "+v"(off[1]), "+v"(off[2]), "+v"(off[3]), "+v"(off[4]), "+v"(off[5]), "+v"(off[6]), "+v"(off[7]), "+v"(off[8]), "+v"(off[9]), "+v"(off[10]), "+v"(off[11]), "+v"(off[12]), "+v"(off[13]), "+v"(off[14]), "+v"(off[15]));
                {
                    float rs[16]; shifted16(CRu, off, ci, first_unit, hi, mu[c], rs);
#pragma unroll
                    for (int r = 0; r < 16; ++r) at_b(RRu, off[r])[ci] = (bf16)f2bf(rs[r]);
                }
                asm volatile("" ::: "memory");
                {
                    float vs[16]; shifted16(CVu, off, ci, first_unit, hi, mu[1024 + c], vs);
                    if (layer > 0) {
                        f32x16 dv;
#pragma unroll
                        for (int r = 0; r < 16; ++r) dv[r] = 0.f;
#pragma unroll
                        for (int kk = 0; kk < 4; ++kk) { const bf16x8 wv = *(const bf16x8*)(LV + c * 64 + 16 * kk + 8 * hi); const bf16x8 xv = *(const LAS bf16x8*)(AV + r32 * RW_AV + 16 * kk + 8 * hi);
                            dv = __builtin_amdgcn_mfma_f32_32x32x16_bf16(xv, wv, dv, 0, 0, 0); }
                        const float v0c = v0[c];
#pragma unroll
                        for (int r = 0; r < 16; ++r) { const float vf = bf2f(at_b(VFu, off[r])[ci]); at_b(RVu, off[r])[ci] = (bf16)f2bf(vs[r] + (vf - vs[r]) * sigmoidf_(v0c + dv[r])); }
                    } else {
#pragma unroll
                        for (int r = 0; r < 16; ++r) { const bf16 vb = (bf16)f2bf(vs[r]); at_b(VFu, off[r])[ci] = vb; at_b(RVu, off[r])[ci] = vb; }
                    }
                }
                asm volatile("" ::: "memory");
                {
                    f32x16 dw;
#pragma unroll
                    for (int r = 0; r < 16; ++r) dw[r] = 0.f;
#pragma unroll
                    for (int kk = 0; kk < 6; ++kk) { const bf16x8 ww = *(const bf16x8*)(LW + c * 96 + 16 * kk + 8 * hi); const bf16x8 xw = *(const LAS bf16x8*)(AW + r32 * RW_AW + 16 * kk + 8 * hi);
                        dw = __builtin_amdgcn_mfma_f32_32x32x16_bf16(xw, ww, dw, 0, 0, 0); }
                    const float w0c = w0[c];
#pragma unroll
                    for (int r = 0; r < 16; ++r) { const float z = -(w0c + dw[r]); const float sp = fmaxf(z, 0.f) + __logf(1.0f + __expf(-fabsf(z)));
                        at_b(RUu, off[r])[ci] = (bf16)f2bf(1.0f - __expf(-__expf(-sp - 0.5f))); }
                }
                asm volatile("" ::: "memory");
                {
                    f32x16 da;
#pragma unroll
                    for (int r = 0; r < 16; ++r) da[r] = 0.f;
#pragma unroll
                    for (int kk = 0; kk < 6; ++kk) { const bf16x8 wa = *(const bf16x8*)(LA + c * 96 + 16 * kk + 8 * hi); const bf16x8 xa = *(const LAS bf16x8*)(AA + r32 * RW_AW + 16 * kk + 8 * hi);
                        da = __builtin_amdgcn_mfma_f32_32x32x16_bf16(xa, wa, da, 0, 0, 0); }
                    const float a0c = a0[c], kkc = k_k[c], kac = k_a[c];
#pragma unroll
                    for (int r = 0; r < 16; ++r) { const float a = sigmoidf_(a0c + da[r]); const float ksx = ks[cb][r]; const float kk = ksx * kkc * inv[r];
                        at_b(RKHu, off[r])[ci] = (bf16)f2bf(ksx * (1.0f + (a - 1.0f) * kac)); at_b(RAu, off[r])[ci] = (bf16)f2bf(-kk); at_b(RBu, off[r])[ci] = (bf16)f2bf(kk * a); }
                }
                asm volatile("" ::: "memory");
            }
        }
        if (has_next) RW1_STORE(kbuf ^ 1);
        __syncthreads();
        if (!has_next) break;
        u = un;
    }
#undef RW1_LOAD
#undef RW1_STORE
}
constexpr int RW_L = 128, RW_NC = T / RW_L;
constexpr int RW_TB = 8, RW_STG = 5 * RW_TB * 64 + 64;
__device__ __forceinline__ float xhalf_sum(float x) { const auto rr = __builtin_amdgcn_permlane32_swap(__float_as_uint(x), __float_as_uint(x), false, false); return __uint_as_float(rr[0]) + __uint_as_float(rr[1]); }
__device__ __forceinline__ float dot32(const f32x16& d0, const f32x16& d1, const f32x4 (&v)[2][4]) {
    f32x2 acc = {0.f, 0.f};
#pragma unroll
    for (int g = 0; g < 4; ++g) { acc += (f32x2){d0[4 * g], d0[4 * g + 1]} * (f32x2){v[0][g].x, v[0][g].y}; acc += (f32x2){d0[4 * g + 2], d0[4 * g + 3]} * (f32x2){v[0][g].z, v[0][g].w};
        acc += (f32x2){d1[4 * g], d1[4 * g + 1]} * (f32x2){v[1][g].x, v[1][g].y}; acc += (f32x2){d1[4 * g + 2], d1[4 * g + 3]} * (f32x2){v[1][g].z, v[1][g].w}; }
    return acc.x + acc.y;
}
template <int NS, bool OUT>
__device__ __forceinline__ void rwkv_chunk(f32x16 (&D)[NS][2][2], LAS float* stg, const bf16* RWd, const bf16* RA, const bf16* RB, const bf16* RKH, const bf16* RV, const bf16* RR, float* Y, size_t base0, int nsteps, int lane) {
    const int r32 = lane & 31, hi = lane >> 5;
    unsigned short qw[RW_TB], qa[RW_TB], qr[RW_TB], qb[RW_TB], qk[RW_TB], qv[RW_TB];
#define RWC_LOAD(tt) do { _Pragma("unroll") for (int s = 0; s < RW_TB; ++s) { const size_t o = base0 + (size_t)((tt) + s) * 512 + lane; qw[s] = RWd[o]; qa[s] = RA[o]; if (OUT) qr[s] = RR[o]; qb[s] = RB[o]; qk[s] = RKH[o]; qv[s] = RV[o]; } } while (0)
    RWC_LOAD(0);
    float G = 1.0f;
    for (int t0 = 0; t0 < nsteps; t0 += RW_TB) {
#pragma unroll
        for (int s = 0; s < RW_TB; ++s) { const float w = 1.0f - bf2f(qw[s]); stg[(0 * RW_TB + s) * 64 + lane] = bf2f(qa[s]) * G; G *= w; const float ig = __builtin_amdgcn_rcpf(G);
            if (OUT) stg[(1 * RW_TB + s) * 64 + lane] = bf2f(qr[s]) * G; stg[(2 * RW_TB + s) * 64 + lane] = bf2f(qb[s]) * ig; stg[(3 * RW_TB + s) * 64 + lane] = bf2f(qk[s]) * ig; stg[(4 * RW_TB + s) * 64 + lane] = bf2f(qv[s]); }
        if (t0 + RW_TB < nsteps) RWC_LOAD(t0 + RW_TB);
        LDS_WAIT(); asm volatile("" ::: "memory");
#pragma unroll 1
        for (int s = 0; s < RW_TB; ++s) {
            const LAS float* sa_ = stg + (0 * RW_TB + s) * 64 + 4 * hi; const LAS float* sr = stg + (1 * RW_TB + s) * 64 + 4 * hi;
            const LAS float* sbk = stg + ((hi ? 3 : 2) * RW_TB + s) * 64 + r32; const LAS float* sv = stg + (4 * RW_TB + s) * 64 + r32;
            const float bk0 = sbk[0], bk1 = sbk[32], v0 = sv[0], v1 = sv[32];
            float sav[NS][2];
            {
                f32x4 av[2][4];
#pragma unroll
                for (int jb = 0; jb < 2; ++jb)
#pragma unroll
                    for (int g = 0; g < 4; ++g) av[jb][g] = *(const LAS f32x4*)(sa_ + 32 * jb + 8 * g);
#pragma unroll
                for (int st = 0; st < NS; ++st)
#pragma unroll
                    for (int ib = 0; ib < 2; ++ib) sav[st][ib] = xhalf_sum(dot32(D[st][0][ib], D[st][1][ib], av));
            }
#pragma unroll
            for (int st = 0; st < NS; ++st) {
                const bool inject = (NS == 1) || (st == 1);
#pragma unroll
                for (int jb = 0; jb < 2; ++jb) { const float bkj = jb == 0 ? bk0 : bk1; const float A = inject ? bkj : (hi ? 0.f : bkj);
#pragma unroll
                    for (int ib = 0; ib < 2; ++ib) { const float B = hi ? (ib == 0 ? v0 : v1) : sav[st][ib];
                        D[st][jb][ib] = __builtin_amdgcn_mfma_f32_32x32x2f32(A, B, D[st][jb][ib], 0, 0, 0); } }
            }
            if (OUT) {
                f32x4 rv[2][4];
#pragma unroll
                for (int jb = 0; jb < 2; ++jb)
#pragma unroll
                    for (int g = 0; g < 4; ++g) rv[jb][g] = *(const LAS f32x4*)(sr + 32 * jb + 8 * g);
#pragma unroll
                for (int ib = 0; ib < 2; ++ib) { const float y = xhalf_sum(dot32(D[NS - 1][0][ib], D[NS - 1][1][ib], rv));
                    if (hi == 0) Y[base0 + (size_t)(t0 + s) * 512 + 32 * ib + r32] = y; }
            }
        }
        LDS_WAIT(); asm volatile("" ::: "memory");
    }
#undef RWC_LOAD
    stg[5 * RW_TB * 64 + lane] = G;
    LDS_WAIT(); asm volatile("" ::: "memory");
    {
        f32x4 gv[2][4];
#pragma unroll
        for (int jb = 0; jb < 2; ++jb)
#pragma unroll
            for (int g = 0; g < 4; ++g) gv[jb][g] = *(const LAS f32x4*)(stg + 5 * RW_TB * 64 + 4 * hi + 32 * jb + 8 * g);
#pragma unroll
        for (int st = 0; st < NS; ++st)
#pragma unroll
            for (int jb = 0; jb < 2; ++jb)
#pragma unroll
                for (int ib = 0; ib < 2; ++ib)
#pragma unroll
                    for (int g = 0; g < 4; ++g) { f32x16& d = D[st][jb][ib]; d[4 * g] *= gv[jb][g].x; d[4 * g + 1] *= gv[jb][g].y; d[4 * g + 2] *= gv[jb][g].z; d[4 * g + 3] *= gv[jb][g].w; }
    }
    LDS_WAIT(); asm volatile("" ::: "memory");
}
__device__ __forceinline__ void phase_rw2(const Ctx& C) {
    const bf16* RWd = (const bf16*)(C.ws + WS_RW); const bf16* RA = (const bf16*)(C.ws + WS_RA); const bf16* RB = (const bf16*)(C.ws + WS_RB); const bf16* RKH = (const bf16*)(C.ws + WS_RKH); const bf16* RV = (const bf16*)(C.ws + WS_RV);
    float* PHI = (float*)(C.ws + WS_PHI); float* PSI = (float*)(C.ws + WS_PSI);
    LAS float* stg = (LAS float*)C.lds + C.wave * RW_STG;
    const int ntask = NB * 8 * RW_NC, r32 = C.lane & 31, hi = C.lane >> 5;
    for (int task = C.wave * C.G + C.bid; task < ntask; task += C.G * NWAVES) {
        const int ck = task % RW_NC, bh = task / RW_NC, h = bh & 7, b = bh >> 3;
        const size_t base0 = ((size_t)b * T + (size_t)ck * RW_L) * 512 + h * 64;
        f32x16 D[2][2][2];
#pragma unroll
        for (int jb = 0; jb < 2; ++jb)
#pragma unroll
            for (int ib = 0; ib < 2; ++ib)
#pragma unroll
                for (int r = 0; r < 16; ++r) { D[0][jb][ib][r] = (jb == ib && ((r & 3) + 8 * (r >> 2) + 4 * hi) == r32) ? 1.f : 0.f; D[1][jb][ib][r] = 0.f; }
        rwkv_chunk<2, false>(D, stg, RWd, RA, RB, RKH, RV, nullptr, nullptr, base0, RW_L, C.lane);
#pragma unroll
        for (int st = 0; st < 2; ++st) { float* dst = (st == 0 ? PHI : PSI) + (size_t)task * 4096;
#pragma unroll
            for (int jb = 0; jb < 2; ++jb)
#pragma unroll
                for (int ib = 0; ib < 2; ++ib)
#pragma unroll
                    for (int g = 0; g < 4; ++g) *(f32x4*)(dst + (32 * ib + r32) * 64 + 32 * jb + 8 * g + 4 * hi) = (f32x4){D[st][jb][ib][4 * g], D[st][jb][ib][4 * g + 1], D[st][jb][ib][4 * g + 2], D[st][jb][ib][4 * g + 3]}; }
    }
}
constexpr int R3_P = 65;
__device__ __forceinline__ void phase_rw3(const Ctx& C) {
    const float* PHI = (const float*)(C.ws + WS_PHI); const float* PSI = (const float*)(C.ws + WS_PSI); float* SST = (float*)(C.ws + WS_SST);
    const int half = C.wave >> 2, w4 = C.wave & 3, ibo = w4 >> 1, kb = w4 & 1, r32 = C.lane & 31, hi = C.lane >> 5;
    LAS float* Sl = (LAS float*)C.lds + half * (2 * 64 * R3_P);
    for (int pr = C.bid; pr < NB * 8 / 2; pr += C.G) {
        const int bh = 2 * pr + half;
        f32x16 acc;
#pragma unroll
        for (int r = 0; r < 16; ++r) acc[r] = 0.f;
        float ph[32], psn[16];
#define R3_LOAD(tk) do { _Pragma("unroll") for (int s = 0; s < 32; ++s) ph[s] = PHI[(tk) * 4096 + (2 * s + hi) * 64 + 32 * kb + r32]; \
        _Pragma("unroll") for (int r = 0; r < 16; ++r) psn[r] = PSI[(tk) * 4096 + (32 * ibo + (r & 3) + 8 * (r >> 2) + 4 * hi) * 64 + 32 * kb + r32]; } while (0)
        R3_LOAD((size_t)bh * RW_NC);
        for (int ck = 0; ck < RW_NC; ++ck) {
            const size_t task = (size_t)bh * RW_NC + ck; LAS float* Sb = Sl + (ck & 1) * (64 * R3_P);
            float* dst = SST + task * 4096;
#pragma unroll
            for (int r = 0; r < 16; ++r) { const int i = 32 * ibo + (r & 3) + 8 * (r >> 2) + 4 * hi; dst[i * 64 + 32 * kb + r32] = acc[r]; Sb[i * R3_P + 32 * kb + r32] = acc[r]; }
            if (ck + 1 == RW_NC) break;
            float pc[32];
#pragma unroll
            for (int s = 0; s < 32; ++s) pc[s] = ph[s];
#pragma unroll
            for (int r = 0; r < 16; ++r) acc[r] = psn[r];
            if (ck + 2 < RW_NC) R3_LOAD(task + 1);
            __syncthreads();
#pragma unroll
            for (int s = 0; s < 32; ++s) { const float a = Sb[(32 * ibo + r32) * R3_P + 2 * s + hi]; acc = __builtin_amdgcn_mfma_f32_32x32x2f32(a, pc[s], acc, 0, 0, 0); }
        }
#undef R3_LOAD
        __syncthreads();
    }
}
__device__ __forceinline__ void phase_rw4(const Ctx& C) {
    const bf16* RWd = (const bf16*)(C.ws + WS_RW); const bf16* RA = (const bf16*)(C.ws + WS_RA); const bf16* RB = (const bf16*)(C.ws + WS_RB); const bf16* RKH = (const bf16*)(C.ws + WS_RKH); const bf16* RV = (const bf16*)(C.ws + WS_RV); const bf16* RR = (const bf16*)(C.ws + WS_RR);
    const float* SST = (const float*)(C.ws + WS_SST); float* Y = (float*)(C.ws + WS_Y);
    LAS float* stg = (LAS float*)C.lds + C.wave * RW_STG;
    const int ntask = NB * 8 * RW_NC, r32 = C.lane & 31, hi = C.lane >> 5;
    for (int task = C.wave * C.G + C.bid; task < ntask; task += C.G * NWAVES) {
        const int ck = task % RW_NC, bh = task / RW_NC, h = bh & 7, b = bh >> 3;
        const size_t base0 = ((size_t)b * T + (size_t)ck * RW_L) * 512 + h * 64;
        f32x16 D[1][2][2]; const float* src = SST + (size_t)task * 4096;
#pragma unroll
        for (int jb = 0; jb < 2; ++jb)
#pragma unroll
            for (int ib = 0; ib < 2; ++ib)
#pragma unroll
                for (int g = 0; g < 4; ++g) { const f32x4 v = *(const f32x4*)(src + (32 * ib + r32) * 64 + 32 * jb + 8 * g + 4 * hi); D[0][jb][ib][4 * g] = v.x; D[0][jb][ib][4 * g + 1] = v.y; D[0][jb][ib][4 * g + 2] = v.z; D[0][jb][ib][4 * g + 3] = v.w; }
        rwkv_chunk<1, true>(D, stg, RWd, RA, RB, RKH, RV, RR, Y, base0, RW_L, C.lane);
    }
}
__device__ __forceinline__ void phase_rw5(const Ctx& C, int layer, const RwP& P) {
    LAS bf16* ACT = (LAS bf16*)C.lds;
    const bf16* CG = (const bf16*)(C.ws + WS_CG); const bf16* LG = (const bf16*)(C.ws + WS_LORA + LO_G);
    const float* Y = (const float*)(C.ws + WS_Y); const bf16* RR = (const bf16*)(C.ws + WS_RR); const bf16* RKH = (const bf16*)(C.ws + WS_RKH); const bf16* RV = (const bf16*)(C.ws + WS_RV);
    bf16* CAT = (bf16*)(C.ws + WS_CAT);
    const float* mu = P.mu + (size_t)layer * 1984 + 1728; const float* r_k = P.r_k + layer * 512; const float* lnx_g = P.lnx_g + layer * 512; const float* lnx_b = P.lnx_b + layer * 512;
    const int tid = C.tid, lane = C.lane, wid = C.wave;
    constexpr int NU = M / 32;
    u32x4 ncur[2], nprv[2];
#define RW5_LOAD(uu) do { _Pragma("unroll") for (int j = 0; j < 2; ++j) { const int ci = tid + 512 * j, tok = ci >> 5, c8 = (ci & 31) * 8; const size_t mm = (size_t)(uu) * 32 + tok; \
        ncur[j] = *(const u32x4*)(CG + mm * 256 + c8); const u32x4 z4 = {0u, 0u, 0u, 0u}; nprv[j] = (mm & (T - 1)) == 0 ? z4 : *(const u32x4*)(CG + (mm - 1) * 256 + c8); } } while (0)
#define RW5_STORE(bufi) do { _Pragma("unroll") for (int j = 0; j < 2; ++j) { const int ci = tid + 512 * j, tok = ci >> 5, c8 = (ci & 31) * 8; \
        const f32x4 m0v = *(const f32x4*)(mu + c8), m1v = *(const f32x4*)(mu + c8 + 4); \
        float xs[8]; _Pragma("unroll") for (int e = 0; e < 4; ++e) { const float c0 = bflo(ncur[j][e]), c1 = bfhi(ncur[j][e]), p0 = bflo(nprv[j][e]), p1 = bfhi(nprv[j][e]); \
            const float ma = e < 2 ? m0v[2 * e] : m1v[2 * e - 4], mb = e < 2 ? m0v[2 * e + 1] : m1v[2 * e - 3]; xs[2 * e] = sigmoidf_(c0 + (p0 - c0) * ma); xs[2 * e + 1] = sigmoidf_(c1 + (p1 - c1) * mb); } \
        u32x4 o; o.x = pk2(xs[0], xs[1]); o.y = pk2(xs[2], xs[3]); o.z = pk2(xs[4], xs[5]); o.w = pk2(xs[6], xs[7]); \
        *(LAS u32x4*)(ACT + (bufi) * (32 * RW_AG) + tok * RW_AG + c8) = o; } } while (0)
    int u = C.bid; if (u >= NU) return;
    RW5_LOAD(u); RW5_STORE(0); __syncthreads();
    for (int kbuf = 0; ; kbuf ^= 1) {
        const int un = u + C.G; const bool has_next = un < NU;
        if (has_next) RW5_LOAD(un);
        {
            int r32 = lane & 31, hi = lane >> 5; asm volatile("" : "+v"(r32), "+v"(hi));
            const size_t m0 = (size_t)u * 32; const LAS bf16* AG = ACT + kbuf * (32 * RW_AG);
            unsigned off[16];
#pragma unroll
            for (int r = 0; r < 16; ++r) off[r] = (unsigned)(tokr(r, hi) * 512 + 64 * wid + r32) * 2u;
            GAS float* Yu = opaque_g(Y + m0 * 512); GAS bf16* RRu = opaque_g(RR + m0 * 512); GAS bf16* RKHu = opaque_g(RKH + m0 * 512); GAS bf16* RVu = opaque_g(RV + m0 * 512); GAS bf16* CATu = opaque_g(CAT + m0 * 2048 + 1536);
            float yv[2][16], sy[16], sq[16], sb[16];
#pragma unroll
            for (int r = 0; r < 16; ++r) { sy[r] = 0.f; sq[r] = 0.f; sb[r] = 0.f; }
#pragma unroll
            for (int cb = 0; cb < 2; ++cb) { const int c = 64 * wid + 32 * cb + r32; const float rkc = r_k[c];
                asm volatile("" : "+v"(off[0]), "+v"(off[1]), "+v"(off[2]), "+v"(off[3]), "+v"(off[4]), "+v"(off[5]), "+v"(off[6]), "+v"(off[7]), "+v"(off[8]), "+v"(off[9]), "+v"(off[10]), "+v"(off[11]), "+v"(off[12]), "+v"(off[13]), "+v"(off[14]), "+v"(off[15]));
#pragma unroll
                for (int r = 0; r < 16; ++r) { const unsigned o = off[r]; const int ci = 32 * cb; const float y = at_b(Yu, 2u * o)[ci]; yv[cb][r] = y; sy[r] += y; sq[r] += y * y; sb[r] += bf2f(at_b(RRu, o)[ci]) * bf2f(at_b(RKHu, o)[ci]) * rkc; } }
#pragma unroll
            for (int r = 0; r < 16; ++r) { const float mean = half_sum32(sy[r]) * (1.0f / 64.0f); const float ex2 = half_sum32(sq[r]) * (1.0f / 64.0f); sb[r] = half_sum32(sb[r]);
                sy[r] = mean; sq[r] = rsqrtf(fmaxf(ex2 - mean * mean, 0.f) + 64e-5f); }
#pragma unroll
            for (int cb = 0; cb < 2; ++cb) { const int c = 64 * wid + 32 * cb + r32;
                f32x16 dg;
#pragma unroll
                for (int r = 0; r < 16; ++r) dg[r] = 0.f;
#pragma unroll
                for (int kk = 0; kk < 16; ++kk) { const bf16x8 wg = *(const bf16x8*)(LG + c * 256 + 16 * kk + 8 * hi); const bf16x8 xg = *(const LAS bf16x8*)(AG + r32 * RW_AG + 16 * kk + 8 * hi);
                    dg = __builtin_amdgcn_mfma_f32_32x32x16_bf16(xg, wg, dg, 0, 0, 0); }
                const float lgc = lnx_g[c], lbc = lnx_b[c];
#pragma unroll
                for (int r = 0; r < 16; ++r) { const unsigned o = off[r]; const int ci = 32 * cb; const float v = bf2f(at_b(RVu, o)[ci]);
                    at_b(CATu, (unsigned)(tokr(r, hi) * 2048 + 64 * wid + r32) * 2u)[ci] = (bf16)f2bf(((yv[cb][r] - sy[r]) * sq[r] * lgc + lbc + sb[r] * v) * dg[r]); }
            }
        }
        if (has_next) RW5_STORE(kbuf ^ 1);
        __syncthreads();
        if (!has_next) break;
        u = un;
    }
#undef RW5_LOAD
#undef RW5_STORE
}
__device__ __forceinline__ void* launder_ptr(const void* p) {
    unsigned lo = (unsigned)(uintptr_t)p, hi = (unsigned)((uintptr_t)p >> 32); asm volatile("" : "+v"(lo), "+v"(hi));
    lo = __builtin_amdgcn_readfirstlane(lo); hi = __builtin_amdgcn_readfirstlane(hi); return (void*)(((uintptr_t)hi << 32) | lo);
}
#ifndef MK_PER_PHASE
#define MK_PER_PHASE 0
#endif
constexpr int PH_PER_LAYER = 13, N_PHASES = DEPTH * PH_PER_LAYER + 1;
struct Args { const float* in[23]; float* out; unsigned char* ws; int ph_lo, ph_hi; };
#define FRESH() do { KA = (const CAS Args*)launder_ptr((const void*)(uintptr_t)__builtin_amdgcn_kernarg_segment_ptr()); C.ws = KA->ws; C.out = KA->out; ctl = (unsigned*)(C.ws + WS_CTL); asm volatile("" : "+v"(C.tid)); C.lane = C.tid & 63; C.wave = __builtin_amdgcn_readfirstlane(C.tid >> 6); C.lds = (LAS unsigned char*)lds_raw; } while (0)
#ifndef ATT_REP
#define ATT_REP 1
#endif
#ifndef REP_MASK
#define REP_MASK 0u
#endif
#ifndef ONLY_PH
#define ONLY_PH -1
#endif
#ifndef PH_MASK
#define PH_MASK 0xFFFFFFFFu
#endif
#define IN(k) (lo <= (k) && (k) < hi && (ONLY_PH < 0 || ((k) % PH_PER_LAYER) == ONLY_PH) && ((PH_MASK >> ((k) % PH_PER_LAYER)) & 1u))
#define SEAM(k) do { if (IN(k) && IN((k) + 1)) { bar.bar = ctl + CW_BAR; xcd_barrier(bar); } } while (0)
#define PH_BODY(k, ...) do { FRESH(); if (IN(p0 + (k))) { __VA_ARGS__; if ((REP_MASK >> (k)) & 1u) { xcd_barrier(bar); FRESH(); __VA_ARGS__; } } SEAM(p0 + (k)); } while (0)
template <int layer>
__device__ __forceinline__ void layer_phases(Ctx& C, const CAS Args*& KA, XcdBarrier& bar, unsigned*& ctl, unsigned char* lds_raw, const int lo, const int hi) {
    const int p0 = layer * PH_PER_LAYER;
    PH_BODY(0, { const WSrc W{KA->in[2], KA->in[3], KA->in[18], KA->in[20], KA->in[21], KA->in[7], KA->in[9], KA->in[12], KA->in[11]}; phase_wconv(C, layer, W);
                 if (layer == 0) phase_xg(C, KA->in[0], KA->in[1], (bf16*)(C.ws + WS_H), (float*)(C.ws + WS_SS1)); });
    PH_BODY(1, { pg8::Gemm g{(const pg8::bf16_t*)(C.ws + WS_H), (const pg8::bf16_t*)(C.ws + WS_WIN), M, N_INP, DM}; pg8::StaticOrder S; S.init(M, N_INP, C.G, C.bid);
                 pg8::EpiProj E{C.ws, (const float*)(C.ws + WS_SS1)}; pg8::gemm_phase<pg8::EpiProj, pg8::StaticOrder, true, true>(C.lds, g, S, E); });
    FRESH(); if (IN(p0 + 2)) phase_prep_a(C); SEAM(p0 + 2);
    PH_BODY(3, { phase_indexer(C); __syncthreads(); phase_ret1(C); });
    FRESH(); if (IN(p0 + 4)) { for (int rep_a = 0; rep_a < ATT_REP; ++rep_a) { phase_attn(C); __syncthreads(); } phase_ret2(C); } SEAM(p0 + 4);
    PH_BODY(5, { const RwP P{KA->in[4], KA->in[5], KA->in[6], KA->in[8], KA->in[10], KA->in[13], KA->in[14], KA->in[15], KA->in[16], KA->in[17]}; phase_rw1(C, layer, P); });
    PH_BODY(6, { phase_rw2(C); });
    PH_BODY(7, { if (C.G > 32) { if (C.bid < 16) phase_rw3(C); else { Ctx C2 = C; C2.bid = C.bid - 16; C2.G = C.G - 16; phase_ret3(C2); } } else { phase_rw3(C); __syncthreads(); phase_ret3(C); } });
    PH_BODY(8, { phase_rw4(C); });
    PH_BODY(9, { const RwP P{KA->in[4], KA->in[5], KA->in[6], KA->in[8], KA->in[10], KA->in[13], KA->in[14], KA->in[15], KA->in[16], KA->in[17]}; phase_rw5(C, layer, P); });
    FRESH(); if (IN(p0 + 10)) { const float* xin = layer == 0 ? KA->in[0] : C.out;
        pg8::Gemm g{(const pg8::bf16_t*)(C.ws + WS_CAT), (const pg8::bf16_t*)(C.ws + WS_WOUT), M, DM, DM}; pg8::StaticOrder S; S.init(M, DM, C.G, C.bid);
        pg8::EpiResid E{xin, C.out, DM, KA->in[19] + layer * DM, (pg8::bf16_t*)(C.ws + WS_H2), (float*)(C.ws + WS_SS2)}; pg8::gemm_phase<pg8::EpiResid, pg8::StaticOrder, true, true>(C.lds, g, S, E); }
    SEAM(p0 + 10);
    PH_BODY(11, { pg8::Gemm g{(const pg8::bf16_t*)(C.ws + WS_H2), (const pg8::bf16_t*)(C.ws + WS_WGU), M, 2 * DFF, DM}; pg8::StaticOrder S; S.init(M, 2 * DFF, C.G, C.bid);
                  pg8::EpiSwiGLU E{(pg8::bf16_t*)(C.ws + WS_ACT), DFF, (const float*)(C.ws + WS_SS2)}; pg8::gemm_phase<pg8::EpiSwiGLU, pg8::StaticOrder, true, true>(C.lds, g, S, E); });
    FRESH(); if (IN(p0 + 12)) { pg8::Gemm g{(const pg8::bf16_t*)(C.ws + WS_ACT), (const pg8::bf16_t*)(C.ws + WS_WDN), M, DM, DFF}; pg8::StaticOrder S; S.init(M, DM, C.G, C.bid);
        pg8::EpiResid E{C.out, C.out, DM, layer + 1 < DEPTH ? KA->in[1] + (layer + 1) * DM : KA->in[22], layer + 1 < DEPTH ? (pg8::bf16_t*)(C.ws + WS_H) : nullptr, (float*)(C.ws + WS_SS1)};
        pg8::gemm_phase<pg8::EpiResid, pg8::StaticOrder, true, true>(C.lds, g, S, E); }
    SEAM(p0 + 12);
}
__global__ void __launch_bounds__(NTHR, 2) fwd_kernel(Args args) {
    extern __shared__ __attribute__((aligned(16))) unsigned char lds_raw[];
    Ctx C;
    C.lds = (LAS unsigned char*)lds_raw; C.tid = threadIdx.x; C.lane = C.tid & 63; C.wave = __builtin_amdgcn_readfirstlane(C.tid >> 6);
    C.G = gridDim.x; C.bid = blockIdx.x;
    const CAS Args* KA = (const CAS Args*)launder_ptr((const void*)(uintptr_t)__builtin_amdgcn_kernarg_segment_ptr());
    C.ws = KA->ws; C.out = KA->out;
    volatile LAS unsigned* MISC = (volatile LAS unsigned*)(C.lds + MISC_OFF);
    if (C.tid < 32) MISC[C.tid] = 0u;
    __syncthreads();
    unsigned* ctl = (unsigned*)(C.ws + WS_CTL);
    XcdBarrier bar; bar.bar = ctl + CW_BAR; bar.x = 0; bar.st = nullptr;
    if (!MK_PER_PHASE) bar = xcd_barrier_post(ctl + CW_BAR, MISC + 8);
    const int lo = KA->ph_lo, hi = KA->ph_hi;
    layer_phases<0>(C, KA, bar, ctl, lds_raw, lo, hi);
    layer_phases<1>(C, KA, bar, ctl, lds_raw, lo, hi);
    FRESH(); if (IN(N_PHASES - 1)) phase_final_norm(C, C.out, KA->in[22], (const float*)(C.ws + WS_SS1));
#undef IN
#undef SEAM
}

extern "C" void kernel_launch(void* const* d_in, const int* in_sizes, int n_in, void* d_out, int out_size, void* d_ws, size_t ws_size, hipStream_t stream) {
    static int grid = 0;
    if (grid == 0) {
        if (n_in != 23 || out_size != M * DM || ws_size < WS_NEED) { fprintf(stderr, "kernel_launch: unexpected problem (n_in %d, out %d, ws %zu); nothing launched\n", n_in, out_size, ws_size); grid = -1; return; }
        int dev = 0, cus = 0, per_cu = 0;
        if (hipGetDevice(&dev) != hipSuccess || hipDeviceGetAttribute(&cus, hipDeviceAttributeMultiprocessorCount, dev) != hipSuccess) { grid = -1; return; }
        if (hipFuncSetAttribute((const void*)fwd_kernel, hipFuncAttributeMaxDynamicSharedMemorySize, LDS_BYTES) != hipSuccess) { fprintf(stderr, "kernel_launch: hipFuncSetAttribute failed\n"); grid = -1; return; }
        if (hipOccupancyMaxActiveBlocksPerMultiprocessor(&per_cu, (const void*)fwd_kernel, NTHR, LDS_BYTES) != hipSuccess || per_cu < 1) { fprintf(stderr, "kernel_launch: occupancy query says %d blocks per CU\n", per_cu); }
        (void)hipGetLastError();
        grid = cus;
    }
    if (grid < 0) return;
    (void)hipMemsetAsync((char*)d_ws + WS_CTL, 0, CTL_ZERO_BYTES, stream);
    Args a{};
    for (int i = 0; i < 23; ++i) a.in[i] = (const float*)d_in[i];
    a.out = (float*)d_out; a.ws = (unsigned char*)d_ws;
#if MK_PER_PHASE
    for (int p = 0; p < N_PHASES; ++p) { a.ph_lo = p; a.ph_hi = p + 1; hipLaunchKernelGGL(fwd_kernel, dim3(grid), dim3(NTHR), LDS_BYTES, stream, a); }
#else
    a.ph_lo = 0; a.ph_hi = N_PHASES;
    hipLaunchKernelGGL(fwd_kernel, dim3(grid), dim3(NTHR), LDS_BYTES, stream, a);
#endif
    const hipError_t le = hipPeekAtLastError();
    if (le != hipSuccess) fprintf(stderr, "kernel_launch: launch failed: %s\n", hipGetErrorName(le));
}
```

```cpp
#include <hip/hip_runtime.h>
#include <hip/hip_fp16.h>
#include <cstdio>
#include <cstdint>
namespace pg8 {
#define PG8_LAS __attribute__((address_space(3)))
typedef unsigned short bf16_t;
typedef short bf16x8 __attribute__((ext_vector_type(8)));
typedef float f32x4 __attribute__((ext_vector_type(4)));
typedef unsigned u32x4 __attribute__((ext_vector_type(4)));
constexpr int BM = 256, BK = 64, HALF = 128, HTB = HALF * BK * 2  , STAGE_BYTES = 8 * HTB, NXCD = 8, WGM = 8;

__host__ __device__ __forceinline__ int lds_byte(int r, int c) { const int st = (r >> 4) * 2 + (c >> 5), rr = r & 15, cc = c & 31, ob = rr * 64 + cc * 2; return st * 1024 + (ob ^ (((ob >> 9) & 1) << 5)); }
__host__ __device__ __forceinline__ void stage_rc(int b, int& R, int& C) { const int st = b / 1024, sb = b % 1024, swz = sb ^ (((sb >> 9) & 1) << 5); R = (st >> 1) * 16 + swz / 64; C = (st & 1) * 32 + (swz % 64) / 2; }
__host__ __device__ __forceinline__ int perm32(int rho) { const int n = rho >> 4, i = rho & 15; return 8 * (i >> 2) + 4 * n + (i & 3); }

struct Unit { int pm, pn; };
struct Gemm { const bf16_t* A; const bf16_t* Bt; int M, N, K; };

struct StaticOrder {
    int nM, nN, nwg, G, c;
    __host__ __device__ void init(int M, int N, int G_, int c_) { nM = M / BM; nN = N / BM; nwg = nM * nN; G = G_; c = c_; }
    __host__ __device__ bool next(int i, Unit& u) const {
        const long L = (long)i * G + c; if (L >= nwg) return false;
        int wgid = (int)L; { const int q = nwg / NXCD, r = nwg % NXCD, xcd = wgid % NXCD, off = wgid / NXCD; wgid = (xcd < r ? xcd * (q + 1) : r * (q + 1) + (xcd - r) * q) + off; }
        const int nig = WGM * nN, gid = wgid / nig, fm = gid * WGM, gsz = (nM - fm) < WGM ? (nM - fm) : WGM;
        u.pm = fm + ((wgid % nig) % gsz); u.pn = (wgid % nig) / gsz; return true;
    }
    __device__ __forceinline__ void a_ready(const Unit&) const {}
    __device__ __forceinline__ void done(const Unit&) const {}
};

__device__ __forceinline__ unsigned cvt_pk_bf16(float lo, float hi) { unsigned r; asm volatile("v_cvt_pk_bf16_f32 %0, %1, %2" : "=v"(r) : "v"(lo), "v"(hi)); return r; }
typedef float f32x2 __attribute__((ext_vector_type(2)));
__device__ __forceinline__ f32x2 gelu_pk(f32x2 v) {
    const f32x2 av = __builtin_elementwise_abs(v), d = av * 0.2316418882f + 1.0f;
    f32x2 t; t.x = __builtin_amdgcn_rcpf(d.x); t.y = __builtin_amdgcn_rcpf(d.y);
    f32x2 q = t * 0.5307027145f + (-0.7265760135f); q = q * t + 0.7107068705f; q = q * t + (-0.142248368f); q = q * t + 0.127414796f; q = q * t;
    const f32x2 s = (v * v) * (-0.72134752044f);
    f32x2 e; e.x = __builtin_amdgcn_exp2f(s.x); e.y = __builtin_amdgcn_exp2f(s.y);
    const f32x2 m = v * (q * e), r = v - m;
    f32x2 o; o.x = v.x < 0.f ? m.x : r.x; o.y = v.y < 0.f ? m.y : r.y; return o;
}

template <int ACT  > struct EpiBf16 {
    static constexpr bool PERM = true, AFTER_DRAIN = false; static_assert(ACT == 0 || ACT == 1, "EpiBf16: ACT is 0 (none) or 1 (gelu_pk)");
    bf16_t* O; int ldc; const float* bias; int split_cols; size_t split_stride; float scale0;
    __device__ __forceinline__ void operator()(const f32x4 (&acc)[2][2][4][2], const Unit& u, int wr, int wc, int fr, int fq) const {
        const int row0 = u.pm * BM + wr * 64 + fr; int colt = u.pn * BM; bf16_t* base = O;
        float sc = 1.f; if (split_cols) { const int t = colt / split_cols; base += (size_t)t * split_stride; colt -= t * split_cols; if (t == 0) sc = scale0; }
        const int col0 = colt + wc * 32 + 8 * fq, bcol0 = u.pn * BM + wc * 32 + 8 * fq;
        f32x4 bv[2][2];
#pragma unroll
        for (int bj = 0; bj < 2; ++bj)
#pragma unroll
            for (int n = 0; n < 2; ++n) bv[bj][n] = bias ? *(const f32x4*)(bias + bcol0 + bj * HALF + 4 * n) : (f32x4){0.f, 0.f, 0.f, 0.f};
#pragma unroll
        for (int ai = 0; ai < 2; ++ai)
#pragma unroll
            for (int m = 0; m < 4; ++m) { bf16_t* rowp = base + (size_t)(row0 + ai * HALF + m * 16) * ldc + col0;
#pragma unroll
                for (int bj = 0; bj < 2; ++bj) { f32x4 v0 = acc[ai][bj][m][0] + bv[bj][0], v1 = acc[ai][bj][m][1] + bv[bj][1];
                    if (ACT == 1) { f32x2 a = gelu_pk((f32x2){v0[0], v0[1]}), b = gelu_pk((f32x2){v0[2], v0[3]}), c = gelu_pk((f32x2){v1[0], v1[1]}), d = gelu_pk((f32x2){v1[2], v1[3]});
                        v0 = (f32x4){a.x, a.y, b.x, b.y}; v1 = (f32x4){c.x, c.y, d.x, d.y}; }
                    v0 = v0 * sc; v1 = v1 * sc; u32x4 w; w.x = cvt_pk_bf16(v0[0], v0[1]); w.y = cvt_pk_bf16(v0[2], v0[3]); w.z = cvt_pk_bf16(v1[0], v1[1]); w.w = cvt_pk_bf16(v1[2], v1[3]);
                    *(u32x4*)(rowp + bj * HALF) = w; } }
    }
};

__device__ __forceinline__ void tile_dest(int pn, size_t& off, int& ld, int& colt);
__device__ __forceinline__ float row_rstd(const float* ss, int row, int fq) {
    const f32x4* p = (const f32x4*)(ss + (size_t)row * 32 + 8 * fq); const f32x4 a = p[0], b = p[1];
    float s = ((a[0] + a[1]) + (a[2] + a[3])) + ((b[0] + b[1]) + (b[2] + b[3])); s += __shfl_xor(s, 16); s += __shfl_xor(s, 32);
    return rsqrtf(s * (1.0f / 2048.0f) + 1e-5f);
}
struct EpiProj {
    static constexpr bool PERM = true, AFTER_DRAIN = false;
    unsigned char* ws; const float* ss;
    __device__ __forceinline__ void operator()(const f32x4 (&acc)[2][2][4][2], const Unit& u, int wr, int wc, int fr, int fq) const {
        size_t off; int ld, colt; tile_dest(u.pn, off, ld, colt);
        bf16_t* base = (bf16_t*)(ws + off);
        const int row0 = u.pm * BM + wr * 64 + fr, col0 = colt + wc * 32 + 8 * fq;
        const float sc = u.pn < 4 ? 0.12751743074602467f : 1.0f;
        float rsv[2][4];
#pragma unroll
        for (int ai = 0; ai < 2; ++ai)
#pragma unroll
            for (int m = 0; m < 4; ++m) rsv[ai][m] = row_rstd(ss, row0 + ai * HALF + m * 16, fq) * sc;
#pragma unroll
        for (int ai = 0; ai < 2; ++ai)
#pragma unroll
            for (int m = 0; m < 4; ++m) { const int row = row0 + ai * HALF + m * 16; bf16_t* rowp = base + (size_t)row * ld + col0; const float rs = rsv[ai][m];
#pragma unroll
                for (int bj = 0; bj < 2; ++bj) { const f32x4 v0 = acc[ai][bj][m][0] * rs, v1 = acc[ai][bj][m][1] * rs;
                    u32x4 w; w.x = cvt_pk_bf16(v0[0], v0[1]); w.y = cvt_pk_bf16(v0[2], v0[3]); w.z = cvt_pk_bf16(v1[0], v1[1]); w.w = cvt_pk_bf16(v1[2], v1[3]);
                    *(u32x4*)(rowp + bj * HALF) = w; } }
    }
};
struct EpiResid {
    static constexpr bool PERM = true, AFTER_DRAIN = false;
    const bf16_t* base; bf16_t* out; int ldc; float* ss;
    __device__ __forceinline__ static float lo(unsigned w) { return __builtin_bit_cast(float, w << 16); }
    __device__ __forceinline__ static float hi(unsigned w) { return __builtin_bit_cast(float, w & 0xffff0000u); }
    __device__ __forceinline__ void operator()(const f32x4 (&acc)[2][2][4][2], const Unit& u, int wr, int wc, int fr, int fq) const {
        const int row0 = u.pm * BM + wr * 64 + fr, col0 = u.pn * BM + wc * 32 + 8 * fq;
#pragma unroll
        for (int ai = 0; ai < 2; ++ai) { u32x4 bv[4][2];
#pragma unroll
            for (int m = 0; m < 4; ++m)
#pragma unroll
                for (int bj = 0; bj < 2; ++bj) bv[m][bj] = *(const u32x4*)(base + (size_t)(row0 + ai * HALF + m * 16) * ldc + col0 + bj * HALF);
#pragma unroll
            for (int m = 0; m < 4; ++m) { const int row = row0 + ai * HALF + m * 16; const size_t off = (size_t)row * ldc + col0; float sq = 0.f;
#pragma unroll
                for (int bj = 0; bj < 2; ++bj) { const size_t p = off + bj * HALF; const u32x4 b = bv[m][bj]; const f32x4 a0 = acc[ai][bj][m][0], a1 = acc[ai][bj][m][1];
                    u32x4 w; w.x = cvt_pk_bf16(lo(b.x) + a0[0], hi(b.x) + a0[1]); w.y = cvt_pk_bf16(lo(b.y) + a0[2], hi(b.y) + a0[3]);
                    w.z = cvt_pk_bf16(lo(b.z) + a1[0], hi(b.z) + a1[1]); w.w = cvt_pk_bf16(lo(b.w) + a1[2], hi(b.w) + a1[3]);
                    *(u32x4*)(out + p) = w;
                    sq += (lo(w.x) * lo(w.x) + hi(w.x) * hi(w.x)) + (lo(w.y) * lo(w.y) + hi(w.y) * hi(w.y)) + (lo(w.z) * lo(w.z) + hi(w.z) * hi(w.z)) + (lo(w.w) * lo(w.w) + hi(w.w) * hi(w.w)); }
                sq += __shfl_xor(sq, 16); sq += __shfl_xor(sq, 32);
                if (fq == 0) ss[(size_t)row * 32 + u.pn * 4 + wc] = sq; } }
    }
};
struct EpiSwiGLU {
    static constexpr bool PERM = true, AFTER_DRAIN = false;
    bf16_t* O; int ldc; const float* ss;
    __device__ __forceinline__ static float silu_mul(float g, float u) { return g * u * __builtin_amdgcn_rcpf(1.0f + __expf(-g)); }
    __device__ __forceinline__ void operator()(const f32x4 (&acc)[2][2][4][2], const Unit& u, int wr, int wc, int fr, int fq) const {
        const int row0 = u.pm * BM + wr * 64 + fr, col0 = u.pn * HALF + wc * 32 + 8 * fq;
        float rsv[2][4];
#pragma unroll
        for (int ai = 0; ai < 2; ++ai)
#pragma unroll
            for (int m = 0; m < 4; ++m) rsv[ai][m] = row_rstd(ss, row0 + ai * HALF + m * 16, fq);
#pragma unroll
        for (int ai = 0; ai < 2; ++ai)
#pragma unroll
            for (int m = 0; m < 4; ++m) { const int row = row0 + ai * HALF + m * 16; bf16_t* rowp = O + (size_t)row * ldc + col0; const float rs = rsv[ai][m];
                const f32x4 g0 = acc[ai][0][m][0] * rs, g1 = acc[ai][0][m][1] * rs, u0 = acc[ai][1][m][0] * rs, u1 = acc[ai][1][m][1] * rs;
                u32x4 w; w.x = cvt_pk_bf16(silu_mul(g0[0], u0[0]), silu_mul(g0[1], u0[1])); w.y = cvt_pk_bf16(silu_mul(g0[2], u0[2]), silu_mul(g0[3], u0[3]));
                w.z = cvt_pk_bf16(silu_mul(g1[0], u1[0]), silu_mul(g1[1], u1[1])); w.w = cvt_pk_bf16(silu_mul(g1[2], u1[2]), silu_mul(g1[3], u1[3]));
                *(u32x4*)rowp = w; }
    }
};
template <class Epi, class Sched, bool ALIGN_EPI = false, bool SP2 = false>
__device__ __forceinline__ void gemm_phase(PG8_LAS unsigned char* lds, const Gemm g, const Sched& S, const Epi& E) {
    int tid_ = threadIdx.x; asm volatile("" : "+v"(tid_));
    const int tid = tid_, wid = __builtin_amdgcn_readfirstlane(tid >> 6), lane = tid & 63, wr = wid >> 2, wc = wid & 3, fr = lane & 15, fq = lane >> 4;
    const int K = g.K, nt = K / BK;
    unsigned voffA[2], voffB[2];
#pragma unroll
    for (int i = 0; i < 2; ++i) { int R, C; stage_rc(tid * 16 + i * 8192, R, C); const int Rb = Epi::PERM ? ((R & ~31) + perm32(R & 31)) : R;
        voffA[i] = (unsigned)(R * K + C) * 2u; voffB[i] = (unsigned)(Rb * K + C) * 2u; }
    const size_t kstep = (size_t)(BK * 2);
    const size_t hstep = (size_t)HALF * K * 2;
    const size_t tstep = 2 * hstep;
    const unsigned ldsw = (unsigned)wid * 1024u;
    const int aoff = lds_byte(wr * 64 + fr, fq * 8), boff = lds_byte(wc * 32 + fr, fq * 8);
#define PG8_SA(b, h) (((b) * 2 + (h)) * HTB)
#define PG8_SB(b, h) ((4 + (b) * 2 + (h)) * HTB)
#define PG8_STAGE(bufoff, gbase, voff) do { _Pragma("unroll") for (int _i = 0; _i < 2; ++_i) \
        __builtin_amdgcn_global_load_lds((const unsigned*)((const char*)(gbase) + (voff)[_i]), (PG8_LAS unsigned*)(lds + (bufoff) + ldsw + _i * 8192), 16, 0, 0); } while (0)
#define PG8_LDA(dst, b, h) do { _Pragma("unroll") for (int m = 0; m < 4; ++m) _Pragma("unroll") for (int k = 0; k < 2; ++k) dst[m][k] = *(const PG8_LAS bf16x8*)(lds + PG8_SA(b, h) + aoff + m * 2048 + k * 1024); } while (0)
#define PG8_LDB(dst, b, h) do { _Pragma("unroll") for (int n = 0; n < 2; ++n) _Pragma("unroll") for (int k = 0; k < 2; ++k) dst[n][k] = *(const PG8_LAS bf16x8*)(lds + PG8_SB(b, h) + boff + n * 2048 + k * 1024); } while (0)
#define PG8_MMA(ai, bj, At, Bt) do { __builtin_amdgcn_s_setprio(1); _Pragma("unroll") for (int m = 0; m < 4; ++m) _Pragma("unroll") for (int n = 0; n < 2; ++n) _Pragma("unroll") for (int k = 0; k < 2; ++k) \
        acc[ai][bj][m][n] = __builtin_amdgcn_mfma_f32_16x16x32_bf16(Bt[n][k], At[m][k], acc[ai][bj][m][n], 0, 0, 0); __builtin_amdgcn_s_setprio(0); } while (0)
#define PG8_WAIT_V(n) asm volatile("s_waitcnt vmcnt(" #n ")" ::: "memory")
#define PG8_WAIT_L(n) asm volatile("s_waitcnt lgkmcnt(" #n ")" ::: "memory")
#define PG8_BAR __builtin_amdgcn_s_barrier()
#define PG8_SCHED __builtin_amdgcn_sched_barrier(0)
    Unit cur, nxt; int ui = 0;
    if (!S.next(0, cur)) return;
    f32x4 acc[2][2][4][2];
#pragma unroll
    for (int a = 0; a < 2; ++a)
#pragma unroll
        for (int b = 0; b < 2; ++b)
#pragma unroll
            for (int m = 0; m < 4; ++m)
#pragma unroll
                for (int n = 0; n < 2; ++n) acc[a][b][m][n] = (f32x4){0.f, 0.f, 0.f, 0.f};
    bf16x8 At[4][2], B0[2][2], B1[2][2];
    const char* cA = (const char*)g.A + (size_t)cur.pm * tstep; const char* cB = (const char*)g.Bt + (size_t)cur.pn * tstep;
    S.a_ready(cur);
    if constexpr (SP2) {
        PG8_STAGE(PG8_SB(0, 0), cB, voffB); PG8_STAGE(PG8_SB(0, 1), cB + hstep, voffB); PG8_STAGE(PG8_SA(0, 0), cA, voffA); PG8_STAGE(PG8_SA(0, 1), cA + hstep, voffA);
        if (wr == 1) PG8_BAR;
        PG8_WAIT_V(2); PG8_BAR;
        PG8_STAGE(PG8_SB(1, 0), cB + kstep, voffB); PG8_STAGE(PG8_SA(1, 0), cA + kstep, voffA); PG8_STAGE(PG8_SB(1, 1), cB + hstep + kstep, voffB);
        PG8_WAIT_V(6); PG8_BAR;
    } else {
        PG8_STAGE(PG8_SB(0, 0), cB, voffB); PG8_STAGE(PG8_SA(0, 0), cA, voffA); PG8_STAGE(PG8_SB(0, 1), cB + hstep, voffB); PG8_STAGE(PG8_SA(0, 1), cA + hstep, voffA);
        if (wr == 1) PG8_BAR;
        PG8_WAIT_V(4); PG8_BAR;
        PG8_STAGE(PG8_SB(1, 0), cB + kstep, voffB); PG8_STAGE(PG8_SA(1, 0), cA + kstep, voffA); PG8_STAGE(PG8_SB(1, 1), cB + hstep + kstep, voffB);
        PG8_WAIT_V(6); PG8_BAR;
    }
    for (;;) {
        const bool has_next = S.next(ui + 1, nxt);
        const char* nA = has_next ? (const char*)g.A + (size_t)nxt.pm * tstep : cA; const char* nB = has_next ? (const char*)g.Bt + (size_t)nxt.pn * tstep : cB;
        for (int t = 0; t < nt; t += 2) {
            const bool last = (t == nt - 2);
            const char* a1 = cA + (size_t)(t + 1) * kstep;
            const char* a2 = last ? nA : cA + (size_t)(t + 2) * kstep; const char* b2 = last ? nB : cB + (size_t)(t + 2) * kstep;
            const char* a3 = a2 + kstep; const char* b3 = b2 + kstep;
            if (last && has_next) S.a_ready(nxt);
            if constexpr (SP2) {
            PG8_LDB(B0, 0, 0); PG8_LDB(B1, 0, 1); PG8_SCHED; PG8_LDA(At, 0, 0); PG8_STAGE(PG8_SA(1, 1), a1 + hstep, voffA);
            PG8_WAIT_V(8); PG8_WAIT_L(0); PG8_BAR; PG8_MMA(0, 0, At, B0); PG8_MMA(0, 1, At, B1); PG8_BAR; PG8_SCHED;
            PG8_LDA(At, 0, 1); PG8_STAGE(PG8_SB(0, 0), b2, voffB); PG8_STAGE(PG8_SB(0, 1), b2 + hstep, voffB); PG8_STAGE(PG8_SA(0, 0), a2, voffA);
            PG8_WAIT_V(8); PG8_WAIT_L(0); PG8_BAR; PG8_MMA(1, 0, At, B0); PG8_MMA(1, 1, At, B1); PG8_BAR; PG8_SCHED;
            PG8_LDB(B0, 1, 0); PG8_LDB(B1, 1, 1); PG8_SCHED; PG8_LDA(At, 1, 0); PG8_STAGE(PG8_SA(0, 1), a2 + hstep, voffA);
            PG8_WAIT_V(8); PG8_WAIT_L(0); PG8_BAR; PG8_MMA(0, 0, At, B0); PG8_MMA(0, 1, At, B1); PG8_BAR; PG8_SCHED;
            PG8_LDA(At, 1, 1); PG8_STAGE(PG8_SB(1, 0), b3, voffB); PG8_STAGE(PG8_SB(1, 1), b3 + hstep, voffB); PG8_STAGE(PG8_SA(1, 0), a3, voffA);
            PG8_WAIT_V(8); PG8_WAIT_L(0); PG8_BAR; PG8_MMA(1, 0, At, B0); PG8_MMA(1, 1, At, B1); PG8_BAR; PG8_SCHED;
            } else {
            PG8_LDB(B0, 0, 0); PG8_SCHED; PG8_LDA(At, 0, 0); PG8_STAGE(PG8_SA(1, 1), a1 + hstep, voffA);
            PG8_WAIT_L(8); PG8_BAR; PG8_WAIT_L(0); PG8_MMA(0, 0, At, B0); PG8_BAR; PG8_SCHED;
            PG8_LDB(B1, 0, 1); PG8_STAGE(PG8_SB(0, 0), b2, voffB);
            PG8_BAR; PG8_WAIT_L(0); PG8_MMA(0, 1, At, B1); PG8_BAR;
            PG8_LDA(At, 0, 1); PG8_STAGE(PG8_SA(0, 0), a2, voffA);
            PG8_BAR; PG8_WAIT_L(0); PG8_MMA(1, 0, At, B0); PG8_BAR; PG8_SCHED;
            PG8_STAGE(PG8_SB(0, 1), b2 + hstep, voffB);
            PG8_WAIT_V(6); PG8_BAR; PG8_MMA(1, 1, At, B1); PG8_BAR;
            PG8_LDB(B0, 1, 0); PG8_SCHED; PG8_LDA(At, 1, 0); PG8_STAGE(PG8_SA(0, 1), a2 + hstep, voffA);
            PG8_WAIT_L(8); PG8_BAR; PG8_WAIT_L(0); PG8_MMA(0, 0, At, B0); PG8_BAR; PG8_SCHED;
            PG8_LDB(B1, 1, 1); PG8_STAGE(PG8_SB(1, 0), b3, voffB);
            PG8_BAR; PG8_WAIT_L(0); PG8_MMA(0, 1, At, B1); PG8_BAR;
            PG8_LDA(At, 1, 1); PG8_STAGE(PG8_SA(1, 0), a3, voffA);
            PG8_BAR; PG8_WAIT_L(0); PG8_MMA(1, 0, At, B0); PG8_BAR; PG8_SCHED;
            PG8_STAGE(PG8_SB(1, 1), b3 + hstep, voffB);
            PG8_WAIT_V(6); PG8_BAR; PG8_MMA(1, 1, At, B1); PG8_BAR;
            }
        }
        if constexpr (ALIGN_EPI) { if (wr == 0) PG8_BAR; }
        if constexpr (!Epi::AFTER_DRAIN) { E(acc, cur, wr, wc, fr, fq); S.done(cur); }
        if (!has_next) break;
#pragma unroll
        for (int a = 0; a < 2; ++a)
#pragma unroll
            for (int b = 0; b < 2; ++b)
#pragma unroll
                for (int m = 0; m < 4; ++m)
#pragma unroll
                    for (int n = 0; n < 2; ++n) acc[a][b][m][n] = (f32x4){0.f, 0.f, 0.f, 0.f};
        cur = nxt; cA = nA; cB = nB; ++ui;
        if constexpr (ALIGN_EPI) { if (wr == 1) PG8_BAR; }
    }
    PG8_WAIT_V(0);
    if constexpr (!ALIGN_EPI) { if (wr == 0) PG8_BAR; }
    PG8_BAR;
    if constexpr (Epi::AFTER_DRAIN) { E.fused(acc, cur, wr, wc, fr, fq, lds, wid, lane); S.done(cur); }
#undef PG8_SA
#undef PG8_SB
#undef PG8_STAGE
#undef PG8_LDA
#undef PG8_LDB
#undef PG8_MMA
#undef PG8_WAIT_V
#undef PG8_WAIT_L
#undef PG8_BAR
#undef PG8_SCHED
}
}
constexpr int NB = 4, T = 8192, M = NB * T, DM = 2048, DFF = 5632, DEPTH = 2;
constexpr int N_IN = 7696, N_INP = 7936;
constexpr int NWAVES = 8, NTHR = NWAVES * 64;
#define LAS __attribute__((address_space(3)))
#define GAS __attribute__((address_space(1)))
#define CAS __attribute__((address_space(4)))
typedef unsigned short bf16;
typedef short bf16x8 __attribute__((ext_vector_type(8)));
typedef float f32x4 __attribute__((ext_vector_type(4)));
typedef float f32x16 __attribute__((ext_vector_type(16)));
typedef unsigned u32x4 __attribute__((ext_vector_type(4)));
typedef unsigned u32x2 __attribute__((ext_vector_type(2)));
typedef unsigned long long u64;

constexpr size_t MiB = 1u << 20;
constexpr size_t WS_CTL = 0, CTL_ZERO_BYTES = 1 * MiB;
constexpr size_t WS_WIN = 1 * MiB, WS_WOUT = 32 * MiB, WS_WGU = 40 * MiB, WS_WDN = 84 * MiB;
constexpr size_t WS_LORA = 106 * MiB;
constexpr size_t LO_W = 0, LO_A = 512 * 96 * 2, LO_V = 2 * 512 * 96 * 2, LO_G = LO_V + 512 * 64 * 2;
constexpr size_t WS_VFIRST = 107 * MiB;
constexpr size_t WS_H = 139 * MiB;
constexpr size_t WS_VT = 139 * MiB, WS_MASK = 203 * MiB;
constexpr size_t WS_Q = 267 * MiB, WS_K = 331 * MiB, WS_QI = 395 * MiB, WS_V = 459 * MiB, WS_KW = 523 * MiB, WS_BQ = 539 * MiB, WS_BK = 555 * MiB, WS_BV = 571 * MiB, WS_BG = 603 * MiB;
constexpr size_t WS_CR = 635 * MiB, WS_CK = 667 * MiB, WS_CV = 699 * MiB, WS_CL = 731 * MiB, WS_CG = 747 * MiB;
constexpr size_t WS_CAT = 763 * MiB;
constexpr size_t WS_KVST = 891 * MiB;
constexpr size_t WS_TAB = 955 * MiB;
constexpr size_t WS_SS1 = 960 * MiB, WS_SS2 = 964 * MiB;
constexpr size_t TAB_A = 0, TAB_I = (size_t)T * 16 * 8, TAB_R = TAB_I + (size_t)T * 8 * 8, TAB_END = TAB_R + (size_t)T * 32 * 8;
constexpr size_t WS_RR = 139 * MiB, WS_RW = 171 * MiB, WS_RKH = 203 * MiB, WS_RV = 235 * MiB, WS_RA = 267 * MiB, WS_RB = 299 * MiB;
constexpr size_t WS_PHI = 331 * MiB, WS_PSI = 363 * MiB, WS_SST = 395 * MiB, WS_Y = 635 * MiB;
constexpr size_t WS_H2 = 139 * MiB, WS_ACT = 267 * MiB;
constexpr size_t WS_NEED = 1024 * MiB;
static_assert(WS_TAB + TAB_END <= WS_NEED && WS_ACT + (size_t)M * DFF * 2 <= WS_CR && WS_SST + 32 * MiB <= WS_V && WS_RB + 32 * MiB <= WS_PHI && WS_Y + (size_t)M * 512 * 4 <= WS_CV, "ws map");

constexpr int LDS_BYTES = 147456, MISC_OFF = 143360;
constexpr int CW_BAR = 4096;

__device__ __forceinline__ unsigned f2bf(float f) { unsigned u = __builtin_bit_cast(unsigned, f); return (u + 0x7fffu + ((u >> 16) & 1u)) >> 16; }
__device__ __forceinline__ unsigned pk2(float lo, float hi) { return f2bf(lo) | (f2bf(hi) << 16); }
__device__ __forceinline__ float bf2f(unsigned short b) { return __builtin_bit_cast(float, (unsigned)b << 16); }
__device__ __forceinline__ float bflo(unsigned w) { return __builtin_bit_cast(float, w << 16); }
__device__ __forceinline__ float bfhi(unsigned w) { return __builtin_bit_cast(float, w & 0xffff0000u); }
__device__ __forceinline__ float wave_sum(float v) {
#pragma unroll
    for (int o = 1; o < 64; o <<= 1) v += __shfl_xor(v, o);
    return v;
}
#define LDS_WAIT() asm volatile("s_waitcnt lgkmcnt(0)" ::: "memory")
typedef float f32x2 __attribute__((ext_vector_type(2)));
template <class TT> __device__ __forceinline__ GAS TT* at_b(GAS TT* ub, unsigned boff) { return (GAS TT*)((GAS char*)ub + boff); }
__device__ __forceinline__ float half_sum32(float v) { v += __shfl_xor(v, 1); v += __shfl_xor(v, 2); v += __shfl_xor(v, 4); v += __shfl_xor(v, 8); v += __shfl_xor(v, 16); return v; }


namespace pg8 {
__device__ __forceinline__ void tile_dest(int pn, size_t& off, int& ld, int& colt) {
    if (pn < 16) { const int g = pn >> 2; off = g == 0 ? WS_Q : g == 1 ? WS_K : g == 2 ? WS_V : WS_QI; ld = 1024; colt = (pn & 3) * 256; }
    else if (pn == 16) { off = WS_BQ; ld = 256; colt = 0; }
    else if (pn == 17) { off = WS_BK; ld = 256; colt = 0; }
    else if (pn < 20) { off = WS_BV; ld = 512; colt = (pn - 18) * 256; }
    else if (pn < 22) { off = WS_BG; ld = 512; colt = (pn - 20) * 256; }
    else if (pn == 22) { off = WS_KW; ld = 256; colt = 0; }
    else if (pn < 25) { off = WS_CR; ld = 512; colt = (pn - 23) * 256; }
    else if (pn < 27) { off = WS_CK; ld = 512; colt = (pn - 25) * 256; }
    else if (pn < 29) { off = WS_CV; ld = 512; colt = (pn - 27) * 256; }
    else if (pn == 29) { off = WS_CL; ld = 256; colt = 0; }
    else { off = WS_CG; ld = 256; colt = 0; }
}
}
__device__ __forceinline__ int win_src(int n, int layer) {
    if (n < 4096) return n;
    if (n < 4352) return 4176 + (n - 4096);
    if (n < 4608) return 4432 + (n - 4352);
    if (n < 5120) return 4688 + (n - 4608);
    if (n < 5632) return 5200 + (n - 5120);
    if (n < 5888) { const int j = n - 5632; return j < 64 ? 4096 + j : (j < 80 ? 4160 + (j - 64) : -1); }
    if (n < 7424) return 5712 + (n - 5888);
    if (n < 7680) { const int j = n - 7424; return j < 96 ? 7248 + j : (j < 192 ? 7344 + (j - 96) : (layer > 0 ? -2 - (j - 192) : -1)); }
    return 7440 + (n - 7680);
}
#define XB_TMO      128
#define XB_XCNT(j)  (256  + 64 * (j))
#define XB_XSUB(j)  (1280 + 64 * (j))
#define XB_XGEN(j)  (2304 + 64 * (j))
#define XB_TOP      3328
#define XB_TOPGEN   3392
#define XCD_BAR_WORDS 3456
#define XB_SPIN_CAP (1u << 18)

__device__ __forceinline__ unsigned xb_ld(unsigned* p)              { return __hip_atomic_load(p, __ATOMIC_RELAXED, __HIP_MEMORY_SCOPE_AGENT); }
__device__ __forceinline__ unsigned xb_add(unsigned* p, unsigned v) { return __hip_atomic_fetch_add(p, v, __ATOMIC_RELAXED, __HIP_MEMORY_SCOPE_AGENT); }
__device__ __forceinline__ unsigned xb_xcc_id() { return (unsigned)__builtin_amdgcn_s_getreg((3 << 11) | 20) & 0xFu; }
#define XB_SPIN(cond, bar) do { unsigned _sp = 0; while (cond) { __builtin_amdgcn_s_sleep(1); \
    if ((++_sp & 255u) == 0u) { if (xb_ld(&(bar)[XB_TMO])) break; if (_sp > XB_SPIN_CAP) { atomicAdd(&(bar)[XB_TMO], 1u); break; } } } } while (0)

struct XcdBarrier {
    unsigned* bar; unsigned x;
    volatile LAS unsigned* st;
};

__device__ __forceinline__ XcdBarrier xcd_barrier_post(unsigned* bar, volatile LAS unsigned* st) {
    XcdBarrier b; b.bar = bar; b.x = xb_xcc_id(); b.st = st;
    if (threadIdx.x == 0) (void)xb_add(&bar[XB_XCNT(b.x)], 1u);
    return b;
}
__device__ __forceinline__ void xcd_barrier_complete(unsigned* bar, unsigned x, unsigned& nloc, unsigned& nx) {
    const unsigned G = gridDim.x * gridDim.y * gridDim.z;
    unsigned sum, cnt, mine, sp = 0u;
    for (;;) {
        sum = 0u; cnt = 0u; mine = 0u;
#pragma unroll
        for (unsigned j = 0; j < 16; ++j) { const unsigned c = xb_ld(&bar[XB_XCNT(j)]); sum += c; cnt += (c > 0u) ? 1u : 0u; mine = (j == x) ? c : mine; }
        if (sum == G) break;
        __builtin_amdgcn_s_sleep(1);
        if ((++sp & 255u) == 0u) { if (xb_ld(&bar[XB_TMO])) break; if (sp > XB_SPIN_CAP) { atomicAdd(&bar[XB_TMO], 1u); break; } }
    }
    nloc = mine > 0u ? mine : 1u; nx = cnt > 0u ? cnt : 1u;
}

__device__ __forceinline__ void xcd_barrier(const XcdBarrier& b) {
    asm volatile("s_waitcnt vmcnt(0)" ::: "memory");
    __syncthreads();
    if (threadIdx.x == 0) {
        unsigned* bar = b.bar;
        __builtin_amdgcn_s_waitcnt(0);
        unsigned nloc = b.st[0], nx = b.st[1];
        if (nloc == 0u) { xcd_barrier_complete(bar, b.x, nloc, nx); b.st[0] = nloc; b.st[1] = nx; }
        const unsigned old = xb_add(&bar[XB_XSUB(b.x)], 1u);
        const unsigned gen = old / nloc;
        if (old + 1u == (gen + 1u) * nloc) {
            __builtin_amdgcn_fence(__ATOMIC_RELEASE, "agent");
            asm volatile("s_waitcnt vmcnt(0)" ::: "memory");
            const unsigned og = xb_add(&bar[XB_TOP], 1u);
            const unsigned tg = og / nx;
            if (og + 1u == (tg + 1u) * nx) xb_add(&bar[XB_TOPGEN], 1u);
            else XB_SPIN(xb_ld(&bar[XB_TOPGEN]) == tg, bar);
            __builtin_amdgcn_fence(__ATOMIC_ACQUIRE, "agent");
            xb_add(&bar[XB_XGEN(b.x)], 1u);
            asm volatile("s_waitcnt vmcnt(0)" ::: "memory");
        } else {
            XB_SPIN(xb_ld(&bar[XB_XGEN(b.x)]) == gen, bar);
            __builtin_amdgcn_fence(__ATOMIC_ACQUIRE, "agent");
            asm volatile("s_waitcnt vmcnt(0)" ::: "memory");
        }
    }
    __syncthreads();
}

struct Ctx {
    LAS unsigned char* lds; int tid, lane, wave, G, bid; unsigned char* ws; float* out;
};

template <int MAP>
__device__ __forceinline__ void wconv_item(const float* W, int ldw, const float* W2, int K, bf16* WT, LAS float* scr, int item, int nblk, int lane, int layer, const float* gk) {
    const int kb = item / nblk, nb = item % nblk, k0 = 64 * kb, n0 = 32 * nb;
    const int n = n0 + (lane & 31);
    const float* src = nullptr; int ld = ldw;
    if (MAP == 0) src = W + n;
    else if (MAP == 1) { const int s = win_src(n, layer); if (s >= 0) src = W + s; else if (s <= -2) { src = W2 + (-2 - s); ld = 64; } }
    else { const int tl = n >> 8, j = n & 255; src = W + (j < 128 ? tl * 128 + j : DFF + tl * 128 + (j - 128)); }
    float tv[32];
#pragma unroll
    for (int i = 0; i < 32; ++i) { const int kk = 2 * i + (lane >> 5); tv[i] = src ? src[(size_t)(k0 + kk) * ld] : 0.f; }
#pragma unroll
    for (int i = 0; i < 32; ++i) { const int kk = 2 * i + (lane >> 5); scr[kk * 33 + (lane & 31)] = tv[i]; }
    LDS_WAIT(); asm volatile("" ::: "memory");
    const int c = lane & 7;
    f32x4 ga = {1.f, 1.f, 1.f, 1.f}, gb = ga; if (gk) { ga = *(const f32x4*)(gk + k0 + 8 * c); gb = *(const f32x4*)(gk + k0 + 8 * c + 4); }
#pragma unroll
    for (int j = 0; j < 4; ++j) { const int nn = (lane >> 3) + 8 * j; const LAS float* s = scr + (8 * c) * 33 + nn;
        u32x4 o; o.x = pk2(s[0 * 33] * ga.x, s[1 * 33] * ga.y); o.y = pk2(s[2 * 33] * ga.z, s[3 * 33] * ga.w); o.z = pk2(s[4 * 33] * gb.x, s[5 * 33] * gb.y); o.w = pk2(s[6 * 33] * gb.z, s[7 * 33] * gb.w);
        *(u32x4*)(WT + (size_t)(n0 + nn) * K + k0 + 8 * c) = o; }
    LDS_WAIT(); asm volatile("" ::: "memory");
}
struct WSrc { const float *w_in, *w_vres, *w_out, *w_gu, *w_dn, *wlb, *alb, *glb, *vlb, *g_mix, *g_ffn; };
__device__ __forceinline__ void phase_wconv(const Ctx& C, int layer, const WSrc& W) {
    LAS float* scr = (LAS float*)(C.lds + C.wave * 16384);
    const int gw = C.bid * NWAVES + C.wave, NGW = C.G * NWAVES;
    const float* w_in = W.w_in + (size_t)layer * DM * N_IN; const float* w_vres = W.w_vres;
    const float* w_out = W.w_out + (size_t)layer * DM * DM; const float* w_gu = W.w_gu + (size_t)layer * DM * 2 * DFF; const float* w_dn = W.w_dn + (size_t)layer * DFF * DM;
    constexpr int I_IN = (DM / 64) * (N_INP / 32), I_OUT = (DM / 64) * (DM / 32), I_GU = (DM / 64) * (2 * DFF / 32), I_DN = (DFF / 64) * (DM / 32);
    for (int it = gw; it < I_IN + I_OUT + I_GU + I_DN; it += NGW) {
        int r = it;
        if (r < I_IN) { wconv_item<1>(w_in, N_IN, w_vres, DM, (bf16*)(C.ws + WS_WIN), scr, r, N_INP / 32, C.lane, layer, W.g_mix + layer * DM); continue; } r -= I_IN;
        if (r < I_OUT) { wconv_item<0>(w_out, DM, nullptr, DM, (bf16*)(C.ws + WS_WOUT), scr, r, DM / 32, C.lane, layer, nullptr); continue; } r -= I_OUT;
        if (r < I_GU) { wconv_item<2>(w_gu, 2 * DFF, nullptr, DM, (bf16*)(C.ws + WS_WGU), scr, r, 2 * DFF / 32, C.lane, layer, W.g_ffn + layer * DM); continue; } r -= I_GU;
        wconv_item<0>(w_dn, DM, nullptr, DFF, (bf16*)(C.ws + WS_WDN), scr, r, DM / 32, C.lane, layer, nullptr);
    }
    const int gt = C.bid * NTHR + C.tid, NGT = C.G * NTHR;
    const float* wlb = W.wlb + (size_t)layer * 96 * 512; const float* alb = W.alb + (size_t)layer * 96 * 512; const float* glb = W.glb + (size_t)layer * 256 * 512;
    const float* vlb = W.vlb;
    bf16* LW = (bf16*)(C.ws + WS_LORA + LO_W); bf16* LA = (bf16*)(C.ws + WS_LORA + LO_A); bf16* LV = (bf16*)(C.ws + WS_LORA + LO_V); bf16* LG = (bf16*)(C.ws + WS_LORA + LO_G);
    for (int i = gt; i < 512 * 96; i += NGT) { const int n = i / 96, k = i % 96; LW[i] = (bf16)f2bf(wlb[k * 512 + n]); LA[i] = (bf16)f2bf(alb[k * 512 + n]); }
    for (int i = gt; i < 512 * 64; i += NGT) { const int n = i / 64, k = i % 64; LV[i] = (bf16)f2bf(layer > 0 ? vlb[k * 512 + n] : 0.f); }
    for (int i = gt; i < 512 * 256; i += NGT) { const int n = i / 256, k = i % 256; LG[i] = (bf16)f2bf(glb[k * 512 + n]); }
    if (layer == 0) {
        float2* TA = (float2*)(C.ws + WS_TAB + TAB_A); float2* TI = (float2*)(C.ws + WS_TAB + TAB_I); float2* TR = (float2*)(C.ws + WS_TAB + TAB_R);
        const float l2a = 18.931568569324174f  , l2r = 13.287712379549449f  ;
        for (int i = gt; i < T * 56; i += NGT) {
            const int pos = i / 56, j = i % 56; float fr; float2* dst;
            if (j < 16) { fr = exp2f(-(float)j * (1.0f / 16.0f) * l2a); dst = TA + pos * 16 + j; }
            else if (j < 24) { fr = exp2f(-(float)(j - 16) * (1.0f / 8.0f) * l2a); dst = TI + pos * 8 + (j - 16); }
            else { fr = exp2f(-(float)(j - 24) * (1.0f / 32.0f) * l2r); dst = TR + pos * 32 + (j - 24); }
            const float ang = (float)pos * fr; *dst = make_float2(cosf(ang), sinf(ang));
        }
    }
}
__device__ __forceinline__ void phase_xg(const Ctx& C, const float* x, bf16* out, float* ss) {
    const int gw = C.bid * NWAVES + C.wave, NGW = C.G * NWAVES;
    for (int m = gw; m < M; m += NGW) {
        const f32x4* xr = (const f32x4*)(x + (size_t)m * DM) + C.lane; f32x4 v[8]; float s = 0.f;
#pragma unroll
        for (int j = 0; j < 8; ++j) { v[j] = xr[64 * j]; s += (v[j].x * v[j].x + v[j].y * v[j].y) + (v[j].z * v[j].z + v[j].w * v[j].w); }
        s = wave_sum(s); if (C.lane < 32) ss[(size_t)m * 32 + C.lane] = C.lane == 0 ? s : 0.f;
        u32x2* o = (u32x2*)(out + (size_t)m * DM) + C.lane;
#pragma unroll
        for (int j = 0; j < 8; ++j) { u32x2 w; w.x = pk2(v[j].x, v[j].y); w.y = pk2(v[j].z, v[j].w); o[64 * j] = w; }
    }
}
__device__ __forceinline__ void phase_final_norm(const Ctx& C, const bf16* x, float* out, const float* g, const float* ss) {
    const int gw = C.bid * NWAVES + C.wave, NGW = C.G * NWAVES;
    f32x4 gv[8];
#pragma unroll
    for (int j = 0; j < 8; ++j) gv[j] = *(const f32x4*)(g + 4 * (C.lane + 64 * j));
    for (int m = gw; m < M; m += NGW) {
        const u32x2* xr = (const u32x2*)(x + (size_t)m * DM) + C.lane; f32x4* orow = (f32x4*)(out + (size_t)m * DM) + C.lane; const float rs = rsqrtf(wave_sum(C.lane < 32 ? ss[(size_t)m * 32 + C.lane] : 0.f) * (1.0f / DM) + 1e-5f);
#pragma unroll
        for (int j = 0; j < 8; ++j) { const u32x2 w = xr[64 * j]; const f32x4 v = {bflo(w.x), bfhi(w.x), bflo(w.y), bfhi(w.y)}; orow[64 * j] = v * rs * gv[j]; }
    }
}
__device__ __forceinline__ void phase_prep_a(const Ctx& C) {
    const long gt = (long)C.bid * NTHR + C.tid, NGT = (long)C.G * NTHR;
    for (int cfg = 0; cfg < 6; ++cfg) {
        size_t off; int ld, nh, hd, half; size_t tab;
        if (cfg == 0) { off = WS_Q; ld = 1024; nh = 8; hd = 128; half = 16; tab = TAB_A; }
        else if (cfg == 1) { off = WS_K; ld = 1024; nh = 8; hd = 128; half = 16; tab = TAB_A; }
        else if (cfg == 2) { off = WS_QI; ld = 1024; nh = 16; hd = 64; half = 8; tab = TAB_I; }
        else if (cfg == 3) { off = WS_KW; ld = 256; nh = 1; hd = 64; half = 8; tab = TAB_I; }
        else if (cfg == 4) { off = WS_BQ; ld = 256; nh = 4; hd = 64; half = 32; tab = TAB_R; }
        else { off = WS_BK; ld = 256; nh = 4; hd = 64; half = 32; tab = TAB_R; }
        bf16* buf = (bf16*)(C.ws + off); const float2* tb = (const float2*)(C.ws + WS_TAB + tab);
        const int cpp = half >> 3; const long total = (long)M * nh * cpp;
        for (long it0 = gt; it0 < total; it0 += 4 * NGT) {
            bf16* p1[4]; u32x4 a[4], b[4]; f32x4 tcs[4][4]; bool ok[4];
#pragma unroll
            for (int q = 0; q < 4; ++q) { const long it = it0 + q * NGT; ok[q] = it < total; const long itc = ok[q] ? it : gt;
                const int c = (int)(itc % cpp); const long r2 = itc / cpp; const int h = (int)(r2 % nh); const int row = (int)(r2 / nh); const int pos = row & (T - 1);
                p1[q] = buf + (size_t)row * ld + h * hd + 8 * c; a[q] = *(const u32x4*)p1[q]; b[q] = *(const u32x4*)(p1[q] + half);
                const f32x4* tp = (const f32x4*)(tb + (size_t)pos * half + 8 * c);
#pragma unroll
                for (int e = 0; e < 4; ++e) tcs[q][e] = tp[e]; }
#pragma unroll
            for (int q = 0; q < 4; ++q) { if (!ok[q]) continue; u32x4 oa, ob;
#pragma unroll
                for (int e = 0; e < 4; ++e) { const float x10 = bflo(a[q][e]), x11 = bfhi(a[q][e]), x20 = bflo(b[q][e]), x21 = bfhi(b[q][e]); const f32x4 t = tcs[q][e];
                    oa[e] = pk2(x10 * t.x - x20 * t.y, x11 * t.z - x21 * t.w); ob[e] = pk2(x20 * t.x + x10 * t.y, x21 * t.z + x11 * t.w); }
                *(u32x4*)p1[q] = oa; *(u32x4*)(p1[q] + half) = ob; }
        }
    }
    {
        LAS unsigned short* scr = (LAS unsigned short*)(C.lds + C.wave * 9216);
        const bf16* V = (const bf16*)(C.ws + WS_V); bf16* Vt = (bf16*)(C.ws + WS_VT);
        const int gw = C.bid * NWAVES + C.wave, NGW = C.G * NWAVES, lane = C.lane;
        for (int it = gw; it < NB * 128 * 16; it += NGW) {
            const int ct = it & 15, tt = (it >> 4) & 127, b = it >> 11;
            const int t0 = tt * 64, c0 = ct * 64;
            u32x4 v[8];
#pragma unroll
            for (int i = 0; i < 8; ++i) { const int tr = 8 * i + (lane >> 3), c8 = (lane & 7) * 8; v[i] = *(const u32x4*)(V + (size_t)(b * T + t0 + tr) * 1024 + c0 + c8); }
#pragma unroll
            for (int i = 0; i < 8; ++i) { const int tr = 8 * i + (lane >> 3), c8 = (lane & 7) * 8; *(LAS u32x4*)(scr + tr * 72 + c8) = v[i]; }
            LDS_WAIT(); asm volatile("" ::: "memory");
#pragma unroll
            for (int i = 0; i < 8; ++i) { const int cr = 8 * i + (lane >> 3), t8 = (lane & 7) * 8; u32x4 w;
#pragma unroll
                for (int e = 0; e < 4; ++e) w[e] = (unsigned)scr[(t8 + 2 * e) * 72 + cr] | ((unsigned)scr[(t8 + 2 * e + 1) * 72 + cr] << 16);
                *(u32x4*)(Vt + ((size_t)b * 1024 + c0 + cr) * T + t0 + t8) = w; }
            LDS_WAIT(); asm volatile("" ::: "memory");
        }
    }
}
#ifndef IDX_REP_T
#define IDX_REP_T 1
#endif
#ifndef IDX_REP_S
#define IDX_REP_S 1
#endif
__device__ __forceinline__ void phase_indexer(const Ctx& C) {
    LAS unsigned short* sc = (LAS unsigned short*)C.lds;
    LAS unsigned* hist = (LAS unsigned*)(C.lds + 131072) + C.wave * 256;
    LAS float* wvl = (LAS float*)(C.lds + 131072 + 8192);
    LAS unsigned short* qbl = (LAS unsigned short*)(C.lds + 131072 + 8192 + 512);
    const bf16* QI = (const bf16*)(C.ws + WS_QI); const bf16* KW = (const bf16*)(C.ws + WS_KW); u64* MASK = (u64*)(C.ws + WS_MASK);
    const int lane = C.lane, r32 = lane & 31, hi = lane >> 5;
    for (int itk = 0; itk * C.G < NB * (T / 8); ++itk) {
        const int it = itk * C.G + ((itk & 1) ? C.G - 1 - C.bid : C.bid); if (it >= NB * (T / 8)) break;
        const int b = it & 3, qg = it >> 2, q0 = qg * 8, qchunk = q0 >> 6, nadm = 64 * (qchunk + 1);
        const int qrow = b * T + q0 + C.wave;
        if (qchunk < 4) {
            MASK[(size_t)qrow * 128 + lane] = lane <= qchunk ? ~0ull : 0ull; MASK[(size_t)qrow * 128 + 64 + lane] = 0ull;
            continue;
        }
        bf16x8 af[4][4];
        {
            const int qq = (r32 >> 2) & 1, hh = (r32 & 3) + 4 * (r32 >> 3);
#pragma unroll
            for (int pr = 0; pr < 4; ++pr) {
                const bf16* qp = QI + (size_t)(b * T + q0 + 2 * pr + qq) * 1024 + hh * 64 + 8 * hi;
#pragma unroll
                for (int kk = 0; kk < 4; ++kk) af[pr][kk] = *(const bf16x8*)(qp + 16 * kk);
            }
            { LAS u32x4* hz = (LAS u32x4*)(C.lds + 131072); hz[C.tid] = (u32x4){0u, 0u, 0u, 0u}; }
            if (C.tid < 128) wvl[C.tid] = bf2f(KW[(size_t)(b * T + q0 + (C.tid >> 4)) * 256 + 64 + (C.tid & 15)]) * 0.015625f;
        }
        __syncthreads();
        { const int qx = C.tid >> 6, dx = C.tid & 63; const bf16* qp = QI + (size_t)(b * T + q0 + qx) * 1024 + dx; float acc = 0.f;
#pragma unroll
          for (int h = 0; h < 16; ++h) acc += wvl[qx * 16 + h] * bf2f(qp[h * 64]);
          qbl[qx * 64 + dx] = (unsigned short)f2bf(acc); }
        __syncthreads();
        bf16x8 afl[4];
        { const int qsel = 2 * (r32 & 3) + ((r32 >> 2) & 1);
#pragma unroll
          for (int kk = 0; kk < 4; ++kk) { const u32x4 z = {0u, 0u, 0u, 0u}; afl[kk] = r32 < 8 ? *(const LAS bf16x8*)(qbl + qsel * 64 + 16 * kk + 8 * hi) : __builtin_bit_cast(bf16x8, z); } }
        {
            const int ntile = nadm / 32; LAS unsigned* histq = (LAS unsigned*)(C.lds + 131072);
            bf16x8 bfr[4], bnx[4];
            { const bf16* kp = KW + (size_t)(b * T + 32 * C.wave + r32) * 256 + 8 * hi;
#pragma unroll
              for (int kk = 0; kk < 4; ++kk) bnx[kk] = *(const bf16x8*)(kp + 16 * kk); }
            for (int tile = C.wave; tile < ntile; tile += NWAVES) {
                const int key0 = 32 * tile;
#pragma unroll
                for (int kk = 0; kk < 4; ++kk) bfr[kk] = bnx[kk];
                if (tile + NWAVES < ntile) { const bf16* kp = KW + (size_t)(b * T + key0 + 32 * NWAVES + r32) * 256 + 8 * hi;
#pragma unroll
                    for (int kk = 0; kk < 4; ++kk) bnx[kk] = *(const bf16x8*)(kp + 16 * kk); }
                const int kpos = (key0 & ~127) + 2 * ((key0 & 63) + r32) + ((key0 >> 6) & 1);
                f32x16 dl = {0.f, 0.f, 0.f, 0.f, 0.f, 0.f, 0.f, 0.f, 0.f, 0.f, 0.f, 0.f, 0.f, 0.f, 0.f, 0.f};
#pragma unroll
                for (int kk = 0; kk < 4; ++kk) dl = __builtin_amdgcn_mfma_f32_32x32x16_bf16(afl[kk], bfr[kk], dl, 0, 0, 0);
#pragma unroll
                for (int pr = 0; pr < 4; ++pr) {
                    f32x16 d = {0.f, 0.f, 0.f, 0.f, 0.f, 0.f, 0.f, 0.f, 0.f, 0.f, 0.f, 0.f, 0.f, 0.f, 0.f, 0.f};
#pragma unroll
                    for (int kk = 0; kk < 4; ++kk) d = __builtin_amdgcn_mfma_f32_32x32x16_bf16(af[pr][kk], bfr[kk], d, 0, 0, 0);
                    float s0 = dl[pr];
#pragma unroll
                    for (int g = 0; g < 4; ++g) { const f32x4 w4 = *(const LAS f32x4*)(wvl + (2 * pr + hi) * 16 + 4 * g);
                        s0 = __builtin_fmaf(__builtin_fabsf(d[4 * g]), w4.x, s0); s0 = __builtin_fmaf(__builtin_fabsf(d[4 * g + 1]), w4.y, s0); s0 = __builtin_fmaf(__builtin_fabsf(d[4 * g + 2]), w4.z, s0); s0 = __builtin_fmaf(__builtin_fabsf(d[4 * g + 3]), w4.w, s0); }
                    const unsigned short hb = __half_as_ushort(__float2half_rn(s0));
                    const unsigned short key = (hb & 0x8000u) ? (unsigned short)~hb : (unsigned short)(hb | 0x8000u);
                    sc[(2 * pr + hi) * 8192 + kpos] = key; atomicAdd((unsigned*)&histq[(2 * pr + hi) * 256 + (key >> 8)], 1u);
                }
            }
        }
        __syncthreads();
        const LAS unsigned* my = (const LAS unsigned*)(sc + C.wave * 8192);
        const int nit = nadm / 128;
        const bool tail = (nadm & 64) != 0;
        unsigned thr = 0;
        {
            unsigned want = 256u, prefix = 0u;
#pragma unroll 1
            for (int lvl = 0; lvl < 2; ++lvl) {
                if (lvl == 1) {
                    hist[lane] = 0u; hist[64 + lane] = 0u; hist[128 + lane] = 0u; hist[192 + lane] = 0u;
                    LDS_WAIT(); asm volatile("" ::: "memory");
                    int i = 0;
                    for (; i + 4 <= nit; i += 4) { unsigned kv[4];
#pragma unroll
                        for (int u = 0; u < 4; ++u) kv[u] = my[64 * (i + u) + lane];
#pragma unroll
                        for (int u = 0; u < 4; ++u) { const unsigned k0 = kv[u] & 0xffffu, k1 = kv[u] >> 16;
                            if ((k0 >> 8) == prefix) atomicAdd((unsigned*)&hist[k0 & 255u], 1u); if ((k1 >> 8) == prefix) atomicAdd((unsigned*)&hist[k1 & 255u], 1u); } }
                    for (; i < nit + (tail ? 1 : 0); ++i) { const unsigned kvv = my[64 * i + lane]; const unsigned k0 = kvv & 0xffffu, k1 = kvv >> 16; const bool two = i < nit;
                        if ((k0 >> 8) == prefix) atomicAdd((unsigned*)&hist[k0 & 255u], 1u); if (two && (k1 >> 8) == prefix) atomicAdd((unsigned*)&hist[k1 & 255u], 1u); }
                    LDS_WAIT(); asm volatile("" ::: "memory");
                }
                const unsigned c0 = hist[4 * lane], c1 = hist[4 * lane + 1], c2 = hist[4 * lane + 2], c3 = hist[4 * lane + 3];
                const unsigned tl = c0 + c1 + c2 + c3; unsigned inc = tl;
#pragma unroll
                for (int o = 1; o < 64; o <<= 1) { const unsigned v = __shfl_down(inc, o); if (lane + o < 64) inc += v; }
                const unsigned ab3 = inc - tl, ab2 = ab3 + c3, ab1 = ab2 + c2, ab0 = ab1 + c1;
                int selb = -1; unsigned rem = 0;
                if (ab3 < want && ab3 + c3 >= want) { selb = 3; rem = want - ab3; }
                else if (ab2 < want && ab2 + c2 >= want) { selb = 2; rem = want - ab2; }
                else if (ab1 < want && ab1 + c1 >= want) { selb = 1; rem = want - ab1; }
                else if (ab0 < want && ab0 + c0 >= want) { selb = 0; rem = want - ab0; }
                const u64 bal = __ballot(selb >= 0); const int src = bal ? (int)__ffsll((long long)bal) - 1 : 0;
                const unsigned bin = (unsigned)__shfl(4 * lane + (selb < 0 ? 0 : selb), src); want = (unsigned)__shfl((int)rem, src);
                if (lvl == 0) prefix = bin; else thr = (prefix << 8) | bin;
                LDS_WAIT(); asm volatile("" ::: "memory");
            }
        }
        u64 w0 = 0, w1 = 0;
        for (int i = 0; i < nit + (tail ? 1 : 0); ++i) { const unsigned kvv = my[64 * i + lane]; const u64 b0 = __ballot((kvv & 0xffffu) >= thr), b1 = (i < nit) ? __ballot((kvv >> 16) >= thr) : 0ull;
            if (i < 32) { if (lane == 2 * i) w0 = b0; if (lane == 2 * i + 1) w0 = b1; } else { if (lane == 2 * i - 64) w1 = b0; if (lane == 2 * i - 63) w1 = b1; } }
        MASK[(size_t)qrow * 128 + lane] = w0; MASK[(size_t)qrow * 128 + 64 + lane] = w1;
        __syncthreads();
    }
}
constexpr int AT_KROW = 272, AT_VROW = 136, AT_KB = 64 * AT_KROW, AT_VB = 128 * AT_VROW, AT_BUF = AT_KB + AT_VB;
__device__ __forceinline__ void attn_unit(const Ctx& C, int b, int head, int qb) {
    const bf16* Q = (const bf16*)(C.ws + WS_Q); const bf16* K = (const bf16*)(C.ws + WS_K); const bf16* Vt = (const bf16*)(C.ws + WS_VT);
    const u64* MASK = (const u64*)(C.ws + WS_MASK); bf16* CAT = (bf16*)(C.ws + WS_CAT);
    const int tid = C.tid, lane = C.lane, wid = C.wave, r32 = lane & 31, hi = lane >> 5;
    const int q = 256 * qb + 32 * wid + r32; const size_t row = (size_t)b * T + q;
    const int nt = 4 * qb + 4, myc = 4 * qb + (wid >> 1); const bool late = wid >= 4;
    bf16x8 qf[8];
#pragma unroll
    for (int d0 = 0; d0 < 8; ++d0) qf[d0] = *(const bf16x8*)(Q + row * 1024 + head * 128 + 16 * d0 + 8 * hi);
    const bf16* kg[2]; const bf16* vg[2]; int kl[2], vl[2];
#pragma unroll
    for (int i = 0; i < 2; ++i) { const int c = tid + 512 * i;
        kg[i] = K + ((size_t)b * T + (c >> 4)) * 1024 + head * 128 + (c & 15) * 8; kl[i] = (c >> 4) * AT_KROW + (c & 15) * 16;
        vg[i] = Vt + ((size_t)(b * 8 + head) * 128 + (c >> 3)) * T + (c & 7) * 8; vl[i] = 2 * AT_KB + (c >> 3) * AT_VROW + (c & 7) * 16; }
    u32x4 kr[2], vr[2];
#pragma unroll
    for (int i = 0; i < 2; ++i) { kr[i] = *(const u32x4*)kg[i]; vr[i] = *(const u32x4*)vg[i]; }
#pragma unroll
    for (int i = 0; i < 2; ++i) { *(LAS u32x4*)(C.lds + kl[i]) = kr[i]; *(LAS u32x2*)(C.lds + vl[i]) = (u32x2){vr[i].x, vr[i].y}; *(LAS u32x2*)(C.lds + vl[i] + 8) = (u32x2){vr[i].z, vr[i].w}; }
    __syncthreads();
    float lrun = 0.f; f32x16 o[4];
#pragma unroll
    for (int db = 0; db < 4; ++db)
#pragma unroll
        for (int r = 0; r < 16; ++r) o[db][r] = 0.f;
    bf16x8 pb[4];
#pragma unroll
    for (int kk = 0; kk < 4; ++kk) { const u32x4 z = {0u, 0u, 0u, 0u}; pb[kk] = __builtin_bit_cast(bf16x8, z); }
    f32x16 p0, p1;
#define AT_QK(Ksp) do { _Pragma("unroll") for (int r = 0; r < 16; ++r) { p0[r] = 0.f; p1[r] = 0.f; } \
        const LAS unsigned char* kp0 = (Ksp) + r32 * AT_KROW + 16 * hi; const LAS unsigned char* kp1 = kp0 + 32 * AT_KROW; \
        bf16x8 ka = *(const LAS bf16x8*)kp0, kb = *(const LAS bf16x8*)kp1; \
        _Pragma("unroll") for (int d0 = 0; d0 < 8; ++d0) { bf16x8 na = ka, nb = kb; \
            if (d0 < 7) { na = *(const LAS bf16x8*)(kp0 + 32 * (d0 + 1)); nb = *(const LAS bf16x8*)(kp1 + 32 * (d0 + 1)); } \
            __builtin_amdgcn_sched_barrier(0); \
            p0 = __builtin_amdgcn_mfma_f32_32x32x16_bf16(ka, qf[d0], p0, 0, 0, 0); p1 = __builtin_amdgcn_mfma_f32_32x32x16_bf16(kb, qf[d0], p1, 0, 0, 0); \
            __builtin_amdgcn_sched_barrier(0); ka = na; kb = nb; } } while (0)
#define AT_SM(mwv) do { const int mlo = (int)((unsigned)(mwv) >> (4 * hi)), mhi = (int)((unsigned)((mwv) >> 32) >> (4 * hi)); float ls0 = 0.f, ls1 = 0.f; \
        _Pragma("unroll") for (int r = 0; r < 16; ++r) { const int c = (r & 3) + 8 * (r >> 2); unsigned s0, s1; \
            asm("v_bfe_i32 %0, %1, %2, 1" : "=v"(s0) : "v"(mlo), "n"(c)); asm("v_bfe_i32 %0, %1, %2, 1" : "=v"(s1) : "v"(mhi), "n"(c));       \
            const unsigned e0 = __float_as_uint(__builtin_amdgcn_exp2f(p0[r])) & s0; const unsigned e1 = __float_as_uint(__builtin_amdgcn_exp2f(p1[r])) & s1; \
            p0[r] = __uint_as_float(e0); p1[r] = __uint_as_float(e1); ls0 += p0[r]; ls1 += p1[r]; } \
        lrun += ls0 + ls1; \
        _Pragma("unroll") for (int kk = 0; kk < 4; ++kk) { u32x4 w; \
            _Pragma("unroll") for (int e = 0; e < 4; ++e) { const int r = 8 * (kk & 1) + 2 * e; w[e] = (kk < 2) ? pg8::cvt_pk_bf16(p0[r], p0[r + 1]) : pg8::cvt_pk_bf16(p1[r], p1[r + 1]); } \
            pb[kk] = __builtin_bit_cast(bf16x8, w); } } while (0)
#define AT_PV(Vsp) do { const LAS unsigned char* vp0 = (Vsp) + r32 * AT_VROW + 8 * hi; u32x4 va[4], vn[4]; \
        _Pragma("unroll") for (int kk = 0; kk < 4; ++kk) { const u32x2 a0 = *(const LAS u32x2*)(vp0 + 32 * kk), a1 = *(const LAS u32x2*)(vp0 + 32 * kk + 16); va[kk] = (u32x4){a0.x, a0.y, a1.x, a1.y}; } \
        _Pragma("unroll") for (int db = 0; db < 4; ++db) { \
            if (db < 3) { _Pragma("unroll") for (int kk = 0; kk < 4; ++kk) { const LAS unsigned char* vp = vp0 + 32 * (db + 1) * AT_VROW + 32 * kk; const u32x2 a0 = *(const LAS u32x2*)vp, a1 = *(const LAS u32x2*)(vp + 16); vn[kk] = (u32x4){a0.x, a0.y, a1.x, a1.y}; } } \
            __builtin_amdgcn_sched_barrier(0); \
            _Pragma("unroll") for (int kk = 0; kk < 4; ++kk) o[db] = __builtin_amdgcn_mfma_f32_32x32x16_bf16(__builtin_bit_cast(bf16x8, va[kk]), pb[kk], o[db], 0, 0, 0); \
            __builtin_amdgcn_sched_barrier(0); \
            _Pragma("unroll") for (int kk = 0; kk < 4; ++kk) va[kk] = vn[kk]; } } while (0)
    for (int t = 0; t < nt; ++t) {
        const int kcur = (t & 1) * AT_KB, knxt = ((t + 1) & 1) * AT_KB, vcur = (t % 3) * AT_VB, vprv = ((t + 2) % 3) * AT_VB, vnxt = ((t + 1) % 3) * AT_VB;
        if (t + 1 < nt) {
#pragma unroll
            for (int i = 0; i < 2; ++i) { kr[i] = *(const u32x4*)(kg[i] + (size_t)(t + 1) * 64 * 1024); vr[i] = *(const u32x4*)(vg[i] + (t + 1) * 64); }
        }
        if (late && t >= 1 && t - 1 <= myc) AT_PV(C.lds + 2 * AT_KB + vprv);
        if (t <= myc) { const u64 mw = MASK[row * 128 + t]; AT_QK(C.lds + kcur); AT_SM(mw); }
        if (!late && t <= myc) AT_PV(C.lds + 2 * AT_KB + vcur);
        if (t + 1 < nt) {
#pragma unroll
            for (int i = 0; i < 2; ++i) { *(LAS u32x4*)(C.lds + knxt + kl[i]) = kr[i]; *(LAS u32x2*)(C.lds + vnxt + vl[i]) = (u32x2){vr[i].x, vr[i].y}; *(LAS u32x2*)(C.lds + vnxt + vl[i] + 8) = (u32x2){vr[i].z, vr[i].w}; }
        }
        __syncthreads();
    }
    if (late && nt - 1 <= myc) AT_PV(C.lds + 2 * AT_KB + ((nt - 1) % 3) * AT_VB);
#undef AT_QK
#undef AT_SM
#undef AT_PV
    lrun += __shfl_xor(lrun, 32);
    const float inv = 1.0f / lrun;
    bf16* op = CAT + row * 2048 + head * 128 + 4 * hi;
#pragma unroll
    for (int db = 0; db < 4; ++db)
#pragma unroll
        for (int g = 0; g < 4; ++g) { u32x2 w; w.x = pk2(o[db][4 * g] * inv, o[db][4 * g + 1] * inv); w.y = pk2(o[db][4 * g + 2] * inv, o[db][4 * g + 3] * inv);
            *(u32x2*)(op + 32 * db + 8 * g) = w; }
}
__device__ __forceinline__ void phase_attn(const Ctx& C) {
    for (int i = C.bid; i < 1024; i += C.G) {
        const int w = i & 255, k = i >> 8, combo = ((w & 7) >> 1) * 8 + (w >> 5), j = 2 * ((w >> 3) & 3) + (w & 1);
        const int qb = k == 0 ? j : k == 1 ? 15 - j : k == 2 ? 16 + j : 31 - j;
        attn_unit(C, combo >> 3, combo & 7, qb);
        __syncthreads();
    }
}
__device__ __forceinline__ float ret_logg(int h) { return log1pf(-exp2f(-5.0f - (float)h)); }
constexpr int RT_KP = 72, RT_VP = 136;
__device__ __forceinline__ bf16x8 lds_col8(const LAS bf16* p, int pitch, const int (&rows)[8]) {
    u32x4 w;
#pragma unroll
    for (int e = 0; e < 4; ++e) w[e] = (unsigned)p[rows[2 * e] * pitch] | ((unsigned)p[rows[2 * e + 1] * pitch] << 16);
    return __builtin_bit_cast(bf16x8, w);
}
__device__ __forceinline__ void phase_ret1(const Ctx& C) {
    LAS bf16* Ks = (LAS bf16*)C.lds;
    LAS bf16* Vs = Ks + 64 * RT_KP;
    const bf16* BK = (const bf16*)(C.ws + WS_BK); const bf16* BV = (const bf16*)(C.ws + WS_BV); float* KV = (float*)(C.ws + WS_KVST);
    const int tid = C.tid, lane = C.lane, r32 = lane & 31, hi = lane >> 5, db = C.wave >> 2, eb = C.wave & 3;
    u32x4 kw, vw[2];
#define RET1_LOAD(uu) do { const int h_ = (uu) & 3, c_ = ((uu) >> 2) & 127, b_ = (uu) >> 9; const size_t r0_ = (size_t)b_ * T + 64 * c_; \
        kw = *(const u32x4*)(BK + (r0_ + (tid >> 3)) * 256 + h_ * 64 + (tid & 7) * 8); \
        _Pragma("unroll") for (int i = 0; i < 2; ++i) { const int cidx = tid + 512 * i; vw[i] = *(const u32x4*)(BV + (r0_ + (cidx >> 4)) * 512 + h_ * 128 + (cidx & 15) * 8); } } while (0)
    if (C.bid < NB * 128 * 4) RET1_LOAD(C.bid);
    for (int u = C.bid; u < NB * 128 * 4; u += C.G) {
        const int h = u & 3; const float lg = ret_logg(h);
        { const int m = tid >> 3, d8 = (tid & 7) * 8; const u32x4 w = kw; const float z = __expf((63.0f - (float)m) * lg) * 0.125f;
          u32x4 o;
#pragma unroll
          for (int e = 0; e < 4; ++e) o[e] = pk2(bflo(w[e]) * z, bfhi(w[e]) * z);
          *(LAS u32x4*)(Ks + m * RT_KP + d8) = o; }
#pragma unroll
        for (int i = 0; i < 2; ++i) { const int cidx = tid + 512 * i, m = cidx >> 4, e8 = (cidx & 15) * 8; *(LAS u32x4*)(Vs + m * RT_VP + e8) = vw[i]; }
        if (u + C.G < NB * 128 * 4) RET1_LOAD(u + C.G);
        __syncthreads();
        f32x16 acc;
#pragma unroll
        for (int r = 0; r < 16; ++r) acc[r] = 0.f;
#pragma unroll
        for (int kk = 0; kk < 4; ++kk) {
            int rows[8];
#pragma unroll
            for (int j = 0; j < 8; ++j) rows[j] = 16 * kk + 8 * hi + j;
            const bf16x8 af = lds_col8(Ks + 32 * db + r32, RT_KP, rows), bfv = lds_col8(Vs + 32 * eb + r32, RT_VP, rows);
            acc = __builtin_amdgcn_mfma_f32_32x32x16_bf16(af, bfv, acc, 0, 0, 0);
        }
        float* dst = KV + (size_t)u * 8192 + (size_t)(32 * eb + r32) * 64 + 32 * db + 4 * hi;
#pragma unroll
        for (int g = 0; g < 4; ++g) *(f32x4*)(dst + 8 * g) = (f32x4){acc[4 * g], acc[4 * g + 1], acc[4 * g + 2], acc[4 * g + 3]};
        __syncthreads();
    }
}
__device__ __forceinline__ void phase_ret2(const Ctx& C) {
    float* KV = (float*)(C.ws + WS_KVST);
    for (int g = C.bid * NTHR + C.tid; g < NB * 4 * 8192; g += C.G * NTHR) {
        const int el = g & 8191, h = (g >> 13) & 3, b = g >> 15; const float gc = __expf(64.0f * ret_logg(h));
        float* p = KV + ((size_t)b * 512 + h) * 8192 + el;
        float st = 0.f;
        for (int c0 = 0; c0 < 128; c0 += 8) { float x[8];
#pragma unroll
            for (int i = 0; i < 8; ++i) x[i] = p[(size_t)(c0 + i) * 4 * 8192];
#pragma unroll
            for (int i = 0; i < 8; ++i) { p[(size_t)(c0 + i) * 4 * 8192] = st; st = st * gc + x[i]; } }
    }
}
#undef RET1_LOAD
__device__ __forceinline__ void phase_ret3(const Ctx& C, int u_end = NB * 128 * 4) {
    LAS bf16* Qs = (LAS bf16*)C.lds;
    LAS bf16* Ks = Qs + 64 * RT_KP;
    LAS bf16* Vs = Ks + 64 * RT_KP;
    LAS float* Red = (LAS float*)(Vs + 64 * RT_VP);
    const bf16* BQ = (const bf16*)(C.ws + WS_BQ); const bf16* BK = (const bf16*)(C.ws + WS_BK); const bf16* BV = (const bf16*)(C.ws + WS_BV); const bf16* BG = (const bf16*)(C.ws + WS_BG);
    const float* KV = (const float*)(C.ws + WS_KVST); bf16* CAT = (bf16*)(C.ws + WS_CAT);
    const int tid = C.tid, lane = C.lane, r32 = lane & 31, hi = lane >> 5, nb = C.wave >> 2, eb = C.wave & 3;
    u32x4 qw, kw, vw[2]; f32x4 sw[8];
#define RET3_LOAD(uu) do { const int h_ = (uu) & 3, c_ = ((uu) >> 2) & 127, b_ = (uu) >> 9; const size_t r0_ = (size_t)b_ * T + 64 * c_; \
        qw = *(const u32x4*)(BQ + (r0_ + (tid >> 3)) * 256 + h_ * 64 + (tid & 7) * 8); kw = *(const u32x4*)(BK + (r0_ + (tid >> 3)) * 256 + h_ * 64 + (tid & 7) * 8); \
        _Pragma("unroll") for (int i = 0; i < 2; ++i) { const int cidx = tid + 512 * i; vw[i] = *(const u32x4*)(BV + (r0_ + (cidx >> 4)) * 512 + h_ * 128 + (cidx & 15) * 8); } \
        const float* pp_ = KV + (size_t)(uu) * 8192 + (size_t)(32 * eb + r32) * 64 + 8 * hi; \
        _Pragma("unroll") for (int kk = 0; kk < 4; ++kk) { sw[2 * kk] = *(const f32x4*)(pp_ + 16 * kk); sw[2 * kk + 1] = *(const f32x4*)(pp_ + 16 * kk + 4); } } while (0)
    for (int u = C.bid; u < u_end; u += C.G) {
        const int h = u & 3, c = (u >> 2) & 127, b = u >> 9; const size_t row0 = (size_t)b * T + 64 * c; const float l2g = ret_logg(h) * 1.4426950408889634f;
        RET3_LOAD(u);
        { const int m = tid >> 3, d8 = (tid & 7) * 8; *(LAS u32x4*)(Qs + m * RT_KP + d8) = qw;
          const u32x4 w = kw; u32x4 o;
#pragma unroll
          for (int e = 0; e < 4; ++e) o[e] = pk2(bflo(w[e]) * 0.125f, bfhi(w[e]) * 0.125f);
          *(LAS u32x4*)(Ks + m * RT_KP + d8) = o; }
#pragma unroll
        for (int i = 0; i < 2; ++i) { const int cidx = tid + 512 * i, m = cidx >> 4, e8 = (cidx & 15) * 8; *(LAS u32x4*)(Vs + m * RT_VP + e8) = vw[i]; }
        bf16x8 pf[4];
#pragma unroll
        for (int kk = 0; kk < 4; ++kk) { const f32x4 a0 = sw[2 * kk], a1 = sw[2 * kk + 1];
            u32x4 w; w.x = pk2(a0.x, a0.y); w.y = pk2(a0.z, a0.w); w.z = pk2(a1.x, a1.y); w.w = pk2(a1.z, a1.w); pf[kk] = __builtin_bit_cast(bf16x8, w); }
        __syncthreads();
        bf16x8 qf[4];
#pragma unroll
        for (int kk = 0; kk < 4; ++kk) qf[kk] = *(const LAS bf16x8*)(Qs + (32 * nb + r32) * RT_KP + 16 * kk + 8 * hi);
        f32x16 cr, out;
#pragma unroll
        for (int r = 0; r < 16; ++r) { cr[r] = 0.f; out[r] = 0.f; }
#pragma unroll
        for (int kk = 0; kk < 4; ++kk) cr = __builtin_amdgcn_mfma_f32_32x32x16_bf16(qf[kk], pf[kk], cr, 0, 0, 0);
        const float gn = __builtin_amdgcn_exp2f((float)(32 * nb + r32) * l2g);
#pragma unroll
        for (int mb = 0; mb < 2; ++mb) {
            if (mb > nb) continue;
            f32x16 st;
#pragma unroll
            for (int r = 0; r < 16; ++r) st[r] = 0.f;
#pragma unroll
            for (int kk = 0; kk < 4; ++kk) { const bf16x8 kf = *(const LAS bf16x8*)(Ks + (32 * mb + r32) * RT_KP + 16 * kk + 8 * hi); st = __builtin_amdgcn_mfma_f32_32x32x16_bf16(kf, qf[kk], st, 0, 0, 0); }
            const int nq = 32 * nb + r32;
#pragma unroll
            for (int r = 0; r < 16; ++r) { const int m = 32 * mb + (r & 3) + 8 * (r >> 2) + 4 * hi; st[r] = (m <= nq) ? st[r] * gn * __builtin_amdgcn_exp2f(-(float)m * l2g) : 0.f; }
#pragma unroll
            for (int s2 = 0; s2 < 2; ++s2) {
                u32x4 w;
#pragma unroll
                for (int e = 0; e < 4; ++e) w[e] = pg8::cvt_pk_bf16(st[8 * s2 + 2 * e], st[8 * s2 + 2 * e + 1]);
                int rows[8];
#pragma unroll
                for (int j = 0; j < 8; ++j) rows[j] = 32 * mb + 16 * s2 + 8 * (j >> 2) + 4 * hi + (j & 3);
                const bf16x8 vf = lds_col8(Vs + 32 * eb + r32, RT_VP, rows);
                out = __builtin_amdgcn_mfma_f32_32x32x16_bf16(__builtin_bit_cast(bf16x8, w), vf, out, 0, 0, 0);
            }
        }
        float sv[16], s2v[16];
#pragma unroll
        for (int r = 0; r < 16; ++r) { const int n = 32 * nb + (r & 3) + 8 * (r >> 2) + 4 * hi; out[r] += __builtin_amdgcn_exp2f((float)(n + 1) * l2g) * cr[r]; sv[r] = half_sum32(out[r]); s2v[r] = half_sum32(out[r] * out[r]); }
        if (r32 == 0) {
#pragma unroll
            for (int r = 0; r < 16; ++r) { const int n = 32 * nb + (r & 3) + 8 * (r >> 2) + 4 * hi; *(LAS f32x2*)(Red + (n * 4 + eb) * 2) = (f32x2){sv[r], s2v[r]}; }
        }
        __syncthreads();
#pragma unroll
        for (int r = 0; r < 16; ++r) { const int n = 32 * nb + (r & 3) + 8 * (r >> 2) + 4 * hi;
            const f32x4 p0 = *(const LAS f32x4*)(Red + n * 8), p1 = *(const LAS f32x4*)(Red + n * 8 + 4);
            const float mean = (p0.x + p0.z + p1.x + p1.z) * (1.0f / 128.0f), ex2 = (p0.y + p0.w + p1.y + p1.w) * (1.0f / 128.0f);
            const float rstd = rsqrtf(fmaxf(ex2 - mean * mean, 0.f) + 1e-5f);
            const float gg = bf2f(BG[(row0 + n) * 512 + h * 128 + 32 * eb + r32]); const float sl = gg * __builtin_amdgcn_rcpf(1.0f + __expf(-gg));
            CAT[(row0 + n) * 2048 + 1024 + h * 128 + 32 * eb + r32] = (bf16)f2bf((out[r] - mean) * rstd * sl); }
        __syncthreads();
    }
}
#undef RET3_LOAD
__device__ __forceinline__ float sigmoidf_(float x) { return __builtin_amdgcn_rcpf(1.0f + __expf(-x)); }
constexpr int RW_AW = 104, RW_AV = 72, RW_AG = 264;
constexpr int RW1_BUF = 32 * RW_AW * 2 + 32 * RW_AV;
struct RwP { const float *mu, *mu_v, *w0, *a0, *v0, *k_k, *k_a, *r_k, *lnx_g, *lnx_b; };
template <class TT> __device__ __forceinline__ GAS TT* opaque_g(const TT* p) {
    unsigned lo = (unsigned)(uintptr_t)p, hi = (unsigned)((uintptr_t)p >> 32); asm volatile("" : "+v"(lo), "+v"(hi));
    lo = __builtin_amdgcn_readfirstlane(lo); hi = __builtin_amdgcn_readfirstlane(hi); return (GAS TT*)(((uintptr_t)hi << 32) | lo);
}
__device__ __forceinline__ int tokr(int r, int hi) { return (r & 3) + 8 * (r >> 2) + 4 * hi; }
__device__ __forceinline__ void shifted16(GAS bf16* ub, const unsigned (&off)[16], int cbo, bool first_unit, int hi, float mu, float (&x)[16]) {
    float cur[16], prv[4];
#pragma unroll
    for (int r = 0; r < 16; ++r) cur[r] = bf2f(at_b(ub, off[r])[cbo]);
#pragma unroll
    for (int g = 0; g < 4; ++g) { const bool first = (g == 0) && (hi == 0) && first_unit; prv[g] = first ? 0.f : bf2f(at_b(ub, off[4 * g])[cbo - 512]); }
#pragma unroll
    for (int r = 0; r < 16; ++r) { const float p = (r & 3) == 0 ? prv[r >> 2] : cur[r - 1]; x[r] = cur[r] + (p - cur[r]) * mu; }
}
__device__ __forceinline__ void phase_rw1(const Ctx& C, int layer, const RwP& P) {
    LAS bf16* ACT = (LAS bf16*)C.lds;
    const bf16* CR = (const bf16*)(C.ws + WS_CR); const bf16* CK = (const bf16*)(C.ws + WS_CK); const bf16* CV = (const bf16*)(C.ws + WS_CV); const bf16* CL = (const bf16*)(C.ws + WS_CL);
    const bf16* LW = (const bf16*)(C.ws + WS_LORA + LO_W); const bf16* LA = (const bf16*)(C.ws + WS_LORA + LO_A); const bf16* LV = (const bf16*)(C.ws + WS_LORA + LO_V);
    bf16* VF = (bf16*)(C.ws + WS_VFIRST);
    bf16* RR = (bf16*)(C.ws + WS_RR); bf16* RU = (bf16*)(C.ws + WS_RW); bf16* RKH = (bf16*)(C.ws + WS_RKH); bf16* RV = (bf16*)(C.ws + WS_RV); bf16* RA = (bf16*)(C.ws + WS_RA); bf16* RB = (bf16*)(C.ws + WS_RB);
    const float* mu = P.mu + (size_t)layer * 1984; const float* mu_v = P.mu_v;
    const float* w0 = P.w0 + layer * 512; const float* a0 = P.a0 + layer * 512; const float* v0 = P.v0; const float* k_k = P.k_k + layer * 512; const float* k_a = P.k_a + layer * 512;
    const int tid = C.tid, lane = C.lane, wid = C.wave;
    constexpr int NU = M / 32;
    u32x4 ncur[2], nprv[2];
#define RW1_LOAD(uu) do { _Pragma("unroll") for (int j = 0; j < 2; ++j) { const int ci = tid + 512 * j, tok = ci >> 5, c8 = (ci & 31) * 8; const size_t mm = (size_t)(uu) * 32 + tok; \
        ncur[j] = *(const u32x4*)(CL + mm * 256 + c8); const u32x4 z4 = {0u, 0u, 0u, 0u}; nprv[j] = (mm & (T - 1)) == 0 ? z4 : *(const u32x4*)(CL + (mm - 1) * 256 + c8); } } while (0)
#define RW1_STORE(bufi) do { _Pragma("unroll") for (int j = 0; j < 2; ++j) { const int ci = tid + 512 * j, tok = ci >> 5, c8 = (ci & 31) * 8; \
        const float* mp = c8 < 192 ? mu + 1536 + c8 : mu_v + (c8 - 192); f32x4 m0v = {0.f, 0.f, 0.f, 0.f}, m1v = m0v; if (c8 < 192 || layer > 0) { m0v = *(const f32x4*)mp; m1v = *(const f32x4*)(mp + 4); } \
        float xs[8]; _Pragma("unroll") for (int e = 0; e < 4; ++e) { const float c0 = bflo(ncur[j][e]), c1 = bfhi(ncur[j][e]), p0 = bflo(nprv[j][e]), p1 = bfhi(nprv[j][e]); \
            const float ma = e < 2 ? m0v[2 * e] : m1v[2 * e - 4], mb = e < 2 ? m0v[2 * e + 1] : m1v[2 * e - 3]; xs[2 * e] = c0 + (p0 - c0) * ma; xs[2 * e + 1] = c1 + (p1 - c1) * mb; } \
        if (c8 < 96) { _Pragma("unroll") for (int e = 0; e < 8; ++e) xs[e] = 1.0f - 2.0f * __builtin_amdgcn_rcpf(__expf(2.0f * xs[e]) + 1.0f); }     \
        u32x4 o; o.x = pk2(xs[0], xs[1]); o.y = pk2(xs[2], xs[3]); o.z = pk2(xs[4], xs[5]); o.w = pk2(xs[6], xs[7]); \
        LAS bf16* dst = ACT + (bufi) * RW1_BUF + (c8 < 96 ? tok * RW_AW + c8 : c8 < 192 ? 32 * RW_AW + tok * RW_AW + (c8 - 96) : 64 * RW_AW + tok * RW_AV + (c8 - 192)); \
        *(LAS u32x4*)dst = o; } } while (0)
    int u = C.bid; if (u >= NU) return;
    RW1_LOAD(u); RW1_STORE(0); __syncthreads();
    for (int kbuf = 0; ; kbuf ^= 1) {
        const int un = u + C.G; const bool has_next = un < NU;
        if (has_next) RW1_LOAD(un);
        {
            int r32 = lane & 31, hi = lane >> 5; asm volatile("" : "+v"(r32), "+v"(hi));
            const size_t m0 = (size_t)u * 32; const bool first_unit = (m0 & (T - 1)) == 0;
            const LAS bf16* AW = ACT + kbuf * RW1_BUF; const LAS bf16* AA = AW + 32 * RW_AW; const LAS bf16* AV = AA + 32 * RW_AW;
            unsigned off[16];
#pragma unroll
            for (int r = 0; r < 16; ++r) off[r] = (unsigned)(tokr(r, hi) * 512 + 64 * wid + r32) * 2u;
            GAS bf16* CRu = opaque_g(CR + m0 * 512); GAS bf16* CKu = opaque_g(CK + m0 * 512); GAS bf16* CVu = opaque_g(CV + m0 * 512); GAS bf16* VFu = opaque_g(VF + m0 * 512);
            GAS bf16* RRu = opaque_g(RR + m0 * 512); GAS bf16* RUu = opaque_g(RU + m0 * 512); GAS bf16* RKHu = opaque_g(RKH + m0 * 512); GAS bf16* RVu = opaque_g(RV + m0 * 512); GAS bf16* RAu = opaque_g(RA + m0 * 512); GAS bf16* RBu = opaque_g(RB + m0 * 512);
            float ks[2][16], inv[16];
            {
                float ssr[16];
#pragma unroll
                for (int r = 0; r < 16; ++r) ssr[r] = 0.f;
#pragma unroll
                for (int cb = 0; cb < 2; ++cb) { const int c = 64 * wid + 32 * cb + r32; const float kkc = k_k[c]; shifted16(CKu, off, 32 * cb, first_unit, hi, mu[512 + c], ks[cb]);
#pragma unroll
                    for (int r = 0; r < 16; ++r) { const float kr = ks[cb][r] * kkc; ssr[r] += kr * kr; } }
#pragma unroll
                for (int r = 0; r < 16; ++r) inv[r] = 1.0f / fmaxf(sqrtf(half_sum32(ssr[r])), 1e-12f);
            }
#pragma unroll
            for (int cb = 0; cb < 2; ++cb) {
                const int c = 64 * wid + 32 * cb + r32; const int ci = 32 * cb;
                asm volatile("" : "+v"(off[0]), "+v"(off[1]), "+v"(off[2]), "+v"(off[3]), "+v"(off[4]), "+v"(off[5]), "+v"(off[6]), "+v"(off[7]), "+v"(off[8]), "+v"(off[9]), "+v"(off[10]), "+v"(off[11]), "+v"(off[12]), "+v"(off[13]), "+v"(off[14]), "+v"(off[15]));
                {
                    float rs[16]; shifted16(CRu, off, ci, first_unit, hi, mu[c], rs);
#pragma unroll
                    for (int r = 0; r < 16; ++r) at_b(RRu, off[r])[ci] = (bf16)f2bf(rs[r]);
                }
                asm volatile("" ::: "memory");
                {
                    float vs[16]; shifted16(CVu, off, ci, first_unit, hi, mu[1024 + c], vs);
                    if (layer > 0) {
                        f32x16 dv;
#pragma unroll
                        for (int r = 0; r < 16; ++r) dv[r] = 0.f;
#pragma unroll
                        for (int kk = 0; kk < 4; ++kk) { const bf16x8 wv = *(const bf16x8*)(LV + c * 64 + 16 * kk + 8 * hi); const bf16x8 xv = *(const LAS bf16x8*)(AV + r32 * RW_AV + 16 * kk + 8 * hi);
                            dv = __builtin_amdgcn_mfma_f32_32x32x16_bf16(xv, wv, dv, 0, 0, 0); }
                        const float v0c = v0[c];
#pragma unroll
                        for (int r = 0; r < 16; ++r) { const float vf = bf2f(at_b(VFu, off[r])[ci]); at_b(RVu, off[r])[ci] = (bf16)f2bf(vs[r] + (vf - vs[r]) * sigmoidf_(v0c + dv[r])); }
                    } else {
#pragma unroll
                        for (int r = 0; r < 16; ++r) { const bf16 vb = (bf16)f2bf(vs[r]); at_b(VFu, off[r])[ci] = vb; at_b(RVu, off[r])[ci] = vb; }
                    }
                }
                asm volatile("" ::: "memory");
                {
                    f32x16 dw;
#pragma unroll
                    for (int r = 0; r < 16; ++r) dw[r] = 0.f;
#pragma unroll
                    for (int kk = 0; kk < 6; ++kk) { const bf16x8 ww = *(const bf16x8*)(LW + c * 96 + 16 * kk + 8 * hi); const bf16x8 xw = *(const LAS bf16x8*)(AW + r32 * RW_AW + 16 * kk + 8 * hi);
                        dw = __builtin_amdgcn_mfma_f32_32x32x16_bf16(xw, ww, dw, 0, 0, 0); }
                    const float w0c = w0[c];
#pragma unroll
                    for (int r = 0; r < 16; ++r) { const float z = -(w0c + dw[r]); const float sp = fmaxf(z, 0.f) + __logf(1.0f + __expf(-fabsf(z)));
                        at_b(RUu, off[r])[ci] = (bf16)f2bf(1.0f - __expf(-__expf(-sp - 0.5f))); }
                }
                asm volatile("" ::: "memory");
                {
                    f32x16 da;
#pragma unroll
                    for (int r = 0; r < 16; ++r) da[r] = 0.f;
#pragma unroll
                    for (int kk = 0; kk < 6; ++kk) { const bf16x8 wa = *(const bf16x8*)(LA + c * 96 + 16 * kk + 8 * hi); const bf16x8 xa = *(const LAS bf16x8*)(AA + r32 * RW_AW + 16 * kk + 8 * hi);
                        da = __builtin_amdgcn_mfma_f32_32x32x16_bf16(xa, wa, da, 0, 0, 0); }
                    const float a0c = a0[c], kkc = k_k[c], kac = k_a[c];
#pragma unroll
                    for (int r = 0; r < 16; ++r) { const float a = sigmoidf_(a0c + da[r]); const float ksx = ks[cb][r]; const float kk = ksx * kkc * inv[r];
                        at_b(RKHu, off[r])[ci] = (bf16)f2bf(ksx * (1.0f + (a - 1.0f) * kac)); at_b(RAu, off[r])[ci] = (bf16)f2bf(-kk); at_b(RBu, off[r])[ci] = (bf16)f2bf(kk * a); }
                }
                asm volatile("" ::: "memory");
            }
        }
        if (has_next) RW1_STORE(kbuf ^ 1);
        __syncthreads();
        if (!has_next) break;
        u = un;
    }
#undef RW1_LOAD
#undef RW1_STORE
}
constexpr int RW_L = 128, RW_NC = T / RW_L;
constexpr int RW_TB = 8, RW_STG = 5 * RW_TB * 64 + 64;
__device__ __forceinline__ float xhalf_sum(float x) { const auto rr = __builtin_amdgcn_permlane32_swap(__float_as_uint(x), __float_as_uint(x), false, false); return __uint_as_float(rr[0]) + __uint_as_float(rr[1]); }
__device__ __forceinline__ float dot32(const f32x16& d0, const f32x16& d1, const f32x4 (&v)[2][4]) {
    f32x2 acc = {0.f, 0.f};
#pragma unroll
    for (int g = 0; g < 4; ++g) { acc += (f32x2){d0[4 * g], d0[4 * g + 1]} * (f32x2){v[0][g].x, v[0][g].y}; acc += (f32x2){d0[4 * g + 2], d0[4 * g + 3]} * (f32x2){v[0][g].z, v[0][g].w};
        acc += (f32x2){d1[4 * g], d1[4 * g + 1]} * (f32x2){v[1][g].x, v[1][g].y}; acc += (f32x2){d1[4 * g + 2], d1[4 * g + 3]} * (f32x2){v[1][g].z, v[1][g].w}; }
    return acc.x + acc.y;
}
template <int NS, bool OUT>
__device__ __forceinline__ void rwkv_chunk(f32x16 (&D)[NS][2][2], LAS float* stg, const bf16* RWd, const bf16* RA, const bf16* RB, const bf16* RKH, const bf16* RV, const bf16* RR, float* Y, size_t base0, int nsteps, int lane) {
    const int r32 = lane & 31, hi = lane >> 5;
    unsigned short qw[RW_TB], qa[RW_TB], qr[RW_TB], qb[RW_TB], qk[RW_TB], qv[RW_TB];
#define RWC_LOAD(tt) do { _Pragma("unroll") for (int s = 0; s < RW_TB; ++s) { const size_t o = base0 + (size_t)((tt) + s) * 512 + lane; qw[s] = RWd[o]; qa[s] = RA[o]; if (OUT) qr[s] = RR[o]; qb[s] = RB[o]; qk[s] = RKH[o]; qv[s] = RV[o]; } } while (0)
    RWC_LOAD(0);
    float G = 1.0f;
    for (int t0 = 0; t0 < nsteps; t0 += RW_TB) {
#pragma unroll
        for (int s = 0; s < RW_TB; ++s) { const float w = 1.0f - bf2f(qw[s]); stg[(0 * RW_TB + s) * 64 + lane] = bf2f(qa[s]) * G; G *= w; const float ig = __builtin_amdgcn_rcpf(G);
            if (OUT) stg[(1 * RW_TB + s) * 64 + lane] = bf2f(qr[s]) * G; stg[(2 * RW_TB + s) * 64 + lane] = bf2f(qb[s]) * ig; stg[(3 * RW_TB + s) * 64 + lane] = bf2f(qk[s]) * ig; stg[(4 * RW_TB + s) * 64 + lane] = bf2f(qv[s]); }
        if (t0 + RW_TB < nsteps) RWC_LOAD(t0 + RW_TB);
        LDS_WAIT(); asm volatile("" ::: "memory");
#pragma unroll 1
        for (int s = 0; s < RW_TB; ++s) {
            const LAS float* sa_ = stg + (0 * RW_TB + s) * 64 + 4 * hi; const LAS float* sr = stg + (1 * RW_TB + s) * 64 + 4 * hi;
            const LAS float* sbk = stg + ((hi ? 3 : 2) * RW_TB + s) * 64 + r32; const LAS float* sv = stg + (4 * RW_TB + s) * 64 + r32;
            const float bk0 = sbk[0], bk1 = sbk[32], v0 = sv[0], v1 = sv[32];
            float sav[NS][2];
            {
                f32x4 av[2][4];
#pragma unroll
                for (int jb = 0; jb < 2; ++jb)
#pragma unroll
                    for (int g = 0; g < 4; ++g) av[jb][g] = *(const LAS f32x4*)(sa_ + 32 * jb + 8 * g);
#pragma unroll
                for (int st = 0; st < NS; ++st)
#pragma unroll
                    for (int ib = 0; ib < 2; ++ib) sav[st][ib] = xhalf_sum(dot32(D[st][0][ib], D[st][1][ib], av));
            }
#pragma unroll
            for (int st = 0; st < NS; ++st) {
                const bool inject = (NS == 1) || (st == 1);
#pragma unroll
                for (int jb = 0; jb < 2; ++jb) { const float bkj = jb == 0 ? bk0 : bk1; const float A = inject ? bkj : (hi ? 0.f : bkj);
#pragma unroll
                    for (int ib = 0; ib < 2; ++ib) { const float B = hi ? (ib == 0 ? v0 : v1) : sav[st][ib];
                        D[st][jb][ib] = __builtin_amdgcn_mfma_f32_32x32x2f32(A, B, D[st][jb][ib], 0, 0, 0); } }
            }
            if (OUT) {
                f32x4 rv[2][4];
#pragma unroll
                for (int jb = 0; jb < 2; ++jb)
#pragma unroll
                    for (int g = 0; g < 4; ++g) rv[jb][g] = *(const LAS f32x4*)(sr + 32 * jb + 8 * g);
#pragma unroll
                for (int ib = 0; ib < 2; ++ib) { const float y = xhalf_sum(dot32(D[NS - 1][0][ib], D[NS - 1][1][ib], rv));
                    if (hi == 0) Y[base0 + (size_t)(t0 + s) * 512 + 32 * ib + r32] = y; }
            }
        }
        LDS_WAIT(); asm volatile("" ::: "memory");
    }
#undef RWC_LOAD
    stg[5 * RW_TB * 64 + lane] = G;
    LDS_WAIT(); asm volatile("" ::: "memory");
    {
        f32x4 gv[2][4];
#pragma unroll
        for (int jb = 0; jb < 2; ++jb)
#pragma unroll
            for (int g = 0; g < 4; ++g) gv[jb][g] = *(const LAS f32x4*)(stg + 5 * RW_TB * 64 + 4 * hi + 32 * jb + 8 * g);
#pragma unroll
        for (int st = 0; st < NS; ++st)
#pragma unroll
            for (int jb = 0; jb < 2; ++jb)
#pragma unroll
                for (int ib = 0; ib < 2; ++ib)
#pragma unroll
                    for (int g = 0; g < 4; ++g) { f32x16& d = D[st][jb][ib]; d[4 * g] *= gv[jb][g].x; d[4 * g + 1] *= gv[jb][g].y; d[4 * g + 2] *= gv[jb][g].z; d[4 * g + 3] *= gv[jb][g].w; }
    }
    LDS_WAIT(); asm volatile("" ::: "memory");
}
__device__ __forceinline__ void phase_rw2(const Ctx& C) {
    const bf16* RWd = (const bf16*)(C.ws + WS_RW); const bf16* RA = (const bf16*)(C.ws + WS_RA); const bf16* RB = (const bf16*)(C.ws + WS_RB); const bf16* RKH = (const bf16*)(C.ws + WS_RKH); const bf16* RV = (const bf16*)(C.ws + WS_RV);
    float* PHI = (float*)(C.ws + WS_PHI); float* PSI = (float*)(C.ws + WS_PSI);
    LAS float* stg = (LAS float*)C.lds + C.wave * RW_STG;
    const int ntask = NB * 8 * RW_NC, r32 = C.lane & 31, hi = C.lane >> 5;
    for (int task = C.wave * C.G + C.bid; task < ntask; task += C.G * NWAVES) {
        const int ck = task % RW_NC, bh = task / RW_NC, h = bh & 7, b = bh >> 3;
        const size_t base0 = ((size_t)b * T + (size_t)ck * RW_L) * 512 + h * 64;
        f32x16 D[2][2][2];
#pragma unroll
        for (int jb = 0; jb < 2; ++jb)
#pragma unroll
            for (int ib = 0; ib < 2; ++ib)
#pragma unroll
                for (int r = 0; r < 16; ++r) { D[0][jb][ib][r] = (jb == ib && ((r & 3) + 8 * (r >> 2) + 4 * hi) == r32) ? 1.f : 0.f; D[1][jb][ib][r] = 0.f; }
        rwkv_chunk<2, false>(D, stg, RWd, RA, RB, RKH, RV, nullptr, nullptr, base0, RW_L, C.lane);
#pragma unroll
        for (int st = 0; st < 2; ++st) { float* dst = (st == 0 ? PHI : PSI) + (size_t)task * 4096;
#pragma unroll
            for (int jb = 0; jb < 2; ++jb)
#pragma unroll
                for (int ib = 0; ib < 2; ++ib)
#pragma unroll
                    for (int g = 0; g < 4; ++g) *(f32x4*)(dst + (32 * ib + r32) * 64 + 32 * jb + 8 * g + 4 * hi) = (f32x4){D[st][jb][ib][4 * g], D[st][jb][ib][4 * g + 1], D[st][jb][ib][4 * g + 2], D[st][jb][ib][4 * g + 3]}; }
    }
}
constexpr int R3_P = 65;
__device__ __forceinline__ void phase_rw3(const Ctx& C) {
    const float* PHI = (const float*)(C.ws + WS_PHI); const float* PSI = (const float*)(C.ws + WS_PSI); float* SST = (float*)(C.ws + WS_SST);
    const bool act = C.wave < 4; const int w4 = C.wave & 3, ibo = w4 >> 1, kb = w4 & 1, r32 = C.lane & 31, hi = C.lane >> 5;
    LAS float* Sl = (LAS float*)C.lds;
    for (int bh = C.bid; bh < NB * 8; bh += C.G) {
        f32x16 acc;
#pragma unroll
        for (int r = 0; r < 16; ++r) acc[r] = 0.f;
        float ph[32], psn[16];
#define R3_LOAD(tk) do { _Pragma("unroll") for (int s = 0; s < 32; ++s) ph[s] = PHI[(tk) * 4096 + (2 * s + hi) * 64 + 32 * kb + r32]; \
        _Pragma("unroll") for (int r = 0; r < 16; ++r) psn[r] = PSI[(tk) * 4096 + (32 * ibo + (r & 3) + 8 * (r >> 2) + 4 * hi) * 64 + 32 * kb + r32]; } while (0)
        if (act) R3_LOAD((size_t)bh * RW_NC);
        for (int ck = 0; ck < RW_NC; ++ck) {
            const size_t task = (size_t)bh * RW_NC + ck; LAS float* Sb = Sl + (ck & 1) * (64 * R3_P);
            float* dst = SST + task * 4096;
            if (act) {
#pragma unroll
                for (int r = 0; r < 16; ++r) { const int i = 32 * ibo + (r & 3) + 8 * (r >> 2) + 4 * hi; dst[i * 64 + 32 * kb + r32] = acc[r]; Sb[i * R3_P + 32 * kb + r32] = acc[r]; }
            }
            if (ck + 1 == RW_NC) break;
            float pc[32];
            if (act) {
#pragma unroll
                for (int s = 0; s < 32; ++s) pc[s] = ph[s];
#pragma unroll
                for (int r = 0; r < 16; ++r) acc[r] = psn[r];
                if (ck + 2 < RW_NC) R3_LOAD(task + 1);
            }
            __syncthreads();
            if (act) {
#pragma unroll
                for (int s = 0; s < 32; ++s) { const float a = Sb[(32 * ibo + r32) * R3_P + 2 * s + hi]; acc = __builtin_amdgcn_mfma_f32_32x32x2f32(a, pc[s], acc, 0, 0, 0); }
            }
        }
#undef R3_LOAD
        __syncthreads();
    }
}
__device__ __forceinline__ void phase_rw4(const Ctx& C) {
    const bf16* RWd = (const bf16*)(C.ws + WS_RW); const bf16* RA = (const bf16*)(C.ws + WS_RA); const bf16* RB = (const bf16*)(C.ws + WS_RB); const bf16* RKH = (const bf16*)(C.ws + WS_RKH); const bf16* RV = (const bf16*)(C.ws + WS_RV); const bf16* RR = (const bf16*)(C.ws + WS_RR);
    const float* SST = (const float*)(C.ws + WS_SST); float* Y = (float*)(C.ws + WS_Y);
    LAS float* stg = (LAS float*)C.lds + C.wave * RW_STG;
    const int ntask = NB * 8 * RW_NC, r32 = C.lane & 31, hi = C.lane >> 5;
    for (int task = C.wave * C.G + C.bid; task < ntask; task += C.G * NWAVES) {
        const int ck = task % RW_NC, bh = task / RW_NC, h = bh & 7, b = bh >> 3;
        const size_t base0 = ((size_t)b * T + (size_t)ck * RW_L) * 512 + h * 64;
        f32x16 D[1][2][2]; const float* src = SST + (size_t)task * 4096;
#pragma unroll
        for (int jb = 0; jb < 2; ++jb)
#pragma unroll
            for (int ib = 0; ib < 2; ++ib)
#pragma unroll
                for (int g = 0; g < 4; ++g) { const f32x4 v = *(const f32x4*)(src + (32 * ib + r32) * 64 + 32 * jb + 8 * g + 4 * hi); D[0][jb][ib][4 * g] = v.x; D[0][jb][ib][4 * g + 1] = v.y; D[0][jb][ib][4 * g + 2] = v.z; D[0][jb][ib][4 * g + 3] = v.w; }
        rwkv_chunk<1, true>(D, stg, RWd, RA, RB, RKH, RV, RR, Y, base0, RW_L, C.lane);
    }
}
__device__ __forceinline__ void phase_rw5(const Ctx& C, int layer, const RwP& P) {
    LAS bf16* ACT = (LAS bf16*)C.lds;
    const bf16* CG = (const bf16*)(C.ws + WS_CG); const bf16* LG = (const bf16*)(C.ws + WS_LORA + LO_G);
    const float* Y = (const float*)(C.ws + WS_Y); const bf16* RR = (const bf16*)(C.ws + WS_RR); const bf16* RKH = (const bf16*)(C.ws + WS_RKH); const bf16* RV = (const bf16*)(C.ws + WS_RV);
    bf16* CAT = (bf16*)(C.ws + WS_CAT);
    const float* mu = P.mu + (size_t)layer * 1984 + 1728; const float* r_k = P.r_k + layer * 512; const float* lnx_g = P.lnx_g + layer * 512; const float* lnx_b = P.lnx_b + layer * 512;
    const int tid = C.tid, lane = C.lane, wid = C.wave;
    constexpr int NU = M / 32;
    u32x4 ncur[2], nprv[2];
#define RW5_LOAD(uu) do { _Pragma("unroll") for (int j = 0; j < 2; ++j) { const int ci = tid + 512 * j, tok = ci >> 5, c8 = (ci & 31) * 8; const size_t mm = (size_t)(uu) * 32 + tok; \
        ncur[j] = *(const u32x4*)(CG + mm * 256 + c8); const u32x4 z4 = {0u, 0u, 0u, 0u}; nprv[j] = (mm & (T - 1)) == 0 ? z4 : *(const u32x4*)(CG + (mm - 1) * 256 + c8); } } while (0)
#define RW5_STORE(bufi) do { _Pragma("unroll") for (int j = 0; j < 2; ++j) { const int ci = tid + 512 * j, tok = ci >> 5, c8 = (ci & 31) * 8; \
        const f32x4 m0v = *(const f32x4*)(mu + c8), m1v = *(const f32x4*)(mu + c8 + 4); \
        float xs[8]; _Pragma("unroll") for (int e = 0; e < 4; ++e) { const float c0 = bflo(ncur[j][e]), c1 = bfhi(ncur[j][e]), p0 = bflo(nprv[j][e]), p1 = bfhi(nprv[j][e]); \
            const float ma = e < 2 ? m0v[2 * e] : m1v[2 * e - 4], mb = e < 2 ? m0v[2 * e + 1] : m1v[2 * e - 3]; xs[2 * e] = sigmoidf_(c0 + (p0 - c0) * ma); xs[2 * e + 1] = sigmoidf_(c1 + (p1 - c1) * mb); } \
        u32x4 o; o.x = pk2(xs[0], xs[1]); o.y = pk2(xs[2], xs[3]); o.z = pk2(xs[4], xs[5]); o.w = pk2(xs[6], xs[7]); \
        *(LAS u32x4*)(ACT + (bufi) * (32 * RW_AG) + tok * RW_AG + c8) = o; } } while (0)
    int u = C.bid; if (u >= NU) return;
    RW5_LOAD(u); RW5_STORE(0); __syncthreads();
    for (int kbuf = 0; ; kbuf ^= 1) {
        const int un = u + C.G; const bool has_next = un < NU;
        if (has_next) RW5_LOAD(un);
        {
            int r32 = lane & 31, hi = lane >> 5; asm volatile("" : "+v"(r32), "+v"(hi));
            const size_t m0 = (size_t)u * 32; const LAS bf16* AG = ACT + kbuf * (32 * RW_AG);
            unsigned off[16];
#pragma unroll
            for (int r = 0; r < 16; ++r) off[r] = (unsigned)(tokr(r, hi) * 512 + 64 * wid + r32) * 2u;
            GAS float* Yu = opaque_g(Y + m0 * 512); GAS bf16* RRu = opaque_g(RR + m0 * 512); GAS bf16* RKHu = opaque_g(RKH + m0 * 512); GAS bf16* RVu = opaque_g(RV + m0 * 512); GAS bf16* CATu = opaque_g(CAT + m0 * 2048 + 1536);
            float yv[2][16], sy[16], sq[16], sb[16];
#pragma unroll
            for (int r = 0; r < 16; ++r) { sy[r] = 0.f; sq[r] = 0.f; sb[r] = 0.f; }
#pragma unroll
            for (int cb = 0; cb < 2; ++cb) { const int c = 64 * wid + 32 * cb + r32; const float rkc = r_k[c];
                asm volatile("" : "+v"(off[0]), "+v"(off[1]), "+v"(off[2]), "+v"(off[3]), "+v"(off[4]), "+v"(off[5]), "+v"(off[6]), "+v"(off[7]), "+v"(off[8]), "+v"(off[9]), "+v"(off[10]), "+v"(off[11]), "+v"(off[12]), "+v"(off[13]), "+v"(off[14]), "+v"(off[15]));
#pragma unroll
                for (int r = 0; r < 16; ++r) { const unsigned o = off[r]; const int ci = 32 * cb; const float y = at_b(Yu, 2u * o)[ci]; yv[cb][r] = y; sy[r] += y; sq[r] += y * y; sb[r] += bf2f(at_b(RRu, o)[ci]) * bf2f(at_b(RKHu, o)[ci]) * rkc; } }
#pragma unroll
            for (int r = 0; r < 16; ++r) { const float mean = half_sum32(sy[r]) * (1.0f / 64.0f); const float ex2 = half_sum32(sq[r]) * (1.0f / 64.0f); sb[r] = half_sum32(sb[r]);
                sy[r] = mean; sq[r] = rsqrtf(fmaxf(ex2 - mean * mean, 0.f) + 64e-5f); }
#pragma unroll
            for (int cb = 0; cb < 2; ++cb) { const int c = 64 * wid + 32 * cb + r32;
                f32x16 dg;
#pragma unroll
                for (int r = 0; r < 16; ++r) dg[r] = 0.f;
#pragma unroll
                for (int kk = 0; kk < 16; ++kk) { const bf16x8 wg = *(const bf16x8*)(LG + c * 256 + 16 * kk + 8 * hi); const bf16x8 xg = *(const LAS bf16x8*)(AG + r32 * RW_AG + 16 * kk + 8 * hi);
                    dg = __builtin_amdgcn_mfma_f32_32x32x16_bf16(xg, wg, dg, 0, 0, 0); }
                const float lgc = lnx_g[c], lbc = lnx_b[c];
#pragma unroll
                for (int r = 0; r < 16; ++r) { const unsigned o = off[r]; const int ci = 32 * cb; const float v = bf2f(at_b(RVu, o)[ci]);
                    at_b(CATu, (unsigned)(tokr(r, hi) * 2048 + 64 * wid + r32) * 2u)[ci] = (bf16)f2bf(((yv[cb][r] - sy[r]) * sq[r] * lgc + lbc + sb[r] * v) * dg[r]); }
            }
        }
        if (has_next) RW5_STORE(kbuf ^ 1);
        __syncthreads();
        if (!has_next) break;
        u = un;
    }
#undef RW5_LOAD
#undef RW5_STORE
}
__device__ __forceinline__ void* launder_ptr(const void* p) {
    unsigned lo = (unsigned)(uintptr_t)p, hi = (unsigned)((uintptr_t)p >> 32); asm volatile("" : "+v"(lo), "+v"(hi));
    lo = __builtin_amdgcn_readfirstlane(lo); hi = __builtin_amdgcn_readfirstlane(hi); return (void*)(((uintptr_t)hi << 32) | lo);
}
#ifndef MK_PER_PHASE
#define MK_PER_PHASE 0
#endif
constexpr int PH_PER_LAYER = 13, N_PHASES = DEPTH * PH_PER_LAYER + 1;
struct Args { const float* in[23]; float* out; unsigned char* ws; int ph_lo, ph_hi; };
#define FRESH() do { KA = (const CAS Args*)launder_ptr((const void*)(uintptr_t)__builtin_amdgcn_kernarg_segment_ptr()); C.ws = KA->ws; C.out = KA->out; ctl = (unsigned*)(C.ws + WS_CTL); asm volatile("" : "+v"(C.tid)); C.lane = C.tid & 63; C.wave = __builtin_amdgcn_readfirstlane(C.tid >> 6); C.lds = (LAS unsigned char*)lds_raw; } while (0)
#ifndef ATT_REP
#define ATT_REP 1
#endif
#ifndef REP_MASK
#define REP_MASK 0u
#endif
#ifndef ONLY_PH
#define ONLY_PH -1
#endif
#ifndef PH_MASK
#define PH_MASK 0xFFFFFFFFu
#endif
#define IN(k) (lo <= (k) && (k) < hi && (ONLY_PH < 0 || ((k) % PH_PER_LAYER) == ONLY_PH) && ((PH_MASK >> ((k) % PH_PER_LAYER)) & 1u))
#define SEAM(k) do { if (IN(k) && IN((k) + 1)) { bar.bar = ctl + CW_BAR; xcd_barrier(bar); } } while (0)
#define PH_BODY(k, ...) do { FRESH(); if (IN(p0 + (k))) { __VA_ARGS__; if ((REP_MASK >> (k)) & 1u) { xcd_barrier(bar); FRESH(); __VA_ARGS__; } } SEAM(p0 + (k)); } while (0)
template <int layer>
__device__ __forceinline__ void layer_phases(Ctx& C, const CAS Args*& KA, XcdBarrier& bar, unsigned*& ctl, unsigned char* lds_raw, const int lo, const int hi) {
    const int p0 = layer * PH_PER_LAYER;
    PH_BODY(0, { const WSrc W{KA->in[2], KA->in[3], KA->in[18], KA->in[20], KA->in[21], KA->in[7], KA->in[9], KA->in[12], KA->in[11], KA->in[1], KA->in[19]}; phase_wconv(C, layer, W);
                 if (layer == 0) phase_xg(C, KA->in[0], (bf16*)C.out, (float*)(C.ws + WS_SS1)); });
    PH_BODY(1, { pg8::Gemm g{(const pg8::bf16_t*)C.out, (const pg8::bf16_t*)(C.ws + WS_WIN), M, N_INP, DM}; pg8::StaticOrder S; S.init(M, N_INP, C.G, C.bid);
                 pg8::EpiProj E{C.ws, (const float*)(C.ws + WS_SS1)}; pg8::gemm_phase<pg8::EpiProj, pg8::StaticOrder, true, true>(C.lds, g, S, E); });
    FRESH(); if (IN(p0 + 2)) phase_prep_a(C); SEAM(p0 + 2);
    PH_BODY(3, { phase_indexer(C); __syncthreads(); phase_ret1(C); });
    FRESH(); if (IN(p0 + 4)) { for (int rep_a = 0; rep_a < ATT_REP; ++rep_a) { phase_attn(C); __syncthreads(); } phase_ret2(C); } SEAM(p0 + 4);
    PH_BODY(5, { const RwP P{KA->in[4], KA->in[5], KA->in[6], KA->in[8], KA->in[10], KA->in[13], KA->in[14], KA->in[15], KA->in[16], KA->in[17]}; phase_rw1(C, layer, P); });
    PH_BODY(6, { phase_rw2(C); });
    PH_BODY(7, { if (C.G == 256) {
                      if (C.bid < 32) { phase_rw3(C); __syncthreads(); Ctx C2 = C; C2.bid = 2016 + C.bid; C2.G = 4096; phase_ret3(C2); } else { Ctx C2 = C; C2.bid = C.bid - 32; C2.G = 224; phase_ret3(C2, 2016); } }
                  else if (C.G > 64) { if (C.bid < 32) phase_rw3(C); else { Ctx C2 = C; C2.bid = C.bid - 32; C2.G = C.G - 32; phase_ret3(C2); } } else { phase_rw3(C); __syncthreads(); phase_ret3(C); } });
    PH_BODY(8, { phase_rw4(C); });
    PH_BODY(9, { const RwP P{KA->in[4], KA->in[5], KA->in[6], KA->in[8], KA->in[10], KA->in[13], KA->in[14], KA->in[15], KA->in[16], KA->in[17]}; phase_rw5(C, layer, P); });
    FRESH(); if (IN(p0 + 10)) { pg8::Gemm g{(const pg8::bf16_t*)(C.ws + WS_CAT), (const pg8::bf16_t*)(C.ws + WS_WOUT), M, DM, DM}; pg8::StaticOrder S; S.init(M, DM, C.G, C.bid);
        pg8::EpiResid E{(const pg8::bf16_t*)C.out, (pg8::bf16_t*)C.out, DM, (float*)(C.ws + WS_SS2)}; pg8::gemm_phase<pg8::EpiResid, pg8::StaticOrder, true, true>(C.lds, g, S, E); }
    SEAM(p0 + 10);
    PH_BODY(11, { pg8::Gemm g{(const pg8::bf16_t*)C.out, (const pg8::bf16_t*)(C.ws + WS_WGU), M, 2 * DFF, DM}; pg8::StaticOrder S; S.init(M, 2 * DFF, C.G, C.bid);
                  pg8::EpiSwiGLU E{(pg8::bf16_t*)(C.ws + WS_ACT), DFF, (const float*)(C.ws + WS_SS2)}; pg8::gemm_phase<pg8::EpiSwiGLU, pg8::StaticOrder, true, true>(C.lds, g, S, E); });
    FRESH(); if (IN(p0 + 12)) { pg8::Gemm g{(const pg8::bf16_t*)(C.ws + WS_ACT), (const pg8::bf16_t*)(C.ws + WS_WDN), M, DM, DFF}; pg8::StaticOrder S; S.init(M, DM, C.G, C.bid);
        pg8::EpiResid E{(const pg8::bf16_t*)C.out, layer + 1 < DEPTH ? (pg8::bf16_t*)C.out : (pg8::bf16_t*)(C.ws + WS_CAT), DM, (float*)(C.ws + WS_SS1)};
        pg8::gemm_phase<pg8::EpiResid, pg8::StaticOrder, true, true>(C.lds, g, S, E); }
    SEAM(p0 + 12);
}
__global__ void __launch_bounds__(NTHR, 2) fwd_kernel(Args args) {
    extern __shared__ __attribute__((aligned(16))) unsigned char lds_raw[];
    Ctx C;
    C.lds = (LAS unsigned char*)lds_raw; C.tid = threadIdx.x; C.lane = C.tid & 63; C.wave = __builtin_amdgcn_readfirstlane(C.tid >> 6);
    C.G = gridDim.x; C.bid = blockIdx.x;
    const CAS Args* KA = (const CAS Args*)launder_ptr((const void*)(uintptr_t)__builtin_amdgcn_kernarg_segment_ptr());
    C.ws = KA->ws; C.out = KA->out;
    volatile LAS unsigned* MISC = (volatile LAS unsigned*)(C.lds + MISC_OFF);
    if (C.tid < 32) MISC[C.tid] = 0u;
    __syncthreads();
    unsigned* ctl = (unsigned*)(C.ws + WS_CTL);
    XcdBarrier bar; bar.bar = ctl + CW_BAR; bar.x = 0; bar.st = nullptr;
    if (!MK_PER_PHASE) bar = xcd_barrier_post(ctl + CW_BAR, MISC + 8);
    const int lo = KA->ph_lo, hi = KA->ph_hi;
    layer_phases<0>(C, KA, bar, ctl, lds_raw, lo, hi);
    layer_phases<1>(C, KA, bar, ctl, lds_raw, lo, hi);
    FRESH(); if (IN(N_PHASES - 1)) phase_final_norm(C, (const bf16*)(C.ws + WS_CAT), C.out, KA->in[22], (const float*)(C.ws + WS_SS1));
#undef IN
#undef SEAM
}

extern "C" void kernel_launch(void* const* d_in, const int* in_sizes, int n_in, void* d_out, int out_size, void* d_ws, size_t ws_size, hipStream_t stream) {
    static int grid = 0;
    if (grid == 0) {
        if (n_in != 23 || out_size != M * DM || ws_size < WS_NEED) { fprintf(stderr, "kernel_launch: unexpected problem (n_in %d, out %d, ws %zu); nothing launched\n", n_in, out_size, ws_size); grid = -1; return; }
        int dev = 0, cus = 0, per_cu = 0;
        if (hipGetDevice(&dev) != hipSuccess || hipDeviceGetAttribute(&cus, hipDeviceAttributeMultiprocessorCount, dev) != hipSuccess) { grid = -1; return; }
        if (hipFuncSetAttribute((const void*)fwd_kernel, hipFuncAttributeMaxDynamicSharedMemorySize, LDS_BYTES) != hipSuccess) { fprintf(stderr, "kernel_launch: hipFuncSetAttribute failed\n"); grid = -1; return; }
        if (hipOccupancyMaxActiveBlocksPerMultiprocessor(&per_cu, (const void*)fwd_kernel, NTHR, LDS_BYTES) != hipSuccess || per_cu < 1) { fprintf(stderr, "kernel_launch: occupancy query says %d blocks per CU\n", per_cu); }
        (void)hipGetLastError();
        grid = cus;
    }
    if (grid < 0) return;
    (void)hipMemsetAsync((char*)d_ws + WS_CTL, 0, CTL_ZERO_BYTES, stream);
    Args a{};
    for (int i = 0; i < 23; ++i) a.in[i] = (const float*)d_in[i];
    a.out = (float*)d_out; a.ws = (unsigned char*)d_ws;
#if MK_PER_PHASE
    for (int p = 0; p < N_PHASES; ++p) { a.ph_lo = p; a.ph_hi = p + 1; hipLaunchKernelGGL(fwd_kernel, dim3(grid), dim3(NTHR), LDS_BYTES, stream, a); }
#else
    a.ph_lo = 0; a.ph_hi = N_PHASES;
    hipLaunchKernelGGL(fwd_kernel, dim3(grid), dim3(NTHR), LDS_BYTES, stream, a);
#endif
    const hipError_t le = hipPeekAtLastError();
    if (le != hipSuccess) fprintf(stderr, "kernel_launch: launch failed: %s\n", hipGetErrorName(le));
}
```

```cpp
#include <hip/hip_runtime.h>
#include <hip/hip_fp16.h>
#include <cstdio>
#include <cstdint>
namespace pg8 {
#define PG8_LAS __attribute__((address_space(3)))
typedef unsigned short bf16_t;
typedef short bf16x8 __attribute__((ext_vector_type(8)));
typedef float f32x4 __attribute__((ext_vector_type(4)));
typedef unsigned u32x4 __attribute__((ext_vector_type(4)));
constexpr int BM = 256, BK = 64, HALF = 128, HTB = HALF * BK * 2  , STAGE_BYTES = 8 * HTB, NXCD = 8, WGM = 8;

__host__ __device__ __forceinline__ int lds_byte(int r, int c) { const int st = (r >> 4) * 2 + (c >> 5), rr = r & 15, cc = c & 31, ob = rr * 64 + cc * 2; return st * 1024 + (ob ^ (((ob >> 9) & 1) << 5)); }
__host__ __device__ __forceinline__ void stage_rc(int b, int& R, int& C) { const int st = b / 1024, sb = b % 1024, swz = sb ^ (((sb >> 9) & 1) << 5); R = (st >> 1) * 16 + swz / 64; C = (st & 1) * 32 + (swz % 64) / 2; }
__host__ __device__ __forceinline__ int perm32(int rho) { const int n = rho >> 4, i = rho & 15; return 8 * (i >> 2) + 4 * n + (i & 3); }

struct Unit { int pm, pn; };
struct Gemm { const bf16_t* A; const bf16_t* Bt; int M, N, K; };

struct StaticOrder {
    int nM, nN, nwg, G, c;
    __host__ __device__ void init(int M, int N, int G_, int c_) { nM = M / BM; nN = N / BM; nwg = nM * nN; G = G_; c = c_; }
    __host__ __device__ bool next(int i, Unit& u) const {
        const long L = (long)i * G + c; if (L >= nwg) return false;
        int wgid = (int)L; { const int q = nwg / NXCD, r = nwg % NXCD, xcd = wgid % NXCD, off = wgid / NXCD; wgid = (xcd < r ? xcd * (q + 1) : r * (q + 1) + (xcd - r) * q) + off; }
        const int nig = WGM * nN, gid = wgid / nig, fm = gid * WGM, gsz = (nM - fm) < WGM ? (nM - fm) : WGM;
        u.pm = fm + ((wgid % nig) % gsz); u.pn = (wgid % nig) / gsz; return true;
    }
    __device__ __forceinline__ void a_ready(const Unit&) const {}
    __device__ __forceinline__ void done(const Unit&) const {}
};

__device__ __forceinline__ unsigned cvt_pk_bf16(float lo, float hi) { unsigned r; asm volatile("v_cvt_pk_bf16_f32 %0, %1, %2" : "=v"(r) : "v"(lo), "v"(hi)); return r; }
typedef float f32x2 __attribute__((ext_vector_type(2)));
__device__ __forceinline__ f32x2 gelu_pk(f32x2 v) {
    const f32x2 av = __builtin_elementwise_abs(v), d = av * 0.2316418882f + 1.0f;
    f32x2 t; t.x = __builtin_amdgcn_rcpf(d.x); t.y = __builtin_amdgcn_rcpf(d.y);
    f32x2 q = t * 0.5307027145f + (-0.7265760135f); q = q * t + 0.7107068705f; q = q * t + (-0.142248368f); q = q * t + 0.127414796f; q = q * t;
    const f32x2 s = (v * v) * (-0.72134752044f);
    f32x2 e; e.x = __builtin_amdgcn_exp2f(s.x); e.y = __builtin_amdgcn_exp2f(s.y);
    const f32x2 m = v * (q * e), r = v - m;
    f32x2 o; o.x = v.x < 0.f ? m.x : r.x; o.y = v.y < 0.f ? m.y : r.y; return o;
}

template <int ACT  > struct EpiBf16 {
    static constexpr bool PERM = true, AFTER_DRAIN = false; static_assert(ACT == 0 || ACT == 1, "EpiBf16: ACT is 0 (none) or 1 (gelu_pk)");
    bf16_t* O; int ldc; const float* bias; int split_cols; size_t split_stride; float scale0;
    __device__ __forceinline__ void operator()(const f32x4 (&acc)[2][2][4][2], const Unit& u, int wr, int wc, int fr, int fq) const {
        const int row0 = u.pm * BM + wr * 64 + fr; int colt = u.pn * BM; bf16_t* base = O;
        float sc = 1.f; if (split_cols) { const int t = colt / split_cols; base += (size_t)t * split_stride; colt -= t * split_cols; if (t == 0) sc = scale0; }
        const int col0 = colt + wc * 32 + 8 * fq, bcol0 = u.pn * BM + wc * 32 + 8 * fq;
        f32x4 bv[2][2];
#pragma unroll
        for (int bj = 0; bj < 2; ++bj)
#pragma unroll
            for (int n = 0; n < 2; ++n) bv[bj][n] = bias ? *(const f32x4*)(bias + bcol0 + bj * HALF + 4 * n) : (f32x4){0.f, 0.f, 0.f, 0.f};
#pragma unroll
        for (int ai = 0; ai < 2; ++ai)
#pragma unroll
            for (int m = 0; m < 4; ++m) { bf16_t* rowp = base + (size_t)(row0 + ai * HALF + m * 16) * ldc + col0;
#pragma unroll
                for (int bj = 0; bj < 2; ++bj) { f32x4 v0 = acc[ai][bj][m][0] + bv[bj][0], v1 = acc[ai][bj][m][1] + bv[bj][1];
                    if (ACT == 1) { f32x2 a = gelu_pk((f32x2){v0[0], v0[1]}), b = gelu_pk((f32x2){v0[2], v0[3]}), c = gelu_pk((f32x2){v1[0], v1[1]}), d = gelu_pk((f32x2){v1[2], v1[3]});
                        v0 = (f32x4){a.x, a.y, b.x, b.y}; v1 = (f32x4){c.x, c.y, d.x, d.y}; }
                    v0 = v0 * sc; v1 = v1 * sc; u32x4 w; w.x = cvt_pk_bf16(v0[0], v0[1]); w.y = cvt_pk_bf16(v0[2], v0[3]); w.z = cvt_pk_bf16(v1[0], v1[1]); w.w = cvt_pk_bf16(v1[2], v1[3]);
                    *(u32x4*)(rowp + bj * HALF) = w; } }
    }
};

__device__ __forceinline__ void tile_dest(int pn, size_t& off, int& ld, int& colt);
__device__ __forceinline__ float row_rstd(const float* ss, int row, int fq) {
    const f32x4* p = (const f32x4*)(ss + (size_t)row * 32 + 8 * fq); const f32x4 a = p[0], b = p[1];
    float s = ((a[0] + a[1]) + (a[2] + a[3])) + ((b[0] + b[1]) + (b[2] + b[3])); s += __shfl_xor(s, 16); s += __shfl_xor(s, 32);
    return rsqrtf(s * (1.0f / 2048.0f) + 1e-5f);
}
struct EpiProj {
    static constexpr bool PERM = true, AFTER_DRAIN = false;
    unsigned char* ws; const float* ss;
    __device__ __forceinline__ void operator()(const f32x4 (&acc)[2][2][4][2], const Unit& u, int wr, int wc, int fr, int fq) const {
        size_t off; int ld, colt; tile_dest(u.pn, off, ld, colt);
        bf16_t* base = (bf16_t*)(ws + off);
        const int row0 = u.pm * BM + wr * 64 + fr, col0 = colt + wc * 32 + 8 * fq;
        const float sc = u.pn < 4 ? 0.12751743074602467f : 1.0f;
        float rsv[2][4];
#pragma unroll
        for (int ai = 0; ai < 2; ++ai)
#pragma unroll
            for (int m = 0; m < 4; ++m) rsv[ai][m] = row_rstd(ss, row0 + ai * HALF + m * 16, fq) * sc;
#pragma unroll
        for (int ai = 0; ai < 2; ++ai)
#pragma unroll
            for (int m = 0; m < 4; ++m) { const int row = row0 + ai * HALF + m * 16; bf16_t* rowp = base + (size_t)row * ld + col0; const float rs = rsv[ai][m];
#pragma unroll
                for (int bj = 0; bj < 2; ++bj) { const f32x4 v0 = acc[ai][bj][m][0] * rs, v1 = acc[ai][bj][m][1] * rs;
                    u32x4 w; w.x = cvt_pk_bf16(v0[0], v0[1]); w.y = cvt_pk_bf16(v0[2], v0[3]); w.z = cvt_pk_bf16(v1[0], v1[1]); w.w = cvt_pk_bf16(v1[2], v1[3]);
                    *(u32x4*)(rowp + bj * HALF) = w; } }
    }
};
struct EpiResid {
    static constexpr bool PERM = true, AFTER_DRAIN = false;
    const bf16_t* base; bf16_t* out; int ldc; float* ss;
    __device__ __forceinline__ static float lo(unsigned w) { return __builtin_bit_cast(float, w << 16); }
    __device__ __forceinline__ static float hi(unsigned w) { return __builtin_bit_cast(float, w & 0xffff0000u); }
    __device__ __forceinline__ void operator()(const f32x4 (&acc)[2][2][4][2], const Unit& u, int wr, int wc, int fr, int fq) const {
        const int row0 = u.pm * BM + wr * 64 + fr, col0 = u.pn * BM + wc * 32 + 8 * fq;
#pragma unroll
        for (int ai = 0; ai < 2; ++ai) { u32x4 bv[4][2];
#pragma unroll
            for (int m = 0; m < 4; ++m)
#pragma unroll
                for (int bj = 0; bj < 2; ++bj) bv[m][bj] = *(const u32x4*)(base + (size_t)(row0 + ai * HALF + m * 16) * ldc + col0 + bj * HALF);
#pragma unroll
            for (int m = 0; m < 4; ++m) { const int row = row0 + ai * HALF + m * 16; const size_t off = (size_t)row * ldc + col0; float sq = 0.f;
#pragma unroll
                for (int bj = 0; bj < 2; ++bj) { const size_t p = off + bj * HALF; const u32x4 b = bv[m][bj]; const f32x4 a0 = acc[ai][bj][m][0], a1 = acc[ai][bj][m][1];
                    u32x4 w; w.x = cvt_pk_bf16(lo(b.x) + a0[0], hi(b.x) + a0[1]); w.y = cvt_pk_bf16(lo(b.y) + a0[2], hi(b.y) + a0[3]);
                    w.z = cvt_pk_bf16(lo(b.z) + a1[0], hi(b.z) + a1[1]); w.w = cvt_pk_bf16(lo(b.w) + a1[2], hi(b.w) + a1[3]);
                    *(u32x4*)(out + p) = w;
                    sq += (lo(w.x) * lo(w.x) + hi(w.x) * hi(w.x)) + (lo(w.y) * lo(w.y) + hi(w.y) * hi(w.y)) + (lo(w.z) * lo(w.z) + hi(w.z) * hi(w.z)) + (lo(w.w) * lo(w.w) + hi(w.w) * hi(w.w)); }
                sq += __shfl_xor(sq, 16); sq += __shfl_xor(sq, 32);
                if (fq == 0) ss[(size_t)row * 32 + u.pn * 4 + wc] = sq; } }
    }
};
struct EpiSwiGLU {
    static constexpr bool PERM = true, AFTER_DRAIN = false;
    bf16_t* O; int ldc; const float* ss;
    __device__ __forceinline__ static float silu_mul(float g, float u) { return g * u * __builtin_amdgcn_rcpf(1.0f + __expf(-g)); }
    __device__ __forceinline__ void operator()(const f32x4 (&acc)[2][2][4][2], const Unit& u, int wr, int wc, int fr, int fq) const {
        const int row0 = u.pm * BM + wr * 64 + fr, col0 = u.pn * HALF + wc * 32 + 8 * fq;
        float rsv[2][4];
#pragma unroll
        for (int ai = 0; ai < 2; ++ai)
#pragma unroll
            for (int m = 0; m < 4; ++m) rsv[ai][m] = row_rstd(ss, row0 + ai * HALF + m * 16, fq);
#pragma unroll
        for (int ai = 0; ai < 2; ++ai)
#pragma unroll
            for (int m = 0; m < 4; ++m) { const int row = row0 + ai * HALF + m * 16; bf16_t* rowp = O + (size_t)row * ldc + col0; const float rs = rsv[ai][m];
                const f32x4 g0 = acc[ai][0][m][0] * rs, g1 = acc[ai][0][m][1] * rs, u0 = acc[ai][1][m][0] * rs, u1 = acc[ai][1][m][1] * rs;
                u32x4 w; w.x = cvt_pk_bf16(silu_mul(g0[0], u0[0]), silu_mul(g0[1], u0[1])); w.y = cvt_pk_bf16(silu_mul(g0[2], u0[2]), silu_mul(g0[3], u0[3]));
                w.z = cvt_pk_bf16(silu_mul(g1[0], u1[0]), silu_mul(g1[1], u1[1])); w.w = cvt_pk_bf16(silu_mul(g1[2], u1[2]), silu_mul(g1[3], u1[3]));
                *(u32x4*)rowp = w; }
    }
};
template <class Epi, class Sched, bool ALIGN_EPI = false, bool SP2 = false>
__device__ __forceinline__ void gemm_phase(PG8_LAS unsigned char* lds, const Gemm g, const Sched& S, const Epi& E) {
    int tid_ = threadIdx.x; asm volatile("" : "+v"(tid_));
    const int tid = tid_, wid = __builtin_amdgcn_readfirstlane(tid >> 6), lane = tid & 63, wr = wid >> 2, wc = wid & 3, fr = lane & 15, fq = lane >> 4;
    const int K = g.K, nt = K / BK;
    unsigned voffA[2], voffB[2];
#pragma unroll
    for (int i = 0; i < 2; ++i) { int R, C; stage_rc(tid * 16 + i * 8192, R, C); const int Rb = Epi::PERM ? ((R & ~31) + perm32(R & 31)) : R;
        voffA[i] = (unsigned)(R * K + C) * 2u; voffB[i] = (unsigned)(Rb * K + C) * 2u; }
    const size_t kstep = (size_t)(BK * 2);
    const size_t hstep = (size_t)HALF * K * 2;
    const size_t tstep = 2 * hstep;
    const unsigned ldsw = (unsigned)wid * 1024u;
    const int aoff = lds_byte(wr * 64 + fr, fq * 8), boff = lds_byte(wc * 32 + fr, fq * 8);
#define PG8_SA(b, h) (((b) * 2 + (h)) * HTB)
#define PG8_SB(b, h) ((4 + (b) * 2 + (h)) * HTB)
#define PG8_STAGE(bufoff, gbase, voff) do { _Pragma("unroll") for (int _i = 0; _i < 2; ++_i) \
        __builtin_amdgcn_global_load_lds((const unsigned*)((const char*)(gbase) + (voff)[_i]), (PG8_LAS unsigned*)(lds + (bufoff) + ldsw + _i * 8192), 16, 0, 0); } while (0)
#define PG8_LDA(dst, b, h) do { _Pragma("unroll") for (int m = 0; m < 4; ++m) _Pragma("unroll") for (int k = 0; k < 2; ++k) dst[m][k] = *(const PG8_LAS bf16x8*)(lds + PG8_SA(b, h) + aoff + m * 2048 + k * 1024); } while (0)
#define PG8_LDB(dst, b, h) do { _Pragma("unroll") for (int n = 0; n < 2; ++n) _Pragma("unroll") for (int k = 0; k < 2; ++k) dst[n][k] = *(const PG8_LAS bf16x8*)(lds + PG8_SB(b, h) + boff + n * 2048 + k * 1024); } while (0)
#define PG8_MMA(ai, bj, At, Bt) do { __builtin_amdgcn_s_setprio(1); _Pragma("unroll") for (int m = 0; m < 4; ++m) _Pragma("unroll") for (int n = 0; n < 2; ++n) _Pragma("unroll") for (int k = 0; k < 2; ++k) \
        acc[ai][bj][m][n] = __builtin_amdgcn_mfma_f32_16x16x32_bf16(Bt[n][k], At[m][k], acc[ai][bj][m][n], 0, 0, 0); __builtin_amdgcn_s_setprio(0); } while (0)
#define PG8_WAIT_V(n) asm volatile("s_waitcnt vmcnt(" #n ")" ::: "memory")
#define PG8_WAIT_L(n) asm volatile("s_waitcnt lgkmcnt(" #n ")" ::: "memory")
#define PG8_BAR __builtin_amdgcn_s_barrier()
#define PG8_SCHED __builtin_amdgcn_sched_barrier(0)
    Unit cur, nxt; int ui = 0;
    if (!S.next(0, cur)) return;
    f32x4 acc[2][2][4][2];
#pragma unroll
    for (int a = 0; a < 2; ++a)
#pragma unroll
        for (int b = 0; b < 2; ++b)
#pragma unroll
            for (int m = 0; m < 4; ++m)
#pragma unroll
                for (int n = 0; n < 2; ++n) acc[a][b][m][n] = (f32x4){0.f, 0.f, 0.f, 0.f};
    bf16x8 At[4][2], B0[2][2], B1[2][2];
    const char* cA = (const char*)g.A + (size_t)cur.pm * tstep; const char* cB = (const char*)g.Bt + (size_t)cur.pn * tstep;
    S.a_ready(cur);
    if constexpr (SP2) {
        PG8_STAGE(PG8_SB(0, 0), cB, voffB); PG8_STAGE(PG8_SB(0, 1), cB + hstep, voffB); PG8_STAGE(PG8_SA(0, 0), cA, voffA); PG8_STAGE(PG8_SA(0, 1), cA + hstep, voffA);
        if (wr == 1) PG8_BAR;
        PG8_WAIT_V(2); PG8_BAR;
        PG8_STAGE(PG8_SB(1, 0), cB + kstep, voffB); PG8_STAGE(PG8_SA(1, 0), cA + kstep, voffA); PG8_STAGE(PG8_SB(1, 1), cB + hstep + kstep, voffB);
        PG8_WAIT_V(6); PG8_BAR;
    } else {
        PG8_STAGE(PG8_SB(0, 0), cB, voffB); PG8_STAGE(PG8_SA(0, 0), cA, voffA); PG8_STAGE(PG8_SB(0, 1), cB + hstep, voffB); PG8_STAGE(PG8_SA(0, 1), cA + hstep, voffA);
        if (wr == 1) PG8_BAR;
        PG8_WAIT_V(4); PG8_BAR;
        PG8_STAGE(PG8_SB(1, 0), cB + kstep, voffB); PG8_STAGE(PG8_SA(1, 0), cA + kstep, voffA); PG8_STAGE(PG8_SB(1, 1), cB + hstep + kstep, voffB);
        PG8_WAIT_V(6); PG8_BAR;
    }
    for (;;) {
        const bool has_next = S.next(ui + 1, nxt);
        const char* nA = has_next ? (const char*)g.A + (size_t)nxt.pm * tstep : cA; const char* nB = has_next ? (const char*)g.Bt + (size_t)nxt.pn * tstep : cB;
        for (int t = 0; t < nt; t += 2) {
            const bool last = (t == nt - 2);
            const char* a1 = cA + (size_t)(t + 1) * kstep;
            const char* a2 = last ? nA : cA + (size_t)(t + 2) * kstep; const char* b2 = last ? nB : cB + (size_t)(t + 2) * kstep;
            const char* a3 = a2 + kstep; const char* b3 = b2 + kstep;
            if (last && has_next) S.a_ready(nxt);
            if constexpr (SP2) {
            PG8_LDB(B0, 0, 0); PG8_LDB(B1, 0, 1); PG8_SCHED; PG8_LDA(At, 0, 0); PG8_STAGE(PG8_SA(1, 1), a1 + hstep, voffA);
            PG8_WAIT_V(8); PG8_WAIT_L(0); PG8_BAR; PG8_MMA(0, 0, At, B0); PG8_MMA(0, 1, At, B1); PG8_BAR; PG8_SCHED;
            PG8_LDA(At, 0, 1); PG8_STAGE(PG8_SB(0, 0), b2, voffB); PG8_STAGE(PG8_SB(0, 1), b2 + hstep, voffB); PG8_STAGE(PG8_SA(0, 0), a2, voffA);
            PG8_WAIT_V(8); PG8_WAIT_L(0); PG8_BAR; PG8_MMA(1, 0, At, B0); PG8_MMA(1, 1, At, B1); PG8_BAR; PG8_SCHED;
            PG8_LDB(B0, 1, 0); PG8_LDB(B1, 1, 1); PG8_SCHED; PG8_LDA(At, 1, 0); PG8_STAGE(PG8_SA(0, 1), a2 + hstep, voffA);
            PG8_WAIT_V(8); PG8_WAIT_L(0); PG8_BAR; PG8_MMA(0, 0, At, B0); PG8_MMA(0, 1, At, B1); PG8_BAR; PG8_SCHED;
            PG8_LDA(At, 1, 1); PG8_STAGE(PG8_SB(1, 0), b3, voffB); PG8_STAGE(PG8_SB(1, 1), b3 + hstep, voffB); PG8_STAGE(PG8_SA(1, 0), a3, voffA);
            PG8_WAIT_V(8); PG8_WAIT_L(0); PG8_BAR; PG8_MMA(1, 0, At, B0); PG8_MMA(1, 1, At, B1); PG8_BAR; PG8_SCHED;
            } else {
            PG8_LDB(B0, 0, 0); PG8_SCHED; PG8_LDA(At, 0, 0); PG8_STAGE(PG8_SA(1, 1), a1 + hstep, voffA);
            PG8_WAIT_L(8); PG8_BAR; PG8_WAIT_L(0); PG8_MMA(0, 0, At, B0); PG8_BAR; PG8_SCHED;
            PG8_LDB(B1, 0, 1); PG8_STAGE(PG8_SB(0, 0), b2, voffB);
            PG8_BAR; PG8_WAIT_L(0); PG8_MMA(0, 1, At, B1); PG8_BAR;
            PG8_LDA(At, 0, 1); PG8_STAGE(PG8_SA(0, 0), a2, voffA);
            PG8_BAR; PG8_WAIT_L(0); PG8_MMA(1, 0, At, B0); PG8_BAR; PG8_SCHED;
            PG8_STAGE(PG8_SB(0, 1), b2 + hstep, voffB);
            PG8_WAIT_V(6); PG8_BAR; PG8_MMA(1, 1, At, B1); PG8_BAR;
            PG8_LDB(B0, 1, 0); PG8_SCHED; PG8_LDA(At, 1, 0); PG8_STAGE(PG8_SA(0, 1), a2 + hstep, voffA);
            PG8_WAIT_L(8); PG8_BAR; PG8_WAIT_L(0); PG8_MMA(0, 0, At, B0); PG8_BAR; PG8_SCHED;
            PG8_LDB(B1, 1, 1); PG8_STAGE(PG8_SB(1, 0), b3, voffB);
            PG8_BAR; PG8_WAIT_L(0); PG8_MMA(0, 1, At, B1); PG8_BAR;
            PG8_LDA(At, 1, 1); PG8_STAGE(PG8_SA(1, 0), a3, voffA);
            PG8_BAR; PG8_WAIT_L(0); PG8_MMA(1, 0, At, B0); PG8_BAR; PG8_SCHED;
            PG8_STAGE(PG8_SB(1, 1), b3 + hstep, voffB);
            PG8_WAIT_V(6); PG8_BAR; PG8_MMA(1, 1, At, B1); PG8_BAR;
            }
        }
        if constexpr (ALIGN_EPI) { if (wr == 0) PG8_BAR; }
        if constexpr (!Epi::AFTER_DRAIN) { E(acc, cur, wr, wc, fr, fq); S.done(cur); }
        if (!has_next) break;
#pragma unroll
        for (int a = 0; a < 2; ++a)
#pragma unroll
            for (int b = 0; b < 2; ++b)
#pragma unroll
                for (int m = 0; m < 4; ++m)
#pragma unroll
                    for (int n = 0; n < 2; ++n) acc[a][b][m][n] = (f32x4){0.f, 0.f, 0.f, 0.f};
        cur = nxt; cA = nA; cB = nB; ++ui;
        if constexpr (ALIGN_EPI) { if (wr == 1) PG8_BAR; }
    }
    PG8_WAIT_V(0);
    if constexpr (!ALIGN_EPI) { if (wr == 0) PG8_BAR; }
    PG8_BAR;
    if constexpr (Epi::AFTER_DRAIN) { E.fused(acc, cur, wr, wc, fr, fq, lds, wid, lane); S.done(cur); }
#undef PG8_SA
#undef PG8_SB
#undef PG8_STAGE
#undef PG8_LDA
#undef PG8_LDB
#undef PG8_MMA
#undef PG8_WAIT_V
#undef PG8_WAIT_L
#undef PG8_BAR
#undef PG8_SCHED
}
}
constexpr int NB = 4, T = 8192, M = NB * T, DM = 2048, DFF = 5632, DEPTH = 2;
constexpr int N_IN = 7696, N_INP = 7936;
constexpr int NWAVES = 8, NTHR = NWAVES * 64;
#define LAS __attribute__((address_space(3)))
#define GAS __attribute__((address_space(1)))
#define CAS __attribute__((address_space(4)))
typedef unsigned short bf16;
typedef short bf16x8 __attribute__((ext_vector_type(8)));
typedef float f32x4 __attribute__((ext_vector_type(4)));
typedef float f32x16 __attribute__((ext_vector_type(16)));
typedef unsigned u32x4 __attribute__((ext_vector_type(4)));
typedef unsigned u32x2 __attribute__((ext_vector_type(2)));
typedef unsigned long long u64;

constexpr size_t MiB = 1u << 20;
constexpr size_t WS_CTL = 0, CTL_ZERO_BYTES = 1 * MiB;
constexpr size_t WS_WIN = 1 * MiB, WS_WOUT = 32 * MiB, WS_WGU = 40 * MiB, WS_WDN = 84 * MiB;
constexpr size_t WS_LORA = 106 * MiB;
constexpr size_t LO_W = 0, LO_A = 512 * 96 * 2, LO_V = 2 * 512 * 96 * 2, LO_G = LO_V + 512 * 64 * 2;
constexpr size_t WS_VFIRST = 107 * MiB;
constexpr size_t WS_H = 139 * MiB;
constexpr size_t WS_VT = 139 * MiB, WS_MASK = 203 * MiB;
constexpr size_t WS_Q = 267 * MiB, WS_K = 331 * MiB, WS_QI = 395 * MiB, WS_V = 459 * MiB, WS_KW = 523 * MiB, WS_BQ = 539 * MiB, WS_BK = 555 * MiB, WS_BV = 571 * MiB, WS_BG = 603 * MiB;
constexpr size_t WS_CR = 635 * MiB, WS_CK = 667 * MiB, WS_CV = 699 * MiB, WS_CL = 731 * MiB, WS_CG = 747 * MiB;
constexpr size_t WS_CAT = 763 * MiB;
constexpr size_t WS_KVST = 891 * MiB;
constexpr size_t WS_TAB = 955 * MiB;
constexpr size_t WS_SS1 = 960 * MiB, WS_SS2 = 964 * MiB;
constexpr size_t TAB_A = 0, TAB_I = (size_t)T * 16 * 8, TAB_R = TAB_I + (size_t)T * 8 * 8, TAB_END = TAB_R + (size_t)T * 32 * 8;
constexpr size_t WS_RR = 139 * MiB, WS_RW = 171 * MiB, WS_RKH = 203 * MiB, WS_RV = 235 * MiB, WS_RA = 267 * MiB, WS_RB = 299 * MiB;
constexpr size_t WS_PHI = 331 * MiB, WS_PSI = 363 * MiB, WS_SST = 395 * MiB, WS_Y = 635 * MiB;
constexpr size_t WS_H2 = 139 * MiB, WS_ACT = 267 * MiB;
constexpr size_t WS_NEED = 1024 * MiB;
static_assert(WS_TAB + TAB_END <= WS_NEED && WS_ACT + (size_t)M * DFF * 2 <= WS_CR && WS_SST + 32 * MiB <= WS_V && WS_RB + 32 * MiB <= WS_PHI && WS_Y + (size_t)M * 512 * 4 <= WS_CV, "ws map");

constexpr int LDS_BYTES = 147456, MISC_OFF = 143360;
constexpr int CW_BAR = 4096;

__device__ __forceinline__ unsigned f2bf(float f) { unsigned u = __builtin_bit_cast(unsigned, f); return (u + 0x7fffu + ((u >> 16) & 1u)) >> 16; }
__device__ __forceinline__ unsigned pk2(float lo, float hi) { return f2bf(lo) | (f2bf(hi) << 16); }
__device__ __forceinline__ float bf2f(unsigned short b) { return __builtin_bit_cast(float, (unsigned)b << 16); }
__device__ __forceinline__ float bflo(unsigned w) { return __builtin_bit_cast(float, w << 16); }
__device__ __forceinline__ float bfhi(unsigned w) { return __builtin_bit_cast(float, w & 0xffff0000u); }
__device__ __forceinline__ float wave_sum(float v) {
#pragma unroll
    for (int o = 1; o < 64; o <<= 1) v += __shfl_xor(v, o);
    return v;
}
#define LDS_WAIT() asm volatile("s_waitcnt lgkmcnt(0)" ::: "memory")
typedef float f32x2 __attribute__((ext_vector_type(2)));
template <class TT> __device__ __forceinline__ GAS TT* at_b(GAS TT* ub, unsigned boff) { return (GAS TT*)((GAS char*)ub + boff); }
__device__ __forceinline__ float half_sum32(float v) { v += __shfl_xor(v, 1); v += __shfl_xor(v, 2); v += __shfl_xor(v, 4); v += __shfl_xor(v, 8); v += __shfl_xor(v, 16); return v; }


namespace pg8 {
__device__ __forceinline__ void tile_dest(int pn, size_t& off, int& ld, int& colt) {
    if (pn < 16) { const int g = pn >> 2; off = g == 0 ? WS_Q : g == 1 ? WS_K : g == 2 ? WS_V : WS_QI; ld = 1024; colt = (pn & 3) * 256; }
    else if (pn == 16) { off = WS_BQ; ld = 256; colt = 0; }
    else if (pn == 17) { off = WS_BK; ld = 256; colt = 0; }
    else if (pn < 20) { off = WS_BV; ld = 512; colt = (pn - 18) * 256; }
    else if (pn < 22) { off = WS_BG; ld = 512; colt = (pn - 20) * 256; }
    else if (pn == 22) { off = WS_KW; ld = 256; colt = 0; }
    else if (pn < 25) { off = WS_CR; ld = 512; colt = (pn - 23) * 256; }
    else if (pn < 27) { off = WS_CK; ld = 512; colt = (pn - 25) * 256; }
    else if (pn < 29) { off = WS_CV; ld = 512; colt = (pn - 27) * 256; }
    else if (pn == 29) { off = WS_CL; ld = 256; colt = 0; }
    else { off = WS_CG; ld = 256; colt = 0; }
}
}
__device__ __forceinline__ int win_src(int n, int layer) {
    if (n < 4096) return n;
    if (n < 4352) return 4176 + (n - 4096);
    if (n < 4608) return 4432 + (n - 4352);
    if (n < 5120) return 4688 + (n - 4608);
    if (n < 5632) return 5200 + (n - 5120);
    if (n < 5888) { const int j = n - 5632; return j < 64 ? 4096 + j : (j < 80 ? 4160 + (j - 64) : -1); }
    if (n < 7424) return 5712 + (n - 5888);
    if (n < 7680) { const int j = n - 7424; return j < 96 ? 7248 + j : (j < 192 ? 7344 + (j - 96) : (layer > 0 ? -2 - (j - 192) : -1)); }
    return 7440 + (n - 7680);
}
#define XB_TMO      128
#define XB_XCNT(j)  (256  + 64 * (j))
#define XB_XSUB(j)  (1280 + 64 * (j))
#define XB_XGEN(j)  (2304 + 64 * (j))
#define XB_TOP      3328
#define XB_TOPGEN   3392
#define XCD_BAR_WORDS 3456
#define XB_SPIN_CAP (1u << 18)

__device__ __forceinline__ unsigned xb_ld(unsigned* p)              { return __hip_atomic_load(p, __ATOMIC_RELAXED, __HIP_MEMORY_SCOPE_AGENT); }
__device__ __forceinline__ unsigned xb_add(unsigned* p, unsigned v) { return __hip_atomic_fetch_add(p, v, __ATOMIC_RELAXED, __HIP_MEMORY_SCOPE_AGENT); }
__device__ __forceinline__ unsigned xb_xcc_id() { return (unsigned)__builtin_amdgcn_s_getreg((3 << 11) | 20) & 0xFu; }
#define XB_SPIN(cond, bar) do { unsigned _sp = 0; while (cond) { __builtin_amdgcn_s_sleep(1); \
    if ((++_sp & 255u) == 0u) { if (xb_ld(&(bar)[XB_TMO])) break; if (_sp > XB_SPIN_CAP) { atomicAdd(&(bar)[XB_TMO], 1u); break; } } } } while (0)

struct XcdBarrier {
    unsigned* bar; unsigned x;
    volatile LAS unsigned* st;
};

__device__ __forceinline__ XcdBarrier xcd_barrier_post(unsigned* bar, volatile LAS unsigned* st) {
    XcdBarrier b; b.bar = bar; b.x = xb_xcc_id(); b.st = st;
    if (threadIdx.x == 0) (void)xb_add(&bar[XB_XCNT(b.x)], 1u);
    return b;
}
__device__ __forceinline__ void xcd_barrier_complete(unsigned* bar, unsigned x, unsigned& nloc, unsigned& nx) {
    const unsigned G = gridDim.x * gridDim.y * gridDim.z;
    unsigned sum, cnt, mine, sp = 0u;
    for (;;) {
        sum = 0u; cnt = 0u; mine = 0u;
#pragma unroll
        for (unsigned j = 0; j < 16; ++j) { const unsigned c = xb_ld(&bar[XB_XCNT(j)]); sum += c; cnt += (c > 0u) ? 1u : 0u; mine = (j == x) ? c : mine; }
        if (sum == G) break;
        __builtin_amdgcn_s_sleep(1);
        if ((++sp & 255u) == 0u) { if (xb_ld(&bar[XB_TMO])) break; if (sp > XB_SPIN_CAP) { atomicAdd(&bar[XB_TMO], 1u); break; } }
    }
    nloc = mine > 0u ? mine : 1u; nx = cnt > 0u ? cnt : 1u;
}

__device__ __forceinline__ void xcd_barrier(const XcdBarrier& b) {
    asm volatile("s_waitcnt vmcnt(0)" ::: "memory");
    __syncthreads();
    if (threadIdx.x == 0) {
        unsigned* bar = b.bar;
        __builtin_amdgcn_s_waitcnt(0);
        unsigned nloc = b.st[0], nx = b.st[1];
        if (nloc == 0u) { xcd_barrier_complete(bar, b.x, nloc, nx); b.st[0] = nloc; b.st[1] = nx; }
        const unsigned old = xb_add(&bar[XB_XSUB(b.x)], 1u);
        const unsigned gen = old / nloc;
        if (old + 1u == (gen + 1u) * nloc) {
            __builtin_amdgcn_fence(__ATOMIC_RELEASE, "agent");
            asm volatile("s_waitcnt vmcnt(0)" ::: "memory");
            const unsigned og = xb_add(&bar[XB_TOP], 1u);
            const unsigned tg = og / nx;
            if (og + 1u == (tg + 1u) * nx) xb_add(&bar[XB_TOPGEN], 1u);
            else XB_SPIN(xb_ld(&bar[XB_TOPGEN]) == tg, bar);
            __builtin_amdgcn_fence(__ATOMIC_ACQUIRE, "agent");
            xb_add(&bar[XB_XGEN(b.x)], 1u);
            asm volatile("s_waitcnt vmcnt(0)" ::: "memory");
        } else {
            XB_SPIN(xb_ld(&bar[XB_XGEN(b.x)]) == gen, bar);
            __builtin_amdgcn_fence(__ATOMIC_ACQUIRE, "agent");
            asm volatile("s_waitcnt vmcnt(0)" ::: "memory");
        }
    }
    __syncthreads();
}

struct Ctx {
    LAS unsigned char* lds; int tid, lane, wave, G, bid; unsigned char* ws; float* out;
};

template <int MAP>
__device__ __forceinline__ void wconv_item(const float* W, int ldw, const float* W2, int K, bf16* WT, LAS float* scr, int item, int nblk, int lane, int layer, const float* gk) {
    const int kb = item / nblk, nb = item % nblk, k0 = 64 * kb, n0 = 32 * nb;
    const int n = n0 + (lane & 31);
    const float* src = nullptr; int ld = ldw;
    if (MAP == 0) src = W + n;
    else if (MAP == 1) { const int s = win_src(n, layer); if (s >= 0) src = W + s; else if (s <= -2) { src = W2 + (-2 - s); ld = 64; } }
    else { const int tl = n >> 8, j = n & 255; src = W + (j < 128 ? tl * 128 + j : DFF + tl * 128 + (j - 128)); }
    float tv[32];
#pragma unroll
    for (int i = 0; i < 32; ++i) { const int kk = 2 * i + (lane >> 5); tv[i] = src ? src[(size_t)(k0 + kk) * ld] : 0.f; }
#pragma unroll
    for (int i = 0; i < 32; ++i) { const int kk = 2 * i + (lane >> 5); scr[kk * 33 + (lane & 31)] = tv[i]; }
    LDS_WAIT(); asm volatile("" ::: "memory");
    const int c = lane & 7;
    f32x4 ga = {1.f, 1.f, 1.f, 1.f}, gb = ga; if (gk) { ga = *(const f32x4*)(gk + k0 + 8 * c); gb = *(const f32x4*)(gk + k0 + 8 * c + 4); }
#pragma unroll
    for (int j = 0; j < 4; ++j) { const int nn = (lane >> 3) + 8 * j; const LAS float* s = scr + (8 * c) * 33 + nn;
        u32x4 o; o.x = pk2(s[0 * 33] * ga.x, s[1 * 33] * ga.y); o.y = pk2(s[2 * 33] * ga.z, s[3 * 33] * ga.w); o.z = pk2(s[4 * 33] * gb.x, s[5 * 33] * gb.y); o.w = pk2(s[6 * 33] * gb.z, s[7 * 33] * gb.w);
        *(u32x4*)(WT + (size_t)(n0 + nn) * K + k0 + 8 * c) = o; }
    LDS_WAIT(); asm volatile("" ::: "memory");
}
struct WSrc { const float *w_in, *w_vres, *w_out, *w_gu, *w_dn, *wlb, *alb, *glb, *vlb, *g_mix, *g_ffn; };
__device__ __forceinline__ void phase_wconv(const Ctx& C, int layer, const WSrc& W) {
    LAS float* scr = (LAS float*)(C.lds + C.wave * 16384);
    const int gw = C.bid * NWAVES + C.wave, NGW = C.G * NWAVES;
    const float* w_in = W.w_in + (size_t)layer * DM * N_IN; const float* w_vres = W.w_vres;
    const float* w_out = W.w_out + (size_t)layer * DM * DM; const float* w_gu = W.w_gu + (size_t)layer * DM * 2 * DFF; const float* w_dn = W.w_dn + (size_t)layer * DFF * DM;
    constexpr int I_IN = (DM / 64) * (N_INP / 32), I_OUT = (DM / 64) * (DM / 32), I_GU = (DM / 64) * (2 * DFF / 32), I_DN = (DFF / 64) * (DM / 32);
    for (int it = gw; it < I_IN + I_OUT + I_GU + I_DN; it += NGW) {
        int r = it;
        if (r < I_IN) { wconv_item<1>(w_in, N_IN, w_vres, DM, (bf16*)(C.ws + WS_WIN), scr, r, N_INP / 32, C.lane, layer, W.g_mix + layer * DM); continue; } r -= I_IN;
        if (r < I_OUT) { wconv_item<0>(w_out, DM, nullptr, DM, (bf16*)(C.ws + WS_WOUT), scr, r, DM / 32, C.lane, layer, nullptr); continue; } r -= I_OUT;
        if (r < I_GU) { wconv_item<2>(w_gu, 2 * DFF, nullptr, DM, (bf16*)(C.ws + WS_WGU), scr, r, 2 * DFF / 32, C.lane, layer, W.g_ffn + layer * DM); continue; } r -= I_GU;
        wconv_item<0>(w_dn, DM, nullptr, DFF, (bf16*)(C.ws + WS_WDN), scr, r, DM / 32, C.lane, layer, nullptr);
    }
    const int gt = C.bid * NTHR + C.tid, NGT = C.G * NTHR;
    const float* wlb = W.wlb + (size_t)layer * 96 * 512; const float* alb = W.alb + (size_t)layer * 96 * 512; const float* glb = W.glb + (size_t)layer * 256 * 512;
    const float* vlb = W.vlb;
    bf16* LW = (bf16*)(C.ws + WS_LORA + LO_W); bf16* LA = (bf16*)(C.ws + WS_LORA + LO_A); bf16* LV = (bf16*)(C.ws + WS_LORA + LO_V); bf16* LG = (bf16*)(C.ws + WS_LORA + LO_G);
    for (int i = gt; i < 512 * 96; i += NGT) { const int n = i / 96, k = i % 96; LW[i] = (bf16)f2bf(wlb[k * 512 + n]); LA[i] = (bf16)f2bf(alb[k * 512 + n]); }
    for (int i = gt; i < 512 * 64; i += NGT) { const int n = i / 64, k = i % 64; LV[i] = (bf16)f2bf(layer > 0 ? vlb[k * 512 + n] : 0.f); }
    for (int i = gt; i < 512 * 256; i += NGT) { const int n = i / 256, k = i % 256; LG[i] = (bf16)f2bf(glb[k * 512 + n]); }
    if (layer == 0) {
        float2* TA = (float2*)(C.ws + WS_TAB + TAB_A); float2* TI = (float2*)(C.ws + WS_TAB + TAB_I); float2* TR = (float2*)(C.ws + WS_TAB + TAB_R);
        const float l2a = 18.931568569324174f  , l2r = 13.287712379549449f  ;
        for (int i = gt; i < T * 56; i += NGT) {
            const int pos = i / 56, j = i % 56; float fr; float2* dst;
            if (j < 16) { fr = exp2f(-(float)j * (1.0f / 16.0f) * l2a); dst = TA + pos * 16 + j; }
            else if (j < 24) { fr = exp2f(-(float)(j - 16) * (1.0f / 8.0f) * l2a); dst = TI + pos * 8 + (j - 16); }
            else { fr = exp2f(-(float)(j - 24) * (1.0f / 32.0f) * l2r); dst = TR + pos * 32 + (j - 24); }
            const float ang = (float)pos * fr; *dst = make_float2(cosf(ang), sinf(ang));
        }
    }
}
__device__ __forceinline__ void phase_xg(const Ctx& C, const float* x, bf16* out, float* ss) {
    const int gw = C.bid * NWAVES + C.wave, NGW = C.G * NWAVES;
    for (int m = gw; m < M; m += 2 * NGW) {
        const int m1 = m + NGW < M ? m + NGW : m;
        const f32x4* xr0 = (const f32x4*)(x + (size_t)m * DM) + C.lane; const f32x4* xr1 = (const f32x4*)(x + (size_t)m1 * DM) + C.lane; f32x4 v0[8], v1[8];
#pragma unroll
        for (int j = 0; j < 8; ++j) { v0[j] = xr0[64 * j]; v1[j] = xr1[64 * j]; }
        float s0 = 0.f, s1 = 0.f;
#pragma unroll
        for (int j = 0; j < 8; ++j) { s0 += (v0[j].x * v0[j].x + v0[j].y * v0[j].y) + (v0[j].z * v0[j].z + v0[j].w * v0[j].w); s1 += (v1[j].x * v1[j].x + v1[j].y * v1[j].y) + (v1[j].z * v1[j].z + v1[j].w * v1[j].w); }
        s0 = wave_sum(s0); s1 = wave_sum(s1);
        if (C.lane < 32) { ss[(size_t)m * 32 + C.lane] = C.lane == 0 ? s0 : 0.f; if (m1 != m) ss[(size_t)m1 * 32 + C.lane] = C.lane == 0 ? s1 : 0.f; }
        u32x2* o0 = (u32x2*)(out + (size_t)m * DM) + C.lane; u32x2* o1 = (u32x2*)(out + (size_t)m1 * DM) + C.lane;
#pragma unroll
        for (int j = 0; j < 8; ++j) { u32x2 w; w.x = pk2(v0[j].x, v0[j].y); w.y = pk2(v0[j].z, v0[j].w); o0[64 * j] = w; }
        if (m1 != m) {
#pragma unroll
            for (int j = 0; j < 8; ++j) { u32x2 w; w.x = pk2(v1[j].x, v1[j].y); w.y = pk2(v1[j].z, v1[j].w); o1[64 * j] = w; }
        }
    }
}
__device__ __forceinline__ void phase_final_norm(const Ctx& C, const bf16* x, float* out, const float* g, const float* ss) {
    const int gw = C.bid * NWAVES + C.wave, NGW = C.G * NWAVES;
    f32x4 gv[8];
#pragma unroll
    for (int j = 0; j < 8; ++j) gv[j] = *(const f32x4*)(g + 4 * (C.lane + 64 * j));
    for (int m = gw; m < M; m += 2 * NGW) {
        const int m1 = m + NGW < M ? m + NGW : m;
        const u32x2* xr0 = (const u32x2*)(x + (size_t)m * DM) + C.lane; const u32x2* xr1 = (const u32x2*)(x + (size_t)m1 * DM) + C.lane;
        const float s0 = C.lane < 32 ? ss[(size_t)m * 32 + C.lane] : 0.f, s1 = C.lane < 32 ? ss[(size_t)m1 * 32 + C.lane] : 0.f;
        u32x2 w0[8], w1[8];
#pragma unroll
        for (int j = 0; j < 8; ++j) { w0[j] = xr0[64 * j]; w1[j] = xr1[64 * j]; }
        const float rs0 = rsqrtf(wave_sum(s0) * (1.0f / DM) + 1e-5f), rs1 = rsqrtf(wave_sum(s1) * (1.0f / DM) + 1e-5f);
        f32x4* or0 = (f32x4*)(out + (size_t)m * DM) + C.lane; f32x4* or1 = (f32x4*)(out + (size_t)m1 * DM) + C.lane;
#pragma unroll
        for (int j = 0; j < 8; ++j) { const f32x4 v = {bflo(w0[j].x), bfhi(w0[j].x), bflo(w0[j].y), bfhi(w0[j].y)}; or0[64 * j] = v * rs0 * gv[j]; }
        if (m1 != m) {
#pragma unroll
            for (int j = 0; j < 8; ++j) { const f32x4 v = {bflo(w1[j].x), bfhi(w1[j].x), bflo(w1[j].y), bfhi(w1[j].y)}; or1[64 * j] = v * rs1 * gv[j]; }
        }
    }
}
__device__ __forceinline__ void phase_prep_a(const Ctx& C) {
    const long gt = (long)C.bid * NTHR + C.tid, NGT = (long)C.G * NTHR;
    for (int cfg = 0; cfg < 6; ++cfg) {
        size_t off; int ld, nh, hd, half; size_t tab;
        if (cfg == 0) { off = WS_Q; ld = 1024; nh = 8; hd = 128; half = 16; tab = TAB_A; }
        else if (cfg == 1) { off = WS_K; ld = 1024; nh = 8; hd = 128; half = 16; tab = TAB_A; }
        else if (cfg == 2) { off = WS_QI; ld = 1024; nh = 16; hd = 64; half = 8; tab = TAB_I; }
        else if (cfg == 3) { off = WS_KW; ld = 256; nh = 1; hd = 64; half = 8; tab = TAB_I; }
        else if (cfg == 4) { off = WS_BQ; ld = 256; nh = 4; hd = 64; half = 32; tab = TAB_R; }
        else { off = WS_BK; ld = 256; nh = 4; hd = 64; half = 32; tab = TAB_R; }
        bf16* buf = (bf16*)(C.ws + off); const float2* tb = (const float2*)(C.ws + WS_TAB + tab);
        const int cpp = half >> 3; const long total = (long)M * nh * cpp;
        for (long it0 = gt; it0 < total; it0 += 4 * NGT) {
            bf16* p1[4]; u32x4 a[4], b[4]; f32x4 tcs[4][4]; bool ok[4];
#pragma unroll
            for (int q = 0; q < 4; ++q) { const long it = it0 + q * NGT; ok[q] = it < total; const long itc = ok[q] ? it : gt;
                const int c = (int)(itc % cpp); const long r2 = itc / cpp; const int h = (int)(r2 % nh); const int row = (int)(r2 / nh); const int pos = row & (T - 1);
                p1[q] = buf + (size_t)row * ld + h * hd + 8 * c; a[q] = *(const u32x4*)p1[q]; b[q] = *(const u32x4*)(p1[q] + half);
                const f32x4* tp = (const f32x4*)(tb + (size_t)pos * half + 8 * c);
#pragma unroll
                for (int e = 0; e < 4; ++e) tcs[q][e] = tp[e]; }
#pragma unroll
            for (int q = 0; q < 4; ++q) { if (!ok[q]) continue; u32x4 oa, ob;
#pragma unroll
                for (int e = 0; e < 4; ++e) { const float x10 = bflo(a[q][e]), x11 = bfhi(a[q][e]), x20 = bflo(b[q][e]), x21 = bfhi(b[q][e]); const f32x4 t = tcs[q][e];
                    oa[e] = pk2(x10 * t.x - x20 * t.y, x11 * t.z - x21 * t.w); ob[e] = pk2(x20 * t.x + x10 * t.y, x21 * t.z + x11 * t.w); }
                *(u32x4*)p1[q] = oa; *(u32x4*)(p1[q] + half) = ob; }
        }
    }
    {
        LAS unsigned short* scr = (LAS unsigned short*)(C.lds + C.wave * 9216);
        const bf16* V = (const bf16*)(C.ws + WS_V); bf16* Vt = (bf16*)(C.ws + WS_VT);
        const int gw = C.bid * NWAVES + C.wave, NGW = C.G * NWAVES, lane = C.lane;
        for (int it = gw; it < NB * 128 * 16; it += NGW) {
            const int ct = it & 15, tt = (it >> 4) & 127, b = it >> 11;
            const int t0 = tt * 64, c0 = ct * 64;
            u32x4 v[8];
#pragma unroll
            for (int i = 0; i < 8; ++i) { const int tr = 8 * i + (lane >> 3), c8 = (lane & 7) * 8; v[i] = *(const u32x4*)(V + (size_t)(b * T + t0 + tr) * 1024 + c0 + c8); }
#pragma unroll
            for (int i = 0; i < 8; ++i) { const int tr = 8 * i + (lane >> 3), c8 = (lane & 7) * 8; *(LAS u32x4*)(scr + tr * 72 + c8) = v[i]; }
            LDS_WAIT(); asm volatile("" ::: "memory");
#pragma unroll
            for (int i = 0; i < 8; ++i) { const int cr = 8 * i + (lane >> 3), t8 = (lane & 7) * 8; u32x4 w;
#pragma unroll
                for (int e = 0; e < 4; ++e) w[e] = (unsigned)scr[(t8 + 2 * e) * 72 + cr] | ((unsigned)scr[(t8 + 2 * e + 1) * 72 + cr] << 16);
                *(u32x4*)(Vt + ((size_t)b * 1024 + c0 + cr) * T + t0 + t8) = w; }
            LDS_WAIT(); asm volatile("" ::: "memory");
        }
    }
}
#ifndef IDX_REP_T
#define IDX_REP_T 1
#endif
#ifndef IDX_REP_S
#define IDX_REP_S 1
#endif
__device__ __forceinline__ void phase_indexer(const Ctx& C) {
    LAS unsigned short* sc = (LAS unsigned short*)C.lds;
    LAS unsigned* hist = (LAS unsigned*)(C.lds + 131072) + C.wave * 256;
    LAS float* wvl = (LAS float*)(C.lds + 131072 + 8192);
    LAS unsigned short* qbl = (LAS unsigned short*)(C.lds + 131072 + 8192 + 512);
    const bf16* QI = (const bf16*)(C.ws + WS_QI); const bf16* KW = (const bf16*)(C.ws + WS_KW); u64* MASK = (u64*)(C.ws + WS_MASK);
    const int lane = C.lane, r32 = lane & 31, hi = lane >> 5;
    for (int itk = 0; itk * C.G < NB * (T / 8); ++itk) {
        const int it = itk * C.G + ((itk & 1) ? C.G - 1 - C.bid : C.bid); if (it >= NB * (T / 8)) break;
        const int b = it & 3, qg = it >> 2, q0 = qg * 8, qchunk = q0 >> 6, nadm = 64 * (qchunk + 1);
        const int qrow = b * T + q0 + C.wave;
        if (qchunk < 4) {
            MASK[(size_t)qrow * 128 + lane] = lane <= qchunk ? ~0ull : 0ull; MASK[(size_t)qrow * 128 + 64 + lane] = 0ull;
            continue;
        }
        bf16x8 af[4][4];
        {
            const int qq = (r32 >> 2) & 1, hh = (r32 & 3) + 4 * (r32 >> 3);
#pragma unroll
            for (int pr = 0; pr < 4; ++pr) {
                const bf16* qp = QI + (size_t)(b * T + q0 + 2 * pr + qq) * 1024 + hh * 64 + 8 * hi;
#pragma unroll
                for (int kk = 0; kk < 4; ++kk) af[pr][kk] = *(const bf16x8*)(qp + 16 * kk);
            }
            { LAS u32x4* hz = (LAS u32x4*)(C.lds + 131072); hz[C.tid] = (u32x4){0u, 0u, 0u, 0u}; }
            if (C.tid < 128) wvl[C.tid] = bf2f(KW[(size_t)(b * T + q0 + (C.tid >> 4)) * 256 + 64 + (C.tid & 15)]) * 0.015625f;
        }
        __syncthreads();
        { const int qx = C.tid >> 6, dx = C.tid & 63; const bf16* qp = QI + (size_t)(b * T + q0 + qx) * 1024 + dx; float acc = 0.f;
#pragma unroll
          for (int h = 0; h < 16; ++h) acc += wvl[qx * 16 + h] * bf2f(qp[h * 64]);
          qbl[qx * 64 + dx] = (unsigned short)f2bf(acc); }
        __syncthreads();
        bf16x8 afl[4];
        { const int qsel = 2 * (r32 & 3) + ((r32 >> 2) & 1);
#pragma unroll
          for (int kk = 0; kk < 4; ++kk) { const u32x4 z = {0u, 0u, 0u, 0u}; afl[kk] = r32 < 8 ? *(const LAS bf16x8*)(qbl + qsel * 64 + 16 * kk + 8 * hi) : __builtin_bit_cast(bf16x8, z); } }
        {
            const int ntile = nadm / 32; LAS unsigned* histq = (LAS unsigned*)(C.lds + 131072);
            bf16x8 bfr[4], bnx[4];
            { const bf16* kp = KW + (size_t)(b * T + 32 * C.wave + r32) * 256 + 8 * hi;
#pragma unroll
              for (int kk = 0; kk < 4; ++kk) bnx[kk] = *(const bf16x8*)(kp + 16 * kk); }
            for (int tile = C.wave; tile < ntile; tile += NWAVES) {
                const int key0 = 32 * tile;
#pragma unroll
                for (int kk = 0; kk < 4; ++kk) bfr[kk] = bnx[kk];
                if (tile + NWAVES < ntile) { const bf16* kp = KW + (size_t)(b * T + key0 + 32 * NWAVES + r32) * 256 + 8 * hi;
#pragma unroll
                    for (int kk = 0; kk < 4; ++kk) bnx[kk] = *(const bf16x8*)(kp + 16 * kk); }
                const int kpos = (key0 & ~127) + 2 * ((key0 & 63) + r32) + ((key0 >> 6) & 1);
                f32x16 dl = {0.f, 0.f, 0.f, 0.f, 0.f, 0.f, 0.f, 0.f, 0.f, 0.f, 0.f, 0.f, 0.f, 0.f, 0.f, 0.f};
#pragma unroll
                for (int kk = 0; kk < 4; ++kk) dl = __builtin_amdgcn_mfma_f32_32x32x16_bf16(afl[kk], bfr[kk], dl, 0, 0, 0);
#pragma unroll
                for (int pr = 0; pr < 4; ++pr) {
                    f32x16 d = {0.f, 0.f, 0.f, 0.f, 0.f, 0.f, 0.f, 0.f, 0.f, 0.f, 0.f, 0.f, 0.f, 0.f, 0.f, 0.f};
#pragma unroll
                    for (int kk = 0; kk < 4; ++kk) d = __builtin_amdgcn_mfma_f32_32x32x16_bf16(af[pr][kk], bfr[kk], d, 0, 0, 0);
                    float s0 = dl[pr];
#pragma unroll
                    for (int g = 0; g < 4; ++g) { const f32x4 w4 = *(const LAS f32x4*)(wvl + (2 * pr + hi) * 16 + 4 * g);
                        s0 = __builtin_fmaf(__builtin_fabsf(d[4 * g]), w4.x, s0); s0 = __builtin_fmaf(__builtin_fabsf(d[4 * g + 1]), w4.y, s0); s0 = __builtin_fmaf(__builtin_fabsf(d[4 * g + 2]), w4.z, s0); s0 = __builtin_fmaf(__builtin_fabsf(d[4 * g + 3]), w4.w, s0); }
                    const unsigned short hb = __half_as_ushort(__float2half_rn(s0));
                    const unsigned short key = (hb & 0x8000u) ? (unsigned short)~hb : (unsigned short)(hb | 0x8000u);
                    sc[(2 * pr + hi) * 8192 + kpos] = key; atomicAdd((unsigned*)&histq[(2 * pr + hi) * 256 + (key >> 8)], 1u);
                }
            }
        }
        __syncthreads();
        const LAS unsigned* my = (const LAS unsigned*)(sc + C.wave * 8192);
        const int nit = nadm / 128;
        const bool tail = (nadm & 64) != 0;
        unsigned thr = 0;
        {
            unsigned want = 256u, prefix = 0u;
#pragma unroll 1
            for (int lvl = 0; lvl < 2; ++lvl) {
                if (lvl == 1) {
                    hist[lane] = 0u; hist[64 + lane] = 0u; hist[128 + lane] = 0u; hist[192 + lane] = 0u;
                    LDS_WAIT(); asm volatile("" ::: "memory");
                    int i = 0;
                    for (; i + 4 <= nit; i += 4) { unsigned kv[4];
#pragma unroll
                        for (int u = 0; u < 4; ++u) kv[u] = my[64 * (i + u) + lane];
#pragma unroll
                        for (int u = 0; u < 4; ++u) { const unsigned k0 = kv[u] & 0xffffu, k1 = kv[u] >> 16;
                            if ((k0 >> 8) == prefix) atomicAdd((unsigned*)&hist[k0 & 255u], 1u); if ((k1 >> 8) == prefix) atomicAdd((unsigned*)&hist[k1 & 255u], 1u); } }
                    for (; i < nit + (tail ? 1 : 0); ++i) { const unsigned kvv = my[64 * i + lane]; const unsigned k0 = kvv & 0xffffu, k1 = kvv >> 16; const bool two = i < nit;
                        if ((k0 >> 8) == prefix) atomicAdd((unsigned*)&hist[k0 & 255u], 1u); if (two && (k1 >> 8) == prefix) atomicAdd((unsigned*)&hist[k1 & 255u], 1u); }
                    LDS_WAIT(); asm volatile("" ::: "memory");
                }
                const unsigned c0 = hist[4 * lane], c1 = hist[4 * lane + 1], c2 = hist[4 * lane + 2], c3 = hist[4 * lane + 3];
                const unsigned tl = c0 + c1 + c2 + c3; unsigned inc = tl;
#pragma unroll
                for (int o = 1; o < 64; o <<= 1) { const unsigned v = __shfl_down(inc, o); if (lane + o < 64) inc += v; }
                const unsigned ab3 = inc - tl, ab2 = ab3 + c3, ab1 = ab2 + c2, ab0 = ab1 + c1;
                int selb = -1; unsigned rem = 0;
                if (ab3 < want && ab3 + c3 >= want) { selb = 3; rem = want - ab3; }
                else if (ab2 < want && ab2 + c2 >= want) { selb = 2; rem = want - ab2; }
                else if (ab1 < want && ab1 + c1 >= want) { selb = 1; rem = want - ab1; }
                else if (ab0 < want && ab0 + c0 >= want) { selb = 0; rem = want - ab0; }
                const u64 bal = __ballot(selb >= 0); const int src = bal ? (int)__ffsll((long long)bal) - 1 : 0;
                const unsigned bin = (unsigned)__shfl(4 * lane + (selb < 0 ? 0 : selb), src); want = (unsigned)__shfl((int)rem, src);
                if (lvl == 0) prefix = bin; else thr = (prefix << 8) | bin;
                LDS_WAIT(); asm volatile("" ::: "memory");
            }
        }
        u64 w0 = 0, w1 = 0;
        for (int i = 0; i < nit + (tail ? 1 : 0); ++i) { const unsigned kvv = my[64 * i + lane]; const u64 b0 = __ballot((kvv & 0xffffu) >= thr), b1 = (i < nit) ? __ballot((kvv >> 16) >= thr) : 0ull;
            if (i < 32) { if (lane == 2 * i) w0 = b0; if (lane == 2 * i + 1) w0 = b1; } else { if (lane == 2 * i - 64) w1 = b0; if (lane == 2 * i - 63) w1 = b1; } }
        MASK[(size_t)qrow * 128 + lane] = w0; MASK[(size_t)qrow * 128 + 64 + lane] = w1;
        __syncthreads();
    }
}
constexpr int AT_KROW = 272, AT_VROW = 136, AT_KB = 64 * AT_KROW, AT_VB = 128 * AT_VROW, AT_BUF = AT_KB + AT_VB;
__device__ __forceinline__ void attn_unit(const Ctx& C, int b, int head, int qb) {
    const bf16* Q = (const bf16*)(C.ws + WS_Q); const bf16* K = (const bf16*)(C.ws + WS_K); const bf16* Vt = (const bf16*)(C.ws + WS_VT);
    const u64* MASK = (const u64*)(C.ws + WS_MASK); bf16* CAT = (bf16*)(C.ws + WS_CAT);
    const int tid = C.tid, lane = C.lane, wid = C.wave, r32 = lane & 31, hi = lane >> 5;
    const int q = 256 * qb + 32 * wid + r32; const size_t row = (size_t)b * T + q;
    const int nt = 4 * qb + 4, myc = 4 * qb + (wid >> 1); const bool late = wid >= 4;
    bf16x8 qf[8];
#pragma unroll
    for (int d0 = 0; d0 < 8; ++d0) qf[d0] = *(const bf16x8*)(Q + row * 1024 + head * 128 + 16 * d0 + 8 * hi);
    const bf16* kg[2]; const bf16* vg[2]; int kl[2], vl[2];
#pragma unroll
    for (int i = 0; i < 2; ++i) { const int c = tid + 512 * i;
        kg[i] = K + ((size_t)b * T + (c >> 4)) * 1024 + head * 128 + (c & 15) * 8; kl[i] = (c >> 4) * AT_KROW + (c & 15) * 16;
        vg[i] = Vt + ((size_t)(b * 8 + head) * 128 + (c >> 3)) * T + (c & 7) * 8; vl[i] = 2 * AT_KB + (c >> 3) * AT_VROW + (c & 7) * 16; }
    u32x4 kr[2], vr[2];
#pragma unroll
    for (int i = 0; i < 2; ++i) { kr[i] = *(const u32x4*)kg[i]; vr[i] = *(const u32x4*)vg[i]; }
#pragma unroll
    for (int i = 0; i < 2; ++i) { *(LAS u32x4*)(C.lds + kl[i]) = kr[i]; *(LAS u32x2*)(C.lds + vl[i]) = (u32x2){vr[i].x, vr[i].y}; *(LAS u32x2*)(C.lds + vl[i] + 8) = (u32x2){vr[i].z, vr[i].w}; }
    __syncthreads();
    float lrun = 0.f; f32x16 o[4];
#pragma unroll
    for (int db = 0; db < 4; ++db)
#pragma unroll
        for (int r = 0; r < 16; ++r) o[db][r] = 0.f;
    bf16x8 pb[4];
#pragma unroll
    for (int kk = 0; kk < 4; ++kk) { const u32x4 z = {0u, 0u, 0u, 0u}; pb[kk] = __builtin_bit_cast(bf16x8, z); }
    f32x16 p0, p1;
#define AT_QK(Ksp) do { _Pragma("unroll") for (int r = 0; r < 16; ++r) { p0[r] = 0.f; p1[r] = 0.f; } \
        const LAS unsigned char* kp0 = (Ksp) + r32 * AT_KROW + 16 * hi; const LAS unsigned char* kp1 = kp0 + 32 * AT_KROW; \
        bf16x8 ka = *(const LAS bf16x8*)kp0, kb = *(const LAS bf16x8*)kp1; \
        _Pragma("unroll") for (int d0 = 0; d0 < 8; ++d0) { bf16x8 na = ka, nb = kb; \
            if (d0 < 7) { na = *(const LAS bf16x8*)(kp0 + 32 * (d0 + 1)); nb = *(const LAS bf16x8*)(kp1 + 32 * (d0 + 1)); } \
            __builtin_amdgcn_sched_barrier(0); \
            p0 = __builtin_amdgcn_mfma_f32_32x32x16_bf16(ka, qf[d0], p0, 0, 0, 0); p1 = __builtin_amdgcn_mfma_f32_32x32x16_bf16(kb, qf[d0], p1, 0, 0, 0); \
            __builtin_amdgcn_sched_barrier(0); ka = na; kb = nb; } } while (0)
#define AT_SM(mwv) do { const int mlo = (int)((unsigned)(mwv) >> (4 * hi)), mhi = (int)((unsigned)((mwv) >> 32) >> (4 * hi)); float ls0 = 0.f, ls1 = 0.f; \
        _Pragma("unroll") for (int r = 0; r < 16; ++r) { const int c = (r & 3) + 8 * (r >> 2); unsigned s0, s1; \
            asm("v_bfe_i32 %0, %1, %2, 1" : "=v"(s0) : "v"(mlo), "n"(c)); asm("v_bfe_i32 %0, %1, %2, 1" : "=v"(s1) : "v"(mhi), "n"(c));       \
            const unsigned e0 = __float_as_uint(__builtin_amdgcn_exp2f(p0[r])) & s0; const unsigned e1 = __float_as_uint(__builtin_amdgcn_exp2f(p1[r])) & s1; \
            p0[r] = __uint_as_float(e0); p1[r] = __uint_as_float(e1); ls0 += p0[r]; ls1 += p1[r]; } \
        lrun += ls0 + ls1; \
        _Pragma("unroll") for (int kk = 0; kk < 4; ++kk) { u32x4 w; \
            _Pragma("unroll") for (int e = 0; e < 4; ++e) { const int r = 8 * (kk & 1) + 2 * e; w[e] = (kk < 2) ? pg8::cvt_pk_bf16(p0[r], p0[r + 1]) : pg8::cvt_pk_bf16(p1[r], p1[r + 1]); } \
            pb[kk] = __builtin_bit_cast(bf16x8, w); } } while (0)
#define AT_PV(Vsp) do { const LAS unsigned char* vp0 = (Vsp) + r32 * AT_VROW + 8 * hi; u32x4 va[4], vn[4]; \
        _Pragma("unroll") for (int kk = 0; kk < 4; ++kk) { const u32x2 a0 = *(const LAS u32x2*)(vp0 + 32 * kk), a1 = *(const LAS u32x2*)(vp0 + 32 * kk + 16); va[kk] = (u32x4){a0.x, a0.y, a1.x, a1.y}; } \
        _Pragma("unroll") for (int db = 0; db < 4; ++db) { \
            if (db < 3) { _Pragma("unroll") for (int kk = 0; kk < 4; ++kk) { const LAS unsigned char* vp = vp0 + 32 * (db + 1) * AT_VROW + 32 * kk; const u32x2 a0 = *(const LAS u32x2*)vp, a1 = *(const LAS u32x2*)(vp + 16); vn[kk] = (u32x4){a0.x, a0.y, a1.x, a1.y}; } } \
            __builtin_amdgcn_sched_barrier(0); \
            _Pragma("unroll") for (int kk = 0; kk < 4; ++kk) o[db] = __builtin_amdgcn_mfma_f32_32x32x16_bf16(__builtin_bit_cast(bf16x8, va[kk]), pb[kk], o[db], 0, 0, 0); \
            __builtin_amdgcn_sched_barrier(0); \
            _Pragma("unroll") for (int kk = 0; kk < 4; ++kk) va[kk] = vn[kk]; } } while (0)
    for (int t = 0; t < nt; ++t) {
        const int kcur = (t & 1) * AT_KB, knxt = ((t + 1) & 1) * AT_KB, vcur = (t % 3) * AT_VB, vprv = ((t + 2) % 3) * AT_VB, vnxt = ((t + 1) % 3) * AT_VB;
        if (t + 1 < nt) {
#pragma unroll
            for (int i = 0; i < 2; ++i) { kr[i] = *(const u32x4*)(kg[i] + (size_t)(t + 1) * 64 * 1024); vr[i] = *(const u32x4*)(vg[i] + (t + 1) * 64); }
        }
        if (late && t >= 1 && t - 1 <= myc) AT_PV(C.lds + 2 * AT_KB + vprv);
        if (t <= myc) { const u64 mw = MASK[row * 128 + t]; AT_QK(C.lds + kcur); AT_SM(mw); }
        if (!late && t <= myc) AT_PV(C.lds + 2 * AT_KB + vcur);
        if (t + 1 < nt) {
#pragma unroll
            for (int i = 0; i < 2; ++i) { *(LAS u32x4*)(C.lds + knxt + kl[i]) = kr[i]; *(LAS u32x2*)(C.lds + vnxt + vl[i]) = (u32x2){vr[i].x, vr[i].y}; *(LAS u32x2*)(C.lds + vnxt + vl[i] + 8) = (u32x2){vr[i].z, vr[i].w}; }
        }
        __syncthreads();
    }
    if (late && nt - 1 <= myc) AT_PV(C.lds + 2 * AT_KB + ((nt - 1) % 3) * AT_VB);
#undef AT_QK
#undef AT_SM
#undef AT_PV
    lrun += __shfl_xor(lrun, 32);
    const float inv = 1.0f / lrun;
    bf16* op = CAT + row * 2048 + head * 128 + 4 * hi;
#pragma unroll
    for (int db = 0; db < 4; ++db)
#pragma unroll
        for (int g = 0; g < 4; ++g) { u32x2 w; w.x = pk2(o[db][4 * g] * inv, o[db][4 * g + 1] * inv); w.y = pk2(o[db][4 * g + 2] * inv, o[db][4 * g + 3] * inv);
            *(u32x2*)(op + 32 * db + 8 * g) = w; }
}
__device__ __forceinline__ void phase_attn(const Ctx& C) {
    for (int i = C.bid; i < 1024; i += C.G) {
        const int w = i & 255, k = i >> 8, combo = (w & 7) * 4 + (w >> 6), j = (w >> 3) & 7;
        const int qb = k == 0 ? j : k == 1 ? 15 - j : k == 2 ? 16 + j : 31 - j;
        attn_unit(C, combo >> 3, combo & 7, qb);
        __syncthreads();
    }
}
__device__ __forceinline__ float ret_logg(int h) { return log1pf(-exp2f(-5.0f - (float)h)); }
constexpr int RT_KP = 72, RT_VP = 136;
__device__ __forceinline__ bf16x8 lds_col8(const LAS bf16* p, int pitch, const int (&rows)[8]) {
    u32x4 w;
#pragma unroll
    for (int e = 0; e < 4; ++e) w[e] = (unsigned)p[rows[2 * e] * pitch] | ((unsigned)p[rows[2 * e + 1] * pitch] << 16);
    return __builtin_bit_cast(bf16x8, w);
}
__device__ __forceinline__ void phase_ret1(const Ctx& C) {
    LAS bf16* Ks = (LAS bf16*)C.lds;
    LAS bf16* Vs = Ks + 64 * RT_KP;
    const bf16* BK = (const bf16*)(C.ws + WS_BK); const bf16* BV = (const bf16*)(C.ws + WS_BV); float* KV = (float*)(C.ws + WS_KVST);
    const int tid = C.tid, lane = C.lane, r32 = lane & 31, hi = lane >> 5, db = C.wave >> 2, eb = C.wave & 3;
    u32x4 kw, vw[2];
#define RET1_LOAD(uu) do { const int h_ = (uu) & 3, c_ = ((uu) >> 2) & 127, b_ = (uu) >> 9; const size_t r0_ = (size_t)b_ * T + 64 * c_; \
        kw = *(const u32x4*)(BK + (r0_ + (tid >> 3)) * 256 + h_ * 64 + (tid & 7) * 8); \
        _Pragma("unroll") for (int i = 0; i < 2; ++i) { const int cidx = tid + 512 * i; vw[i] = *(const u32x4*)(BV + (r0_ + (cidx >> 4)) * 512 + h_ * 128 + (cidx & 15) * 8); } } while (0)
    if (C.bid < NB * 128 * 4) RET1_LOAD(C.bid);
    for (int u = C.bid; u < NB * 128 * 4; u += C.G) {
        const int h = u & 3; const float lg = ret_logg(h);
        { const int m = tid >> 3, d8 = (tid & 7) * 8; const u32x4 w = kw; const float z = __expf((63.0f - (float)m) * lg) * 0.125f;
          u32x4 o;
#pragma unroll
          for (int e = 0; e < 4; ++e) o[e] = pk2(bflo(w[e]) * z, bfhi(w[e]) * z);
          *(LAS u32x4*)(Ks + m * RT_KP + d8) = o; }
#pragma unroll
        for (int i = 0; i < 2; ++i) { const int cidx = tid + 512 * i, m = cidx >> 4, e8 = (cidx & 15) * 8; *(LAS u32x4*)(Vs + m * RT_VP + e8) = vw[i]; }
        if (u + C.G < NB * 128 * 4) RET1_LOAD(u + C.G);
        __syncthreads();
        f32x16 acc;
#pragma unroll
        for (int r = 0; r < 16; ++r) acc[r] = 0.f;
#pragma unroll
        for (int kk = 0; kk < 4; ++kk) {
            int rows[8];
#pragma unroll
            for (int j = 0; j < 8; ++j) rows[j] = 16 * kk + 8 * hi + j;
            const bf16x8 af = lds_col8(Ks + 32 * db + r32, RT_KP, rows), bfv = lds_col8(Vs + 32 * eb + r32, RT_VP, rows);
            acc = __builtin_amdgcn_mfma_f32_32x32x16_bf16(af, bfv, acc, 0, 0, 0);
        }
        float* dst = KV + (size_t)u * 8192 + (size_t)(32 * eb + r32) * 64 + 32 * db + 4 * hi;
#pragma unroll
        for (int g = 0; g < 4; ++g) *(f32x4*)(dst + 8 * g) = (f32x4){acc[4 * g], acc[4 * g + 1], acc[4 * g + 2], acc[4 * g + 3]};
        __syncthreads();
    }
}
__device__ __forceinline__ void phase_ret2(const Ctx& C) {
    float* KV = (float*)(C.ws + WS_KVST);
    for (int g = C.bid * NTHR + C.tid; g < NB * 4 * 8192; g += C.G * NTHR) {
        const int el = g & 8191, h = (g >> 13) & 3, b = g >> 15; const float gc = __expf(64.0f * ret_logg(h));
        float* p = KV + ((size_t)b * 512 + h) * 8192 + el;
        float st = 0.f;
        for (int c0 = 0; c0 < 128; c0 += 32) { float x[32];
#pragma unroll
            for (int i = 0; i < 32; ++i) x[i] = p[(size_t)(c0 + i) * 4 * 8192];
#pragma unroll
            for (int i = 0; i < 32; ++i) { p[(size_t)(c0 + i) * 4 * 8192] = st; st = st * gc + x[i]; } }
    }
}
#undef RET1_LOAD
__device__ __forceinline__ void phase_ret3(const Ctx& C, int u_end = NB * 128 * 4) {
    LAS bf16* Qs = (LAS bf16*)C.lds;
    LAS bf16* Ks = Qs + 64 * RT_KP;
    LAS bf16* Vs = Ks + 64 * RT_KP;
    LAS float* Red = (LAS float*)(Vs + 64 * RT_VP);
    const bf16* BQ = (const bf16*)(C.ws + WS_BQ); const bf16* BK = (const bf16*)(C.ws + WS_BK); const bf16* BV = (const bf16*)(C.ws + WS_BV); const bf16* BG = (const bf16*)(C.ws + WS_BG);
    const float* KV = (const float*)(C.ws + WS_KVST); bf16* CAT = (bf16*)(C.ws + WS_CAT);
    const int tid = C.tid, lane = C.lane, r32 = lane & 31, hi = lane >> 5, nb = C.wave >> 2, eb = C.wave & 3;
    u32x4 qw, kw, vw[2]; f32x4 sw[8];
#define RET3_LOAD(uu) do { const int h_ = (uu) & 3, c_ = ((uu) >> 2) & 127, b_ = (uu) >> 9; const size_t r0_ = (size_t)b_ * T + 64 * c_; \
        qw = *(const u32x4*)(BQ + (r0_ + (tid >> 3)) * 256 + h_ * 64 + (tid & 7) * 8); kw = *(const u32x4*)(BK + (r0_ + (tid >> 3)) * 256 + h_ * 64 + (tid & 7) * 8); \
        _Pragma("unroll") for (int i = 0; i < 2; ++i) { const int cidx = tid + 512 * i; vw[i] = *(const u32x4*)(BV + (r0_ + (cidx >> 4)) * 512 + h_ * 128 + (cidx & 15) * 8); } \
        const float* pp_ = KV + (size_t)(uu) * 8192 + (size_t)(32 * eb + r32) * 64 + 8 * hi; \
        _Pragma("unroll") for (int kk = 0; kk < 4; ++kk) { sw[2 * kk] = *(const f32x4*)(pp_ + 16 * kk); sw[2 * kk + 1] = *(const f32x4*)(pp_ + 16 * kk + 4); } } while (0)
    for (int u = C.bid; u < u_end; u += C.G) {
        const int h = u & 3, c = (u >> 2) & 127, b = u >> 9; const size_t row0 = (size_t)b * T + 64 * c; const float l2g = ret_logg(h) * 1.4426950408889634f;
        RET3_LOAD(u);
        { const int m = tid >> 3, d8 = (tid & 7) * 8; *(LAS u32x4*)(Qs + m * RT_KP + d8) = qw;
          const u32x4 w = kw; u32x4 o;
#pragma unroll
          for (int e = 0; e < 4; ++e) o[e] = pk2(bflo(w[e]) * 0.125f, bfhi(w[e]) * 0.125f);
          *(LAS u32x4*)(Ks + m * RT_KP + d8) = o; }
#pragma unroll
        for (int i = 0; i < 2; ++i) { const int cidx = tid + 512 * i, m = cidx >> 4, e8 = (cidx & 15) * 8; *(LAS u32x4*)(Vs + m * RT_VP + e8) = vw[i]; }
        bf16x8 pf[4];
#pragma unroll
        for (int kk = 0; kk < 4; ++kk) { const f32x4 a0 = sw[2 * kk], a1 = sw[2 * kk + 1];
            u32x4 w; w.x = pk2(a0.x, a0.y); w.y = pk2(a0.z, a0.w); w.z = pk2(a1.x, a1.y); w.w = pk2(a1.z, a1.w); pf[kk] = __builtin_bit_cast(bf16x8, w); }
        __syncthreads();
        bf16x8 qf[4];
#pragma unroll
        for (int kk = 0; kk < 4; ++kk) qf[kk] = *(const LAS bf16x8*)(Qs + (32 * nb + r32) * RT_KP + 16 * kk + 8 * hi);
        f32x16 cr, out;
#pragma unroll
        for (int r = 0; r < 16; ++r) { cr[r] = 0.f; out[r] = 0.f; }
#pragma unroll
        for (int kk = 0; kk < 4; ++kk) cr = __builtin_amdgcn_mfma_f32_32x32x16_bf16(qf[kk], pf[kk], cr, 0, 0, 0);
        const float gn = __builtin_amdgcn_exp2f((float)(32 * nb + r32) * l2g);
#pragma unroll
        for (int mb = 0; mb < 2; ++mb) {
            if (mb > nb) continue;
            f32x16 st;
#pragma unroll
            for (int r = 0; r < 16; ++r) st[r] = 0.f;
#pragma unroll
            for (int kk = 0; kk < 4; ++kk) { const bf16x8 kf = *(const LAS bf16x8*)(Ks + (32 * mb + r32) * RT_KP + 16 * kk + 8 * hi); st = __builtin_amdgcn_mfma_f32_32x32x16_bf16(kf, qf[kk], st, 0, 0, 0); }
            const int nq = 32 * nb + r32;
#pragma unroll
            for (int r = 0; r < 16; ++r) { const int m = 32 * mb + (r & 3) + 8 * (r >> 2) + 4 * hi; st[r] = (m <= nq) ? st[r] * gn * __builtin_amdgcn_exp2f(-(float)m * l2g) : 0.f; }
#pragma unroll
            for (int s2 = 0; s2 < 2; ++s2) {
                u32x4 w;
#pragma unroll
                for (int e = 0; e < 4; ++e) w[e] = pg8::cvt_pk_bf16(st[8 * s2 + 2 * e], st[8 * s2 + 2 * e + 1]);
                int rows[8];
#pragma unroll
                for (int j = 0; j < 8; ++j) rows[j] = 32 * mb + 16 * s2 + 8 * (j >> 2) + 4 * hi + (j & 3);
                const bf16x8 vf = lds_col8(Vs + 32 * eb + r32, RT_VP, rows);
                out = __builtin_amdgcn_mfma_f32_32x32x16_bf16(__builtin_bit_cast(bf16x8, w), vf, out, 0, 0, 0);
            }
        }
        float sv[16], s2v[16];
#pragma unroll
        for (int r = 0; r < 16; ++r) { const int n = 32 * nb + (r & 3) + 8 * (r >> 2) + 4 * hi; out[r] += __builtin_amdgcn_exp2f((float)(n + 1) * l2g) * cr[r]; sv[r] = half_sum32(out[r]); s2v[r] = half_sum32(out[r] * out[r]); }
        if (r32 == 0) {
#pragma unroll
            for (int r = 0; r < 16; ++r) { const int n = 32 * nb + (r & 3) + 8 * (r >> 2) + 4 * hi; *(LAS f32x2*)(Red + (n * 4 + eb) * 2) = (f32x2){sv[r], s2v[r]}; }
        }
        __syncthreads();
#pragma unroll
        for (int r = 0; r < 16; ++r) { const int n = 32 * nb + (r & 3) + 8 * (r >> 2) + 4 * hi;
            const f32x4 p0 = *(const LAS f32x4*)(Red + n * 8), p1 = *(const LAS f32x4*)(Red + n * 8 + 4);
            const float mean = (p0.x + p0.z + p1.x + p1.z) * (1.0f / 128.0f), ex2 = (p0.y + p0.w + p1.y + p1.w) * (1.0f / 128.0f);
            const float rstd = rsqrtf(fmaxf(ex2 - mean * mean, 0.f) + 1e-5f);
            const float gg = bf2f(BG[(row0 + n) * 512 + h * 128 + 32 * eb + r32]); const float sl = gg * __builtin_amdgcn_rcpf(1.0f + __expf(-gg));
            CAT[(row0 + n) * 2048 + 1024 + h * 128 + 32 * eb + r32] = (bf16)f2bf((out[r] - mean) * rstd * sl); }
        __syncthreads();
    }
}
#undef RET3_LOAD
__device__ __forceinline__ float sigmoidf_(float x) { return __builtin_amdgcn_rcpf(1.0f + __expf(-x)); }
constexpr int RW_AW = 104, RW_AV = 72, RW_AG = 264;
constexpr int RW1_BUF = 32 * RW_AW * 2 + 32 * RW_AV;
struct RwP { const float *mu, *mu_v, *w0, *a0, *v0, *k_k, *k_a, *r_k, *lnx_g, *lnx_b; };
template <class TT> __device__ __forceinline__ GAS TT* opaque_g(const TT* p) {
    unsigned lo = (unsigned)(uintptr_t)p, hi = (unsigned)((uintptr_t)p >> 32); asm volatile("" : "+v"(lo), "+v"(hi));
    lo = __builtin_amdgcn_readfirstlane(lo); hi = __builtin_amdgcn_readfirstlane(hi); return (GAS TT*)(((uintptr_t)hi << 32) | lo);
}
__device__ __forceinline__ int tokr(int r, int hi) { return (r & 3) + 8 * (r >> 2) + 4 * hi; }
constexpr int RW_SP = 40;
constexpr int RW1_SCR = 36864, RW_SCR_TILE = 34 * RW_SP * 2;
__device__ __forceinline__ void flush_tile32(const LAS bf16* st, GAS bf16* ub, unsigned colb, int lane, unsigned rowb = 1024u) {
    LDS_WAIT(); asm volatile("" ::: "memory");
#pragma unroll
    for (int j = 0; j < 2; ++j) { const int id = lane + 64 * j, row = id >> 2, c16 = id & 3; const u32x4 w = *(const LAS u32x4*)(st + row * RW_SP + c16 * 8);
        *(GAS u32x4*)((GAS char*)ub + (unsigned)row * rowb + (unsigned)(c16 * 16) + colb) = w; }
    asm volatile("" ::: "memory");
}
struct Tile33 { u32x4 w0, w1, wp; };
__device__ __forceinline__ Tile33 issue_tile33(GAS bf16* ub, unsigned colb, bool with_prev, bool first_unit, int lane) {
    Tile33 t; const u32x4 z = {0u, 0u, 0u, 0u}; t.wp = z;
    { const int row = lane >> 2, c16 = lane & 3; t.w0 = *(const GAS u32x4*)((GAS char*)ub + (unsigned)(row * 1024 + c16 * 16) + colb); t.w1 = *(const GAS u32x4*)((GAS char*)ub + (unsigned)((row + 16) * 1024 + c16 * 16) + colb); }
    if (with_prev && !first_unit && lane < 4) t.wp = *(const GAS u32x4*)((GAS char*)ub - 1024 + (unsigned)(lane * 16) + colb);
    return t;
}
__device__ __forceinline__ void commit_tile33(const Tile33& t, LAS bf16* tile, bool with_prev, int lane) {
    { const int row = lane >> 2, c16 = lane & 3; *(LAS u32x4*)(tile + (row + 1) * RW_SP + c16 * 8) = t.w0; *(LAS u32x4*)(tile + (row + 17) * RW_SP + c16 * 8) = t.w1; }
    if (with_prev && lane < 4) *(LAS u32x4*)(tile + lane * 8) = t.wp;
    LDS_WAIT(); asm volatile("" ::: "memory");
}
__device__ __forceinline__ void shifted16_lds(const LAS bf16* tl, float mu, float (&x)[16]) {
    float cur[16], prv[4];
#pragma unroll
    for (int r = 0; r < 16; ++r) cur[r] = bf2f(tl[(1 + (r & 3) + 8 * (r >> 2)) * RW_SP]);
#pragma unroll
    for (int g = 0; g < 4; ++g) prv[g] = bf2f(tl[8 * g * RW_SP]);
#pragma unroll
    for (int r = 0; r < 16; ++r) { const float p = (r & 3) == 0 ? prv[r >> 2] : cur[r - 1]; x[r] = cur[r] + (p - cur[r]) * mu; }
}
__device__ __forceinline__ void shifted16(GAS bf16* ub, const unsigned (&off)[16], int cbo, bool first_unit, int hi, float mu, float (&x)[16]) {
    float cur[16], prv[4];
#pragma unroll
    for (int r = 0; r < 16; ++r) cur[r] = bf2f(at_b(ub, off[r])[cbo]);
#pragma unroll
    for (int g = 0; g < 4; ++g) { const bool first = (g == 0) && (hi == 0) && first_unit; prv[g] = first ? 0.f : bf2f(at_b(ub, off[4 * g])[cbo - 512]); }
#pragma unroll
    for (int r = 0; r < 16; ++r) { const float p = (r & 3) == 0 ? prv[r >> 2] : cur[r - 1]; x[r] = cur[r] + (p - cur[r]) * mu; }
}
__device__ __forceinline__ void phase_rw1(const Ctx& C, int layer, const RwP& P) {
    LAS bf16* ACT = (LAS bf16*)C.lds;
    const bf16* CR = (const bf16*)(C.ws + WS_CR); const bf16* CK = (const bf16*)(C.ws + WS_CK); const bf16* CV = (const bf16*)(C.ws + WS_CV); const bf16* CL = (const bf16*)(C.ws + WS_CL);
    const bf16* LW = (const bf16*)(C.ws + WS_LORA + LO_W); const bf16* LA = (const bf16*)(C.ws + WS_LORA + LO_A); const bf16* LV = (const bf16*)(C.ws + WS_LORA + LO_V);
    bf16* VF = (bf16*)(C.ws + WS_VFIRST);
    bf16* RR = (bf16*)(C.ws + WS_RR); bf16* RU = (bf16*)(C.ws + WS_RW); bf16* RKH = (bf16*)(C.ws + WS_RKH); bf16* RV = (bf16*)(C.ws + WS_RV); bf16* RA = (bf16*)(C.ws + WS_RA); bf16* RB = (bf16*)(C.ws + WS_RB);
    const float* mu = P.mu + (size_t)layer * 1984; const float* mu_v = P.mu_v;
    const float* w0 = P.w0 + layer * 512; const float* a0 = P.a0 + layer * 512; const float* v0 = P.v0; const float* k_k = P.k_k + layer * 512; const float* k_a = P.k_a + layer * 512;
    const int tid = C.tid, lane = C.lane, wid = C.wave;
    constexpr int NU = M / 32;
    u32x4 ncur[2], nprv[2];
#define RW1_LOAD(uu) do { _Pragma("unroll") for (int j = 0; j < 2; ++j) { const int ci = tid + 512 * j, tok = ci >> 5, c8 = (ci & 31) * 8; const size_t mm = (size_t)(uu) * 32 + tok; \
        ncur[j] = *(const u32x4*)(CL + mm * 256 + c8); const u32x4 z4 = {0u, 0u, 0u, 0u}; nprv[j] = (mm & (T - 1)) == 0 ? z4 : *(const u32x4*)(CL + (mm - 1) * 256 + c8); } } while (0)
#define RW1_STORE(bufi) do { _Pragma("unroll") for (int j = 0; j < 2; ++j) { const int ci = tid + 512 * j, tok = ci >> 5, c8 = (ci & 31) * 8; \
        const float* mp = c8 < 192 ? mu + 1536 + c8 : mu_v + (c8 - 192); f32x4 m0v = {0.f, 0.f, 0.f, 0.f}, m1v = m0v; if (c8 < 192 || layer > 0) { m0v = *(const f32x4*)mp; m1v = *(const f32x4*)(mp + 4); } \
        float xs[8]; _Pragma("unroll") for (int e = 0; e < 4; ++e) { const float c0 = bflo(ncur[j][e]), c1 = bfhi(ncur[j][e]), p0 = bflo(nprv[j][e]), p1 = bfhi(nprv[j][e]); \
            const float ma = e < 2 ? m0v[2 * e] : m1v[2 * e - 4], mb = e < 2 ? m0v[2 * e + 1] : m1v[2 * e - 3]; xs[2 * e] = c0 + (p0 - c0) * ma; xs[2 * e + 1] = c1 + (p1 - c1) * mb; } \
        if (c8 < 96) { _Pragma("unroll") for (int e = 0; e < 8; ++e) xs[e] = 1.0f - 2.0f * __builtin_amdgcn_rcpf(__expf(2.0f * xs[e]) + 1.0f); }     \
        u32x4 o; o.x = pk2(xs[0], xs[1]); o.y = pk2(xs[2], xs[3]); o.z = pk2(xs[4], xs[5]); o.w = pk2(xs[6], xs[7]); \
        LAS bf16* dst = ACT + (bufi) * RW1_BUF + (c8 < 96 ? tok * RW_AW + c8 : c8 < 192 ? 32 * RW_AW + tok * RW_AW + (c8 - 96) : 64 * RW_AW + tok * RW_AV + (c8 - 192)); \
        *(LAS u32x4*)dst = o; } } while (0)
    int u = C.bid; if (u >= NU) return;
    RW1_LOAD(u); RW1_STORE(0); __syncthreads();
    for (int kbuf = 0; ; kbuf ^= 1) {
        const int un = u + C.G; const bool has_next = un < NU;
        if (has_next) RW1_LOAD(un);
        {
            int r32 = lane & 31, hi = lane >> 5; asm volatile("" : "+v"(r32), "+v"(hi));
            const size_t m0 = (size_t)u * 32; const bool first_unit = (m0 & (T - 1)) == 0;
            const LAS bf16* AW = ACT + kbuf * RW1_BUF; const LAS bf16* AA = AW + 32 * RW_AW; const LAS bf16* AV = AA + 32 * RW_AW;
            unsigned off[16];
#pragma unroll
            for (int r = 0; r < 16; ++r) off[r] = (unsigned)(tokr(r, hi) * 512 + 64 * wid + r32) * 2u;
            GAS bf16* CRu = opaque_g(CR + m0 * 512); GAS bf16* CKu = opaque_g(CK + m0 * 512); GAS bf16* CVu = opaque_g(CV + m0 * 512); GAS bf16* VFu = opaque_g(VF + m0 * 512);
            GAS bf16* RRu = opaque_g(RR + m0 * 512); GAS bf16* RUu = opaque_g(RU + m0 * 512); GAS bf16* RKHu = opaque_g(RKH + m0 * 512); GAS bf16* RVu = opaque_g(RV + m0 * 512); GAS bf16* RAu = opaque_g(RA + m0 * 512); GAS bf16* RBu = opaque_g(RB + m0 * 512);
            LAS bf16* st0 = (LAS bf16*)(C.lds + RW1_SCR + wid * 4 * RW_SCR_TILE) + 4 * hi * RW_SP + r32; LAS bf16* st1 = st0 + 34 * RW_SP; LAS bf16* st2 = st1 + 34 * RW_SP; LAS bf16* sl = st2 + 34 * RW_SP;
            float ks[2][16], inv[16];
            {
                float ssr[16];
#pragma unroll
                for (int r = 0; r < 16; ++r) ssr[r] = 0.f;
                const Tile33 tK0 = issue_tile33(CKu, (unsigned)(64 * wid) * 2u, true, first_unit, lane), tK1 = issue_tile33(CKu, (unsigned)(64 * wid + 32) * 2u, true, first_unit, lane);
#pragma unroll
                for (int cb = 0; cb < 2; ++cb) { const int c = 64 * wid + 32 * cb + r32; const float kkc = k_k[c]; commit_tile33(cb == 0 ? tK0 : tK1, sl - (4 * hi * RW_SP + r32), true, lane); shifted16_lds(sl, mu[512 + c], ks[cb]);
#pragma unroll
                    for (int r = 0; r < 16; ++r) { const float kr = ks[cb][r] * kkc; ssr[r] += kr * kr; } }
#pragma unroll
                for (int r = 0; r < 16; ++r) inv[r] = 1.0f / fmaxf(sqrtf(half_sum32(ssr[r])), 1e-12f);
            }
#pragma unroll
            for (int cb = 0; cb < 2; ++cb) {
                const int c = 64 * wid + 32 * cb + r32; const int ci = 32 * cb; const unsigned colb = (unsigned)(64 * wid + 32 * cb) * 2u;
                asm volatile("" : "+v"(off[0]), "+v"(off[1]), "+v"(off[2]), "+v"(off[3]), "+v"(off[4]), "+v"(off[5]), "+v"(off[6]), "+v"(off[7]), "+v"(off[8]), "+v"(off[9]), "+v"(off[10]), "+v"(off[11]), "+v"(off[12]), "+v"(off[13]), "+v"(off[14]), "+v"(off[15]));
                const Tile33 tR = issue_tile33(CRu, colb, true, first_unit, lane), tV = issue_tile33(CVu, colb, true, first_unit, lane); Tile33 tF = tV; if (layer > 0) tF = issue_tile33(VFu, colb, false, false, lane);
                {
                    float rs[16]; commit_tile33(tR, sl - (4 * hi * RW_SP + r32), true, lane); shifted16_lds(sl, mu[c], rs);
#pragma unroll
                    for (int r = 0; r < 16; ++r) st0[((r & 3) + 8 * (r >> 2)) * RW_SP] = (bf16)f2bf(rs[r]);
                    flush_tile32(st0 - (4 * hi * RW_SP + r32), RRu, colb, lane);
                }
                asm volatile("" ::: "memory");
                {
                    float vs[16]; commit_tile33(tV, sl - (4 * hi * RW_SP + r32), true, lane); shifted16_lds(sl, mu[1024 + c], vs);
                    if (layer > 0) {
                        f32x16 dv;
#pragma unroll
                        for (int r = 0; r < 16; ++r) dv[r] = 0.f;
#pragma unroll
                        for (int kk = 0; kk < 4; ++kk) { const bf16x8 wv = *(const bf16x8*)(LV + c * 64 + 16 * kk + 8 * hi); const bf16x8 xv = *(const LAS bf16x8*)(AV + r32 * RW_AV + 16 * kk + 8 * hi);
                            dv = __builtin_amdgcn_mfma_f32_32x32x16_bf16(xv, wv, dv, 0, 0, 0); }
                        const float v0c = v0[c];
                        commit_tile33(tF, sl - (4 * hi * RW_SP + r32), false, lane);
#pragma unroll
                        for (int r = 0; r < 16; ++r) { const float vf = bf2f(sl[(1 + (r & 3) + 8 * (r >> 2)) * RW_SP]); st1[((r & 3) + 8 * (r >> 2)) * RW_SP] = (bf16)f2bf(vs[r] + (vf - vs[r]) * sigmoidf_(v0c + dv[r])); }
                        flush_tile32(st1 - (4 * hi * RW_SP + r32), RVu, colb, lane);
                    } else {
#pragma unroll
                        for (int r = 0; r < 16; ++r) st1[((r & 3) + 8 * (r >> 2)) * RW_SP] = (bf16)f2bf(vs[r]);
                        flush_tile32(st1 - (4 * hi * RW_SP + r32), VFu, colb, lane); flush_tile32(st1 - (4 * hi * RW_SP + r32), RVu, colb, lane);
                    }
                }
                asm volatile("" ::: "memory");
                {
                    f32x16 dw;
#pragma unroll
                    for (int r = 0; r < 16; ++r) dw[r] = 0.f;
#pragma unroll
                    for (int kk = 0; kk < 6; ++kk) { const bf16x8 ww = *(const bf16x8*)(LW + c * 96 + 16 * kk + 8 * hi); const bf16x8 xw = *(const LAS bf16x8*)(AW + r32 * RW_AW + 16 * kk + 8 * hi);
                        dw = __builtin_amdgcn_mfma_f32_32x32x16_bf16(xw, ww, dw, 0, 0, 0); }
                    const float w0c = w0[c];
#pragma unroll
                    for (int r = 0; r < 16; ++r) { const float z = -(w0c + dw[r]); const float sp = fmaxf(z, 0.f) + __logf(1.0f + __expf(-fabsf(z)));
                        st2[((r & 3) + 8 * (r >> 2)) * RW_SP] = (bf16)f2bf(1.0f - __expf(-__expf(-sp - 0.5f))); }
                    flush_tile32(st2 - (4 * hi * RW_SP + r32), RUu, colb, lane);
                }
                asm volatile("" ::: "memory");
                {
                    f32x16 da;
#pragma unroll
                    for (int r = 0; r < 16; ++r) da[r] = 0.f;
#pragma unroll
                    for (int kk = 0; kk < 6; ++kk) { const bf16x8 wa = *(const bf16x8*)(LA + c * 96 + 16 * kk + 8 * hi); const bf16x8 xa = *(const LAS bf16x8*)(AA + r32 * RW_AW + 16 * kk + 8 * hi);
                        da = __builtin_amdgcn_mfma_f32_32x32x16_bf16(xa, wa, da, 0, 0, 0); }
                    const float a0c = a0[c], kkc = k_k[c], kac = k_a[c];
#pragma unroll
                    for (int r = 0; r < 16; ++r) { const float a = sigmoidf_(a0c + da[r]); const float ksx = ks[cb][r]; const float kk = ksx * kkc * inv[r];
                        const int so = ((r & 3) + 8 * (r >> 2)) * RW_SP; st0[so] = (bf16)f2bf(ksx * (1.0f + (a - 1.0f) * kac)); st1[so] = (bf16)f2bf(-kk); st2[so] = (bf16)f2bf(kk * a); }
                    flush_tile32(st0 - (4 * hi * RW_SP + r32), RKHu, colb, lane); flush_tile32(st1 - (4 * hi * RW_SP + r32), RAu, colb, lane); flush_tile32(st2 - (4 * hi * RW_SP + r32), RBu, colb, lane);
                }
                asm volatile("" ::: "memory");
            }
        }
        if (has_next) RW1_STORE(kbuf ^ 1);
        __syncthreads();
        if (!has_next) break;
        u = un;
    }
#undef RW1_LOAD
#undef RW1_STORE
}
constexpr int RW_L = 128, RW_NC = T / RW_L;
constexpr int RW_TB = 8, RW_STG = 5 * RW_TB * 64 + 64;
__device__ __forceinline__ float xhalf_sum(float x) { const auto rr = __builtin_amdgcn_permlane32_swap(__float_as_uint(x), __float_as_uint(x), false, false); return __uint_as_float(rr[0]) + __uint_as_float(rr[1]); }
__device__ __forceinline__ float dot32(const f32x16& d0, const f32x16& d1, const f32x4 (&v)[2][4]) {
    f32x2 acc = {0.f, 0.f};
#pragma unroll
    for (int g = 0; g < 4; ++g) { acc += (f32x2){d0[4 * g], d0[4 * g + 1]} * (f32x2){v[0][g].x, v[0][g].y}; acc += (f32x2){d0[4 * g + 2], d0[4 * g + 3]} * (f32x2){v[0][g].z, v[0][g].w};
        acc += (f32x2){d1[4 * g], d1[4 * g + 1]} * (f32x2){v[1][g].x, v[1][g].y}; acc += (f32x2){d1[4 * g + 2], d1[4 * g + 3]} * (f32x2){v[1][g].z, v[1][g].w}; }
    return acc.x + acc.y;
}
template <int NS, bool OUT>
__device__ __forceinline__ void rwkv_chunk(f32x16 (&D)[NS][2][2], LAS float* stg, const bf16* RWd, const bf16* RA, const bf16* RB, const bf16* RKH, const bf16* RV, const bf16* RR, float* Y, size_t base0, int nsteps, int lane) {
    const int r32 = lane & 31, hi = lane >> 5;
    unsigned short qw[RW_TB], qa[RW_TB], qr[RW_TB], qb[RW_TB], qk[RW_TB], qv[RW_TB];
#define RWC_LOAD(tt) do { _Pragma("unroll") for (int s = 0; s < RW_TB; ++s) { const size_t o = base0 + (size_t)((tt) + s) * 512 + lane; qw[s] = RWd[o]; qa[s] = RA[o]; if (OUT) qr[s] = RR[o]; qb[s] = RB[o]; qk[s] = RKH[o]; qv[s] = RV[o]; } } while (0)
    RWC_LOAD(0);
    float G = 1.0f;
    for (int t0 = 0; t0 < nsteps; t0 += RW_TB) {
#pragma unroll
        for (int s = 0; s < RW_TB; ++s) { const float w = 1.0f - bf2f(qw[s]); stg[(0 * RW_TB + s) * 64 + lane] = bf2f(qa[s]) * G; G *= w; const float ig = __builtin_amdgcn_rcpf(G);
            if (OUT) stg[(1 * RW_TB + s) * 64 + lane] = bf2f(qr[s]) * G; stg[(2 * RW_TB + s) * 64 + lane] = bf2f(qb[s]) * ig; stg[(3 * RW_TB + s) * 64 + lane] = bf2f(qk[s]) * ig; stg[(4 * RW_TB + s) * 64 + lane] = bf2f(qv[s]); }
        if (t0 + RW_TB < nsteps) RWC_LOAD(t0 + RW_TB);
        LDS_WAIT(); asm volatile("" ::: "memory");
#pragma unroll 1
        for (int s = 0; s < RW_TB; ++s) {
            const LAS float* sa_ = stg + (0 * RW_TB + s) * 64 + 4 * hi; const LAS float* sr = stg + (1 * RW_TB + s) * 64 + 4 * hi;
            const LAS float* sbk = stg + ((hi ? 3 : 2) * RW_TB + s) * 64 + r32; const LAS float* sv = stg + (4 * RW_TB + s) * 64 + r32;
            const float bk0 = sbk[0], bk1 = sbk[32], v0 = sv[0], v1 = sv[32];
            float sav[NS][2];
            {
                f32x4 av[2][4];
#pragma unroll
                for (int jb = 0; jb < 2; ++jb)
#pragma unroll
                    for (int g = 0; g < 4; ++g) av[jb][g] = *(const LAS f32x4*)(sa_ + 32 * jb + 8 * g);
#pragma unroll
                for (int st = 0; st < NS; ++st)
#pragma unroll
                    for (int ib = 0; ib < 2; ++ib) sav[st][ib] = xhalf_sum(dot32(D[st][0][ib], D[st][1][ib], av));
            }
#pragma unroll
            for (int st = 0; st < NS; ++st) {
                const bool inject = (NS == 1) || (st == 1);
#pragma unroll
                for (int jb = 0; jb < 2; ++jb) { const float bkj = jb == 0 ? bk0 : bk1; const float A = inject ? bkj : (hi ? 0.f : bkj);
#pragma unroll
                    for (int ib = 0; ib < 2; ++ib) { const float B = hi ? (ib == 0 ? v0 : v1) : sav[st][ib];
                        D[st][jb][ib] = __builtin_amdgcn_mfma_f32_32x32x2f32(A, B, D[st][jb][ib], 0, 0, 0); } }
            }
            if (OUT) {
                f32x4 rv[2][4];
#pragma unroll
                for (int jb = 0; jb < 2; ++jb)
#pragma unroll
                    for (int g = 0; g < 4; ++g) rv[jb][g] = *(const LAS f32x4*)(sr + 32 * jb + 8 * g);
#pragma unroll
                for (int ib = 0; ib < 2; ++ib) { const float y = xhalf_sum(dot32(D[NS - 1][0][ib], D[NS - 1][1][ib], rv));
                    if (hi == 0) Y[base0 + (size_t)(t0 + s) * 512 + 32 * ib + r32] = y; }
            }
        }
        LDS_WAIT(); asm volatile("" ::: "memory");
    }
#undef RWC_LOAD
    stg[5 * RW_TB * 64 + lane] = G;
    LDS_WAIT(); asm volatile("" ::: "memory");
    {
        f32x4 gv[2][4];
#pragma unroll
        for (int jb = 0; jb < 2; ++jb)
#pragma unroll
            for (int g = 0; g < 4; ++g) gv[jb][g] = *(const LAS f32x4*)(stg + 5 * RW_TB * 64 + 4 * hi + 32 * jb + 8 * g);
#pragma unroll
        for (int st = 0; st < NS; ++st)
#pragma unroll
            for (int jb = 0; jb < 2; ++jb)
#pragma unroll
                for (int ib = 0; ib < 2; ++ib)
#pragma unroll
                    for (int g = 0; g < 4; ++g) { f32x16& d = D[st][jb][ib]; d[4 * g] *= gv[jb][g].x; d[4 * g + 1] *= gv[jb][g].y; d[4 * g + 2] *= gv[jb][g].z; d[4 * g + 3] *= gv[jb][g].w; }
    }
    LDS_WAIT(); asm volatile("" ::: "memory");
}
__device__ __forceinline__ void phase_rw2(const Ctx& C) {
    const bf16* RWd = (const bf16*)(C.ws + WS_RW); const bf16* RA = (const bf16*)(C.ws + WS_RA); const bf16* RB = (const bf16*)(C.ws + WS_RB); const bf16* RKH = (const bf16*)(C.ws + WS_RKH); const bf16* RV = (const bf16*)(C.ws + WS_RV);
    float* PHI = (float*)(C.ws + WS_PHI); float* PSI = (float*)(C.ws + WS_PSI);
    LAS float* stg = (LAS float*)C.lds + C.wave * RW_STG;
    const int ntask = NB * 8 * RW_NC, r32 = C.lane & 31, hi = C.lane >> 5;
    for (int task = C.wave * C.G + C.bid; task < ntask; task += C.G * NWAVES) {
        const int ck = task % RW_NC, bh = task / RW_NC, h = bh & 7, b = bh >> 3;
        const size_t base0 = ((size_t)b * T + (size_t)ck * RW_L) * 512 + h * 64;
        f32x16 D[2][2][2];
#pragma unroll
        for (int jb = 0; jb < 2; ++jb)
#pragma unroll
            for (int ib = 0; ib < 2; ++ib)
#pragma unroll
                for (int r = 0; r < 16; ++r) { D[0][jb][ib][r] = (jb == ib && ((r & 3) + 8 * (r >> 2) + 4 * hi) == r32) ? 1.f : 0.f; D[1][jb][ib][r] = 0.f; }
        rwkv_chunk<2, false>(D, stg, RWd, RA, RB, RKH, RV, nullptr, nullptr, base0, RW_L, C.lane);
#pragma unroll
        for (int st = 0; st < 2; ++st) { float* dst = (st == 0 ? PHI : PSI) + (size_t)task * 4096;
#pragma unroll
            for (int jb = 0; jb < 2; ++jb)
#pragma unroll
                for (int ib = 0; ib < 2; ++ib)
#pragma unroll
                    for (int g = 0; g < 4; ++g) *(f32x4*)(dst + (32 * ib + r32) * 64 + 32 * jb + 8 * g + 4 * hi) = (f32x4){D[st][jb][ib][4 * g], D[st][jb][ib][4 * g + 1], D[st][jb][ib][4 * g + 2], D[st][jb][ib][4 * g + 3]}; }
    }
}
constexpr int R3_P = 65;
__device__ __forceinline__ void phase_rw3(const Ctx& C) {
    const float* PHI = (const float*)(C.ws + WS_PHI); const float* PSI = (const float*)(C.ws + WS_PSI); float* SST = (float*)(C.ws + WS_SST);
    const bool act = C.wave < 4; const int w4 = C.wave & 3, ibo = w4 >> 1, kb = w4 & 1, r32 = C.lane & 31, hi = C.lane >> 5;
    LAS float* Sl = (LAS float*)C.lds;
    for (int bh = C.bid; bh < NB * 8; bh += C.G) {
        f32x16 acc;
#pragma unroll
        for (int r = 0; r < 16; ++r) acc[r] = 0.f;
        float ph[32], psn[16];
#define R3_LOAD(tk) do { _Pragma("unroll") for (int s = 0; s < 32; ++s) ph[s] = PHI[(tk) * 4096 + (2 * s + hi) * 64 + 32 * kb + r32]; \
        _Pragma("unroll") for (int r = 0; r < 16; ++r) psn[r] = PSI[(tk) * 4096 + (32 * ibo + (r & 3) + 8 * (r >> 2) + 4 * hi) * 64 + 32 * kb + r32]; } while (0)
        if (act) R3_LOAD((size_t)bh * RW_NC);
        for (int ck = 0; ck < RW_NC; ++ck) {
            const size_t task = (size_t)bh * RW_NC + ck; LAS float* Sb = Sl + (ck & 1) * (64 * R3_P);
            float* dst = SST + task * 4096;
            if (act) {
#pragma unroll
                for (int r = 0; r < 16; ++r) { const int i = 32 * ibo + (r & 3) + 8 * (r >> 2) + 4 * hi; dst[i * 64 + 32 * kb + r32] = acc[r]; Sb[i * R3_P + 32 * kb + r32] = acc[r]; }
            }
            if (ck + 1 == RW_NC) break;
            float pc[32];
            if (act) {
#pragma unroll
                for (int s = 0; s < 32; ++s) pc[s] = ph[s];
#pragma unroll
                for (int r = 0; r < 16; ++r) acc[r] = psn[r];
                if (ck + 2 < RW_NC) R3_LOAD(task + 1);
            }
            __syncthreads();
            if (act) {
#pragma unroll
                for (int s = 0; s < 32; ++s) { const float a = Sb[(32 * ibo + r32) * R3_P + 2 * s + hi]; acc = __builtin_amdgcn_mfma_f32_32x32x2f32(a, pc[s], acc, 0, 0, 0); }
            }
        }
#undef R3_LOAD
        __syncthreads();
    }
}
__device__ __forceinline__ void phase_rw4(const Ctx& C) {
    const bf16* RWd = (const bf16*)(C.ws + WS_RW); const bf16* RA = (const bf16*)(C.ws + WS_RA); const bf16* RB = (const bf16*)(C.ws + WS_RB); const bf16* RKH = (const bf16*)(C.ws + WS_RKH); const bf16* RV = (const bf16*)(C.ws + WS_RV); const bf16* RR = (const bf16*)(C.ws + WS_RR);
    const float* SST = (const float*)(C.ws + WS_SST); float* Y = (float*)(C.ws + WS_Y);
    LAS float* stg = (LAS float*)C.lds + C.wave * RW_STG;
    const int ntask = NB * 8 * RW_NC, r32 = C.lane & 31, hi = C.lane >> 5;
    for (int task = C.wave * C.G + C.bid; task < ntask; task += C.G * NWAVES) {
        const int ck = task % RW_NC, bh = task / RW_NC, h = bh & 7, b = bh >> 3;
        const size_t base0 = ((size_t)b * T + (size_t)ck * RW_L) * 512 + h * 64;
        f32x16 D[1][2][2]; const float* src = SST + (size_t)task * 4096;
#pragma unroll
        for (int jb = 0; jb < 2; ++jb)
#pragma unroll
            for (int ib = 0; ib < 2; ++ib)
#pragma unroll
                for (int g = 0; g < 4; ++g) { const f32x4 v = *(const f32x4*)(src + (32 * ib + r32) * 64 + 32 * jb + 8 * g + 4 * hi); D[0][jb][ib][4 * g] = v.x; D[0][jb][ib][4 * g + 1] = v.y; D[0][jb][ib][4 * g + 2] = v.z; D[0][jb][ib][4 * g + 3] = v.w; }
        rwkv_chunk<1, true>(D, stg, RWd, RA, RB, RKH, RV, RR, Y, base0, RW_L, C.lane);
    }
}
__device__ __forceinline__ void phase_rw5(const Ctx& C, int layer, const RwP& P) {
    LAS bf16* ACT = (LAS bf16*)C.lds;
    const bf16* CG = (const bf16*)(C.ws + WS_CG); const bf16* LG = (const bf16*)(C.ws + WS_LORA + LO_G);
    const float* Y = (const float*)(C.ws + WS_Y); const bf16* RR = (const bf16*)(C.ws + WS_RR); const bf16* RKH = (const bf16*)(C.ws + WS_RKH); const bf16* RV = (const bf16*)(C.ws + WS_RV);
    bf16* CAT = (bf16*)(C.ws + WS_CAT);
    const float* mu = P.mu + (size_t)layer * 1984 + 1728; const float* r_k = P.r_k + layer * 512; const float* lnx_g = P.lnx_g + layer * 512; const float* lnx_b = P.lnx_b + layer * 512;
    const int tid = C.tid, lane = C.lane, wid = C.wave;
    constexpr int NU = M / 32;
    u32x4 ncur[2], nprv[2];
#define RW5_LOAD(uu) do { _Pragma("unroll") for (int j = 0; j < 2; ++j) { const int ci = tid + 512 * j, tok = ci >> 5, c8 = (ci & 31) * 8; const size_t mm = (size_t)(uu) * 32 + tok; \
        ncur[j] = *(const u32x4*)(CG + mm * 256 + c8); const u32x4 z4 = {0u, 0u, 0u, 0u}; nprv[j] = (mm & (T - 1)) == 0 ? z4 : *(const u32x4*)(CG + (mm - 1) * 256 + c8); } } while (0)
#define RW5_STORE(bufi) do { _Pragma("unroll") for (int j = 0; j < 2; ++j) { const int ci = tid + 512 * j, tok = ci >> 5, c8 = (ci & 31) * 8; \
        const f32x4 m0v = *(const f32x4*)(mu + c8), m1v = *(const f32x4*)(mu + c8 + 4); \
        float xs[8]; _Pragma("unroll") for (int e = 0; e < 4; ++e) { const float c0 = bflo(ncur[j][e]), c1 = bfhi(ncur[j][e]), p0 = bflo(nprv[j][e]), p1 = bfhi(nprv[j][e]); \
            const float ma = e < 2 ? m0v[2 * e] : m1v[2 * e - 4], mb = e < 2 ? m0v[2 * e + 1] : m1v[2 * e - 3]; xs[2 * e] = sigmoidf_(c0 + (p0 - c0) * ma); xs[2 * e + 1] = sigmoidf_(c1 + (p1 - c1) * mb); } \
        u32x4 o; o.x = pk2(xs[0], xs[1]); o.y = pk2(xs[2], xs[3]); o.z = pk2(xs[4], xs[5]); o.w = pk2(xs[6], xs[7]); \
        *(LAS u32x4*)(ACT + (bufi) * (32 * RW_AG) + tok * RW_AG + c8) = o; } } while (0)
    int u = C.bid; if (u >= NU) return;
    RW5_LOAD(u); RW5_STORE(0); __syncthreads();
    for (int kbuf = 0; ; kbuf ^= 1) {
        const int un = u + C.G; const bool has_next = un < NU;
        if (has_next) RW5_LOAD(un);
        {
            int r32 = lane & 31, hi = lane >> 5; asm volatile("" : "+v"(r32), "+v"(hi));
            const size_t m0 = (size_t)u * 32; const LAS bf16* AG = ACT + kbuf * (32 * RW_AG);
            unsigned off[16];
#pragma unroll
            for (int r = 0; r < 16; ++r) off[r] = (unsigned)(tokr(r, hi) * 512 + 64 * wid + r32) * 2u;
            GAS float* Yu = opaque_g(Y + m0 * 512); GAS bf16* RRu = opaque_g(RR + m0 * 512); GAS bf16* RKHu = opaque_g(RKH + m0 * 512); GAS bf16* RVu = opaque_g(RV + m0 * 512); GAS bf16* CATu = opaque_g(CAT + m0 * 2048 + 1536);
            LAS bf16* sl0 = (LAS bf16*)(C.lds + RW1_SCR + wid * 4 * RW_SCR_TILE); LAS bf16* sl1 = sl0 + 34 * RW_SP; LAS bf16* st0 = sl1 + 34 * RW_SP; const int lo_ = 4 * hi * RW_SP + r32;
            const Tile33 tR0 = issue_tile33(RRu, (unsigned)(64 * wid) * 2u, false, false, lane), tK0 = issue_tile33(RKHu, (unsigned)(64 * wid) * 2u, false, false, lane);
            const Tile33 tR1 = issue_tile33(RRu, (unsigned)(64 * wid + 32) * 2u, false, false, lane), tK1 = issue_tile33(RKHu, (unsigned)(64 * wid + 32) * 2u, false, false, lane);
            float yv[2][16], sy[16], sq[16], sb[16];
#pragma unroll
            for (int r = 0; r < 16; ++r) { sy[r] = 0.f; sq[r] = 0.f; sb[r] = 0.f; }
#pragma unroll
            for (int cb = 0; cb < 2; ++cb) { const int c = 64 * wid + 32 * cb + r32; const float rkc = r_k[c];
                commit_tile33(cb == 0 ? tR0 : tR1, sl0, false, lane); commit_tile33(cb == 0 ? tK0 : tK1, sl1, false, lane);
                asm volatile("" : "+v"(off[0]), "+v"(off[1]), "+v"(off[2]), "+v"(off[3]), "+v"(off[4]), "+v"(off[5]), "+v"(off[6]), "+v"(off[7]), "+v"(off[8]), "+v"(off[9]), "+v"(off[10]), "+v"(off[11]), "+v"(off[12]), "+v"(off[13]), "+v"(off[14]), "+v"(off[15]));
#pragma unroll
                for (int r = 0; r < 16; ++r) { const unsigned o = off[r]; const int ci = 32 * cb; const float y = at_b(Yu, 2u * o)[ci]; yv[cb][r] = y; sy[r] += y; sq[r] += y * y; const int so = (1 + (r & 3) + 8 * (r >> 2)) * RW_SP + lo_; sb[r] += bf2f(sl0[so]) * bf2f(sl1[so]) * rkc; } }
            const Tile33 tV0 = issue_tile33(RVu, (unsigned)(64 * wid) * 2u, false, false, lane), tV1 = issue_tile33(RVu, (unsigned)(64 * wid + 32) * 2u, false, false, lane);
#pragma unroll
            for (int r = 0; r < 16; ++r) { const float mean = half_sum32(sy[r]) * (1.0f / 64.0f); const float ex2 = half_sum32(sq[r]) * (1.0f / 64.0f); sb[r] = half_sum32(sb[r]);
                sy[r] = mean; sq[r] = rsqrtf(fmaxf(ex2 - mean * mean, 0.f) + 64e-5f); }
#pragma unroll
            for (int cb = 0; cb < 2; ++cb) { const int c = 64 * wid + 32 * cb + r32;
                f32x16 dg;
#pragma unroll
                for (int r = 0; r < 16; ++r) dg[r] = 0.f;
#pragma unroll
                for (int kk = 0; kk < 16; ++kk) { const bf16x8 wg = *(const bf16x8*)(LG + c * 256 + 16 * kk + 8 * hi); const bf16x8 xg = *(const LAS bf16x8*)(AG + r32 * RW_AG + 16 * kk + 8 * hi);
                    dg = __builtin_amdgcn_mfma_f32_32x32x16_bf16(xg, wg, dg, 0, 0, 0); }
                const float lgc = lnx_g[c], lbc = lnx_b[c];
                commit_tile33(cb == 0 ? tV0 : tV1, sl0, false, lane);
#pragma unroll
                for (int r = 0; r < 16; ++r) { const int tk = (r & 3) + 8 * (r >> 2); const float v = bf2f(sl0[(1 + tk) * RW_SP + lo_]);
                    st0[tk * RW_SP + lo_] = (bf16)f2bf(((yv[cb][r] - sy[r]) * sq[r] * lgc + lbc + sb[r] * v) * dg[r]); }
                flush_tile32(st0, CATu, (unsigned)(64 * wid + 32 * cb) * 2u, lane, 4096u);
            }
        }
        if (has_next) RW5_STORE(kbuf ^ 1);
        __syncthreads();
        if (!has_next) break;
        u = un;
    }
#undef RW5_LOAD
#undef RW5_STORE
}
__device__ __forceinline__ void* launder_ptr(const void* p) {
    unsigned lo = (unsigned)(uintptr_t)p, hi = (unsigned)((uintptr_t)p >> 32); asm volatile("" : "+v"(lo), "+v"(hi));
    lo = __builtin_amdgcn_readfirstlane(lo); hi = __builtin_amdgcn_readfirstlane(hi); return (void*)(((uintptr_t)hi << 32) | lo);
}
#ifndef MK_PER_PHASE
#define MK_PER_PHASE 0
#endif
constexpr int PH_PER_LAYER = 13, N_PHASES = DEPTH * PH_PER_LAYER + 1;
struct Args { const float* in[23]; float* out; unsigned char* ws; int ph_lo, ph_hi; };
#define FRESH() do { KA = (const CAS Args*)launder_ptr((const void*)(uintptr_t)__builtin_amdgcn_kernarg_segment_ptr()); C.ws = KA->ws; C.out = KA->out; ctl = (unsigned*)(C.ws + WS_CTL); asm volatile("" : "+v"(C.tid)); C.lane = C.tid & 63; C.wave = __builtin_amdgcn_readfirstlane(C.tid >> 6); C.lds = (LAS unsigned char*)lds_raw; } while (0)
#ifndef ATT_REP
#define ATT_REP 1
#endif
#ifndef REP_MASK
#define REP_MASK 0u
#endif
#ifndef ONLY_PH
#define ONLY_PH -1
#endif
#ifndef PH_MASK
#define PH_MASK 0xFFFFFFFFu
#endif
#define IN(k) (lo <= (k) && (k) < hi && (ONLY_PH < 0 || ((k) % PH_PER_LAYER) == ONLY_PH) && ((PH_MASK >> ((k) % PH_PER_LAYER)) & 1u))
#define SEAM(k) do { if (IN(k) && IN((k) + 1)) { bar.bar = ctl + CW_BAR; xcd_barrier(bar); } } while (0)
#define PH_BODY(k, ...) do { FRESH(); if (IN(p0 + (k))) { __VA_ARGS__; if ((REP_MASK >> (k)) & 1u) { xcd_barrier(bar); FRESH(); __VA_ARGS__; } } SEAM(p0 + (k)); } while (0)
template <int layer>
__device__ __forceinline__ void layer_phases(Ctx& C, const CAS Args*& KA, XcdBarrier& bar, unsigned*& ctl, unsigned char* lds_raw, const int lo, const int hi) {
    const int p0 = layer * PH_PER_LAYER;
    PH_BODY(0, { const WSrc W{KA->in[2], KA->in[3], KA->in[18], KA->in[20], KA->in[21], KA->in[7], KA->in[9], KA->in[12], KA->in[11], KA->in[1], KA->in[19]}; phase_wconv(C, layer, W);
                 if (layer == 0) phase_xg(C, KA->in[0], (bf16*)C.out, (float*)(C.ws + WS_SS1)); });
    PH_BODY(1, { pg8::Gemm g{(const pg8::bf16_t*)C.out, (const pg8::bf16_t*)(C.ws + WS_WIN), M, N_INP, DM}; pg8::StaticOrder S; S.init(M, N_INP, C.G, C.bid);
                 pg8::EpiProj E{C.ws, (const float*)(C.ws + WS_SS1)}; pg8::gemm_phase<pg8::EpiProj, pg8::StaticOrder, true, true>(C.lds, g, S, E); });
    FRESH(); if (IN(p0 + 2)) phase_prep_a(C); SEAM(p0 + 2);
    PH_BODY(3, { phase_indexer(C); __syncthreads(); phase_ret1(C); });
    FRESH(); if (IN(p0 + 4)) { for (int rep_a = 0; rep_a < ATT_REP; ++rep_a) { phase_attn(C); __syncthreads(); } phase_ret2(C); } SEAM(p0 + 4);
    PH_BODY(5, { const RwP P{KA->in[4], KA->in[5], KA->in[6], KA->in[8], KA->in[10], KA->in[13], KA->in[14], KA->in[15], KA->in[16], KA->in[17]}; phase_rw1(C, layer, P); });
    PH_BODY(6, { phase_rw2(C); });
    PH_BODY(7, { if (C.G == 256) {
                      if (C.bid < 32) { phase_rw3(C); __syncthreads(); Ctx C2 = C; C2.bid = 2016 + C.bid; C2.G = 4096; phase_ret3(C2); } else { Ctx C2 = C; C2.bid = C.bid - 32; C2.G = 224; phase_ret3(C2, 2016); } }
                  else if (C.G > 64) { if (C.bid < 32) phase_rw3(C); else { Ctx C2 = C; C2.bid = C.bid - 32; C2.G = C.G - 32; phase_ret3(C2); } } else { phase_rw3(C); __syncthreads(); phase_ret3(C); } });
    PH_BODY(8, { phase_rw4(C); });
    PH_BODY(9, { const RwP P{KA->in[4], KA->in[5], KA->in[6], KA->in[8], KA->in[10], KA->in[13], KA->in[14], KA->in[15], KA->in[16], KA->in[17]}; phase_rw5(C, layer, P); });
    FRESH(); if (IN(p0 + 10)) { pg8::Gemm g{(const pg8::bf16_t*)(C.ws + WS_CAT), (const pg8::bf16_t*)(C.ws + WS_WOUT), M, DM, DM}; pg8::StaticOrder S; S.init(M, DM, C.G, C.bid);
        pg8::EpiResid E{(const pg8::bf16_t*)C.out, (pg8::bf16_t*)C.out, DM, (float*)(C.ws + WS_SS2)}; pg8::gemm_phase<pg8::EpiResid, pg8::StaticOrder, true, true>(C.lds, g, S, E); }
    SEAM(p0 + 10);
    PH_BODY(11, { pg8::Gemm g{(const pg8::bf16_t*)C.out, (const pg8::bf16_t*)(C.ws + WS_WGU), M, 2 * DFF, DM}; pg8::StaticOrder S; S.init(M, 2 * DFF, C.G, C.bid);
                  pg8::EpiSwiGLU E{(pg8::bf16_t*)(C.ws + WS_ACT), DFF, (const float*)(C.ws + WS_SS2)}; pg8::gemm_phase<pg8::EpiSwiGLU, pg8::StaticOrder, true, true>(C.lds, g, S, E); });
    FRESH(); if (IN(p0 + 12)) { pg8::Gemm g{(const pg8::bf16_t*)(C.ws + WS_ACT), (const pg8::bf16_t*)(C.ws + WS_WDN), M, DM, DFF}; pg8::StaticOrder S; S.init(M, DM, C.G, C.bid);
        pg8::EpiResid E{(const pg8::bf16_t*)C.out, layer + 1 < DEPTH ? (pg8::bf16_t*)C.out : (pg8::bf16_t*)(C.ws + WS_CAT), DM, (float*)(C.ws + WS_SS1)};
        pg8::gemm_phase<pg8::EpiResid, pg8::StaticOrder, true, true>(C.lds, g, S, E); }
    SEAM(p0 + 12);
}
__global__ void __launch_bounds__(NTHR, 2) fwd_kernel(Args args) {
    extern __shared__ __attribute__((aligned(16))) unsigned char lds_raw[];
    Ctx C;
    C.lds = (LAS unsigned char*)lds_raw; C.tid = threadIdx.x; C.lane = C.tid & 63; C.wave = __builtin_amdgcn_readfirstlane(C.tid >> 6);
    C.G = gridDim.x; C.bid = blockIdx.x;
    const CAS Args* KA = (const CAS Args*)launder_ptr((const void*)(uintptr_t)__builtin_amdgcn_kernarg_segment_ptr());
    C.ws = KA->ws; C.out = KA->out;
    volatile LAS unsigned* MISC = (volatile LAS unsigned*)(C.lds + MISC_OFF);
    if (C.tid < 32) MISC[C.tid] = 0u;
    __syncthreads();
    unsigned* ctl = (unsigned*)(C.ws + WS_CTL);
    XcdBarrier bar; bar.bar = ctl + CW_BAR; bar.x = 0; bar.st = nullptr;
    if (!MK_PER_PHASE) bar = xcd_barrier_post(ctl + CW_BAR, MISC + 8);
    const int lo = KA->ph_lo, hi = KA->ph_hi;
    layer_phases<0>(C, KA, bar, ctl, lds_raw, lo, hi);
    layer_phases<1>(C, KA, bar, ctl, lds_raw, lo, hi);
    FRESH(); if (IN(N_PHASES - 1)) phase_final_norm(C, (const bf16*)(C.ws + WS_CAT), C.out, KA->in[22], (const float*)(C.ws + WS_SS1));
#undef IN
#undef SEAM
}

extern "C" void kernel_launch(void* const* d_in, const int* in_sizes, int n_in, void* d_out, int out_size, void* d_ws, size_t ws_size, hipStream_t stream) {
    static int grid = 0;
    if (grid == 0) {
        if (n_in != 23 || out_size != M * DM || ws_size < WS_NEED) { fprintf(stderr, "kernel_launch: unexpected problem (n_in %d, out %d, ws %zu); nothing launched\n", n_in, out_size, ws_size); grid = -1; return; }
        int dev = 0, cus = 0, per_cu = 0;
        if (hipGetDevice(&dev) != hipSuccess || hipDeviceGetAttribute(&cus, hipDeviceAttributeMultiprocessorCount, dev) != hipSuccess) { grid = -1; return; }
        if (hipFuncSetAttribute((const void*)fwd_kernel, hipFuncAttributeMaxDynamicSharedMemorySize, LDS_BYTES) != hipSuccess) { fprintf(stderr, "kernel_launch: hipFuncSetAttribute failed\n"); grid = -1; return; }
        if (hipOccupancyMaxActiveBlocksPerMultiprocessor(&per_cu, (const void*)fwd_kernel, NTHR, LDS_BYTES) != hipSuccess || per_cu < 1) { fprintf(stderr, "kernel_launch: occupancy query says %d blocks per CU\n", per_cu); }
        (void)hipGetLastError();
        grid = cus;
    }
    if (grid < 0) return;
    (void)hipMemsetAsync((char*)d_ws + WS_CTL, 0, CTL_ZERO_BYTES, stream);
    Args a{};
    for (int i = 0; i < 23; ++i) a.in[i] = (const float*)d_in[i];
    a.out = (float*)d_out; a.ws = (unsigned char*)d_ws;
#if MK_PER_PHASE
    for (int p = 0; p < N_PHASES; ++p) { a.ph_lo = p; a.ph_hi = p + 1; hipLaunchKernelGGL(fwd_kernel, dim3(grid), dim3(NTHR), LDS_BYTES, stream, a); }
#else
    a.ph_lo = 0; a.ph_hi = N_PHASES;
    hipLaunchKernelGGL(fwd_kernel, dim3(grid), dim3(NTHR), LDS_BYTES, stream, a);
#endif
    const hipError_t le = hipPeekAtLastError();
    if (le != hipSuccess) fprintf(stderr, "kernel_launch: launch failed: %s\n", hipGetErrorName(le));
}
```
